# Optimizing an MI355X kernel written in HIP

```python
import math
import jax, jax.numpy as jnp
from jax import lax
import numpy as np


D_MODEL = 1024
BATCH = 16
SEQ = 2048
DEPTH = 4

GRID_W = 64
CTX_LEN = 256
DIFF_HEADS = D_MODEL // 256
DIFF_QK_DIM = 64
DIFF_V_DIM = 2 * DIFF_QK_DIM
DIFF_WIDTH = DIFF_HEADS * DIFF_V_DIM
GLA_HEADS = D_MODEL // 256
GLA_DK = 64
GLA_DV = 128
GLA_WIDTH = GLA_HEADS * GLA_DV
GLA_GATE_RANK = 16
GLA_GATE_NORMALIZER = 16.0
GLA_CHUNK = 64
MIX_WIDTH = DIFF_WIDTH + GLA_WIDTH
Q_BLOCK = 128
ROPE_THETA = 10000.0
D_FF = 2816
N_EXPERTS = 8
TOP_K = 2
N_DENSE = (DEPTH + 1) // 2
N_MOE = DEPTH // 2
N_MOD = 6
EPS = 1e-6
IN_SIZES = (2 * DIFF_HEADS * DIFF_QK_DIM, 2 * DIFF_HEADS * DIFF_QK_DIM, DIFF_WIDTH, GLA_HEADS * GLA_DK, GLA_HEADS * GLA_DK, GLA_WIDTH, GLA_WIDTH, 2 * GLA_GATE_RANK)
IN_OFFSETS = tuple(int(o) for o in np.cumsum(IN_SIZES)[:-1])
N_IN = int(sum(IN_SIZES))

kernel_name = 'hybrid_diffattn_gla_moe_dit_block'


def rms_norm(x, g):
    xf = x.astype(jnp.float32)
    y = xf * lax.rsqrt(jnp.mean(xf * xf, axis=-1, keepdims=True) + EPS)
    return (y * g.astype(jnp.float32)).astype(x.dtype)


def rope_tables(n_tokens, dtype):
    rows_n = n_tokens // GRID_W
    row = jnp.repeat(jnp.arange(rows_n), GRID_W).astype(jnp.float32)
    col = jnp.tile(jnp.arange(GRID_W), rows_n).astype(jnp.float32)
    n_freq = DIFF_QK_DIM // 4
    inv = ROPE_THETA ** (-jnp.arange(n_freq, dtype=jnp.float32) / n_freq)
    ang_r = row[:, None] * inv
    ang_c = col[:, None] * inv
    return (jnp.cos(ang_r).astype(dtype), jnp.sin(ang_r).astype(dtype),
            jnp.cos(ang_c).astype(dtype), jnp.sin(ang_c).astype(dtype))


def apply_rot(x, cos, sin):
    x1, x2 = jnp.split(x, 2, axis=-1)
    c = cos[None, :, None, :]
    s = sin[None, :, None, :]
    return jnp.concatenate([x1 * c - x2 * s, x1 * s + x2 * c], axis=-1)


def rope_2d(x, tabs):
    cr, sr, cc, sc = tabs
    half = x.shape[-1] // 2
    return jnp.concatenate([apply_rot(x[..., :half], cr, sr), apply_rot(x[..., half:], cc, sc)], axis=-1)


def diff_attn_core(q1, q2, k1, k2, v, lam):
    scale = DIFF_QK_DIM ** -0.5
    s1 = jnp.einsum('bqhd,bkhd->bhqk', q1, k1).astype(jnp.float32) * scale
    s2 = jnp.einsum('bqhd,bkhd->bhqk', q2, k2).astype(jnp.float32) * scale
    a = jax.nn.softmax(s1, axis=-1) - lam * jax.nn.softmax(s2, axis=-1)
    return jnp.einsum('bhqk,bkhe->bqhe', a.astype(v.dtype), v)


def diff_attn_blocked(q1, q2, k1, k2, v, lam):
    b, s, h, d = q1.shape
    nb = s // Q_BLOCK
    to_blocks = lambda q: q.reshape(b, nb, Q_BLOCK, h, d).transpose(1, 0, 2, 3, 4)
    o = lax.map(lambda qq: diff_attn_core(qq[0], qq[1], k1, k2, v, lam), (to_blocks(q1), to_blocks(q2)))
    return o.transpose(1, 0, 2, 3, 4).reshape(b, s, h, v.shape[-1])


def gla_chunked(q, k, v, glog, s0):
    b, s, h, dk = q.shape
    dv = v.shape[-1]
    C = GLA_CHUNK
    nc = s // C
    f32 = jnp.float32
    qc = q.reshape(b, nc, C, h, dk).astype(f32)
    kc = k.reshape(b, nc, C, h, dk).astype(f32)
    vc = v.reshape(b, nc, C, h, dv).astype(f32)
    g = jnp.cumsum(glog.reshape(b, nc, C, h, dk).astype(f32), axis=2)
    g_last = g[:, :, -1:]
    g_mid = g[:, :, C // 2 - 1:C // 2]
    att = jnp.einsum('bnihk,bnjhk->bnhij', qc * jnp.exp(g - g_mid), kc * jnp.exp(g_mid - g))
    att = jnp.where(jnp.tril(jnp.ones((C, C), dtype=bool)), att, 0.0)
    o_intra = jnp.einsum('bnhij,bnjhv->bnihv', att, vc)
    ds = jnp.einsum('bnjhk,bnjhv->bnhkv', kc * jnp.exp(g_last - g), vc)
    decay = jnp.exp(g_last[:, :, 0])

    def step(state, inp):
        dec, d_s = inp
        return dec[..., None] * state + d_s, state

    s_final, s_prev = lax.scan(step, s0.astype(f32), (jnp.moveaxis(decay, 1, 0), jnp.moveaxis(ds, 1, 0)))
    s_prev = jnp.moveaxis(s_prev, 0, 1)
    o_inter = jnp.einsum('bnihk,bnhkv->bnihv', qc * jnp.exp(g), s_prev)
    o = (o_intra + o_inter).reshape(b, s, h, dv).astype(v.dtype)
    return o, s_final


def gla_bidir(q, k, v, gl_f, gl_b, s0_f, s0_b):
    flip = lambda t: t[:, ::-1]
    o_f, s_f = gla_chunked(q, k, v, gl_f, s0_f)
    o_b, s_b = gla_chunked(flip(q), flip(k), flip(v), flip(gl_b), s0_b)
    return o_f + flip(o_b), s_f, s_b


def gla_gates(glr, gate_w2, gate_b):
    b, s = glr.shape[:2]
    z = jnp.einsum('bsdr,drk->bsdk', glr, gate_w2) + gate_b
    gl = (jax.nn.log_sigmoid(z.astype(jnp.float32)) / GLA_GATE_NORMALIZER).reshape(b, s, 2, GLA_HEADS, GLA_DK)
    return gl[:, :, 0], gl[:, :, 1]


def split_proj(p):
    b, s = p.shape[:2]
    dq, dk, dv, gq, gk, gv, gg, glr = jnp.split(p, IN_OFFSETS, axis=-1)
    dq = dq.reshape(b, s, DIFF_HEADS, 2, DIFF_QK_DIM)
    dk = dk.reshape(b, s, DIFF_HEADS, 2, DIFF_QK_DIM)
    dv = dv.reshape(b, s, DIFF_HEADS, DIFF_V_DIM)
    gq = gq.reshape(b, s, GLA_HEADS, GLA_DK) * (GLA_DK ** -0.5)
    gk = gk.reshape(b, s, GLA_HEADS, GLA_DK)
    gv = gv.reshape(b, s, GLA_HEADS, GLA_DV)
    glr = glr.reshape(b, s, 2, GLA_GATE_RANK)
    return dq[..., 0, :], dq[..., 1, :], dk[..., 0, :], dk[..., 1, :], dv, gq, gk, gv, gg, glr


def token_mixer(h_lat, h_ctx, w_in, gate_w2, gate_b, lam_vec, lam_init, subln_g, onorm_g, w_out, rope_tabs, with_ctx_out):
    f32 = jnp.float32
    lv = lam_vec.astype(f32)
    lam = jnp.exp(jnp.sum(lv[0] * lv[1])) - jnp.exp(jnp.sum(lv[2] * lv[3])) + lam_init
    q1l, q2l, k1l, k2l, vl, gql, gkl, gvl, ggl, glrl = split_proj(h_lat @ w_in)
    q1c, q2c, k1c, k2c, vc, gqc, gkc, gvc, ggc, glrc = split_proj(h_ctx @ w_in)
    q1l, q2l, k1l, k2l = (rope_2d(t, rope_tabs) for t in (q1l, q2l, k1l, k2l))
    k1a = jnp.concatenate([k1c, k1l], axis=1)
    k2a = jnp.concatenate([k2c, k2l], axis=1)
    va = jnp.concatenate([vc, vl], axis=1)
    od_lat = diff_attn_blocked(q1l, q2l, k1a, k2a, va, lam)
    gf_c, gb_c = gla_gates(glrc, gate_w2, gate_b)
    gf_l, gb_l = gla_gates(glrl, gate_w2, gate_b)
    s0 = jnp.zeros((h_ctx.shape[0], GLA_HEADS, GLA_DK, GLA_DV), f32)
    og_ctx, s_f, s_b = gla_bidir(gqc, gkc, gvc, gf_c, gb_c, s0, s0)
    og_lat, _, _ = gla_bidir(gql, gkl, gvl, gf_l, gb_l, s_f, s_b)

    def merge(o_diff, o_gla, g_out):
        b, s = o_diff.shape[:2]
        od = (rms_norm(o_diff, subln_g) * (1.0 - lam_init)).reshape(b, s, DIFF_WIDTH)
        og = rms_norm(o_gla, onorm_g).reshape(b, s, GLA_WIDTH) * jax.nn.silu(g_out)
        return jnp.concatenate([od, og], axis=-1) @ w_out

    y_lat = merge(od_lat, og_lat, ggl)
    y_ctx = None
    if with_ctx_out:
        od_ctx = diff_attn_core(q1c, q2c, k1c, k2c, vc, lam)
        y_ctx = merge(od_ctx, og_ctx, ggc)
    return y_lat, y_ctx


def swiglu(h, w1, w3, w2):
    return (jax.nn.silu(h @ w1) * (h @ w3)) @ w2


def moe_ffn(h, router, w1, w3, w2):
    shape = h.shape
    ht = h.reshape(-1, shape[-1])
    logits = (ht @ router).astype(jnp.float32)
    top_v, top_i = lax.top_k(logits, TOP_K)
    wts = jax.nn.softmax(top_v, axis=-1)
    combine = jnp.sum(jax.nn.one_hot(top_i, N_EXPERTS, dtype=jnp.float32) * wts[..., None], axis=1).astype(h.dtype)

    def expert_step(acc, p):
        e1, e3, e2, cw = p
        return acc + cw[:, None] * swiglu(ht, e1, e3, e2), None

    out, _ = lax.scan(expert_step, jnp.zeros_like(ht), (w1, w3, w2, combine.T))
    return out.reshape(shape)


def setup_inputs(seed: int = 0) -> dict:
    key = jax.random.key(seed)
    ks = jax.random.split(key, 24)
    f32 = jnp.float32
    nrm = lambda k, shape, s: jax.random.normal(k, shape, f32) * s
    gain = lambda k, shape: 1.0 + 0.02 * jax.random.normal(k, shape, f32)
    return {
        'x': nrm(ks[0], (BATCH, SEQ, D_MODEL), 1.0),
        'c': nrm(ks[1], (BATCH, D_MODEL), 1.0),
        'ctx': nrm(ks[2], (BATCH, CTX_LEN, D_MODEL), 1.0),
        'c_ctx': nrm(ks[3], (D_MODEL,), 1.0),
        'w_mod': nrm(ks[4], (DEPTH, D_MODEL, N_MOD * D_MODEL), 0.5 * D_MODEL ** -0.5),
        'b_mod': nrm(ks[5], (DEPTH, N_MOD * D_MODEL), 0.02),
        'g_pre_mix': gain(ks[6], (DEPTH, D_MODEL)),
        'g_post_mix': gain(ks[7], (DEPTH, D_MODEL)),
        'g_pre_ffn': gain(ks[8], (DEPTH, D_MODEL)),
        'g_post_ffn': gain(ks[9], (DEPTH, D_MODEL)),
        'w_in': nrm(ks[10], (DEPTH, D_MODEL, N_IN), D_MODEL ** -0.5),
        'gla_gate_w2': nrm(ks[11], (DEPTH, 2, GLA_GATE_RANK, GLA_HEADS * GLA_DK), GLA_GATE_RANK ** -0.5),
        'gla_gate_b': nrm(ks[12], (DEPTH, 2, GLA_HEADS * GLA_DK), 0.1),
        'diff_lambda': nrm(ks[13], (DEPTH, 4, DIFF_QK_DIM), 0.1),
        'diff_subln': gain(ks[14], (DEPTH, DIFF_V_DIM)),
        'gla_onorm': gain(ks[15], (DEPTH, GLA_DV)),
        'w_out': nrm(ks[16], (DEPTH, MIX_WIDTH, D_MODEL), MIX_WIDTH ** -0.5),
        'ffn_w1': nrm(ks[17], (N_DENSE, D_MODEL, D_FF), D_MODEL ** -0.5),
        'ffn_w3': nrm(ks[18], (N_DENSE, D_MODEL, D_FF), D_MODEL ** -0.5),
        'ffn_w2': nrm(ks[19], (N_DENSE, D_FF, D_MODEL), D_FF ** -0.5),
        'router': nrm(ks[20], (N_MOE, D_MODEL, N_EXPERTS), D_MODEL ** -0.5),
        'moe_w1': nrm(ks[21], (N_MOE, N_EXPERTS, D_MODEL, D_FF), D_MODEL ** -0.5),
        'moe_w3': nrm(ks[22], (N_MOE, N_EXPERTS, D_MODEL, D_FF), D_MODEL ** -0.5),
        'moe_w2': nrm(ks[23], (N_MOE, N_EXPERTS, D_FF, D_MODEL), D_FF ** -0.5),
    }


def reference(x, c, ctx, c_ctx, w_mod, b_mod, g_pre_mix, g_post_mix, g_pre_ffn, g_post_ffn, w_in, gla_gate_w2, gla_gate_b, diff_lambda, diff_subln, gla_onorm, w_out, ffn_w1, ffn_w3, ffn_w2, router, moe_w1, moe_w3, moe_w2):
    rope_tabs = rope_tables(x.shape[1], x.dtype)
    silu_c = jax.nn.silu(c)
    silu_cc = jax.nn.silu(c_ctx)
    xc = ctx
    for l in range(DEPTH):
        last = l == DEPTH - 1
        lam_init = 0.8 - 0.6 * math.exp(-0.3 * l)
        sh1, sc1, gt1, sh2, sc2, gt2 = (m[:, None] for m in jnp.split(silu_c @ w_mod[l] + b_mod[l], N_MOD, axis=-1))
        csh1, csc1, cgt1, csh2, csc2, cgt2 = jnp.split(silu_cc @ w_mod[l] + b_mod[l], N_MOD, axis=-1)
        h = rms_norm(x, g_pre_mix[l]) * (1.0 + sc1) + sh1
        hc = rms_norm(xc, g_pre_mix[l]) * (1.0 + csc1) + csh1
        y, yc = token_mixer(h, hc, w_in[l], gla_gate_w2[l], gla_gate_b[l], diff_lambda[l], lam_init,
                            diff_subln[l], gla_onorm[l], w_out[l], rope_tabs, not last)
        x = x + gt1 * rms_norm(y, g_post_mix[l])
        if not last:
            xc = xc + cgt1 * rms_norm(yc, g_post_mix[l])
        if l % 2 == 0:
            ffn = lambda t, i=l // 2: swiglu(t, ffn_w1[i], ffn_w3[i], ffn_w2[i])
        else:
            ffn = lambda t, i=l // 2: moe_ffn(t, router[i], moe_w1[i], moe_w3[i], moe_w2[i])
        h = rms_norm(x, g_pre_ffn[l]) * (1.0 + sc2) + sh2
        x = x + gt2 * rms_norm(ffn(h), g_post_ffn[l])
        if not last:
            hc = rms_norm(xc, g_pre_ffn[l]) * (1.0 + csc2) + csh2
            xc = xc + cgt2 * rms_norm(ffn(hc), g_post_ffn[l])
    return x
```

```cpp
#include <hip/hip_runtime.h>
#include <cstdio>
#include <cstdint>
namespace pg8 {
#define PG8_LAS __attribute__((address_space(3)))
typedef unsigned short bf16_t;
typedef short bf16x8 __attribute__((ext_vector_type(8)));
typedef float f32x4 __attribute__((ext_vector_type(4)));
typedef unsigned u32x4 __attribute__((ext_vector_type(4)));
constexpr int BM = 256, BK = 64, HALF = 128, HTB = HALF * BK * 2  , STAGE_BYTES = 8 * HTB, NXCD = 8, WGM = 8;

__host__ __device__ __forceinline__ int lds_byte(int r, int c) { const int st = (r >> 4) * 2 + (c >> 5), rr = r & 15, cc = c & 31, ob = rr * 64 + cc * 2; return st * 1024 + (ob ^ (((ob >> 9) & 1) << 5)); }
__host__ __device__ __forceinline__ void stage_rc(int b, int& R, int& C) { const int st = b / 1024, sb = b % 1024, swz = sb ^ (((sb >> 9) & 1) << 5); R = (st >> 1) * 16 + swz / 64; C = (st & 1) * 32 + (swz % 64) / 2; }
__host__ __device__ __forceinline__ int perm32(int rho) { const int n = rho >> 4, i = rho & 15; return 8 * (i >> 2) + 4 * n + (i & 3); }

struct Unit { int pm, pn; };
struct Gemm { const bf16_t* A; const bf16_t* Bt; int M, N, K; };

struct StaticOrder {
    int nM, nN, nwg, G, c;
    __host__ __device__ void init(int M, int N, int G_, int c_) { nM = M / BM; nN = N / BM; nwg = nM * nN; G = G_; c = c_; }
    __host__ __device__ bool next(int i, Unit& u) const {
        const long L = (long)i * G + c; if (L >= nwg) return false;
        int wgid = (int)L; { const int q = nwg / NXCD, r = nwg % NXCD, xcd = wgid % NXCD, off = wgid / NXCD; wgid = (xcd < r ? xcd * (q + 1) : r * (q + 1) + (xcd - r) * q) + off; }
        const int nig = WGM * nN, gid = wgid / nig, fm = gid * WGM, gsz = (nM - fm) < WGM ? (nM - fm) : WGM;
        u.pm = fm + ((wgid % nig) % gsz); u.pn = (wgid % nig) / gsz; return true;
    }
    __device__ __forceinline__ void a_ready(const Unit&) const {}
    __device__ __forceinline__ void done(const Unit&) const {}
};

__device__ __forceinline__ unsigned cvt_pk_bf16(float lo, float hi) { unsigned r; asm volatile("v_cvt_pk_bf16_f32 %0, %1, %2" : "=v"(r) : "v"(lo), "v"(hi)); return r; }
typedef float f32x2 __attribute__((ext_vector_type(2)));
template <class Epi, class Sched, bool ALIGN_EPI = false, bool SP2 = false>
__device__ __forceinline__ void gemm_phase(PG8_LAS unsigned char* lds, const Gemm g, const Sched& S, const Epi& E) {
    int tid_ = threadIdx.x; asm volatile("" : "+v"(tid_));
    const int tid = tid_, wid = __builtin_amdgcn_readfirstlane(tid >> 6), lane = tid & 63, wr = wid >> 2, wc = wid & 3, fr = lane & 15, fq = lane >> 4;
    const int K = g.K, nt = K / BK;
    unsigned voffA[2], voffB[2];
#pragma unroll
    for (int i = 0; i < 2; ++i) { int R, C; stage_rc(tid * 16 + i * 8192, R, C); const int Rb = Epi::PERM ? ((R & ~31) + perm32(R & 31)) : R;
        voffA[i] = (unsigned)(R * K + C) * 2u; voffB[i] = (unsigned)(Rb * K + C) * 2u; }
    const size_t kstep = (size_t)(BK * 2);
    const size_t hstep = (size_t)HALF * K * 2;
    const size_t tstep = 2 * hstep;
    const unsigned ldsw = (unsigned)wid * 1024u;
    const int aoff = lds_byte(wr * 64 + fr, fq * 8), boff = lds_byte(wc * 32 + fr, fq * 8);
#define PG8_SA(b, h) (((b) * 2 + (h)) * HTB)
#define PG8_SB(b, h) ((4 + (b) * 2 + (h)) * HTB)
#define PG8_STAGE(bufoff, gbase, voff) do { _Pragma("unroll") for (int _i = 0; _i < 2; ++_i) \
        __builtin_amdgcn_global_load_lds((const unsigned*)((const char*)(gbase) + (voff)[_i]), (PG8_LAS unsigned*)(lds + (bufoff) + ldsw + _i * 8192), 16, 0, 0); } while (0)
#define PG8_LDA(dst, b, h) do { _Pragma("unroll") for (int m = 0; m < 4; ++m) _Pragma("unroll") for (int k = 0; k < 2; ++k) dst[m][k] = *(const PG8_LAS bf16x8*)(lds + PG8_SA(b, h) + aoff + m * 2048 + k * 1024); } while (0)
#define PG8_LDB(dst, b, h) do { _Pragma("unroll") for (int n = 0; n < 2; ++n) _Pragma("unroll") for (int k = 0; k < 2; ++k) dst[n][k] = *(const PG8_LAS bf16x8*)(lds + PG8_SB(b, h) + boff + n * 2048 + k * 1024); } while (0)
#define PG8_MMA(ai, bj, At, Bt) do { __builtin_amdgcn_s_setprio(1); _Pragma("unroll") for (int m = 0; m < 4; ++m) _Pragma("unroll") for (int n = 0; n < 2; ++n) _Pragma("unroll") for (int k = 0; k < 2; ++k) \
        acc[ai][bj][m][n] = __builtin_amdgcn_mfma_f32_16x16x32_bf16(Bt[n][k], At[m][k], acc[ai][bj][m][n], 0, 0, 0); __builtin_amdgcn_s_setprio(0); } while (0)
#define PG8_WAIT_V(n) asm volatile("s_waitcnt vmcnt(" #n ")" ::: "memory")
#define PG8_WAIT_L(n) asm volatile("s_waitcnt lgkmcnt(" #n ")" ::: "memory")
#define PG8_BAR __builtin_amdgcn_s_barrier()
#define PG8_SCHED __builtin_amdgcn_sched_barrier(0)
    Unit cur, nxt; int ui = 0;
    if (!S.next(0, cur)) return;
    f32x4 acc[2][2][4][2];
#pragma unroll
    for (int a = 0; a < 2; ++a)
#pragma unroll
        for (int b = 0; b < 2; ++b)
#pragma unroll
            for (int m = 0; m < 4; ++m)
#pragma unroll
                for (int n = 0; n < 2; ++n) acc[a][b][m][n] = (f32x4){0.f, 0.f, 0.f, 0.f};
    bf16x8 At[4][2], B0[2][2], B1[2][2];
    const char* cA = (const char*)g.A + (size_t)cur.pm * tstep; const char* cB = (const char*)g.Bt + (size_t)cur.pn * tstep;
    S.a_ready(cur);
    if constexpr (SP2) {
        PG8_STAGE(PG8_SB(0, 0), cB, voffB); PG8_STAGE(PG8_SB(0, 1), cB + hstep, voffB); PG8_STAGE(PG8_SA(0, 0), cA, voffA); PG8_STAGE(PG8_SA(0, 1), cA + hstep, voffA);
        if (wr == 1) PG8_BAR;
        PG8_WAIT_V(2); PG8_BAR;
        PG8_STAGE(PG8_SB(1, 0), cB + kstep, voffB); PG8_STAGE(PG8_SA(1, 0), cA + kstep, voffA); PG8_STAGE(PG8_SB(1, 1), cB + hstep + kstep, voffB);
        PG8_WAIT_V(6); PG8_BAR;
    } else {
        PG8_STAGE(PG8_SB(0, 0), cB, voffB); PG8_STAGE(PG8_SA(0, 0), cA, voffA); PG8_STAGE(PG8_SB(0, 1), cB + hstep, voffB); PG8_STAGE(PG8_SA(0, 1), cA + hstep, voffA);
        if (wr == 1) PG8_BAR;
        PG8_WAIT_V(4); PG8_BAR;
        PG8_STAGE(PG8_SB(1, 0), cB + kstep, voffB); PG8_STAGE(PG8_SA(1, 0), cA + kstep, voffA); PG8_STAGE(PG8_SB(1, 1), cB + hstep + kstep, voffB);
        PG8_WAIT_V(6); PG8_BAR;
    }
    for (;;) {
        const bool has_next = S.next(ui + 1, nxt);
        const char* nA = has_next ? (const char*)g.A + (size_t)nxt.pm * tstep : cA; const char* nB = has_next ? (const char*)g.Bt + (size_t)nxt.pn * tstep : cB;
        for (int t = 0; t < nt; t += 2) {
            const bool last = (t == nt - 2);
            const char* a1 = cA + (size_t)(t + 1) * kstep;
            const char* a2 = last ? nA : cA + (size_t)(t + 2) * kstep; const char* b2 = last ? nB : cB + (size_t)(t + 2) * kstep;
            const char* a3 = a2 + kstep; const char* b3 = b2 + kstep;
            if (last && has_next) S.a_ready(nxt);
            if constexpr (SP2) {
            PG8_LDB(B0, 0, 0); PG8_LDB(B1, 0, 1); PG8_SCHED; PG8_LDA(At, 0, 0); PG8_STAGE(PG8_SA(1, 1), a1 + hstep, voffA);
            PG8_WAIT_V(8); PG8_WAIT_L(0); PG8_BAR; PG8_MMA(0, 0, At, B0); PG8_MMA(0, 1, At, B1); PG8_BAR; PG8_SCHED;
            PG8_LDA(At, 0, 1); PG8_STAGE(PG8_SB(0, 0), b2, voffB); PG8_STAGE(PG8_SB(0, 1), b2 + hstep, voffB); PG8_STAGE(PG8_SA(0, 0), a2, voffA);
            PG8_WAIT_V(8); PG8_WAIT_L(0); PG8_BAR; PG8_MMA(1, 0, At, B0); PG8_MMA(1, 1, At, B1); PG8_BAR; PG8_SCHED;
            PG8_LDB(B0, 1, 0); PG8_LDB(B1, 1, 1); PG8_SCHED; PG8_LDA(At, 1, 0); PG8_STAGE(PG8_SA(0, 1), a2 + hstep, voffA);
            PG8_WAIT_V(8); PG8_WAIT_L(0); PG8_BAR; PG8_MMA(0, 0, At, B0); PG8_MMA(0, 1, At, B1); PG8_BAR; PG8_SCHED;
            PG8_LDA(At, 1, 1); PG8_STAGE(PG8_SB(1, 0), b3, voffB); PG8_STAGE(PG8_SB(1, 1), b3 + hstep, voffB); PG8_STAGE(PG8_SA(1, 0), a3, voffA);
            PG8_WAIT_V(8); PG8_WAIT_L(0); PG8_BAR; PG8_MMA(1, 0, At, B0); PG8_MMA(1, 1, At, B1); PG8_BAR; PG8_SCHED;
            } else {
            PG8_LDB(B0, 0, 0); PG8_SCHED; PG8_LDA(At, 0, 0); PG8_STAGE(PG8_SA(1, 1), a1 + hstep, voffA);
            PG8_WAIT_L(8); PG8_BAR; PG8_WAIT_L(0); PG8_MMA(0, 0, At, B0); PG8_BAR; PG8_SCHED;
            PG8_LDB(B1, 0, 1); PG8_STAGE(PG8_SB(0, 0), b2, voffB);
            PG8_BAR; PG8_WAIT_L(0); PG8_MMA(0, 1, At, B1); PG8_BAR;
            PG8_LDA(At, 0, 1); PG8_STAGE(PG8_SA(0, 0), a2, voffA);
            PG8_BAR; PG8_WAIT_L(0); PG8_MMA(1, 0, At, B0); PG8_BAR; PG8_SCHED;
            PG8_STAGE(PG8_SB(0, 1), b2 + hstep, voffB);
            PG8_WAIT_V(6); PG8_BAR; PG8_MMA(1, 1, At, B1); PG8_BAR;
            PG8_LDB(B0, 1, 0); PG8_SCHED; PG8_LDA(At, 1, 0); PG8_STAGE(PG8_SA(0, 1), a2 + hstep, voffA);
            PG8_WAIT_L(8); PG8_BAR; PG8_WAIT_L(0); PG8_MMA(0, 0, At, B0); PG8_BAR; PG8_SCHED;
            PG8_LDB(B1, 1, 1); PG8_STAGE(PG8_SB(1, 0), b3, voffB);
            PG8_BAR; PG8_WAIT_L(0); PG8_MMA(0, 1, At, B1); PG8_BAR;
            PG8_LDA(At, 1, 1); PG8_STAGE(PG8_SA(1, 0), a3, voffA);
            PG8_BAR; PG8_WAIT_L(0); PG8_MMA(1, 0, At, B0); PG8_BAR; PG8_SCHED;
            PG8_STAGE(PG8_SB(1, 1), b3 + hstep, voffB);
            PG8_WAIT_V(6); PG8_BAR; PG8_MMA(1, 1, At, B1); PG8_BAR;
            }
        }
        if constexpr (ALIGN_EPI) { if (wr == 0) PG8_BAR; }
        if constexpr (!Epi::AFTER_DRAIN) { E(acc, cur, wr, wc, fr, fq); S.done(cur); }
        if (!has_next) break;
#pragma unroll
        for (int a = 0; a < 2; ++a)
#pragma unroll
            for (int b = 0; b < 2; ++b)
#pragma unroll
                for (int m = 0; m < 4; ++m)
#pragma unroll
                    for (int n = 0; n < 2; ++n) acc[a][b][m][n] = (f32x4){0.f, 0.f, 0.f, 0.f};
        cur = nxt; cA = nA; cB = nB; ++ui;
        if constexpr (ALIGN_EPI) { if (wr == 1) PG8_BAR; }
    }
    PG8_WAIT_V(0);
    if constexpr (!ALIGN_EPI) { if (wr == 0) PG8_BAR; }
    PG8_BAR;
    if constexpr (Epi::AFTER_DRAIN) { E.fused(acc, cur, wr, wc, fr, fq, lds, wid, lane); S.done(cur); }
#undef PG8_SA
#undef PG8_SB
#undef PG8_STAGE
#undef PG8_LDA
#undef PG8_LDB
#undef PG8_MMA
#undef PG8_WAIT_V
#undef PG8_WAIT_L
#undef PG8_BAR
#undef PG8_SCHED
}
}
#define GAS __attribute__((address_space(1)))
#define LAS __attribute__((address_space(3)))
typedef unsigned short bf16;
typedef unsigned v4u __attribute__((ext_vector_type(4)));
typedef float f32x4 __attribute__((ext_vector_type(4)));
typedef short bf16x8 __attribute__((ext_vector_type(8)));
typedef GAS unsigned gu32;
typedef GAS unsigned long long gu64;
#define RLX_AGENT __ATOMIC_RELAXED, __HIP_MEMORY_SCOPE_AGENT
#define LDS_WAIT() asm volatile("s_waitcnt lgkmcnt(0)" ::: "memory")
#define VM_WAIT() asm volatile("s_waitcnt vmcnt(0)" ::: "memory")
__device__ __forceinline__ unsigned long long rt() { return __builtin_amdgcn_s_memrealtime(); }
__device__ __forceinline__ unsigned f2bf(float f) { unsigned u = __builtin_bit_cast(unsigned, f); return (u + 0x7fffu + ((u >> 16) & 1u)) >> 16; }
__device__ __forceinline__ unsigned pk2(float lo, float hi) { return f2bf(lo) | (f2bf(hi) << 16); }

#define XB_TMO      128
#define XB_XCNT(j)  (256  + 64 * (j))
#define XB_XSUB(j)  (1280 + 64 * (j))
#define XB_XGEN(j)  (2304 + 64 * (j))
#define XB_TOP      3328
#define XB_TOPGEN   3392
#define XCD_BAR_WORDS 3456
#define XB_SPIN_CAP (1u << 18)

__device__ __forceinline__ unsigned xb_ld(unsigned* p)              { return __hip_atomic_load(p, __ATOMIC_RELAXED, __HIP_MEMORY_SCOPE_AGENT); }
__device__ __forceinline__ unsigned xb_add(unsigned* p, unsigned v) { return __hip_atomic_fetch_add(p, v, __ATOMIC_RELAXED, __HIP_MEMORY_SCOPE_AGENT); }
__device__ __forceinline__ unsigned xb_xcc_id() { return (unsigned)__builtin_amdgcn_s_getreg((3 << 11) | 20) & 0xFu; }
#define XB_SPIN(cond, bar) do { unsigned _sp = 0; while (cond) { __builtin_amdgcn_s_sleep(1); \
    if ((++_sp & 255u) == 0u) { if (xb_ld(&(bar)[XB_TMO])) break; if (_sp > XB_SPIN_CAP) { atomicAdd(&(bar)[XB_TMO], 1u); break; } } } } while (0)

struct XcdBarrier {
    unsigned* bar; unsigned x;
    volatile LAS unsigned* st;
};

__device__ __forceinline__ XcdBarrier xcd_barrier_post(unsigned* bar, volatile LAS unsigned* st) {
    XcdBarrier b; b.bar = bar; b.x = xb_xcc_id(); b.st = st;
    if (threadIdx.x == 0) (void)xb_add(&bar[XB_XCNT(b.x)], 1u);
    return b;
}
__device__ __forceinline__ void xcd_barrier_complete(unsigned* bar, unsigned x, unsigned& nloc, unsigned& nx) {
    const unsigned G = gridDim.x * gridDim.y * gridDim.z;
    unsigned sum, cnt, mine, sp = 0u;
    for (;;) {
        sum = 0u; cnt = 0u; mine = 0u;
#pragma unroll
        for (unsigned j = 0; j < 16; ++j) { const unsigned c = xb_ld(&bar[XB_XCNT(j)]); sum += c; cnt += (c > 0u) ? 1u : 0u; mine = (j == x) ? c : mine; }
        if (sum == G) break;
        __builtin_amdgcn_s_sleep(1);
        if ((++sp & 255u) == 0u) { if (xb_ld(&bar[XB_TMO])) break; if (sp > XB_SPIN_CAP) { atomicAdd(&bar[XB_TMO], 1u); break; } }
    }
    nloc = mine > 0u ? mine : 1u; nx = cnt > 0u ? cnt : 1u;
}

__device__ __forceinline__ void xcd_barrier(const XcdBarrier& b) {
    asm volatile("s_waitcnt vmcnt(0)" ::: "memory");
    __syncthreads();
    if (threadIdx.x == 0) {
        unsigned* bar = b.bar; asm volatile("" : "+s"(bar));
        __builtin_amdgcn_s_waitcnt(0);
        unsigned nloc = b.st[0], nx = b.st[1];
        if (nloc == 0u) { xcd_barrier_complete(bar, b.x, nloc, nx); b.st[0] = nloc; b.st[1] = nx; }
        const unsigned old = xb_add(&bar[XB_XSUB(b.x)], 1u);
        const unsigned gen = old / nloc;
        if (old + 1u == (gen + 1u) * nloc) {
            __builtin_amdgcn_fence(__ATOMIC_RELEASE, "agent");
            asm volatile("s_waitcnt vmcnt(0)" ::: "memory");
            const unsigned og = xb_add(&bar[XB_TOP], 1u);
            const unsigned tg = og / nx;
            if (og + 1u == (tg + 1u) * nx) xb_add(&bar[XB_TOPGEN], 1u);
            else XB_SPIN(xb_ld(&bar[XB_TOPGEN]) == tg, bar);
            __builtin_amdgcn_fence(__ATOMIC_ACQUIRE, "agent");
            xb_add(&bar[XB_XGEN(b.x)], 1u);
            asm volatile("s_waitcnt vmcnt(0)" ::: "memory");
        } else {
            XB_SPIN(xb_ld(&bar[XB_XGEN(b.x)]) == gen, bar);
            __builtin_amdgcn_fence(__ATOMIC_ACQUIRE, "agent");
            asm volatile("s_waitcnt vmcnt(0)" ::: "memory");
        }
    }
    __syncthreads();
}

constexpr int NWAVES = 8;
constexpr int DM = 1024, NBATCH = 16, SEQ = 2048, CTX = 256, TPB = SEQ + CTX, M = NBATCH * TPB;
constexpr int DEPTH = 4, NIN = 3104, NP = 3328, DFF = 2816, NE = 8;
constexpr int MP = 2 * M + NE * 256;
constexpr int C_Q = 0, C_K = 512, C_V = 1024, C_GQ = 1536, C_GK = 1792, C_GV = 2048, C_GG = 2560, C_GLR = 3072;
constexpr float EPS = 1e-6f;
constexpr float C2 = 0.125f * 1.4426950408889634f;
constexpr int NCH = TPB / 64;
constexpr int NGLA = NBATCH * 4 * 2 * NCH;

constexpr size_t MiB = 1u << 20;
constexpr size_t WS_CTL = 0, CTL_ZERO_BYTES = 1 * MiB;
constexpr size_t WS_MOD = 1 * MiB;
constexpr size_t WS_ROPE = 3 * MiB;
constexpr size_t WS_TOPE = 4 * MiB;
constexpr size_t WS_LIDX = WS_TOPE + 160 * 1024;
constexpr size_t WS_TOPW = WS_LIDX + 320 * 1024;
constexpr size_t WS_BLKB = WS_TOPW + 320 * 1024;
constexpr size_t WS_RMAP = WS_BLKB + 64 * 1024;
constexpr size_t WS_ROWW = WS_RMAP + 320 * 1024;
static_assert(WS_ROWW + 320 * 1024 <= 6 * MiB, "small tables");
constexpr size_t WS_X = 6 * MiB;
constexpr size_t WS_WIN = 150 * MiB;
constexpr size_t WS_WOUT = WS_WIN + 13 * MiB / 2;
constexpr size_t WS_WUP = WS_WOUT + 2 * MiB;
constexpr size_t WS_WDN = WS_WUP + 88 * MiB;
constexpr size_t WS_D = 291 * MiB;
static_assert(WS_WDN + 44 * MiB <= WS_D, "weights");
constexpr size_t WS_PROJ = WS_D;
constexpr size_t WS_OD = WS_D + 234 * MiB;
constexpr size_t WS_DS = WS_D + 306 * MiB;
constexpr size_t WS_DEC = WS_D + 450 * MiB;
constexpr size_t WS_H = WS_D + 452 * MiB;
constexpr size_t WS_Y = WS_D;
constexpr size_t WS_HG = WS_D;
constexpr size_t WS_F2 = WS_D;
constexpr size_t WS_U = WS_D + 148 * MiB;
constexpr size_t WS_H2 = WS_D + 483 * MiB;
constexpr size_t WS_END = WS_D + 555 * MiB;
static_assert((size_t)MP * DFF * 2 <= 407 * MiB && (size_t)MP * DM * 2 <= 148 * MiB && (size_t)M * NP * 2 <= 234 * MiB, "dynamic map");
static_assert((size_t)M * DFF * 2 + 148 * MiB <= 483 * MiB, "dense U clear of H2");

constexpr int CW_BAR = 4096;
constexpr int CW_CNT = 8192;

constexpr int RING_BYTES = 131072;
constexpr int TEXP_OFF = 139264;
constexpr int MISC_OFF = 146432 - 512;
constexpr int LDS_BYTES = 147456;

typedef unsigned u32x2 __attribute__((ext_vector_type(2)));

__device__ __forceinline__ float bf2f(unsigned short x) { return __uint_as_float((unsigned)x << 16); }
__device__ __forceinline__ float bflo(unsigned w) { return __uint_as_float(w << 16); }
__device__ __forceinline__ float bfhi(unsigned w) { return __uint_as_float(w & 0xffff0000u); }
__device__ __forceinline__ float siluf(float x) { return x / (1.f + __expf(-x)); }
template <int MASK> __device__ __forceinline__ float xadd(float v) {
    if constexpr (MASK == 32) { const auto rr = __builtin_amdgcn_permlane32_swap(__float_as_uint(v), __float_as_uint(v), false, false); return __uint_as_float(rr[0]) + __uint_as_float(rr[1]); }
    else return v + __int_as_float(__builtin_amdgcn_ds_swizzle(__float_as_int(v), 0x1f | (MASK << 10)));
}
__device__ __forceinline__ float wave_sum(float v) {
    v = xadd<1>(v); v = xadd<2>(v); v = xadd<4>(v); v = xadd<8>(v); v = xadd<16>(v); v = xadd<32>(v);
    return v;
}

struct Args { const float* in[24]; float* out; unsigned char* ws; };
struct Frame {
    LAS unsigned char* lds;
    volatile LAS unsigned* MISC;
    int tid, lane, wave, G, blk, gw, NGW, z;
    const Args* A;
    unsigned char* ws;
};


__device__ __forceinline__ void refresh(Frame& F) {
    int t = threadIdx.x; asm volatile("" : "+v"(t));
    int bl = blockIdx.x, z = 0; asm volatile("" : "+s"(bl), "+s"(z));
    F.blk = bl; F.z = z;
    F.tid = t; F.lane = t & 63; F.wave = __builtin_amdgcn_readfirstlane(t >> 6); F.gw = F.blk * NWAVES + F.wave;
}
#define INP(k) (F.A->in[(k) + F.z])
namespace pg8 {
struct EpiProj {
    static constexpr bool PERM = false, AFTER_DRAIN = false;
    bf16_t* P; const float* ropec; const float* ropes;
    __device__ __forceinline__ void operator()(const f32x4 (&acc)[2][2][4][2], const Unit& u, int wr, int wc, int fr, int fq) const {
        const int pn = u.pn, pm = u.pm, tb = pm % 9;
        const bool do_rope = (tb != 0) && (pn < 4);
        const float sc = (pn < 2) ? C2 : (pn == 6 ? 0.125f : 1.f);
        const bool st_ok_all = pn < 12;
#pragma unroll
        for (int ai = 0; ai < 2; ++ai)
#pragma unroll
            for (int m = 0; m < 4; ++m) {
                const int rit = ai * HALF + wr * 64 + m * 16 + fr;
                const size_t grow = (size_t)pm * BM + rit;
                const int s = (tb - 1) * 256 + rit;
                const int pos = (wc & 1) ? (s & 63) : (s >> 6);
                f32x4 cs = {1.f, 1.f, 1.f, 1.f}, sn = {0.f, 0.f, 0.f, 0.f};
                if (do_rope) { cs = *(const f32x4*)(ropec + pos * 16 + 4 * fq); sn = *(const f32x4*)(ropes + pos * 16 + 4 * fq); }
#pragma unroll
                for (int bj = 0; bj < 2; ++bj) {
                    f32x4 v0 = acc[ai][bj][m][0], v1 = acc[ai][bj][m][1];
                    if (do_rope) { const f32x4 a = v0 * cs - v1 * sn, b = v0 * sn + v1 * cs; v0 = a; v1 = b; }
                    v0 = v0 * sc; v1 = v1 * sc;
                    const int col0 = pn * BM + bj * HALF + wc * 32 + 4 * fq;
                    if (st_ok_all || (bj == 0 && wc == 0)) {
                        u32x2 w0, w1; w0.x = cvt_pk_bf16(v0[0], v0[1]); w0.y = cvt_pk_bf16(v0[2], v0[3]); w1.x = cvt_pk_bf16(v1[0], v1[1]); w1.y = cvt_pk_bf16(v1[2], v1[3]);
                        *(u32x2*)(P + grow * NP + col0) = w0; *(u32x2*)(P + grow * NP + col0 + 16) = w1;
                    }
                }
            }
    }
};
struct EpiF32 {
    static constexpr bool PERM = false, AFTER_DRAIN = false;
    float* Y;
    __device__ __forceinline__ void operator()(const f32x4 (&acc)[2][2][4][2], const Unit& u, int wr, int wc, int fr, int fq) const {
#pragma unroll
        for (int ai = 0; ai < 2; ++ai)
#pragma unroll
            for (int m = 0; m < 4; ++m) {
                float* rowp = Y + ((size_t)u.pm * BM + ai * HALF + wr * 64 + m * 16 + fr) * DM + u.pn * BM + wc * 32 + 4 * fq;
#pragma unroll
                for (int bj = 0; bj < 2; ++bj)
#pragma unroll
                    for (int n = 0; n < 2; ++n) *(f32x4*)(rowp + bj * HALF + n * 16) = acc[ai][bj][m][n];
            }
    }
};
struct EpiSwiglu {
    static constexpr bool PERM = true, AFTER_DRAIN = false;
    bf16_t* U;
    __device__ __forceinline__ void operator()(const f32x4 (&acc)[2][2][4][2], const Unit& u, int wr, int wc, int fr, int fq) const {
        const int pnl = u.pn % 22;
        const int col0 = pnl * 128 + wc * 32 + 8 * fq;
#pragma unroll
        for (int ai = 0; ai < 2; ++ai)
#pragma unroll
            for (int m = 0; m < 4; ++m) {
                bf16_t* rowp = U + ((size_t)u.pm * BM + ai * HALF + wr * 64 + m * 16 + fr) * DFF + col0;
                float o[8];
#pragma unroll
                for (int n = 0; n < 2; ++n)
#pragma unroll
                    for (int j = 0; j < 4; ++j) { const float g = acc[ai][0][m][n][j], up = acc[ai][1][m][n][j]; o[n * 4 + j] = g / (1.f + __expf(-g)) * up; }
                u32x4 w; w.x = cvt_pk_bf16(o[0], o[1]); w.y = cvt_pk_bf16(o[2], o[3]); w.z = cvt_pk_bf16(o[4], o[5]); w.w = cvt_pk_bf16(o[6], o[7]);
                *(u32x4*)rowp = w;
            }
    }
};
struct EpiDown {
    static constexpr bool PERM = true, AFTER_DRAIN = false;
    bf16_t* F2; const int* rmap; const float* roww; int dense;
    __device__ __forceinline__ void operator()(const f32x4 (&acc)[2][2][4][2], const Unit& u, int wr, int wc, int fr, int fq) const {
        const int pnl = u.pn & 3;
        const int col0 = pnl * BM + wc * 32 + 8 * fq;
#pragma unroll
        for (int ai = 0; ai < 2; ++ai)
#pragma unroll
            for (int m = 0; m < 4; ++m) {
                const int grow = u.pm * BM + ai * HALF + wr * 64 + m * 16 + fr;
                int tok = grow, slot = 0; float w = 1.f; bool ok = true;
                if (!dense) { const int rm = rmap[grow]; ok = rm >= 0; tok = rm & 0x3fffffff; slot = (rm >> 30) & 1; w = roww[grow]; }
                if (ok) {
                    bf16_t* rowp = F2 + ((size_t)slot * M + tok) * DM + col0;
#pragma unroll
                    for (int bj = 0; bj < 2; ++bj) {
                        const f32x4 v0 = acc[ai][bj][m][0] * w, v1 = acc[ai][bj][m][1] * w;
                        u32x4 q; q.x = cvt_pk_bf16(v0[0], v0[1]); q.y = cvt_pk_bf16(v0[2], v0[3]); q.z = cvt_pk_bf16(v1[0], v1[1]); q.w = cvt_pk_bf16(v1[2], v1[3]);
                        *(u32x4*)(rowp + bj * HALF) = q;
                    }
                }
            }
    }
};
struct GroupedOrder {
    StaticOrder S; const PG8_LAS int* texp; int nN;
    __device__ __forceinline__ bool next(int i, Unit& u) const { if (!S.next(i, u)) return false; u.pn += texp[u.pm] * nN; return true; }
    __device__ __forceinline__ void a_ready(const Unit&) const {}
    __device__ __forceinline__ void done(const Unit&) const {}
};
}

__device__ __forceinline__ void ld_row_f32(const float* row, int lane, f32x4 (&v)[4]) {
#pragma unroll
    for (int j = 0; j < 4; ++j) v[j] = *(const f32x4*)(row + 4 * lane + 256 * j);
}
__device__ __forceinline__ void st_row_f32(float* row, int lane, const f32x4 (&v)[4]) {
#pragma unroll
    for (int j = 0; j < 4; ++j) *(f32x4*)(row + 4 * lane + 256 * j) = v[j];
}
__device__ __forceinline__ void ld_row_bf16(const bf16* row, int lane, f32x4 (&v)[4]) {
#pragma unroll
    for (int j = 0; j < 4; ++j) { const u32x2 w = *(const u32x2*)(row + 4 * lane + 256 * j); v[j] = (f32x4){bflo(w.x), bfhi(w.x), bflo(w.y), bfhi(w.y)}; }
}
__device__ __forceinline__ void st_row_bf16(bf16* row, int lane, const f32x4 (&v)[4]) {
#pragma unroll
    for (int j = 0; j < 4; ++j) { u32x2 w; w.x = pg8::cvt_pk_bf16(v[j][0], v[j][1]); w.y = pg8::cvt_pk_bf16(v[j][2], v[j][3]); *(u32x2*)(row + 4 * lane + 256 * j) = w; }
}
__device__ __forceinline__ float row_rinv(const f32x4 (&v)[4]) {
    float s = 0.f;
#pragma unroll
    for (int j = 0; j < 4; ++j) s += (v[j][0] * v[j][0] + v[j][1] * v[j][1]) + (v[j][2] * v[j][2] + v[j][3] * v[j][3]);
    return 1.0f / sqrtf(wave_sum(s) * (1.f / DM) + EPS);
}

__device__ __forceinline__ void transpose_tile(const float* W, int N, int k0, int n0, bf16* WT, int K, int drow0, LAS float* scr, int lane) {
#pragma unroll 8
    for (int i = 0; i < 32; ++i) { const int kk = 2 * i + (lane >> 5); scr[kk * 33 + (lane & 31)] = W[(size_t)(k0 + kk) * N + n0 + (lane & 31)]; }
    LDS_WAIT(); asm volatile("" ::: "memory");
    const int c = lane & 7;
#pragma unroll
    for (int j = 0; j < 4; ++j) { const int n = (lane >> 3) + 8 * j; const LAS float* s = scr + (8 * c) * 33 + n;
        v4u o; o.x = pk2(s[0 * 33], s[1 * 33]); o.y = pk2(s[2 * 33], s[3 * 33]); o.z = pk2(s[4 * 33], s[5 * 33]); o.w = pk2(s[6 * 33], s[7 * 33]);
        *(GAS v4u*)(WT + (size_t)(drow0 + n) * K + k0 + 8 * c) = o; }
    LDS_WAIT(); asm volatile("" ::: "memory");
}
__device__ __forceinline__ void convert_weights(Frame& F, int l) {
    refresh(F);
    const bool moe = l & 1; const int ne = moe ? NE : 1, li = l >> 1;
    const float* w1 = moe ? INP(21) + (size_t)li * NE * DM * DFF : INP(17) + (size_t)li * DM * DFF;
    const float* w3 = moe ? INP(22) + (size_t)li * NE * DM * DFF : INP(18) + (size_t)li * DM * DFF;
    const float* w2 = moe ? INP(23) + (size_t)li * NE * DM * DFF : INP(19) + (size_t)li * DM * DFF;
    const float* win = INP(10) + (size_t)l * DM * NIN;
    const float* wout = INP(16) + (size_t)l * DM * DM;
    bf16* WIN = (bf16*)(F.ws + WS_WIN); bf16* WOUT = (bf16*)(F.ws + WS_WOUT); bf16* WUP = (bf16*)(F.ws + WS_WUP); bf16* WDN = (bf16*)(F.ws + WS_WDN);
    LAS float* scr = (LAS float*)(F.lds + F.wave * 16384);
    const int nA = 16 * 97, nZ = NP - NIN, nB = 16 * 32, nC1 = 16 * 88, nD1 = 44 * 32;
    const int nC = ne * 2 * nC1, nD = ne * nD1, total = nA + nZ + nB + nC + nD;
    for (int it = F.gw; it < total; it += F.NGW) {
        int r = it;
        if (r < nA) { const int kb = r / 97, nb = r % 97; transpose_tile(win, NIN, 64 * kb, 32 * nb, WIN, DM, 32 * nb, scr, F.lane); continue; } r -= nA;
        if (r < nZ) { v4u z = {0u, 0u, 0u, 0u}; GAS v4u* p = (GAS v4u*)(WIN + (size_t)(NIN + r) * DM) + F.lane * 2; p[0] = z; p[1] = z; continue; } r -= nZ;
        if (r < nB) { const int kb = r / 32, nb = r % 32; transpose_tile(wout, DM, 64 * kb, 32 * nb, WOUT, DM, 32 * nb, scr, F.lane); continue; } r -= nB;
        if (r < nC) { const int e = r / (2 * nC1), q = r % (2 * nC1), which = q / nC1, t = q % nC1, kb = t / 88, nb = t % 88, n0 = 32 * nb;
            const float* src = (which ? w3 : w1) + (size_t)e * DM * DFF;
            transpose_tile(src, DFF, 64 * kb, n0, WUP, DM, e * 5632 + (n0 / 128) * 256 + (n0 % 128) + which * 128, scr, F.lane); continue; } r -= nC;
        { const int e = r / nD1, t = r % nD1, kb = t / 32, nb = t % 32;
            transpose_tile(w2 + (size_t)e * DFF * DM, DM, 64 * kb, 32 * nb, WDN + (size_t)e * DM * DFF, DFF, 32 * nb, scr, F.lane); }
    }
}

__device__ __forceinline__ void p0_mod(Frame& F) {
    refresh(F);
    LAS float* S = (LAS float*)(F.lds);
    LAS float* R = (LAS float*)(F.lds + 69632);
    const float* c = INP(1); const float* cc = INP(3); const float* wmod = INP(4); const float* bmod = INP(5);
    float* MOD = (float*)(F.ws + WS_MOD);
    for (int i = F.tid; i < 17 * 1024; i += 512) { const int b = i >> 10, k = i & 1023; const float v = b < 16 ? c[b * 1024 + k] : cc[k]; S[i] = siluf(v); }
    __syncthreads();
    const int kq = F.lane >> 4, c4 = (F.lane & 15) * 4;
    for (int item = F.blk; item < 4 * 96; item += F.G) {
        const int l = item / 96, col0 = (item % 96) * 64;
        const float* W = wmod + (size_t)l * DM * 6144;
        float acc[17][4];
#pragma unroll
        for (int b = 0; b < 17; ++b)
#pragma unroll
            for (int j = 0; j < 4; ++j) acc[b][j] = 0.f;
        for (int it = 0; it < 32; ++it) {
            const int k = F.wave * 128 + it * 4 + kq;
            const f32x4 w = *(const f32x4*)(W + (size_t)k * 6144 + col0 + c4);
#pragma unroll
            for (int b = 0; b < 17; ++b) { const float s = S[b * 1024 + k];
#pragma unroll
                for (int j = 0; j < 4; ++j) acc[b][j] += s * w[j]; }
        }
#pragma unroll
        for (int b = 0; b < 17; ++b)
#pragma unroll
            for (int j = 0; j < 4; ++j) { float v = acc[b][j]; v = xadd<16>(v); v = xadd<32>(v); acc[b][j] = v; }
        if (kq == 0) {
#pragma unroll
            for (int b = 0; b < 17; ++b)
#pragma unroll
                for (int j = 0; j < 4; ++j) R[(F.wave * 17 + b) * 64 + c4 + j] = acc[b][j];
        }
        __syncthreads();
        for (int o = F.tid; o < 17 * 64; o += 512) { const int b = o >> 6, ccx = o & 63; float s = bmod[l * 6144 + col0 + ccx];
            for (int w = 0; w < 8; ++w) s += R[(w * 17 + b) * 64 + ccx];
            MOD[((size_t)l * 17 + b) * 6144 + col0 + ccx] = s; }
        __syncthreads();
    }
}
__device__ __forceinline__ float lam_init_of(int l) { return 0.8f - 0.6f * expf(-0.3f * (float)l); }
__device__ __forceinline__ void p0_misc(Frame& F) {
    refresh(F);
    float* ropec = (float*)(F.ws + WS_ROPE); float* ropes = ropec + 1024; float* lam = (float*)(F.ws + WS_ROPE + 16384);
    if (F.blk == 0) {
        for (int i = F.tid; i < 1024; i += 512) { const int pos = i >> 4, f = i & 15; const float inv = powf(10000.f, -(float)f / 16.f); const float ang = (float)pos * inv; ropec[i] = cosf(ang); ropes[i] = sinf(ang); }
    }
    if (F.blk == (1 % F.G) && F.wave < 4) {
        const int l = F.wave; const float* lv = INP(13) + l * 256;
        const float a = wave_sum(lv[F.lane] * lv[64 + F.lane]), b = wave_sum(lv[128 + F.lane] * lv[192 + F.lane]);
        if (F.lane == 0) lam[l] = expf(a) - expf(b) + lam_init_of(l);
    }
}

__device__ __forceinline__ void p1_rows(Frame& F, int l) {
    refresh(F);
    const float* MOD = (const float*)(F.ws + WS_MOD);
    float* X = (float*)(F.ws + WS_X); bf16* H = (bf16*)(F.ws + WS_H); const bf16* F2 = (const bf16*)(F.ws + WS_F2);
    const float* gpre = INP(6) + l * DM;
    for (int r = F.gw; r < M; r += F.NGW) {
        const int b = r / TPB, p = r % TPB; const bool isc = p < CTX; const int mrow = isc ? 16 : b;
        f32x4 x[4];
        if (l == 0) { ld_row_f32(isc ? INP(2) + ((size_t)b * CTX + p) * DM : INP(0) + ((size_t)b * SEQ + (p - CTX)) * DM, F.lane, x); }
        else {
            ld_row_f32(X + (size_t)r * DM, F.lane, x);
            f32x4 f[4]; ld_row_bf16(F2 + (size_t)r * DM, F.lane, f);
            if ((l - 1) & 1) { f32x4 g[4]; ld_row_bf16(F2 + ((size_t)M + r) * DM, F.lane, g);
#pragma unroll
                for (int j = 0; j < 4; ++j) f[j] = f[j] + g[j]; }
            const float rinv = row_rinv(f);
            const float* modp = MOD + ((size_t)(l - 1) * 17 + mrow) * 6144; const float* gpost = INP(9) + (l - 1) * DM;
#pragma unroll
            for (int j = 0; j < 4; ++j) { const int cidx = 4 * F.lane + 256 * j; const f32x4 gt = *(const f32x4*)(modp + 5 * 1024 + cidx), gp = *(const f32x4*)(gpost + cidx);
                x[j] = x[j] + gt * (f[j] * rinv * gp); }
        }
        st_row_f32(X + (size_t)r * DM, F.lane, x);
        const float rinv = row_rinv(x);
        const float* modp = MOD + ((size_t)l * 17 + mrow) * 6144;
        f32x4 h[4];
#pragma unroll
        for (int j = 0; j < 4; ++j) { const int cidx = 4 * F.lane + 256 * j; const f32x4 sh = *(const f32x4*)(modp + cidx), sc = *(const f32x4*)(modp + 1024 + cidx), gp = *(const f32x4*)(gpre + cidx);
            h[j] = (x[j] * rinv * gp) * (sc + 1.0f) + sh; }
        st_row_bf16(H + (size_t)r * DM, F.lane, h);
    }
}
__device__ __forceinline__ void pf_final(Frame& F) {
    refresh(F);
    const float* MOD = (const float*)(F.ws + WS_MOD);
    const float* X = (const float*)(F.ws + WS_X); const bf16* F2 = (const bf16*)(F.ws + WS_F2);
    const int l = DEPTH - 1;
    for (int i = F.gw; i < NBATCH * SEQ; i += F.NGW) {
        const int b = i / SEQ, s = i % SEQ; const size_t r = (size_t)b * TPB + CTX + s;
        f32x4 x[4], f[4], g[4]; ld_row_f32(X + r * DM, F.lane, x); ld_row_bf16(F2 + r * DM, F.lane, f); ld_row_bf16(F2 + ((size_t)M + r) * DM, F.lane, g);
#pragma unroll
        for (int j = 0; j < 4; ++j) f[j] = f[j] + g[j];
        const float rinv = row_rinv(f);
        const float* modp = MOD + ((size_t)l * 17 + b) * 6144; const float* gpost = INP(9) + l * DM;
#pragma unroll
        for (int j = 0; j < 4; ++j) { const int cidx = 4 * F.lane + 256 * j; const f32x4 gt = *(const f32x4*)(modp + 5 * 1024 + cidx), gp = *(const f32x4*)(gpost + cidx);
            x[j] = x[j] + gt * (f[j] * rinv * gp); }
        st_row_f32(F.A->out + (size_t)i * DM, F.lane, x);
    }
}

__device__ __forceinline__ void p3_attn_naive(Frame& F) {
    refresh(F);
    const bf16* P = (const bf16*)(F.ws + WS_PROJ); bf16* OD = (bf16*)(F.ws + WS_OD);
    LAS float* Ks = (LAS float*)(F.lds); LAS float* Vs = (LAS float*)(F.lds + 16384);
    const int qi = F.tid & 255, half = F.tid >> 8;
    for (int un = F.blk; un < NBATCH * 8 * 9; un += F.G) {
        const int b = un / 72, rem = un % 72, hh = rem / 9, qt = rem % 9;
        const int nkeys = qt == 0 ? CTX : TPB;
        const size_t rowq = (size_t)b * TPB + qt * 256 + qi;
        float q[64], o[64];
        { const bf16* qp = P + rowq * NP + C_Q + hh * 64;
#pragma unroll
          for (int j = 0; j < 8; ++j) { const v4u w = *(const v4u*)(qp + 8 * j);
              q[8 * j + 0] = bflo(w.x); q[8 * j + 1] = bfhi(w.x); q[8 * j + 2] = bflo(w.y); q[8 * j + 3] = bfhi(w.y);
              q[8 * j + 4] = bflo(w.z); q[8 * j + 5] = bfhi(w.z); q[8 * j + 6] = bflo(w.w); q[8 * j + 7] = bfhi(w.w); } }
#pragma unroll
        for (int i = 0; i < 64; ++i) o[i] = 0.f;
        float mx = -1e30f, lsum = 0.f;
        for (int k0 = 0; k0 < nkeys; k0 += 64) {
            __syncthreads();
            { const int rr = F.tid >> 3, ch = F.tid & 7; const size_t rowk = (size_t)b * TPB + k0 + rr;
              const v4u w = *(const v4u*)(P + rowk * NP + C_K + hh * 64 + ch * 8);
              LAS float* d = Ks + rr * 64 + ch * 8;
              d[0] = bflo(w.x); d[1] = bfhi(w.x); d[2] = bflo(w.y); d[3] = bfhi(w.y); d[4] = bflo(w.z); d[5] = bfhi(w.z); d[6] = bflo(w.w); d[7] = bfhi(w.w);
#pragma unroll
              for (int t = 0; t < 2; ++t) { const v4u x = *(const v4u*)(P + rowk * NP + C_V + (hh >> 1) * 128 + ch * 16 + t * 8);
                  LAS float* e = Vs + rr * 128 + ch * 16 + t * 8;
                  e[0] = bflo(x.x); e[1] = bfhi(x.x); e[2] = bflo(x.y); e[3] = bfhi(x.y); e[4] = bflo(x.z); e[5] = bfhi(x.z); e[6] = bflo(x.w); e[7] = bfhi(x.w); } }
            __syncthreads();
            for (int u = 0; u < 64; ++u) {
                float s = 0.f;
#pragma unroll
                for (int d4 = 0; d4 < 16; ++d4) { const f32x4 kv = *(const LAS f32x4*)(Ks + u * 64 + d4 * 4);
                    s += q[4 * d4] * kv[0] + q[4 * d4 + 1] * kv[1] + q[4 * d4 + 2] * kv[2] + q[4 * d4 + 3] * kv[3]; }
                if (s > mx) { const float a = exp2f(mx - s); lsum *= a;
#pragma unroll
                    for (int i = 0; i < 64; ++i) o[i] *= a;
                    mx = s; }
                const float p = exp2f(s - mx); lsum += p;
#pragma unroll
                for (int d4 = 0; d4 < 16; ++d4) { const f32x4 vv = *(const LAS f32x4*)(Vs + u * 128 + half * 64 + d4 * 4);
                    o[4 * d4] += p * vv[0]; o[4 * d4 + 1] += p * vv[1]; o[4 * d4 + 2] += p * vv[2]; o[4 * d4 + 3] += p * vv[3]; }
            }
        }
        const float il = 1.f / lsum;
        bf16* op = OD + rowq * DM + hh * 128 + half * 64;
#pragma unroll
        for (int j = 0; j < 8; ++j) { v4u w; w.x = pg8::cvt_pk_bf16(o[8 * j] * il, o[8 * j + 1] * il); w.y = pg8::cvt_pk_bf16(o[8 * j + 2] * il, o[8 * j + 3] * il);
            w.z = pg8::cvt_pk_bf16(o[8 * j + 4] * il, o[8 * j + 5] * il); w.w = pg8::cvt_pk_bf16(o[8 * j + 6] * il, o[8 * j + 7] * il); *(v4u*)(op + 8 * j) = w; }
    }
    __syncthreads();
}

constexpr int GST = 68;
__device__ __forceinline__ float logsigmoidf(float z) { return fminf(z, 0.f) - log1pf(expf(-fabsf(z))); }
__device__ __forceinline__ void gla_gates(Frame& F, int l, int b, int h, int dir, int c, LAS float* G) {
    const bf16* P = (const bf16*)(F.ws + WS_PROJ);
    const float* w2 = INP(11) + (size_t)((l * 2 + dir) * 16) * 256 + h * 64; const float* gb = INP(12) + (l * 2 + dir) * 256 + h * 64;
    for (int idx = F.tid; idx < 4096; idx += 512) {
        const int t = idx >> 6, k = idx & 63, tok = dir ? 63 - t : t; const size_t r = (size_t)b * TPB + c * 64 + tok;
        const bf16* gp = P + r * NP + C_GLR + dir * 16;
        float z = gb[k];
#pragma unroll
        for (int j = 0; j < 16; ++j) z += bf2f(gp[j]) * w2[j * 256 + k];
        G[t * GST + k] = logsigmoidf(z) * (1.f / 16.f);
    }
    __syncthreads();
    if (F.tid < 64) { float run = 0.f; for (int t = 0; t < 64; ++t) { run += G[t * GST + F.tid]; G[t * GST + F.tid] = run; } }
    __syncthreads();
}
__device__ __forceinline__ int gla_item(int b, int h, int dir, int c) { return ((b * 4 + h) * 2 + dir) * NCH + c; }
__device__ __forceinline__ void p3_gla_states(Frame& F, int l) {
    refresh(F);
    const bf16* P = (const bf16*)(F.ws + WS_PROJ); float* DS = (float*)(F.ws + WS_DS); float* DEC = (float*)(F.ws + WS_DEC);
    LAS float* G = (LAS float*)(F.lds); LAS float* Kt = (LAS float*)(F.lds + 17408); LAS float* Vs = (LAS float*)(F.lds + 34816);
    for (int item = F.blk; item < NGLA; item += F.G) {
        const int c = item % NCH, dir = (item / NCH) & 1, h = (item / (2 * NCH)) & 3, b = item / (8 * NCH);
        gla_gates(F, l, b, h, dir, c, G);
        for (int idx = F.tid; idx < 4096; idx += 512) { const int t = idx >> 6, k = idx & 63, tok = dir ? 63 - t : t; const size_t r = (size_t)b * TPB + c * 64 + tok;
            Kt[t * GST + k] = bf2f(P[r * NP + C_GK + h * 64 + k]) * expf(G[63 * GST + k] - G[t * GST + k]); }
        for (int idx = F.tid; idx < 8192; idx += 512) { const int t = idx >> 7, v = idx & 127, tok = dir ? 63 - t : t; const size_t r = (size_t)b * TPB + c * 64 + tok;
            Vs[t * 128 + v] = bf2f(P[r * NP + C_GV + h * 128 + v]); }
        __syncthreads();
        const int k = F.tid >> 3, vg = F.tid & 7;
        float acc[16];
#pragma unroll
        for (int i = 0; i < 16; ++i) acc[i] = 0.f;
        for (int t = 0; t < 64; ++t) { const float kk = Kt[t * GST + k];
#pragma unroll
            for (int i4 = 0; i4 < 4; ++i4) { const f32x4 vv = *(const LAS f32x4*)(Vs + t * 128 + vg * 16 + i4 * 4);
                acc[4 * i4] += kk * vv[0]; acc[4 * i4 + 1] += kk * vv[1]; acc[4 * i4 + 2] += kk * vv[2]; acc[4 * i4 + 3] += kk * vv[3]; } }
        float* dp = DS + (size_t)item * 8192 + k * 128 + vg * 16;
#pragma unroll
        for (int i4 = 0; i4 < 4; ++i4) *(f32x4*)(dp + 4 * i4) = (f32x4){acc[4 * i4], acc[4 * i4 + 1], acc[4 * i4 + 2], acc[4 * i4 + 3]};
        if (vg == 0) DEC[(size_t)item * 64 + k] = expf(G[63 * GST + k]);
        __syncthreads();
    }
}
__device__ __forceinline__ void p4_scan(Frame& F) {
    refresh(F);
    float* DS = (float*)(F.ws + WS_DS); const float* DEC = (const float*)(F.ws + WS_DEC);
    for (int i = F.blk * 512 + F.tid; i < 128 * 1024; i += F.G * 512) {
        const int chain = i >> 10, grp = i & 1023, k = grp >> 4, dir = chain & 1;
        f32x4 s0 = {0.f, 0.f, 0.f, 0.f}, s1 = {0.f, 0.f, 0.f, 0.f};
        for (int j = 0; j < NCH; ++j) {
            const int c = dir == 0 ? j : (j < 4 ? 3 - j : 39 - j);
            const size_t item = (size_t)chain * NCH + c;
            float* p = DS + item * 8192 + grp * 8;
            const f32x4 d0 = *(const f32x4*)p, d1 = *(const f32x4*)(p + 4); const float dec = DEC[item * 64 + k];
            *(f32x4*)p = s0; *(f32x4*)(p + 4) = s1;
            s0 = s0 * dec + d0; s1 = s1 * dec + d1;
        }
    }
}
__device__ __forceinline__ void p5_gla_out(Frame& F, int l) {
    refresh(F);
    const bf16* P = (const bf16*)(F.ws + WS_PROJ); const float* DS = (const float*)(F.ws + WS_DS); bf16* MRG = (bf16*)(F.ws + WS_H);
    LAS float* A0 = (LAS float*)(F.lds); LAS float* Qt = (LAS float*)(F.lds + 17408); LAS float* Qh = (LAS float*)(F.lds + 2 * 17408); LAS float* Kt = (LAS float*)(F.lds + 3 * 17408);
    LAS float* Vs = (LAS float*)(F.lds + 4 * 17408); LAS float* Ss = (LAS float*)(F.lds + 4 * 17408 + 32768);
    const float* onorm = INP(15) + l * 128;
    const int tt = F.tid >> 3, vg = F.tid & 7;
    for (int it = F.blk; it < NBATCH * 4 * NCH; it += F.G) {
        const int c = it % NCH, h = (it / NCH) & 3, b = it / (4 * NCH);
        float o[16];
#pragma unroll
        for (int i = 0; i < 16; ++i) o[i] = 0.f;
        __syncthreads();
        for (int idx = F.tid; idx < 8192; idx += 512) { const int t = idx >> 7, v = idx & 127; const size_t r = (size_t)b * TPB + c * 64 + t;
            Vs[t * 128 + v] = bf2f(P[r * NP + C_GV + h * 128 + v]); }
        for (int dir = 0; dir < 2; ++dir) {
            gla_gates(F, l, b, h, dir, c, A0);
            for (int idx = F.tid; idx < 4096; idx += 512) { const int t = idx >> 6, k = idx & 63, tok = dir ? 63 - t : t; const size_t r = (size_t)b * TPB + c * 64 + tok;
                const float qv = bf2f(P[r * NP + C_GQ + h * 64 + k]), kv = bf2f(P[r * NP + C_GK + h * 64 + k]);
                const float g = A0[t * GST + k], gm = A0[31 * GST + k];
                Qt[t * GST + k] = qv * expf(g - gm); Kt[t * GST + k] = kv * expf(gm - g); Qh[t * GST + k] = qv * expf(g); }
            { const float* sp = DS + (size_t)gla_item(b, h, dir, c) * 8192;
              for (int idx = F.tid; idx < 2048; idx += 512) *(LAS f32x4*)(Ss + idx * 4) = *(const f32x4*)(sp + idx * 4); }
            __syncthreads();
            for (int idx = F.tid; idx < 4096; idx += 512) { const int t = idx >> 6, u = idx & 63; float s = 0.f;
                if (u <= t) {
#pragma unroll
                    for (int k4 = 0; k4 < 16; ++k4) { const f32x4 a = *(const LAS f32x4*)(Qt + t * GST + k4 * 4), bb = *(const LAS f32x4*)(Kt + u * GST + k4 * 4);
                        s += a[0] * bb[0] + a[1] * bb[1] + a[2] * bb[2] + a[3] * bb[3]; } }
                A0[t * GST + u] = s; }
            __syncthreads();
            { const int t = dir ? 63 - tt : tt;
              for (int u = 0; u <= t; ++u) { const float a = A0[t * GST + u]; const int tok = dir ? 63 - u : u;
#pragma unroll
                  for (int i4 = 0; i4 < 4; ++i4) { const f32x4 vv = *(const LAS f32x4*)(Vs + tok * 128 + vg * 16 + i4 * 4);
                      o[4 * i4] += a * vv[0]; o[4 * i4 + 1] += a * vv[1]; o[4 * i4 + 2] += a * vv[2]; o[4 * i4 + 3] += a * vv[3]; } }
              for (int k = 0; k < 64; ++k) { const float a = Qh[t * GST + k];
#pragma unroll
                  for (int i4 = 0; i4 < 4; ++i4) { const f32x4 sv = *(const LAS f32x4*)(Ss + k * 128 + vg * 16 + i4 * 4);
                      o[4 * i4] += a * sv[0]; o[4 * i4 + 1] += a * sv[1]; o[4 * i4 + 2] += a * sv[2]; o[4 * i4 + 3] += a * sv[3]; } } }
            __syncthreads();
        }
        float ss = 0.f;
#pragma unroll
        for (int i = 0; i < 16; ++i) ss += o[i] * o[i];
        ss = xadd<1>(ss); ss = xadd<2>(ss); ss = xadd<4>(ss);
        const float rinv = 1.0f / sqrtf(ss * (1.f / 128.f) + EPS);
        const size_t r = (size_t)b * TPB + c * 64 + tt;
        const bf16* gp = P + r * NP + C_GG + h * 128 + vg * 16;
        bf16* mp = MRG + r * DM + 512 + h * 128 + vg * 16;
        float res[16];
#pragma unroll
        for (int i = 0; i < 16; ++i) res[i] = o[i] * rinv * onorm[vg * 16 + i] * siluf(bf2f(gp[i]));
#pragma unroll
        for (int j = 0; j < 2; ++j) { v4u w; w.x = pg8::cvt_pk_bf16(res[8 * j], res[8 * j + 1]); w.y = pg8::cvt_pk_bf16(res[8 * j + 2], res[8 * j + 3]);
            w.z = pg8::cvt_pk_bf16(res[8 * j + 4], res[8 * j + 5]); w.w = pg8::cvt_pk_bf16(res[8 * j + 6], res[8 * j + 7]); *(v4u*)(mp + 8 * j) = w; }
    }
    __syncthreads();
}
__device__ __forceinline__ void p5_merge_attn(Frame& F, int l) {
    refresh(F);
    const bf16* OD = (const bf16*)(F.ws + WS_OD); bf16* MRG = (bf16*)(F.ws + WS_H);
    const float lam = ((const float*)(F.ws + WS_ROPE + 16384))[l]; const float omli = 1.f - lam_init_of(l);
    const float* subln = INP(14) + l * 128;
    const int h = F.lane >> 4, c0 = (F.lane & 15) * 8;
    for (int r = F.gw; r < M; r += F.NGW) {
        const v4u a = *(const v4u*)(OD + (size_t)r * DM + h * 256 + c0), bq = *(const v4u*)(OD + (size_t)r * DM + h * 256 + 128 + c0);
        float d[8];
        d[0] = bflo(a.x) - lam * bflo(bq.x); d[1] = bfhi(a.x) - lam * bfhi(bq.x); d[2] = bflo(a.y) - lam * bflo(bq.y); d[3] = bfhi(a.y) - lam * bfhi(bq.y);
        d[4] = bflo(a.z) - lam * bflo(bq.z); d[5] = bfhi(a.z) - lam * bfhi(bq.z); d[6] = bflo(a.w) - lam * bflo(bq.w); d[7] = bfhi(a.w) - lam * bfhi(bq.w);
        float ss = 0.f;
#pragma unroll
        for (int i = 0; i < 8; ++i) ss += d[i] * d[i];
        ss = xadd<1>(ss); ss = xadd<2>(ss); ss = xadd<4>(ss); ss = xadd<8>(ss);
        const float sc = omli / sqrtf(ss * (1.f / 128.f) + EPS);
#pragma unroll
        for (int i = 0; i < 8; ++i) d[i] = d[i] * sc * subln[c0 + i];
        v4u w; w.x = pg8::cvt_pk_bf16(d[0], d[1]); w.y = pg8::cvt_pk_bf16(d[2], d[3]); w.z = pg8::cvt_pk_bf16(d[4], d[5]); w.w = pg8::cvt_pk_bf16(d[6], d[7]);
        *(v4u*)(MRG + (size_t)r * DM + h * 128 + c0) = w;
    }
}

__device__ __forceinline__ void p7_rows(Frame& F, int l) {
    refresh(F);
    const float* MOD = (const float*)(F.ws + WS_MOD);
    float* X = (float*)(F.ws + WS_X); const float* Y = (const float*)(F.ws + WS_Y); bf16* H2 = (bf16*)(F.ws + WS_H2);
    const bool moe = l & 1; const int li = l >> 1;
    const float* gpost = INP(7) + l * DM; const float* gpre = INP(8) + l * DM; const float* router = INP(20) + (size_t)li * DM * NE;
    int* TOPE = (int*)(F.ws + WS_TOPE); int* LIDX = (int*)(F.ws + WS_LIDX); float* TOPW = (float*)(F.ws + WS_TOPW); int* BLKB = (int*)(F.ws + WS_BLKB);
    volatile LAS unsigned* LCNT = F.MISC + 16;
    if (moe) { if (F.tid < 8) LCNT[F.tid] = 0u; __syncthreads(); }
    for (int r = F.gw; r < M; r += F.NGW) {
        const int b = r / TPB, p = r % TPB; const int mrow = p < CTX ? 16 : b;
        const float* modp = MOD + ((size_t)l * 17 + mrow) * 6144;
        f32x4 x[4], y[4]; ld_row_f32(X + (size_t)r * DM, F.lane, x); ld_row_f32(Y + (size_t)r * DM, F.lane, y);
        const float ry = row_rinv(y);
#pragma unroll
        for (int j = 0; j < 4; ++j) { const int cidx = 4 * F.lane + 256 * j; const f32x4 gt = *(const f32x4*)(modp + 2 * 1024 + cidx), gp = *(const f32x4*)(gpost + cidx);
            x[j] = x[j] + gt * (y[j] * ry * gp); }
        st_row_f32(X + (size_t)r * DM, F.lane, x);
        const float rx = row_rinv(x);
        f32x4 h[4];
#pragma unroll
        for (int j = 0; j < 4; ++j) { const int cidx = 4 * F.lane + 256 * j; const f32x4 sh = *(const f32x4*)(modp + 3 * 1024 + cidx), sc = *(const f32x4*)(modp + 4 * 1024 + cidx), gp = *(const f32x4*)(gpre + cidx);
            h[j] = (x[j] * rx * gp) * (sc + 1.0f) + sh; }
        st_row_bf16(H2 + (size_t)r * DM, F.lane, h);
        if (moe) {
            float lg[8];
#pragma unroll
            for (int e = 0; e < 8; ++e) lg[e] = 0.f;
#pragma unroll
            for (int j = 0; j < 4; ++j)
#pragma unroll
                for (int i = 0; i < 4; ++i) { const int cidx = 4 * F.lane + 256 * j + i; const f32x4 r0 = *(const f32x4*)(router + (size_t)cidx * 8), r1 = *(const f32x4*)(router + (size_t)cidx * 8 + 4); const float hv = h[j][i];
                    lg[0] += hv * r0[0]; lg[1] += hv * r0[1]; lg[2] += hv * r0[2]; lg[3] += hv * r0[3]; lg[4] += hv * r1[0]; lg[5] += hv * r1[1]; lg[6] += hv * r1[2]; lg[7] += hv * r1[3]; }
#pragma unroll
            for (int e = 0; e < 8; ++e) lg[e] = wave_sum(lg[e]);
            int e0 = 0; float v0 = lg[0];
#pragma unroll
            for (int e = 1; e < 8; ++e) if (lg[e] > v0) { v0 = lg[e]; e0 = e; }
            int e1 = -1; float v1 = -3.0e38f;
#pragma unroll
            for (int e = 0; e < 8; ++e) if (e != e0 && lg[e] > v1) { v1 = lg[e]; e1 = e; }
            const float ex = expf(v1 - v0), w0 = 1.f / (1.f + ex), w1 = ex / (1.f + ex);
            if (F.lane == 0) {
                const unsigned i0 = atomicAdd((unsigned*)&LCNT[e0], 1u), i1 = atomicAdd((unsigned*)&LCNT[e1], 1u);
                TOPE[r] = e0 | (e1 << 8); LIDX[2 * r] = (int)i0; LIDX[2 * r + 1] = (int)i1; TOPW[2 * r] = w0; TOPW[2 * r + 1] = w1;
            }
        }
    }
    if (moe) {
        __syncthreads();
        if (F.tid < 8) { const unsigned base = __hip_atomic_fetch_add((unsigned*)(((gu32*)F.ws) + CW_CNT + 64 * li + F.tid), LCNT[F.tid], __ATOMIC_RELAXED, __HIP_MEMORY_SCOPE_AGENT); BLKB[F.blk * 8 + F.tid] = (int)base; }
    }
}
__device__ __forceinline__ void moe_offsets(Frame& F, int li, int (&cnt)[8], int (&off)[9]) {
    off[0] = 0;
#pragma unroll
    for (int e = 0; e < 8; ++e) { cnt[e] = (int)__hip_atomic_load((unsigned*)(((gu32*)F.ws) + CW_CNT + 64 * li + e), __ATOMIC_RELAXED, __HIP_MEMORY_SCOPE_AGENT); off[e + 1] = off[e] + ((cnt[e] + 255) & ~255); }
}
__device__ __forceinline__ void p7b_gather(Frame& F, int l) {
    refresh(F);
    const int li = l >> 1; int cnt[8], off[9]; moe_offsets(F, li, cnt, off);
    const bf16* H2 = (const bf16*)(F.ws + WS_H2); bf16* HG = (bf16*)(F.ws + WS_HG);
    const int* TOPE = (const int*)(F.ws + WS_TOPE); const int* LIDX = (const int*)(F.ws + WS_LIDX); const float* TOPW = (const float*)(F.ws + WS_TOPW); const int* BLKB = (const int*)(F.ws + WS_BLKB);
    int* RMAP = (int*)(F.ws + WS_RMAP); float* ROWW = (float*)(F.ws + WS_ROWW);
    for (int r = F.gw; r < M; r += F.NGW) {
        const int te = TOPE[r];
        const v4u a = *(const v4u*)(H2 + (size_t)r * DM + F.lane * 16), bq = *(const v4u*)(H2 + (size_t)r * DM + F.lane * 16 + 8);
#pragma unroll
        for (int s = 0; s < 2; ++s) {
            const int e = (te >> (8 * s)) & 0xff;
            int o = 0;
#pragma unroll
            for (int q = 0; q < 8; ++q) o = (q == e) ? off[q] : o;
            const int pos = o + BLKB[F.blk * 8 + e] + LIDX[2 * r + s];
            *(v4u*)(HG + (size_t)pos * DM + F.lane * 16) = a; *(v4u*)(HG + (size_t)pos * DM + F.lane * 16 + 8) = bq;
            if (F.lane == 0) { RMAP[pos] = r | (s << 30); ROWW[pos] = TOPW[2 * r + s]; }
        }
    }
#pragma unroll
    for (int e = 0; e < 8; ++e) {
        const int npad = off[e + 1] - off[e] - cnt[e];
        for (int i = F.gw; i < npad; i += F.NGW) { const int pos = off[e] + cnt[e] + i; const v4u z = {0u, 0u, 0u, 0u};
            *(v4u*)(HG + (size_t)pos * DM + F.lane * 16) = z; *(v4u*)(HG + (size_t)pos * DM + F.lane * 16 + 8) = z;
            if (F.lane == 0) { RMAP[pos] = -1; ROWW[pos] = 0.f; } }
    }
}

__global__ void __launch_bounds__(NWAVES * 64, 2) mk_fwd(Args args) {
    extern __shared__ __attribute__((aligned(16))) unsigned char lds[];
    Frame F;
    F.lds = (LAS unsigned char*)lds;
    F.MISC = (volatile LAS unsigned*)(F.lds + MISC_OFF);
    F.tid = threadIdx.x; F.lane = F.tid & 63; F.wave = __builtin_amdgcn_readfirstlane(F.tid >> 6);
    F.G = gridDim.x; F.blk = blockIdx.x; F.gw = F.blk * NWAVES + F.wave; F.NGW = F.G * NWAVES;
    F.ws = args.ws;
    F.A = &args;
    for (int u = F.tid; u < 128; u += NWAVES * 64) F.MISC[u] = 0u;
    __syncthreads();
    { XcdBarrier b0 = xcd_barrier_post((unsigned*)F.ws + CW_BAR, F.MISC + 8); (void)b0; }
#define GRID_BAR() do { XcdBarrier b_; b_.bar = (unsigned*)F.ws + CW_BAR; b_.x = xb_xcc_id(); b_.st = F.MISC + 8; xcd_barrier(b_); } while (0)

#ifndef NO_P0
    p0_mod(F); p0_misc(F); convert_weights(F, 0);
#endif
    GRID_BAR();
    for (int l = 0; l < DEPTH; ++l) {
        const bool moe = l & 1; const int li = l >> 1;
        { unsigned char* wsp = args.ws; asm volatile("" : "+s"(wsp)); F.ws = wsp; }
#ifndef NO_P1
        p1_rows(F, l);
        if (l > 0) convert_weights(F, l);
#endif
        GRID_BAR();
#ifndef NO_G2
        {
            refresh(F);
            pg8::Gemm g{(const pg8::bf16_t*)(F.ws + WS_H), (const pg8::bf16_t*)(F.ws + WS_WIN), M, NP, DM};
            pg8::StaticOrder S; S.init(M, NP, F.G, F.blk);
            pg8::EpiProj E{(pg8::bf16_t*)(F.ws + WS_PROJ), (const float*)(F.ws + WS_ROPE), (const float*)(F.ws + WS_ROPE) + 1024};
            pg8::gemm_phase<pg8::EpiProj, pg8::StaticOrder, true, true>(F.lds, g, S, E);
        }
#endif
        GRID_BAR();
#ifndef NO_ATT
        p3_attn_naive(F);
#endif
#ifndef NO_GLA
        p3_gla_states(F, l);
#endif
        GRID_BAR();
#ifndef NO_GLA
        p4_scan(F);
#endif
        GRID_BAR();
#ifndef NO_GLA
        p5_gla_out(F, l);
#endif
#ifndef NO_MRG
        p5_merge_attn(F, l);
#endif
        GRID_BAR();
#ifndef NO_G6
        {
            refresh(F);
            pg8::Gemm g{(const pg8::bf16_t*)(F.ws + WS_H), (const pg8::bf16_t*)(F.ws + WS_WOUT), M, DM, DM};
            pg8::StaticOrder S; S.init(M, DM, F.G, F.blk);
            pg8::EpiF32 E{(float*)(F.ws + WS_Y)};
            pg8::gemm_phase<pg8::EpiF32, pg8::StaticOrder, true, true>(F.lds, g, S, E);
        }
#endif
        GRID_BAR();
#ifndef NO_P7
        p7_rows(F, l);
#endif
        GRID_BAR();
#ifndef NO_P7
        if (moe) { p7b_gather(F, l); GRID_BAR(); }
#endif
        int ntiles = M / 256;
        {
            refresh(F);
            LAS int* texp = (LAS int*)(F.lds + TEXP_OFF);
            if (moe) { int cnt[8], off[9]; moe_offsets(F, li, cnt, off); ntiles = off[8] >> 8;
                for (int t = F.tid; t < ntiles; t += 512) { int e = 0;
#pragma unroll
                    for (int q = 1; q < 8; ++q) e += ((t << 8) >= off[q]) ? 1 : 0;
                    texp[t] = e; } }
            else { for (int t = F.tid; t < ntiles; t += 512) texp[t] = 0; }
            __syncthreads();
        }
#ifndef NO_G8
        {
            refresh(F);
            pg8::Gemm g{(const pg8::bf16_t*)(F.ws + (moe ? WS_HG : WS_H2)), (const pg8::bf16_t*)(F.ws + WS_WUP), ntiles * 256, 2 * DFF, DM};
            pg8::GroupedOrder S; S.S.init(ntiles * 256, 2 * DFF, F.G, F.blk); S.texp = (const LAS int*)(F.lds + TEXP_OFF); S.nN = 22;
            pg8::EpiSwiglu E{(pg8::bf16_t*)(F.ws + WS_U)};
            pg8::gemm_phase<pg8::EpiSwiglu, pg8::GroupedOrder, true, true>(F.lds, g, S, E);
        }
#endif
        GRID_BAR();
#ifndef NO_G9
        {
            refresh(F);
            pg8::Gemm g{(const pg8::bf16_t*)(F.ws + WS_U), (const pg8::bf16_t*)(F.ws + WS_WDN), ntiles * 256, DM, DFF};
            pg8::GroupedOrder S; S.S.init(ntiles * 256, DM, F.G, F.blk); S.texp = (const LAS int*)(F.lds + TEXP_OFF); S.nN = 4;
            pg8::EpiDown E{(pg8::bf16_t*)(F.ws + WS_F2), (const int*)(F.ws + WS_RMAP), (const float*)(F.ws + WS_ROWW), moe ? 0 : 1};
            pg8::gemm_phase<pg8::EpiDown, pg8::GroupedOrder, true, true>(F.lds, g, S, E);
        }
#endif
        GRID_BAR();
    }
#ifndef NO_PF
    pf_final(F);
#endif
}

extern "C" void kernel_launch(void* const* d_in, const int* in_sizes, int n_in, void* d_out, int out_size, void* d_ws, size_t ws_size, hipStream_t stream) {
    static int grid = 0;
    if (grid == 0) {
        if (n_in != 24 || out_size != NBATCH * SEQ * DM || ws_size < WS_END) { fprintf(stderr, "kernel_launch: unexpected shapes or workspace (%d inputs, out %d, ws %zu < %zu)\n", n_in, out_size, ws_size, (size_t)WS_END); grid = -1; return; }
        int dev = 0, cus = 0, per_cu = 0;
        if (hipGetDevice(&dev) != hipSuccess || hipDeviceGetAttribute(&cus, hipDeviceAttributeMultiprocessorCount, dev) != hipSuccess) { grid = -1; return; }
        if (hipFuncSetAttribute((const void*)mk_fwd, hipFuncAttributeMaxDynamicSharedMemorySize, LDS_BYTES) != hipSuccess) { grid = -1; return; }
        if (hipOccupancyMaxActiveBlocksPerMultiprocessor(&per_cu, (const void*)mk_fwd, NWAVES * 64, LDS_BYTES) != hipSuccess || per_cu < 1) { fprintf(stderr, "kernel_launch: occupancy query says %d\n", per_cu); }
        (void)hipGetLastError();
        grid = cus;
    }
    if (grid < 0) return;
    if (hipMemsetAsync((char*)d_ws + WS_CTL, 0, CTL_ZERO_BYTES, stream) != hipSuccess) return;
    Args a{};
    for (int i = 0; i < 24; ++i) a.in[i] = (const float*)d_in[i];
    a.out = (float*)d_out; a.ws = (unsigned char*)d_ws;
    hipLaunchKernelGGL(mk_fwd, dim3(grid), dim3(NWAVES * 64), LDS_BYTES, stream, a);
}
```

```cpp
#include <hip/hip_runtime.h>
#include <cstdio>
#include <cstdint>
namespace pg8 {
#define PG8_LAS __attribute__((address_space(3)))
typedef unsigned short bf16_t;
__device__ __forceinline__ int lane_id_opaque() { int l; asm volatile("v_mbcnt_lo_u32_b32 %0, -1, 0\n\tv_mbcnt_hi_u32_b32 %0, -1, %0" : "=v"(l)); return l; }
typedef short bf16x8 __attribute__((ext_vector_type(8)));
typedef float f32x4 __attribute__((ext_vector_type(4)));
typedef unsigned u32x4 __attribute__((ext_vector_type(4)));
constexpr int BM = 256, BK = 64, HALF = 128, HTB = HALF * BK * 2  , STAGE_BYTES = 8 * HTB, NXCD = 8, WGM = 8;

__host__ __device__ __forceinline__ int lds_byte(int r, int c) { const int st = (r >> 4) * 2 + (c >> 5), rr = r & 15, cc = c & 31, ob = rr * 64 + cc * 2; return st * 1024 + (ob ^ (((ob >> 9) & 1) << 5)); }
__host__ __device__ __forceinline__ void stage_rc(int b, int& R, int& C) { const int st = b / 1024, sb = b % 1024, swz = sb ^ (((sb >> 9) & 1) << 5); R = (st >> 1) * 16 + swz / 64; C = (st & 1) * 32 + (swz % 64) / 2; }
__host__ __device__ __forceinline__ int perm32(int rho) { const int n = rho >> 4, i = rho & 15; return 8 * (i >> 2) + 4 * n + (i & 3); }

struct Unit { int pm, pn; };
struct Gemm { const bf16_t* A; const bf16_t* Bt; int M, N, K; };

struct StaticOrder {
    int nM, nN, nwg, G, c;
    __host__ __device__ void init(int M, int N, int G_, int c_) { nM = M / BM; nN = N / BM; nwg = nM * nN; G = G_; c = c_; }
    __host__ __device__ bool next(int i, Unit& u) const {
        const long L = (long)i * G + c; if (L >= nwg) return false;
        int wgid = (int)L; { const int q = nwg / NXCD, r = nwg % NXCD, xcd = wgid % NXCD, off = wgid / NXCD; wgid = (xcd < r ? xcd * (q + 1) : r * (q + 1) + (xcd - r) * q) + off; }
        const int nig = WGM * nN, gid = wgid / nig, fm = gid * WGM, gsz = (nM - fm) < WGM ? (nM - fm) : WGM;
        u.pm = fm + ((wgid % nig) % gsz); u.pn = (wgid % nig) / gsz; return true;
    }
    __device__ __forceinline__ void a_ready(const Unit&) const {}
    __device__ __forceinline__ void done(const Unit&) const {}
};

__device__ __forceinline__ unsigned cvt_pk_bf16(float lo, float hi) { unsigned r; asm volatile("v_cvt_pk_bf16_f32 %0, %1, %2" : "=v"(r) : "v"(lo), "v"(hi)); return r; }
typedef float f32x2 __attribute__((ext_vector_type(2)));
template <class Epi, class Sched, bool ALIGN_EPI = false, bool SP2 = false, bool F8 = false>
__device__ __forceinline__ void gemm_phase(PG8_LAS unsigned char* lds, const Gemm g, const Sched& S, const Epi& E, const int wv  ) {
    int tid_ = wv * 64 + lane_id_opaque();
    const int tid = tid_, wid = __builtin_amdgcn_readfirstlane(tid >> 6), lane = tid & 63, wr = wid >> 2, wc = wid & 3, fr = lane & 15, fq = lane >> 4;
    const int K = g.K, nt = K / BK;
    unsigned voffA[2], voffB[2];
#pragma unroll
    for (int i = 0; i < 2; ++i) { int R, C; stage_rc(tid * 16 + i * 8192, R, C); const int Rb = Epi::PERM ? ((R & ~31) + perm32(R & 31)) : R;
        voffA[i] = (unsigned)(R * K + C) * 2u; voffB[i] = (unsigned)(Rb * K + C) * 2u; }
    const size_t kstep = (size_t)(BK * 2);
    const size_t hstep = (size_t)HALF * K * 2;
    const size_t tstep = 2 * hstep;
    const unsigned ldsw = (unsigned)wid * 1024u;
    const int aoff = lds_byte(wr * 64 + fr, fq * 8), boff = lds_byte(wc * 32 + fr, fq * 8);
#define PG8_SA(b, h) (((b) * 2 + (h)) * HTB)
#define PG8_SB(b, h) ((4 + (b) * 2 + (h)) * HTB)
#define PG8_STAGE(bufoff, gbase, voff) do { _Pragma("unroll") for (int _i = 0; _i < 2; ++_i) \
        __builtin_amdgcn_global_load_lds((const __attribute__((address_space(1))) unsigned*)((const __attribute__((address_space(1))) char*)(gbase) + (voff)[_i]), (PG8_LAS unsigned*)(lds + (bufoff) + ldsw + _i * 8192), 16, 0, 0); } while (0)
#define PG8_LDA(dst, b, h) do { _Pragma("unroll") for (int m = 0; m < 4; ++m) _Pragma("unroll") for (int k = 0; k < 2; ++k) dst[m][k] = *(const PG8_LAS bf16x8*)(lds + PG8_SA(b, h) + aoff + m * 2048 + k * 1024); } while (0)
#define PG8_LDB(dst, b, h) do { _Pragma("unroll") for (int n = 0; n < 2; ++n) _Pragma("unroll") for (int k = 0; k < 2; ++k) dst[n][k] = *(const PG8_LAS bf16x8*)(lds + PG8_SB(b, h) + boff + n * 2048 + k * 1024); } while (0)
#define PG8_MMA(ai, bj, At, Bt) do { if constexpr (F8) __builtin_amdgcn_sched_barrier(0); __builtin_amdgcn_s_setprio(1); _Pragma("unroll") for (int m = 0; m < 4; ++m) _Pragma("unroll") for (int n = 0; n < 2; ++n) { \
        if constexpr (F8) { typedef int i32x4_ __attribute__((ext_vector_type(4))); \
            acc[ai][bj][m][n] = __builtin_amdgcn_mfma_scale_f32_16x16x128_f8f6f4(__builtin_shufflevector(__builtin_bit_cast(i32x4_, Bt[n][0]), __builtin_bit_cast(i32x4_, Bt[n][1]), 0, 1, 2, 3, 4, 5, 6, 7), \
                __builtin_shufflevector(__builtin_bit_cast(i32x4_, At[m][0]), __builtin_bit_cast(i32x4_, At[m][1]), 0, 1, 2, 3, 4, 5, 6, 7), acc[ai][bj][m][n], 0, 0, 0, 0x7f7f7f7f, 0, 0x7f7f7f7f); } \
        else { _Pragma("unroll") for (int k = 0; k < 2; ++k) acc[ai][bj][m][n] = __builtin_amdgcn_mfma_f32_16x16x32_bf16(Bt[n][k], At[m][k], acc[ai][bj][m][n], 0, 0, 0); } } \
        __builtin_amdgcn_s_setprio(0); if constexpr (F8) __builtin_amdgcn_sched_barrier(0); } while (0)
#define PG8_WAIT_V(n) asm volatile("s_waitcnt vmcnt(" #n ")" ::: "memory")
#define PG8_WAIT_L(n) asm volatile("s_waitcnt lgkmcnt(" #n ")" ::: "memory")
#define PG8_BAR __builtin_amdgcn_s_barrier()
#define PG8_SCHED __builtin_amdgcn_sched_barrier(0)
    Unit cur, nxt; int ui = 0;
    if (!S.next(0, cur)) return;
    f32x4 acc[2][2][4][2];
#pragma unroll
    for (int a = 0; a < 2; ++a)
#pragma unroll
        for (int b = 0; b < 2; ++b)
#pragma unroll
            for (int m = 0; m < 4; ++m)
#pragma unroll
                for (int n = 0; n < 2; ++n) acc[a][b][m][n] = (f32x4){0.f, 0.f, 0.f, 0.f};
    bf16x8 At[4][2], B0[2][2], B1[2][2];
    const char* cA = (const char*)g.A + (size_t)cur.pm * tstep; const char* cB = (const char*)g.Bt + (size_t)cur.pn * tstep;
    S.a_ready(cur);
    if constexpr (SP2) {
        PG8_STAGE(PG8_SB(0, 0), cB, voffB); PG8_STAGE(PG8_SB(0, 1), cB + hstep, voffB); PG8_STAGE(PG8_SA(0, 0), cA, voffA); PG8_STAGE(PG8_SA(0, 1), cA + hstep, voffA);
        if (wr == 1) PG8_BAR;
        PG8_WAIT_V(2); PG8_BAR;
        PG8_STAGE(PG8_SB(1, 0), cB + kstep, voffB); PG8_STAGE(PG8_SA(1, 0), cA + kstep, voffA); PG8_STAGE(PG8_SB(1, 1), cB + hstep + kstep, voffB);
        PG8_WAIT_V(6); PG8_BAR;
    } else {
        PG8_STAGE(PG8_SB(0, 0), cB, voffB); PG8_STAGE(PG8_SA(0, 0), cA, voffA); PG8_STAGE(PG8_SB(0, 1), cB + hstep, voffB); PG8_STAGE(PG8_SA(0, 1), cA + hstep, voffA);
        if (wr == 1) PG8_BAR;
        PG8_WAIT_V(4); PG8_BAR;
        PG8_STAGE(PG8_SB(1, 0), cB + kstep, voffB); PG8_STAGE(PG8_SA(1, 0), cA + kstep, voffA); PG8_STAGE(PG8_SB(1, 1), cB + hstep + kstep, voffB);
        PG8_WAIT_V(6); PG8_BAR;
    }
    for (;;) {
        const bool has_next = S.next(ui + 1, nxt);
        const char* nA = has_next ? (const char*)g.A + (size_t)nxt.pm * tstep : cA; const char* nB = has_next ? (const char*)g.Bt + (size_t)nxt.pn * tstep : cB;
        for (int t = 0; t < nt; t += 2) {
            const bool last = (t == nt - 2);
            const char* a1 = cA + (size_t)(t + 1) * kstep;
            const char* a2 = last ? nA : cA + (size_t)(t + 2) * kstep; const char* b2 = last ? nB : cB + (size_t)(t + 2) * kstep;
            const char* a3 = a2 + kstep; const char* b3 = b2 + kstep;
            if (last && has_next) S.a_ready(nxt);
            if constexpr (SP2) {
            PG8_LDB(B0, 0, 0); PG8_LDB(B1, 0, 1); PG8_SCHED; PG8_LDA(At, 0, 0); PG8_STAGE(PG8_SA(1, 1), a1 + hstep, voffA);
            PG8_WAIT_V(8); PG8_WAIT_L(0); PG8_BAR; PG8_MMA(0, 0, At, B0); PG8_MMA(0, 1, At, B1); PG8_BAR; PG8_SCHED;
            PG8_LDA(At, 0, 1); PG8_STAGE(PG8_SB(0, 0), b2, voffB); PG8_STAGE(PG8_SB(0, 1), b2 + hstep, voffB); PG8_STAGE(PG8_SA(0, 0), a2, voffA);
            PG8_WAIT_V(8); PG8_WAIT_L(0); PG8_BAR; PG8_MMA(1, 0, At, B0); PG8_MMA(1, 1, At, B1); PG8_BAR; PG8_SCHED;
            PG8_LDB(B0, 1, 0); PG8_LDB(B1, 1, 1); PG8_SCHED; PG8_LDA(At, 1, 0); PG8_STAGE(PG8_SA(0, 1), a2 + hstep, voffA);
            PG8_WAIT_V(8); PG8_WAIT_L(0); PG8_BAR; PG8_MMA(0, 0, At, B0); PG8_MMA(0, 1, At, B1); PG8_BAR; PG8_SCHED;
            PG8_LDA(At, 1, 1); PG8_STAGE(PG8_SB(1, 0), b3, voffB); PG8_STAGE(PG8_SB(1, 1), b3 + hstep, voffB); PG8_STAGE(PG8_SA(1, 0), a3, voffA);
            PG8_WAIT_V(8); PG8_WAIT_L(0); PG8_BAR; PG8_MMA(1, 0, At, B0); PG8_MMA(1, 1, At, B1); PG8_BAR; PG8_SCHED;
            } else {
            PG8_LDB(B0, 0, 0); PG8_SCHED; PG8_LDA(At, 0, 0); PG8_STAGE(PG8_SA(1, 1), a1 + hstep, voffA);
            PG8_WAIT_L(8); PG8_BAR; PG8_WAIT_L(0); PG8_MMA(0, 0, At, B0); PG8_BAR; PG8_SCHED;
            PG8_LDB(B1, 0, 1); PG8_STAGE(PG8_SB(0, 0), b2, voffB);
            PG8_BAR; PG8_WAIT_L(0); PG8_MMA(0, 1, At, B1); PG8_BAR;
            PG8_LDA(At, 0, 1); PG8_STAGE(PG8_SA(0, 0), a2, voffA);
            PG8_BAR; PG8_WAIT_L(0); PG8_MMA(1, 0, At, B0); PG8_BAR; PG8_SCHED;
            PG8_STAGE(PG8_SB(0, 1), b2 + hstep, voffB);
            PG8_WAIT_V(6); PG8_BAR; PG8_MMA(1, 1, At, B1); PG8_BAR;
            PG8_LDB(B0, 1, 0); PG8_SCHED; PG8_LDA(At, 1, 0); PG8_STAGE(PG8_SA(0, 1), a2 + hstep, voffA);
            PG8_WAIT_L(8); PG8_BAR; PG8_WAIT_L(0); PG8_MMA(0, 0, At, B0); PG8_BAR; PG8_SCHED;
            PG8_LDB(B1, 1, 1); PG8_STAGE(PG8_SB(1, 0), b3, voffB);
            PG8_BAR; PG8_WAIT_L(0); PG8_MMA(0, 1, At, B1); PG8_BAR;
            PG8_LDA(At, 1, 1); PG8_STAGE(PG8_SA(1, 0), a3, voffA);
            PG8_BAR; PG8_WAIT_L(0); PG8_MMA(1, 0, At, B0); PG8_BAR; PG8_SCHED;
            PG8_STAGE(PG8_SB(1, 1), b3 + hstep, voffB);
            PG8_WAIT_V(6); PG8_BAR; PG8_MMA(1, 1, At, B1); PG8_BAR;
            }
        }
        if constexpr (ALIGN_EPI) { if (wr == 0) PG8_BAR; }
        if constexpr (!Epi::AFTER_DRAIN) { const int t2_ = lane_id_opaque(); const int fr_ = t2_ & 15, fq_ = (t2_ & 63) >> 4;
            E(acc, cur, wr, wc, fr_, fq_); S.done(cur); }
        if (!has_next) break;
#pragma unroll
        for (int a = 0; a < 2; ++a)
#pragma unroll
            for (int b = 0; b < 2; ++b)
#pragma unroll
                for (int m = 0; m < 4; ++m)
#pragma unroll
                    for (int n = 0; n < 2; ++n) acc[a][b][m][n] = (f32x4){0.f, 0.f, 0.f, 0.f};
        cur = nxt; cA = nA; cB = nB; ++ui;
        if constexpr (ALIGN_EPI) { if (wr == 1) PG8_BAR; }
    }
    PG8_WAIT_V(0);
    if constexpr (!ALIGN_EPI) { if (wr == 0) PG8_BAR; }
    PG8_BAR;
    if constexpr (Epi::AFTER_DRAIN) { E.fused(acc, cur, wr, wc, fr, fq, lds, wid, lane); S.done(cur); }
#undef PG8_SA
#undef PG8_SB
#undef PG8_STAGE
#undef PG8_LDA
#undef PG8_LDB
#undef PG8_MMA
#undef PG8_WAIT_V
#undef PG8_WAIT_L
#undef PG8_BAR
#undef PG8_SCHED
}
}
#define GAS __attribute__((address_space(1)))
#define LAS __attribute__((address_space(3)))
typedef unsigned short bf16;
typedef unsigned v4u __attribute__((ext_vector_type(4)));
typedef float f32x4 __attribute__((ext_vector_type(4)));
typedef short bf16x8 __attribute__((ext_vector_type(8)));
typedef GAS unsigned gu32;
typedef GAS unsigned long long gu64;
#define RLX_AGENT __ATOMIC_RELAXED, __HIP_MEMORY_SCOPE_AGENT
#define LDS_WAIT() asm volatile("s_waitcnt lgkmcnt(0)" ::: "memory")
#define VM_WAIT() asm volatile("s_waitcnt vmcnt(0)" ::: "memory")
__device__ __forceinline__ unsigned long long rt() { return __builtin_amdgcn_s_memrealtime(); }
__device__ __forceinline__ unsigned f2bf(float f) { unsigned u = __builtin_bit_cast(unsigned, f); return (u + 0x7fffu + ((u >> 16) & 1u)) >> 16; }
__device__ __forceinline__ unsigned pk2(float lo, float hi) { return f2bf(lo) | (f2bf(hi) << 16); }

#define XB_TMO      128
#define XB_XCNT(j)  (256  + 64 * (j))
#define XB_XSUB(j)  (1280 + 64 * (j))
#define XB_XGEN(j)  (2304 + 64 * (j))
#define XB_TOP      3328
#define XB_TOPGEN   3392
#define XCD_BAR_WORDS 3456
#define XB_SPIN_CAP (1u << 18)

__device__ __forceinline__ unsigned xb_ld(unsigned* p)              { return __hip_atomic_load(p, __ATOMIC_RELAXED, __HIP_MEMORY_SCOPE_AGENT); }
__device__ __forceinline__ unsigned xb_add(unsigned* p, unsigned v) { return __hip_atomic_fetch_add(p, v, __ATOMIC_RELAXED, __HIP_MEMORY_SCOPE_AGENT); }
__device__ __forceinline__ unsigned xb_xcc_id() { return (unsigned)__builtin_amdgcn_s_getreg((3 << 11) | 20) & 0xFu; }
#define XB_SPIN(cond, bar) do { unsigned _sp = 0; while (cond) { __builtin_amdgcn_s_sleep(1); \
    if ((++_sp & 255u) == 0u) { if (xb_ld(&(bar)[XB_TMO])) break; if (_sp > XB_SPIN_CAP) { atomicAdd(&(bar)[XB_TMO], 1u); break; } } } } while (0)

struct XcdBarrier {
    unsigned* bar; unsigned x;
    volatile LAS unsigned* st;
};

__device__ __forceinline__ XcdBarrier xcd_barrier_post(unsigned* bar, volatile LAS unsigned* st) {
    XcdBarrier b; b.bar = bar; b.x = xb_xcc_id(); b.st = st;
    if (threadIdx.x == 0) (void)xb_add(&bar[XB_XCNT(b.x)], 1u);
    return b;
}
__device__ __forceinline__ void xcd_barrier_complete(unsigned* bar, unsigned x, unsigned& nloc, unsigned& nx) {
    const unsigned G = gridDim.x * gridDim.y * gridDim.z;
    unsigned sum, cnt, mine, sp = 0u;
    for (;;) {
        sum = 0u; cnt = 0u; mine = 0u;
#pragma unroll
        for (unsigned j = 0; j < 16; ++j) { const unsigned c = xb_ld(&bar[XB_XCNT(j)]); sum += c; cnt += (c > 0u) ? 1u : 0u; mine = (j == x) ? c : mine; }
        if (sum == G) break;
        __builtin_amdgcn_s_sleep(1);
        if ((++sp & 255u) == 0u) { if (xb_ld(&bar[XB_TMO])) break; if (sp > XB_SPIN_CAP) { atomicAdd(&bar[XB_TMO], 1u); break; } }
    }
    nloc = mine > 0u ? mine : 1u; nx = cnt > 0u ? cnt : 1u;
}

__device__ __forceinline__ void xcd_barrier(const XcdBarrier& b, const bool leader  ) {
    asm volatile("s_waitcnt vmcnt(0)" ::: "memory");
    __syncthreads();
    if (leader) {
        unsigned* bar = b.bar; asm volatile("" : "+s"(bar));
        __builtin_amdgcn_s_waitcnt(0);
        unsigned nloc = b.st[0], nx = b.st[1];
        if (nloc == 0u) { xcd_barrier_complete(bar, b.x, nloc, nx); b.st[0] = nloc; b.st[1] = nx; }
        const unsigned old = xb_add(&bar[XB_XSUB(b.x)], 1u);
        const unsigned gen = old / nloc;
        if (old + 1u == (gen + 1u) * nloc) {
            __builtin_amdgcn_fence(__ATOMIC_RELEASE, "agent");
            asm volatile("s_waitcnt vmcnt(0)" ::: "memory");
            const unsigned og = xb_add(&bar[XB_TOP], 1u);
            const unsigned tg = og / nx;
            if (og + 1u == (tg + 1u) * nx) xb_add(&bar[XB_TOPGEN], 1u);
            else XB_SPIN(xb_ld(&bar[XB_TOPGEN]) == tg, bar);
            __builtin_amdgcn_fence(__ATOMIC_ACQUIRE, "agent");
            xb_add(&bar[XB_XGEN(b.x)], 1u);
            asm volatile("s_waitcnt vmcnt(0)" ::: "memory");
        } else {
            XB_SPIN(xb_ld(&bar[XB_XGEN(b.x)]) == gen, bar);
            __builtin_amdgcn_fence(__ATOMIC_ACQUIRE, "agent");
            asm volatile("s_waitcnt vmcnt(0)" ::: "memory");
        }
    }
    __syncthreads();
}

#ifndef FFN_F8
#define FFN_F8 1
#endif
constexpr int NWAVES = 8;
constexpr float W8S = 32.f, U8S = 4.f;
constexpr int DM = 1024, NBATCH = 16, SEQ = 2048, CTX = 256, TPB = SEQ + CTX, M = NBATCH * TPB;
constexpr int DEPTH = 4, NIN = 3104, NP = 3328, DFF = 2816, NE = 8;
constexpr int MP = 2 * M + NE * 256;
constexpr int C_Q = 0, C_K = 512, C_V = 1024, C_GQ = 1536, C_GK = 1792, C_GV = 2048, C_GG = 2560, C_GLR = 3072;
constexpr float EPS = 1e-6f;
constexpr float C2 = 0.125f * 1.4426950408889634f;
constexpr int NCH = TPB / 64;
constexpr int NGLA = NBATCH * 4 * 2 * NCH;

constexpr size_t MiB = 1u << 20;
constexpr size_t WS_CTL = 0, CTL_ZERO_BYTES = 1 * MiB;
constexpr size_t WS_MOD = 1 * MiB;
constexpr size_t WS_ROPE = 3 * MiB;
constexpr size_t WS_TOPE = 4 * MiB;
constexpr size_t WS_LIDX = WS_TOPE + 160 * 1024;
constexpr size_t WS_TOPW = WS_LIDX + 320 * 1024;
constexpr size_t WS_BLKB = WS_TOPW + 320 * 1024;
constexpr size_t WS_RMAP = WS_BLKB + 64 * 1024;
constexpr size_t WS_ROWW = WS_RMAP + 320 * 1024;
static_assert(WS_ROWW + 320 * 1024 <= 6 * MiB, "small tables");
constexpr size_t WS_X = 6 * MiB;
constexpr size_t WS_WIN = 150 * MiB;
constexpr size_t WS_WOUT = WS_WIN + 13 * MiB / 2;
constexpr size_t WS_WUP = WS_WOUT + 2 * MiB;
constexpr size_t WS_WDN = WS_WUP + 88 * MiB;
constexpr size_t WS_D = 291 * MiB;
static_assert(WS_WDN + 44 * MiB <= WS_D, "weights");
constexpr size_t WS_PROJ = WS_D;
constexpr size_t WS_OD = WS_D + 234 * MiB;
constexpr size_t WS_DS = WS_D + 306 * MiB;
constexpr size_t WS_DEC = WS_D + 450 * MiB;
constexpr size_t WS_H = WS_D + 452 * MiB;
constexpr size_t WS_Y = WS_D;
constexpr size_t WS_HG = WS_D;
constexpr size_t WS_F2 = WS_D;
constexpr size_t WS_U = WS_D + 148 * MiB;
constexpr size_t WS_H2 = WS_D + 483 * MiB;
constexpr size_t WS_END = WS_D + 555 * MiB;
static_assert((size_t)MP * DFF * 2 <= 407 * MiB && (size_t)MP * DM * 2 <= 148 * MiB && (size_t)M * NP * 2 <= 234 * MiB, "dynamic map");
static_assert((size_t)M * DFF * 2 + 148 * MiB <= 483 * MiB, "dense U clear of H2");

constexpr int CW_BAR = 4096;
constexpr int CW_CNT = 8192;

constexpr int RING_BYTES = 131072;
constexpr int TEXP_OFF = 139264;
constexpr int MISC_OFF = 146432 - 512;
constexpr int LDS_BYTES = 147456;

typedef unsigned u32x2 __attribute__((ext_vector_type(2)));

__device__ __forceinline__ float bf2f(unsigned short x) { return __uint_as_float((unsigned)x << 16); }
__device__ __forceinline__ float bflo(unsigned w) { return __uint_as_float(w << 16); }
__device__ __forceinline__ float bfhi(unsigned w) { return __uint_as_float(w & 0xffff0000u); }
__device__ __forceinline__ float siluf(float x) { return x * __builtin_amdgcn_rcpf(1.f + __expf(-x)); }
__device__ __forceinline__ float clamp8(float x) { return fminf(fmaxf(x, -448.f), 448.f); }
__device__ __forceinline__ unsigned pk4_f8(float a, float b, float c, float d) { unsigned w = 0u; w = __builtin_amdgcn_cvt_pk_fp8_f32(clamp8(a), clamp8(b), w, false); w = __builtin_amdgcn_cvt_pk_fp8_f32(clamp8(c), clamp8(d), w, true); return w; }
template <int MASK> __device__ __forceinline__ float xadd(float v) {
    if constexpr (MASK == 32) { const auto rr = __builtin_amdgcn_permlane32_swap(__float_as_uint(v), __float_as_uint(v), false, false); return __uint_as_float(rr[0]) + __uint_as_float(rr[1]); }
    else return v + __int_as_float(__builtin_amdgcn_ds_swizzle(__float_as_int(v), 0x1f | (MASK << 10)));
}
__device__ __forceinline__ float wave_sum(float v) {
    v = xadd<1>(v); v = xadd<2>(v); v = xadd<4>(v); v = xadd<8>(v); v = xadd<16>(v); v = xadd<32>(v);
    return v;
}

struct Args { const float* in[24]; float* out; unsigned char* ws; };
struct Frame {
    LAS unsigned char* lds;
    volatile LAS unsigned* MISC;
    int tid, lane, wave, G, blk, gw, NGW, z, wv;
    const Args* A;
    unsigned char* ws;
};


__device__ __forceinline__ void refresh(Frame& F) {
    int wv = F.wv; asm volatile("" : "+s"(wv));
    const int t = wv * 64 + pg8::lane_id_opaque();
    int bl = blockIdx.x, z = 0, gg = gridDim.x; asm volatile("" : "+s"(bl), "+s"(z), "+s"(gg));
    F.blk = bl; F.z = z; F.G = gg; F.NGW = gg * NWAVES;
    F.tid = t; F.lane = t & 63; F.wave = wv; F.gw = F.blk * NWAVES + F.wave;
}
#define INP(k) (F.A->in[(k) + F.z])
namespace pg8 {
struct EpiProj {
    static constexpr bool PERM = false, AFTER_DRAIN = false;
    bf16_t* P; const float* ropec; const float* ropes;
    __device__ __forceinline__ void operator()(const f32x4 (&acc)[2][2][4][2], const Unit& u, int wr, int wc, int fr, int fq) const {
        const int pn = u.pn, pm = u.pm, tb = pm % 9;
        const bool do_rope = (tb != 0) && (pn < 4);
        const float sc = (pn < 2) ? C2 : (pn == 6 ? 0.125f : 1.f);
        const bool st_ok_all = pn < 12;
#pragma unroll
        for (int ai = 0; ai < 2; ++ai)
#pragma unroll
            for (int m = 0; m < 4; ++m) {
                const int rit = ai * HALF + wr * 64 + m * 16 + fr;
                const size_t grow = (size_t)pm * BM + rit;
                const int s = (tb - 1) * 256 + rit;
                const int pos = (wc & 1) ? (s & 63) : (s >> 6);
                f32x4 cs = {1.f, 1.f, 1.f, 1.f}, sn = {0.f, 0.f, 0.f, 0.f};
                if (do_rope) { cs = *(const f32x4*)(ropec + pos * 16 + 4 * fq); sn = *(const f32x4*)(ropes + pos * 16 + 4 * fq); }
#pragma unroll
                for (int bj = 0; bj < 2; ++bj) {
                    f32x4 v0 = acc[ai][bj][m][0], v1 = acc[ai][bj][m][1];
                    if (do_rope) { const f32x4 a = v0 * cs - v1 * sn, b = v0 * sn + v1 * cs; v0 = a; v1 = b; }
                    v0 = v0 * sc; v1 = v1 * sc;
                    const int col0 = pn * BM + bj * HALF + wc * 32 + 4 * fq;
                    if (st_ok_all || (bj == 0 && wc == 0)) {
                        u32x2 w0, w1; w0.x = cvt_pk_bf16(v0[0], v0[1]); w0.y = cvt_pk_bf16(v0[2], v0[3]); w1.x = cvt_pk_bf16(v1[0], v1[1]); w1.y = cvt_pk_bf16(v1[2], v1[3]);
                        *(u32x2*)(P + grow * NP + col0) = w0; *(u32x2*)(P + grow * NP + col0 + 16) = w1;
                    }
                }
            }
    }
};
struct EpiF32 {
    static constexpr bool PERM = true, AFTER_DRAIN = false;
    bf16_t* Y;
    __device__ __forceinline__ void operator()(const f32x4 (&acc)[2][2][4][2], const Unit& u, int wr, int wc, int fr, int fq) const {
#pragma unroll
        for (int ai = 0; ai < 2; ++ai)
#pragma unroll
            for (int m = 0; m < 4; ++m) {
                bf16_t* rowp = Y + ((size_t)u.pm * BM + ai * HALF + wr * 64 + m * 16 + fr) * DM + u.pn * BM + wc * 32 + 8 * fq;
#pragma unroll
                for (int bj = 0; bj < 2; ++bj) { const f32x4 v0 = acc[ai][bj][m][0], v1 = acc[ai][bj][m][1];
                    u32x4 w; w.x = cvt_pk_bf16(v0[0], v0[1]); w.y = cvt_pk_bf16(v0[2], v0[3]); w.z = cvt_pk_bf16(v1[0], v1[1]); w.w = cvt_pk_bf16(v1[2], v1[3]);
                    *(u32x4*)(rowp + bj * HALF) = w; }
            }
    }
};
struct EpiSwiglu {
    static constexpr bool PERM = true, AFTER_DRAIN = false;
    bf16_t* U;
    __device__ __forceinline__ void operator()(const f32x4 (&acc)[2][2][4][2], const Unit& u, int wr, int wc, int fr, int fq) const {
        const int pnl = u.pn % 22;
        const int col0 = pnl * 128 + wc * 32 + 8 * fq;
#pragma unroll
        for (int ai = 0; ai < 2; ++ai)
#pragma unroll
            for (int m = 0; m < 4; ++m) {
                const size_t rowi = (size_t)u.pm * BM + ai * HALF + wr * 64 + m * 16 + fr;
                float o[8];
                constexpr float ws = FFN_F8 ? 1.f / W8S : 1.f, us = FFN_F8 ? U8S : 1.f;
#pragma unroll
                for (int n = 0; n < 2; ++n)
#pragma unroll
                    for (int j = 0; j < 4; ++j) { const float g = acc[ai][0][m][n][j] * ws, up = acc[ai][1][m][n][j] * (ws * us); o[n * 4 + j] = g * __builtin_amdgcn_rcpf(1.f + __expf(-g)) * up; }
                if constexpr (FFN_F8) { u32x2 w; w.x = pk4_f8(o[0], o[1], o[2], o[3]); w.y = pk4_f8(o[4], o[5], o[6], o[7]); *(u32x2*)((unsigned char*)U + rowi * DFF + col0) = w; }
                else { u32x4 w; w.x = cvt_pk_bf16(o[0], o[1]); w.y = cvt_pk_bf16(o[2], o[3]); w.z = cvt_pk_bf16(o[4], o[5]); w.w = cvt_pk_bf16(o[6], o[7]); *(u32x4*)(U + rowi * DFF + col0) = w; }
            }
    }
};
struct EpiDown {
    static constexpr bool PERM = true, AFTER_DRAIN = false;
    bf16_t* F2; const int* rmap; const float* roww; int dense;
    __device__ __forceinline__ void operator()(const f32x4 (&acc)[2][2][4][2], const Unit& u, int wr, int wc, int fr, int fq) const {
        const int pnl = u.pn & 3;
        const int col0 = pnl * BM + wc * 32 + 8 * fq;
#pragma unroll
        for (int ai = 0; ai < 2; ++ai)
#pragma unroll
            for (int m = 0; m < 4; ++m) {
                const int grow = u.pm * BM + ai * HALF + wr * 64 + m * 16 + fr;
                int tok = grow, slot = 0; float w = 1.f; bool ok = true;
                if (!dense) { const int rm = rmap[grow]; ok = rm >= 0; tok = rm & 0x3fffffff; slot = (rm >> 30) & 1; w = roww[grow]; }
                if constexpr (FFN_F8) w *= 1.f / (W8S * U8S);
                if (ok) {
                    bf16_t* rowp = F2 + ((size_t)slot * M + tok) * DM + col0;
#pragma unroll
                    for (int bj = 0; bj < 2; ++bj) {
                        const f32x4 v0 = acc[ai][bj][m][0] * w, v1 = acc[ai][bj][m][1] * w;
                        u32x4 q; q.x = cvt_pk_bf16(v0[0], v0[1]); q.y = cvt_pk_bf16(v0[2], v0[3]); q.z = cvt_pk_bf16(v1[0], v1[1]); q.w = cvt_pk_bf16(v1[2], v1[3]);
                        *(u32x4*)(rowp + bj * HALF) = q;
                    }
                }
            }
    }
};
struct GroupedOrder {
    StaticOrder S; const PG8_LAS int* texp; int nN;
    __device__ __forceinline__ bool next(int i, Unit& u) const { if (!S.next(i, u)) return false; u.pn += __builtin_amdgcn_readfirstlane(texp[u.pm]) * nN; return true; }
    __device__ __forceinline__ void a_ready(const Unit&) const {}
    __device__ __forceinline__ void done(const Unit&) const {}
};
struct LatOrder {
    StaticOrder S; int lat;
    __device__ __forceinline__ bool next(int i, Unit& u) const { if (!S.next(i, u)) return false; if (lat) u.pm += (u.pm >> 3) + 1; return true; }
    __device__ __forceinline__ void a_ready(const Unit&) const {}
    __device__ __forceinline__ void done(const Unit&) const {}
};
}

__device__ __forceinline__ void ld_row_f32(const float* row, int lane, f32x4 (&v)[4]) {
#pragma unroll
    for (int j = 0; j < 4; ++j) v[j] = *(const f32x4*)(row + 4 * lane + 256 * j);
}
__device__ __forceinline__ void st_row_f32(float* row, int lane, const f32x4 (&v)[4]) {
#pragma unroll
    for (int j = 0; j < 4; ++j) *(f32x4*)(row + 4 * lane + 256 * j) = v[j];
}
__device__ __forceinline__ void ld_row_bf16(const bf16* row, int lane, f32x4 (&v)[4]) {
#pragma unroll
    for (int j = 0; j < 4; ++j) { const u32x2 w = *(const u32x2*)(row + 4 * lane + 256 * j); v[j] = (f32x4){bflo(w.x), bfhi(w.x), bflo(w.y), bfhi(w.y)}; }
}
__device__ __forceinline__ void st_row_bf16(bf16* row, int lane, const f32x4 (&v)[4]) {
#pragma unroll
    for (int j = 0; j < 4; ++j) { u32x2 w; w.x = pg8::cvt_pk_bf16(v[j][0], v[j][1]); w.y = pg8::cvt_pk_bf16(v[j][2], v[j][3]); *(u32x2*)(row + 4 * lane + 256 * j) = w; }
}
__device__ __forceinline__ float row_rinv(const f32x4 (&v)[4]) {
    float s = 0.f;
#pragma unroll
    for (int j = 0; j < 4; ++j) s += (v[j][0] * v[j][0] + v[j][1] * v[j][1]) + (v[j][2] * v[j][2] + v[j][3] * v[j][3]);
    return 1.0f / sqrtf(wave_sum(s) * (1.f / DM) + EPS);
}

__device__ __forceinline__ void transpose_tile(const float* W, int N, int k0, int n0, bf16* WT, int K, int drow0, LAS float* scr, int lane) {
#pragma unroll 8
    for (int i = 0; i < 32; ++i) { const int kk = 2 * i + (lane >> 5); scr[kk * 33 + (lane & 31)] = W[(size_t)(k0 + kk) * N + n0 + (lane & 31)]; }
    LDS_WAIT(); asm volatile("" ::: "memory");
    const int c = lane & 7;
#pragma unroll
    for (int j = 0; j < 4; ++j) { const int n = (lane >> 3) + 8 * j; const LAS float* s = scr + (8 * c) * 33 + n;
        v4u o; o.x = pk2(s[0 * 33], s[1 * 33]); o.y = pk2(s[2 * 33], s[3 * 33]); o.z = pk2(s[4 * 33], s[5 * 33]); o.w = pk2(s[6 * 33], s[7 * 33]);
        *(GAS v4u*)(WT + (size_t)(drow0 + n) * K + k0 + 8 * c) = o; }
    LDS_WAIT(); asm volatile("" ::: "memory");
}
__device__ __forceinline__ void transpose_tile_f8(const float* W, int N, int k0, int n0, unsigned char* WT, int Kb, int drow0, LAS float* scr, int lane, float scale) {
#pragma unroll 8
    for (int i = 0; i < 32; ++i) { const int kk = 2 * i + (lane >> 5); scr[kk * 33 + (lane & 31)] = W[(size_t)(k0 + kk) * N + n0 + (lane & 31)]; }
    LDS_WAIT(); asm volatile("" ::: "memory");
    const int n = lane >> 1, hf = lane & 1; const LAS float* s = scr + (hf * 32) * 33 + n;
    v4u o0, o1;
    o0.x = pk4_f8(s[0 * 33] * scale, s[1 * 33] * scale, s[2 * 33] * scale, s[3 * 33] * scale);     o0.y = pk4_f8(s[4 * 33] * scale, s[5 * 33] * scale, s[6 * 33] * scale, s[7 * 33] * scale);
    o0.z = pk4_f8(s[8 * 33] * scale, s[9 * 33] * scale, s[10 * 33] * scale, s[11 * 33] * scale);   o0.w = pk4_f8(s[12 * 33] * scale, s[13 * 33] * scale, s[14 * 33] * scale, s[15 * 33] * scale);
    o1.x = pk4_f8(s[16 * 33] * scale, s[17 * 33] * scale, s[18 * 33] * scale, s[19 * 33] * scale); o1.y = pk4_f8(s[20 * 33] * scale, s[21 * 33] * scale, s[22 * 33] * scale, s[23 * 33] * scale);
    o1.z = pk4_f8(s[24 * 33] * scale, s[25 * 33] * scale, s[26 * 33] * scale, s[27 * 33] * scale); o1.w = pk4_f8(s[28 * 33] * scale, s[29 * 33] * scale, s[30 * 33] * scale, s[31 * 33] * scale);
    GAS v4u* dst = (GAS v4u*)(WT + (size_t)(drow0 + n) * Kb + k0 + hf * 32);
    dst[0] = o0; dst[1] = o1;
    LDS_WAIT(); asm volatile("" ::: "memory");
}
__device__ __forceinline__ void convert_weights(Frame& F, int l) {
    refresh(F);
    const bool moe = l & 1; const int ne = moe ? NE : 1, li = l >> 1;
    const float* w1 = moe ? INP(21) + (size_t)li * NE * DM * DFF : INP(17) + (size_t)li * DM * DFF;
    const float* w3 = moe ? INP(22) + (size_t)li * NE * DM * DFF : INP(18) + (size_t)li * DM * DFF;
    const float* w2 = moe ? INP(23) + (size_t)li * NE * DM * DFF : INP(19) + (size_t)li * DM * DFF;
    const float* win = INP(10) + (size_t)l * DM * NIN;
    const float* wout = INP(16) + (size_t)l * DM * DM;
    bf16* WIN = (bf16*)(F.ws + WS_WIN); bf16* WOUT = (bf16*)(F.ws + WS_WOUT); bf16* WUP = (bf16*)(F.ws + WS_WUP); bf16* WDN = (bf16*)(F.ws + WS_WDN);
    LAS float* scr = (LAS float*)(F.lds + F.wave * 16384);
    const int nA = 16 * 97, nZ = NP - NIN, nB = 16 * 32, nC1 = 16 * 88, nD1 = 44 * 32;
    const int nC = ne * 2 * nC1, nD = ne * nD1, total = nA + nZ + nB + nC + nD;
    for (int it = F.gw; it < total; it += F.NGW) {
        int r = it;
        if (r < nA) { const int kb = r / 97, nb = r % 97; transpose_tile(win, NIN, 64 * kb, 32 * nb, WIN, DM, 32 * nb, scr, F.lane); continue; } r -= nA;
        if (r < nZ) { const unsigned zz = (unsigned)F.z; v4u z = {zz, zz, zz, zz}; GAS v4u* p = (GAS v4u*)(WIN + (size_t)(NIN + r) * DM) + F.lane * 2; p[0] = z; p[1] = z; continue; } r -= nZ;
        if (r < nB) { const int kb = r / 32, nb = r % 32; transpose_tile(wout, DM, 64 * kb, 32 * nb, WOUT, DM, 32 * nb, scr, F.lane); continue; } r -= nB;
        if (r < nC) { const int e = r / (2 * nC1), q = r % (2 * nC1), which = q / nC1, t = q % nC1, kb = t / 88, nb = t % 88, n0 = 32 * nb;
            const float* src = (which ? w3 : w1) + (size_t)e * DM * DFF;
            if constexpr (FFN_F8) transpose_tile_f8(src, DFF, 64 * kb, n0, (unsigned char*)WUP, DM, e * 5632 + (n0 / 128) * 256 + (n0 % 128) + which * 128, scr, F.lane, W8S);
            else transpose_tile(src, DFF, 64 * kb, n0, WUP, DM, e * 5632 + (n0 / 128) * 256 + (n0 % 128) + which * 128, scr, F.lane); continue; } r -= nC;
        { const int e = r / nD1, t = r % nD1, kb = t / 32, nb = t % 32;
            if constexpr (FFN_F8) transpose_tile_f8(w2 + (size_t)e * DFF * DM, DM, 64 * kb, 32 * nb, (unsigned char*)WDN + (size_t)e * DM * DFF, DFF, 32 * nb, scr, F.lane, W8S);
            else transpose_tile(w2 + (size_t)e * DFF * DM, DM, 64 * kb, 32 * nb, WDN + (size_t)e * DM * DFF, DFF, 32 * nb, scr, F.lane); }
    }
}

__device__ __forceinline__ void p0_mod(Frame& F) {
    refresh(F);
    LAS float* S = (LAS float*)(F.lds);
    LAS float* R = (LAS float*)(F.lds + 69632);
    const float* c = INP(1); const float* cc = INP(3); const float* wmod = INP(4); const float* bmod = INP(5);
    float* MOD = (float*)(F.ws + WS_MOD);
    for (int i = F.tid; i < 17 * 1024; i += 512) { const int b = i >> 10, k = i & 1023; const float v = b < 16 ? c[b * 1024 + k] : cc[k]; S[i] = siluf(v); }
    __syncthreads();
    const int kq = F.lane >> 4, c4 = (F.lane & 15) * 4;
    for (int item = F.blk; item < 4 * 96; item += F.G) {
        const int l = item / 96, col0 = (item % 96) * 64;
        const float* W = wmod + (size_t)l * DM * 6144;
        float acc[17][4];
#pragma unroll
        for (int b = 0; b < 17; ++b)
#pragma unroll
            for (int j = 0; j < 4; ++j) acc[b][j] = 0.f;
        for (int it = 0; it < 32; ++it) {
            const int k = F.wave * 128 + it * 4 + kq;
            const f32x4 w = *(const f32x4*)(W + (size_t)k * 6144 + col0 + c4);
#pragma unroll
            for (int b = 0; b < 17; ++b) { const float s = S[b * 1024 + k];
#pragma unroll
                for (int j = 0; j < 4; ++j) acc[b][j] += s * w[j]; }
        }
#pragma unroll
        for (int b = 0; b < 17; ++b)
#pragma unroll
            for (int j = 0; j < 4; ++j) { float v = acc[b][j]; v = xadd<16>(v); v = xadd<32>(v); acc[b][j] = v; }
        if (kq == 0) {
#pragma unroll
            for (int b = 0; b < 17; ++b)
#pragma unroll
                for (int j = 0; j < 4; ++j) R[(F.wave * 17 + b) * 64 + c4 + j] = acc[b][j];
        }
        __syncthreads();
        for (int o = F.tid; o < 17 * 64; o += 512) { const int b = o >> 6, ccx = o & 63; float s = bmod[l * 6144 + col0 + ccx];
            for (int w = 0; w < 8; ++w) s += R[(w * 17 + b) * 64 + ccx];
            MOD[((size_t)l * 17 + b) * 6144 + col0 + ccx] = s; }
        __syncthreads();
    }
}
__device__ __forceinline__ float lam_init_of(int l) { return 0.8f - 0.6f * expf(-0.3f * (float)l); }
__device__ __forceinline__ void p0_misc(Frame& F) {
    refresh(F);
    float* ropec = (float*)(F.ws + WS_ROPE); float* ropes = ropec + 1024; float* lam = (float*)(F.ws + WS_ROPE + 16384);
    if (F.blk == 0) {
        for (int i = F.tid; i < 1024; i += 512) { const int pos = i >> 4, f = i & 15; const float inv = powf(10000.f, -(float)f / 16.f); const float ang = (float)pos * inv; ropec[i] = cosf(ang); ropes[i] = sinf(ang); }
    }
    if (F.blk == (1 % F.G) && F.wave < 4) {
        const int l = F.wave; const float* lv = INP(13) + l * 256;
        const float a = wave_sum(lv[F.lane] * lv[64 + F.lane]), b = wave_sum(lv[128 + F.lane] * lv[192 + F.lane]);
        if (F.lane == 0) lam[l] = expf(a) - expf(b) + lam_init_of(l);
    }
}

namespace att {
using bf16x8 = __attribute__((ext_vector_type(8))) short;
using s16x4  = __attribute__((ext_vector_type(4))) short;
using f32x16 = __attribute__((ext_vector_type(16))) float;
using u32x4  = __attribute__((ext_vector_type(4))) unsigned;
constexpr int QBLK = 32, KVBLK = 64, NW = 8, DV = 128;
constexpr float THR = 8.f;
constexpr size_t SHM_V = KVBLK * DV * 2, SHM_K = KVBLK * 64 * 2, SHM_ATTN = 2 * SHM_V + 2 * SHM_K + NW * 64 * 4;
#define KSWZ64(row, colB) ((row) * 128 + ((colB) ^ ((((row) >> 1) & 7) << 4)))
#define SBAR() __builtin_amdgcn_sched_barrier(0)
__device__ __forceinline__ int crow(int r, int hi) { return (r & 3) + 8 * (r >> 2) + 4 * hi; }
__device__ __forceinline__ unsigned cvtpk(float lo, float hi) { unsigned r; asm volatile("v_cvt_pk_bf16_f32 %0, %1, %2" : "=v"(r) : "v"(lo), "v"(hi)); return r; }
__device__ __forceinline__ void partialSM(f32x16& p0, f32x16& p1, float& m_reg, float& mn, float& alpha) {
  float pmax = p0[0];
#pragma unroll
  for (int r = 1; r < 16; ++r) pmax = fmaxf(pmax, p0[r]);
#pragma unroll
  for (int r = 0; r < 16; ++r) pmax = fmaxf(pmax, p1[r]);
  { auto rr = __builtin_amdgcn_permlane32_swap(__float_as_uint(pmax), __float_as_uint(pmax), false, false);
    pmax = fmaxf(__uint_as_float(rr[0]), __uint_as_float(rr[1])); }
  if (__builtin_expect(__all(pmax - m_reg <= THR), 1)) { mn = m_reg; alpha = 1.f; }
  else { mn = fmaxf(m_reg, pmax); alpha = __builtin_amdgcn_exp2f(m_reg - mn); m_reg = mn; }
#pragma unroll
  for (int r = 0; r < 16; ++r) p0[r] = p0[r] - mn;
#pragma unroll
  for (int r = 0; r < 16; ++r) p1[r] = p1[r] - mn;
#pragma unroll
  for (int r = 0; r < 16; ++r) p0[r] = __builtin_amdgcn_exp2f(p0[r]);
}
__device__ __forceinline__ void finishSM(f32x16& p0, f32x16& p1, float alpha, float& l_reg, bf16x8& pa0, bf16x8& pa1, bf16x8& pa2, bf16x8& pa3) {
#pragma unroll
  for (int r = 0; r < 16; ++r) p1[r] = __builtin_amdgcn_exp2f(p1[r]);
  float ps = 0;
#pragma unroll
  for (int r = 0; r < 16; ++r) ps += p0[r];
#pragma unroll
  for (int r = 0; r < 16; ++r) ps += p1[r];
  { auto rr = __builtin_amdgcn_permlane32_swap(__float_as_uint(ps), __float_as_uint(ps), false, false);
    ps = __uint_as_float(rr[0]) + __uint_as_float(rr[1]); }
  l_reg = l_reg * alpha + ps;
#define PK4(P, BASE, OUT) do { unsigned a0 = cvtpk(P[BASE + 0], P[BASE + 1]), a1 = cvtpk(P[BASE + 2], P[BASE + 3]);   \
    unsigned b0 = cvtpk(P[BASE + 4], P[BASE + 5]), b1 = cvtpk(P[BASE + 6], P[BASE + 7]);                              \
    auto r0 = __builtin_amdgcn_permlane32_swap(a0, b0, false, false); auto r1 = __builtin_amdgcn_permlane32_swap(a1, b1, false, false); \
    u32x4 w = {r0[0], r1[0], r0[1], r1[1]}; OUT = *reinterpret_cast<bf16x8*>(&w); } while (0)
  PK4(p0, 0, pa0); PK4(p0, 8, pa1); PK4(p1, 0, pa2); PK4(p1, 8, pa3);
#undef PK4
}
__device__ __forceinline__ void pack_p(const f32x16& p0, const f32x16& p1, bf16x8& pa0, bf16x8& pa1, bf16x8& pa2, bf16x8& pa3) {
#define PK4(P, BASE, OUT) do { unsigned a0 = cvtpk(P[BASE + 0], P[BASE + 1]), a1 = cvtpk(P[BASE + 2], P[BASE + 3]);   \
    unsigned b0 = cvtpk(P[BASE + 4], P[BASE + 5]), b1 = cvtpk(P[BASE + 6], P[BASE + 7]);                              \
    auto r0 = __builtin_amdgcn_permlane32_swap(a0, b0, false, false); auto r1 = __builtin_amdgcn_permlane32_swap(a1, b1, false, false); \
    u32x4 w = {r0[0], r1[0], r0[1], r1[1]}; OUT = *reinterpret_cast<bf16x8*>(&w); } while (0)
  PK4(p0, 0, pa0); PK4(p0, 8, pa1); PK4(p1, 0, pa2); PK4(p1, 8, pa3);
#undef PK4
}
__device__ __forceinline__ void qkt(f32x16& p0, f32x16& p1, const bf16* Ks, const bf16x8* qr, int r32, int hi) {
  p0 = f32x16{}; p1 = f32x16{};
#pragma unroll
  for (int d0 = 0; d0 < 4; ++d0) { int cb = (d0 * 16 + hi * 8) * 2;
    bf16x8 b0 = *reinterpret_cast<const bf16x8*>((const char*)Ks + KSWZ64(r32, cb));
    bf16x8 b1 = *reinterpret_cast<const bf16x8*>((const char*)Ks + KSWZ64(32 + r32, cb));
    p0 = __builtin_amdgcn_mfma_f32_32x32x16_bf16(b0, qr[d0], p0, 0, 0, 0);
    p1 = __builtin_amdgcn_mfma_f32_32x32x16_bf16(b1, qr[d0], p1, 0, 0, 0); }
}
__device__ __forceinline__ int v_st(int k, int c) { const int kk = (k & ~0xC) | ((k & 4) << 1) | ((k & 8) >> 1); return ((kk >> 3) * 4 + (c >> 5)) * 512 + ((kk & 7) * 32 + (c & 31)) * 2; }
__device__ __forceinline__ int v_rd_base(int lane) { return ((lane & 3) << 3) | (((lane >> 2) & 3) << 6) | (((lane >> 4) & 1) << 5) | (((lane >> 5) & 1) << 8); }
constexpr int v_rd_off(int d0, int ks, int half) { return d0 * 512 + ks * 4096 + half * 2048; }
template <int OFF> __device__ __forceinline__ s16x4 tr_read(int vb) {
  s16x4 r; asm volatile("ds_read_b64_tr_b16 %0, %1 offset:%2" : "=&v"(r) : "v"(vb), "i"(OFF) : "memory"); return r;
}
template <int D0> __device__ __forceinline__ void pv_one(f32x16& od, int vb, bf16x8 pa0, bf16x8 pa1, bf16x8 pa2, bf16x8 pa3) {
  const s16x4 l0 = tr_read<v_rd_off(D0, 0, 0)>(vb), h0 = tr_read<v_rd_off(D0, 0, 1)>(vb), l1 = tr_read<v_rd_off(D0, 1, 0)>(vb), h1 = tr_read<v_rd_off(D0, 1, 1)>(vb);
  const s16x4 l2 = tr_read<v_rd_off(D0, 2, 0)>(vb), h2 = tr_read<v_rd_off(D0, 2, 1)>(vb), l3 = tr_read<v_rd_off(D0, 3, 0)>(vb), h3 = tr_read<v_rd_off(D0, 3, 1)>(vb);
  asm volatile("s_waitcnt lgkmcnt(0)" ::: "memory"); SBAR();
#define PK(L, H) (bf16x8){L[0], L[1], L[2], L[3], H[0], H[1], H[2], H[3]}
  od = __builtin_amdgcn_mfma_f32_32x32x16_bf16(pa0, PK(l0, h0), od, 0, 0, 0);
  od = __builtin_amdgcn_mfma_f32_32x32x16_bf16(pa1, PK(l1, h1), od, 0, 0, 0);
  od = __builtin_amdgcn_mfma_f32_32x32x16_bf16(pa2, PK(l2, h2), od, 0, 0, 0);
  od = __builtin_amdgcn_mfma_f32_32x32x16_bf16(pa3, PK(l3, h3), od, 0, 0, 0);
#undef PK
}
__device__ __forceinline__ void pv_d0(f32x16* o, int vb, bf16x8 pa0, bf16x8 pa1, bf16x8 pa2, bf16x8 pa3) {
  pv_one<0>(o[0], vb, pa0, pa1, pa2, pa3); pv_one<1>(o[1], vb, pa0, pa1, pa2, pa3); pv_one<2>(o[2], vb, pa0, pa1, pa2, pa3); pv_one<3>(o[3], vb, pa0, pa1, pa2, pa3);
}
constexpr int LDQ = NP, LDK = NP, LDO = DM;
__device__ __forceinline__ void attn_unit(const bf16* __restrict__ Qb, const bf16* __restrict__ Kh, const bf16* __restrict__ Vh, bf16* __restrict__ Ob, int seq, char* lds, int tid) {
  const int wid = tid >> 6, lane = tid & 63, r32 = lane & 31, hi = lane >> 5;
  bf16* V_lds = (bf16*)lds; bf16* K_lds = (bf16*)(lds + 2 * SHM_V);
  float* ws = (float*)(lds + 2 * SHM_V + 2 * SHM_K) + wid * 64; float* li_l = ws; float* al_l = ws + 32;
  float m_reg = -1e30f, l_reg = 0; f32x16 o[4] = {}; bf16x8 qr[4];
  const bf16* Qw = Qb + (long)(wid * QBLK + r32) * LDQ + hi * 8;
#pragma unroll
  for (int d0 = 0; d0 < 4; ++d0) qr[d0] = *(const __attribute__((address_space(1))) bf16x8*)(Qw + d0 * 16);
  const int sr = tid >> 4, sc = (tid & 15) * 8, vst0 = v_st(sr, sc), vst1 = v_st(32 + sr, sc);
  const int kr = tid >> 3, kc = (tid & 7) * 8, kst = KSWZ64(kr, kc * 2);
  const int vb0 = (int)(uintptr_t)V_lds + v_rd_base(lane);
  struct { bf16x8 vs0, vs1, ks0; } sr_[2];
#define GLD8(p) (*(const __attribute__((address_space(1))) bf16x8*)(p))
#define SLOAD(i, k0) do { sr_[i].vs0 = GLD8(&Vh[(long)((k0) + sr) * LDK + sc]); sr_[i].vs1 = GLD8(&Vh[(long)((k0) + 32 + sr) * LDK + sc]); \
    sr_[i].ks0 = GLD8(&Kh[(long)((k0) + kr) * LDK + kc]); } while (0)
#define SWRITE(b, i) do { *(bf16x8*)((char*)V_lds + (b) * SHM_V + vst0) = sr_[i].vs0; *(bf16x8*)((char*)V_lds + (b) * SHM_V + vst1) = sr_[i].vs1; \
    *(bf16x8*)((char*)K_lds + (b) * SHM_K + kst) = sr_[i].ks0; } while (0)
#define SWAIT() asm volatile("s_waitcnt vmcnt(3)" ::: "memory")
#define RESC(a) do { if (__any((a) < 1.f)) { if (hi == 0) al_l[r32] = (a); asm volatile("s_waitcnt lgkmcnt(0)" ::: "memory"); \
    _Pragma("unroll") for (int d = 0; d < 4; ++d) _Pragma("unroll") for (int r = 0; r < 16; ++r) o[d][r] *= al_l[crow(r, hi)]; } } while (0)
  f32x16 pA0, pA1, pB0, pB1; float mnA, mnB, alA, alB; bf16x8 pa0, pa1, pa2, pa3; const int NT = seq / KVBLK;
  constexpr int SE = 0, SO = 1;
  SLOAD(SE, 0); asm volatile("s_waitcnt vmcnt(0)" ::: "memory"); SWRITE(0, SE); __syncthreads();
  qkt(pA0, pA1, K_lds, qr, r32, hi); partialSM(pA0, pA1, m_reg, mnA, alA);
  SLOAD(SO, KVBLK); if (2 < NT) SLOAD(SE, 2 * KVBLK);
  SWAIT(); SWRITE(1, SO); __syncthreads();
  for (int j = 1; j + 1 < NT; j += 2) {
    SBAR(); qkt(pB0, pB1, (bf16*)((char*)K_lds + SHM_K), qr, r32, hi);
    finishSM(pA0, pA1, alA, l_reg, pa0, pa1, pa2, pa3); SBAR();
    SLOAD(SO, (j + 2) * KVBLK); SBAR();
    pv_d0(o, vb0, pa0, pa1, pa2, pa3); partialSM(pB0, pB1, m_reg, mnB, alB);
    __syncthreads(); SWAIT(); SWRITE(0, SE);
    RESC(alB); __syncthreads();
    SBAR(); qkt(pA0, pA1, K_lds, qr, r32, hi);
    finishSM(pB0, pB1, alB, l_reg, pa0, pa1, pa2, pa3); SBAR();
    if (j + 3 < NT) SLOAD(SE, (j + 3) * KVBLK); SBAR();
    pv_d0(o, vb0 + (int)SHM_V, pa0, pa1, pa2, pa3); partialSM(pA0, pA1, m_reg, mnA, alA);
    __syncthreads(); SWAIT(); SWRITE(1, SO);
    RESC(alA); __syncthreads();
  }
  SBAR(); qkt(pB0, pB1, (bf16*)((char*)K_lds + SHM_K), qr, r32, hi);
  finishSM(pA0, pA1, alA, l_reg, pa0, pa1, pa2, pa3); SBAR();
  pv_d0(o, vb0, pa0, pa1, pa2, pa3); partialSM(pB0, pB1, m_reg, mnB, alB);
  __syncthreads(); RESC(alB);
  finishSM(pB0, pB1, alB, l_reg, pa0, pa1, pa2, pa3); SBAR();
  pv_d0(o, vb0 + (int)SHM_V, pa0, pa1, pa2, pa3);
  if (hi == 0) li_l[r32] = l_reg; asm volatile("s_waitcnt lgkmcnt(0)" ::: "memory");
  float rli[16];
#pragma unroll
  for (int r = 0; r < 16; ++r) rli[r] = __builtin_amdgcn_rcpf(li_l[crow(r, hi)]);
  bf16* Ow = Ob + (long)(wid * QBLK) * LDO;
#pragma unroll
  for (int r = 0; r < 16; ++r) { const int orow = crow(r, hi);
#pragma unroll
    for (int d0 = 0; d0 < 4; ++d0) Ow[(long)orow * LDO + d0 * 32 + r32] = (bf16)(cvtpk(o[d0][r] * rli[r], 0.f) & 0xffffu); }
#undef SLOAD
#undef GLD8
#undef SWRITE
#undef SWAIT
#undef RESC
}
}

__device__ __forceinline__ int gla_item(int b, int h, int dir, int c) { return ((b * 4 + h) * 2 + dir) * NCH + c; }
namespace gla {
using att::bf16x8; using att::f32x16; using att::u32x4;
__device__ __forceinline__ void gates8(const bf16* P, const float* w2, const float* gb, size_t row0, int dir, int seg, int k, float (&gl)[8]) {
    float w[16];
#pragma unroll
    for (int j = 0; j < 16; ++j) w[j] = w2[j * 256 + k];
    const float bias = gb[k];
#pragma unroll
    for (int i = 0; i < 8; ++i) {
        const bf16* gp = P + (row0 + seg * 8 + i) * NP + C_GLR + dir * 16;
        const v4u a = *(const v4u*)gp, b = *(const v4u*)(gp + 8);
        float z = bias;
        z += bflo(a.x) * w[0] + bfhi(a.x) * w[1] + bflo(a.y) * w[2] + bfhi(a.y) * w[3] + bflo(a.z) * w[4] + bfhi(a.z) * w[5] + bflo(a.w) * w[6] + bfhi(a.w) * w[7];
        z += bflo(b.x) * w[8] + bfhi(b.x) * w[9] + bflo(b.y) * w[10] + bfhi(b.y) * w[11] + bflo(b.z) * w[12] + bfhi(b.z) * w[13] + bflo(b.w) * w[14] + bfhi(b.w) * w[15];
        gl[i] = (fminf(z, 0.f) - log1pf(expf(-fabsf(z)))) * (1.f / 16.f);
    }
}
__device__ __forceinline__ float lscan(const float (&gl)[8], int dir, float (&loc)[8]) {
    float run = 0.f;
    if (dir == 0) {
#pragma unroll
        for (int i = 0; i < 8; ++i) { run += gl[i]; loc[i] = run; }
    } else {
#pragma unroll
        for (int i = 7; i >= 0; --i) { run += gl[i]; loc[i] = run; }
    }
    return run;
}
__device__ __forceinline__ void stage_tile_bf16(const bf16* src, size_t pitch, char* tile, int tid) {
    const int sr = tid >> 4, sc = (tid & 15) * 8;
    const bf16x8 a = *reinterpret_cast<const bf16x8*>(src + (size_t)sr * pitch + sc), b = *reinterpret_cast<const bf16x8*>(src + (size_t)(32 + sr) * pitch + sc);
    *(bf16x8*)(tile + att::v_st(sr, sc)) = a; *(bf16x8*)(tile + att::v_st(32 + sr, sc)) = b;
}
__device__ __forceinline__ void stage_tile_f32(const float* src, char* tile, int tid) {
    const int sr = tid >> 4, sc = (tid & 15) * 8;
#pragma unroll
    for (int t = 0; t < 2; ++t) { const int row = sr + 32 * t; const f32x4 x = *(const f32x4*)(src + row * 128 + sc), y = *(const f32x4*)(src + row * 128 + sc + 4);
        u32x4 w = {att::cvtpk(x[0], x[1]), att::cvtpk(x[2], x[3]), att::cvtpk(y[0], y[1]), att::cvtpk(y[2], y[3])};
        *(u32x4*)(tile + att::v_st(row, sc)) = w; }
}
__device__ __forceinline__ void pv_sel(int d0, f32x16& o, int vb, bf16x8 a0, bf16x8 a1, bf16x8 a2, bf16x8 a3) {
    switch (d0) { case 0: att::pv_one<0>(o, vb, a0, a1, a2, a3); break; case 1: att::pv_one<1>(o, vb, a0, a1, a2, a3); break;
                  case 2: att::pv_one<2>(o, vb, a0, a1, a2, a3); break; default: att::pv_one<3>(o, vb, a0, a1, a2, a3); break; }
}
__device__ __forceinline__ void afrag4(const char* img, int row, int hi, bf16x8 (&a)[4]) {
#pragma unroll
    for (int s = 0; s < 4; ++s) a[s] = *reinterpret_cast<const bf16x8*>(img + KSWZ64(row, (s * 16 + hi * 8) * 2));
}
__device__ __forceinline__ void st_sw(char* img, int row, int col, float v) { *(unsigned short*)(img + KSWZ64(row, col * 2)) = (unsigned short)(att::cvtpk(v, 0.f) & 0xffffu); }
}

constexpr size_t WS_OG = WS_DS;
constexpr int CW_Q = 12288;
struct GlaPre { unsigned g; unsigned short q[8], k[8]; att::bf16x8 v0, v1; };
__device__ __forceinline__ void gla_prefetch(GlaPre& R, const bf16* P_, size_t row0, int h, int dir, int k, int seg, int tid) {
    const GAS bf16* P = (const GAS bf16*)P_;
    R.g = *(const GAS unsigned*)(P + (row0 + seg * 8 + (k >> 3)) * NP + C_GLR + dir * 16 + (k & 7) * 2);
#pragma unroll
    for (int i = 0; i < 8; ++i) { const GAS bf16* rp = P + (row0 + seg * 8 + i) * NP; R.q[i] = rp[C_GQ + h * 64 + k]; R.k[i] = rp[C_GK + h * 64 + k]; }
    const int sr = tid >> 4, sc = (tid & 15) * 8;
    R.v0 = *(const GAS att::bf16x8*)(P + (row0 + sr) * NP + C_GV + h * 128 + sc); R.v1 = *(const GAS att::bf16x8*)(P + (row0 + 32 + sr) * NP + C_GV + h * 128 + sc);
}
__device__ __forceinline__ void gla_chain(Frame& F, int l, int chain) {
    const int b = chain >> 3, h = (chain >> 1) & 3, dir = chain & 1;
    const bf16* P = (const bf16*)(F.ws + WS_PROJ); bf16* OG = (bf16*)(F.ws + WS_OG) + (size_t)dir * M * 512;
    char* lds = (char*)F.lds; char* Vt = lds; char* St = lds + 16384; char* KtT = lds + 32768; char* Kt = lds + 40960; char* Qt = lds + 49152; char* Qh = lds + 57344;
    float* T = (float*)(lds + 65536); float* Dec = (float*)(lds + 67584);
    const int k = F.lane, seg = F.tid >> 6, r32 = F.lane & 31, hi = F.lane >> 5, mt = F.wave >> 2, d0 = F.wave & 3;
    const int vbV = (int)(uintptr_t)Vt + att::v_rd_base(F.lane), vbS = (int)(uintptr_t)St + att::v_rd_base(F.lane);
    const int sr = F.tid >> 4, sc = (F.tid & 15) * 8;
    float w[16];
    { const float* w2 = INP(11) + (size_t)((l * 2 + dir) * 16) * 256 + h * 64;
#pragma unroll
      for (int j = 0; j < 16; ++j) w[j] = w2[j * 256 + k]; }
    const float bias = (INP(12) + (l * 2 + dir) * 256 + h * 64)[k];
    att::f32x16 S = {};
    GlaPre R, RN;
    { const int c0 = dir == 0 ? 0 : 3; gla_prefetch(RN, P, (size_t)b * TPB + c0 * 64, h, dir, k, seg, F.tid); }
    for (int j = 0; j < NCH; ++j) {
        const int c = dir == 0 ? j : (j < 4 ? 3 - j : 39 - j);
        const size_t row0 = (size_t)b * TPB + c * 64;
        R = RN;
        if (j + 1 < NCH) { const int cn = dir == 0 ? j + 1 : (j + 1 < 4 ? 2 - j : 38 - j); gla_prefetch(RN, P, (size_t)b * TPB + cn * 64, h, dir, k, seg, F.tid); }
        float gl[8], loc[8];
#pragma unroll
        for (int i = 0; i < 8; ++i) {
            float z = bias;
#pragma unroll
            for (int d = 0; d < 8; ++d) { const unsigned s = (unsigned)__builtin_amdgcn_readlane((int)R.g, i * 8 + d); z += bflo(s) * w[2 * d] + bfhi(s) * w[2 * d + 1]; }
            gl[i] = (fminf(z, 0.f) - __logf(1.f + __expf(-fabsf(z)))) * (1.f / 16.f); }
        const float segtot = gla::lscan(gl, dir, loc);
        T[seg * 64 + k] = segtot;
        *(att::bf16x8*)(Vt + att::v_st(sr, sc)) = R.v0; *(att::bf16x8*)(Vt + att::v_st(32 + sr, sc)) = R.v1;
#pragma unroll
        for (int r = 0; r < 16; ++r) *(unsigned short*)(St + att::v_st(mt * 32 + att::crow(r, hi), d0 * 32 + r32)) = (unsigned short)(att::cvtpk(S[r], 0.f) & 0xffffu);
        __syncthreads();
        float off = 0.f, tot = 0.f;
        int sg = seg; asm volatile("" : "+v"(sg));
#pragma unroll
        for (int s = 0; s < 8; ++s) { const float t = T[s * 64 + k]; tot += t; const bool inoff = dir == 0 ? (s < sg) : (s > sg); off += inoff ? t : 0.f; }
        const float etot = __expf(tot);
        float kt[8];
#pragma unroll
        for (int i = 0; i < 8; ++i) { const int tau = seg * 8 + i; const float qv = bf2f(R.q[i]), kv = bf2f(R.k[i]); const float cc = loc[i] + off;
            const float a = fmaxf(__expf(cc), 1e-30f)  , bq = __builtin_amdgcn_rcpf(a), kb = kv * bq;
            kt[i] = kb * etot;
            gla::st_sw(Qh, tau, k, qv * a); gla::st_sw(Kt, tau, k, kb); }
        { att::u32x4 wv = {att::cvtpk(kt[0], kt[1]), att::cvtpk(kt[2], kt[3]), att::cvtpk(kt[4], kt[5]), att::cvtpk(kt[6], kt[7])};
          *(att::u32x4*)(KtT + KSWZ64(k, seg * 16)) = wv; }
        if (sg == 0) Dec[k] = etot;
        __syncthreads();
        att::f32x16 o = {};
        int tau_q = mt * 32 + r32; asm volatile("" : "+v"(tau_q));
        { att::bf16x8 qr[4]; gla::afrag4(Qh, tau_q, hi, qr);
          att::f32x16 p0, p1; att::qkt(p0, p1, (const bf16*)Kt, qr, r32, hi);
#pragma unroll
          for (int r = 0; r < 16; ++r) { const int t0 = att::crow(r, hi), t1 = 32 + t0;
              const bool k0 = dir == 0 ? (t0 <= tau_q) : (t0 >= tau_q), k1 = dir == 0 ? (t1 <= tau_q) : (t1 >= tau_q);
              p0[r] = k0 ? p0[r] : 0.f; p1[r] = k1 ? p1[r] : 0.f; }
          att::bf16x8 pa0, pa1, pa2, pa3; att::pack_p(p0, p1, pa0, pa1, pa2, pa3);
          gla::pv_sel(d0, o, vbV, pa0, pa1, pa2, pa3);
          gla::pv_sel(d0, o, vbS, qr[0], qr[1], qr[2], qr[3]); }
#pragma unroll
        for (int r = 0; r < 16; ++r) S[r] *= Dec[mt * 32 + att::crow(r, hi)];
        { att::bf16x8 a[4]; gla::afrag4(KtT, mt * 32 + r32, hi, a); gla::pv_sel(d0, S, vbV, a[0], a[1], a[2], a[3]); }
        GAS bf16* op = (GAS bf16*)(OG + row0 * 512 + h * 128 + d0 * 32 + r32);
#pragma unroll
        for (int r = 0; r < 16; ++r) op[(size_t)(mt * 32 + att::crow(r, hi)) * 512] = (bf16)(att::cvtpk(o[r], 0.f) & 0xffffu);
        __syncthreads();
    }
}
__device__ __forceinline__ void p3_mixer(Frame& F, int l) {
    refresh(F);
    for (int ch = F.blk; ch < NBATCH * 8; ch += F.G) gla_chain(F, l, ch);
    const bf16* P = (const bf16*)(F.ws + WS_PROJ); bf16* OD = (bf16*)(F.ws + WS_OD);
    volatile LAS unsigned* slot = F.MISC + 24;
    int myq = F.blk & 7, tries = 0;
    for (;;) {
        __syncthreads();
        if (F.tid == 0) slot[0] = __hip_atomic_fetch_add((unsigned*)((gu32*)F.ws + CW_Q + 64 * l + 8 * 0 + myq), 1u, __ATOMIC_RELAXED, __HIP_MEMORY_SCOPE_AGENT);
        __syncthreads();
        const int u = (int)slot[0];
        if (u >= (l == DEPTH - 1 ? 128 : 144)) { if (++tries >= 8) break; myq = (myq + 1) & 7; continue; }
        int g, qt;
        if (u < 128) { const int pi = u >> 4, mp = (u >> 3) & 1; g = ((pi * 8 + myq) << 1) + mp; qt = 1 + (u & 7); }
        else { const int gi = u - 128; g = (((gi >> 1) * 8 + myq) << 1) + (gi & 1); qt = 0; }
        const int b = g >> 3, hh = g & 7;
        const size_t row0 = (size_t)b * TPB;
        att::attn_unit(P + (row0 + qt * 256) * NP + C_Q + hh * 64, P + row0 * NP + C_K + hh * 64, P + row0 * NP + C_V + (hh >> 1) * 128,
                       OD + (row0 + qt * 256) * DM + hh * 128, qt == 0 ? CTX : TPB, (char*)F.lds, F.tid);
    }
    __syncthreads();
}
__device__ __forceinline__ void p5_merge_all(Frame& F, int l) {
    refresh(F);
    const bf16* OD = (const bf16*)(F.ws + WS_OD); const bf16* OG = (const bf16*)(F.ws + WS_OG); const bf16* P = (const bf16*)(F.ws + WS_PROJ); bf16* MRG = (bf16*)(F.ws + WS_H);
    const float lam = ((const float*)(F.ws + WS_ROPE + 16384))[l]; const float omli = 1.f - lam_init_of(l);
    const float* subln = INP(14) + l * 128; const float* onorm = INP(15) + l * 128;
    const int h = F.lane >> 4, c0 = (F.lane & 15) * 8;
    const int rpw = (M + F.NGW - 1) / F.NGW, r0 = F.gw * rpw, r1 = (r0 + rpw < M) ? r0 + rpw : M;
    for (int r = r0; r < r1; ++r) {
        const v4u a = *(const v4u*)(OD + (size_t)r * DM + h * 256 + c0), bq = *(const v4u*)(OD + (size_t)r * DM + h * 256 + 128 + c0);
        const v4u gf = *(const v4u*)(OG + (size_t)r * 512 + h * 128 + c0), gbk = *(const v4u*)(OG + ((size_t)M + r) * 512 + h * 128 + c0);
        const v4u gt = *(const v4u*)(P + (size_t)r * NP + C_GG + h * 128 + c0);
        float d[8], e[8], g[8];
        d[0] = bflo(a.x) - lam * bflo(bq.x); d[1] = bfhi(a.x) - lam * bfhi(bq.x); d[2] = bflo(a.y) - lam * bflo(bq.y); d[3] = bfhi(a.y) - lam * bfhi(bq.y);
        d[4] = bflo(a.z) - lam * bflo(bq.z); d[5] = bfhi(a.z) - lam * bfhi(bq.z); d[6] = bflo(a.w) - lam * bflo(bq.w); d[7] = bfhi(a.w) - lam * bfhi(bq.w);
        e[0] = bflo(gf.x) + bflo(gbk.x); e[1] = bfhi(gf.x) + bfhi(gbk.x); e[2] = bflo(gf.y) + bflo(gbk.y); e[3] = bfhi(gf.y) + bfhi(gbk.y);
        e[4] = bflo(gf.z) + bflo(gbk.z); e[5] = bfhi(gf.z) + bfhi(gbk.z); e[6] = bflo(gf.w) + bflo(gbk.w); e[7] = bfhi(gf.w) + bfhi(gbk.w);
        g[0] = bflo(gt.x); g[1] = bfhi(gt.x); g[2] = bflo(gt.y); g[3] = bfhi(gt.y); g[4] = bflo(gt.z); g[5] = bfhi(gt.z); g[6] = bflo(gt.w); g[7] = bfhi(gt.w);
        float ss = 0.f, se = 0.f;
#pragma unroll
        for (int i = 0; i < 8; ++i) { ss += d[i] * d[i]; se += e[i] * e[i]; }
        ss = xadd<1>(ss); ss = xadd<2>(ss); ss = xadd<4>(ss); ss = xadd<8>(ss);
        se = xadd<1>(se); se = xadd<2>(se); se = xadd<4>(se); se = xadd<8>(se);
        const float sc = omli / sqrtf(ss * (1.f / 128.f) + EPS), se2 = 1.0f / sqrtf(se * (1.f / 128.f) + EPS);
#pragma unroll
        for (int i = 0; i < 8; ++i) { d[i] = d[i] * sc * subln[c0 + i]; e[i] = e[i] * se2 * onorm[c0 + i] * siluf(g[i]); }
        v4u w; w.x = pg8::cvt_pk_bf16(d[0], d[1]); w.y = pg8::cvt_pk_bf16(d[2], d[3]); w.z = pg8::cvt_pk_bf16(d[4], d[5]); w.w = pg8::cvt_pk_bf16(d[6], d[7]);
        *(v4u*)(MRG + (size_t)r * DM + h * 128 + c0) = w;
        v4u x; x.x = pg8::cvt_pk_bf16(e[0], e[1]); x.y = pg8::cvt_pk_bf16(e[2], e[3]); x.z = pg8::cvt_pk_bf16(e[4], e[5]); x.w = pg8::cvt_pk_bf16(e[6], e[7]);
        *(v4u*)(MRG + (size_t)r * DM + 512 + h * 128 + c0) = x;
    }
}

__device__ __forceinline__ float dpp_sum16(float v) {
    v += __int_as_float(__builtin_amdgcn_update_dpp(0, __float_as_int(v), 0xB1, 0xF, 0xF, true));
    v += __int_as_float(__builtin_amdgcn_update_dpp(0, __float_as_int(v), 0x4E, 0xF, 0xF, true));
    v += __int_as_float(__builtin_amdgcn_update_dpp(0, __float_as_int(v), 0x141, 0xF, 0xF, true));
    v += __int_as_float(__builtin_amdgcn_update_dpp(0, __float_as_int(v), 0x140, 0xF, 0xF, true));
    return v;
}
__device__ __forceinline__ float wave_sum2(float v) { v = dpp_sum16(v); v = xadd<16>(v); v = xadd<32>(v); return v; }
__device__ __forceinline__ float row_rinv2(const f32x4 (&v)[4]) {
    float s = 0.f;
#pragma unroll
    for (int j = 0; j < 4; ++j) s += (v[j][0] * v[j][0] + v[j][1] * v[j][1]) + (v[j][2] * v[j][2] + v[j][3] * v[j][3]);
    return __builtin_amdgcn_rsqf(wave_sum2(s) * (1.f / DM) + EPS);
}
__device__ __forceinline__ void ld_raw_bf16(const bf16* row, int lane, u32x2 (&v)[4]) {
#pragma unroll
    for (int j = 0; j < 4; ++j) v[j] = *(const u32x2*)(row + 4 * lane + 256 * j);
}
__device__ __forceinline__ f32x4 raw2f(u32x2 w) { return (f32x4){bflo(w.x), bfhi(w.x), bflo(w.y), bfhi(w.y)}; }
__device__ __forceinline__ void ld_vec(const float* p, int lane, f32x4 (&v)[4]) {
#pragma unroll
    for (int j = 0; j < 4; ++j) v[j] = *(const f32x4*)(p + 4 * lane + 256 * j);
}

__device__ __forceinline__ void p1_rows(Frame& F, int l) {
    refresh(F);
    const float* MOD = (const float*)(F.ws + WS_MOD);
    bf16* X = (bf16*)(F.ws + WS_X); bf16* H = (bf16*)(F.ws + WS_H); const bf16* F2 = (const bf16*)(F.ws + WS_F2);
    const int rpw = (M + F.NGW - 1) / F.NGW, r0 = F.gw * rpw, r1 = (r0 + rpw < M) ? r0 + rpw : M;
    if (r0 >= r1) return;
    const bool two = l > 0 && ((l - 1) & 1);
    f32x4 gpre[4], gpost[4], sh[4], sc[4], gt[4];
    ld_vec(INP(6) + l * DM, F.lane, gpre);
    if (l > 0) ld_vec(INP(9) + (l - 1) * DM, F.lane, gpost);
    int cur = -1;
    f32x4 xn[4]; u32x2 xr[4], fn[4], gn[4];
#define P1_ISSUE(r) do { const int b_ = (r) / TPB, p_ = (r) % TPB; \
        if (l == 0) ld_row_f32(p_ < CTX ? INP(2) + ((size_t)b_ * CTX + p_) * DM : INP(0) + ((size_t)b_ * SEQ + (p_ - CTX)) * DM, F.lane, xn); \
        else ld_raw_bf16(X + (size_t)(r) * DM, F.lane, xr); \
        if (l > 0) { ld_raw_bf16(F2 + (size_t)(r) * DM, F.lane, fn); if (two) ld_raw_bf16(F2 + ((size_t)M + (r)) * DM, F.lane, gn); } } while (0)
    P1_ISSUE(r0);
    for (int r = r0; r < r1; ++r) {
        f32x4 x[4]; u32x2 fr[4], gr[4];
#pragma unroll
        for (int j = 0; j < 4; ++j) { x[j] = (l == 0) ? xn[j] : raw2f(xr[j]); fr[j] = fn[j]; gr[j] = gn[j]; }
        if (r + 1 < r1) P1_ISSUE(r + 1);
        const int b = r / TPB, p = r % TPB, mrow = p < CTX ? 16 : b;
        if (mrow != cur) { cur = mrow; const float* modp = MOD + ((size_t)l * 17 + mrow) * 6144; ld_vec(modp, F.lane, sh); ld_vec(modp + 1024, F.lane, sc);
            if (l > 0) ld_vec(MOD + ((size_t)(l - 1) * 17 + mrow) * 6144 + 5 * 1024, F.lane, gt); }
        if (l > 0) {
            f32x4 f[4];
#pragma unroll
            for (int j = 0; j < 4; ++j) { f[j] = raw2f(fr[j]); if (two) f[j] = f[j] + raw2f(gr[j]); }
            const float rinv = row_rinv2(f);
#pragma unroll
            for (int j = 0; j < 4; ++j) x[j] = x[j] + gt[j] * (f[j] * rinv * gpost[j]);
        }
        st_row_bf16(X + (size_t)r * DM, F.lane, x);
        const float rinv = row_rinv2(x);
        f32x4 h[4];
#pragma unroll
        for (int j = 0; j < 4; ++j) h[j] = (x[j] * rinv * gpre[j]) * (sc[j] + 1.0f) + sh[j];
        st_row_bf16(H + (size_t)r * DM, F.lane, h);
    }
#undef P1_ISSUE
}
__device__ __forceinline__ void pf_final(Frame& F) {
    refresh(F);
    const float* MOD = (const float*)(F.ws + WS_MOD);
    const bf16* X = (const bf16*)(F.ws + WS_X); const bf16* F2 = (const bf16*)(F.ws + WS_F2);
    const int l = DEPTH - 1, NR = NBATCH * SEQ;
    const int rpw = (NR + F.NGW - 1) / F.NGW, i0 = F.gw * rpw, i1 = (i0 + rpw < NR) ? i0 + rpw : NR;
    if (i0 >= i1) return;
    f32x4 gpost[4], gt[4]; ld_vec(INP(9) + l * DM, F.lane, gpost);
    int cur = -1;
    u32x2 xn[4], fn[4], gn[4];
#define PF_ISSUE(i) do { const size_t r_ = (size_t)((i) / SEQ) * TPB + CTX + (i) % SEQ; ld_raw_bf16(X + r_ * DM, F.lane, xn); ld_raw_bf16(F2 + r_ * DM, F.lane, fn); ld_raw_bf16(F2 + ((size_t)M + r_) * DM, F.lane, gn); } while (0)
    PF_ISSUE(i0);
    for (int i = i0; i < i1; ++i) {
        f32x4 x[4], f[4];
#pragma unroll
        for (int j = 0; j < 4; ++j) { x[j] = raw2f(xn[j]); f[j] = raw2f(fn[j]) + raw2f(gn[j]); }
        if (i + 1 < i1) PF_ISSUE(i + 1);
        const int b = i / SEQ;
        if (b != cur) { cur = b; ld_vec(MOD + ((size_t)l * 17 + b) * 6144 + 5 * 1024, F.lane, gt); }
        const float rinv = row_rinv2(f);
#pragma unroll
        for (int j = 0; j < 4; ++j) x[j] = x[j] + gt[j] * (f[j] * rinv * gpost[j]);
        st_row_f32(F.A->out + (size_t)i * DM, F.lane, x);
    }
#undef PF_ISSUE
}
__device__ __forceinline__ void p7_rows(Frame& F, int l) {
    refresh(F);
    const float* MOD = (const float*)(F.ws + WS_MOD);
    bf16* X = (bf16*)(F.ws + WS_X); const bf16* Y = (const bf16*)(F.ws + WS_Y); bf16* H2 = (bf16*)(F.ws + WS_H2);
    const bool moe = l & 1; const int li = l >> 1;
    int* TOPE = (int*)(F.ws + WS_TOPE); int* LIDX = (int*)(F.ws + WS_LIDX); float* TOPW = (float*)(F.ws + WS_TOPW); int* BLKB = (int*)(F.ws + WS_BLKB);
    volatile LAS unsigned* LCNT = F.MISC + 16;
    LAS float* RT = (LAS float*)F.lds;
    if (moe) {
        const float* router = INP(20) + (size_t)li * DM * NE;
        if (F.tid < 8) LCNT[F.tid] = 0u;
        for (int i = F.tid; i < DM * NE / 4; i += 512) *(LAS f32x4*)(RT + 4 * i) = *(const f32x4*)(router + 4 * i);
        __syncthreads();
    }
    const bool lastl = (l == DEPTH - 1); const int NR = lastl ? NBATCH * SEQ : M;
#define P7_ROW(i) (lastl ? ((i) / SEQ) * TPB + CTX + (i) % SEQ : (i))
    const int rpw = (NR + F.NGW - 1) / F.NGW, r0 = F.gw * rpw, r1 = (r0 + rpw < NR) ? r0 + rpw : NR;
    if (r0 < r1) {
        f32x4 gpost[4], gpre[4], gt[4], sh[4], sc[4];
        ld_vec(INP(7) + l * DM, F.lane, gpost); ld_vec(INP(8) + l * DM, F.lane, gpre);
        int cur = -1;
        u32x2 xn[4], yn[4];
        ld_raw_bf16(X + (size_t)P7_ROW(r0) * DM, F.lane, xn); ld_raw_bf16(Y + (size_t)P7_ROW(r0) * DM, F.lane, yn);
        for (int ri = r0; ri < r1; ++ri) {
            const int r = P7_ROW(ri);
            f32x4 x[4], y[4];
#pragma unroll
            for (int j = 0; j < 4; ++j) { x[j] = raw2f(xn[j]); y[j] = raw2f(yn[j]); }
            if (ri + 1 < r1) { const int rn = P7_ROW(ri + 1); ld_raw_bf16(X + (size_t)rn * DM, F.lane, xn); ld_raw_bf16(Y + (size_t)rn * DM, F.lane, yn); }
            const int b = r / TPB, p = r % TPB, mrow = p < CTX ? 16 : b;
            if (mrow != cur) { cur = mrow; const float* modp = MOD + ((size_t)l * 17 + mrow) * 6144; ld_vec(modp + 2 * 1024, F.lane, gt); ld_vec(modp + 3 * 1024, F.lane, sh); ld_vec(modp + 4 * 1024, F.lane, sc); }
            const float ry = row_rinv2(y);
#pragma unroll
            for (int j = 0; j < 4; ++j) x[j] = x[j] + gt[j] * (y[j] * ry * gpost[j]);
            st_row_bf16(X + (size_t)r * DM, F.lane, x);
            const float rx = row_rinv2(x);
            f32x4 h[4];
#pragma unroll
            for (int j = 0; j < 4; ++j) h[j] = (x[j] * rx * gpre[j]) * (sc[j] + 1.0f) + sh[j];
            if constexpr (FFN_F8) {
#pragma unroll
                for (int j = 0; j < 4; ++j) *(unsigned*)((unsigned char*)H2 + (size_t)r * DM + 4 * F.lane + 256 * j) = pk4_f8(h[j][0], h[j][1], h[j][2], h[j][3]);
            } else st_row_bf16(H2 + (size_t)r * DM, F.lane, h);
            if (moe) {
                float lg[8];
#pragma unroll
                for (int e = 0; e < 8; ++e) lg[e] = 0.f;
#pragma unroll
                for (int j = 0; j < 4; ++j)
#pragma unroll
                    for (int i = 0; i < 4; ++i) { const int cidx = 4 * F.lane + 256 * j + i; const f32x4 q0 = *(const LAS f32x4*)(RT + cidx * 8), q1 = *(const LAS f32x4*)(RT + cidx * 8 + 4); const float hv = h[j][i];
                        lg[0] += hv * q0[0]; lg[1] += hv * q0[1]; lg[2] += hv * q0[2]; lg[3] += hv * q0[3]; lg[4] += hv * q1[0]; lg[5] += hv * q1[1]; lg[6] += hv * q1[2]; lg[7] += hv * q1[3]; }
#pragma unroll
                for (int e = 0; e < 8; ++e) lg[e] = wave_sum2(lg[e]);
                int e0 = 0; float v0 = lg[0];
#pragma unroll
                for (int e = 1; e < 8; ++e) if (lg[e] > v0) { v0 = lg[e]; e0 = e; }
                int e1 = -1; float v1 = -3.0e38f;
#pragma unroll
                for (int e = 0; e < 8; ++e) if (e != e0 && lg[e] > v1) { v1 = lg[e]; e1 = e; }
                const float ex = __expf(v1 - v0), w0 = 1.f / (1.f + ex), w1 = ex / (1.f + ex);
                if (F.lane == 0) {
                    const unsigned i0 = __hip_atomic_fetch_add((LAS unsigned*)&LCNT[e0], 1u, __ATOMIC_RELAXED, __HIP_MEMORY_SCOPE_WORKGROUP), i1 = __hip_atomic_fetch_add((LAS unsigned*)&LCNT[e1], 1u, __ATOMIC_RELAXED, __HIP_MEMORY_SCOPE_WORKGROUP);
                    TOPE[r] = e0 | (e1 << 8); LIDX[2 * r] = (int)i0; LIDX[2 * r + 1] = (int)i1; TOPW[2 * r] = w0; TOPW[2 * r + 1] = w1;
                }
            }
        }
    }
    if (moe) {
        __syncthreads();
        if (F.tid < 8) { const unsigned base = __hip_atomic_fetch_add((unsigned*)((gu32*)F.ws + CW_CNT + 64 * li + F.tid), LCNT[F.tid], __ATOMIC_RELAXED, __HIP_MEMORY_SCOPE_AGENT); BLKB[F.blk * 8 + F.tid] = (int)base; }
    }
#undef P7_ROW
}
__device__ __forceinline__ void moe_offsets(Frame& F, int li, int (&cnt)[8], int (&off)[9]) {
    off[0] = 0;
#pragma unroll
    for (int e = 0; e < 8; ++e) { cnt[e] = (int)__hip_atomic_load((unsigned*)(((gu32*)F.ws) + CW_CNT + 64 * li + e), __ATOMIC_RELAXED, __HIP_MEMORY_SCOPE_AGENT); off[e + 1] = off[e] + ((cnt[e] + 255) & ~255); }
}
__device__ __forceinline__ void p7b_gather(Frame& F, int l) {
    refresh(F);
    const int li = l >> 1; int cnt[8], off[9]; moe_offsets(F, li, cnt, off);
    const bf16* H2 = (const bf16*)(F.ws + WS_H2); bf16* HG = (bf16*)(F.ws + WS_HG);
    const int* TOPE = (const int*)(F.ws + WS_TOPE); const int* LIDX = (const int*)(F.ws + WS_LIDX); const float* TOPW = (const float*)(F.ws + WS_TOPW); const int* BLKB = (const int*)(F.ws + WS_BLKB);
    int* RMAP = (int*)(F.ws + WS_RMAP); float* ROWW = (float*)(F.ws + WS_ROWW);
    constexpr int RB = FFN_F8 ? DM : 2 * DM, LB = RB / 64;
    const unsigned char* H2b = (const unsigned char*)H2; unsigned char* HGb = (unsigned char*)HG;
    const bool lastl = (l == DEPTH - 1); const int NR = lastl ? NBATCH * SEQ : M;
    const int rpw = (NR + F.NGW - 1) / F.NGW, r0 = F.gw * rpw, r1 = (r0 + rpw < NR) ? r0 + rpw : NR;
    for (int ri = r0; ri < r1; ++ri) {
        const int r = lastl ? (ri / SEQ) * TPB + CTX + ri % SEQ : ri;
        const int te = TOPE[r];
        v4u a, bq = {0u, 0u, 0u, 0u}; a = *(const v4u*)(H2b + (size_t)r * RB + F.lane * LB); if constexpr (!FFN_F8) bq = *(const v4u*)(H2b + (size_t)r * RB + F.lane * LB + 16);
#pragma unroll
        for (int s = 0; s < 2; ++s) {
            const int e = (te >> (8 * s)) & 0xff;
            int o = 0;
#pragma unroll
            for (int q = 0; q < 8; ++q) o = (q == e) ? off[q] : o;
            const int pos = o + BLKB[F.blk * 8 + e] + LIDX[2 * r + s];
            *(v4u*)(HGb + (size_t)pos * RB + F.lane * LB) = a; if constexpr (!FFN_F8) *(v4u*)(HGb + (size_t)pos * RB + F.lane * LB + 16) = bq;
            if (F.lane == 0) { RMAP[pos] = r | (s << 30); ROWW[pos] = TOPW[2 * r + s]; }
        }
    }
#pragma unroll
    for (int e = 0; e < 8; ++e) {
        const int npad = off[e + 1] - off[e] - cnt[e];
        for (int i = F.gw; i < npad; i += F.NGW) { const int pos = off[e] + cnt[e] + i; const unsigned zz = (unsigned)F.z; const v4u z = {zz, zz, zz, zz};
            *(v4u*)(HGb + (size_t)pos * RB + F.lane * LB) = z; if constexpr (!FFN_F8) *(v4u*)(HGb + (size_t)pos * RB + F.lane * LB + 16) = z;
            if (F.lane == 0) { RMAP[pos] = -1; ROWW[pos] = 0.f; } }
    }
}

__global__ void __launch_bounds__(NWAVES * 64, 2) mk_fwd(Args args) {
    extern __shared__ __attribute__((aligned(16))) unsigned char lds[];
    Frame F;
    F.lds = (LAS unsigned char*)lds;
    F.MISC = (volatile LAS unsigned*)(F.lds + MISC_OFF);
    F.tid = threadIdx.x; F.lane = F.tid & 63; F.wave = __builtin_amdgcn_readfirstlane(F.tid >> 6); F.wv = F.wave;
    F.G = gridDim.x; F.blk = blockIdx.x; F.gw = F.blk * NWAVES + F.wave; F.NGW = F.G * NWAVES;
    F.ws = args.ws;
    F.A = &args;
    for (int u = F.tid; u < 128; u += NWAVES * 64) F.MISC[u] = 0u;
    __syncthreads();
    { XcdBarrier b0 = xcd_barrier_post((unsigned*)F.ws + CW_BAR, F.MISC + 8); (void)b0; }
#define GRID_BAR() do { XcdBarrier b_; b_.bar = (unsigned*)F.ws + CW_BAR; b_.x = xb_xcc_id(); b_.st = F.MISC + 8; refresh(F); xcd_barrier(b_, F.tid == 0); } while (0)

    p0_mod(F); p0_misc(F); convert_weights(F, 0);
    GRID_BAR();
    for (int l = 0; l < DEPTH; ++l) {
        const bool moe = l & 1; const int li = l >> 1;
        { unsigned char* wsp = args.ws; asm volatile("" : "+s"(wsp)); F.ws = wsp; }
        p1_rows(F, l);
        if (l > 0) convert_weights(F, l);
        GRID_BAR();
        {
            refresh(F);
            pg8::Gemm g{(const pg8::bf16_t*)(F.ws + WS_H), (const pg8::bf16_t*)(F.ws + WS_WIN), M, NP, DM};
            pg8::StaticOrder S; S.init(M, NP, F.G, F.blk);
            pg8::EpiProj E{(pg8::bf16_t*)(F.ws + WS_PROJ), (const float*)(F.ws + WS_ROPE), (const float*)(F.ws + WS_ROPE) + 1024};
            pg8::gemm_phase<pg8::EpiProj, pg8::StaticOrder, true, true>(F.lds, g, S, E, F.wave);
        }
        GRID_BAR();
        p3_mixer(F, l);
        GRID_BAR();
        p5_merge_all(F, l);
        GRID_BAR();
        {
            refresh(F);
            pg8::Gemm g{(const pg8::bf16_t*)(F.ws + WS_H), (const pg8::bf16_t*)(F.ws + WS_WOUT), M, DM, DM};
            const int lastl = (l == DEPTH - 1);
            pg8::LatOrder S; S.S.init(lastl ? NBATCH * SEQ : M, DM, F.G, F.blk); S.lat = lastl;
            pg8::EpiF32 E{(pg8::bf16_t*)(F.ws + WS_Y)};
            pg8::gemm_phase<pg8::EpiF32, pg8::LatOrder, true, true>(F.lds, g, S, E, F.wave);
        }
        GRID_BAR();
        p7_rows(F, l);
        GRID_BAR();
        if (moe) { p7b_gather(F, l); GRID_BAR(); }
        int ntiles = M / 256;
        {
            refresh(F);
            LAS int* texp = (LAS int*)(F.lds + TEXP_OFF);
            if (moe) { int cnt[8], off[9]; moe_offsets(F, li, cnt, off); ntiles = off[8] >> 8;
                for (int t = F.tid; t < ntiles; t += 512) { int e = 0;
#pragma unroll
                    for (int q = 1; q < 8; ++q) e += ((t << 8) >= off[q]) ? 1 : 0;
                    texp[t] = e; } }
            else { for (int t = F.tid; t < ntiles; t += 512) texp[t] = 0; }
            __syncthreads();
        }
        {
            refresh(F);
            pg8::Gemm g{(const pg8::bf16_t*)(F.ws + (moe ? WS_HG : WS_H2)), (const pg8::bf16_t*)(F.ws + WS_WUP), ntiles * 256, 2 * DFF, FFN_F8 ? DM / 2 : DM};
            pg8::GroupedOrder S; S.S.init(ntiles * 256, 2 * DFF, F.G, F.blk); S.texp = (const LAS int*)(F.lds + TEXP_OFF); S.nN = 22;
            pg8::EpiSwiglu E{(pg8::bf16_t*)(F.ws + WS_U)};
            pg8::gemm_phase<pg8::EpiSwiglu, pg8::GroupedOrder, true, true, FFN_F8 != 0>(F.lds, g, S, E, F.wave);
        }
        GRID_BAR();
        {
            refresh(F);
            pg8::Gemm g{(const pg8::bf16_t*)(F.ws + WS_U), (const pg8::bf16_t*)(F.ws + WS_WDN), ntiles * 256, DM, FFN_F8 ? DFF / 2 : DFF};
            pg8::GroupedOrder S; S.S.init(ntiles * 256, DM, F.G, F.blk); S.texp = (const LAS int*)(F.lds + TEXP_OFF); S.nN = 4;
            pg8::EpiDown E{(pg8::bf16_t*)(F.ws + WS_F2), (const int*)(F.ws + WS_RMAP), (const float*)(F.ws + WS_ROWW), moe ? 0 : 1};
            pg8::gemm_phase<pg8::EpiDown, pg8::GroupedOrder, true, true, FFN_F8 != 0>(F.lds, g, S, E, F.wave);
        }
        GRID_BAR();
    }
    pf_final(F);
}

extern "C" void kernel_launch(void* const* d_in, const int* in_sizes, int n_in, void* d_out, int out_size, void* d_ws, size_t ws_size, hipStream_t stream) {
    static int grid = 0;
    if (grid == 0) {
        if (n_in != 24 || out_size != NBATCH * SEQ * DM || ws_size < WS_END) { fprintf(stderr, "kernel_launch: unexpected shapes or workspace (%d inputs, out %d, ws %zu < %zu)\n", n_in, out_size, ws_size, (size_t)WS_END); grid = -1; return; }
        int dev = 0, cus = 0, per_cu = 0;
        if (hipGetDevice(&dev) != hipSuccess || hipDeviceGetAttribute(&cus, hipDeviceAttributeMultiprocessorCount, dev) != hipSuccess) { grid = -1; return; }
        if (hipFuncSetAttribute((const void*)mk_fwd, hipFuncAttributeMaxDynamicSharedMemorySize, LDS_BYTES) != hipSuccess) { grid = -1; return; }
        if (hipOccupancyMaxActiveBlocksPerMultiprocessor(&per_cu, (const void*)mk_fwd, NWAVES * 64, LDS_BYTES) != hipSuccess || per_cu < 1) { fprintf(stderr, "kernel_launch: occupancy query says %d\n", per_cu); }
        (void)hipGetLastError();
        grid = cus;
    }
    if (grid < 0) return;
    if (hipMemsetAsync((char*)d_ws + WS_CTL, 0, CTL_ZERO_BYTES, stream) != hipSuccess) return;
    Args a{};
    for (int i = 0; i < 24; ++i) a.in[i] = (const float*)d_in[i];
    a.out = (float*)d_out; a.ws = (unsigned char*)d_ws;
    hipLaunchKernelGGL(mk_fwd, dim3(grid), dim3(NWAVES * 64), LDS_BYTES, stream, a);
}
```

```cpp
#include <hip/hip_runtime.h>
#include <cstdio>
#include <cstdint>
namespace pg8 {
#define PG8_LAS __attribute__((address_space(3)))
typedef unsigned short bf16_t;
__device__ __forceinline__ int lane_id_opaque() { int l; asm volatile("v_mbcnt_lo_u32_b32 %0, -1, 0\n\tv_mbcnt_hi_u32_b32 %0, -1, %0" : "=v"(l)); return l; }
typedef short bf16x8 __attribute__((ext_vector_type(8)));
typedef float f32x4 __attribute__((ext_vector_type(4)));
typedef unsigned u32x4 __attribute__((ext_vector_type(4)));
constexpr int BM = 256, BK = 64, HALF = 128, HTB = HALF * BK * 2  , STAGE_BYTES = 8 * HTB, NXCD = 8, WGM = 8;

__host__ __device__ __forceinline__ int lds_byte(int r, int c) { const int st = (r >> 4) * 2 + (c >> 5), rr = r & 15, cc = c & 31, ob = rr * 64 + cc * 2; return st * 1024 + (ob ^ (((ob >> 9) & 1) << 5)); }
__host__ __device__ __forceinline__ void stage_rc(int b, int& R, int& C) { const int st = b / 1024, sb = b % 1024, swz = sb ^ (((sb >> 9) & 1) << 5); R = (st >> 1) * 16 + swz / 64; C = (st & 1) * 32 + (swz % 64) / 2; }
__host__ __device__ __forceinline__ int perm32(int rho) { const int n = rho >> 4, i = rho & 15; return 8 * (i >> 2) + 4 * n + (i & 3); }

struct Unit { int pm, pn; };
struct Gemm { const bf16_t* A; const bf16_t* Bt; int M, N, K; };

struct StaticOrder {
    int nM, nN, nwg, G, c;
    __host__ __device__ void init(int M, int N, int G_, int c_) { nM = M / BM; nN = N / BM; nwg = nM * nN; G = G_; c = c_; }
    __host__ __device__ bool next(int i, Unit& u) const {
        const long L = (long)i * G + c; if (L >= nwg) return false;
        int wgid = (int)L; { const int q = nwg / NXCD, r = nwg % NXCD, xcd = wgid % NXCD, off = wgid / NXCD; wgid = (xcd < r ? xcd * (q + 1) : r * (q + 1) + (xcd - r) * q) + off; }
        const int nig = WGM * nN, gid = wgid / nig, fm = gid * WGM, gsz = (nM - fm) < WGM ? (nM - fm) : WGM;
        u.pm = fm + ((wgid % nig) % gsz); u.pn = (wgid % nig) / gsz; return true;
    }
    __device__ __forceinline__ void a_ready(const Unit&) const {}
    __device__ __forceinline__ void done(const Unit&) const {}
};

__device__ __forceinline__ unsigned cvt_pk_bf16(float lo, float hi) { unsigned r; asm volatile("v_cvt_pk_bf16_f32 %0, %1, %2" : "=v"(r) : "v"(lo), "v"(hi)); return r; }
typedef float f32x2 __attribute__((ext_vector_type(2)));
template <class Epi, class Sched, bool ALIGN_EPI = false, bool SP2 = false, bool F8 = false>
__device__ __forceinline__ void gemm_phase(PG8_LAS unsigned char* lds, const Gemm g, const Sched& S, const Epi& E, const int wv  ) {
    int tid_ = wv * 64 + lane_id_opaque();
    const int tid = tid_, wid = __builtin_amdgcn_readfirstlane(tid >> 6), lane = tid & 63, wr = wid >> 2, wc = wid & 3, fr = lane & 15, fq = lane >> 4;
    const int K = g.K, nt = K / BK;
    unsigned voffA[2], voffB[2];
#pragma unroll
    for (int i = 0; i < 2; ++i) { int R, C; stage_rc(tid * 16 + i * 8192, R, C); const int Rb = Epi::PERM ? ((R & ~31) + perm32(R & 31)) : R;
        voffA[i] = (unsigned)(R * K + C) * 2u; voffB[i] = (unsigned)(Rb * K + C) * 2u; }
    const size_t kstep = (size_t)(BK * 2);
    const size_t hstep = (size_t)HALF * K * 2;
    const size_t tstep = 2 * hstep;
    const unsigned ldsw = (unsigned)wid * 1024u;
    const int aoff = lds_byte(wr * 64 + fr, fq * 8), boff = lds_byte(wc * 32 + fr, fq * 8);
#define PG8_SA(b, h) (((b) * 2 + (h)) * HTB)
#define PG8_SB(b, h) ((4 + (b) * 2 + (h)) * HTB)
#define PG8_STAGE(bufoff, gbase, voff) do { _Pragma("unroll") for (int _i = 0; _i < 2; ++_i) \
        __builtin_amdgcn_global_load_lds((const __attribute__((address_space(1))) unsigned*)((const __attribute__((address_space(1))) char*)(gbase) + (voff)[_i]), (PG8_LAS unsigned*)(lds + (bufoff) + ldsw + _i * 8192), 16, 0, 0); } while (0)
#define PG8_LDA(dst, b, h) do { _Pragma("unroll") for (int m = 0; m < 4; ++m) _Pragma("unroll") for (int k = 0; k < 2; ++k) dst[m][k] = *(const PG8_LAS bf16x8*)(lds + PG8_SA(b, h) + aoff + m * 2048 + k * 1024); } while (0)
#define PG8_LDB(dst, b, h) do { _Pragma("unroll") for (int n = 0; n < 2; ++n) _Pragma("unroll") for (int k = 0; k < 2; ++k) dst[n][k] = *(const PG8_LAS bf16x8*)(lds + PG8_SB(b, h) + boff + n * 2048 + k * 1024); } while (0)
#define PG8_MMA(ai, bj, At, Bt) do { if constexpr (F8) __builtin_amdgcn_sched_barrier(0); __builtin_amdgcn_s_setprio(1); _Pragma("unroll") for (int m = 0; m < 4; ++m) _Pragma("unroll") for (int n = 0; n < 2; ++n) { \
        if constexpr (F8) { typedef int i32x4_ __attribute__((ext_vector_type(4))); \
            acc[ai][bj][m][n] = __builtin_amdgcn_mfma_scale_f32_16x16x128_f8f6f4(__builtin_shufflevector(__builtin_bit_cast(i32x4_, Bt[n][0]), __builtin_bit_cast(i32x4_, Bt[n][1]), 0, 1, 2, 3, 4, 5, 6, 7), \
                __builtin_shufflevector(__builtin_bit_cast(i32x4_, At[m][0]), __builtin_bit_cast(i32x4_, At[m][1]), 0, 1, 2, 3, 4, 5, 6, 7), acc[ai][bj][m][n], 0, 0, 0, 0x7f7f7f7f, 0, 0x7f7f7f7f); } \
        else { _Pragma("unroll") for (int k = 0; k < 2; ++k) acc[ai][bj][m][n] = __builtin_amdgcn_mfma_f32_16x16x32_bf16(Bt[n][k], At[m][k], acc[ai][bj][m][n], 0, 0, 0); } } \
        __builtin_amdgcn_s_setprio(0); if constexpr (F8) __builtin_amdgcn_sched_barrier(0); } while (0)
#define PG8_WAIT_V(n) asm volatile("s_waitcnt vmcnt(" #n ")" ::: "memory")
#define PG8_WAIT_L(n) asm volatile("s_waitcnt lgkmcnt(" #n ")" ::: "memory")
#define PG8_BAR __builtin_amdgcn_s_barrier()
#define PG8_SCHED __builtin_amdgcn_sched_barrier(0)
    Unit cur, nxt; int ui = 0;
    if (!S.next(0, cur)) return;
    f32x4 acc[2][2][4][2];
#pragma unroll
    for (int a = 0; a < 2; ++a)
#pragma unroll
        for (int b = 0; b < 2; ++b)
#pragma unroll
            for (int m = 0; m < 4; ++m)
#pragma unroll
                for (int n = 0; n < 2; ++n) acc[a][b][m][n] = (f32x4){0.f, 0.f, 0.f, 0.f};
    bf16x8 At[4][2], B0[2][2], B1[2][2];
    const char* cA = (const char*)g.A + (size_t)cur.pm * tstep; const char* cB = (const char*)g.Bt + (size_t)cur.pn * tstep;
    S.a_ready(cur);
    if constexpr (SP2) {
        PG8_STAGE(PG8_SB(0, 0), cB, voffB); PG8_STAGE(PG8_SB(0, 1), cB + hstep, voffB); PG8_STAGE(PG8_SA(0, 0), cA, voffA); PG8_STAGE(PG8_SA(0, 1), cA + hstep, voffA);
        if (wr == 1) PG8_BAR;
        PG8_WAIT_V(2); PG8_BAR;
        PG8_STAGE(PG8_SB(1, 0), cB + kstep, voffB); PG8_STAGE(PG8_SA(1, 0), cA + kstep, voffA); PG8_STAGE(PG8_SB(1, 1), cB + hstep + kstep, voffB);
        PG8_WAIT_V(6); PG8_BAR;
    } else {
        PG8_STAGE(PG8_SB(0, 0), cB, voffB); PG8_STAGE(PG8_SA(0, 0), cA, voffA); PG8_STAGE(PG8_SB(0, 1), cB + hstep, voffB); PG8_STAGE(PG8_SA(0, 1), cA + hstep, voffA);
        if (wr == 1) PG8_BAR;
        PG8_WAIT_V(4); PG8_BAR;
        PG8_STAGE(PG8_SB(1, 0), cB + kstep, voffB); PG8_STAGE(PG8_SA(1, 0), cA + kstep, voffA); PG8_STAGE(PG8_SB(1, 1), cB + hstep + kstep, voffB);
        PG8_WAIT_V(6); PG8_BAR;
    }
    for (;;) {
        const bool has_next = S.next(ui + 1, nxt);
        const char* nA = has_next ? (const char*)g.A + (size_t)nxt.pm * tstep : cA; const char* nB = has_next ? (const char*)g.Bt + (size_t)nxt.pn * tstep : cB;
        for (int t = 0; t < nt; t += 2) {
            const bool last = (t == nt - 2);
            const char* a1 = cA + (size_t)(t + 1) * kstep;
            const char* a2 = last ? nA : cA + (size_t)(t + 2) * kstep; const char* b2 = last ? nB : cB + (size_t)(t + 2) * kstep;
            const char* a3 = a2 + kstep; const char* b3 = b2 + kstep;
            if (last && has_next) S.a_ready(nxt);
            if constexpr (SP2) {
            PG8_LDB(B0, 0, 0); PG8_LDB(B1, 0, 1); PG8_SCHED; PG8_LDA(At, 0, 0); PG8_STAGE(PG8_SA(1, 1), a1 + hstep, voffA);
            PG8_WAIT_V(8); PG8_WAIT_L(0); PG8_BAR; PG8_MMA(0, 0, At, B0); PG8_MMA(0, 1, At, B1); PG8_BAR; PG8_SCHED;
            PG8_LDA(At, 0, 1); PG8_STAGE(PG8_SB(0, 0), b2, voffB); PG8_STAGE(PG8_SB(0, 1), b2 + hstep, voffB); PG8_STAGE(PG8_SA(0, 0), a2, voffA);
            PG8_WAIT_V(8); PG8_WAIT_L(0); PG8_BAR; PG8_MMA(1, 0, At, B0); PG8_MMA(1, 1, At, B1); PG8_BAR; PG8_SCHED;
            PG8_LDB(B0, 1, 0); PG8_LDB(B1, 1, 1); PG8_SCHED; PG8_LDA(At, 1, 0); PG8_STAGE(PG8_SA(0, 1), a2 + hstep, voffA);
            PG8_WAIT_V(8); PG8_WAIT_L(0); PG8_BAR; PG8_MMA(0, 0, At, B0); PG8_MMA(0, 1, At, B1); PG8_BAR; PG8_SCHED;
            PG8_LDA(At, 1, 1); PG8_STAGE(PG8_SB(1, 0), b3, voffB); PG8_STAGE(PG8_SB(1, 1), b3 + hstep, voffB); PG8_STAGE(PG8_SA(1, 0), a3, voffA);
            PG8_WAIT_V(8); PG8_WAIT_L(0); PG8_BAR; PG8_MMA(1, 0, At, B0); PG8_MMA(1, 1, At, B1); PG8_BAR; PG8_SCHED;
            } else {
            PG8_LDB(B0, 0, 0); PG8_SCHED; PG8_LDA(At, 0, 0); PG8_STAGE(PG8_SA(1, 1), a1 + hstep, voffA);
            PG8_WAIT_L(8); PG8_BAR; PG8_WAIT_L(0); PG8_MMA(0, 0, At, B0); PG8_BAR; PG8_SCHED;
            PG8_LDB(B1, 0, 1); PG8_STAGE(PG8_SB(0, 0), b2, voffB);
            PG8_BAR; PG8_WAIT_L(0); PG8_MMA(0, 1, At, B1); PG8_BAR;
            PG8_LDA(At, 0, 1); PG8_STAGE(PG8_SA(0, 0), a2, voffA);
            PG8_BAR; PG8_WAIT_L(0); PG8_MMA(1, 0, At, B0); PG8_BAR; PG8_SCHED;
            PG8_STAGE(PG8_SB(0, 1), b2 + hstep, voffB);
            PG8_WAIT_V(6); PG8_BAR; PG8_MMA(1, 1, At, B1); PG8_BAR;
            PG8_LDB(B0, 1, 0); PG8_SCHED; PG8_LDA(At, 1, 0); PG8_STAGE(PG8_SA(0, 1), a2 + hstep, voffA);
            PG8_WAIT_L(8); PG8_BAR; PG8_WAIT_L(0); PG8_MMA(0, 0, At, B0); PG8_BAR; PG8_SCHED;
            PG8_LDB(B1, 1, 1); PG8_STAGE(PG8_SB(1, 0), b3, voffB);
            PG8_BAR; PG8_WAIT_L(0); PG8_MMA(0, 1, At, B1); PG8_BAR;
            PG8_LDA(At, 1, 1); PG8_STAGE(PG8_SA(1, 0), a3, voffA);
            PG8_BAR; PG8_WAIT_L(0); PG8_MMA(1, 0, At, B0); PG8_BAR; PG8_SCHED;
            PG8_STAGE(PG8_SB(1, 1), b3 + hstep, voffB);
            PG8_WAIT_V(6); PG8_BAR; PG8_MMA(1, 1, At, B1); PG8_BAR;
            }
        }
        if constexpr (ALIGN_EPI) { if (wr == 0) PG8_BAR; }
        if constexpr (!Epi::AFTER_DRAIN) { const int t2_ = lane_id_opaque(); const int fr_ = t2_ & 15, fq_ = (t2_ & 63) >> 4;
            E(acc, cur, wr, wc, fr_, fq_); S.done(cur); }
        if (!has_next) break;
#pragma unroll
        for (int a = 0; a < 2; ++a)
#pragma unroll
            for (int b = 0; b < 2; ++b)
#pragma unroll
                for (int m = 0; m < 4; ++m)
#pragma unroll
                    for (int n = 0; n < 2; ++n) acc[a][b][m][n] = (f32x4){0.f, 0.f, 0.f, 0.f};
        cur = nxt; cA = nA; cB = nB; ++ui;
        if constexpr (ALIGN_EPI) { if (wr == 1) PG8_BAR; }
    }
    PG8_WAIT_V(0);
    if constexpr (!ALIGN_EPI) { if (wr == 0) PG8_BAR; }
    PG8_BAR;
    if constexpr (Epi::AFTER_DRAIN) { E.fused(acc, cur, wr, wc, fr, fq, lds, wid, lane); S.done(cur); }
#undef PG8_SA
#undef PG8_SB
#undef PG8_STAGE
#undef PG8_LDA
#undef PG8_LDB
#undef PG8_MMA
#undef PG8_WAIT_V
#undef PG8_WAIT_L
#undef PG8_BAR
#undef PG8_SCHED
}
}
#define GAS __attribute__((address_space(1)))
#define LAS __attribute__((address_space(3)))
typedef unsigned short bf16;
typedef unsigned v4u __attribute__((ext_vector_type(4)));
typedef float f32x4 __attribute__((ext_vector_type(4)));
typedef short bf16x8 __attribute__((ext_vector_type(8)));
typedef GAS unsigned gu32;
typedef GAS unsigned long long gu64;
#define RLX_AGENT __ATOMIC_RELAXED, __HIP_MEMORY_SCOPE_AGENT
#define LDS_WAIT() asm volatile("s_waitcnt lgkmcnt(0)" ::: "memory")
#define VM_WAIT() asm volatile("s_waitcnt vmcnt(0)" ::: "memory")
__device__ __forceinline__ unsigned long long rt() { return __builtin_amdgcn_s_memrealtime(); }
__device__ __forceinline__ unsigned f2bf(float f) { unsigned u = __builtin_bit_cast(unsigned, f); return (u + 0x7fffu + ((u >> 16) & 1u)) >> 16; }
__device__ __forceinline__ unsigned pk2(float lo, float hi) { return f2bf(lo) | (f2bf(hi) << 16); }

#define XB_TMO      128
#define XB_XCNT(j)  (256  + 64 * (j))
#define XB_XSUB(j)  (1280 + 64 * (j))
#define XB_XGEN(j)  (2304 + 64 * (j))
#define XB_TOP      3328
#define XB_TOPGEN   3392
#define XCD_BAR_WORDS 3456
#define XB_SPIN_CAP (1u << 18)

__device__ __forceinline__ unsigned xb_ld(unsigned* p)              { return __hip_atomic_load(p, __ATOMIC_RELAXED, __HIP_MEMORY_SCOPE_AGENT); }
__device__ __forceinline__ unsigned xb_add(unsigned* p, unsigned v) { return __hip_atomic_fetch_add(p, v, __ATOMIC_RELAXED, __HIP_MEMORY_SCOPE_AGENT); }
__device__ __forceinline__ unsigned xb_xcc_id() { return (unsigned)__builtin_amdgcn_s_getreg((3 << 11) | 20) & 0xFu; }
#define XB_SPIN(cond, bar) do { unsigned _sp = 0; while (cond) { __builtin_amdgcn_s_sleep(1); \
    if ((++_sp & 255u) == 0u) { if (xb_ld(&(bar)[XB_TMO])) break; if (_sp > XB_SPIN_CAP) { atomicAdd(&(bar)[XB_TMO], 1u); break; } } } } while (0)

struct XcdBarrier {
    unsigned* bar; unsigned x;
    volatile LAS unsigned* st;
};

__device__ __forceinline__ XcdBarrier xcd_barrier_post(unsigned* bar, volatile LAS unsigned* st) {
    XcdBarrier b; b.bar = bar; b.x = xb_xcc_id(); b.st = st;
    if (threadIdx.x == 0) (void)xb_add(&bar[XB_XCNT(b.x)], 1u);
    return b;
}
__device__ __forceinline__ void xcd_barrier_complete(unsigned* bar, unsigned x, unsigned& nloc, unsigned& nx) {
    const unsigned G = gridDim.x * gridDim.y * gridDim.z;
    unsigned sum, cnt, mine, sp = 0u;
    for (;;) {
        sum = 0u; cnt = 0u; mine = 0u;
#pragma unroll
        for (unsigned j = 0; j < 16; ++j) { const unsigned c = xb_ld(&bar[XB_XCNT(j)]); sum += c; cnt += (c > 0u) ? 1u : 0u; mine = (j == x) ? c : mine; }
        if (sum == G) break;
        __builtin_amdgcn_s_sleep(1);
        if ((++sp & 255u) == 0u) { if (xb_ld(&bar[XB_TMO])) break; if (sp > XB_SPIN_CAP) { atomicAdd(&bar[XB_TMO], 1u); break; } }
    }
    nloc = mine > 0u ? mine : 1u; nx = cnt > 0u ? cnt : 1u;
}

__device__ __forceinline__ void xcd_barrier(const XcdBarrier& b, const bool leader  ) {
    asm volatile("s_waitcnt vmcnt(0)" ::: "memory");
    __syncthreads();
    if (leader) {
        unsigned* bar = b.bar; asm volatile("" : "+s"(bar));
        __builtin_amdgcn_s_waitcnt(0);
        unsigned nloc = b.st[0], nx = b.st[1];
        if (nloc == 0u) { xcd_barrier_complete(bar, b.x, nloc, nx); b.st[0] = nloc; b.st[1] = nx; }
        const unsigned old = xb_add(&bar[XB_XSUB(b.x)], 1u);
        const unsigned gen = old / nloc;
        if (old + 1u == (gen + 1u) * nloc) {
            __builtin_amdgcn_fence(__ATOMIC_RELEASE, "agent");
            asm volatile("s_waitcnt vmcnt(0)" ::: "memory");
            const unsigned og = xb_add(&bar[XB_TOP], 1u);
            const unsigned tg = og / nx;
            if (og + 1u == (tg + 1u) * nx) xb_add(&bar[XB_TOPGEN], 1u);
            else XB_SPIN(xb_ld(&bar[XB_TOPGEN]) == tg, bar);
            __builtin_amdgcn_fence(__ATOMIC_ACQUIRE, "agent");
            xb_add(&bar[XB_XGEN(b.x)], 1u);
            asm volatile("s_waitcnt vmcnt(0)" ::: "memory");
        } else {
            XB_SPIN(xb_ld(&bar[XB_XGEN(b.x)]) == gen, bar);
            __builtin_amdgcn_fence(__ATOMIC_ACQUIRE, "agent");
            asm volatile("s_waitcnt vmcnt(0)" ::: "memory");
        }
    }
    __syncthreads();
}

#ifndef FFN_F8
#define FFN_F8 1
#endif
constexpr int NWAVES = 8;
constexpr float W8S = 32.f, U8S = 4.f;
constexpr int DM = 1024, NBATCH = 16, SEQ = 2048, CTX = 256, TPB = SEQ + CTX, M = NBATCH * TPB;
constexpr int DEPTH = 4, NIN = 3104, NP = 3328, DFF = 2816, NE = 8;
constexpr int MP = 2 * M + NE * 256;
constexpr int C_Q = 0, C_K = 512, C_V = 1024, C_GQ = 1536, C_GK = 1792, C_GV = 2048, C_GG = 2560, C_GLR = 3072;
constexpr float EPS = 1e-6f;
constexpr float C2 = 0.125f * 1.4426950408889634f;
constexpr int NCH = TPB / 64;
constexpr int NGLA = NBATCH * 4 * 2 * NCH;

constexpr size_t MiB = 1u << 20;
constexpr size_t WS_CTL = 0, CTL_ZERO_BYTES = 1 * MiB;
constexpr size_t WS_MOD = 1 * MiB;
constexpr size_t WS_ROPE = 3 * MiB;
constexpr size_t WS_TOPE = 4 * MiB;
constexpr size_t WS_LIDX = WS_TOPE + 160 * 1024;
constexpr size_t WS_TOPW = WS_LIDX + 320 * 1024;
constexpr size_t WS_BLKB = WS_TOPW + 320 * 1024;
constexpr size_t WS_RMAP = WS_BLKB + 64 * 1024;
constexpr size_t WS_ROWW = WS_RMAP + 320 * 1024;
static_assert(WS_ROWW + 320 * 1024 <= 6 * MiB, "small tables");
constexpr size_t WS_X = 6 * MiB;
constexpr size_t WS_WIN = 150 * MiB;
constexpr size_t WS_WOUT = WS_WIN + 13 * MiB / 2;
constexpr size_t WS_WUP = WS_WOUT + 2 * MiB;
constexpr size_t WS_WDN = WS_WUP + 88 * MiB;
constexpr size_t WS_D = 291 * MiB;
static_assert(WS_WDN + 44 * MiB <= WS_D, "weights");
constexpr size_t WS_PROJ = WS_D;
constexpr size_t WS_OD = WS_D + 234 * MiB;
constexpr size_t WS_DS = WS_D + 306 * MiB;
constexpr size_t WS_DEC = WS_D + 450 * MiB;
constexpr size_t WS_H = WS_D + 452 * MiB;
constexpr size_t WS_Y = WS_D;
constexpr size_t WS_HG = WS_D;
constexpr size_t WS_F2 = WS_D;
constexpr size_t WS_U = WS_D + 148 * MiB;
constexpr size_t WS_H2 = WS_D + 483 * MiB;
constexpr size_t WS_END = WS_D + 555 * MiB;
static_assert((size_t)MP * DFF * 2 <= 407 * MiB && (size_t)MP * DM * 2 <= 148 * MiB && (size_t)M * NP * 2 <= 234 * MiB, "dynamic map");
static_assert((size_t)M * DFF * 2 + 148 * MiB <= 483 * MiB, "dense U clear of H2");

constexpr int CW_BAR = 4096;
constexpr int CW_CNT = 8192;

constexpr int RING_BYTES = 131072;
constexpr int TEXP_OFF = 139264;
constexpr int MISC_OFF = 146432 - 512;
constexpr int LDS_BYTES = 147456;

typedef unsigned u32x2 __attribute__((ext_vector_type(2)));

__device__ __forceinline__ float bf2f(unsigned short x) { return __uint_as_float((unsigned)x << 16); }
__device__ __forceinline__ float bflo(unsigned w) { return __uint_as_float(w << 16); }
__device__ __forceinline__ float bfhi(unsigned w) { return __uint_as_float(w & 0xffff0000u); }
__device__ __forceinline__ float siluf(float x) { return x * __builtin_amdgcn_rcpf(1.f + __expf(-x)); }
__device__ __forceinline__ float clamp8(float x) { return fminf(fmaxf(x, -448.f), 448.f); }
__device__ __forceinline__ unsigned pk4_f8(float a, float b, float c, float d) { unsigned w = 0u; w = __builtin_amdgcn_cvt_pk_fp8_f32(clamp8(a), clamp8(b), w, false); w = __builtin_amdgcn_cvt_pk_fp8_f32(clamp8(c), clamp8(d), w, true); return w; }
template <int MASK> __device__ __forceinline__ float xadd(float v) {
    if constexpr (MASK == 32) { const auto rr = __builtin_amdgcn_permlane32_swap(__float_as_uint(v), __float_as_uint(v), false, false); return __uint_as_float(rr[0]) + __uint_as_float(rr[1]); }
    else return v + __int_as_float(__builtin_amdgcn_ds_swizzle(__float_as_int(v), 0x1f | (MASK << 10)));
}
__device__ __forceinline__ float wave_sum(float v) {
    v = xadd<1>(v); v = xadd<2>(v); v = xadd<4>(v); v = xadd<8>(v); v = xadd<16>(v); v = xadd<32>(v);
    return v;
}

struct Args { const float* in[24]; float* out; unsigned char* ws; };
struct Frame {
    LAS unsigned char* lds;
    volatile LAS unsigned* MISC;
    int tid, lane, wave, G, blk, gw, NGW, z, wv;
    const Args* A;
    unsigned char* ws;
};


__device__ __forceinline__ void refresh(Frame& F) {
    int wv = F.wv; asm volatile("" : "+s"(wv));
    const int t = wv * 64 + pg8::lane_id_opaque();
    int bl = blockIdx.x, z = 0, gg = gridDim.x; asm volatile("" : "+s"(bl), "+s"(z), "+s"(gg));
    F.blk = bl; F.z = z; F.G = gg; F.NGW = gg * NWAVES;
    F.tid = t; F.lane = t & 63; F.wave = wv; F.gw = F.blk * NWAVES + F.wave;
}
#define INP(k) (F.A->in[(k) + F.z])
namespace pg8 {
struct EpiProj {
    static constexpr bool PERM = false, AFTER_DRAIN = false;
    bf16_t* P; const float* ropec; const float* ropes;
    __device__ __forceinline__ void operator()(const f32x4 (&acc)[2][2][4][2], const Unit& u, int wr, int wc, int fr, int fq) const {
        const int pn = u.pn, pm = u.pm, tb = pm % 9;
        const bool do_rope = (tb != 0) && (pn < 4);
        const float sc = (pn < 2) ? C2 : (pn == 6 ? 0.125f : 1.f);
        const bool st_ok_all = pn < 12;
#pragma unroll
        for (int ai = 0; ai < 2; ++ai)
#pragma unroll
            for (int m = 0; m < 4; ++m) {
                const int rit = ai * HALF + wr * 64 + m * 16 + fr;
                const size_t grow = (size_t)pm * BM + rit;
                const int s = (tb - 1) * 256 + rit;
                const int pos = (wc & 1) ? (s & 63) : (s >> 6);
                f32x4 cs = {1.f, 1.f, 1.f, 1.f}, sn = {0.f, 0.f, 0.f, 0.f};
                if (do_rope) { cs = *(const f32x4*)(ropec + pos * 16 + 4 * fq); sn = *(const f32x4*)(ropes + pos * 16 + 4 * fq); }
#pragma unroll
                for (int bj = 0; bj < 2; ++bj) {
                    f32x4 v0 = acc[ai][bj][m][0], v1 = acc[ai][bj][m][1];
                    if (do_rope) { const f32x4 a = v0 * cs - v1 * sn, b = v0 * sn + v1 * cs; v0 = a; v1 = b; }
                    v0 = v0 * sc; v1 = v1 * sc;
                    const int col0 = pn * BM + bj * HALF + wc * 32 + 4 * fq;
                    if (st_ok_all || (bj == 0 && wc == 0)) {
                        u32x2 w0, w1; w0.x = cvt_pk_bf16(v0[0], v0[1]); w0.y = cvt_pk_bf16(v0[2], v0[3]); w1.x = cvt_pk_bf16(v1[0], v1[1]); w1.y = cvt_pk_bf16(v1[2], v1[3]);
                        *(u32x2*)(P + grow * NP + col0) = w0; *(u32x2*)(P + grow * NP + col0 + 16) = w1;
                    }
                }
            }
    }
};
struct EpiF32 {
    static constexpr bool PERM = true, AFTER_DRAIN = false;
    bf16_t* Y;
    __device__ __forceinline__ void operator()(const f32x4 (&acc)[2][2][4][2], const Unit& u, int wr, int wc, int fr, int fq) const {
#pragma unroll
        for (int ai = 0; ai < 2; ++ai)
#pragma unroll
            for (int m = 0; m < 4; ++m) {
                bf16_t* rowp = Y + ((size_t)u.pm * BM + ai * HALF + wr * 64 + m * 16 + fr) * DM + u.pn * BM + wc * 32 + 8 * fq;
#pragma unroll
                for (int bj = 0; bj < 2; ++bj) { const f32x4 v0 = acc[ai][bj][m][0], v1 = acc[ai][bj][m][1];
                    u32x4 w; w.x = cvt_pk_bf16(v0[0], v0[1]); w.y = cvt_pk_bf16(v0[2], v0[3]); w.z = cvt_pk_bf16(v1[0], v1[1]); w.w = cvt_pk_bf16(v1[2], v1[3]);
                    *(u32x4*)(rowp + bj * HALF) = w; }
            }
    }
};
struct EpiSwiglu {
    static constexpr bool PERM = true, AFTER_DRAIN = false;
    bf16_t* U;
    __device__ __forceinline__ void operator()(const f32x4 (&acc)[2][2][4][2], const Unit& u, int wr, int wc, int fr, int fq) const {
        const int pnl = u.pn % 22;
        const int col0 = pnl * 128 + wc * 32 + 8 * fq;
        constexpr float ws = FFN_F8 ? 1.f / W8S : 1.f, us = FFN_F8 ? U8S : 1.f, kS = ws * ws * us, kE = -ws * 1.4426950408889634f;
        const float cE = -__builtin_log2f(kS), c1 = 1.f / kS;
#pragma unroll
        for (int ai = 0; ai < 2; ++ai)
#pragma unroll
            for (int m = 0; m < 4; ++m) {
                const size_t rowi = (size_t)u.pm * BM + ai * HALF + wr * 64 + m * 16 + fr;
                f32x2 g[4], up[4], t[4], r[4];
#pragma unroll
                for (int n = 0; n < 2; ++n) { g[2 * n] = (f32x2){acc[ai][0][m][n][0], acc[ai][0][m][n][1]}; g[2 * n + 1] = (f32x2){acc[ai][0][m][n][2], acc[ai][0][m][n][3]};
                                              up[2 * n] = (f32x2){acc[ai][1][m][n][0], acc[ai][1][m][n][1]}; up[2 * n + 1] = (f32x2){acc[ai][1][m][n][2], acc[ai][1][m][n][3]}; }
#pragma unroll
                for (int q = 0; q < 4; ++q) t[q] = g[q] * kE + cE;
#pragma unroll
                for (int q = 0; q < 4; ++q) { t[q].x = __builtin_amdgcn_exp2f(t[q].x); t[q].y = __builtin_amdgcn_exp2f(t[q].y); }
#pragma unroll
                for (int q = 0; q < 4; ++q) t[q] = t[q] + c1;
#pragma unroll
                for (int q = 0; q < 4; ++q) { r[q].x = __builtin_amdgcn_rcpf(t[q].x); r[q].y = __builtin_amdgcn_rcpf(t[q].y); }
#pragma unroll
                for (int q = 0; q < 4; ++q) g[q] = (g[q] * up[q]) * r[q];
                if constexpr (FFN_F8) { u32x2 w; w.x = pk4_f8(g[0].x, g[0].y, g[1].x, g[1].y); w.y = pk4_f8(g[2].x, g[2].y, g[3].x, g[3].y); *(u32x2*)((unsigned char*)U + rowi * DFF + col0) = w; }
                else { u32x4 w; w.x = cvt_pk_bf16(g[0].x, g[0].y); w.y = cvt_pk_bf16(g[1].x, g[1].y); w.z = cvt_pk_bf16(g[2].x, g[2].y); w.w = cvt_pk_bf16(g[3].x, g[3].y); *(u32x4*)(U + rowi * DFF + col0) = w; }
            }
    }
};
struct EpiDown {
    static constexpr bool PERM = true, AFTER_DRAIN = false;
    bf16_t* F2; const int* rmap; const float* roww; int dense;
    __device__ __forceinline__ void operator()(const f32x4 (&acc)[2][2][4][2], const Unit& u, int wr, int wc, int fr, int fq) const {
        const int pnl = u.pn & 3;
        const int col0 = pnl * BM + wc * 32 + 8 * fq;
#pragma unroll
        for (int ai = 0; ai < 2; ++ai)
#pragma unroll
            for (int m = 0; m < 4; ++m) {
                const int grow = u.pm * BM + ai * HALF + wr * 64 + m * 16 + fr;
                int tok = grow, slot = 0; float w = 1.f; bool ok = true;
                if (!dense) { const int rm = rmap[grow]; ok = rm >= 0; tok = rm & 0x3fffffff; slot = (rm >> 30) & 1; w = roww[grow]; }
                if constexpr (FFN_F8) w *= 1.f / (W8S * U8S);
                if (ok) {
                    bf16_t* rowp = F2 + ((size_t)slot * M + tok) * DM + col0;
#pragma unroll
                    for (int bj = 0; bj < 2; ++bj) {
                        const f32x4 v0 = acc[ai][bj][m][0] * w, v1 = acc[ai][bj][m][1] * w;
                        u32x4 q; q.x = cvt_pk_bf16(v0[0], v0[1]); q.y = cvt_pk_bf16(v0[2], v0[3]); q.z = cvt_pk_bf16(v1[0], v1[1]); q.w = cvt_pk_bf16(v1[2], v1[3]);
                        *(u32x4*)(rowp + bj * HALF) = q;
                    }
                }
            }
    }
};
struct GroupedOrder {
    StaticOrder S; const PG8_LAS int* texp; int nN;
    __device__ __forceinline__ bool next(int i, Unit& u) const { if (!S.next(i, u)) return false; u.pn += __builtin_amdgcn_readfirstlane(texp[u.pm]) * nN; return true; }
    __device__ __forceinline__ void a_ready(const Unit&) const {}
    __device__ __forceinline__ void done(const Unit&) const {}
};
struct LatOrder {
    StaticOrder S; int lat;
    __device__ __forceinline__ bool next(int i, Unit& u) const { if (!S.next(i, u)) return false; if (lat) u.pm += (u.pm >> 3) + 1; return true; }
    __device__ __forceinline__ void a_ready(const Unit&) const {}
    __device__ __forceinline__ void done(const Unit&) const {}
};
}

__device__ __forceinline__ void ld_row_f32(const float* row, int lane, f32x4 (&v)[4]) {
#pragma unroll
    for (int j = 0; j < 4; ++j) v[j] = *(const f32x4*)(row + 4 * lane + 256 * j);
}
__device__ __forceinline__ void st_row_f32(float* row, int lane, const f32x4 (&v)[4]) {
#pragma unroll
    for (int j = 0; j < 4; ++j) *(f32x4*)(row + 4 * lane + 256 * j) = v[j];
}
__device__ __forceinline__ void ld_row_bf16(const bf16* row, int lane, f32x4 (&v)[4]) {
#pragma unroll
    for (int j = 0; j < 4; ++j) { const u32x2 w = *(const u32x2*)(row + 4 * lane + 256 * j); v[j] = (f32x4){bflo(w.x), bfhi(w.x), bflo(w.y), bfhi(w.y)}; }
}
__device__ __forceinline__ void st_row_bf16(bf16* row, int lane, const f32x4 (&v)[4]) {
#pragma unroll
    for (int j = 0; j < 4; ++j) { u32x2 w; w.x = pg8::cvt_pk_bf16(v[j][0], v[j][1]); w.y = pg8::cvt_pk_bf16(v[j][2], v[j][3]); *(u32x2*)(row + 4 * lane + 256 * j) = w; }
}
__device__ __forceinline__ float row_rinv(const f32x4 (&v)[4]) {
    float s = 0.f;
#pragma unroll
    for (int j = 0; j < 4; ++j) s += (v[j][0] * v[j][0] + v[j][1] * v[j][1]) + (v[j][2] * v[j][2] + v[j][3] * v[j][3]);
    return 1.0f / sqrtf(wave_sum(s) * (1.f / DM) + EPS);
}

__device__ __forceinline__ void transpose_tile(const float* W, int N, int k0, int n0, bf16* WT, int K, int drow0, LAS float* scr, int lane) {
#pragma unroll 8
    for (int i = 0; i < 32; ++i) { const int kk = 2 * i + (lane >> 5); scr[kk * 33 + (lane & 31)] = W[(size_t)(k0 + kk) * N + n0 + (lane & 31)]; }
    LDS_WAIT(); asm volatile("" ::: "memory");
    const int c = lane & 7;
#pragma unroll
    for (int j = 0; j < 4; ++j) { const int n = (lane >> 3) + 8 * j; const LAS float* s = scr + (8 * c) * 33 + n;
        v4u o; o.x = pk2(s[0 * 33], s[1 * 33]); o.y = pk2(s[2 * 33], s[3 * 33]); o.z = pk2(s[4 * 33], s[5 * 33]); o.w = pk2(s[6 * 33], s[7 * 33]);
        *(GAS v4u*)(WT + (size_t)(drow0 + n) * K + k0 + 8 * c) = o; }
    LDS_WAIT(); asm volatile("" ::: "memory");
}
__device__ __forceinline__ void transpose_tile_f8(const float* W, int N, int k0, int n0, unsigned char* WT, int Kb, int drow0, LAS float* scr, int lane, float scale) {
#pragma unroll 8
    for (int i = 0; i < 32; ++i) { const int kk = 2 * i + (lane >> 5); scr[kk * 33 + (lane & 31)] = W[(size_t)(k0 + kk) * N + n0 + (lane & 31)]; }
    LDS_WAIT(); asm volatile("" ::: "memory");
    const int n = lane >> 1, hf = lane & 1; const LAS float* s = scr + (hf * 32) * 33 + n;
    v4u o0, o1;
    o0.x = pk4_f8(s[0 * 33] * scale, s[1 * 33] * scale, s[2 * 33] * scale, s[3 * 33] * scale);     o0.y = pk4_f8(s[4 * 33] * scale, s[5 * 33] * scale, s[6 * 33] * scale, s[7 * 33] * scale);
    o0.z = pk4_f8(s[8 * 33] * scale, s[9 * 33] * scale, s[10 * 33] * scale, s[11 * 33] * scale);   o0.w = pk4_f8(s[12 * 33] * scale, s[13 * 33] * scale, s[14 * 33] * scale, s[15 * 33] * scale);
    o1.x = pk4_f8(s[16 * 33] * scale, s[17 * 33] * scale, s[18 * 33] * scale, s[19 * 33] * scale); o1.y = pk4_f8(s[20 * 33] * scale, s[21 * 33] * scale, s[22 * 33] * scale, s[23 * 33] * scale);
    o1.z = pk4_f8(s[24 * 33] * scale, s[25 * 33] * scale, s[26 * 33] * scale, s[27 * 33] * scale); o1.w = pk4_f8(s[28 * 33] * scale, s[29 * 33] * scale, s[30 * 33] * scale, s[31 * 33] * scale);
    GAS v4u* dst = (GAS v4u*)(WT + (size_t)(drow0 + n) * Kb + k0 + hf * 32);
    dst[0] = o0; dst[1] = o1;
    LDS_WAIT(); asm volatile("" ::: "memory");
}
__device__ __forceinline__ void convert_weights(Frame& F, int l) {
    refresh(F);
    const bool moe = l & 1; const int ne = moe ? NE : 1, li = l >> 1;
    const float* w1 = moe ? INP(21) + (size_t)li * NE * DM * DFF : INP(17) + (size_t)li * DM * DFF;
    const float* w3 = moe ? INP(22) + (size_t)li * NE * DM * DFF : INP(18) + (size_t)li * DM * DFF;
    const float* w2 = moe ? INP(23) + (size_t)li * NE * DM * DFF : INP(19) + (size_t)li * DM * DFF;
    const float* win = INP(10) + (size_t)l * DM * NIN;
    const float* wout = INP(16) + (size_t)l * DM * DM;
    bf16* WIN = (bf16*)(F.ws + WS_WIN); bf16* WOUT = (bf16*)(F.ws + WS_WOUT); bf16* WUP = (bf16*)(F.ws + WS_WUP); bf16* WDN = (bf16*)(F.ws + WS_WDN);
    LAS float* scr = (LAS float*)(F.lds + F.wave * 16384);
    const int nA = 16 * 97, nZ = NP - NIN, nB = 16 * 32, nC1 = 16 * 88, nD1 = 44 * 32;
    const int nC = ne * 2 * nC1, nD = ne * nD1, total = nA + nZ + nB + nC + nD;
    for (int it = F.gw; it < total; it += F.NGW) {
        int r = it;
        if (r < nA) { const int kb = r / 97, nb = r % 97; transpose_tile(win, NIN, 64 * kb, 32 * nb, WIN, DM, 32 * nb, scr, F.lane); continue; } r -= nA;
        if (r < nZ) { const unsigned zz = (unsigned)F.z; v4u z = {zz, zz, zz, zz}; GAS v4u* p = (GAS v4u*)(WIN + (size_t)(NIN + r) * DM) + F.lane * 2; p[0] = z; p[1] = z; continue; } r -= nZ;
        if (r < nB) { const int kb = r / 32, nb = r % 32; transpose_tile(wout, DM, 64 * kb, 32 * nb, WOUT, DM, 32 * nb, scr, F.lane); continue; } r -= nB;
        if (r < nC) { const int e = r / (2 * nC1), q = r % (2 * nC1), which = q / nC1, t = q % nC1, kb = t / 88, nb = t % 88, n0 = 32 * nb;
            const float* src = (which ? w3 : w1) + (size_t)e * DM * DFF;
            if constexpr (FFN_F8) transpose_tile_f8(src, DFF, 64 * kb, n0, (unsigned char*)WUP, DM, e * 5632 + (n0 / 128) * 256 + (n0 % 128) + which * 128, scr, F.lane, W8S);
            else transpose_tile(src, DFF, 64 * kb, n0, WUP, DM, e * 5632 + (n0 / 128) * 256 + (n0 % 128) + which * 128, scr, F.lane); continue; } r -= nC;
        { const int e = r / nD1, t = r % nD1, kb = t / 32, nb = t % 32;
            if constexpr (FFN_F8) transpose_tile_f8(w2 + (size_t)e * DFF * DM, DM, 64 * kb, 32 * nb, (unsigned char*)WDN + (size_t)e * DM * DFF, DFF, 32 * nb, scr, F.lane, W8S);
            else transpose_tile(w2 + (size_t)e * DFF * DM, DM, 64 * kb, 32 * nb, WDN + (size_t)e * DM * DFF, DFF, 32 * nb, scr, F.lane); }
    }
}

__device__ __forceinline__ void p0_mod(Frame& F) {
    refresh(F);
    LAS float* S = (LAS float*)(F.lds);
    LAS float* R = (LAS float*)(F.lds + 69632);
    const float* c = INP(1); const float* cc = INP(3); const float* wmod = INP(4); const float* bmod = INP(5);
    float* MOD = (float*)(F.ws + WS_MOD);
    for (int i = F.tid; i < 17 * 1024; i += 512) { const int b = i >> 10, k = i & 1023; const float v = b < 16 ? c[b * 1024 + k] : cc[k]; S[i] = siluf(v); }
    __syncthreads();
    const int kq = F.lane >> 4, c4 = (F.lane & 15) * 4;
    for (int item = F.blk; item < 4 * 96; item += F.G) {
        const int l = item / 96, col0 = (item % 96) * 64;
        const float* W = wmod + (size_t)l * DM * 6144;
        float acc[17][4];
#pragma unroll
        for (int b = 0; b < 17; ++b)
#pragma unroll
            for (int j = 0; j < 4; ++j) acc[b][j] = 0.f;
        for (int it = 0; it < 32; ++it) {
            const int k = F.wave * 128 + it * 4 + kq;
            const f32x4 w = *(const f32x4*)(W + (size_t)k * 6144 + col0 + c4);
#pragma unroll
            for (int b = 0; b < 17; ++b) { const float s = S[b * 1024 + k];
#pragma unroll
                for (int j = 0; j < 4; ++j) acc[b][j] += s * w[j]; }
        }
#pragma unroll
        for (int b = 0; b < 17; ++b)
#pragma unroll
            for (int j = 0; j < 4; ++j) { float v = acc[b][j]; v = xadd<16>(v); v = xadd<32>(v); acc[b][j] = v; }
        if (kq == 0) {
#pragma unroll
            for (int b = 0; b < 17; ++b)
#pragma unroll
                for (int j = 0; j < 4; ++j) R[(F.wave * 17 + b) * 64 + c4 + j] = acc[b][j];
        }
        __syncthreads();
        for (int o = F.tid; o < 17 * 64; o += 512) { const int b = o >> 6, ccx = o & 63; float s = bmod[l * 6144 + col0 + ccx];
            for (int w = 0; w < 8; ++w) s += R[(w * 17 + b) * 64 + ccx];
            MOD[((size_t)l * 17 + b) * 6144 + col0 + ccx] = s; }
        __syncthreads();
    }
}
__device__ __forceinline__ float lam_init_of(int l) { return 0.8f - 0.6f * expf(-0.3f * (float)l); }
__device__ __forceinline__ void p0_misc(Frame& F) {
    refresh(F);
    float* ropec = (float*)(F.ws + WS_ROPE); float* ropes = ropec + 1024; float* lam = (float*)(F.ws + WS_ROPE + 16384);
    if (F.blk == 0) {
        for (int i = F.tid; i < 1024; i += 512) { const int pos = i >> 4, f = i & 15; const float inv = powf(10000.f, -(float)f / 16.f); const float ang = (float)pos * inv; ropec[i] = cosf(ang); ropes[i] = sinf(ang); }
    }
    if (F.blk == (1 % F.G) && F.wave < 4) {
        const int l = F.wave; const float* lv = INP(13) + l * 256;
        const float a = wave_sum(lv[F.lane] * lv[64 + F.lane]), b = wave_sum(lv[128 + F.lane] * lv[192 + F.lane]);
        if (F.lane == 0) lam[l] = expf(a) - expf(b) + lam_init_of(l);
    }
}

namespace att {
using bf16x8 = __attribute__((ext_vector_type(8))) short;
using s16x4  = __attribute__((ext_vector_type(4))) short;
using f32x16 = __attribute__((ext_vector_type(16))) float;
using u32x4  = __attribute__((ext_vector_type(4))) unsigned;
constexpr int QBLK = 32, KVBLK = 64, NW = 8, DV = 128;
constexpr float THR = 8.f;
constexpr size_t SHM_V = KVBLK * DV * 2, SHM_K = KVBLK * 64 * 2, SHM_ATTN = 2 * SHM_V + 2 * SHM_K + NW * 64 * 4;
#define KSWZ64(row, colB) ((row) * 128 + ((colB) ^ ((((row) >> 1) & 7) << 4)))
#define SBAR() __builtin_amdgcn_sched_barrier(0)
__device__ __forceinline__ int crow(int r, int hi) { return (r & 3) + 8 * (r >> 2) + 4 * hi; }
__device__ __forceinline__ unsigned cvtpk(float lo, float hi) { unsigned r; asm volatile("v_cvt_pk_bf16_f32 %0, %1, %2" : "=v"(r) : "v"(lo), "v"(hi)); return r; }
__device__ __forceinline__ void partialSM(f32x16& p0, f32x16& p1, float& m_reg, float& mn, float& alpha) {
  float pmax = p0[0];
#pragma unroll
  for (int r = 1; r < 16; ++r) pmax = fmaxf(pmax, p0[r]);
#pragma unroll
  for (int r = 0; r < 16; ++r) pmax = fmaxf(pmax, p1[r]);
  { auto rr = __builtin_amdgcn_permlane32_swap(__float_as_uint(pmax), __float_as_uint(pmax), false, false);
    pmax = fmaxf(__uint_as_float(rr[0]), __uint_as_float(rr[1])); }
  if (__builtin_expect(__all(pmax - m_reg <= THR), 1)) { mn = m_reg; alpha = 1.f; }
  else { mn = fmaxf(m_reg, pmax); alpha = __builtin_amdgcn_exp2f(m_reg - mn); m_reg = mn; }
#pragma unroll
  for (int r = 0; r < 16; ++r) p0[r] = p0[r] - mn;
#pragma unroll
  for (int r = 0; r < 16; ++r) p1[r] = p1[r] - mn;
#pragma unroll
  for (int r = 0; r < 16; ++r) p0[r] = __builtin_amdgcn_exp2f(p0[r]);
}
__device__ __forceinline__ void finishSM(f32x16& p0, f32x16& p1, float alpha, float& l_reg, bf16x8& pa0, bf16x8& pa1, bf16x8& pa2, bf16x8& pa3) {
#pragma unroll
  for (int r = 0; r < 16; ++r) p1[r] = __builtin_amdgcn_exp2f(p1[r]);
  float ps = 0;
#pragma unroll
  for (int r = 0; r < 16; ++r) ps += p0[r];
#pragma unroll
  for (int r = 0; r < 16; ++r) ps += p1[r];
  { auto rr = __builtin_amdgcn_permlane32_swap(__float_as_uint(ps), __float_as_uint(ps), false, false);
    ps = __uint_as_float(rr[0]) + __uint_as_float(rr[1]); }
  l_reg = l_reg * alpha + ps;
#define PK4(P, BASE, OUT) do { unsigned a0 = cvtpk(P[BASE + 0], P[BASE + 1]), a1 = cvtpk(P[BASE + 2], P[BASE + 3]);   \
    unsigned b0 = cvtpk(P[BASE + 4], P[BASE + 5]), b1 = cvtpk(P[BASE + 6], P[BASE + 7]);                              \
    auto r0 = __builtin_amdgcn_permlane32_swap(a0, b0, false, false); auto r1 = __builtin_amdgcn_permlane32_swap(a1, b1, false, false); \
    u32x4 w = {r0[0], r1[0], r0[1], r1[1]}; OUT = *reinterpret_cast<bf16x8*>(&w); } while (0)
  PK4(p0, 0, pa0); PK4(p0, 8, pa1); PK4(p1, 0, pa2); PK4(p1, 8, pa3);
#undef PK4
}
__device__ __forceinline__ void pack_p(const f32x16& p0, const f32x16& p1, bf16x8& pa0, bf16x8& pa1, bf16x8& pa2, bf16x8& pa3) {
#define PK4(P, BASE, OUT) do { unsigned a0 = cvtpk(P[BASE + 0], P[BASE + 1]), a1 = cvtpk(P[BASE + 2], P[BASE + 3]);   \
    unsigned b0 = cvtpk(P[BASE + 4], P[BASE + 5]), b1 = cvtpk(P[BASE + 6], P[BASE + 7]);                              \
    auto r0 = __builtin_amdgcn_permlane32_swap(a0, b0, false, false); auto r1 = __builtin_amdgcn_permlane32_swap(a1, b1, false, false); \
    u32x4 w = {r0[0], r1[0], r0[1], r1[1]}; OUT = *reinterpret_cast<bf16x8*>(&w); } while (0)
  PK4(p0, 0, pa0); PK4(p0, 8, pa1); PK4(p1, 0, pa2); PK4(p1, 8, pa3);
#undef PK4
}
__device__ __forceinline__ void qkt(f32x16& p0, f32x16& p1, const bf16* Ks, const bf16x8* qr, int r32, int hi) {
  p0 = f32x16{}; p1 = f32x16{};
#pragma unroll
  for (int d0 = 0; d0 < 4; ++d0) { int cb = (d0 * 16 + hi * 8) * 2;
    bf16x8 b0 = *reinterpret_cast<const bf16x8*>((const char*)Ks + KSWZ64(r32, cb));
    bf16x8 b1 = *reinterpret_cast<const bf16x8*>((const char*)Ks + KSWZ64(32 + r32, cb));
    p0 = __builtin_amdgcn_mfma_f32_32x32x16_bf16(b0, qr[d0], p0, 0, 0, 0);
    p1 = __builtin_amdgcn_mfma_f32_32x32x16_bf16(b1, qr[d0], p1, 0, 0, 0); }
}
__device__ __forceinline__ int v_st(int k, int c) { const int kk = (k & ~0xC) | ((k & 4) << 1) | ((k & 8) >> 1); return ((kk >> 3) * 4 + (c >> 5)) * 512 + ((kk & 7) * 32 + (c & 31)) * 2; }
__device__ __forceinline__ int v_rd_base(int lane) { return ((lane & 3) << 3) | (((lane >> 2) & 3) << 6) | (((lane >> 4) & 1) << 5) | (((lane >> 5) & 1) << 8); }
constexpr int v_rd_off(int d0, int ks, int half) { return d0 * 512 + ks * 4096 + half * 2048; }
template <int OFF> __device__ __forceinline__ s16x4 tr_read(int vb) {
  s16x4 r; asm volatile("ds_read_b64_tr_b16 %0, %1 offset:%2" : "=&v"(r) : "v"(vb), "i"(OFF) : "memory"); return r;
}
template <int D0> __device__ __forceinline__ void pv_one(f32x16& od, int vb, bf16x8 pa0, bf16x8 pa1, bf16x8 pa2, bf16x8 pa3) {
  const s16x4 l0 = tr_read<v_rd_off(D0, 0, 0)>(vb), h0 = tr_read<v_rd_off(D0, 0, 1)>(vb), l1 = tr_read<v_rd_off(D0, 1, 0)>(vb), h1 = tr_read<v_rd_off(D0, 1, 1)>(vb);
  const s16x4 l2 = tr_read<v_rd_off(D0, 2, 0)>(vb), h2 = tr_read<v_rd_off(D0, 2, 1)>(vb), l3 = tr_read<v_rd_off(D0, 3, 0)>(vb), h3 = tr_read<v_rd_off(D0, 3, 1)>(vb);
  asm volatile("s_waitcnt lgkmcnt(0)" ::: "memory"); SBAR();
#define PK(L, H) (bf16x8){L[0], L[1], L[2], L[3], H[0], H[1], H[2], H[3]}
  od = __builtin_amdgcn_mfma_f32_32x32x16_bf16(pa0, PK(l0, h0), od, 0, 0, 0);
  od = __builtin_amdgcn_mfma_f32_32x32x16_bf16(pa1, PK(l1, h1), od, 0, 0, 0);
  od = __builtin_amdgcn_mfma_f32_32x32x16_bf16(pa2, PK(l2, h2), od, 0, 0, 0);
  od = __builtin_amdgcn_mfma_f32_32x32x16_bf16(pa3, PK(l3, h3), od, 0, 0, 0);
#undef PK
}
__device__ __forceinline__ void pv_d0(f32x16* o, int vb, bf16x8 pa0, bf16x8 pa1, bf16x8 pa2, bf16x8 pa3) {
  pv_one<0>(o[0], vb, pa0, pa1, pa2, pa3); pv_one<1>(o[1], vb, pa0, pa1, pa2, pa3); pv_one<2>(o[2], vb, pa0, pa1, pa2, pa3); pv_one<3>(o[3], vb, pa0, pa1, pa2, pa3);
}
constexpr int LDQ = NP, LDK = NP, LDO = DM;
__device__ __forceinline__ void attn_unit(const bf16* __restrict__ Qb, const bf16* __restrict__ Kh, const bf16* __restrict__ Vh, bf16* __restrict__ Ob, int seq, char* lds, int tid) {
  const int wid = tid >> 6, lane = tid & 63, r32 = lane & 31, hi = lane >> 5;
  bf16* V_lds = (bf16*)lds; bf16* K_lds = (bf16*)(lds + 2 * SHM_V);
  float* ws = (float*)(lds + 2 * SHM_V + 2 * SHM_K) + wid * 64; float* li_l = ws; float* al_l = ws + 32;
  float m_reg = -1e30f, l_reg = 0; f32x16 o[4] = {}; bf16x8 qr[4];
  const bf16* Qw = Qb + (long)(wid * QBLK + r32) * LDQ + hi * 8;
#pragma unroll
  for (int d0 = 0; d0 < 4; ++d0) qr[d0] = *(const __attribute__((address_space(1))) bf16x8*)(Qw + d0 * 16);
  const int sr = tid >> 4, sc = (tid & 15) * 8, vst0 = v_st(sr, sc), vst1 = v_st(32 + sr, sc);
  const int kr = tid >> 3, kc = (tid & 7) * 8, kst = KSWZ64(kr, kc * 2);
  const int vb0 = (int)(uintptr_t)V_lds + v_rd_base(lane);
  struct { bf16x8 vs0, vs1, ks0; } sr_[2];
#define GLD8(p) (*(const __attribute__((address_space(1))) bf16x8*)(p))
#define SLOAD(i, k0) do { sr_[i].vs0 = GLD8(&Vh[(long)((k0) + sr) * LDK + sc]); sr_[i].vs1 = GLD8(&Vh[(long)((k0) + 32 + sr) * LDK + sc]); \
    sr_[i].ks0 = GLD8(&Kh[(long)((k0) + kr) * LDK + kc]); } while (0)
#define SWRITE(b, i) do { *(bf16x8*)((char*)V_lds + (b) * SHM_V + vst0) = sr_[i].vs0; *(bf16x8*)((char*)V_lds + (b) * SHM_V + vst1) = sr_[i].vs1; \
    *(bf16x8*)((char*)K_lds + (b) * SHM_K + kst) = sr_[i].ks0; } while (0)
#define SWAIT() asm volatile("s_waitcnt vmcnt(3)" ::: "memory")
#define RESC(a) do { if (__any((a) < 1.f)) { if (hi == 0) al_l[r32] = (a); asm volatile("s_waitcnt lgkmcnt(0)" ::: "memory"); \
    _Pragma("unroll") for (int d = 0; d < 4; ++d) _Pragma("unroll") for (int r = 0; r < 16; ++r) o[d][r] *= al_l[crow(r, hi)]; } } while (0)
  f32x16 pA0, pA1, pB0, pB1; float mnA, mnB, alA, alB; bf16x8 pa0, pa1, pa2, pa3; const int NT = seq / KVBLK;
  constexpr int SE = 0, SO = 1;
  SLOAD(SE, 0); asm volatile("s_waitcnt vmcnt(0)" ::: "memory"); SWRITE(0, SE); __syncthreads();
  qkt(pA0, pA1, K_lds, qr, r32, hi); partialSM(pA0, pA1, m_reg, mnA, alA);
  SLOAD(SO, KVBLK); if (2 < NT) SLOAD(SE, 2 * KVBLK);
  SWAIT(); SWRITE(1, SO); __syncthreads();
  for (int j = 1; j + 1 < NT; j += 2) {
    SBAR(); qkt(pB0, pB1, (bf16*)((char*)K_lds + SHM_K), qr, r32, hi);
    finishSM(pA0, pA1, alA, l_reg, pa0, pa1, pa2, pa3); SBAR();
    SLOAD(SO, (j + 2) * KVBLK); SBAR();
    pv_d0(o, vb0, pa0, pa1, pa2, pa3); partialSM(pB0, pB1, m_reg, mnB, alB);
    __syncthreads(); SWAIT(); SWRITE(0, SE);
    RESC(alB); __syncthreads();
    SBAR(); qkt(pA0, pA1, K_lds, qr, r32, hi);
    finishSM(pB0, pB1, alB, l_reg, pa0, pa1, pa2, pa3); SBAR();
    if (j + 3 < NT) SLOAD(SE, (j + 3) * KVBLK); SBAR();
    pv_d0(o, vb0 + (int)SHM_V, pa0, pa1, pa2, pa3); partialSM(pA0, pA1, m_reg, mnA, alA);
    __syncthreads(); SWAIT(); SWRITE(1, SO);
    RESC(alA); __syncthreads();
  }
  SBAR(); qkt(pB0, pB1, (bf16*)((char*)K_lds + SHM_K), qr, r32, hi);
  finishSM(pA0, pA1, alA, l_reg, pa0, pa1, pa2, pa3); SBAR();
  pv_d0(o, vb0, pa0, pa1, pa2, pa3); partialSM(pB0, pB1, m_reg, mnB, alB);
  __syncthreads(); RESC(alB);
  finishSM(pB0, pB1, alB, l_reg, pa0, pa1, pa2, pa3); SBAR();
  pv_d0(o, vb0 + (int)SHM_V, pa0, pa1, pa2, pa3);
  if (hi == 0) li_l[r32] = l_reg; asm volatile("s_waitcnt lgkmcnt(0)" ::: "memory");
  float rli[16];
#pragma unroll
  for (int r = 0; r < 16; ++r) rli[r] = __builtin_amdgcn_rcpf(li_l[crow(r, hi)]);
  bf16* Ow = Ob + (long)(wid * QBLK) * LDO;
#pragma unroll
  for (int r = 0; r < 16; ++r) { const int orow = crow(r, hi);
#pragma unroll
    for (int d0 = 0; d0 < 4; ++d0) Ow[(long)orow * LDO + d0 * 32 + r32] = (bf16)(cvtpk(o[d0][r] * rli[r], 0.f) & 0xffffu); }
#undef SLOAD
#undef GLD8
#undef SWRITE
#undef SWAIT
#undef RESC
}
}

__device__ __forceinline__ int gla_item(int b, int h, int dir, int c) { return ((b * 4 + h) * 2 + dir) * NCH + c; }
namespace gla {
using att::bf16x8; using att::f32x16; using att::u32x4;
__device__ __forceinline__ void gates8(const bf16* P, const float* w2, const float* gb, size_t row0, int dir, int seg, int k, float (&gl)[8]) {
    float w[16];
#pragma unroll
    for (int j = 0; j < 16; ++j) w[j] = w2[j * 256 + k];
    const float bias = gb[k];
#pragma unroll
    for (int i = 0; i < 8; ++i) {
        const bf16* gp = P + (row0 + seg * 8 + i) * NP + C_GLR + dir * 16;
        const v4u a = *(const v4u*)gp, b = *(const v4u*)(gp + 8);
        float z = bias;
        z += bflo(a.x) * w[0] + bfhi(a.x) * w[1] + bflo(a.y) * w[2] + bfhi(a.y) * w[3] + bflo(a.z) * w[4] + bfhi(a.z) * w[5] + bflo(a.w) * w[6] + bfhi(a.w) * w[7];
        z += bflo(b.x) * w[8] + bfhi(b.x) * w[9] + bflo(b.y) * w[10] + bfhi(b.y) * w[11] + bflo(b.z) * w[12] + bfhi(b.z) * w[13] + bflo(b.w) * w[14] + bfhi(b.w) * w[15];
        gl[i] = (fminf(z, 0.f) - log1pf(expf(-fabsf(z)))) * (1.f / 16.f);
    }
}
__device__ __forceinline__ float lscan(const float (&gl)[8], int dir, float (&loc)[8]) {
    float run = 0.f;
    if (dir == 0) {
#pragma unroll
        for (int i = 0; i < 8; ++i) { run += gl[i]; loc[i] = run; }
    } else {
#pragma unroll
        for (int i = 7; i >= 0; --i) { run += gl[i]; loc[i] = run; }
    }
    return run;
}
__device__ __forceinline__ void stage_tile_bf16(const bf16* src, size_t pitch, char* tile, int tid) {
    const int sr = tid >> 4, sc = (tid & 15) * 8;
    const bf16x8 a = *reinterpret_cast<const bf16x8*>(src + (size_t)sr * pitch + sc), b = *reinterpret_cast<const bf16x8*>(src + (size_t)(32 + sr) * pitch + sc);
    *(bf16x8*)(tile + att::v_st(sr, sc)) = a; *(bf16x8*)(tile + att::v_st(32 + sr, sc)) = b;
}
__device__ __forceinline__ void stage_tile_f32(const float* src, char* tile, int tid) {
    const int sr = tid >> 4, sc = (tid & 15) * 8;
#pragma unroll
    for (int t = 0; t < 2; ++t) { const int row = sr + 32 * t; const f32x4 x = *(const f32x4*)(src + row * 128 + sc), y = *(const f32x4*)(src + row * 128 + sc + 4);
        u32x4 w = {att::cvtpk(x[0], x[1]), att::cvtpk(x[2], x[3]), att::cvtpk(y[0], y[1]), att::cvtpk(y[2], y[3])};
        *(u32x4*)(tile + att::v_st(row, sc)) = w; }
}
__device__ __forceinline__ void pv_sel(int d0, f32x16& o, int vb, bf16x8 a0, bf16x8 a1, bf16x8 a2, bf16x8 a3) {
    switch (d0) { case 0: att::pv_one<0>(o, vb, a0, a1, a2, a3); break; case 1: att::pv_one<1>(o, vb, a0, a1, a2, a3); break;
                  case 2: att::pv_one<2>(o, vb, a0, a1, a2, a3); break; default: att::pv_one<3>(o, vb, a0, a1, a2, a3); break; }
}
__device__ __forceinline__ void afrag4(const char* img, int row, int hi, bf16x8 (&a)[4]) {
#pragma unroll
    for (int s = 0; s < 4; ++s) a[s] = *reinterpret_cast<const bf16x8*>(img + KSWZ64(row, (s * 16 + hi * 8) * 2));
}
__device__ __forceinline__ void st_sw(char* img, int row, int col, float v) { *(unsigned short*)(img + KSWZ64(row, col * 2)) = (unsigned short)(att::cvtpk(v, 0.f) & 0xffffu); }
}

constexpr size_t WS_OG = WS_DS;
constexpr int CW_Q = 12288;
struct GlaPre { unsigned g; unsigned short q[8], k[8]; att::bf16x8 v0, v1; };
__device__ __forceinline__ void gla_prefetch(GlaPre& R, const bf16* P_, size_t row0, int h, int dir, int k, int seg, int tid) {
    const GAS bf16* P = (const GAS bf16*)P_;
    R.g = *(const GAS unsigned*)(P + (row0 + seg * 8 + (k >> 3)) * NP + C_GLR + dir * 16 + (k & 7) * 2);
#pragma unroll
    for (int i = 0; i < 8; ++i) { const GAS bf16* rp = P + (row0 + seg * 8 + i) * NP; R.q[i] = rp[C_GQ + h * 64 + k]; R.k[i] = rp[C_GK + h * 64 + k]; }
    const int sr = tid >> 4, sc = (tid & 15) * 8;
    R.v0 = *(const GAS att::bf16x8*)(P + (row0 + sr) * NP + C_GV + h * 128 + sc); R.v1 = *(const GAS att::bf16x8*)(P + (row0 + 32 + sr) * NP + C_GV + h * 128 + sc);
}
__device__ __forceinline__ void gla_chain(Frame& F, int l, int chain) {
    const int b = chain >> 3, h = (chain >> 1) & 3, dir = chain & 1;
    const bf16* P = (const bf16*)(F.ws + WS_PROJ); bf16* OG = (bf16*)(F.ws + WS_OG) + (size_t)dir * M * 512;
    char* lds = (char*)F.lds; char* Vt = lds; char* St = lds + 16384; char* KtT = lds + 32768; char* Kt = lds + 40960; char* Qt = lds + 49152; char* Qh = lds + 57344;
    float* T = (float*)(lds + 65536); float* Dec = (float*)(lds + 67584);
    const int k = F.lane, seg = F.tid >> 6, r32 = F.lane & 31, hi = F.lane >> 5, mt = F.wave >> 2, d0 = F.wave & 3;
    const int vbV = (int)(uintptr_t)Vt + att::v_rd_base(F.lane), vbS = (int)(uintptr_t)St + att::v_rd_base(F.lane);
    const int sr = F.tid >> 4, sc = (F.tid & 15) * 8;
    float w[16];
    { const float* w2 = INP(11) + (size_t)((l * 2 + dir) * 16) * 256 + h * 64;
#pragma unroll
      for (int j = 0; j < 16; ++j) w[j] = w2[j * 256 + k]; }
    const float bias = (INP(12) + (l * 2 + dir) * 256 + h * 64)[k];
    att::f32x16 S = {};
    GlaPre R, RN;
    { const int c0 = dir == 0 ? 0 : 3; gla_prefetch(RN, P, (size_t)b * TPB + c0 * 64, h, dir, k, seg, F.tid); }
    for (int j = 0; j < NCH; ++j) {
        const int c = dir == 0 ? j : (j < 4 ? 3 - j : 39 - j);
        const size_t row0 = (size_t)b * TPB + c * 64;
        R = RN;
        if (j + 1 < NCH) { const int cn = dir == 0 ? j + 1 : (j + 1 < 4 ? 2 - j : 38 - j); gla_prefetch(RN, P, (size_t)b * TPB + cn * 64, h, dir, k, seg, F.tid); }
        float gl[8], loc[8];
#pragma unroll
        for (int i = 0; i < 8; ++i) {
            float z = bias;
#pragma unroll
            for (int d = 0; d < 8; ++d) { const unsigned s = (unsigned)__builtin_amdgcn_readlane((int)R.g, i * 8 + d); z += bflo(s) * w[2 * d] + bfhi(s) * w[2 * d + 1]; }
            gl[i] = (fminf(z, 0.f) - __logf(1.f + __expf(-fabsf(z)))) * (1.f / 16.f); }
        const float segtot = gla::lscan(gl, dir, loc);
        T[seg * 64 + k] = segtot;
        *(att::bf16x8*)(Vt + att::v_st(sr, sc)) = R.v0; *(att::bf16x8*)(Vt + att::v_st(32 + sr, sc)) = R.v1;
#pragma unroll
        for (int r = 0; r < 16; ++r) *(unsigned short*)(St + att::v_st(mt * 32 + att::crow(r, hi), d0 * 32 + r32)) = (unsigned short)(att::cvtpk(S[r], 0.f) & 0xffffu);
        __syncthreads();
        float off = 0.f, tot = 0.f;
        int sg = seg; asm volatile("" : "+v"(sg));
#pragma unroll
        for (int s = 0; s < 8; ++s) { const float t = T[s * 64 + k]; tot += t; const bool inoff = dir == 0 ? (s < sg) : (s > sg); off += inoff ? t : 0.f; }
        const float etot = __expf(tot);
        float kt[8];
#pragma unroll
        for (int i = 0; i < 8; ++i) { const int tau = seg * 8 + i; const float qv = bf2f(R.q[i]), kv = bf2f(R.k[i]); const float cc = loc[i] + off;
            const float a = fmaxf(__expf(cc), 1e-30f)  , bq = __builtin_amdgcn_rcpf(a), kb = kv * bq;
            kt[i] = kb * etot;
            gla::st_sw(Qh, tau, k, qv * a); gla::st_sw(Kt, tau, k, kb); }
        { att::u32x4 wv = {att::cvtpk(kt[0], kt[1]), att::cvtpk(kt[2], kt[3]), att::cvtpk(kt[4], kt[5]), att::cvtpk(kt[6], kt[7])};
          *(att::u32x4*)(KtT + KSWZ64(k, seg * 16)) = wv; }
        if (sg == 0) Dec[k] = etot;
        __syncthreads();
        att::f32x16 o = {};
        int tau_q = mt * 32 + r32; asm volatile("" : "+v"(tau_q));
        { att::bf16x8 qr[4]; gla::afrag4(Qh, tau_q, hi, qr);
          att::f32x16 p0, p1; att::qkt(p0, p1, (const bf16*)Kt, qr, r32, hi);
#pragma unroll
          for (int r = 0; r < 16; ++r) { const int t0 = att::crow(r, hi), t1 = 32 + t0;
              const bool k0 = dir == 0 ? (t0 <= tau_q) : (t0 >= tau_q), k1 = dir == 0 ? (t1 <= tau_q) : (t1 >= tau_q);
              p0[r] = k0 ? p0[r] : 0.f; p1[r] = k1 ? p1[r] : 0.f; }
          att::bf16x8 pa0, pa1, pa2, pa3; att::pack_p(p0, p1, pa0, pa1, pa2, pa3);
          gla::pv_sel(d0, o, vbV, pa0, pa1, pa2, pa3);
          gla::pv_sel(d0, o, vbS, qr[0], qr[1], qr[2], qr[3]); }
#pragma unroll
        for (int r = 0; r < 16; ++r) S[r] *= Dec[mt * 32 + att::crow(r, hi)];
        { att::bf16x8 a[4]; gla::afrag4(KtT, mt * 32 + r32, hi, a); gla::pv_sel(d0, S, vbV, a[0], a[1], a[2], a[3]); }
        GAS bf16* op = (GAS bf16*)(OG + row0 * 512 + h * 128 + d0 * 32 + r32);
#pragma unroll
        for (int r = 0; r < 16; ++r) op[(size_t)(mt * 32 + att::crow(r, hi)) * 512] = (bf16)(att::cvtpk(o[r], 0.f) & 0xffffu);
        __syncthreads();
    }
}
__device__ __forceinline__ void p3_mixer(Frame& F, int l) {
    refresh(F);
    for (int ch = F.blk; ch < NBATCH * 8; ch += F.G) gla_chain(F, l, ch);
    const bf16* P = (const bf16*)(F.ws + WS_PROJ); bf16* OD = (bf16*)(F.ws + WS_OD);
    volatile LAS unsigned* slot = F.MISC + 24;
    int myq = F.blk & 7, tries = 0;
    for (;;) {
        __syncthreads();
        if (F.tid == 0) slot[0] = __hip_atomic_fetch_add((unsigned*)((gu32*)F.ws + CW_Q + 64 * l + 8 * 0 + myq), 1u, __ATOMIC_RELAXED, __HIP_MEMORY_SCOPE_AGENT);
        __syncthreads();
        const int u = (int)slot[0];
        if (u >= (l == DEPTH - 1 ? 128 : 144)) { if (++tries >= 8) break; myq = (myq + 1) & 7; continue; }
        int g, qt;
        if (u < 128) { const int pi = u >> 4, mp = (u >> 3) & 1; g = ((pi * 8 + myq) << 1) + mp; qt = 1 + (u & 7); }
        else { const int gi = u - 128; g = (((gi >> 1) * 8 + myq) << 1) + (gi & 1); qt = 0; }
        const int b = g >> 3, hh = g & 7;
        const size_t row0 = (size_t)b * TPB;
        att::attn_unit(P + (row0 + qt * 256) * NP + C_Q + hh * 64, P + row0 * NP + C_K + hh * 64, P + row0 * NP + C_V + (hh >> 1) * 128,
                       OD + (row0 + qt * 256) * DM + hh * 128, qt == 0 ? CTX : TPB, (char*)F.lds, F.tid);
    }
    __syncthreads();
}
__device__ __forceinline__ void p5_merge_all(Frame& F, int l) {
    refresh(F);
    const bf16* OD = (const bf16*)(F.ws + WS_OD); const bf16* OG = (const bf16*)(F.ws + WS_OG); const bf16* P = (const bf16*)(F.ws + WS_PROJ); bf16* MRG = (bf16*)(F.ws + WS_H);
    const float lam = ((const float*)(F.ws + WS_ROPE + 16384))[l]; const float omli = 1.f - lam_init_of(l);
    const float* subln = INP(14) + l * 128; const float* onorm = INP(15) + l * 128;
    const int h = F.lane >> 4, c0 = (F.lane & 15) * 8;
    const int rpw = (M + F.NGW - 1) / F.NGW, r0 = F.gw * rpw, r1 = (r0 + rpw < M) ? r0 + rpw : M;
    for (int r = r0; r < r1; ++r) {
        const v4u a = *(const v4u*)(OD + (size_t)r * DM + h * 256 + c0), bq = *(const v4u*)(OD + (size_t)r * DM + h * 256 + 128 + c0);
        const v4u gf = *(const v4u*)(OG + (size_t)r * 512 + h * 128 + c0), gbk = *(const v4u*)(OG + ((size_t)M + r) * 512 + h * 128 + c0);
        const v4u gt = *(const v4u*)(P + (size_t)r * NP + C_GG + h * 128 + c0);
        float d[8], e[8], g[8];
        d[0] = bflo(a.x) - lam * bflo(bq.x); d[1] = bfhi(a.x) - lam * bfhi(bq.x); d[2] = bflo(a.y) - lam * bflo(bq.y); d[3] = bfhi(a.y) - lam * bfhi(bq.y);
        d[4] = bflo(a.z) - lam * bflo(bq.z); d[5] = bfhi(a.z) - lam * bfhi(bq.z); d[6] = bflo(a.w) - lam * bflo(bq.w); d[7] = bfhi(a.w) - lam * bfhi(bq.w);
        e[0] = bflo(gf.x) + bflo(gbk.x); e[1] = bfhi(gf.x) + bfhi(gbk.x); e[2] = bflo(gf.y) + bflo(gbk.y); e[3] = bfhi(gf.y) + bfhi(gbk.y);
        e[4] = bflo(gf.z) + bflo(gbk.z); e[5] = bfhi(gf.z) + bfhi(gbk.z); e[6] = bflo(gf.w) + bflo(gbk.w); e[7] = bfhi(gf.w) + bfhi(gbk.w);
        g[0] = bflo(gt.x); g[1] = bfhi(gt.x); g[2] = bflo(gt.y); g[3] = bfhi(gt.y); g[4] = bflo(gt.z); g[5] = bfhi(gt.z); g[6] = bflo(gt.w); g[7] = bfhi(gt.w);
        float ss = 0.f, se = 0.f;
#pragma unroll
        for (int i = 0; i < 8; ++i) { ss += d[i] * d[i]; se += e[i] * e[i]; }
        ss = xadd<1>(ss); ss = xadd<2>(ss); ss = xadd<4>(ss); ss = xadd<8>(ss);
        se = xadd<1>(se); se = xadd<2>(se); se = xadd<4>(se); se = xadd<8>(se);
        const float sc = omli / sqrtf(ss * (1.f / 128.f) + EPS), se2 = 1.0f / sqrtf(se * (1.f / 128.f) + EPS);
#pragma unroll
        for (int i = 0; i < 8; ++i) { d[i] = d[i] * sc * subln[c0 + i]; e[i] = e[i] * se2 * onorm[c0 + i] * siluf(g[i]); }
        v4u w; w.x = pg8::cvt_pk_bf16(d[0], d[1]); w.y = pg8::cvt_pk_bf16(d[2], d[3]); w.z = pg8::cvt_pk_bf16(d[4], d[5]); w.w = pg8::cvt_pk_bf16(d[6], d[7]);
        *(v4u*)(MRG + (size_t)r * DM + h * 128 + c0) = w;
        v4u x; x.x = pg8::cvt_pk_bf16(e[0], e[1]); x.y = pg8::cvt_pk_bf16(e[2], e[3]); x.z = pg8::cvt_pk_bf16(e[4], e[5]); x.w = pg8::cvt_pk_bf16(e[6], e[7]);
        *(v4u*)(MRG + (size_t)r * DM + 512 + h * 128 + c0) = x;
    }
}

__device__ __forceinline__ float dpp_sum16(float v) {
    v += __int_as_float(__builtin_amdgcn_update_dpp(0, __float_as_int(v), 0xB1, 0xF, 0xF, true));
    v += __int_as_float(__builtin_amdgcn_update_dpp(0, __float_as_int(v), 0x4E, 0xF, 0xF, true));
    v += __int_as_float(__builtin_amdgcn_update_dpp(0, __float_as_int(v), 0x141, 0xF, 0xF, true));
    v += __int_as_float(__builtin_amdgcn_update_dpp(0, __float_as_int(v), 0x140, 0xF, 0xF, true));
    return v;
}
__device__ __forceinline__ float wave_sum2(float v) { v = dpp_sum16(v); v = xadd<16>(v); v = xadd<32>(v); return v; }
__device__ __forceinline__ float row_rinv2(const f32x4 (&v)[4]) {
    float s = 0.f;
#pragma unroll
    for (int j = 0; j < 4; ++j) s += (v[j][0] * v[j][0] + v[j][1] * v[j][1]) + (v[j][2] * v[j][2] + v[j][3] * v[j][3]);
    return __builtin_amdgcn_rsqf(wave_sum2(s) * (1.f / DM) + EPS);
}
__device__ __forceinline__ void ld_raw_bf16(const bf16* row, int lane, u32x2 (&v)[4]) {
#pragma unroll
    for (int j = 0; j < 4; ++j) v[j] = *(const u32x2*)(row + 4 * lane + 256 * j);
}
__device__ __forceinline__ f32x4 raw2f(u32x2 w) { return (f32x4){bflo(w.x), bfhi(w.x), bflo(w.y), bfhi(w.y)}; }
__device__ __forceinline__ void ld_vec(const float* p, int lane, f32x4 (&v)[4]) {
#pragma unroll
    for (int j = 0; j < 4; ++j) v[j] = *(const f32x4*)(p + 4 * lane + 256 * j);
}

__device__ __forceinline__ void p1_rows(Frame& F, int l) {
    refresh(F);
    const float* MOD = (const float*)(F.ws + WS_MOD);
    bf16* X = (bf16*)(F.ws + WS_X); bf16* H = (bf16*)(F.ws + WS_H); const bf16* F2 = (const bf16*)(F.ws + WS_F2);
    const int rpw = (M + F.NGW - 1) / F.NGW, r0 = F.gw * rpw, r1 = (r0 + rpw < M) ? r0 + rpw : M;
    if (r0 >= r1) return;
    const bool two = l > 0 && ((l - 1) & 1);
    f32x4 gpre[4], gpost[4], sh[4], sc[4], gt[4];
    ld_vec(INP(6) + l * DM, F.lane, gpre);
    if (l > 0) ld_vec(INP(9) + (l - 1) * DM, F.lane, gpost);
    int cur = -1;
    f32x4 xn[4]; u32x2 xr[4], fn[4], gn[4];
#define P1_ISSUE(r) do { const int b_ = (r) / TPB, p_ = (r) % TPB; \
        if (l == 0) ld_row_f32(p_ < CTX ? INP(2) + ((size_t)b_ * CTX + p_) * DM : INP(0) + ((size_t)b_ * SEQ + (p_ - CTX)) * DM, F.lane, xn); \
        else ld_raw_bf16(X + (size_t)(r) * DM, F.lane, xr); \
        if (l > 0) { ld_raw_bf16(F2 + (size_t)(r) * DM, F.lane, fn); if (two) ld_raw_bf16(F2 + ((size_t)M + (r)) * DM, F.lane, gn); } } while (0)
    P1_ISSUE(r0);
    for (int r = r0; r < r1; ++r) {
        f32x4 x[4]; u32x2 fr[4], gr[4];
#pragma unroll
        for (int j = 0; j < 4; ++j) { x[j] = (l == 0) ? xn[j] : raw2f(xr[j]); fr[j] = fn[j]; gr[j] = gn[j]; }
        if (r + 1 < r1) P1_ISSUE(r + 1);
        const int b = r / TPB, p = r % TPB, mrow = p < CTX ? 16 : b;
        if (mrow != cur) { cur = mrow; const float* modp = MOD + ((size_t)l * 17 + mrow) * 6144; ld_vec(modp, F.lane, sh); ld_vec(modp + 1024, F.lane, sc);
            if (l > 0) ld_vec(MOD + ((size_t)(l - 1) * 17 + mrow) * 6144 + 5 * 1024, F.lane, gt); }
        if (l > 0) {
            f32x4 f[4];
#pragma unroll
            for (int j = 0; j < 4; ++j) { f[j] = raw2f(fr[j]); if (two) f[j] = f[j] + raw2f(gr[j]); }
            const float rinv = row_rinv2(f);
#pragma unroll
            for (int j = 0; j < 4; ++j) x[j] = x[j] + gt[j] * (f[j] * rinv * gpost[j]);
        }
        st_row_bf16(X + (size_t)r * DM, F.lane, x);
        const float rinv = row_rinv2(x);
        f32x4 h[4];
#pragma unroll
        for (int j = 0; j < 4; ++j) h[j] = (x[j] * rinv * gpre[j]) * (sc[j] + 1.0f) + sh[j];
        st_row_bf16(H + (size_t)r * DM, F.lane, h);
    }
#undef P1_ISSUE
}
__device__ __forceinline__ void pf_final(Frame& F) {
    refresh(F);
    const float* MOD = (const float*)(F.ws + WS_MOD);
    const bf16* X = (const bf16*)(F.ws + WS_X); const bf16* F2 = (const bf16*)(F.ws + WS_F2);
    const int l = DEPTH - 1, NR = NBATCH * SEQ;
    const int rpw = (NR + F.NGW - 1) / F.NGW, i0 = F.gw * rpw, i1 = (i0 + rpw < NR) ? i0 + rpw : NR;
    if (i0 >= i1) return;
    f32x4 gpost[4], gt[4]; ld_vec(INP(9) + l * DM, F.lane, gpost);
    int cur = -1;
    u32x2 xn[4], fn[4], gn[4];
#define PF_ISSUE(i) do { const size_t r_ = (size_t)((i) / SEQ) * TPB + CTX + (i) % SEQ; ld_raw_bf16(X + r_ * DM, F.lane, xn); ld_raw_bf16(F2 + r_ * DM, F.lane, fn); ld_raw_bf16(F2 + ((size_t)M + r_) * DM, F.lane, gn); } while (0)
    PF_ISSUE(i0);
    for (int i = i0; i < i1; ++i) {
        f32x4 x[4], f[4];
#pragma unroll
        for (int j = 0; j < 4; ++j) { x[j] = raw2f(xn[j]); f[j] = raw2f(fn[j]) + raw2f(gn[j]); }
        if (i + 1 < i1) PF_ISSUE(i + 1);
        const int b = i / SEQ;
        if (b != cur) { cur = b; ld_vec(MOD + ((size_t)l * 17 + b) * 6144 + 5 * 1024, F.lane, gt); }
        const float rinv = row_rinv2(f);
#pragma unroll
        for (int j = 0; j < 4; ++j) x[j] = x[j] + gt[j] * (f[j] * rinv * gpost[j]);
        st_row_f32(F.A->out + (size_t)i * DM, F.lane, x);
    }
#undef PF_ISSUE
}
__device__ __forceinline__ void p7_rows(Frame& F, int l) {
    refresh(F);
    const float* MOD = (const float*)(F.ws + WS_MOD);
    bf16* X = (bf16*)(F.ws + WS_X); const bf16* Y = (const bf16*)(F.ws + WS_Y); bf16* H2 = (bf16*)(F.ws + WS_H2);
    const bool moe = l & 1; const int li = l >> 1;
    int* TOPE = (int*)(F.ws + WS_TOPE); int* LIDX = (int*)(F.ws + WS_LIDX); float* TOPW = (float*)(F.ws + WS_TOPW); int* BLKB = (int*)(F.ws + WS_BLKB);
    volatile LAS unsigned* LCNT = F.MISC + 16;
    LAS float* RT = (LAS float*)F.lds;
    if (moe) {
        const float* router = INP(20) + (size_t)li * DM * NE;
        if (F.tid < 8) LCNT[F.tid] = 0u;
        for (int i = F.tid; i < DM * NE / 4; i += 512) *(LAS f32x4*)(RT + 4 * i) = *(const f32x4*)(router + 4 * i);
        __syncthreads();
    }
    const bool lastl = (l == DEPTH - 1); const int NR = lastl ? NBATCH * SEQ : M;
#define P7_ROW(i) (lastl ? ((i) / SEQ) * TPB + CTX + (i) % SEQ : (i))
    const int rpw = (NR + F.NGW - 1) / F.NGW, r0 = F.gw * rpw, r1 = (r0 + rpw < NR) ? r0 + rpw : NR;
    if (r0 < r1) {
        f32x4 gpost[4], gpre[4], gt[4], sh[4], sc[4];
        ld_vec(INP(7) + l * DM, F.lane, gpost); ld_vec(INP(8) + l * DM, F.lane, gpre);
        int cur = -1;
        u32x2 xn[4], yn[4];
        ld_raw_bf16(X + (size_t)P7_ROW(r0) * DM, F.lane, xn); ld_raw_bf16(Y + (size_t)P7_ROW(r0) * DM, F.lane, yn);
        for (int ri = r0; ri < r1; ++ri) {
            const int r = P7_ROW(ri);
            f32x4 x[4], y[4];
#pragma unroll
            for (int j = 0; j < 4; ++j) { x[j] = raw2f(xn[j]); y[j] = raw2f(yn[j]); }
            if (ri + 1 < r1) { const int rn = P7_ROW(ri + 1); ld_raw_bf16(X + (size_t)rn * DM, F.lane, xn); ld_raw_bf16(Y + (size_t)rn * DM, F.lane, yn); }
            const int b = r / TPB, p = r % TPB, mrow = p < CTX ? 16 : b;
            if (mrow != cur) { cur = mrow; const float* modp = MOD + ((size_t)l * 17 + mrow) * 6144; ld_vec(modp + 2 * 1024, F.lane, gt); ld_vec(modp + 3 * 1024, F.lane, sh); ld_vec(modp + 4 * 1024, F.lane, sc); }
            const float ry = row_rinv2(y);
#pragma unroll
            for (int j = 0; j < 4; ++j) x[j] = x[j] + gt[j] * (y[j] * ry * gpost[j]);
            st_row_bf16(X + (size_t)r * DM, F.lane, x);
            const float rx = row_rinv2(x);
            f32x4 h[4];
#pragma unroll
            for (int j = 0; j < 4; ++j) h[j] = (x[j] * rx * gpre[j]) * (sc[j] + 1.0f) + sh[j];
            if constexpr (FFN_F8) {
#pragma unroll
                for (int j = 0; j < 4; ++j) *(unsigned*)((unsigned char*)H2 + (size_t)r * DM + 4 * F.lane + 256 * j) = pk4_f8(h[j][0], h[j][1], h[j][2], h[j][3]);
            } else st_row_bf16(H2 + (size_t)r * DM, F.lane, h);
            if (moe) {
                float lg[8];
#pragma unroll
                for (int e = 0; e < 8; ++e) lg[e] = 0.f;
#pragma unroll
                for (int j = 0; j < 4; ++j)
#pragma unroll
                    for (int i = 0; i < 4; ++i) { const int cidx = 4 * F.lane + 256 * j + i; const f32x4 q0 = *(const LAS f32x4*)(RT + cidx * 8), q1 = *(const LAS f32x4*)(RT + cidx * 8 + 4); const float hv = h[j][i];
                        lg[0] += hv * q0[0]; lg[1] += hv * q0[1]; lg[2] += hv * q0[2]; lg[3] += hv * q0[3]; lg[4] += hv * q1[0]; lg[5] += hv * q1[1]; lg[6] += hv * q1[2]; lg[7] += hv * q1[3]; }
#pragma unroll
                for (int e = 0; e < 8; ++e) lg[e] = wave_sum2(lg[e]);
                int e0 = 0; float v0 = lg[0];
#pragma unroll
                for (int e = 1; e < 8; ++e) if (lg[e] > v0) { v0 = lg[e]; e0 = e; }
                int e1 = -1; float v1 = -3.0e38f;
#pragma unroll
                for (int e = 0; e < 8; ++e) if (e != e0 && lg[e] > v1) { v1 = lg[e]; e1 = e; }
                const float ex = __expf(v1 - v0), w0 = 1.f / (1.f + ex), w1 = ex / (1.f + ex);
                if (F.lane == 0) {
                    const unsigned i0 = __hip_atomic_fetch_add((LAS unsigned*)&LCNT[e0], 1u, __ATOMIC_RELAXED, __HIP_MEMORY_SCOPE_WORKGROUP), i1 = __hip_atomic_fetch_add((LAS unsigned*)&LCNT[e1], 1u, __ATOMIC_RELAXED, __HIP_MEMORY_SCOPE_WORKGROUP);
                    TOPE[r] = e0 | (e1 << 8); LIDX[2 * r] = (int)i0; LIDX[2 * r + 1] = (int)i1; TOPW[2 * r] = w0; TOPW[2 * r + 1] = w1;
                }
            }
        }
    }
    if (moe) {
        __syncthreads();
        if (F.tid < 8) { const unsigned base = __hip_atomic_fetch_add((unsigned*)((gu32*)F.ws + CW_CNT + 64 * li + F.tid), LCNT[F.tid], __ATOMIC_RELAXED, __HIP_MEMORY_SCOPE_AGENT); BLKB[F.blk * 8 + F.tid] = (int)base; }
    }
#undef P7_ROW
}
__device__ __forceinline__ void moe_offsets(Frame& F, int li, int (&cnt)[8], int (&off)[9]) {
    off[0] = 0;
#pragma unroll
    for (int e = 0; e < 8; ++e) { cnt[e] = (int)__hip_atomic_load((unsigned*)(((gu32*)F.ws) + CW_CNT + 64 * li + e), __ATOMIC_RELAXED, __HIP_MEMORY_SCOPE_AGENT); off[e + 1] = off[e] + ((cnt[e] + 255) & ~255); }
}
__device__ __forceinline__ void p7b_gather(Frame& F, int l) {
    refresh(F);
    const int li = l >> 1; int cnt[8], off[9]; moe_offsets(F, li, cnt, off);
    const bf16* H2 = (const bf16*)(F.ws + WS_H2); bf16* HG = (bf16*)(F.ws + WS_HG);
    const int* TOPE = (const int*)(F.ws + WS_TOPE); const int* LIDX = (const int*)(F.ws + WS_LIDX); const float* TOPW = (const float*)(F.ws + WS_TOPW); const int* BLKB = (const int*)(F.ws + WS_BLKB);
    int* RMAP = (int*)(F.ws + WS_RMAP); float* ROWW = (float*)(F.ws + WS_ROWW);
    constexpr int RB = FFN_F8 ? DM : 2 * DM, LB = RB / 64;
    const unsigned char* H2b = (const unsigned char*)H2; unsigned char* HGb = (unsigned char*)HG;
    const bool lastl = (l == DEPTH - 1); const int NR = lastl ? NBATCH * SEQ : M;
    const int rpw = (NR + F.NGW - 1) / F.NGW, r0 = F.gw * rpw, r1 = (r0 + rpw < NR) ? r0 + rpw : NR;
    for (int ri = r0; ri < r1; ++ri) {
        const int r = lastl ? (ri / SEQ) * TPB + CTX + ri % SEQ : ri;
        const int te = TOPE[r];
        v4u a, bq = {0u, 0u, 0u, 0u}; a = *(const v4u*)(H2b + (size_t)r * RB + F.lane * LB); if constexpr (!FFN_F8) bq = *(const v4u*)(H2b + (size_t)r * RB + F.lane * LB + 16);
#pragma unroll
        for (int s = 0; s < 2; ++s) {
            const int e = (te >> (8 * s)) & 0xff;
            int o = 0;
#pragma unroll
            for (int q = 0; q < 8; ++q) o = (q == e) ? off[q] : o;
            const int pos = o + BLKB[F.blk * 8 + e] + LIDX[2 * r + s];
            *(v4u*)(HGb + (size_t)pos * RB + F.lane * LB) = a; if constexpr (!FFN_F8) *(v4u*)(HGb + (size_t)pos * RB + F.lane * LB + 16) = bq;
            if (F.lane == 0) { RMAP[pos] = r | (s << 30); ROWW[pos] = TOPW[2 * r + s]; }
        }
    }
#pragma unroll
    for (int e = 0; e < 8; ++e) {
        const int npad = off[e + 1] - off[e] - cnt[e];
        for (int i = F.gw; i < npad; i += F.NGW) { const int pos = off[e] + cnt[e] + i; const unsigned zz = (unsigned)F.z; const v4u z = {zz, zz, zz, zz};
            *(v4u*)(HGb + (size_t)pos * RB + F.lane * LB) = z; if constexpr (!FFN_F8) *(v4u*)(HGb + (size_t)pos * RB + F.lane * LB + 16) = z;
            if (F.lane == 0) { RMAP[pos] = -1; ROWW[pos] = 0.f; } }
    }
}

__global__ void __launch_bounds__(NWAVES * 64, 2) mk_fwd(Args args) {
    extern __shared__ __attribute__((aligned(16))) unsigned char lds[];
    Frame F;
    F.lds = (LAS unsigned char*)lds;
    F.MISC = (volatile LAS unsigned*)(F.lds + MISC_OFF);
    F.tid = threadIdx.x; F.lane = F.tid & 63; F.wave = __builtin_amdgcn_readfirstlane(F.tid >> 6); F.wv = F.wave;
    F.G = gridDim.x; F.blk = blockIdx.x; F.gw = F.blk * NWAVES + F.wave; F.NGW = F.G * NWAVES;
    F.ws = args.ws;
    F.A = &args;
    for (int u = F.tid; u < 128; u += NWAVES * 64) F.MISC[u] = 0u;
    __syncthreads();
    { XcdBarrier b0 = xcd_barrier_post((unsigned*)F.ws + CW_BAR, F.MISC + 8); (void)b0; }
#define GRID_BAR() do { XcdBarrier b_; b_.bar = (unsigned*)F.ws + CW_BAR; b_.x = xb_xcc_id(); b_.st = F.MISC + 8; refresh(F); xcd_barrier(b_, F.tid == 0); } while (0)

    p0_mod(F); p0_misc(F); convert_weights(F, 0);
    GRID_BAR();
    for (int l = 0; l < DEPTH; ++l) {
        const bool moe = l & 1; const int li = l >> 1;
        { unsigned char* wsp = args.ws; asm volatile("" : "+s"(wsp)); F.ws = wsp; }
        p1_rows(F, l);
        if (l > 0) convert_weights(F, l);
        GRID_BAR();
        {
            refresh(F);
            pg8::Gemm g{(const pg8::bf16_t*)(F.ws + WS_H), (const pg8::bf16_t*)(F.ws + WS_WIN), M, NP, DM};
            pg8::StaticOrder S; S.init(M, NP, F.G, F.blk);
            pg8::EpiProj E{(pg8::bf16_t*)(F.ws + WS_PROJ), (const float*)(F.ws + WS_ROPE), (const float*)(F.ws + WS_ROPE) + 1024};
            pg8::gemm_phase<pg8::EpiProj, pg8::StaticOrder, true, true>(F.lds, g, S, E, F.wave);
        }
        GRID_BAR();
        p3_mixer(F, l);
        GRID_BAR();
        p5_merge_all(F, l);
        GRID_BAR();
        {
            refresh(F);
            pg8::Gemm g{(const pg8::bf16_t*)(F.ws + WS_H), (const pg8::bf16_t*)(F.ws + WS_WOUT), M, DM, DM};
            const int lastl = (l == DEPTH - 1);
            pg8::LatOrder S; S.S.init(lastl ? NBATCH * SEQ : M, DM, F.G, F.blk); S.lat = lastl;
            pg8::EpiF32 E{(pg8::bf16_t*)(F.ws + WS_Y)};
            pg8::gemm_phase<pg8::EpiF32, pg8::LatOrder, true, true>(F.lds, g, S, E, F.wave);
        }
        GRID_BAR();
        p7_rows(F, l);
        GRID_BAR();
        if (moe) { p7b_gather(F, l); GRID_BAR(); }
        int ntiles = M / 256;
        {
            refresh(F);
            LAS int* texp = (LAS int*)(F.lds + TEXP_OFF);
            if (moe) { int cnt[8], off[9]; moe_offsets(F, li, cnt, off); ntiles = off[8] >> 8;
                for (int t = F.tid; t < ntiles; t += 512) { int e = 0;
#pragma unroll
                    for (int q = 1; q < 8; ++q) e += ((t << 8) >= off[q]) ? 1 : 0;
                    texp[t] = e; } }
            else { for (int t = F.tid; t < ntiles; t += 512) texp[t] = 0; }
            __syncthreads();
        }
        {
            refresh(F);
            pg8::Gemm g{(const pg8::bf16_t*)(F.ws + (moe ? WS_HG : WS_H2)), (const pg8::bf16_t*)(F.ws + WS_WUP), ntiles * 256, 2 * DFF, FFN_F8 ? DM / 2 : DM};
            pg8::GroupedOrder S; S.S.init(ntiles * 256, 2 * DFF, F.G, F.blk); S.texp = (const LAS int*)(F.lds + TEXP_OFF); S.nN = 22;
            pg8::EpiSwiglu E{(pg8::bf16_t*)(F.ws + WS_U)};
            pg8::gemm_phase<pg8::EpiSwiglu, pg8::GroupedOrder, true, true, FFN_F8 != 0>(F.lds, g, S, E, F.wave);
        }
        GRID_BAR();
        {
            refresh(F);
            pg8::Gemm g{(const pg8::bf16_t*)(F.ws + WS_U), (const pg8::bf16_t*)(F.ws + WS_WDN), ntiles * 256, DM, FFN_F8 ? DFF / 2 : DFF};
            pg8::GroupedOrder S; S.S.init(ntiles * 256, DM, F.G, F.blk); S.texp = (const LAS int*)(F.lds + TEXP_OFF); S.nN = 4;
            pg8::EpiDown E{(pg8::bf16_t*)(F.ws + WS_F2), (const int*)(F.ws + WS_RMAP), (const float*)(F.ws + WS_ROWW), moe ? 0 : 1};
            pg8::gemm_phase<pg8::EpiDown, pg8::GroupedOrder, true, true, FFN_F8 != 0>(F.lds, g, S, E, F.wave);
        }
        GRID_BAR();
    }
    pf_final(F);
}

extern "C" void kernel_launch(void* const* d_in, const int* in_sizes, int n_in, void* d_out, int out_size, void* d_ws, size_t ws_size, hipStream_t stream) {
    static int grid = 0;
    if (grid == 0) {
        if (n_in != 24 || out_size != NBATCH * SEQ * DM || ws_size < WS_END) { fprintf(stderr, "kernel_launch: unexpected shapes or workspace (%d inputs, out %d, ws %zu < %zu)\n", n_in, out_size, ws_size, (size_t)WS_END); grid = -1; return; }
        int dev = 0, cus = 0, per_cu = 0;
        if (hipGetDevice(&dev) != hipSuccess || hipDeviceGetAttribute(&cus, hipDeviceAttributeMultiprocessorCount, dev) != hipSuccess) { grid = -1; return; }
        if (hipFuncSetAttribute((const void*)mk_fwd, hipFuncAttributeMaxDynamicSharedMemorySize, LDS_BYTES) != hipSuccess) { grid = -1; return; }
        if (hipOccupancyMaxActiveBlocksPerMultiprocessor(&per_cu, (const void*)mk_fwd, NWAVES * 64, LDS_BYTES) != hipSuccess || per_cu < 1) { fprintf(stderr, "kernel_launch: occupancy query says %d\n", per_cu); }
        (void)hipGetLastError();
        grid = cus;
    }
    if (grid < 0) return;
    if (hipMemsetAsync((char*)d_ws + WS_CTL, 0, CTL_ZERO_BYTES, stream) != hipSuccess) return;
    Args a{};
    for (int i = 0; i < 24; ++i) a.in[i] = (const float*)d_in[i];
    a.out = (float*)d_out; a.ws = (unsigned char*)d_ws;
    hipLaunchKernelGGL(mk_fwd, dim3(grid), dim3(NWAVES * 64), LDS_BYTES, stream, a);
}
```

```cpp
#include <hip/hip_runtime.h>
#include <cstdio>
#include <cstdint>
namespace pg8 {
#define PG8_LAS __attribute__((address_space(3)))
typedef unsigned short bf16_t;
__device__ __forceinline__ int lane_id_opaque() { int l; asm volatile("v_mbcnt_lo_u32_b32 %0, -1, 0\n\tv_mbcnt_hi_u32_b32 %0, -1, %0" : "=v"(l)); return l; }
typedef short bf16x8 __attribute__((ext_vector_type(8)));
typedef float f32x4 __attribute__((ext_vector_type(4)));
typedef unsigned u32x4 __attribute__((ext_vector_type(4)));
constexpr int BM = 256, BK = 64, HALF = 128, HTB = HALF * BK * 2  , STAGE_BYTES = 8 * HTB, NXCD = 8, WGM = 8;

__host__ __device__ __forceinline__ int lds_byte(int r, int c) { const int st = (r >> 4) * 2 + (c >> 5), rr = r & 15, cc = c & 31, ob = rr * 64 + cc * 2; return st * 1024 + (ob ^ (((ob >> 9) & 1) << 5)); }
__host__ __device__ __forceinline__ void stage_rc(int b, int& R, int& C) { const int st = b / 1024, sb = b % 1024, swz = sb ^ (((sb >> 9) & 1) << 5); R = (st >> 1) * 16 + swz / 64; C = (st & 1) * 32 + (swz % 64) / 2; }
__host__ __device__ __forceinline__ int perm32(int rho) { const int n = rho >> 4, i = rho & 15; return 8 * (i >> 2) + 4 * n + (i & 3); }

struct Unit { int pm, pn; };
struct Gemm { const bf16_t* A; const bf16_t* Bt; int M, N, K; };

struct StaticOrder {
    int nM, nN, nwg, G, c;
    __host__ __device__ void init(int M, int N, int G_, int c_) { nM = M / BM; nN = N / BM; nwg = nM * nN; G = G_; c = c_; }
    __host__ __device__ bool next(int i, Unit& u) const {
        const long L = (long)i * G + c; if (L >= nwg) return false;
        int wgid = (int)L; { const int q = nwg / NXCD, r = nwg % NXCD, xcd = wgid % NXCD, off = wgid / NXCD; wgid = (xcd < r ? xcd * (q + 1) : r * (q + 1) + (xcd - r) * q) + off; }
        const int nig = WGM * nN, gid = wgid / nig, fm = gid * WGM, gsz = (nM - fm) < WGM ? (nM - fm) : WGM;
        u.pm = fm + ((wgid % nig) % gsz); u.pn = (wgid % nig) / gsz; return true;
    }
    __device__ __forceinline__ void a_ready(const Unit&) const {}
    __device__ __forceinline__ void done(const Unit&) const {}
};

__device__ __forceinline__ unsigned cvt_pk_bf16(float lo, float hi) { unsigned r; asm volatile("v_cvt_pk_bf16_f32 %0, %1, %2" : "=v"(r) : "v"(lo), "v"(hi)); return r; }
typedef float f32x2 __attribute__((ext_vector_type(2)));
template <class Epi, class Sched, bool ALIGN_EPI = false, bool SP2 = false, bool F8 = false>
__device__ __forceinline__ void gemm_phase(PG8_LAS unsigned char* lds, const Gemm g, const Sched& S, const Epi& E, const int wv  ) {
    int tid_ = wv * 64 + lane_id_opaque();
    const int tid = tid_, wid = __builtin_amdgcn_readfirstlane(tid >> 6), lane = tid & 63, wr = wid >> 2, wc = wid & 3, fr = lane & 15, fq = lane >> 4;
    const int K = g.K, nt = K / BK;
    unsigned voffA[2], voffB[2];
#pragma unroll
    for (int i = 0; i < 2; ++i) { int R, C; stage_rc(tid * 16 + i * 8192, R, C); const int Rb = Epi::PERM ? ((R & ~31) + perm32(R & 31)) : R;
        voffA[i] = (unsigned)(R * K + C) * 2u; voffB[i] = (unsigned)(Rb * K + C) * 2u; }
    const size_t kstep = (size_t)(BK * 2);
    const size_t hstep = (size_t)HALF * K * 2;
    const size_t tstep = 2 * hstep;
    const unsigned ldsw = (unsigned)wid * 1024u;
    const int aoff = lds_byte(wr * 64 + fr, fq * 8), boff = lds_byte(wc * 32 + fr, fq * 8);
#define PG8_SA(b, h) (((b) * 2 + (h)) * HTB)
#define PG8_SB(b, h) ((4 + (b) * 2 + (h)) * HTB)
#define PG8_STAGE(bufoff, gbase, voff) do { _Pragma("unroll") for (int _i = 0; _i < 2; ++_i) \
        __builtin_amdgcn_global_load_lds((const __attribute__((address_space(1))) unsigned*)((const __attribute__((address_space(1))) char*)(gbase) + (voff)[_i]), (PG8_LAS unsigned*)(lds + (bufoff) + ldsw + _i * 8192), 16, 0, 0); } while (0)
#define PG8_LDA(dst, b, h) do { _Pragma("unroll") for (int m = 0; m < 4; ++m) _Pragma("unroll") for (int k = 0; k < 2; ++k) dst[m][k] = *(const PG8_LAS bf16x8*)(lds + PG8_SA(b, h) + aoff + m * 2048 + k * 1024); } while (0)
#define PG8_LDB(dst, b, h) do { _Pragma("unroll") for (int n = 0; n < 2; ++n) _Pragma("unroll") for (int k = 0; k < 2; ++k) dst[n][k] = *(const PG8_LAS bf16x8*)(lds + PG8_SB(b, h) + boff + n * 2048 + k * 1024); } while (0)
#define PG8_MMA(ai, bj, At, Bt) do { if constexpr (F8) __builtin_amdgcn_sched_barrier(0); __builtin_amdgcn_s_setprio(1); _Pragma("unroll") for (int m = 0; m < 4; ++m) _Pragma("unroll") for (int n = 0; n < 2; ++n) { \
        if constexpr (F8) { typedef int i32x4_ __attribute__((ext_vector_type(4))); \
            acc[ai][bj][m][n] = __builtin_amdgcn_mfma_scale_f32_16x16x128_f8f6f4(__builtin_shufflevector(__builtin_bit_cast(i32x4_, Bt[n][0]), __builtin_bit_cast(i32x4_, Bt[n][1]), 0, 1, 2, 3, 4, 5, 6, 7), \
                __builtin_shufflevector(__builtin_bit_cast(i32x4_, At[m][0]), __builtin_bit_cast(i32x4_, At[m][1]), 0, 1, 2, 3, 4, 5, 6, 7), acc[ai][bj][m][n], 0, 0, 0, 0x7f7f7f7f, 0, 0x7f7f7f7f); } \
        else { _Pragma("unroll") for (int k = 0; k < 2; ++k) acc[ai][bj][m][n] = __builtin_amdgcn_mfma_f32_16x16x32_bf16(Bt[n][k], At[m][k], acc[ai][bj][m][n], 0, 0, 0); } } \
        __builtin_amdgcn_s_setprio(0); if constexpr (F8) __builtin_amdgcn_sched_barrier(0); } while (0)
#define PG8_WAIT_V(n) asm volatile("s_waitcnt vmcnt(" #n ")" ::: "memory")
#define PG8_WAIT_L(n) asm volatile("s_waitcnt lgkmcnt(" #n ")" ::: "memory")
#define PG8_BAR __builtin_amdgcn_s_barrier()
#define PG8_SCHED __builtin_amdgcn_sched_barrier(0)
    Unit cur, nxt; int ui = 0;
    if (!S.next(0, cur)) return;
    f32x4 acc[2][2][4][2];
#pragma unroll
    for (int a = 0; a < 2; ++a)
#pragma unroll
        for (int b = 0; b < 2; ++b)
#pragma unroll
            for (int m = 0; m < 4; ++m)
#pragma unroll
                for (int n = 0; n < 2; ++n) acc[a][b][m][n] = (f32x4){0.f, 0.f, 0.f, 0.f};
    bf16x8 At[4][2], B0[2][2], B1[2][2];
    const char* cA = (const char*)g.A + (size_t)cur.pm * tstep; const char* cB = (const char*)g.Bt + (size_t)cur.pn * tstep;
    S.a_ready(cur);
    if constexpr (SP2) {
        PG8_STAGE(PG8_SB(0, 0), cB, voffB); PG8_STAGE(PG8_SB(0, 1), cB + hstep, voffB); PG8_STAGE(PG8_SA(0, 0), cA, voffA); PG8_STAGE(PG8_SA(0, 1), cA + hstep, voffA);
        if (wr == 1) PG8_BAR;
        PG8_WAIT_V(2); PG8_BAR;
        PG8_STAGE(PG8_SB(1, 0), cB + kstep, voffB); PG8_STAGE(PG8_SA(1, 0), cA + kstep, voffA); PG8_STAGE(PG8_SB(1, 1), cB + hstep + kstep, voffB);
        PG8_WAIT_V(6); PG8_BAR;
    } else {
        PG8_STAGE(PG8_SB(0, 0), cB, voffB); PG8_STAGE(PG8_SA(0, 0), cA, voffA); PG8_STAGE(PG8_SB(0, 1), cB + hstep, voffB); PG8_STAGE(PG8_SA(0, 1), cA + hstep, voffA);
        if (wr == 1) PG8_BAR;
        PG8_WAIT_V(4); PG8_BAR;
        PG8_STAGE(PG8_SB(1, 0), cB + kstep, voffB); PG8_STAGE(PG8_SA(1, 0), cA + kstep, voffA); PG8_STAGE(PG8_SB(1, 1), cB + hstep + kstep, voffB);
        PG8_WAIT_V(6); PG8_BAR;
    }
    for (;;) {
        const bool has_next = S.next(ui + 1, nxt);
        const char* nA = has_next ? (const char*)g.A + (size_t)nxt.pm * tstep : cA; const char* nB = has_next ? (const char*)g.Bt + (size_t)nxt.pn * tstep : cB;
        for (int t = 0; t < nt; t += 2) {
            const bool last = (t == nt - 2);
            const char* a1 = cA + (size_t)(t + 1) * kstep;
            const char* a2 = last ? nA : cA + (size_t)(t + 2) * kstep; const char* b2 = last ? nB : cB + (size_t)(t + 2) * kstep;
            const char* a3 = a2 + kstep; const char* b3 = b2 + kstep;
            if (last && has_next) S.a_ready(nxt);
            if constexpr (SP2) {
            PG8_LDB(B0, 0, 0); PG8_LDB(B1, 0, 1); PG8_SCHED; PG8_LDA(At, 0, 0); PG8_STAGE(PG8_SA(1, 1), a1 + hstep, voffA);
            PG8_WAIT_V(8); PG8_WAIT_L(0); PG8_BAR; PG8_MMA(0, 0, At, B0); PG8_MMA(0, 1, At, B1); PG8_BAR; PG8_SCHED;
            PG8_LDA(At, 0, 1); PG8_STAGE(PG8_SB(0, 0), b2, voffB); PG8_STAGE(PG8_SB(0, 1), b2 + hstep, voffB); PG8_STAGE(PG8_SA(0, 0), a2, voffA);
            PG8_WAIT_V(8); PG8_WAIT_L(0); PG8_BAR; PG8_MMA(1, 0, At, B0); PG8_MMA(1, 1, At, B1); PG8_BAR; PG8_SCHED;
            PG8_LDB(B0, 1, 0); PG8_LDB(B1, 1, 1); PG8_SCHED; PG8_LDA(At, 1, 0); PG8_STAGE(PG8_SA(0, 1), a2 + hstep, voffA);
            PG8_WAIT_V(8); PG8_WAIT_L(0); PG8_BAR; PG8_MMA(0, 0, At, B0); PG8_MMA(0, 1, At, B1); PG8_BAR; PG8_SCHED;
            PG8_LDA(At, 1, 1); PG8_STAGE(PG8_SB(1, 0), b3, voffB); PG8_STAGE(PG8_SB(1, 1), b3 + hstep, voffB); PG8_STAGE(PG8_SA(1, 0), a3, voffA);
            PG8_WAIT_V(8); PG8_WAIT_L(0); PG8_BAR; PG8_MMA(1, 0, At, B0); PG8_MMA(1, 1, At, B1); PG8_BAR; PG8_SCHED;
            } else {
            PG8_LDB(B0, 0, 0); PG8_SCHED; PG8_LDA(At, 0, 0); PG8_STAGE(PG8_SA(1, 1), a1 + hstep, voffA);
            PG8_WAIT_L(8); PG8_BAR; PG8_WAIT_L(0); PG8_MMA(0, 0, At, B0); PG8_BAR; PG8_SCHED;
            PG8_LDB(B1, 0, 1); PG8_STAGE(PG8_SB(0, 0), b2, voffB);
            PG8_BAR; PG8_WAIT_L(0); PG8_MMA(0, 1, At, B1); PG8_BAR;
            PG8_LDA(At, 0, 1); PG8_STAGE(PG8_SA(0, 0), a2, voffA);
            PG8_BAR; PG8_WAIT_L(0); PG8_MMA(1, 0, At, B0); PG8_BAR; PG8_SCHED;
            PG8_STAGE(PG8_SB(0, 1), b2 + hstep, voffB);
            PG8_WAIT_V(6); PG8_BAR; PG8_MMA(1, 1, At, B1); PG8_BAR;
            PG8_LDB(B0, 1, 0); PG8_SCHED; PG8_LDA(At, 1, 0); PG8_STAGE(PG8_SA(0, 1), a2 + hstep, voffA);
            PG8_WAIT_L(8); PG8_BAR; PG8_WAIT_L(0); PG8_MMA(0, 0, At, B0); PG8_BAR; PG8_SCHED;
            PG8_LDB(B1, 1, 1); PG8_STAGE(PG8_SB(1, 0), b3, voffB);
            PG8_BAR; PG8_WAIT_L(0); PG8_MMA(0, 1, At, B1); PG8_BAR;
            PG8_LDA(At, 1, 1); PG8_STAGE(PG8_SA(1, 0), a3, voffA);
            PG8_BAR; PG8_WAIT_L(0); PG8_MMA(1, 0, At, B0); PG8_BAR; PG8_SCHED;
            PG8_STAGE(PG8_SB(1, 1), b3 + hstep, voffB);
            PG8_WAIT_V(6); PG8_BAR; PG8_MMA(1, 1, At, B1); PG8_BAR;
            }
        }
        if constexpr (ALIGN_EPI) { if (wr == 0) PG8_BAR; }
        if constexpr (!Epi::AFTER_DRAIN) { const int t2_ = lane_id_opaque(); const int fr_ = t2_ & 15, fq_ = (t2_ & 63) >> 4;
            E(acc, cur, wr, wc, fr_, fq_); S.done(cur); }
        if (!has_next) break;
#pragma unroll
        for (int a = 0; a < 2; ++a)
#pragma unroll
            for (int b = 0; b < 2; ++b)
#pragma unroll
                for (int m = 0; m < 4; ++m)
#pragma unroll
                    for (int n = 0; n < 2; ++n) acc[a][b][m][n] = (f32x4){0.f, 0.f, 0.f, 0.f};
        cur = nxt; cA = nA; cB = nB; ++ui;
        if constexpr (ALIGN_EPI) { if (wr == 1) PG8_BAR; }
    }
    PG8_WAIT_V(0);
    if constexpr (!ALIGN_EPI) { if (wr == 0) PG8_BAR; }
    PG8_BAR;
    if constexpr (Epi::AFTER_DRAIN) { E.fused(acc, cur, wr, wc, fr, fq, lds, wid, lane); S.done(cur); }
#undef PG8_SA
#undef PG8_SB
#undef PG8_STAGE
#undef PG8_LDA
#undef PG8_LDB
#undef PG8_MMA
#undef PG8_WAIT_V
#undef PG8_WAIT_L
#undef PG8_BAR
#undef PG8_SCHED
}
}
#define GAS __attribute__((address_space(1)))
#define LAS __attribute__((address_space(3)))
typedef unsigned short bf16;
typedef unsigned v4u __attribute__((ext_vector_type(4)));
typedef float f32x4 __attribute__((ext_vector_type(4)));
typedef short bf16x8 __attribute__((ext_vector_type(8)));
typedef GAS unsigned gu32;
typedef GAS unsigned long long gu64;
#define RLX_AGENT __ATOMIC_RELAXED, __HIP_MEMORY_SCOPE_AGENT
#define LDS_WAIT() asm volatile("s_waitcnt lgkmcnt(0)" ::: "memory")
#define VM_WAIT() asm volatile("s_waitcnt vmcnt(0)" ::: "memory")
__device__ __forceinline__ unsigned long long rt() { return __builtin_amdgcn_s_memrealtime(); }
__device__ __forceinline__ unsigned f2bf(float f) { unsigned u = __builtin_bit_cast(unsigned, f); return (u + 0x7fffu + ((u >> 16) & 1u)) >> 16; }
__device__ __forceinline__ unsigned pk2(float lo, float hi) { return f2bf(lo) | (f2bf(hi) << 16); }

#define XB_TMO      128
#define XB_XCNT(j)  (256  + 64 * (j))
#define XB_XSUB(j)  (1280 + 64 * (j))
#define XB_XGEN(j)  (2304 + 64 * (j))
#define XB_TOP      3328
#define XB_TOPGEN   3392
#define XCD_BAR_WORDS 3456
#define XB_SPIN_CAP (1u << 18)

__device__ __forceinline__ unsigned xb_ld(unsigned* p)              { return __hip_atomic_load(p, __ATOMIC_RELAXED, __HIP_MEMORY_SCOPE_AGENT); }
__device__ __forceinline__ unsigned xb_add(unsigned* p, unsigned v) { return __hip_atomic_fetch_add(p, v, __ATOMIC_RELAXED, __HIP_MEMORY_SCOPE_AGENT); }
__device__ __forceinline__ unsigned xb_xcc_id() { return (unsigned)__builtin_amdgcn_s_getreg((3 << 11) | 20) & 0xFu; }
#define XB_SPIN(cond, bar) do { unsigned _sp = 0; while (cond) { __builtin_amdgcn_s_sleep(1); \
    if ((++_sp & 255u) == 0u) { if (xb_ld(&(bar)[XB_TMO])) break; if (_sp > XB_SPIN_CAP) { atomicAdd(&(bar)[XB_TMO], 1u); break; } } } } while (0)

struct XcdBarrier {
    unsigned* bar; unsigned x;
    volatile LAS unsigned* st;
};

__device__ __forceinline__ XcdBarrier xcd_barrier_post(unsigned* bar, volatile LAS unsigned* st) {
    XcdBarrier b; b.bar = bar; b.x = xb_xcc_id(); b.st = st;
    if (threadIdx.x == 0) (void)xb_add(&bar[XB_XCNT(b.x)], 1u);
    return b;
}
__device__ __forceinline__ void xcd_barrier_complete(unsigned* bar, unsigned x, unsigned& nloc, unsigned& nx) {
    const unsigned G = gridDim.x * gridDim.y * gridDim.z;
    unsigned sum, cnt, mine, sp = 0u;
    for (;;) {
        sum = 0u; cnt = 0u; mine = 0u;
#pragma unroll
        for (unsigned j = 0; j < 16; ++j) { const unsigned c = xb_ld(&bar[XB_XCNT(j)]); sum += c; cnt += (c > 0u) ? 1u : 0u; mine = (j == x) ? c : mine; }
        if (sum == G) break;
        __builtin_amdgcn_s_sleep(1);
        if ((++sp & 255u) == 0u) { if (xb_ld(&bar[XB_TMO])) break; if (sp > XB_SPIN_CAP) { atomicAdd(&bar[XB_TMO], 1u); break; } }
    }
    nloc = mine > 0u ? mine : 1u; nx = cnt > 0u ? cnt : 1u;
}

__device__ __forceinline__ void xcd_barrier(const XcdBarrier& b, const bool leader  ) {
    asm volatile("s_waitcnt vmcnt(0)" ::: "memory");
    __syncthreads();
    if (leader) {
        unsigned* bar = b.bar; asm volatile("" : "+s"(bar));
        __builtin_amdgcn_s_waitcnt(0);
        unsigned nloc = b.st[0], nx = b.st[1];
        if (nloc == 0u) { xcd_barrier_complete(bar, b.x, nloc, nx); b.st[0] = nloc; b.st[1] = nx; }
        const unsigned old = xb_add(&bar[XB_XSUB(b.x)], 1u);
        const unsigned gen = old / nloc;
        if (old + 1u == (gen + 1u) * nloc) {
            __builtin_amdgcn_fence(__ATOMIC_RELEASE, "agent");
            asm volatile("s_waitcnt vmcnt(0)" ::: "memory");
            const unsigned og = xb_add(&bar[XB_TOP], 1u);
            const unsigned tg = og / nx;
            if (og + 1u == (tg + 1u) * nx) xb_add(&bar[XB_TOPGEN], 1u);
            else XB_SPIN(xb_ld(&bar[XB_TOPGEN]) == tg, bar);
            __builtin_amdgcn_fence(__ATOMIC_ACQUIRE, "agent");
            xb_add(&bar[XB_XGEN(b.x)], 1u);
            asm volatile("s_waitcnt vmcnt(0)" ::: "memory");
        } else {
            XB_SPIN(xb_ld(&bar[XB_XGEN(b.x)]) == gen, bar);
            __builtin_amdgcn_fence(__ATOMIC_ACQUIRE, "agent");
            asm volatile("s_waitcnt vmcnt(0)" ::: "memory");
        }
    }
    __syncthreads();
}

#ifndef FFN_F8
#define FFN_F8 1
#endif
constexpr int NWAVES = 8;
constexpr float W8S = 32.f, U8S = 4.f;
constexpr int DM = 1024, NBATCH = 16, SEQ = 2048, CTX = 256, TPB = SEQ + CTX, M = NBATCH * TPB;
constexpr int DEPTH = 4, NIN = 3104, NP = 3328, DFF = 2816, NE = 8;
constexpr int MP = 2 * M + NE * 256;
constexpr int C_Q = 0, C_K = 512, C_V = 1024, C_GQ = 1536, C_GK = 1792, C_GV = 2048, C_GG = 2560, C_GLR = 3072;
constexpr float EPS = 1e-6f;
constexpr float C2 = 0.125f * 1.4426950408889634f;
constexpr int NCH = TPB / 64;
constexpr int NGLA = NBATCH * 4 * 2 * NCH;

constexpr size_t MiB = 1u << 20;
constexpr size_t WS_CTL = 0, CTL_ZERO_BYTES = 1 * MiB;
constexpr size_t WS_MOD = 1 * MiB;
constexpr size_t WS_ROPE = 3 * MiB;
constexpr size_t WS_TOPE = 4 * MiB;
constexpr size_t WS_LIDX = WS_TOPE + 160 * 1024;
constexpr size_t WS_TOPW = WS_LIDX + 320 * 1024;
constexpr size_t WS_BLKB = WS_TOPW + 320 * 1024;
constexpr size_t WS_RMAP = WS_BLKB + 64 * 1024;
constexpr size_t WS_ROWW = WS_RMAP + 320 * 1024;
static_assert(WS_ROWW + 320 * 1024 <= 6 * MiB, "small tables");
constexpr size_t WS_X = 6 * MiB;
constexpr size_t WS_WIN = 150 * MiB;
constexpr size_t WS_WOUT = WS_WIN + 13 * MiB / 2;
constexpr size_t WS_WUP = WS_WOUT + 2 * MiB;
constexpr size_t WS_WDN = WS_WUP + 88 * MiB;
constexpr size_t WS_D = 291 * MiB;
static_assert(WS_WDN + 44 * MiB <= WS_D, "weights");
constexpr size_t WS_PROJ = WS_D;
constexpr size_t WS_OD = WS_D + 234 * MiB;
constexpr size_t WS_DS = WS_D + 306 * MiB;
constexpr size_t WS_DEC = WS_D + 450 * MiB;
constexpr size_t WS_H = WS_D + 452 * MiB;
constexpr size_t WS_Y = WS_D;
constexpr size_t WS_HG = WS_D;
constexpr size_t WS_F2 = WS_D;
constexpr size_t WS_U = WS_D + 148 * MiB;
constexpr size_t WS_H2 = WS_D + 483 * MiB;
constexpr size_t WS_END = WS_D + 555 * MiB;
static_assert((size_t)MP * DFF * 2 <= 407 * MiB && (size_t)MP * DM * 2 <= 148 * MiB && (size_t)M * NP * 2 <= 234 * MiB, "dynamic map");
static_assert((size_t)M * DFF * 2 + 148 * MiB <= 483 * MiB, "dense U clear of H2");

constexpr int CW_BAR = 4096;
constexpr int CW_CNT = 8192;

constexpr int RING_BYTES = 131072;
constexpr int TEXP_OFF = 139264;
constexpr int MISC_OFF = 146432 - 512;
constexpr int LDS_BYTES = 147456;

typedef unsigned u32x2 __attribute__((ext_vector_type(2)));

__device__ __forceinline__ float bf2f(unsigned short x) { return __uint_as_float((unsigned)x << 16); }
__device__ __forceinline__ float bflo(unsigned w) { return __uint_as_float(w << 16); }
__device__ __forceinline__ float bfhi(unsigned w) { return __uint_as_float(w & 0xffff0000u); }
__device__ __forceinline__ float siluf(float x) { return x * __builtin_amdgcn_rcpf(1.f + __expf(-x)); }
__device__ __forceinline__ float clamp8(float x) { return fminf(fmaxf(x, -448.f), 448.f); }
__device__ __forceinline__ unsigned pk4_f8(float a, float b, float c, float d) { unsigned w = 0u; w = __builtin_amdgcn_cvt_pk_fp8_f32(clamp8(a), clamp8(b), w, false); w = __builtin_amdgcn_cvt_pk_fp8_f32(clamp8(c), clamp8(d), w, true); return w; }
template <int MASK> __device__ __forceinline__ float xadd(float v) {
    if constexpr (MASK == 32) { const auto rr = __builtin_amdgcn_permlane32_swap(__float_as_uint(v), __float_as_uint(v), false, false); return __uint_as_float(rr[0]) + __uint_as_float(rr[1]); }
    else return v + __int_as_float(__builtin_amdgcn_ds_swizzle(__float_as_int(v), 0x1f | (MASK << 10)));
}
__device__ __forceinline__ float wave_sum(float v) {
    v = xadd<1>(v); v = xadd<2>(v); v = xadd<4>(v); v = xadd<8>(v); v = xadd<16>(v); v = xadd<32>(v);
    return v;
}

struct Args { const float* in[24]; float* out; unsigned char* ws; };
struct Frame {
    LAS unsigned char* lds;
    volatile LAS unsigned* MISC;
    int tid, lane, wave, G, blk, gw, NGW, z, wv;
    const Args* A;
    unsigned char* ws;
};


__device__ __forceinline__ void refresh(Frame& F) {
    int wv = F.wv; asm volatile("" : "+s"(wv));
    const int t = wv * 64 + pg8::lane_id_opaque();
    int bl = blockIdx.x, z = 0, gg = gridDim.x; asm volatile("" : "+s"(bl), "+s"(z), "+s"(gg));
    F.blk = bl; F.z = z; F.G = gg; F.NGW = gg * NWAVES;
    F.tid = t; F.lane = t & 63; F.wave = wv; F.gw = F.blk * NWAVES + F.wave;
}
#define INP(k) (F.A->in[(k) + F.z])
namespace pg8 {
struct EpiProj {
    static constexpr bool PERM = false, AFTER_DRAIN = false;
    bf16_t* P; const float* ropec; const float* ropes;
    __device__ __forceinline__ void operator()(const f32x4 (&acc)[2][2][4][2], const Unit& u, int wr, int wc, int fr, int fq) const {
        const int pn = u.pn, pm = u.pm, tb = pm % 9;
        const bool do_rope = (tb != 0) && (pn < 4);
        const float sc = (pn < 2) ? C2 : (pn == 6 ? 0.125f : 1.f);
        const bool st_ok_all = pn < 12;
#pragma unroll
        for (int ai = 0; ai < 2; ++ai)
#pragma unroll
            for (int m = 0; m < 4; ++m) {
                const int rit = ai * HALF + wr * 64 + m * 16 + fr;
                const size_t grow = (size_t)pm * BM + rit;
                const int s = (tb - 1) * 256 + rit;
                const int pos = (wc & 1) ? (s & 63) : (s >> 6);
                f32x4 cs = {1.f, 1.f, 1.f, 1.f}, sn = {0.f, 0.f, 0.f, 0.f};
                if (do_rope) { cs = *(const f32x4*)(ropec + pos * 16 + 4 * fq); sn = *(const f32x4*)(ropes + pos * 16 + 4 * fq); }
#pragma unroll
                for (int bj = 0; bj < 2; ++bj) {
                    f32x4 v0 = acc[ai][bj][m][0], v1 = acc[ai][bj][m][1];
                    if (do_rope) { const f32x4 a = v0 * cs - v1 * sn, b = v0 * sn + v1 * cs; v0 = a; v1 = b; }
                    v0 = v0 * sc; v1 = v1 * sc;
                    const int col0 = pn * BM + bj * HALF + wc * 32 + 4 * fq;
                    if (st_ok_all || (bj == 0 && wc == 0)) {
                        u32x2 w0, w1; w0.x = cvt_pk_bf16(v0[0], v0[1]); w0.y = cvt_pk_bf16(v0[2], v0[3]); w1.x = cvt_pk_bf16(v1[0], v1[1]); w1.y = cvt_pk_bf16(v1[2], v1[3]);
                        *(u32x2*)(P + grow * NP + col0) = w0; *(u32x2*)(P + grow * NP + col0 + 16) = w1;
                    }
                }
            }
    }
};
struct EpiF32 {
    static constexpr bool PERM = true, AFTER_DRAIN = false;
    bf16_t* Y;
    __device__ __forceinline__ void operator()(const f32x4 (&acc)[2][2][4][2], const Unit& u, int wr, int wc, int fr, int fq) const {
#pragma unroll
        for (int ai = 0; ai < 2; ++ai)
#pragma unroll
            for (int m = 0; m < 4; ++m) {
                bf16_t* rowp = Y + ((size_t)u.pm * BM + ai * HALF + wr * 64 + m * 16 + fr) * DM + u.pn * BM + wc * 32 + 8 * fq;
#pragma unroll
                for (int bj = 0; bj < 2; ++bj) { const f32x4 v0 = acc[ai][bj][m][0], v1 = acc[ai][bj][m][1];
                    u32x4 w; w.x = cvt_pk_bf16(v0[0], v0[1]); w.y = cvt_pk_bf16(v0[2], v0[3]); w.z = cvt_pk_bf16(v1[0], v1[1]); w.w = cvt_pk_bf16(v1[2], v1[3]);
                    *(u32x4*)(rowp + bj * HALF) = w; }
            }
    }
};
struct EpiSwiglu {
    static constexpr bool PERM = true, AFTER_DRAIN = false;
    bf16_t* U;
    __device__ __forceinline__ void operator()(const f32x4 (&acc)[2][2][4][2], const Unit& u, int wr, int wc, int fr, int fq) const {
        const int pnl = u.pn % 22;
        const int col0 = pnl * 128 + wc * 32 + 8 * fq;
        constexpr float ws = FFN_F8 ? 1.f / W8S : 1.f, us = FFN_F8 ? U8S : 1.f, kS = ws * ws * us, kE = -ws * 1.4426950408889634f;
        const float cE = -__builtin_log2f(kS), c1 = 1.f / kS;
#pragma unroll
        for (int ai = 0; ai < 2; ++ai)
#pragma unroll
            for (int m = 0; m < 4; ++m) {
                const size_t rowi = (size_t)u.pm * BM + ai * HALF + wr * 64 + m * 16 + fr;
                f32x2 g[4], up[4], t[4], r[4];
#pragma unroll
                for (int n = 0; n < 2; ++n) { g[2 * n] = (f32x2){acc[ai][0][m][n][0], acc[ai][0][m][n][1]}; g[2 * n + 1] = (f32x2){acc[ai][0][m][n][2], acc[ai][0][m][n][3]};
                                              up[2 * n] = (f32x2){acc[ai][1][m][n][0], acc[ai][1][m][n][1]}; up[2 * n + 1] = (f32x2){acc[ai][1][m][n][2], acc[ai][1][m][n][3]}; }
#pragma unroll
                for (int q = 0; q < 4; ++q) t[q] = g[q] * kE + cE;
#pragma unroll
                for (int q = 0; q < 4; ++q) { t[q].x = __builtin_amdgcn_exp2f(t[q].x); t[q].y = __builtin_amdgcn_exp2f(t[q].y); }
#pragma unroll
                for (int q = 0; q < 4; ++q) t[q] = t[q] + c1;
#pragma unroll
                for (int q = 0; q < 4; ++q) { r[q].x = __builtin_amdgcn_rcpf(t[q].x); r[q].y = __builtin_amdgcn_rcpf(t[q].y); }
#pragma unroll
                for (int q = 0; q < 4; ++q) g[q] = (g[q] * up[q]) * r[q];
                if constexpr (FFN_F8) { u32x2 w; w.x = pk4_f8(g[0].x, g[0].y, g[1].x, g[1].y); w.y = pk4_f8(g[2].x, g[2].y, g[3].x, g[3].y); *(u32x2*)((unsigned char*)U + rowi * DFF + col0) = w; }
                else { u32x4 w; w.x = cvt_pk_bf16(g[0].x, g[0].y); w.y = cvt_pk_bf16(g[1].x, g[1].y); w.z = cvt_pk_bf16(g[2].x, g[2].y); w.w = cvt_pk_bf16(g[3].x, g[3].y); *(u32x4*)(U + rowi * DFF + col0) = w; }
            }
    }
};
struct EpiDown {
    static constexpr bool PERM = true, AFTER_DRAIN = false;
    bf16_t* F2; const int* rmap; const float* roww; int dense;
    __device__ __forceinline__ void operator()(const f32x4 (&acc)[2][2][4][2], const Unit& u, int wr, int wc, int fr, int fq) const {
        const int pnl = u.pn & 3;
        const int col0 = pnl * BM + wc * 32 + 8 * fq;
#pragma unroll
        for (int ai = 0; ai < 2; ++ai)
#pragma unroll
            for (int m = 0; m < 4; ++m) {
                const int grow = u.pm * BM + ai * HALF + wr * 64 + m * 16 + fr;
                int tok = grow, slot = 0; float w = 1.f; bool ok = true;
                if (!dense) { const int rm = rmap[grow]; ok = rm >= 0; tok = rm & 0x3fffffff; slot = (rm >> 30) & 1; w = roww[grow]; }
                if constexpr (FFN_F8) w *= 1.f / (W8S * U8S);
                if (ok) {
                    bf16_t* rowp = F2 + ((size_t)slot * M + tok) * DM + col0;
#pragma unroll
                    for (int bj = 0; bj < 2; ++bj) {
                        const f32x4 v0 = acc[ai][bj][m][0] * w, v1 = acc[ai][bj][m][1] * w;
                        u32x4 q; q.x = cvt_pk_bf16(v0[0], v0[1]); q.y = cvt_pk_bf16(v0[2], v0[3]); q.z = cvt_pk_bf16(v1[0], v1[1]); q.w = cvt_pk_bf16(v1[2], v1[3]);
                        *(u32x4*)(rowp + bj * HALF) = q;
                    }
                }
            }
    }
};
struct GroupedOrder {
    StaticOrder S; const PG8_LAS int* texp; int nN;
    __device__ __forceinline__ bool next(int i, Unit& u) const { if (!S.next(i, u)) return false; u.pn += __builtin_amdgcn_readfirstlane(texp[u.pm]) * nN; return true; }
    __device__ __forceinline__ void a_ready(const Unit&) const {}
    __device__ __forceinline__ void done(const Unit&) const {}
};
struct LatOrder {
    StaticOrder S; int lat;
    __device__ __forceinline__ bool next(int i, Unit& u) const { if (!S.next(i, u)) return false; if (lat) u.pm += (u.pm >> 3) + 1; return true; }
    __device__ __forceinline__ void a_ready(const Unit&) const {}
    __device__ __forceinline__ void done(const Unit&) const {}
};
}

__device__ __forceinline__ void ld_row_f32(const float* row, int lane, f32x4 (&v)[4]) {
#pragma unroll
    for (int j = 0; j < 4; ++j) v[j] = *(const f32x4*)(row + 4 * lane + 256 * j);
}
__device__ __forceinline__ void st_row_f32(float* row, int lane, const f32x4 (&v)[4]) {
#pragma unroll
    for (int j = 0; j < 4; ++j) *(f32x4*)(row + 4 * lane + 256 * j) = v[j];
}
__device__ __forceinline__ void ld_row_bf16(const bf16* row, int lane, f32x4 (&v)[4]) {
#pragma unroll
    for (int j = 0; j < 4; ++j) { const u32x2 w = *(const u32x2*)(row + 4 * lane + 256 * j); v[j] = (f32x4){bflo(w.x), bfhi(w.x), bflo(w.y), bfhi(w.y)}; }
}
__device__ __forceinline__ void st_row_bf16(bf16* row, int lane, const f32x4 (&v)[4]) {
#pragma unroll
    for (int j = 0; j < 4; ++j) { u32x2 w; w.x = pg8::cvt_pk_bf16(v[j][0], v[j][1]); w.y = pg8::cvt_pk_bf16(v[j][2], v[j][3]); *(u32x2*)(row + 4 * lane + 256 * j) = w; }
}
__device__ __forceinline__ float row_rinv(const f32x4 (&v)[4]) {
    float s = 0.f;
#pragma unroll
    for (int j = 0; j < 4; ++j) s += (v[j][0] * v[j][0] + v[j][1] * v[j][1]) + (v[j][2] * v[j][2] + v[j][3] * v[j][3]);
    return 1.0f / sqrtf(wave_sum(s) * (1.f / DM) + EPS);
}

__device__ __forceinline__ void transpose_tile(const float* W, int N, int k0, int n0, bf16* WT, int K, int drow0, LAS float* scr, int lane) {
#pragma unroll 8
    for (int i = 0; i < 32; ++i) { const int kk = 2 * i + (lane >> 5); scr[kk * 33 + (lane & 31)] = __builtin_nontemporal_load(&W[(size_t)(k0 + kk) * N + n0 + (lane & 31)]); }
    LDS_WAIT(); asm volatile("" ::: "memory");
    const int c = lane & 7;
#pragma unroll
    for (int j = 0; j < 4; ++j) { const int n = (lane >> 3) + 8 * j; const LAS float* s = scr + (8 * c) * 33 + n;
        v4u o; o.x = pk2(s[0 * 33], s[1 * 33]); o.y = pk2(s[2 * 33], s[3 * 33]); o.z = pk2(s[4 * 33], s[5 * 33]); o.w = pk2(s[6 * 33], s[7 * 33]);
        *(GAS v4u*)(WT + (size_t)(drow0 + n) * K + k0 + 8 * c) = o; }
    LDS_WAIT(); asm volatile("" ::: "memory");
}
__device__ __forceinline__ void transpose_tile_f8(const float* W, int N, int k0, int n0, unsigned char* WT, int Kb, int drow0, LAS float* scr, int lane, float scale) {
#pragma unroll 8
    for (int i = 0; i < 32; ++i) { const int kk = 2 * i + (lane >> 5); scr[kk * 33 + (lane & 31)] = __builtin_nontemporal_load(&W[(size_t)(k0 + kk) * N + n0 + (lane & 31)]); }
    LDS_WAIT(); asm volatile("" ::: "memory");
    const int n = lane >> 1, hf = lane & 1; const LAS float* s = scr + (hf * 32) * 33 + n;
    v4u o0, o1;
    o0.x = pk4_f8(s[0 * 33] * scale, s[1 * 33] * scale, s[2 * 33] * scale, s[3 * 33] * scale);     o0.y = pk4_f8(s[4 * 33] * scale, s[5 * 33] * scale, s[6 * 33] * scale, s[7 * 33] * scale);
    o0.z = pk4_f8(s[8 * 33] * scale, s[9 * 33] * scale, s[10 * 33] * scale, s[11 * 33] * scale);   o0.w = pk4_f8(s[12 * 33] * scale, s[13 * 33] * scale, s[14 * 33] * scale, s[15 * 33] * scale);
    o1.x = pk4_f8(s[16 * 33] * scale, s[17 * 33] * scale, s[18 * 33] * scale, s[19 * 33] * scale); o1.y = pk4_f8(s[20 * 33] * scale, s[21 * 33] * scale, s[22 * 33] * scale, s[23 * 33] * scale);
    o1.z = pk4_f8(s[24 * 33] * scale, s[25 * 33] * scale, s[26 * 33] * scale, s[27 * 33] * scale); o1.w = pk4_f8(s[28 * 33] * scale, s[29 * 33] * scale, s[30 * 33] * scale, s[31 * 33] * scale);
    GAS v4u* dst = (GAS v4u*)(WT + (size_t)(drow0 + n) * Kb + k0 + hf * 32);
    dst[0] = o0; dst[1] = o1;
    LDS_WAIT(); asm volatile("" ::: "memory");
}
__device__ __forceinline__ void convert_weights(Frame& F, int l) {
    refresh(F);
    const bool moe = l & 1; const int ne = moe ? NE : 1, li = l >> 1;
    const float* w1 = moe ? INP(21) + (size_t)li * NE * DM * DFF : INP(17) + (size_t)li * DM * DFF;
    const float* w3 = moe ? INP(22) + (size_t)li * NE * DM * DFF : INP(18) + (size_t)li * DM * DFF;
    const float* w2 = moe ? INP(23) + (size_t)li * NE * DM * DFF : INP(19) + (size_t)li * DM * DFF;
    const float* win = INP(10) + (size_t)l * DM * NIN;
    const float* wout = INP(16) + (size_t)l * DM * DM;
    bf16* WIN = (bf16*)(F.ws + WS_WIN); bf16* WOUT = (bf16*)(F.ws + WS_WOUT); bf16* WUP = (bf16*)(F.ws + WS_WUP); bf16* WDN = (bf16*)(F.ws + WS_WDN);
    LAS float* scr = (LAS float*)(F.lds + F.wave * 16384);
    const int nA = 16 * 97, nZ = NP - NIN, nB = 16 * 32, nC1 = 16 * 88, nD1 = 44 * 32;
    const int nC = ne * 2 * nC1, nD = ne * nD1, total = nA + nZ + nB + nC + nD;
    for (int it = F.gw; it < total; it += F.NGW) {
        int r = it;
        if (r < nA) { const int kb = r / 97, nb = r % 97; transpose_tile(win, NIN, 64 * kb, 32 * nb, WIN, DM, 32 * nb, scr, F.lane); continue; } r -= nA;
        if (r < nZ) { const unsigned zz = (unsigned)F.z; v4u z = {zz, zz, zz, zz}; GAS v4u* p = (GAS v4u*)(WIN + (size_t)(NIN + r) * DM) + F.lane * 2; p[0] = z; p[1] = z; continue; } r -= nZ;
        if (r < nB) { const int kb = r / 32, nb = r % 32; transpose_tile(wout, DM, 64 * kb, 32 * nb, WOUT, DM, 32 * nb, scr, F.lane); continue; } r -= nB;
        if (r < nC) { const int e = r / (2 * nC1), q = r % (2 * nC1), which = q / nC1, t = q % nC1, kb = t / 88, nb = t % 88, n0 = 32 * nb;
            const float* src = (which ? w3 : w1) + (size_t)e * DM * DFF;
            if constexpr (FFN_F8) transpose_tile_f8(src, DFF, 64 * kb, n0, (unsigned char*)WUP, DM, e * 5632 + (n0 / 128) * 256 + (n0 % 128) + which * 128, scr, F.lane, W8S);
            else transpose_tile(src, DFF, 64 * kb, n0, WUP, DM, e * 5632 + (n0 / 128) * 256 + (n0 % 128) + which * 128, scr, F.lane); continue; } r -= nC;
        { const int e = r / nD1, t = r % nD1, kb = t / 32, nb = t % 32;
            if constexpr (FFN_F8) transpose_tile_f8(w2 + (size_t)e * DFF * DM, DM, 64 * kb, 32 * nb, (unsigned char*)WDN + (size_t)e * DM * DFF, DFF, 32 * nb, scr, F.lane, W8S);
            else transpose_tile(w2 + (size_t)e * DFF * DM, DM, 64 * kb, 32 * nb, WDN + (size_t)e * DM * DFF, DFF, 32 * nb, scr, F.lane); }
    }
}

__device__ __forceinline__ void p0_mod(Frame& F) {
    refresh(F);
    LAS float* S = (LAS float*)(F.lds);
    LAS float* R = (LAS float*)(F.lds + 69632);
    const float* c = INP(1); const float* cc = INP(3); const float* wmod = INP(4); const float* bmod = INP(5);
    float* MOD = (float*)(F.ws + WS_MOD);
    for (int i = F.tid; i < 17 * 1024; i += 512) { const int b = i >> 10, k = i & 1023; const float v = b < 16 ? c[b * 1024 + k] : cc[k]; S[i] = siluf(v); }
    __syncthreads();
    const int kq = F.lane >> 4, c4 = (F.lane & 15) * 4;
    for (int item = F.blk; item < 4 * 96; item += F.G) {
        const int l = item / 96, col0 = (item % 96) * 64;
        const float* W = wmod + (size_t)l * DM * 6144;
        float acc[17][4];
#pragma unroll
        for (int b = 0; b < 17; ++b)
#pragma unroll
            for (int j = 0; j < 4; ++j) acc[b][j] = 0.f;
        for (int it = 0; it < 32; ++it) {
            const int k = F.wave * 128 + it * 4 + kq;
            const f32x4 w = *(const f32x4*)(W + (size_t)k * 6144 + col0 + c4);
#pragma unroll
            for (int b = 0; b < 17; ++b) { const float s = S[b * 1024 + k];
#pragma unroll
                for (int j = 0; j < 4; ++j) acc[b][j] += s * w[j]; }
        }
#pragma unroll
        for (int b = 0; b < 17; ++b)
#pragma unroll
            for (int j = 0; j < 4; ++j) { float v = acc[b][j]; v = xadd<16>(v); v = xadd<32>(v); acc[b][j] = v; }
        if (kq == 0) {
#pragma unroll
            for (int b = 0; b < 17; ++b)
#pragma unroll
                for (int j = 0; j < 4; ++j) R[(F.wave * 17 + b) * 64 + c4 + j] = acc[b][j];
        }
        __syncthreads();
        for (int o = F.tid; o < 17 * 64; o += 512) { const int b = o >> 6, ccx = o & 63; float s = bmod[l * 6144 + col0 + ccx];
            for (int w = 0; w < 8; ++w) s += R[(w * 17 + b) * 64 + ccx];
            MOD[((size_t)l * 17 + b) * 6144 + col0 + ccx] = s; }
        __syncthreads();
    }
}
__device__ __forceinline__ float lam_init_of(int l) { return 0.8f - 0.6f * expf(-0.3f * (float)l); }
__device__ __forceinline__ void p0_misc(Frame& F) {
    refresh(F);
    float* ropec = (float*)(F.ws + WS_ROPE); float* ropes = ropec + 1024; float* lam = (float*)(F.ws + WS_ROPE + 16384);
    if (F.blk == 0) {
        for (int i = F.tid; i < 1024; i += 512) { const int pos = i >> 4, f = i & 15; const float inv = powf(10000.f, -(float)f / 16.f); const float ang = (float)pos * inv; ropec[i] = cosf(ang); ropes[i] = sinf(ang); }
    }
    if (F.blk == (1 % F.G) && F.wave < 4) {
        const int l = F.wave; const float* lv = INP(13) + l * 256;
        const float a = wave_sum(lv[F.lane] * lv[64 + F.lane]), b = wave_sum(lv[128 + F.lane] * lv[192 + F.lane]);
        if (F.lane == 0) lam[l] = expf(a) - expf(b) + lam_init_of(l);
    }
}

namespace att {
using bf16x8 = __attribute__((ext_vector_type(8))) short;
using s16x4  = __attribute__((ext_vector_type(4))) short;
using f32x16 = __attribute__((ext_vector_type(16))) float;
using u32x4  = __attribute__((ext_vector_type(4))) unsigned;
constexpr int QBLK = 32, KVBLK = 64, NW = 8, DV = 128;
constexpr float THR = 8.f;
constexpr size_t SHM_V = KVBLK * DV * 2, SHM_K = KVBLK * 64 * 2, SHM_ATTN = 2 * SHM_V + 2 * SHM_K + NW * 64 * 4;
#define KSWZ64(row, colB) ((row) * 128 + ((colB) ^ ((((row) >> 1) & 7) << 4)))
#define SBAR() __builtin_amdgcn_sched_barrier(0)
__device__ __forceinline__ int crow(int r, int hi) { return (r & 3) + 8 * (r >> 2) + 4 * hi; }
__device__ __forceinline__ unsigned cvtpk(float lo, float hi) { unsigned r; asm volatile("v_cvt_pk_bf16_f32 %0, %1, %2" : "=v"(r) : "v"(lo), "v"(hi)); return r; }
__device__ __forceinline__ void partialSM(f32x16& p0, f32x16& p1, float& m_reg, float& mn, float& alpha) {
  float pmax = p0[0];
#pragma unroll
  for (int r = 1; r < 16; ++r) pmax = fmaxf(pmax, p0[r]);
#pragma unroll
  for (int r = 0; r < 16; ++r) pmax = fmaxf(pmax, p1[r]);
  { auto rr = __builtin_amdgcn_permlane32_swap(__float_as_uint(pmax), __float_as_uint(pmax), false, false);
    pmax = fmaxf(__uint_as_float(rr[0]), __uint_as_float(rr[1])); }
  if (__builtin_expect(__all(pmax - m_reg <= THR), 1)) { mn = m_reg; alpha = 1.f; }
  else { mn = fmaxf(m_reg, pmax); alpha = __builtin_amdgcn_exp2f(m_reg - mn); m_reg = mn; }
#pragma unroll
  for (int r = 0; r < 16; ++r) p0[r] = p0[r] - mn;
#pragma unroll
  for (int r = 0; r < 16; ++r) p1[r] = p1[r] - mn;
#pragma unroll
  for (int r = 0; r < 16; ++r) p0[r] = __builtin_amdgcn_exp2f(p0[r]);
}
__device__ __forceinline__ void finishSM(f32x16& p0, f32x16& p1, float alpha, float& l_reg, bf16x8& pa0, bf16x8& pa1, bf16x8& pa2, bf16x8& pa3) {
#pragma unroll
  for (int r = 0; r < 16; ++r) p1[r] = __builtin_amdgcn_exp2f(p1[r]);
  float ps = 0;
#pragma unroll
  for (int r = 0; r < 16; ++r) ps += p0[r];
#pragma unroll
  for (int r = 0; r < 16; ++r) ps += p1[r];
  { auto rr = __builtin_amdgcn_permlane32_swap(__float_as_uint(ps), __float_as_uint(ps), false, false);
    ps = __uint_as_float(rr[0]) + __uint_as_float(rr[1]); }
  l_reg = l_reg * alpha + ps;
#define PK4(P, BASE, OUT) do { unsigned a0 = cvtpk(P[BASE + 0], P[BASE + 1]), a1 = cvtpk(P[BASE + 2], P[BASE + 3]);   \
    unsigned b0 = cvtpk(P[BASE + 4], P[BASE + 5]), b1 = cvtpk(P[BASE + 6], P[BASE + 7]);                              \
    auto r0 = __builtin_amdgcn_permlane32_swap(a0, b0, false, false); auto r1 = __builtin_amdgcn_permlane32_swap(a1, b1, false, false); \
    u32x4 w = {r0[0], r1[0], r0[1], r1[1]}; OUT = *reinterpret_cast<bf16x8*>(&w); } while (0)
  PK4(p0, 0, pa0); PK4(p0, 8, pa1); PK4(p1, 0, pa2); PK4(p1, 8, pa3);
#undef PK4
}
__device__ __forceinline__ void pack_p(const f32x16& p0, const f32x16& p1, bf16x8& pa0, bf16x8& pa1, bf16x8& pa2, bf16x8& pa3) {
#define PK4(P, BASE, OUT) do { unsigned a0 = cvtpk(P[BASE + 0], P[BASE + 1]), a1 = cvtpk(P[BASE + 2], P[BASE + 3]);   \
    unsigned b0 = cvtpk(P[BASE + 4], P[BASE + 5]), b1 = cvtpk(P[BASE + 6], P[BASE + 7]);                              \
    auto r0 = __builtin_amdgcn_permlane32_swap(a0, b0, false, false); auto r1 = __builtin_amdgcn_permlane32_swap(a1, b1, false, false); \
    u32x4 w = {r0[0], r1[0], r0[1], r1[1]}; OUT = *reinterpret_cast<bf16x8*>(&w); } while (0)
  PK4(p0, 0, pa0); PK4(p0, 8, pa1); PK4(p1, 0, pa2); PK4(p1, 8, pa3);
#undef PK4
}
__device__ __forceinline__ void qkt(f32x16& p0, f32x16& p1, const bf16* Ks, const bf16x8* qr, int r32, int hi) {
  p0 = f32x16{}; p1 = f32x16{};
#pragma unroll
  for (int d0 = 0; d0 < 4; ++d0) { int cb = (d0 * 16 + hi * 8) * 2;
    bf16x8 b0 = *reinterpret_cast<const bf16x8*>((const char*)Ks + KSWZ64(r32, cb));
    bf16x8 b1 = *reinterpret_cast<const bf16x8*>((const char*)Ks + KSWZ64(32 + r32, cb));
    p0 = __builtin_amdgcn_mfma_f32_32x32x16_bf16(b0, qr[d0], p0, 0, 0, 0);
    p1 = __builtin_amdgcn_mfma_f32_32x32x16_bf16(b1, qr[d0], p1, 0, 0, 0); }
}
__device__ __forceinline__ int v_st(int k, int c) { const int kk = (k & ~0xC) | ((k & 4) << 1) | ((k & 8) >> 1); return ((kk >> 3) * 4 + (c >> 5)) * 512 + ((kk & 7) * 32 + (c & 31)) * 2; }
__device__ __forceinline__ int v_rd_base(int lane) { return ((lane & 3) << 3) | (((lane >> 2) & 3) << 6) | (((lane >> 4) & 1) << 5) | (((lane >> 5) & 1) << 8); }
constexpr int v_rd_off(int d0, int ks, int half) { return d0 * 512 + ks * 4096 + half * 2048; }
template <int OFF> __device__ __forceinline__ s16x4 tr_read(int vb) {
  s16x4 r; asm volatile("ds_read_b64_tr_b16 %0, %1 offset:%2" : "=&v"(r) : "v"(vb), "i"(OFF) : "memory"); return r;
}
template <int D0> __device__ __forceinline__ void pv_one(f32x16& od, int vb, bf16x8 pa0, bf16x8 pa1, bf16x8 pa2, bf16x8 pa3) {
  const s16x4 l0 = tr_read<v_rd_off(D0, 0, 0)>(vb), h0 = tr_read<v_rd_off(D0, 0, 1)>(vb), l1 = tr_read<v_rd_off(D0, 1, 0)>(vb), h1 = tr_read<v_rd_off(D0, 1, 1)>(vb);
  const s16x4 l2 = tr_read<v_rd_off(D0, 2, 0)>(vb), h2 = tr_read<v_rd_off(D0, 2, 1)>(vb), l3 = tr_read<v_rd_off(D0, 3, 0)>(vb), h3 = tr_read<v_rd_off(D0, 3, 1)>(vb);
  asm volatile("s_waitcnt lgkmcnt(0)" ::: "memory"); SBAR();
#define PK(L, H) (bf16x8){L[0], L[1], L[2], L[3], H[0], H[1], H[2], H[3]}
  od = __builtin_amdgcn_mfma_f32_32x32x16_bf16(pa0, PK(l0, h0), od, 0, 0, 0);
  od = __builtin_amdgcn_mfma_f32_32x32x16_bf16(pa1, PK(l1, h1), od, 0, 0, 0);
  od = __builtin_amdgcn_mfma_f32_32x32x16_bf16(pa2, PK(l2, h2), od, 0, 0, 0);
  od = __builtin_amdgcn_mfma_f32_32x32x16_bf16(pa3, PK(l3, h3), od, 0, 0, 0);
#undef PK
}
__device__ __forceinline__ void pv_d0(f32x16* o, int vb, bf16x8 pa0, bf16x8 pa1, bf16x8 pa2, bf16x8 pa3) {
  pv_one<0>(o[0], vb, pa0, pa1, pa2, pa3); pv_one<1>(o[1], vb, pa0, pa1, pa2, pa3); pv_one<2>(o[2], vb, pa0, pa1, pa2, pa3); pv_one<3>(o[3], vb, pa0, pa1, pa2, pa3);
}
constexpr int LDQ = NP, LDK = NP, LDO = DM;
__device__ __forceinline__ void attn_unit(const bf16* __restrict__ Qb, const bf16* __restrict__ Kh, const bf16* __restrict__ Vh, bf16* __restrict__ Ob, int seq, char* lds, int tid) {
  const int wid = tid >> 6, lane = tid & 63, r32 = lane & 31, hi = lane >> 5;
  bf16* V_lds = (bf16*)lds; bf16* K_lds = (bf16*)(lds + 2 * SHM_V);
  float* ws = (float*)(lds + 2 * SHM_V + 2 * SHM_K) + wid * 64; float* li_l = ws; float* al_l = ws + 32;
  float m_reg = -1e30f, l_reg = 0; f32x16 o[4] = {}; bf16x8 qr[4];
  const bf16* Qw = Qb + (long)(wid * QBLK + r32) * LDQ + hi * 8;
#pragma unroll
  for (int d0 = 0; d0 < 4; ++d0) qr[d0] = *(const __attribute__((address_space(1))) bf16x8*)(Qw + d0 * 16);
  const int sr = tid >> 4, sc = (tid & 15) * 8, vst0 = v_st(sr, sc), vst1 = v_st(32 + sr, sc);
  const int kr = tid >> 3, kc = (tid & 7) * 8, kst = KSWZ64(kr, kc * 2);
  const int vb0 = (int)(uintptr_t)V_lds + v_rd_base(lane);
  struct { bf16x8 vs0, vs1, ks0; } sr_[2];
#define GLD8(p) (*(const __attribute__((address_space(1))) bf16x8*)(p))
#define SLOAD(i, k0) do { sr_[i].vs0 = GLD8(&Vh[(long)((k0) + sr) * LDK + sc]); sr_[i].vs1 = GLD8(&Vh[(long)((k0) + 32 + sr) * LDK + sc]); \
    sr_[i].ks0 = GLD8(&Kh[(long)((k0) + kr) * LDK + kc]); } while (0)
#define SWRITE(b, i) do { *(bf16x8*)((char*)V_lds + (b) * SHM_V + vst0) = sr_[i].vs0; *(bf16x8*)((char*)V_lds + (b) * SHM_V + vst1) = sr_[i].vs1; \
    *(bf16x8*)((char*)K_lds + (b) * SHM_K + kst) = sr_[i].ks0; } while (0)
#define SWAIT() asm volatile("s_waitcnt vmcnt(3)" ::: "memory")
#define RESC(a) do { if (__any((a) < 1.f)) { if (hi == 0) al_l[r32] = (a); asm volatile("s_waitcnt lgkmcnt(0)" ::: "memory"); \
    _Pragma("unroll") for (int d = 0; d < 4; ++d) _Pragma("unroll") for (int r = 0; r < 16; ++r) o[d][r] *= al_l[crow(r, hi)]; } } while (0)
  f32x16 pA0, pA1, pB0, pB1; float mnA, mnB, alA, alB; bf16x8 pa0, pa1, pa2, pa3; const int NT = seq / KVBLK;
  constexpr int SE = 0, SO = 1;
  SLOAD(SE, 0); asm volatile("s_waitcnt vmcnt(0)" ::: "memory"); SWRITE(0, SE); __syncthreads();
  qkt(pA0, pA1, K_lds, qr, r32, hi); partialSM(pA0, pA1, m_reg, mnA, alA);
  SLOAD(SO, KVBLK); if (2 < NT) SLOAD(SE, 2 * KVBLK);
  SWAIT(); SWRITE(1, SO); __syncthreads();
  for (int j = 1; j + 1 < NT; j += 2) {
    SBAR(); qkt(pB0, pB1, (bf16*)((char*)K_lds + SHM_K), qr, r32, hi);
    finishSM(pA0, pA1, alA, l_reg, pa0, pa1, pa2, pa3); SBAR();
    SLOAD(SO, (j + 2) * KVBLK); SBAR();
    pv_d0(o, vb0, pa0, pa1, pa2, pa3); partialSM(pB0, pB1, m_reg, mnB, alB);
    __syncthreads(); SWAIT(); SWRITE(0, SE);
    RESC(alB); __syncthreads();
    SBAR(); qkt(pA0, pA1, K_lds, qr, r32, hi);
    finishSM(pB0, pB1, alB, l_reg, pa0, pa1, pa2, pa3); SBAR();
    if (j + 3 < NT) SLOAD(SE, (j + 3) * KVBLK); SBAR();
    pv_d0(o, vb0 + (int)SHM_V, pa0, pa1, pa2, pa3); partialSM(pA0, pA1, m_reg, mnA, alA);
    __syncthreads(); SWAIT(); SWRITE(1, SO);
    RESC(alA); __syncthreads();
  }
  SBAR(); qkt(pB0, pB1, (bf16*)((char*)K_lds + SHM_K), qr, r32, hi);
  finishSM(pA0, pA1, alA, l_reg, pa0, pa1, pa2, pa3); SBAR();
  pv_d0(o, vb0, pa0, pa1, pa2, pa3); partialSM(pB0, pB1, m_reg, mnB, alB);
  __syncthreads(); RESC(alB);
  finishSM(pB0, pB1, alB, l_reg, pa0, pa1, pa2, pa3); SBAR();
  pv_d0(o, vb0 + (int)SHM_V, pa0, pa1, pa2, pa3);
  if (hi == 0) li_l[r32] = l_reg; asm volatile("s_waitcnt lgkmcnt(0)" ::: "memory");
  float rli[16];
#pragma unroll
  for (int r = 0; r < 16; ++r) rli[r] = __builtin_amdgcn_rcpf(li_l[crow(r, hi)]);
  bf16* Ow = Ob + (long)(wid * QBLK) * LDO;
#pragma unroll
  for (int r = 0; r < 16; ++r) { const int orow = crow(r, hi);
#pragma unroll
    for (int d0 = 0; d0 < 4; ++d0) Ow[(long)orow * LDO + d0 * 32 + r32] = (bf16)(cvtpk(o[d0][r] * rli[r], 0.f) & 0xffffu); }
#undef SLOAD
#undef GLD8
#undef SWRITE
#undef SWAIT
#undef RESC
}
}

__device__ __forceinline__ int gla_item(int b, int h, int dir, int c) { return ((b * 4 + h) * 2 + dir) * NCH + c; }
namespace gla {
using att::bf16x8; using att::f32x16; using att::u32x4;
__device__ __forceinline__ void gates8(const bf16* P, const float* w2, const float* gb, size_t row0, int dir, int seg, int k, float (&gl)[8]) {
    float w[16];
#pragma unroll
    for (int j = 0; j < 16; ++j) w[j] = w2[j * 256 + k];
    const float bias = gb[k];
#pragma unroll
    for (int i = 0; i < 8; ++i) {
        const bf16* gp = P + (row0 + seg * 8 + i) * NP + C_GLR + dir * 16;
        const v4u a = *(const v4u*)gp, b = *(const v4u*)(gp + 8);
        float z = bias;
        z += bflo(a.x) * w[0] + bfhi(a.x) * w[1] + bflo(a.y) * w[2] + bfhi(a.y) * w[3] + bflo(a.z) * w[4] + bfhi(a.z) * w[5] + bflo(a.w) * w[6] + bfhi(a.w) * w[7];
        z += bflo(b.x) * w[8] + bfhi(b.x) * w[9] + bflo(b.y) * w[10] + bfhi(b.y) * w[11] + bflo(b.z) * w[12] + bfhi(b.z) * w[13] + bflo(b.w) * w[14] + bfhi(b.w) * w[15];
        gl[i] = (fminf(z, 0.f) - log1pf(expf(-fabsf(z)))) * (1.f / 16.f);
    }
}
__device__ __forceinline__ float lscan(const float (&gl)[8], int dir, float (&loc)[8]) {
    float run = 0.f;
    if (dir == 0) {
#pragma unroll
        for (int i = 0; i < 8; ++i) { run += gl[i]; loc[i] = run; }
    } else {
#pragma unroll
        for (int i = 7; i >= 0; --i) { run += gl[i]; loc[i] = run; }
    }
    return run;
}
__device__ __forceinline__ void stage_tile_bf16(const bf16* src, size_t pitch, char* tile, int tid) {
    const int sr = tid >> 4, sc = (tid & 15) * 8;
    const bf16x8 a = *reinterpret_cast<const bf16x8*>(src + (size_t)sr * pitch + sc), b = *reinterpret_cast<const bf16x8*>(src + (size_t)(32 + sr) * pitch + sc);
    *(bf16x8*)(tile + att::v_st(sr, sc)) = a; *(bf16x8*)(tile + att::v_st(32 + sr, sc)) = b;
}
__device__ __forceinline__ void stage_tile_f32(const float* src, char* tile, int tid) {
    const int sr = tid >> 4, sc = (tid & 15) * 8;
#pragma unroll
    for (int t = 0; t < 2; ++t) { const int row = sr + 32 * t; const f32x4 x = *(const f32x4*)(src + row * 128 + sc), y = *(const f32x4*)(src + row * 128 + sc + 4);
        u32x4 w = {att::cvtpk(x[0], x[1]), att::cvtpk(x[2], x[3]), att::cvtpk(y[0], y[1]), att::cvtpk(y[2], y[3])};
        *(u32x4*)(tile + att::v_st(row, sc)) = w; }
}
__device__ __forceinline__ void pv_sel(int d0, f32x16& o, int vb, bf16x8 a0, bf16x8 a1, bf16x8 a2, bf16x8 a3) {
    switch (d0) { case 0: att::pv_one<0>(o, vb, a0, a1, a2, a3); break; case 1: att::pv_one<1>(o, vb, a0, a1, a2, a3); break;
                  case 2: att::pv_one<2>(o, vb, a0, a1, a2, a3); break; default: att::pv_one<3>(o, vb, a0, a1, a2, a3); break; }
}
__device__ __forceinline__ void afrag4(const char* img, int row, int hi, bf16x8 (&a)[4]) {
#pragma unroll
    for (int s = 0; s < 4; ++s) a[s] = *reinterpret_cast<const bf16x8*>(img + KSWZ64(row, (s * 16 + hi * 8) * 2));
}
__device__ __forceinline__ void st_sw(char* img, int row, int col, float v) { *(unsigned short*)(img + KSWZ64(row, col * 2)) = (unsigned short)(att::cvtpk(v, 0.f) & 0xffffu); }
}

constexpr size_t WS_OG = WS_DS;
constexpr int CW_Q = 12288;
struct GlaPre { unsigned g; unsigned short q[8], k[8]; att::bf16x8 v0, v1; };
__device__ __forceinline__ void gla_prefetch(GlaPre& R, const bf16* P_, size_t row0, int h, int dir, int k, int seg, int tid) {
    const GAS bf16* P = (const GAS bf16*)P_;
    R.g = *(const GAS unsigned*)(P + (row0 + seg * 8 + (k >> 3)) * NP + C_GLR + dir * 16 + (k & 7) * 2);
#pragma unroll
    for (int i = 0; i < 8; ++i) { const GAS bf16* rp = P + (row0 + seg * 8 + i) * NP; R.q[i] = rp[C_GQ + h * 64 + k]; R.k[i] = rp[C_GK + h * 64 + k]; }
    const int sr = tid >> 4, sc = (tid & 15) * 8;
    R.v0 = *(const GAS att::bf16x8*)(P + (row0 + sr) * NP + C_GV + h * 128 + sc); R.v1 = *(const GAS att::bf16x8*)(P + (row0 + 32 + sr) * NP + C_GV + h * 128 + sc);
}
__device__ __forceinline__ void gla_chain(Frame& F, int l, int chain) {
    const int b = chain >> 3, h = (chain >> 1) & 3, dir = chain & 1;
    const bf16* P = (const bf16*)(F.ws + WS_PROJ); bf16* OG = (bf16*)(F.ws + WS_OG) + (size_t)dir * M * 512;
    char* lds = (char*)F.lds; char* Vt = lds; char* St = lds + 16384; char* KtT = lds + 32768; char* Kt = lds + 40960; char* Qt = lds + 49152; char* Qh = lds + 57344;
    float* T = (float*)(lds + 65536); float* Dec = (float*)(lds + 67584);
    const int k = F.lane, seg = F.tid >> 6, r32 = F.lane & 31, hi = F.lane >> 5, mt = F.wave >> 2, d0 = F.wave & 3;
    const int vbV = (int)(uintptr_t)Vt + att::v_rd_base(F.lane), vbS = (int)(uintptr_t)St + att::v_rd_base(F.lane);
    const int sr = F.tid >> 4, sc = (F.tid & 15) * 8;
    float w[16];
    { const float* w2 = INP(11) + (size_t)((l * 2 + dir) * 16) * 256 + h * 64;
#pragma unroll
      for (int j = 0; j < 16; ++j) w[j] = w2[j * 256 + k]; }
    const float bias = (INP(12) + (l * 2 + dir) * 256 + h * 64)[k];
    att::f32x16 S = {};
    GlaPre R, RN;
    { const int c0 = dir == 0 ? 0 : 3; gla_prefetch(RN, P, (size_t)b * TPB + c0 * 64, h, dir, k, seg, F.tid); }
    for (int j = 0; j < NCH; ++j) {
        const int c = dir == 0 ? j : (j < 4 ? 3 - j : 39 - j);
        const size_t row0 = (size_t)b * TPB + c * 64;
        R = RN;
        if (j + 1 < NCH) { const int cn = dir == 0 ? j + 1 : (j + 1 < 4 ? 2 - j : 38 - j); gla_prefetch(RN, P, (size_t)b * TPB + cn * 64, h, dir, k, seg, F.tid); }
        float gl[8], loc[8];
#pragma unroll
        for (int i = 0; i < 8; ++i) {
            float z = bias;
#pragma unroll
            for (int d = 0; d < 8; ++d) { const unsigned s = (unsigned)__builtin_amdgcn_readlane((int)R.g, i * 8 + d); z += bflo(s) * w[2 * d] + bfhi(s) * w[2 * d + 1]; }
            gl[i] = (fminf(z, 0.f) - __logf(1.f + __expf(-fabsf(z)))) * (1.f / 16.f); }
        const float segtot = gla::lscan(gl, dir, loc);
        T[seg * 64 + k] = segtot;
        *(att::bf16x8*)(Vt + att::v_st(sr, sc)) = R.v0; *(att::bf16x8*)(Vt + att::v_st(32 + sr, sc)) = R.v1;
#pragma unroll
        for (int r = 0; r < 16; ++r) *(unsigned short*)(St + att::v_st(mt * 32 + att::crow(r, hi), d0 * 32 + r32)) = (unsigned short)(att::cvtpk(S[r], 0.f) & 0xffffu);
        __syncthreads();
        float off = 0.f, tot = 0.f;
        int sg = seg; asm volatile("" : "+v"(sg));
#pragma unroll
        for (int s = 0; s < 8; ++s) { const float t = T[s * 64 + k]; tot += t; const bool inoff = dir == 0 ? (s < sg) : (s > sg); off += inoff ? t : 0.f; }
        const float etot = __expf(tot);
        float kt[8];
#pragma unroll
        for (int i = 0; i < 8; ++i) { const int tau = seg * 8 + i; const float qv = bf2f(R.q[i]), kv = bf2f(R.k[i]); const float cc = loc[i] + off;
            const float a = fmaxf(__expf(cc), 1e-30f)  , bq = __builtin_amdgcn_rcpf(a), kb = kv * bq;
            kt[i] = kb * etot;
            gla::st_sw(Qh, tau, k, qv * a); gla::st_sw(Kt, tau, k, kb); }
        { att::u32x4 wv = {att::cvtpk(kt[0], kt[1]), att::cvtpk(kt[2], kt[3]), att::cvtpk(kt[4], kt[5]), att::cvtpk(kt[6], kt[7])};
          *(att::u32x4*)(KtT + KSWZ64(k, seg * 16)) = wv; }
        if (sg == 0) Dec[k] = etot;
        __syncthreads();
        att::f32x16 o = {};
        int tau_q = mt * 32 + r32; asm volatile("" : "+v"(tau_q));
        { att::bf16x8 qr[4]; gla::afrag4(Qh, tau_q, hi, qr);
          att::f32x16 p0, p1; att::qkt(p0, p1, (const bf16*)Kt, qr, r32, hi);
#pragma unroll
          for (int r = 0; r < 16; ++r) { const int t0 = att::crow(r, hi), t1 = 32 + t0;
              const bool k0 = dir == 0 ? (t0 <= tau_q) : (t0 >= tau_q), k1 = dir == 0 ? (t1 <= tau_q) : (t1 >= tau_q);
              p0[r] = k0 ? p0[r] : 0.f; p1[r] = k1 ? p1[r] : 0.f; }
          att::bf16x8 pa0, pa1, pa2, pa3; att::pack_p(p0, p1, pa0, pa1, pa2, pa3);
          gla::pv_sel(d0, o, vbV, pa0, pa1, pa2, pa3);
          gla::pv_sel(d0, o, vbS, qr[0], qr[1], qr[2], qr[3]); }
#pragma unroll
        for (int r = 0; r < 16; ++r) S[r] *= Dec[mt * 32 + att::crow(r, hi)];
        { att::bf16x8 a[4]; gla::afrag4(KtT, mt * 32 + r32, hi, a); gla::pv_sel(d0, S, vbV, a[0], a[1], a[2], a[3]); }
        GAS bf16* op = (GAS bf16*)(OG + row0 * 512 + h * 128 + d0 * 32 + r32);
#pragma unroll
        for (int r = 0; r < 16; ++r) op[(size_t)(mt * 32 + att::crow(r, hi)) * 512] = (bf16)(att::cvtpk(o[r], 0.f) & 0xffffu);
        __syncthreads();
    }
}
__device__ __forceinline__ void p3_mixer(Frame& F, int l) {
    refresh(F);
    for (int ch = F.blk; ch < NBATCH * 8; ch += F.G) gla_chain(F, l, ch);
    const bf16* P = (const bf16*)(F.ws + WS_PROJ); bf16* OD = (bf16*)(F.ws + WS_OD);
    volatile LAS unsigned* slot = F.MISC + 24;
    int myq = F.blk & 7, tries = 0;
    for (;;) {
        __syncthreads();
        if (F.tid == 0) slot[0] = __hip_atomic_fetch_add((unsigned*)((gu32*)F.ws + CW_Q + 64 * l + 8 * 0 + myq), 1u, __ATOMIC_RELAXED, __HIP_MEMORY_SCOPE_AGENT);
        __syncthreads();
        const int u = (int)slot[0];
        if (u >= (l == DEPTH - 1 ? 128 : 144)) { if (++tries >= 8) break; myq = (myq + 1) & 7; continue; }
        int g, qt;
        if (u < 128) { const int pi = u >> 4, mp = (u >> 3) & 1; g = ((pi * 8 + myq) << 1) + mp; qt = 1 + (u & 7); }
        else { const int gi = u - 128; g = (((gi >> 1) * 8 + myq) << 1) + (gi & 1); qt = 0; }
        const int b = g >> 3, hh = g & 7;
        const size_t row0 = (size_t)b * TPB;
        att::attn_unit(P + (row0 + qt * 256) * NP + C_Q + hh * 64, P + row0 * NP + C_K + hh * 64, P + row0 * NP + C_V + (hh >> 1) * 128,
                       OD + (row0 + qt * 256) * DM + hh * 128, qt == 0 ? CTX : TPB, (char*)F.lds, F.tid);
    }
    __syncthreads();
}
__device__ __forceinline__ void p5_merge_all(Frame& F, int l) {
    refresh(F);
    const bf16* OD = (const bf16*)(F.ws + WS_OD); const bf16* OG = (const bf16*)(F.ws + WS_OG); const bf16* P = (const bf16*)(F.ws + WS_PROJ); bf16* MRG = (bf16*)(F.ws + WS_H);
    const float lam = ((const float*)(F.ws + WS_ROPE + 16384))[l]; const float omli = 1.f - lam_init_of(l);
    const float* subln = INP(14) + l * 128; const float* onorm = INP(15) + l * 128;
    const int h = F.lane >> 4, c0 = (F.lane & 15) * 8;
    const int rpw = (M + F.NGW - 1) / F.NGW, r0 = F.gw * rpw, r1 = (r0 + rpw < M) ? r0 + rpw : M;
    for (int r = r0; r < r1; ++r) {
        const v4u a = *(const v4u*)(OD + (size_t)r * DM + h * 256 + c0), bq = *(const v4u*)(OD + (size_t)r * DM + h * 256 + 128 + c0);
        const v4u gf = *(const v4u*)(OG + (size_t)r * 512 + h * 128 + c0), gbk = *(const v4u*)(OG + ((size_t)M + r) * 512 + h * 128 + c0);
        const v4u gt = *(const v4u*)(P + (size_t)r * NP + C_GG + h * 128 + c0);
        float d[8], e[8], g[8];
        d[0] = bflo(a.x) - lam * bflo(bq.x); d[1] = bfhi(a.x) - lam * bfhi(bq.x); d[2] = bflo(a.y) - lam * bflo(bq.y); d[3] = bfhi(a.y) - lam * bfhi(bq.y);
        d[4] = bflo(a.z) - lam * bflo(bq.z); d[5] = bfhi(a.z) - lam * bfhi(bq.z); d[6] = bflo(a.w) - lam * bflo(bq.w); d[7] = bfhi(a.w) - lam * bfhi(bq.w);
        e[0] = bflo(gf.x) + bflo(gbk.x); e[1] = bfhi(gf.x) + bfhi(gbk.x); e[2] = bflo(gf.y) + bflo(gbk.y); e[3] = bfhi(gf.y) + bfhi(gbk.y);
        e[4] = bflo(gf.z) + bflo(gbk.z); e[5] = bfhi(gf.z) + bfhi(gbk.z); e[6] = bflo(gf.w) + bflo(gbk.w); e[7] = bfhi(gf.w) + bfhi(gbk.w);
        g[0] = bflo(gt.x); g[1] = bfhi(gt.x); g[2] = bflo(gt.y); g[3] = bfhi(gt.y); g[4] = bflo(gt.z); g[5] = bfhi(gt.z); g[6] = bflo(gt.w); g[7] = bfhi(gt.w);
        float ss = 0.f, se = 0.f;
#pragma unroll
        for (int i = 0; i < 8; ++i) { ss += d[i] * d[i]; se += e[i] * e[i]; }
        ss = xadd<1>(ss); ss = xadd<2>(ss); ss = xadd<4>(ss); ss = xadd<8>(ss);
        se = xadd<1>(se); se = xadd<2>(se); se = xadd<4>(se); se = xadd<8>(se);
        const float sc = omli / sqrtf(ss * (1.f / 128.f) + EPS), se2 = 1.0f / sqrtf(se * (1.f / 128.f) + EPS);
#pragma unroll
        for (int i = 0; i < 8; ++i) { d[i] = d[i] * sc * subln[c0 + i]; e[i] = e[i] * se2 * onorm[c0 + i] * siluf(g[i]); }
        v4u w; w.x = pg8::cvt_pk_bf16(d[0], d[1]); w.y = pg8::cvt_pk_bf16(d[2], d[3]); w.z = pg8::cvt_pk_bf16(d[4], d[5]); w.w = pg8::cvt_pk_bf16(d[6], d[7]);
        *(v4u*)(MRG + (size_t)r * DM + h * 128 + c0) = w;
        v4u x; x.x = pg8::cvt_pk_bf16(e[0], e[1]); x.y = pg8::cvt_pk_bf16(e[2], e[3]); x.z = pg8::cvt_pk_bf16(e[4], e[5]); x.w = pg8::cvt_pk_bf16(e[6], e[7]);
        *(v4u*)(MRG + (size_t)r * DM + 512 + h * 128 + c0) = x;
    }
}

__device__ __forceinline__ float dpp_sum16(float v) {
    v += __int_as_float(__builtin_amdgcn_update_dpp(0, __float_as_int(v), 0xB1, 0xF, 0xF, true));
    v += __int_as_float(__builtin_amdgcn_update_dpp(0, __float_as_int(v), 0x4E, 0xF, 0xF, true));
    v += __int_as_float(__builtin_amdgcn_update_dpp(0, __float_as_int(v), 0x141, 0xF, 0xF, true));
    v += __int_as_float(__builtin_amdgcn_update_dpp(0, __float_as_int(v), 0x140, 0xF, 0xF, true));
    return v;
}
__device__ __forceinline__ float wave_sum2(float v) { v = dpp_sum16(v); v = xadd<16>(v); v = xadd<32>(v); return v; }
__device__ __forceinline__ float row_rinv2(const f32x4 (&v)[4]) {
    float s = 0.f;
#pragma unroll
    for (int j = 0; j < 4; ++j) s += (v[j][0] * v[j][0] + v[j][1] * v[j][1]) + (v[j][2] * v[j][2] + v[j][3] * v[j][3]);
    return __builtin_amdgcn_rsqf(wave_sum2(s) * (1.f / DM) + EPS);
}
__device__ __forceinline__ void ld_raw_bf16(const bf16* row, int lane, u32x2 (&v)[4]) {
#pragma unroll
    for (int j = 0; j < 4; ++j) v[j] = *(const u32x2*)(row + 4 * lane + 256 * j);
}
__device__ __forceinline__ f32x4 raw2f(u32x2 w) { return (f32x4){bflo(w.x), bfhi(w.x), bflo(w.y), bfhi(w.y)}; }
__device__ __forceinline__ void ld_vec(const float* p, int lane, f32x4 (&v)[4]) {
#pragma unroll
    for (int j = 0; j < 4; ++j) v[j] = *(const f32x4*)(p + 4 * lane + 256 * j);
}

__device__ __forceinline__ void p1_rows(Frame& F, int l) {
    refresh(F);
    const float* MOD = (const float*)(F.ws + WS_MOD);
    bf16* X = (bf16*)(F.ws + WS_X); bf16* H = (bf16*)(F.ws + WS_H); const bf16* F2 = (const bf16*)(F.ws + WS_F2);
    const int rpw = (M + F.NGW - 1) / F.NGW, r0 = F.gw * rpw, r1 = (r0 + rpw < M) ? r0 + rpw : M;
    if (r0 >= r1) return;
    const bool two = l > 0 && ((l - 1) & 1);
    f32x4 gpre[4], gpost[4], sh[4], sc[4], gt[4];
    ld_vec(INP(6) + l * DM, F.lane, gpre);
    if (l > 0) ld_vec(INP(9) + (l - 1) * DM, F.lane, gpost);
    int cur = -1;
    f32x4 xn[4]; u32x2 xr[4], fn[4], gn[4];
#define P1_ISSUE(r) do { const int b_ = (r) / TPB, p_ = (r) % TPB; \
        if (l == 0) ld_row_f32(p_ < CTX ? INP(2) + ((size_t)b_ * CTX + p_) * DM : INP(0) + ((size_t)b_ * SEQ + (p_ - CTX)) * DM, F.lane, xn); \
        else ld_raw_bf16(X + (size_t)(r) * DM, F.lane, xr); \
        if (l > 0) { ld_raw_bf16(F2 + (size_t)(r) * DM, F.lane, fn); if (two) ld_raw_bf16(F2 + ((size_t)M + (r)) * DM, F.lane, gn); } } while (0)
    P1_ISSUE(r0);
    for (int r = r0; r < r1; ++r) {
        f32x4 x[4]; u32x2 fr[4], gr[4];
#pragma unroll
        for (int j = 0; j < 4; ++j) { x[j] = (l == 0) ? xn[j] : raw2f(xr[j]); fr[j] = fn[j]; gr[j] = gn[j]; }
        if (r + 1 < r1) P1_ISSUE(r + 1);
        const int b = r / TPB, p = r % TPB, mrow = p < CTX ? 16 : b;
        if (mrow != cur) { cur = mrow; const float* modp = MOD + ((size_t)l * 17 + mrow) * 6144; ld_vec(modp, F.lane, sh); ld_vec(modp + 1024, F.lane, sc);
            if (l > 0) ld_vec(MOD + ((size_t)(l - 1) * 17 + mrow) * 6144 + 5 * 1024, F.lane, gt); }
        if (l > 0) {
            f32x4 f[4];
#pragma unroll
            for (int j = 0; j < 4; ++j) { f[j] = raw2f(fr[j]); if (two) f[j] = f[j] + raw2f(gr[j]); }
            const float rinv = row_rinv2(f);
#pragma unroll
            for (int j = 0; j < 4; ++j) x[j] = x[j] + gt[j] * (f[j] * rinv * gpost[j]);
        }
        st_row_bf16(X + (size_t)r * DM, F.lane, x);
        const float rinv = row_rinv2(x);
        f32x4 h[4];
#pragma unroll
        for (int j = 0; j < 4; ++j) h[j] = (x[j] * rinv * gpre[j]) * (sc[j] + 1.0f) + sh[j];
        st_row_bf16(H + (size_t)r * DM, F.lane, h);
    }
#undef P1_ISSUE
}
__device__ __forceinline__ void pf_final(Frame& F) {
    refresh(F);
    const float* MOD = (const float*)(F.ws + WS_MOD);
    const bf16* X = (const bf16*)(F.ws + WS_X); const bf16* F2 = (const bf16*)(F.ws + WS_F2);
    const int l = DEPTH - 1, NR = NBATCH * SEQ;
    const int rpw = (NR + F.NGW - 1) / F.NGW, i0 = F.gw * rpw, i1 = (i0 + rpw < NR) ? i0 + rpw : NR;
    if (i0 >= i1) return;
    f32x4 gpost[4], gt[4]; ld_vec(INP(9) + l * DM, F.lane, gpost);
    int cur = -1;
    u32x2 xn[4], fn[4], gn[4];
#define PF_ISSUE(i) do { const size_t r_ = (size_t)((i) / SEQ) * TPB + CTX + (i) % SEQ; ld_raw_bf16(X + r_ * DM, F.lane, xn); ld_raw_bf16(F2 + r_ * DM, F.lane, fn); ld_raw_bf16(F2 + ((size_t)M + r_) * DM, F.lane, gn); } while (0)
    PF_ISSUE(i0);
    for (int i = i0; i < i1; ++i) {
        f32x4 x[4], f[4];
#pragma unroll
        for (int j = 0; j < 4; ++j) { x[j] = raw2f(xn[j]); f[j] = raw2f(fn[j]) + raw2f(gn[j]); }
        if (i + 1 < i1) PF_ISSUE(i + 1);
        const int b = i / SEQ;
        if (b != cur) { cur = b; ld_vec(MOD + ((size_t)l * 17 + b) * 6144 + 5 * 1024, F.lane, gt); }
        const float rinv = row_rinv2(f);
#pragma unroll
        for (int j = 0; j < 4; ++j) x[j] = x[j] + gt[j] * (f[j] * rinv * gpost[j]);
        st_row_f32(F.A->out + (size_t)i * DM, F.lane, x);
    }
#undef PF_ISSUE
}
__device__ __forceinline__ void p7_rows(Frame& F, int l) {
    refresh(F);
    const float* MOD = (const float*)(F.ws + WS_MOD);
    bf16* X = (bf16*)(F.ws + WS_X); const bf16* Y = (const bf16*)(F.ws + WS_Y); bf16* H2 = (bf16*)(F.ws + WS_H2);
    const bool moe = l & 1; const int li = l >> 1;
    int* TOPE = (int*)(F.ws + WS_TOPE); int* LIDX = (int*)(F.ws + WS_LIDX); float* TOPW = (float*)(F.ws + WS_TOPW); int* BLKB = (int*)(F.ws + WS_BLKB);
    volatile LAS unsigned* LCNT = F.MISC + 16;
    LAS float* RT = (LAS float*)F.lds;
    if (moe) {
        const float* router = INP(20) + (size_t)li * DM * NE;
        if (F.tid < 8) LCNT[F.tid] = 0u;
        for (int i = F.tid; i < DM * NE / 4; i += 512) { const f32x4 q = *(const f32x4*)(router + 4 * i); const int c = i >> 1, e0 = (i & 1) * 4;
            RT[(e0 + 0) * DM + c] = q[0]; RT[(e0 + 1) * DM + c] = q[1]; RT[(e0 + 2) * DM + c] = q[2]; RT[(e0 + 3) * DM + c] = q[3]; }
        __syncthreads();
    }
    const bool lastl = (l == DEPTH - 1); const int NR = lastl ? NBATCH * SEQ : M;
#define P7_ROW(i) (lastl ? ((i) / SEQ) * TPB + CTX + (i) % SEQ : (i))
    const int rpw = (NR + F.NGW - 1) / F.NGW, r0 = F.gw * rpw, r1 = (r0 + rpw < NR) ? r0 + rpw : NR;
    if (r0 < r1) {
        f32x4 gpost[4], gpre[4], gt[4], sh[4], sc[4];
        ld_vec(INP(7) + l * DM, F.lane, gpost); ld_vec(INP(8) + l * DM, F.lane, gpre);
        int cur = -1;
        u32x2 xn[4], yn[4];
        ld_raw_bf16(X + (size_t)P7_ROW(r0) * DM, F.lane, xn); ld_raw_bf16(Y + (size_t)P7_ROW(r0) * DM, F.lane, yn);
        for (int ri = r0; ri < r1; ++ri) {
            const int r = P7_ROW(ri);
            f32x4 x[4], y[4];
#pragma unroll
            for (int j = 0; j < 4; ++j) { x[j] = raw2f(xn[j]); y[j] = raw2f(yn[j]); }
            if (ri + 1 < r1) { const int rn = P7_ROW(ri + 1); ld_raw_bf16(X + (size_t)rn * DM, F.lane, xn); ld_raw_bf16(Y + (size_t)rn * DM, F.lane, yn); }
            const int b = r / TPB, p = r % TPB, mrow = p < CTX ? 16 : b;
            if (mrow != cur) { cur = mrow; const float* modp = MOD + ((size_t)l * 17 + mrow) * 6144; ld_vec(modp + 2 * 1024, F.lane, gt); ld_vec(modp + 3 * 1024, F.lane, sh); ld_vec(modp + 4 * 1024, F.lane, sc); }
            const float ry = row_rinv2(y);
#pragma unroll
            for (int j = 0; j < 4; ++j) x[j] = x[j] + gt[j] * (y[j] * ry * gpost[j]);
            st_row_bf16(X + (size_t)r * DM, F.lane, x);
            const float rx = row_rinv2(x);
            f32x4 h[4];
#pragma unroll
            for (int j = 0; j < 4; ++j) h[j] = (x[j] * rx * gpre[j]) * (sc[j] + 1.0f) + sh[j];
            if constexpr (FFN_F8) {
#pragma unroll
                for (int j = 0; j < 4; ++j) *(unsigned*)((unsigned char*)H2 + (size_t)r * DM + 4 * F.lane + 256 * j) = pk4_f8(h[j][0], h[j][1], h[j][2], h[j][3]);
            } else st_row_bf16(H2 + (size_t)r * DM, F.lane, h);
            if (moe) {
                float lg[8];
#pragma unroll
                for (int e = 0; e < 8; ++e) lg[e] = 0.f;
#pragma unroll
                for (int j = 0; j < 4; ++j)
#pragma unroll
                    for (int e = 0; e < 8; ++e) { const f32x4 q = *(const LAS f32x4*)(RT + e * DM + 4 * F.lane + 256 * j); lg[e] += (h[j][0] * q[0] + h[j][1] * q[1]) + (h[j][2] * q[2] + h[j][3] * q[3]); }
#pragma unroll
                for (int e = 0; e < 8; ++e) lg[e] = wave_sum2(lg[e]);
                int e0 = 0; float v0 = lg[0];
#pragma unroll
                for (int e = 1; e < 8; ++e) if (lg[e] > v0) { v0 = lg[e]; e0 = e; }
                int e1 = -1; float v1 = -3.0e38f;
#pragma unroll
                for (int e = 0; e < 8; ++e) if (e != e0 && lg[e] > v1) { v1 = lg[e]; e1 = e; }
                const float ex = __expf(v1 - v0), w0 = 1.f / (1.f + ex), w1 = ex / (1.f + ex);
                if (F.lane == 0) {
                    const unsigned i0 = __hip_atomic_fetch_add((LAS unsigned*)&LCNT[e0], 1u, __ATOMIC_RELAXED, __HIP_MEMORY_SCOPE_WORKGROUP), i1 = __hip_atomic_fetch_add((LAS unsigned*)&LCNT[e1], 1u, __ATOMIC_RELAXED, __HIP_MEMORY_SCOPE_WORKGROUP);
                    TOPE[r] = e0 | (e1 << 8); LIDX[2 * r] = (int)i0; LIDX[2 * r + 1] = (int)i1; TOPW[2 * r] = w0; TOPW[2 * r + 1] = w1;
                }
            }
        }
    }
    if (moe) {
        __syncthreads();
        if (F.tid < 8) { const unsigned base = __hip_atomic_fetch_add((unsigned*)((gu32*)F.ws + CW_CNT + 64 * li + F.tid), LCNT[F.tid], __ATOMIC_RELAXED, __HIP_MEMORY_SCOPE_AGENT); BLKB[F.blk * 8 + F.tid] = (int)base; }
    }
#undef P7_ROW
}
__device__ __forceinline__ void moe_offsets(Frame& F, int li, int (&cnt)[8], int (&off)[9]) {
    off[0] = 0;
#pragma unroll
    for (int e = 0; e < 8; ++e) { cnt[e] = (int)__hip_atomic_load((unsigned*)(((gu32*)F.ws) + CW_CNT + 64 * li + e), __ATOMIC_RELAXED, __HIP_MEMORY_SCOPE_AGENT); off[e + 1] = off[e] + ((cnt[e] + 255) & ~255); }
}
__device__ __forceinline__ void p7b_gather(Frame& F, int l) {
    refresh(F);
    const int li = l >> 1; int cnt[8], off[9]; moe_offsets(F, li, cnt, off);
    const bf16* H2 = (const bf16*)(F.ws + WS_H2); bf16* HG = (bf16*)(F.ws + WS_HG);
    const int* TOPE = (const int*)(F.ws + WS_TOPE); const int* LIDX = (const int*)(F.ws + WS_LIDX); const float* TOPW = (const float*)(F.ws + WS_TOPW); const int* BLKB = (const int*)(F.ws + WS_BLKB);
    int* RMAP = (int*)(F.ws + WS_RMAP); float* ROWW = (float*)(F.ws + WS_ROWW);
    constexpr int RB = FFN_F8 ? DM : 2 * DM, LB = RB / 64;
    const unsigned char* H2b = (const unsigned char*)H2; unsigned char* HGb = (unsigned char*)HG;
    const bool lastl = (l == DEPTH - 1); const int NR = lastl ? NBATCH * SEQ : M;
    const int rpw = (NR + F.NGW - 1) / F.NGW, r0 = F.gw * rpw, r1 = (r0 + rpw < NR) ? r0 + rpw : NR;
    for (int ri = r0; ri < r1; ++ri) {
        const int r = lastl ? (ri / SEQ) * TPB + CTX + ri % SEQ : ri;
        const int te = TOPE[r];
        v4u a, bq = {0u, 0u, 0u, 0u}; a = *(const v4u*)(H2b + (size_t)r * RB + F.lane * LB); if constexpr (!FFN_F8) bq = *(const v4u*)(H2b + (size_t)r * RB + F.lane * LB + 16);
#pragma unroll
        for (int s = 0; s < 2; ++s) {
            const int e = (te >> (8 * s)) & 0xff;
            int o = 0;
#pragma unroll
            for (int q = 0; q < 8; ++q) o = (q == e) ? off[q] : o;
            const int pos = o + BLKB[F.blk * 8 + e] + LIDX[2 * r + s];
            *(v4u*)(HGb + (size_t)pos * RB + F.lane * LB) = a; if constexpr (!FFN_F8) *(v4u*)(HGb + (size_t)pos * RB + F.lane * LB + 16) = bq;
            if (F.lane == 0) { RMAP[pos] = r | (s << 30); ROWW[pos] = TOPW[2 * r + s]; }
        }
    }
#pragma unroll
    for (int e = 0; e < 8; ++e) {
        const int npad = off[e + 1] - off[e] - cnt[e];
        for (int i = F.gw; i < npad; i += F.NGW) { const int pos = off[e] + cnt[e] + i; const unsigned zz = (unsigned)F.z; const v4u z = {zz, zz, zz, zz};
            *(v4u*)(HGb + (size_t)pos * RB + F.lane * LB) = z; if constexpr (!FFN_F8) *(v4u*)(HGb + (size_t)pos * RB + F.lane * LB + 16) = z;
            if (F.lane == 0) { RMAP[pos] = -1; ROWW[pos] = 0.f; } }
    }
}

__global__ void __launch_bounds__(NWAVES * 64, 2) mk_fwd(Args args) {
    extern __shared__ __attribute__((aligned(16))) unsigned char lds[];
    Frame F;
    F.lds = (LAS unsigned char*)lds;
    F.MISC = (volatile LAS unsigned*)(F.lds + MISC_OFF);
    F.tid = threadIdx.x; F.lane = F.tid & 63; F.wave = __builtin_amdgcn_readfirstlane(F.tid >> 6); F.wv = F.wave;
    F.G = gridDim.x; F.blk = blockIdx.x; F.gw = F.blk * NWAVES + F.wave; F.NGW = F.G * NWAVES;
    F.ws = args.ws;
    F.A = &args;
    for (int u = F.tid; u < 128; u += NWAVES * 64) F.MISC[u] = 0u;
    __syncthreads();
    { XcdBarrier b0 = xcd_barrier_post((unsigned*)F.ws + CW_BAR, F.MISC + 8); (void)b0; }
#define GRID_BAR() do { XcdBarrier b_; b_.bar = (unsigned*)F.ws + CW_BAR; b_.x = xb_xcc_id(); b_.st = F.MISC + 8; refresh(F); xcd_barrier(b_, F.tid == 0); } while (0)

    p0_mod(F); p0_misc(F); convert_weights(F, 0);
    GRID_BAR();
    for (int l = 0; l < DEPTH; ++l) {
        const bool moe = l & 1; const int li = l >> 1;
        { unsigned char* wsp = args.ws; asm volatile("" : "+s"(wsp)); F.ws = wsp; }
        p1_rows(F, l);
        if (l > 0) convert_weights(F, l);
        GRID_BAR();
        {
            refresh(F);
            pg8::Gemm g{(const pg8::bf16_t*)(F.ws + WS_H), (const pg8::bf16_t*)(F.ws + WS_WIN), M, NP, DM};
            pg8::StaticOrder S; S.init(M, NP, F.G, F.blk);
            pg8::EpiProj E{(pg8::bf16_t*)(F.ws + WS_PROJ), (const float*)(F.ws + WS_ROPE), (const float*)(F.ws + WS_ROPE) + 1024};
            pg8::gemm_phase<pg8::EpiProj, pg8::StaticOrder, true, true>(F.lds, g, S, E, F.wave);
        }
        GRID_BAR();
        p3_mixer(F, l);
        GRID_BAR();
        p5_merge_all(F, l);
        GRID_BAR();
        {
            refresh(F);
            pg8::Gemm g{(const pg8::bf16_t*)(F.ws + WS_H), (const pg8::bf16_t*)(F.ws + WS_WOUT), M, DM, DM};
            const int lastl = (l == DEPTH - 1);
            pg8::LatOrder S; S.S.init(lastl ? NBATCH * SEQ : M, DM, F.G, F.blk); S.lat = lastl;
            pg8::EpiF32 E{(pg8::bf16_t*)(F.ws + WS_Y)};
            pg8::gemm_phase<pg8::EpiF32, pg8::LatOrder, true, true>(F.lds, g, S, E, F.wave);
        }
        GRID_BAR();
        p7_rows(F, l);
        GRID_BAR();
        if (moe) { p7b_gather(F, l); GRID_BAR(); }
        int ntiles = M / 256;
        {
            refresh(F);
            LAS int* texp = (LAS int*)(F.lds + TEXP_OFF);
            if (moe) { int cnt[8], off[9]; moe_offsets(F, li, cnt, off); ntiles = off[8] >> 8;
                for (int t = F.tid; t < ntiles; t += 512) { int e = 0;
#pragma unroll
                    for (int q = 1; q < 8; ++q) e += ((t << 8) >= off[q]) ? 1 : 0;
                    texp[t] = e; } }
            else { for (int t = F.tid; t < ntiles; t += 512) texp[t] = 0; }
            __syncthreads();
        }
        {
            refresh(F);
            pg8::Gemm g{(const pg8::bf16_t*)(F.ws + (moe ? WS_HG : WS_H2)), (const pg8::bf16_t*)(F.ws + WS_WUP), ntiles * 256, 2 * DFF, FFN_F8 ? DM / 2 : DM};
            pg8::GroupedOrder S; S.S.init(ntiles * 256, 2 * DFF, F.G, F.blk); S.texp = (const LAS int*)(F.lds + TEXP_OFF); S.nN = 22;
            pg8::EpiSwiglu E{(pg8::bf16_t*)(F.ws + WS_U)};
            pg8::gemm_phase<pg8::EpiSwiglu, pg8::GroupedOrder, true, true, FFN_F8 != 0>(F.lds, g, S, E, F.wave);
        }
        GRID_BAR();
        {
            refresh(F);
            pg8::Gemm g{(const pg8::bf16_t*)(F.ws + WS_U), (const pg8::bf16_t*)(F.ws + WS_WDN), ntiles * 256, DM, FFN_F8 ? DFF / 2 : DFF};
            pg8::GroupedOrder S; S.S.init(ntiles * 256, DM, F.G, F.blk); S.texp = (const LAS int*)(F.lds + TEXP_OFF); S.nN = 4;
            pg8::EpiDown E{(pg8::bf16_t*)(F.ws + WS_F2), (const int*)(F.ws + WS_RMAP), (const float*)(F.ws + WS_ROWW), moe ? 0 : 1};
            pg8::gemm_phase<pg8::EpiDown, pg8::GroupedOrder, true, true, FFN_F8 != 0>(F.lds, g, S, E, F.wave);
        }
        GRID_BAR();
    }
    pf_final(F);
}

extern "C" void kernel_launch(void* const* d_in, const int* in_sizes, int n_in, void* d_out, int out_size, void* d_ws, size_t ws_size, hipStream_t stream) {
    static int grid = 0;
    if (grid == 0) {
        if (n_in != 24 || out_size != NBATCH * SEQ * DM || ws_size < WS_END) { fprintf(stderr, "kernel_launch: unexpected shapes or workspace (%d inputs, out %d, ws %zu < %zu)\n", n_in, out_size, ws_size, (size_t)WS_END); grid = -1; return; }
        int dev = 0, cus = 0, per_cu = 0;
        if (hipGetDevice(&dev) != hipSuccess || hipDeviceGetAttribute(&cus, hipDeviceAttributeMultiprocessorCount, dev) != hipSuccess) { grid = -1; return; }
        if (hipFuncSetAttribute((const void*)mk_fwd, hipFuncAttributeMaxDynamicSharedMemorySize, LDS_BYTES) != hipSuccess) { grid = -1; return; }
        if (hipOccupancyMaxActiveBlocksPerMultiprocessor(&per_cu, (const void*)mk_fwd, NWAVES * 64, LDS_BYTES) != hipSuccess || per_cu < 1) { fprintf(stderr, "kernel_launch: occupancy query says %d\n", per_cu); }
        (void)hipGetLastError();
        grid = cus;
    }
    if (grid < 0) return;
    if (hipMemsetAsync((char*)d_ws + WS_CTL, 0, CTL_ZERO_BYTES, stream) != hipSuccess) return;
    Args a{};
    for (int i = 0; i < 24; ++i) a.in[i] = (const float*)d_in[i];
    a.out = (float*)d_out; a.ws = (unsigned char*)d_ws;
    hipLaunchKernelGGL(mk_fwd, dim3(grid), dim3(NWAVES * 64), LDS_BYTES, stream, a);
}
```

```cpp
#include <hip/hip_runtime.h>
#include <cstdio>
#include <cstdint>
namespace pg8 {
#define PG8_LAS __attribute__((address_space(3)))
typedef unsigned short bf16_t;
__device__ __forceinline__ int lane_id_opaque() { int l; asm volatile("v_mbcnt_lo_u32_b32 %0, -1, 0\n\tv_mbcnt_hi_u32_b32 %0, -1, %0" : "=v"(l)); return l; }
typedef short bf16x8 __attribute__((ext_vector_type(8)));
typedef float f32x4 __attribute__((ext_vector_type(4)));
typedef unsigned u32x4 __attribute__((ext_vector_type(4)));
constexpr int BM = 256, BK = 64, HALF = 128, HTB = HALF * BK * 2  , STAGE_BYTES = 8 * HTB, NXCD = 8, WGM = 8;

__host__ __device__ __forceinline__ int lds_byte(int r, int c) { const int st = (r >> 4) * 2 + (c >> 5), rr = r & 15, cc = c & 31, ob = rr * 64 + cc * 2; return st * 1024 + (ob ^ (((ob >> 9) & 1) << 5)); }
__host__ __device__ __forceinline__ void stage_rc(int b, int& R, int& C) { const int st = b / 1024, sb = b % 1024, swz = sb ^ (((sb >> 9) & 1) << 5); R = (st >> 1) * 16 + swz / 64; C = (st & 1) * 32 + (swz % 64) / 2; }
__host__ __device__ __forceinline__ int perm32(int rho) { const int n = rho >> 4, i = rho & 15; return 8 * (i >> 2) + 4 * n + (i & 3); }

struct Unit { int pm, pn; };
struct Gemm { const bf16_t* A; const bf16_t* Bt; int M, N, K; };

struct StaticOrder {
    int nM, nN, nwg, G, c;
    __host__ __device__ void init(int M, int N, int G_, int c_) { nM = M / BM; nN = N / BM; nwg = nM * nN; G = G_; c = c_; }
    __host__ __device__ bool next(int i, Unit& u) const {
        const long L = (long)i * G + c; if (L >= nwg) return false;
        int wgid = (int)L; { const int q = nwg / NXCD, r = nwg % NXCD, xcd = wgid % NXCD, off = wgid / NXCD; wgid = (xcd < r ? xcd * (q + 1) : r * (q + 1) + (xcd - r) * q) + off; }
        const int nig = WGM * nN, gid = wgid / nig, fm = gid * WGM, gsz = (nM - fm) < WGM ? (nM - fm) : WGM;
        u.pm = fm + ((wgid % nig) % gsz); u.pn = (wgid % nig) / gsz; return true;
    }
    __device__ __forceinline__ void a_ready(const Unit&) const {}
    __device__ __forceinline__ void done(const Unit&) const {}
};

__device__ __forceinline__ unsigned cvt_pk_bf16(float lo, float hi) { unsigned r; asm volatile("v_cvt_pk_bf16_f32 %0, %1, %2" : "=v"(r) : "v"(lo), "v"(hi)); return r; }
typedef float f32x2 __attribute__((ext_vector_type(2)));
template <class Epi, class Sched, bool ALIGN_EPI = false, bool SP2 = false, bool F8 = false>
__device__ __forceinline__ void gemm_phase(PG8_LAS unsigned char* lds, const Gemm g, const Sched& S, const Epi& E, const int wv  ) {
    int tid_ = wv * 64 + lane_id_opaque();
    const int tid = tid_, wid = __builtin_amdgcn_readfirstlane(tid >> 6), lane = tid & 63, wr = wid >> 2, wc = wid & 3, fr = lane & 15, fq = lane >> 4;
    const int K = g.K, nt = K / BK;
    unsigned voffA[2], voffB[2];
#pragma unroll
    for (int i = 0; i < 2; ++i) { int R, C; stage_rc(tid * 16 + i * 8192, R, C); const int Rb = Epi::PERM ? ((R & ~31) + perm32(R & 31)) : R;
        voffA[i] = (unsigned)(R * K + C) * 2u; voffB[i] = (unsigned)(Rb * K + C) * 2u; }
    const size_t kstep = (size_t)(BK * 2);
    const size_t hstep = (size_t)HALF * K * 2;
    const size_t tstep = 2 * hstep;
    const unsigned ldsw = (unsigned)wid * 1024u;
    const int aoff = lds_byte(wr * 64 + fr, fq * 8), boff = lds_byte(wc * 32 + fr, fq * 8);
#define PG8_SA(b, h) (((b) * 2 + (h)) * HTB)
#define PG8_SB(b, h) ((4 + (b) * 2 + (h)) * HTB)
#define PG8_STAGE(bufoff, gbase, voff) do { _Pragma("unroll") for (int _i = 0; _i < 2; ++_i) \
        __builtin_amdgcn_global_load_lds((const __attribute__((address_space(1))) unsigned*)((const __attribute__((address_space(1))) char*)(gbase) + (voff)[_i]), (PG8_LAS unsigned*)(lds + (bufoff) + ldsw + _i * 8192), 16, 0, 0); } while (0)
#define PG8_LDA(dst, b, h) do { _Pragma("unroll") for (int m = 0; m < 4; ++m) _Pragma("unroll") for (int k = 0; k < 2; ++k) dst[m][k] = *(const PG8_LAS bf16x8*)(lds + PG8_SA(b, h) + aoff + m * 2048 + k * 1024); } while (0)
#define PG8_LDB(dst, b, h) do { _Pragma("unroll") for (int n = 0; n < 2; ++n) _Pragma("unroll") for (int k = 0; k < 2; ++k) dst[n][k] = *(const PG8_LAS bf16x8*)(lds + PG8_SB(b, h) + boff + n * 2048 + k * 1024); } while (0)
#define PG8_MMA(ai, bj, At, Bt) do { if constexpr (F8) __builtin_amdgcn_sched_barrier(0); __builtin_amdgcn_s_setprio(1); _Pragma("unroll") for (int m = 0; m < 4; ++m) _Pragma("unroll") for (int n = 0; n < 2; ++n) { \
        if constexpr (F8) { typedef int i32x4_ __attribute__((ext_vector_type(4))); \
            acc[ai][bj][m][n] = __builtin_amdgcn_mfma_scale_f32_16x16x128_f8f6f4(__builtin_shufflevector(__builtin_bit_cast(i32x4_, Bt[n][0]), __builtin_bit_cast(i32x4_, Bt[n][1]), 0, 1, 2, 3, 4, 5, 6, 7), \
                __builtin_shufflevector(__builtin_bit_cast(i32x4_, At[m][0]), __builtin_bit_cast(i32x4_, At[m][1]), 0, 1, 2, 3, 4, 5, 6, 7), acc[ai][bj][m][n], 0, 0, 0, 0x7f7f7f7f, 0, 0x7f7f7f7f); } \
        else { _Pragma("unroll") for (int k = 0; k < 2; ++k) acc[ai][bj][m][n] = __builtin_amdgcn_mfma_f32_16x16x32_bf16(Bt[n][k], At[m][k], acc[ai][bj][m][n], 0, 0, 0); } } \
        __builtin_amdgcn_s_setprio(0); if constexpr (F8) __builtin_amdgcn_sched_barrier(0); } while (0)
#define PG8_WAIT_V(n) asm volatile("s_waitcnt vmcnt(" #n ")" ::: "memory")
#define PG8_WAIT_L(n) asm volatile("s_waitcnt lgkmcnt(" #n ")" ::: "memory")
#define PG8_BAR __builtin_amdgcn_s_barrier()
#define PG8_SCHED __builtin_amdgcn_sched_barrier(0)
    Unit cur, nxt; int ui = 0;
    if (!S.next(0, cur)) return;
    f32x4 acc[2][2][4][2];
#pragma unroll
    for (int a = 0; a < 2; ++a)
#pragma unroll
        for (int b = 0; b < 2; ++b)
#pragma unroll
            for (int m = 0; m < 4; ++m)
#pragma unroll
                for (int n = 0; n < 2; ++n) acc[a][b][m][n] = (f32x4){0.f, 0.f, 0.f, 0.f};
    bf16x8 At[4][2], B0[2][2], B1[2][2];
    const char* cA = (const char*)g.A + (size_t)cur.pm * tstep; const char* cB = (const char*)g.Bt + (size_t)cur.pn * tstep;
    S.a_ready(cur);
    if constexpr (SP2) {
        PG8_STAGE(PG8_SB(0, 0), cB, voffB); PG8_STAGE(PG8_SB(0, 1), cB + hstep, voffB); PG8_STAGE(PG8_SA(0, 0), cA, voffA); PG8_STAGE(PG8_SA(0, 1), cA + hstep, voffA);
        if (wr == 1) PG8_BAR;
        PG8_WAIT_V(2); PG8_BAR;
        PG8_STAGE(PG8_SB(1, 0), cB + kstep, voffB); PG8_STAGE(PG8_SA(1, 0), cA + kstep, voffA); PG8_STAGE(PG8_SB(1, 1), cB + hstep + kstep, voffB);
        PG8_WAIT_V(6); PG8_BAR;
    } else {
        PG8_STAGE(PG8_SB(0, 0), cB, voffB); PG8_STAGE(PG8_SA(0, 0), cA, voffA); PG8_STAGE(PG8_SB(0, 1), cB + hstep, voffB); PG8_STAGE(PG8_SA(0, 1), cA + hstep, voffA);
        if (wr == 1) PG8_BAR;
        PG8_WAIT_V(4); PG8_BAR;
        PG8_STAGE(PG8_SB(1, 0), cB + kstep, voffB); PG8_STAGE(PG8_SA(1, 0), cA + kstep, voffA); PG8_STAGE(PG8_SB(1, 1), cB + hstep + kstep, voffB);
        PG8_WAIT_V(6); PG8_BAR;
    }
    for (;;) {
        const bool has_next = S.next(ui + 1, nxt);
        const char* nA = has_next ? (const char*)g.A + (size_t)nxt.pm * tstep : cA; const char* nB = has_next ? (const char*)g.Bt + (size_t)nxt.pn * tstep : cB;
        for (int t = 0; t < nt; t += 2) {
            const bool last = (t == nt - 2);
            const char* a1 = cA + (size_t)(t + 1) * kstep;
            const char* a2 = last ? nA : cA + (size_t)(t + 2) * kstep; const char* b2 = last ? nB : cB + (size_t)(t + 2) * kstep;
            const char* a3 = a2 + kstep; const char* b3 = b2 + kstep;
            if (last && has_next) S.a_ready(nxt);
            if constexpr (SP2) {
            PG8_LDB(B0, 0, 0); PG8_LDB(B1, 0, 1); PG8_SCHED; PG8_LDA(At, 0, 0); PG8_STAGE(PG8_SA(1, 1), a1 + hstep, voffA);
            PG8_WAIT_V(8); PG8_WAIT_L(0); PG8_BAR; PG8_MMA(0, 0, At, B0); PG8_MMA(0, 1, At, B1); PG8_BAR; PG8_SCHED;
            PG8_LDA(At, 0, 1); PG8_STAGE(PG8_SB(0, 0), b2, voffB); PG8_STAGE(PG8_SB(0, 1), b2 + hstep, voffB); PG8_STAGE(PG8_SA(0, 0), a2, voffA);
            PG8_WAIT_V(8); PG8_WAIT_L(0); PG8_BAR; PG8_MMA(1, 0, At, B0); PG8_MMA(1, 1, At, B1); PG8_BAR; PG8_SCHED;
            PG8_LDB(B0, 1, 0); PG8_LDB(B1, 1, 1); PG8_SCHED; PG8_LDA(At, 1, 0); PG8_STAGE(PG8_SA(0, 1), a2 + hstep, voffA);
            PG8_WAIT_V(8); PG8_WAIT_L(0); PG8_BAR; PG8_MMA(0, 0, At, B0); PG8_MMA(0, 1, At, B1); PG8_BAR; PG8_SCHED;
            PG8_LDA(At, 1, 1); PG8_STAGE(PG8_SB(1, 0), b3, voffB); PG8_STAGE(PG8_SB(1, 1), b3 + hstep, voffB); PG8_STAGE(PG8_SA(1, 0), a3, voffA);
            PG8_WAIT_V(8); PG8_WAIT_L(0); PG8_BAR; PG8_MMA(1, 0, At, B0); PG8_MMA(1, 1, At, B1); PG8_BAR; PG8_SCHED;
            } else {
            PG8_LDB(B0, 0, 0); PG8_SCHED; PG8_LDA(At, 0, 0); PG8_STAGE(PG8_SA(1, 1), a1 + hstep, voffA);
            PG8_WAIT_L(8); PG8_BAR; PG8_WAIT_L(0); PG8_MMA(0, 0, At, B0); PG8_BAR; PG8_SCHED;
            PG8_LDB(B1, 0, 1); PG8_STAGE(PG8_SB(0, 0), b2, voffB);
            PG8_BAR; PG8_WAIT_L(0); PG8_MMA(0, 1, At, B1); PG8_BAR;
            PG8_LDA(At, 0, 1); PG8_STAGE(PG8_SA(0, 0), a2, voffA);
            PG8_BAR; PG8_WAIT_L(0); PG8_MMA(1, 0, At, B0); PG8_BAR; PG8_SCHED;
            PG8_STAGE(PG8_SB(0, 1), b2 + hstep, voffB);
            PG8_WAIT_V(6); PG8_BAR; PG8_MMA(1, 1, At, B1); PG8_BAR;
            PG8_LDB(B0, 1, 0); PG8_SCHED; PG8_LDA(At, 1, 0); PG8_STAGE(PG8_SA(0, 1), a2 + hstep, voffA);
            PG8_WAIT_L(8); PG8_BAR; PG8_WAIT_L(0); PG8_MMA(0, 0, At, B0); PG8_BAR; PG8_SCHED;
            PG8_LDB(B1, 1, 1); PG8_STAGE(PG8_SB(1, 0), b3, voffB);
            PG8_BAR; PG8_WAIT_L(0); PG8_MMA(0, 1, At, B1); PG8_BAR;
            PG8_LDA(At, 1, 1); PG8_STAGE(PG8_SA(1, 0), a3, voffA);
            PG8_BAR; PG8_WAIT_L(0); PG8_MMA(1, 0, At, B0); PG8_BAR; PG8_SCHED;
            PG8_STAGE(PG8_SB(1, 1), b3 + hstep, voffB);
            PG8_WAIT_V(6); PG8_BAR; PG8_MMA(1, 1, At, B1); PG8_BAR;
            }
        }
        if constexpr (ALIGN_EPI) { if (wr == 0) PG8_BAR; }
        if constexpr (!Epi::AFTER_DRAIN) { const int t2_ = lane_id_opaque(); const int fr_ = t2_ & 15, fq_ = (t2_ & 63) >> 4;
            E(acc, cur, wr, wc, fr_, fq_); S.done(cur); }
        if (!has_next) break;
#pragma unroll
        for (int a = 0; a < 2; ++a)
#pragma unroll
            for (int b = 0; b < 2; ++b)
#pragma unroll
                for (int m = 0; m < 4; ++m)
#pragma unroll
                    for (int n = 0; n < 2; ++n) acc[a][b][m][n] = (f32x4){0.f, 0.f, 0.f, 0.f};
        cur = nxt; cA = nA; cB = nB; ++ui;
        if constexpr (ALIGN_EPI) { if (wr == 1) PG8_BAR; }
    }
    PG8_WAIT_V(0);
    if constexpr (!ALIGN_EPI) { if (wr == 0) PG8_BAR; }
    PG8_BAR;
    if constexpr (Epi::AFTER_DRAIN) { E.fused(acc, cur, wr, wc, fr, fq, lds, wid, lane); S.done(cur); }
#undef PG8_SA
#undef PG8_SB
#undef PG8_STAGE
#undef PG8_LDA
#undef PG8_LDB
#undef PG8_MMA
#undef PG8_WAIT_V
#undef PG8_WAIT_L
#undef PG8_BAR
#undef PG8_SCHED
}
}
#define GAS __attribute__((address_space(1)))
#define LAS __attribute__((address_space(3)))
typedef unsigned short bf16;
typedef unsigned v4u __attribute__((ext_vector_type(4)));
typedef float f32x4 __attribute__((ext_vector_type(4)));
typedef short bf16x8 __attribute__((ext_vector_type(8)));
typedef GAS unsigned gu32;
typedef GAS unsigned long long gu64;
#define RLX_AGENT __ATOMIC_RELAXED, __HIP_MEMORY_SCOPE_AGENT
#define LDS_WAIT() asm volatile("s_waitcnt lgkmcnt(0)" ::: "memory")
#define VM_WAIT() asm volatile("s_waitcnt vmcnt(0)" ::: "memory")
__device__ __forceinline__ unsigned long long rt() { return __builtin_amdgcn_s_memrealtime(); }
__device__ __forceinline__ unsigned f2bf(float f) { unsigned u = __builtin_bit_cast(unsigned, f); return (u + 0x7fffu + ((u >> 16) & 1u)) >> 16; }
__device__ __forceinline__ unsigned pk2(float lo, float hi) { return f2bf(lo) | (f2bf(hi) << 16); }

#define XB_TMO      128
#define XB_XCNT(j)  (256  + 64 * (j))
#define XB_XSUB(j)  (1280 + 64 * (j))
#define XB_XGEN(j)  (2304 + 64 * (j))
#define XB_TOP      3328
#define XB_TOPGEN   3392
#define XCD_BAR_WORDS 3456
#define XB_SPIN_CAP (1u << 18)

__device__ __forceinline__ unsigned xb_ld(unsigned* p)              { return __hip_atomic_load(p, __ATOMIC_RELAXED, __HIP_MEMORY_SCOPE_AGENT); }
__device__ __forceinline__ unsigned xb_add(unsigned* p, unsigned v) { return __hip_atomic_fetch_add(p, v, __ATOMIC_RELAXED, __HIP_MEMORY_SCOPE_AGENT); }
__device__ __forceinline__ unsigned xb_xcc_id() { return (unsigned)__builtin_amdgcn_s_getreg((3 << 11) | 20) & 0xFu; }
#define XB_SPIN(cond, bar) do { unsigned _sp = 0; while (cond) { __builtin_amdgcn_s_sleep(1); \
    if ((++_sp & 255u) == 0u) { if (xb_ld(&(bar)[XB_TMO])) break; if (_sp > XB_SPIN_CAP) { atomicAdd(&(bar)[XB_TMO], 1u); break; } } } } while (0)

struct XcdBarrier {
    unsigned* bar; unsigned x;
    volatile LAS unsigned* st;
};

__device__ __forceinline__ XcdBarrier xcd_barrier_post(unsigned* bar, volatile LAS unsigned* st) {
    XcdBarrier b; b.bar = bar; b.x = xb_xcc_id(); b.st = st;
    if (threadIdx.x == 0) (void)xb_add(&bar[XB_XCNT(b.x)], 1u);
    return b;
}
__device__ __forceinline__ void xcd_barrier_complete(unsigned* bar, unsigned x, unsigned& nloc, unsigned& nx) {
    const unsigned G = gridDim.x * gridDim.y * gridDim.z;
    unsigned sum, cnt, mine, sp = 0u;
    for (;;) {
        sum = 0u; cnt = 0u; mine = 0u;
#pragma unroll
        for (unsigned j = 0; j < 16; ++j) { const unsigned c = xb_ld(&bar[XB_XCNT(j)]); sum += c; cnt += (c > 0u) ? 1u : 0u; mine = (j == x) ? c : mine; }
        if (sum == G) break;
        __builtin_amdgcn_s_sleep(1);
        if ((++sp & 255u) == 0u) { if (xb_ld(&bar[XB_TMO])) break; if (sp > XB_SPIN_CAP) { atomicAdd(&bar[XB_TMO], 1u); break; } }
    }
    nloc = mine > 0u ? mine : 1u; nx = cnt > 0u ? cnt : 1u;
}

__device__ __forceinline__ void xcd_barrier(const XcdBarrier& b, const bool leader  ) {
    asm volatile("s_waitcnt vmcnt(0)" ::: "memory");
    __syncthreads();
    if (leader) {
        unsigned* bar = b.bar; asm volatile("" : "+s"(bar));
        __builtin_amdgcn_s_waitcnt(0);
        unsigned nloc = b.st[0], nx = b.st[1];
        if (nloc == 0u) { xcd_barrier_complete(bar, b.x, nloc, nx); b.st[0] = nloc; b.st[1] = nx; }
        const unsigned old = xb_add(&bar[XB_XSUB(b.x)], 1u);
        const unsigned gen = old / nloc;
        if (old + 1u == (gen + 1u) * nloc) {
            __builtin_amdgcn_fence(__ATOMIC_RELEASE, "agent");
            asm volatile("s_waitcnt vmcnt(0)" ::: "memory");
            const unsigned og = xb_add(&bar[XB_TOP], 1u);
            const unsigned tg = og / nx;
            if (og + 1u == (tg + 1u) * nx) xb_add(&bar[XB_TOPGEN], 1u);
            else XB_SPIN(xb_ld(&bar[XB_TOPGEN]) == tg, bar);
            __builtin_amdgcn_fence(__ATOMIC_ACQUIRE, "agent");
            xb_add(&bar[XB_XGEN(b.x)], 1u);
            asm volatile("s_waitcnt vmcnt(0)" ::: "memory");
        } else {
            XB_SPIN(xb_ld(&bar[XB_XGEN(b.x)]) == gen, bar);
            __builtin_amdgcn_fence(__ATOMIC_ACQUIRE, "agent");
            asm volatile("s_waitcnt vmcnt(0)" ::: "memory");
        }
    }
    __syncthreads();
}

#ifndef FFN_F8
#define FFN_F8 1
#endif
constexpr int NWAVES = 8;
constexpr float W8S = 32.f, U8S = 4.f;
constexpr int DM = 1024, NBATCH = 16, SEQ = 2048, CTX = 256, TPB = SEQ + CTX, M = NBATCH * TPB;
constexpr int DEPTH = 4, NIN = 3104, NP = 3328, DFF = 2816, NE = 8;
constexpr int MP = 2 * M + NE * 256;
constexpr int C_Q = 0, C_K = 512, C_V = 1024, C_GQ = 1536, C_GK = 1792, C_GV = 2048, C_GG = 2560, C_GLR = 3072;
constexpr float EPS = 1e-6f;
constexpr float C2 = 0.125f * 1.4426950408889634f;
constexpr int NCH = TPB / 64;
constexpr int NGLA = NBATCH * 4 * 2 * NCH;

constexpr size_t MiB = 1u << 20;
constexpr size_t WS_CTL = 0, CTL_ZERO_BYTES = 1 * MiB;
constexpr size_t WS_MOD = 1 * MiB;
constexpr size_t WS_ROPE = 3 * MiB;
constexpr size_t WS_TOPE = 4 * MiB;
constexpr size_t WS_LIDX = WS_TOPE + 160 * 1024;
constexpr size_t WS_TOPW = WS_LIDX + 320 * 1024;
constexpr size_t WS_BLKB = WS_TOPW + 320 * 1024;
constexpr size_t WS_RMAP = WS_BLKB + 64 * 1024;
constexpr size_t WS_ROWW = WS_RMAP + 320 * 1024;
static_assert(WS_ROWW + 320 * 1024 <= 6 * MiB, "small tables");
constexpr size_t WS_X = 6 * MiB;
constexpr size_t WS_WIN = 150 * MiB;
constexpr size_t WS_WOUT = WS_WIN + 13 * MiB / 2;
constexpr size_t WS_WUP = WS_WOUT + 2 * MiB;
constexpr size_t WS_WDN = WS_WUP + 88 * MiB;
constexpr size_t WS_D = 291 * MiB;
static_assert(WS_WDN + 44 * MiB <= WS_D, "weights");
constexpr size_t WS_PROJ = WS_D;
constexpr size_t WS_OD = WS_D + 234 * MiB;
constexpr size_t WS_DS = WS_D + 306 * MiB;
constexpr size_t WS_DEC = WS_D + 450 * MiB;
constexpr size_t WS_H = WS_D + 452 * MiB;
constexpr size_t WS_Y = WS_D;
constexpr size_t WS_HG = WS_D;
constexpr size_t WS_F2 = WS_D;
constexpr size_t WS_U = WS_D + 148 * MiB;
constexpr size_t WS_H2 = WS_D + 483 * MiB;
constexpr size_t WS_END = WS_D + 555 * MiB;
static_assert((size_t)MP * DFF * 2 <= 407 * MiB && (size_t)MP * DM * 2 <= 148 * MiB && (size_t)M * NP * 2 <= 234 * MiB, "dynamic map");
static_assert((size_t)M * DFF * 2 + 148 * MiB <= 483 * MiB, "dense U clear of H2");

constexpr int CW_BAR = 4096;
constexpr int CW_CNT = 8192;

constexpr int RING_BYTES = 131072;
constexpr int TEXP_OFF = 139264;
constexpr int MISC_OFF = 146432 - 512;
constexpr int LDS_BYTES = 147456;

typedef unsigned u32x2 __attribute__((ext_vector_type(2)));

__device__ __forceinline__ float bf2f(unsigned short x) { return __uint_as_float((unsigned)x << 16); }
__device__ __forceinline__ float bflo(unsigned w) { return __uint_as_float(w << 16); }
__device__ __forceinline__ float bfhi(unsigned w) { return __uint_as_float(w & 0xffff0000u); }
__device__ __forceinline__ float siluf(float x) { return x * __builtin_amdgcn_rcpf(1.f + __expf(-x)); }
__device__ __forceinline__ float clamp8(float x) { return fminf(fmaxf(x, -448.f), 448.f); }
__device__ __forceinline__ unsigned pk4_f8(float a, float b, float c, float d) { unsigned w = 0u; w = __builtin_amdgcn_cvt_pk_fp8_f32(clamp8(a), clamp8(b), w, false); w = __builtin_amdgcn_cvt_pk_fp8_f32(clamp8(c), clamp8(d), w, true); return w; }
template <int MASK> __device__ __forceinline__ float xadd(float v) {
    if constexpr (MASK == 32) { const auto rr = __builtin_amdgcn_permlane32_swap(__float_as_uint(v), __float_as_uint(v), false, false); return __uint_as_float(rr[0]) + __uint_as_float(rr[1]); }
    else return v + __int_as_float(__builtin_amdgcn_ds_swizzle(__float_as_int(v), 0x1f | (MASK << 10)));
}
__device__ __forceinline__ float wave_sum(float v) {
    v = xadd<1>(v); v = xadd<2>(v); v = xadd<4>(v); v = xadd<8>(v); v = xadd<16>(v); v = xadd<32>(v);
    return v;
}

struct Args { const float* in[24]; float* out; unsigned char* ws; };
struct Frame {
    LAS unsigned char* lds;
    volatile LAS unsigned* MISC;
    int tid, lane, wave, G, blk, gw, NGW, z, wv;
    const Args* A;
    unsigned char* ws;
};


__device__ __forceinline__ void refresh(Frame& F) {
    int wv = F.wv; asm volatile("" : "+s"(wv));
    const int t = wv * 64 + pg8::lane_id_opaque();
    int bl = blockIdx.x, z = 0, gg = gridDim.x; asm volatile("" : "+s"(bl), "+s"(z), "+s"(gg));
    F.blk = bl; F.z = z; F.G = gg; F.NGW = gg * NWAVES;
    F.tid = t; F.lane = t & 63; F.wave = wv; F.gw = F.blk * NWAVES + F.wave;
}
#define INP(k) (F.A->in[(k) + F.z])
namespace pg8 {
struct EpiProj {
    static constexpr bool PERM = false, AFTER_DRAIN = false;
    bf16_t* P; const float* ropec; const float* ropes;
    __device__ __forceinline__ void operator()(const f32x4 (&acc)[2][2][4][2], const Unit& u, int wr, int wc, int fr, int fq) const {
        const int pn = u.pn, pm = u.pm, tb = pm % 9;
        const bool do_rope = (tb != 0) && (pn < 4);
        const float sc = (pn < 2) ? C2 : (pn == 6 ? 0.125f : 1.f);
        const bool st_ok_all = pn < 12;
#pragma unroll
        for (int ai = 0; ai < 2; ++ai)
#pragma unroll
            for (int m = 0; m < 4; ++m) {
                const int rit = ai * HALF + wr * 64 + m * 16 + fr;
                const size_t grow = (size_t)pm * BM + rit;
                const int s = (tb - 1) * 256 + rit;
                const int pos = (wc & 1) ? (s & 63) : (s >> 6);
                f32x4 cs = {1.f, 1.f, 1.f, 1.f}, sn = {0.f, 0.f, 0.f, 0.f};
                if (do_rope) { cs = *(const f32x4*)(ropec + pos * 16 + 4 * fq); sn = *(const f32x4*)(ropes + pos * 16 + 4 * fq); }
#pragma unroll
                for (int bj = 0; bj < 2; ++bj) {
                    f32x4 v0 = acc[ai][bj][m][0], v1 = acc[ai][bj][m][1];
                    if (do_rope) { const f32x4 a = v0 * cs - v1 * sn, b = v0 * sn + v1 * cs; v0 = a; v1 = b; }
                    v0 = v0 * sc; v1 = v1 * sc;
                    const int col0 = pn * BM + bj * HALF + wc * 32 + 4 * fq;
                    if (st_ok_all || (bj == 0 && wc == 0)) {
                        u32x2 w0, w1; w0.x = cvt_pk_bf16(v0[0], v0[1]); w0.y = cvt_pk_bf16(v0[2], v0[3]); w1.x = cvt_pk_bf16(v1[0], v1[1]); w1.y = cvt_pk_bf16(v1[2], v1[3]);
                        *(u32x2*)(P + grow * NP + col0) = w0; *(u32x2*)(P + grow * NP + col0 + 16) = w1;
                    }
                }
            }
    }
};
struct EpiF32 {
    static constexpr bool PERM = true, AFTER_DRAIN = false;
    bf16_t* Y;
    __device__ __forceinline__ void operator()(const f32x4 (&acc)[2][2][4][2], const Unit& u, int wr, int wc, int fr, int fq) const {
#pragma unroll
        for (int ai = 0; ai < 2; ++ai)
#pragma unroll
            for (int m = 0; m < 4; ++m) {
                bf16_t* rowp = Y + ((size_t)u.pm * BM + ai * HALF + wr * 64 + m * 16 + fr) * DM + u.pn * BM + wc * 32 + 8 * fq;
#pragma unroll
                for (int bj = 0; bj < 2; ++bj) { const f32x4 v0 = acc[ai][bj][m][0], v1 = acc[ai][bj][m][1];
                    u32x4 w; w.x = cvt_pk_bf16(v0[0], v0[1]); w.y = cvt_pk_bf16(v0[2], v0[3]); w.z = cvt_pk_bf16(v1[0], v1[1]); w.w = cvt_pk_bf16(v1[2], v1[3]);
                    *(u32x4*)(rowp + bj * HALF) = w; }
            }
    }
};
struct EpiSwiglu {
    static constexpr bool PERM = true, AFTER_DRAIN = false;
    bf16_t* U;
    __device__ __forceinline__ void operator()(const f32x4 (&acc)[2][2][4][2], const Unit& u, int wr, int wc, int fr, int fq) const {
        const int pnl = u.pn % 22;
        const int col0 = pnl * 128 + wc * 32 + 8 * fq;
        constexpr float ws = FFN_F8 ? 1.f / W8S : 1.f, us = FFN_F8 ? U8S : 1.f, kS = ws * ws * us, kE = -ws * 1.4426950408889634f;
        const float cE = -__builtin_log2f(kS), c1 = 1.f / kS;
#pragma unroll
        for (int ai = 0; ai < 2; ++ai)
#pragma unroll
            for (int m = 0; m < 4; ++m) {
                const size_t rowi = (size_t)u.pm * BM + ai * HALF + wr * 64 + m * 16 + fr;
                f32x2 g[4], up[4], t[4], r[4];
#pragma unroll
                for (int n = 0; n < 2; ++n) { g[2 * n] = (f32x2){acc[ai][0][m][n][0], acc[ai][0][m][n][1]}; g[2 * n + 1] = (f32x2){acc[ai][0][m][n][2], acc[ai][0][m][n][3]};
                                              up[2 * n] = (f32x2){acc[ai][1][m][n][0], acc[ai][1][m][n][1]}; up[2 * n + 1] = (f32x2){acc[ai][1][m][n][2], acc[ai][1][m][n][3]}; }
#pragma unroll
                for (int q = 0; q < 4; ++q) t[q] = g[q] * kE + cE;
#pragma unroll
                for (int q = 0; q < 4; ++q) { t[q].x = __builtin_amdgcn_exp2f(t[q].x); t[q].y = __builtin_amdgcn_exp2f(t[q].y); }
#pragma unroll
                for (int q = 0; q < 4; ++q) t[q] = t[q] + c1;
#pragma unroll
                for (int q = 0; q < 4; ++q) { r[q].x = __builtin_amdgcn_rcpf(t[q].x); r[q].y = __builtin_amdgcn_rcpf(t[q].y); }
#pragma unroll
                for (int q = 0; q < 4; ++q) g[q] = (g[q] * up[q]) * r[q];
                if constexpr (FFN_F8) { u32x2 w; w.x = pk4_f8(g[0].x, g[0].y, g[1].x, g[1].y); w.y = pk4_f8(g[2].x, g[2].y, g[3].x, g[3].y); *(u32x2*)((unsigned char*)U + rowi * DFF + col0) = w; }
                else { u32x4 w; w.x = cvt_pk_bf16(g[0].x, g[0].y); w.y = cvt_pk_bf16(g[1].x, g[1].y); w.z = cvt_pk_bf16(g[2].x, g[2].y); w.w = cvt_pk_bf16(g[3].x, g[3].y); *(u32x4*)(U + rowi * DFF + col0) = w; }
            }
    }
};
struct EpiDown {
    static constexpr bool PERM = true, AFTER_DRAIN = false;
    bf16_t* F2; const int* rmap; const float* roww; int dense;
    __device__ __forceinline__ void operator()(const f32x4 (&acc)[2][2][4][2], const Unit& u, int wr, int wc, int fr, int fq) const {
        const int pnl = u.pn & 3;
        const int col0 = pnl * BM + wc * 32 + 8 * fq;
#pragma unroll
        for (int ai = 0; ai < 2; ++ai)
#pragma unroll
            for (int m = 0; m < 4; ++m) {
                const int grow = u.pm * BM + ai * HALF + wr * 64 + m * 16 + fr;
                int tok = grow, slot = 0; float w = 1.f; bool ok = true;
                if (!dense) { const int rm = rmap[grow]; ok = rm >= 0; tok = rm & 0x3fffffff; slot = (rm >> 30) & 1; w = roww[grow]; }
                if constexpr (FFN_F8) w *= 1.f / (W8S * U8S);
                if (ok) {
                    bf16_t* rowp = F2 + ((size_t)slot * M + tok) * DM + col0;
#pragma unroll
                    for (int bj = 0; bj < 2; ++bj) {
                        const f32x4 v0 = acc[ai][bj][m][0] * w, v1 = acc[ai][bj][m][1] * w;
                        u32x4 q; q.x = cvt_pk_bf16(v0[0], v0[1]); q.y = cvt_pk_bf16(v0[2], v0[3]); q.z = cvt_pk_bf16(v1[0], v1[1]); q.w = cvt_pk_bf16(v1[2], v1[3]);
                        *(u32x4*)(rowp + bj * HALF) = q;
                    }
                }
            }
    }
};
struct GroupedOrder {
    StaticOrder S; const PG8_LAS int* texp; int nN;
    __device__ __forceinline__ bool next(int i, Unit& u) const { if (!S.next(i, u)) return false; u.pn += __builtin_amdgcn_readfirstlane(texp[u.pm]) * nN; return true; }
    __device__ __forceinline__ void a_ready(const Unit&) const {}
    __device__ __forceinline__ void done(const Unit&) const {}
};
struct LatOrder {
    StaticOrder S; int lat;
    __device__ __forceinline__ bool next(int i, Unit& u) const { if (!S.next(i, u)) return false; if (lat) u.pm += (u.pm >> 3) + 1; return true; }
    __device__ __forceinline__ void a_ready(const Unit&) const {}
    __device__ __forceinline__ void done(const Unit&) const {}
};
}

__device__ __forceinline__ void ld_row_f32(const float* row, int lane, f32x4 (&v)[4]) {
#pragma unroll
    for (int j = 0; j < 4; ++j) v[j] = *(const f32x4*)(row + 4 * lane + 256 * j);
}
__device__ __forceinline__ void st_row_f32(float* row, int lane, const f32x4 (&v)[4]) {
#pragma unroll
    for (int j = 0; j < 4; ++j) *(f32x4*)(row + 4 * lane + 256 * j) = v[j];
}
__device__ __forceinline__ void ld_row_bf16(const bf16* row, int lane, f32x4 (&v)[4]) {
#pragma unroll
    for (int j = 0; j < 4; ++j) { const u32x2 w = *(const u32x2*)(row + 4 * lane + 256 * j); v[j] = (f32x4){bflo(w.x), bfhi(w.x), bflo(w.y), bfhi(w.y)}; }
}
__device__ __forceinline__ void st_row_bf16(bf16* row, int lane, const f32x4 (&v)[4]) {
#pragma unroll
    for (int j = 0; j < 4; ++j) { u32x2 w; w.x = pg8::cvt_pk_bf16(v[j][0], v[j][1]); w.y = pg8::cvt_pk_bf16(v[j][2], v[j][3]); *(u32x2*)(row + 4 * lane + 256 * j) = w; }
}
__device__ __forceinline__ float row_rinv(const f32x4 (&v)[4]) {
    float s = 0.f;
#pragma unroll
    for (int j = 0; j < 4; ++j) s += (v[j][0] * v[j][0] + v[j][1] * v[j][1]) + (v[j][2] * v[j][2] + v[j][3] * v[j][3]);
    return 1.0f / sqrtf(wave_sum(s) * (1.f / DM) + EPS);
}

__device__ __forceinline__ void transpose_tile(const float* W, int N, int k0, int n0, bf16* WT, int K, int drow0, LAS float* scr, int lane) {
#pragma unroll 8
    for (int i = 0; i < 32; ++i) { const int kk = 2 * i + (lane >> 5); scr[kk * 33 + (lane & 31)] = __builtin_nontemporal_load(&W[(size_t)(k0 + kk) * N + n0 + (lane & 31)]); }
    LDS_WAIT(); asm volatile("" ::: "memory");
    const int c = lane & 7;
#pragma unroll
    for (int j = 0; j < 4; ++j) { const int n = (lane >> 3) + 8 * j; const LAS float* s = scr + (8 * c) * 33 + n;
        v4u o; o.x = pk2(s[0 * 33], s[1 * 33]); o.y = pk2(s[2 * 33], s[3 * 33]); o.z = pk2(s[4 * 33], s[5 * 33]); o.w = pk2(s[6 * 33], s[7 * 33]);
        *(GAS v4u*)(WT + (size_t)(drow0 + n) * K + k0 + 8 * c) = o; }
    LDS_WAIT(); asm volatile("" ::: "memory");
}
__device__ __forceinline__ void transpose_tile_f8(const float* W, int N, int k0, int n0, unsigned char* WT, int Kb, int drow0, LAS float* scr, int lane, float scale) {
#pragma unroll 8
    for (int i = 0; i < 32; ++i) { const int kk = 2 * i + (lane >> 5); scr[kk * 33 + (lane & 31)] = __builtin_nontemporal_load(&W[(size_t)(k0 + kk) * N + n0 + (lane & 31)]); }
    LDS_WAIT(); asm volatile("" ::: "memory");
    const int n = lane >> 1, hf = lane & 1; const LAS float* s = scr + (hf * 32) * 33 + n;
    v4u o0, o1;
    o0.x = pk4_f8(s[0 * 33] * scale, s[1 * 33] * scale, s[2 * 33] * scale, s[3 * 33] * scale);     o0.y = pk4_f8(s[4 * 33] * scale, s[5 * 33] * scale, s[6 * 33] * scale, s[7 * 33] * scale);
    o0.z = pk4_f8(s[8 * 33] * scale, s[9 * 33] * scale, s[10 * 33] * scale, s[11 * 33] * scale);   o0.w = pk4_f8(s[12 * 33] * scale, s[13 * 33] * scale, s[14 * 33] * scale, s[15 * 33] * scale);
    o1.x = pk4_f8(s[16 * 33] * scale, s[17 * 33] * scale, s[18 * 33] * scale, s[19 * 33] * scale); o1.y = pk4_f8(s[20 * 33] * scale, s[21 * 33] * scale, s[22 * 33] * scale, s[23 * 33] * scale);
    o1.z = pk4_f8(s[24 * 33] * scale, s[25 * 33] * scale, s[26 * 33] * scale, s[27 * 33] * scale); o1.w = pk4_f8(s[28 * 33] * scale, s[29 * 33] * scale, s[30 * 33] * scale, s[31 * 33] * scale);
    GAS v4u* dst = (GAS v4u*)(WT + (size_t)(drow0 + n) * Kb + k0 + hf * 32);
    dst[0] = o0; dst[1] = o1;
    LDS_WAIT(); asm volatile("" ::: "memory");
}
__device__ __forceinline__ void convert_weights(Frame& F, int l) {
    refresh(F);
    const bool moe = l & 1; const int ne = moe ? NE : 1, li = l >> 1;
    const float* w1 = moe ? INP(21) + (size_t)li * NE * DM * DFF : INP(17) + (size_t)li * DM * DFF;
    const float* w3 = moe ? INP(22) + (size_t)li * NE * DM * DFF : INP(18) + (size_t)li * DM * DFF;
    const float* w2 = moe ? INP(23) + (size_t)li * NE * DM * DFF : INP(19) + (size_t)li * DM * DFF;
    const float* win = INP(10) + (size_t)l * DM * NIN;
    const float* wout = INP(16) + (size_t)l * DM * DM;
    bf16* WIN = (bf16*)(F.ws + WS_WIN); bf16* WOUT = (bf16*)(F.ws + WS_WOUT); bf16* WUP = (bf16*)(F.ws + WS_WUP); bf16* WDN = (bf16*)(F.ws + WS_WDN);
    LAS float* scr = (LAS float*)(F.lds + F.wave * 16384);
    const int nA = 16 * 97, nZ = NP - NIN, nB = 16 * 32, nC1 = 16 * 88, nD1 = 44 * 32;
    const int nC = ne * 2 * nC1, nD = ne * nD1, total = nA + nZ + nB + nC + nD;
    for (int it = F.gw; it < total; it += F.NGW) {
        int r = it;
        if (r < nA) { const int kb = r / 97, nb = r % 97; transpose_tile(win, NIN, 64 * kb, 32 * nb, WIN, DM, 32 * nb, scr, F.lane); continue; } r -= nA;
        if (r < nZ) { const unsigned zz = (unsigned)F.z; v4u z = {zz, zz, zz, zz}; GAS v4u* p = (GAS v4u*)(WIN + (size_t)(NIN + r) * DM) + F.lane * 2; p[0] = z; p[1] = z; continue; } r -= nZ;
        if (r < nB) { const int kb = r / 32, nb = r % 32; transpose_tile(wout, DM, 64 * kb, 32 * nb, WOUT, DM, 32 * nb, scr, F.lane); continue; } r -= nB;
        if (r < nC) { const int e = r / (2 * nC1), q = r % (2 * nC1), which = q / nC1, t = q % nC1, kb = t / 88, nb = t % 88, n0 = 32 * nb;
            const float* src = (which ? w3 : w1) + (size_t)e * DM * DFF;
            if constexpr (FFN_F8) transpose_tile_f8(src, DFF, 64 * kb, n0, (unsigned char*)WUP, DM, e * 5632 + (n0 / 128) * 256 + (n0 % 128) + which * 128, scr, F.lane, W8S);
            else transpose_tile(src, DFF, 64 * kb, n0, WUP, DM, e * 5632 + (n0 / 128) * 256 + (n0 % 128) + which * 128, scr, F.lane); continue; } r -= nC;
        { const int e = r / nD1, t = r % nD1, kb = t / 32, nb = t % 32;
            if constexpr (FFN_F8) transpose_tile_f8(w2 + (size_t)e * DFF * DM, DM, 64 * kb, 32 * nb, (unsigned char*)WDN + (size_t)e * DM * DFF, DFF, 32 * nb, scr, F.lane, W8S);
            else transpose_tile(w2 + (size_t)e * DFF * DM, DM, 64 * kb, 32 * nb, WDN + (size_t)e * DM * DFF, DFF, 32 * nb, scr, F.lane); }
    }
}

__device__ __forceinline__ void p0_mod(Frame& F) {
    refresh(F);
    LAS float* S = (LAS float*)(F.lds);
    LAS float* R = (LAS float*)(F.lds + 69632);
    const float* c = INP(1); const float* cc = INP(3); const float* wmod = INP(4); const float* bmod = INP(5);
    float* MOD = (float*)(F.ws + WS_MOD);
    for (int i = F.tid; i < 17 * 1024; i += 512) { const int b = i >> 10, k = i & 1023; const float v = b < 16 ? c[b * 1024 + k] : cc[k]; S[i] = siluf(v); }
    __syncthreads();
    const int kq = F.lane >> 4, c4 = (F.lane & 15) * 4;
    for (int item = F.blk; item < 4 * 96; item += F.G) {
        const int l = item / 96, col0 = (item % 96) * 64;
        const float* W = wmod + (size_t)l * DM * 6144;
        float acc[17][4];
#pragma unroll
        for (int b = 0; b < 17; ++b)
#pragma unroll
            for (int j = 0; j < 4; ++j) acc[b][j] = 0.f;
        for (int it = 0; it < 32; ++it) {
            const int k = F.wave * 128 + it * 4 + kq;
            const f32x4 w = *(const f32x4*)(W + (size_t)k * 6144 + col0 + c4);
#pragma unroll
            for (int b = 0; b < 17; ++b) { const float s = S[b * 1024 + k];
#pragma unroll
                for (int j = 0; j < 4; ++j) acc[b][j] += s * w[j]; }
        }
#pragma unroll
        for (int b = 0; b < 17; ++b)
#pragma unroll
            for (int j = 0; j < 4; ++j) { float v = acc[b][j]; v = xadd<16>(v); v = xadd<32>(v); acc[b][j] = v; }
        if (kq == 0) {
#pragma unroll
            for (int b = 0; b < 17; ++b)
#pragma unroll
                for (int j = 0; j < 4; ++j) R[(F.wave * 17 + b) * 64 + c4 + j] = acc[b][j];
        }
        __syncthreads();
        for (int o = F.tid; o < 17 * 64; o += 512) { const int b = o >> 6, ccx = o & 63; float s = bmod[l * 6144 + col0 + ccx];
            for (int w = 0; w < 8; ++w) s += R[(w * 17 + b) * 64 + ccx];
            MOD[((size_t)l * 17 + b) * 6144 + col0 + ccx] = s; }
        __syncthreads();
    }
}
__device__ __forceinline__ float lam_init_of(int l) { return 0.8f - 0.6f * expf(-0.3f * (float)l); }
__device__ __forceinline__ void p0_misc(Frame& F) {
    refresh(F);
    float* ropec = (float*)(F.ws + WS_ROPE); float* ropes = ropec + 1024; float* lam = (float*)(F.ws + WS_ROPE + 16384);
    if (F.blk == 0) {
        for (int i = F.tid; i < 1024; i += 512) { const int pos = i >> 4, f = i & 15; const float inv = powf(10000.f, -(float)f / 16.f); const float ang = (float)pos * inv; ropec[i] = cosf(ang); ropes[i] = sinf(ang); }
    }
    if (F.blk == (1 % F.G) && F.wave < 4) {
        const int l = F.wave; const float* lv = INP(13) + l * 256;
        const float a = wave_sum(lv[F.lane] * lv[64 + F.lane]), b = wave_sum(lv[128 + F.lane] * lv[192 + F.lane]);
        if (F.lane == 0) lam[l] = expf(a) - expf(b) + lam_init_of(l);
    }
}

namespace att {
using bf16x8 = __attribute__((ext_vector_type(8))) short;
using s16x4  = __attribute__((ext_vector_type(4))) short;
using f32x16 = __attribute__((ext_vector_type(16))) float;
using u32x4  = __attribute__((ext_vector_type(4))) unsigned;
constexpr int QBLK = 32, KVBLK = 64, NW = 8, DV = 128;
constexpr float THR = 8.f;
constexpr size_t SHM_V = KVBLK * DV * 2, SHM_K = KVBLK * 64 * 2, SHM_ATTN = 2 * SHM_V + 2 * SHM_K + NW * 64 * 4;
#define KSWZ64(row, colB) ((row) * 128 + ((colB) ^ ((((row) >> 1) & 7) << 4)))
#define SBAR() __builtin_amdgcn_sched_barrier(0)
__device__ __forceinline__ int crow(int r, int hi) { return (r & 3) + 8 * (r >> 2) + 4 * hi; }
__device__ __forceinline__ unsigned cvtpk(float lo, float hi) { unsigned r; asm volatile("v_cvt_pk_bf16_f32 %0, %1, %2" : "=v"(r) : "v"(lo), "v"(hi)); return r; }
__device__ __forceinline__ void partialSM(f32x16& p0, f32x16& p1, float& m_reg, float& mn, float& alpha) {
  float pmax = p0[0];
#pragma unroll
  for (int r = 1; r < 16; ++r) pmax = fmaxf(pmax, p0[r]);
#pragma unroll
  for (int r = 0; r < 16; ++r) pmax = fmaxf(pmax, p1[r]);
  { auto rr = __builtin_amdgcn_permlane32_swap(__float_as_uint(pmax), __float_as_uint(pmax), false, false);
    pmax = fmaxf(__uint_as_float(rr[0]), __uint_as_float(rr[1])); }
  if (__builtin_expect(__all(pmax - m_reg <= THR), 1)) { mn = m_reg; alpha = 1.f; }
  else { mn = fmaxf(m_reg, pmax); alpha = __builtin_amdgcn_exp2f(m_reg - mn); m_reg = mn; }
#pragma unroll
  for (int r = 0; r < 16; ++r) p0[r] = p0[r] - mn;
#pragma unroll
  for (int r = 0; r < 16; ++r) p1[r] = p1[r] - mn;
#pragma unroll
  for (int r = 0; r < 16; ++r) p0[r] = __builtin_amdgcn_exp2f(p0[r]);
}
__device__ __forceinline__ void finishSM(f32x16& p0, f32x16& p1, float alpha, float& l_reg, bf16x8& pa0, bf16x8& pa1, bf16x8& pa2, bf16x8& pa3) {
#pragma unroll
  for (int r = 0; r < 16; ++r) p1[r] = __builtin_amdgcn_exp2f(p1[r]);
  float ps = 0;
#pragma unroll
  for (int r = 0; r < 16; ++r) ps += p0[r];
#pragma unroll
  for (int r = 0; r < 16; ++r) ps += p1[r];
  { auto rr = __builtin_amdgcn_permlane32_swap(__float_as_uint(ps), __float_as_uint(ps), false, false);
    ps = __uint_as_float(rr[0]) + __uint_as_float(rr[1]); }
  l_reg = l_reg * alpha + ps;
#define PK4(P, BASE, OUT) do { unsigned a0 = cvtpk(P[BASE + 0], P[BASE + 1]), a1 = cvtpk(P[BASE + 2], P[BASE + 3]);   \
    unsigned b0 = cvtpk(P[BASE + 4], P[BASE + 5]), b1 = cvtpk(P[BASE + 6], P[BASE + 7]);                              \
    auto r0 = __builtin_amdgcn_permlane32_swap(a0, b0, false, false); auto r1 = __builtin_amdgcn_permlane32_swap(a1, b1, false, false); \
    u32x4 w = {r0[0], r1[0], r0[1], r1[1]}; OUT = *reinterpret_cast<bf16x8*>(&w); } while (0)
  PK4(p0, 0, pa0); PK4(p0, 8, pa1); PK4(p1, 0, pa2); PK4(p1, 8, pa3);
#undef PK4
}
__device__ __forceinline__ void pack_p(const f32x16& p0, const f32x16& p1, bf16x8& pa0, bf16x8& pa1, bf16x8& pa2, bf16x8& pa3) {
#define PK4(P, BASE, OUT) do { unsigned a0 = cvtpk(P[BASE + 0], P[BASE + 1]), a1 = cvtpk(P[BASE + 2], P[BASE + 3]);   \
    unsigned b0 = cvtpk(P[BASE + 4], P[BASE + 5]), b1 = cvtpk(P[BASE + 6], P[BASE + 7]);                              \
    auto r0 = __builtin_amdgcn_permlane32_swap(a0, b0, false, false); auto r1 = __builtin_amdgcn_permlane32_swap(a1, b1, false, false); \
    u32x4 w = {r0[0], r1[0], r0[1], r1[1]}; OUT = *reinterpret_cast<bf16x8*>(&w); } while (0)
  PK4(p0, 0, pa0); PK4(p0, 8, pa1); PK4(p1, 0, pa2); PK4(p1, 8, pa3);
#undef PK4
}
__device__ __forceinline__ void qkt(f32x16& p0, f32x16& p1, const bf16* Ks, const bf16x8* qr, int r32, int hi) {
  p0 = f32x16{}; p1 = f32x16{};
#pragma unroll
  for (int d0 = 0; d0 < 4; ++d0) { int cb = (d0 * 16 + hi * 8) * 2;
    bf16x8 b0 = *reinterpret_cast<const bf16x8*>((const char*)Ks + KSWZ64(r32, cb));
    bf16x8 b1 = *reinterpret_cast<const bf16x8*>((const char*)Ks + KSWZ64(32 + r32, cb));
    p0 = __builtin_amdgcn_mfma_f32_32x32x16_bf16(b0, qr[d0], p0, 0, 0, 0);
    p1 = __builtin_amdgcn_mfma_f32_32x32x16_bf16(b1, qr[d0], p1, 0, 0, 0); }
}
__device__ __forceinline__ int v_st(int k, int c) { const int kk = (k & ~0xC) | ((k & 4) << 1) | ((k & 8) >> 1); return ((kk >> 3) * 4 + (c >> 5)) * 512 + ((kk & 7) * 32 + (c & 31)) * 2; }
__device__ __forceinline__ int v_rd_base(int lane) { return ((lane & 3) << 3) | (((lane >> 2) & 3) << 6) | (((lane >> 4) & 1) << 5) | (((lane >> 5) & 1) << 8); }
constexpr int v_rd_off(int d0, int ks, int half) { return d0 * 512 + ks * 4096 + half * 2048; }
template <int OFF> __device__ __forceinline__ s16x4 tr_read(int vb) {
  s16x4 r; asm volatile("ds_read_b64_tr_b16 %0, %1 offset:%2" : "=&v"(r) : "v"(vb), "i"(OFF) : "memory"); return r;
}
template <int D0> __device__ __forceinline__ void pv_one(f32x16& od, int vb, bf16x8 pa0, bf16x8 pa1, bf16x8 pa2, bf16x8 pa3) {
  const s16x4 l0 = tr_read<v_rd_off(D0, 0, 0)>(vb), h0 = tr_read<v_rd_off(D0, 0, 1)>(vb), l1 = tr_read<v_rd_off(D0, 1, 0)>(vb), h1 = tr_read<v_rd_off(D0, 1, 1)>(vb);
  const s16x4 l2 = tr_read<v_rd_off(D0, 2, 0)>(vb), h2 = tr_read<v_rd_off(D0, 2, 1)>(vb), l3 = tr_read<v_rd_off(D0, 3, 0)>(vb), h3 = tr_read<v_rd_off(D0, 3, 1)>(vb);
  asm volatile("s_waitcnt lgkmcnt(0)" ::: "memory"); SBAR();
#define PK(L, H) (bf16x8){L[0], L[1], L[2], L[3], H[0], H[1], H[2], H[3]}
  od = __builtin_amdgcn_mfma_f32_32x32x16_bf16(pa0, PK(l0, h0), od, 0, 0, 0);
  od = __builtin_amdgcn_mfma_f32_32x32x16_bf16(pa1, PK(l1, h1), od, 0, 0, 0);
  od = __builtin_amdgcn_mfma_f32_32x32x16_bf16(pa2, PK(l2, h2), od, 0, 0, 0);
  od = __builtin_amdgcn_mfma_f32_32x32x16_bf16(pa3, PK(l3, h3), od, 0, 0, 0);
#undef PK
}
__device__ __forceinline__ void pv_d0(f32x16* o, int vb, bf16x8 pa0, bf16x8 pa1, bf16x8 pa2, bf16x8 pa3) {
  pv_one<0>(o[0], vb, pa0, pa1, pa2, pa3); pv_one<1>(o[1], vb, pa0, pa1, pa2, pa3); pv_one<2>(o[2], vb, pa0, pa1, pa2, pa3); pv_one<3>(o[3], vb, pa0, pa1, pa2, pa3);
}
constexpr int LDQ = NP, LDK = NP, LDO = DM;
__device__ __forceinline__ void attn_unit(const bf16* __restrict__ Qb, const bf16* __restrict__ Kh, const bf16* __restrict__ Vh, bf16* __restrict__ Ob, int seq, char* lds, int tid) {
  const int wid = tid >> 6, lane = tid & 63, r32 = lane & 31, hi = lane >> 5;
  bf16* V_lds = (bf16*)lds; bf16* K_lds = (bf16*)(lds + 2 * SHM_V);
  float* ws = (float*)(lds + 2 * SHM_V + 2 * SHM_K) + wid * 64; float* li_l = ws; float* al_l = ws + 32;
  float m_reg = -1e30f, l_reg = 0; f32x16 o[4] = {}; bf16x8 qr[4];
  const bf16* Qw = Qb + (long)(wid * QBLK + r32) * LDQ + hi * 8;
#pragma unroll
  for (int d0 = 0; d0 < 4; ++d0) qr[d0] = *(const __attribute__((address_space(1))) bf16x8*)(Qw + d0 * 16);
  const int sr = tid >> 4, sc = (tid & 15) * 8, vst0 = v_st(sr, sc), vst1 = v_st(32 + sr, sc);
  const int kr = tid >> 3, kc = (tid & 7) * 8, kst = KSWZ64(kr, kc * 2);
  const int vb0 = (int)(uintptr_t)V_lds + v_rd_base(lane);
  struct { bf16x8 vs0, vs1, ks0; } sr_[2];
#define GLD8(p) (*(const __attribute__((address_space(1))) bf16x8*)(p))
#define SLOAD(i, k0) do { sr_[i].vs0 = GLD8(&Vh[(long)((k0) + sr) * LDK + sc]); sr_[i].vs1 = GLD8(&Vh[(long)((k0) + 32 + sr) * LDK + sc]); \
    sr_[i].ks0 = GLD8(&Kh[(long)((k0) + kr) * LDK + kc]); } while (0)
#define SWRITE(b, i) do { *(bf16x8*)((char*)V_lds + (b) * SHM_V + vst0) = sr_[i].vs0; *(bf16x8*)((char*)V_lds + (b) * SHM_V + vst1) = sr_[i].vs1; \
    *(bf16x8*)((char*)K_lds + (b) * SHM_K + kst) = sr_[i].ks0; } while (0)
#define SWAIT() asm volatile("s_waitcnt vmcnt(3)" ::: "memory")
#define RESC(a) do { if (__any((a) < 1.f)) { if (hi == 0) al_l[r32] = (a); asm volatile("s_waitcnt lgkmcnt(0)" ::: "memory"); \
    _Pragma("unroll") for (int d = 0; d < 4; ++d) _Pragma("unroll") for (int r = 0; r < 16; ++r) o[d][r] *= al_l[crow(r, hi)]; } } while (0)
  f32x16 pA0, pA1, pB0, pB1; float mnA, mnB, alA, alB; bf16x8 pa0, pa1, pa2, pa3; const int NT = seq / KVBLK;
  if (__builtin_amdgcn_readfirstlane(wid) >= 4) __builtin_amdgcn_s_setprio(1);
  constexpr int SE = 0, SO = 1;
  SLOAD(SE, 0); asm volatile("s_waitcnt vmcnt(0)" ::: "memory"); SWRITE(0, SE); __syncthreads();
  qkt(pA0, pA1, K_lds, qr, r32, hi); partialSM(pA0, pA1, m_reg, mnA, alA);
  SLOAD(SO, KVBLK); if (2 < NT) SLOAD(SE, 2 * KVBLK);
  SWAIT(); SWRITE(1, SO); __syncthreads();
  for (int j = 1; j + 1 < NT; j += 2) {
    SBAR(); qkt(pB0, pB1, (bf16*)((char*)K_lds + SHM_K), qr, r32, hi);
    finishSM(pA0, pA1, alA, l_reg, pa0, pa1, pa2, pa3); SBAR();
    SLOAD(SO, (j + 2) * KVBLK); SBAR();
    pv_d0(o, vb0, pa0, pa1, pa2, pa3); partialSM(pB0, pB1, m_reg, mnB, alB);
    __syncthreads(); SWAIT(); SWRITE(0, SE);
    RESC(alB); __syncthreads();
    SBAR(); qkt(pA0, pA1, K_lds, qr, r32, hi);
    finishSM(pB0, pB1, alB, l_reg, pa0, pa1, pa2, pa3); SBAR();
    if (j + 3 < NT) SLOAD(SE, (j + 3) * KVBLK); SBAR();
    pv_d0(o, vb0 + (int)SHM_V, pa0, pa1, pa2, pa3); partialSM(pA0, pA1, m_reg, mnA, alA);
    __syncthreads(); SWAIT(); SWRITE(1, SO);
    RESC(alA); __syncthreads();
  }
  SBAR(); qkt(pB0, pB1, (bf16*)((char*)K_lds + SHM_K), qr, r32, hi);
  finishSM(pA0, pA1, alA, l_reg, pa0, pa1, pa2, pa3); SBAR();
  pv_d0(o, vb0, pa0, pa1, pa2, pa3); partialSM(pB0, pB1, m_reg, mnB, alB);
  __syncthreads(); RESC(alB);
  finishSM(pB0, pB1, alB, l_reg, pa0, pa1, pa2, pa3); SBAR();
  pv_d0(o, vb0 + (int)SHM_V, pa0, pa1, pa2, pa3);
  __builtin_amdgcn_s_setprio(0);
  if (hi == 0) li_l[r32] = l_reg; asm volatile("s_waitcnt lgkmcnt(0)" ::: "memory");
  float rli[16];
#pragma unroll
  for (int r = 0; r < 16; ++r) rli[r] = __builtin_amdgcn_rcpf(li_l[crow(r, hi)]);
  bf16* Ow = Ob + (long)(wid * QBLK) * LDO;
#pragma unroll
  for (int r = 0; r < 16; ++r) { const int orow = crow(r, hi);
#pragma unroll
    for (int d0 = 0; d0 < 4; ++d0) Ow[(long)orow * LDO + d0 * 32 + r32] = (bf16)(cvtpk(o[d0][r] * rli[r], 0.f) & 0xffffu); }
#undef SLOAD
#undef GLD8
#undef SWRITE
#undef SWAIT
#undef RESC
}
}

__device__ __forceinline__ int gla_item(int b, int h, int dir, int c) { return ((b * 4 + h) * 2 + dir) * NCH + c; }
namespace gla {
using att::bf16x8; using att::f32x16; using att::u32x4;
__device__ __forceinline__ void gates8(const bf16* P, const float* w2, const float* gb, size_t row0, int dir, int seg, int k, float (&gl)[8]) {
    float w[16];
#pragma unroll
    for (int j = 0; j < 16; ++j) w[j] = w2[j * 256 + k];
    const float bias = gb[k];
#pragma unroll
    for (int i = 0; i < 8; ++i) {
        const bf16* gp = P + (row0 + seg * 8 + i) * NP + C_GLR + dir * 16;
        const v4u a = *(const v4u*)gp, b = *(const v4u*)(gp + 8);
        float z = bias;
        z += bflo(a.x) * w[0] + bfhi(a.x) * w[1] + bflo(a.y) * w[2] + bfhi(a.y) * w[3] + bflo(a.z) * w[4] + bfhi(a.z) * w[5] + bflo(a.w) * w[6] + bfhi(a.w) * w[7];
        z += bflo(b.x) * w[8] + bfhi(b.x) * w[9] + bflo(b.y) * w[10] + bfhi(b.y) * w[11] + bflo(b.z) * w[12] + bfhi(b.z) * w[13] + bflo(b.w) * w[14] + bfhi(b.w) * w[15];
        gl[i] = (fminf(z, 0.f) - log1pf(expf(-fabsf(z)))) * (1.f / 16.f);
    }
}
__device__ __forceinline__ float lscan(const float (&gl)[8], int dir, float (&loc)[8]) {
    float run = 0.f;
    if (dir == 0) {
#pragma unroll
        for (int i = 0; i < 8; ++i) { run += gl[i]; loc[i] = run; }
    } else {
#pragma unroll
        for (int i = 7; i >= 0; --i) { run += gl[i]; loc[i] = run; }
    }
    return run;
}
__device__ __forceinline__ void stage_tile_bf16(const bf16* src, size_t pitch, char* tile, int tid) {
    const int sr = tid >> 4, sc = (tid & 15) * 8;
    const bf16x8 a = *reinterpret_cast<const bf16x8*>(src + (size_t)sr * pitch + sc), b = *reinterpret_cast<const bf16x8*>(src + (size_t)(32 + sr) * pitch + sc);
    *(bf16x8*)(tile + att::v_st(sr, sc)) = a; *(bf16x8*)(tile + att::v_st(32 + sr, sc)) = b;
}
__device__ __forceinline__ void stage_tile_f32(const float* src, char* tile, int tid) {
    const int sr = tid >> 4, sc = (tid & 15) * 8;
#pragma unroll
    for (int t = 0; t < 2; ++t) { const int row = sr + 32 * t; const f32x4 x = *(const f32x4*)(src + row * 128 + sc), y = *(const f32x4*)(src + row * 128 + sc + 4);
        u32x4 w = {att::cvtpk(x[0], x[1]), att::cvtpk(x[2], x[3]), att::cvtpk(y[0], y[1]), att::cvtpk(y[2], y[3])};
        *(u32x4*)(tile + att::v_st(row, sc)) = w; }
}
__device__ __forceinline__ void pv_sel(int d0, f32x16& o, int vb, bf16x8 a0, bf16x8 a1, bf16x8 a2, bf16x8 a3) {
    switch (d0) { case 0: att::pv_one<0>(o, vb, a0, a1, a2, a3); break; case 1: att::pv_one<1>(o, vb, a0, a1, a2, a3); break;
                  case 2: att::pv_one<2>(o, vb, a0, a1, a2, a3); break; default: att::pv_one<3>(o, vb, a0, a1, a2, a3); break; }
}
__device__ __forceinline__ void afrag4(const char* img, int row, int hi, bf16x8 (&a)[4]) {
#pragma unroll
    for (int s = 0; s < 4; ++s) a[s] = *reinterpret_cast<const bf16x8*>(img + KSWZ64(row, (s * 16 + hi * 8) * 2));
}
__device__ __forceinline__ void st_sw(char* img, int row, int col, float v) { *(unsigned short*)(img + KSWZ64(row, col * 2)) = (unsigned short)(att::cvtpk(v, 0.f) & 0xffffu); }
}

constexpr size_t WS_OG = WS_DS;
constexpr int CW_Q = 12288;
struct GlaPre { unsigned g; unsigned short q[8], k[8]; att::bf16x8 v0, v1; };
__device__ __forceinline__ void gla_prefetch(GlaPre& R, const bf16* P_, size_t row0, int h, int dir, int k, int seg, int tid) {
    const GAS bf16* P = (const GAS bf16*)P_;
    R.g = *(const GAS unsigned*)(P + (row0 + seg * 8 + (k >> 3)) * NP + C_GLR + dir * 16 + (k & 7) * 2);
#pragma unroll
    for (int i = 0; i < 8; ++i) { const GAS bf16* rp = P + (row0 + seg * 8 + i) * NP; R.q[i] = rp[C_GQ + h * 64 + k]; R.k[i] = rp[C_GK + h * 64 + k]; }
    const int sr = tid >> 4, sc = (tid & 15) * 8;
    R.v0 = *(const GAS att::bf16x8*)(P + (row0 + sr) * NP + C_GV + h * 128 + sc); R.v1 = *(const GAS att::bf16x8*)(P + (row0 + 32 + sr) * NP + C_GV + h * 128 + sc);
}
__device__ __forceinline__ void gla_chain(Frame& F, int l, int chain) {
    const int b = chain >> 3, h = (chain >> 1) & 3, dir = chain & 1;
    const bf16* P = (const bf16*)(F.ws + WS_PROJ); bf16* OG = (bf16*)(F.ws + WS_OG) + (size_t)dir * M * 512;
    char* lds = (char*)F.lds; char* Vt = lds; char* St = lds + 16384; char* KtT = lds + 32768; char* Kt = lds + 40960; char* Qt = lds + 49152; char* Qh = lds + 57344;
    float* T = (float*)(lds + 65536); float* Dec = (float*)(lds + 67584);
    const int k = F.lane, seg = F.tid >> 6, r32 = F.lane & 31, hi = F.lane >> 5, mt = F.wave >> 2, d0 = F.wave & 3;
    const int vbV = (int)(uintptr_t)Vt + att::v_rd_base(F.lane), vbS = (int)(uintptr_t)St + att::v_rd_base(F.lane);
    const int sr = F.tid >> 4, sc = (F.tid & 15) * 8;
    float w[16];
    { const float* w2 = INP(11) + (size_t)((l * 2 + dir) * 16) * 256 + h * 64;
#pragma unroll
      for (int j = 0; j < 16; ++j) w[j] = w2[j * 256 + k]; }
    const float bias = (INP(12) + (l * 2 + dir) * 256 + h * 64)[k];
    att::f32x16 S = {};
    GlaPre R, RN;
    { const int c0 = dir == 0 ? 0 : 3; gla_prefetch(RN, P, (size_t)b * TPB + c0 * 64, h, dir, k, seg, F.tid); }
    for (int j = 0; j < NCH; ++j) {
        const int c = dir == 0 ? j : (j < 4 ? 3 - j : 39 - j);
        const size_t row0 = (size_t)b * TPB + c * 64;
        R = RN;
        if (j + 1 < NCH) { const int cn = dir == 0 ? j + 1 : (j + 1 < 4 ? 2 - j : 38 - j); gla_prefetch(RN, P, (size_t)b * TPB + cn * 64, h, dir, k, seg, F.tid); }
        float gl[8], loc[8];
#pragma unroll
        for (int i = 0; i < 8; ++i) {
            float z = bias;
#pragma unroll
            for (int d = 0; d < 8; ++d) { const unsigned s = (unsigned)__builtin_amdgcn_readlane((int)R.g, i * 8 + d); z += bflo(s) * w[2 * d] + bfhi(s) * w[2 * d + 1]; }
            gl[i] = (fminf(z, 0.f) - __logf(1.f + __expf(-fabsf(z)))) * (1.f / 16.f); }
        const float segtot = gla::lscan(gl, dir, loc);
        T[seg * 64 + k] = segtot;
        *(att::bf16x8*)(Vt + att::v_st(sr, sc)) = R.v0; *(att::bf16x8*)(Vt + att::v_st(32 + sr, sc)) = R.v1;
#pragma unroll
        for (int r = 0; r < 16; ++r) *(unsigned short*)(St + att::v_st(mt * 32 + att::crow(r, hi), d0 * 32 + r32)) = (unsigned short)(att::cvtpk(S[r], 0.f) & 0xffffu);
        __syncthreads();
        float off = 0.f, tot = 0.f;
        int sg = seg; asm volatile("" : "+v"(sg));
#pragma unroll
        for (int s = 0; s < 8; ++s) { const float t = T[s * 64 + k]; tot += t; const bool inoff = dir == 0 ? (s < sg) : (s > sg); off += inoff ? t : 0.f; }
        const float etot = __expf(tot);
        float kt[8];
#pragma unroll
        for (int i = 0; i < 8; ++i) { const int tau = seg * 8 + i; const float qv = bf2f(R.q[i]), kv = bf2f(R.k[i]); const float cc = loc[i] + off;
            const float a = fmaxf(__expf(cc), 1e-30f)  , bq = __builtin_amdgcn_rcpf(a), kb = kv * bq;
            kt[i] = kb * etot;
            gla::st_sw(Qh, tau, k, qv * a); gla::st_sw(Kt, tau, k, kb); }
        { att::u32x4 wv = {att::cvtpk(kt[0], kt[1]), att::cvtpk(kt[2], kt[3]), att::cvtpk(kt[4], kt[5]), att::cvtpk(kt[6], kt[7])};
          *(att::u32x4*)(KtT + KSWZ64(k, seg * 16)) = wv; }
        if (sg == 0) Dec[k] = etot;
        __syncthreads();
        att::f32x16 o = {};
        int tau_q = mt * 32 + r32; asm volatile("" : "+v"(tau_q));
        { att::bf16x8 qr[4]; gla::afrag4(Qh, tau_q, hi, qr);
          att::f32x16 p0, p1; att::qkt(p0, p1, (const bf16*)Kt, qr, r32, hi);
#pragma unroll
          for (int r = 0; r < 16; ++r) { const int t0 = att::crow(r, hi), t1 = 32 + t0;
              const bool k0 = dir == 0 ? (t0 <= tau_q) : (t0 >= tau_q), k1 = dir == 0 ? (t1 <= tau_q) : (t1 >= tau_q);
              p0[r] = k0 ? p0[r] : 0.f; p1[r] = k1 ? p1[r] : 0.f; }
          att::bf16x8 pa0, pa1, pa2, pa3; att::pack_p(p0, p1, pa0, pa1, pa2, pa3);
          gla::pv_sel(d0, o, vbV, pa0, pa1, pa2, pa3);
          gla::pv_sel(d0, o, vbS, qr[0], qr[1], qr[2], qr[3]); }
#pragma unroll
        for (int r = 0; r < 16; ++r) S[r] *= Dec[mt * 32 + att::crow(r, hi)];
        { att::bf16x8 a[4]; gla::afrag4(KtT, mt * 32 + r32, hi, a); gla::pv_sel(d0, S, vbV, a[0], a[1], a[2], a[3]); }
        GAS bf16* op = (GAS bf16*)(OG + row0 * 512 + h * 128 + d0 * 32 + r32);
#pragma unroll
        for (int r = 0; r < 16; ++r) op[(size_t)(mt * 32 + att::crow(r, hi)) * 512] = (bf16)(att::cvtpk(o[r], 0.f) & 0xffffu);
        __syncthreads();
    }
}
__device__ __forceinline__ void p3_mixer(Frame& F, int l) {
    refresh(F);
    for (int ch = F.blk; ch < NBATCH * 8; ch += F.G) gla_chain(F, l, ch);
    const bf16* P = (const bf16*)(F.ws + WS_PROJ); bf16* OD = (bf16*)(F.ws + WS_OD);
    volatile LAS unsigned* slot = F.MISC + 24;
    int myq = F.blk & 7, tries = 0;
    for (;;) {
        __syncthreads();
        if (F.tid == 0) slot[0] = __hip_atomic_fetch_add((unsigned*)((gu32*)F.ws + CW_Q + 64 * l + 8 * 0 + myq), 1u, __ATOMIC_RELAXED, __HIP_MEMORY_SCOPE_AGENT);
        __syncthreads();
        const int u = (int)slot[0];
        if (u >= (l == DEPTH - 1 ? 128 : 144)) { if (++tries >= 8) break; myq = (myq + 1) & 7; continue; }
        int g, qt;
        if (u < 128) { const int pi = u >> 4, mp = (u >> 3) & 1; g = ((pi * 8 + myq) << 1) + mp; qt = 1 + (u & 7); }
        else { const int gi = u - 128; g = (((gi >> 1) * 8 + myq) << 1) + (gi & 1); qt = 0; }
        const int b = g >> 3, hh = g & 7;
        const size_t row0 = (size_t)b * TPB;
        att::attn_unit(P + (row0 + qt * 256) * NP + C_Q + hh * 64, P + row0 * NP + C_K + hh * 64, P + row0 * NP + C_V + (hh >> 1) * 128,
                       OD + (row0 + qt * 256) * DM + hh * 128, qt == 0 ? CTX : TPB, (char*)F.lds, F.tid);
    }
    __syncthreads();
}
__device__ __forceinline__ void p5_merge_all(Frame& F, int l) {
    refresh(F);
    const bf16* OD = (const bf16*)(F.ws + WS_OD); const bf16* OG = (const bf16*)(F.ws + WS_OG); const bf16* P = (const bf16*)(F.ws + WS_PROJ); bf16* MRG = (bf16*)(F.ws + WS_H);
    const float lam = ((const float*)(F.ws + WS_ROPE + 16384))[l]; const float omli = 1.f - lam_init_of(l);
    const float* subln = INP(14) + l * 128; const float* onorm = INP(15) + l * 128;
    const int h = F.lane >> 4, c0 = (F.lane & 15) * 8;
    const int rpw = (M + F.NGW - 1) / F.NGW, r0 = F.gw * rpw, r1 = (r0 + rpw < M) ? r0 + rpw : M;
    for (int r = r0; r < r1; ++r) {
        const v4u a = *(const v4u*)(OD + (size_t)r * DM + h * 256 + c0), bq = *(const v4u*)(OD + (size_t)r * DM + h * 256 + 128 + c0);
        const v4u gf = *(const v4u*)(OG + (size_t)r * 512 + h * 128 + c0), gbk = *(const v4u*)(OG + ((size_t)M + r) * 512 + h * 128 + c0);
        const v4u gt = *(const v4u*)(P + (size_t)r * NP + C_GG + h * 128 + c0);
        float d[8], e[8], g[8];
        d[0] = bflo(a.x) - lam * bflo(bq.x); d[1] = bfhi(a.x) - lam * bfhi(bq.x); d[2] = bflo(a.y) - lam * bflo(bq.y); d[3] = bfhi(a.y) - lam * bfhi(bq.y);
        d[4] = bflo(a.z) - lam * bflo(bq.z); d[5] = bfhi(a.z) - lam * bfhi(bq.z); d[6] = bflo(a.w) - lam * bflo(bq.w); d[7] = bfhi(a.w) - lam * bfhi(bq.w);
        e[0] = bflo(gf.x) + bflo(gbk.x); e[1] = bfhi(gf.x) + bfhi(gbk.x); e[2] = bflo(gf.y) + bflo(gbk.y); e[3] = bfhi(gf.y) + bfhi(gbk.y);
        e[4] = bflo(gf.z) + bflo(gbk.z); e[5] = bfhi(gf.z) + bfhi(gbk.z); e[6] = bflo(gf.w) + bflo(gbk.w); e[7] = bfhi(gf.w) + bfhi(gbk.w);
        g[0] = bflo(gt.x); g[1] = bfhi(gt.x); g[2] = bflo(gt.y); g[3] = bfhi(gt.y); g[4] = bflo(gt.z); g[5] = bfhi(gt.z); g[6] = bflo(gt.w); g[7] = bfhi(gt.w);
        float ss = 0.f, se = 0.f;
#pragma unroll
        for (int i = 0; i < 8; ++i) { ss += d[i] * d[i]; se += e[i] * e[i]; }
        ss = xadd<1>(ss); ss = xadd<2>(ss); ss = xadd<4>(ss); ss = xadd<8>(ss);
        se = xadd<1>(se); se = xadd<2>(se); se = xadd<4>(se); se = xadd<8>(se);
        const float sc = omli / sqrtf(ss * (1.f / 128.f) + EPS), se2 = 1.0f / sqrtf(se * (1.f / 128.f) + EPS);
#pragma unroll
        for (int i = 0; i < 8; ++i) { d[i] = d[i] * sc * subln[c0 + i]; e[i] = e[i] * se2 * onorm[c0 + i] * siluf(g[i]); }
        v4u w; w.x = pg8::cvt_pk_bf16(d[0], d[1]); w.y = pg8::cvt_pk_bf16(d[2], d[3]); w.z = pg8::cvt_pk_bf16(d[4], d[5]); w.w = pg8::cvt_pk_bf16(d[6], d[7]);
        *(v4u*)(MRG + (size_t)r * DM + h * 128 + c0) = w;
        v4u x; x.x = pg8::cvt_pk_bf16(e[0], e[1]); x.y = pg8::cvt_pk_bf16(e[2], e[3]); x.z = pg8::cvt_pk_bf16(e[4], e[5]); x.w = pg8::cvt_pk_bf16(e[6], e[7]);
        *(v4u*)(MRG + (size_t)r * DM + 512 + h * 128 + c0) = x;
    }
}

__device__ __forceinline__ float dpp_sum16(float v) {
    v += __int_as_float(__builtin_amdgcn_update_dpp(0, __float_as_int(v), 0xB1, 0xF, 0xF, true));
    v += __int_as_float(__builtin_amdgcn_update_dpp(0, __float_as_int(v), 0x4E, 0xF, 0xF, true));
    v += __int_as_float(__builtin_amdgcn_update_dpp(0, __float_as_int(v), 0x141, 0xF, 0xF, true));
    v += __int_as_float(__builtin_amdgcn_update_dpp(0, __float_as_int(v), 0x140, 0xF, 0xF, true));
    return v;
}
__device__ __forceinline__ float wave_sum2(float v) { v = dpp_sum16(v); v = xadd<16>(v); v = xadd<32>(v); return v; }
__device__ __forceinline__ float row_rinv2(const f32x4 (&v)[4]) {
    float s = 0.f;
#pragma unroll
    for (int j = 0; j < 4; ++j) s += (v[j][0] * v[j][0] + v[j][1] * v[j][1]) + (v[j][2] * v[j][2] + v[j][3] * v[j][3]);
    return __builtin_amdgcn_rsqf(wave_sum2(s) * (1.f / DM) + EPS);
}
__device__ __forceinline__ void ld_raw_bf16(const bf16* row, int lane, u32x2 (&v)[4]) {
#pragma unroll
    for (int j = 0; j < 4; ++j) v[j] = *(const u32x2*)(row + 4 * lane + 256 * j);
}
__device__ __forceinline__ f32x4 raw2f(u32x2 w) { return (f32x4){bflo(w.x), bfhi(w.x), bflo(w.y), bfhi(w.y)}; }
__device__ __forceinline__ void ld_vec(const float* p, int lane, f32x4 (&v)[4]) {
#pragma unroll
    for (int j = 0; j < 4; ++j) v[j] = *(const f32x4*)(p + 4 * lane + 256 * j);
}

__device__ __forceinline__ void p1_rows(Frame& F, int l) {
    refresh(F);
    const float* MOD = (const float*)(F.ws + WS_MOD);
    bf16* X = (bf16*)(F.ws + WS_X); bf16* H = (bf16*)(F.ws + WS_H); const bf16* F2 = (const bf16*)(F.ws + WS_F2);
    const int rpw = (M + F.NGW - 1) / F.NGW, r0 = F.gw * rpw, r1 = (r0 + rpw < M) ? r0 + rpw : M;
    if (r0 >= r1) return;
    const bool two = l > 0 && ((l - 1) & 1);
    f32x4 gpre[4], gpost[4], sh[4], sc[4], gt[4];
    ld_vec(INP(6) + l * DM, F.lane, gpre);
    if (l > 0) ld_vec(INP(9) + (l - 1) * DM, F.lane, gpost);
    int cur = -1;
    f32x4 xn[4]; u32x2 xr[4], fn[4], gn[4];
#define P1_ISSUE(r) do { const int b_ = (r) / TPB, p_ = (r) % TPB; \
        if (l == 0) ld_row_f32(p_ < CTX ? INP(2) + ((size_t)b_ * CTX + p_) * DM : INP(0) + ((size_t)b_ * SEQ + (p_ - CTX)) * DM, F.lane, xn); \
        else ld_raw_bf16(X + (size_t)(r) * DM, F.lane, xr); \
        if (l > 0) { ld_raw_bf16(F2 + (size_t)(r) * DM, F.lane, fn); if (two) ld_raw_bf16(F2 + ((size_t)M + (r)) * DM, F.lane, gn); } } while (0)
    P1_ISSUE(r0);
    for (int r = r0; r < r1; ++r) {
        f32x4 x[4]; u32x2 fr[4], gr[4];
#pragma unroll
        for (int j = 0; j < 4; ++j) { x[j] = (l == 0) ? xn[j] : raw2f(xr[j]); fr[j] = fn[j]; gr[j] = gn[j]; }
        if (r + 1 < r1) P1_ISSUE(r + 1);
        const int b = r / TPB, p = r % TPB, mrow = p < CTX ? 16 : b;
        if (mrow != cur) { cur = mrow; const float* modp = MOD + ((size_t)l * 17 + mrow) * 6144; ld_vec(modp, F.lane, sh); ld_vec(modp + 1024, F.lane, sc);
            if (l > 0) ld_vec(MOD + ((size_t)(l - 1) * 17 + mrow) * 6144 + 5 * 1024, F.lane, gt); }
        if (l > 0) {
            f32x4 f[4];
#pragma unroll
            for (int j = 0; j < 4; ++j) { f[j] = raw2f(fr[j]); if (two) f[j] = f[j] + raw2f(gr[j]); }
            const float rinv = row_rinv2(f);
#pragma unroll
            for (int j = 0; j < 4; ++j) x[j] = x[j] + gt[j] * (f[j] * rinv * gpost[j]);
        }
        st_row_bf16(X + (size_t)r * DM, F.lane, x);
        const float rinv = row_rinv2(x);
        f32x4 h[4];
#pragma unroll
        for (int j = 0; j < 4; ++j) h[j] = (x[j] * rinv * gpre[j]) * (sc[j] + 1.0f) + sh[j];
        st_row_bf16(H + (size_t)r * DM, F.lane, h);
    }
#undef P1_ISSUE
}
__device__ __forceinline__ void pf_final(Frame& F) {
    refresh(F);
    const float* MOD = (const float*)(F.ws + WS_MOD);
    const bf16* X = (const bf16*)(F.ws + WS_X); const bf16* F2 = (const bf16*)(F.ws + WS_F2);
    const int l = DEPTH - 1, NR = NBATCH * SEQ;
    const int rpw = (NR + F.NGW - 1) / F.NGW, i0 = F.gw * rpw, i1 = (i0 + rpw < NR) ? i0 + rpw : NR;
    if (i0 >= i1) return;
    f32x4 gpost[4], gt[4]; ld_vec(INP(9) + l * DM, F.lane, gpost);
    int cur = -1;
    u32x2 xn[4], fn[4], gn[4];
#define PF_ISSUE(i) do { const size_t r_ = (size_t)((i) / SEQ) * TPB + CTX + (i) % SEQ; ld_raw_bf16(X + r_ * DM, F.lane, xn); ld_raw_bf16(F2 + r_ * DM, F.lane, fn); ld_raw_bf16(F2 + ((size_t)M + r_) * DM, F.lane, gn); } while (0)
    PF_ISSUE(i0);
    for (int i = i0; i < i1; ++i) {
        f32x4 x[4], f[4];
#pragma unroll
        for (int j = 0; j < 4; ++j) { x[j] = raw2f(xn[j]); f[j] = raw2f(fn[j]) + raw2f(gn[j]); }
        if (i + 1 < i1) PF_ISSUE(i + 1);
        const int b = i / SEQ;
        if (b != cur) { cur = b; ld_vec(MOD + ((size_t)l * 17 + b) * 6144 + 5 * 1024, F.lane, gt); }
        const float rinv = row_rinv2(f);
#pragma unroll
        for (int j = 0; j < 4; ++j) x[j] = x[j] + gt[j] * (f[j] * rinv * gpost[j]);
        st_row_f32(F.A->out + (size_t)i * DM, F.lane, x);
    }
#undef PF_ISSUE
}
__device__ __forceinline__ void p7_rows(Frame& F, int l) {
    refresh(F);
    const float* MOD = (const float*)(F.ws + WS_MOD);
    bf16* X = (bf16*)(F.ws + WS_X); const bf16* Y = (const bf16*)(F.ws + WS_Y); bf16* H2 = (bf16*)(F.ws + WS_H2);
    const bool moe = l & 1; const int li = l >> 1;
    int* TOPE = (int*)(F.ws + WS_TOPE); int* LIDX = (int*)(F.ws + WS_LIDX); float* TOPW = (float*)(F.ws + WS_TOPW); int* BLKB = (int*)(F.ws + WS_BLKB);
    volatile LAS unsigned* LCNT = F.MISC + 16;
    LAS float* RT = (LAS float*)F.lds;
    if (moe) {
        const float* router = INP(20) + (size_t)li * DM * NE;
        if (F.tid < 8) LCNT[F.tid] = 0u;
        for (int i = F.tid; i < DM * NE / 4; i += 512) { const f32x4 q = *(const f32x4*)(router + 4 * i); const int c = i >> 1, e0 = (i & 1) * 4;
            RT[(e0 + 0) * DM + c] = q[0]; RT[(e0 + 1) * DM + c] = q[1]; RT[(e0 + 2) * DM + c] = q[2]; RT[(e0 + 3) * DM + c] = q[3]; }
        __syncthreads();
    }
    const bool lastl = (l == DEPTH - 1); const int NR = lastl ? NBATCH * SEQ : M;
#define P7_ROW(i) (lastl ? ((i) / SEQ) * TPB + CTX + (i) % SEQ : (i))
    const int rpw = (NR + F.NGW - 1) / F.NGW, r0 = F.gw * rpw, r1 = (r0 + rpw < NR) ? r0 + rpw : NR;
    if (r0 < r1) {
        f32x4 gpost[4], gpre[4], gt[4], sh[4], sc[4];
        ld_vec(INP(7) + l * DM, F.lane, gpost); ld_vec(INP(8) + l * DM, F.lane, gpre);
        int cur = -1;
        u32x2 xn[4], yn[4];
        ld_raw_bf16(X + (size_t)P7_ROW(r0) * DM, F.lane, xn); ld_raw_bf16(Y + (size_t)P7_ROW(r0) * DM, F.lane, yn);
        for (int ri = r0; ri < r1; ++ri) {
            const int r = P7_ROW(ri);
            f32x4 x[4], y[4];
#pragma unroll
            for (int j = 0; j < 4; ++j) { x[j] = raw2f(xn[j]); y[j] = raw2f(yn[j]); }
            if (ri + 1 < r1) { const int rn = P7_ROW(ri + 1); ld_raw_bf16(X + (size_t)rn * DM, F.lane, xn); ld_raw_bf16(Y + (size_t)rn * DM, F.lane, yn); }
            const int b = r / TPB, p = r % TPB, mrow = p < CTX ? 16 : b;
            if (mrow != cur) { cur = mrow; const float* modp = MOD + ((size_t)l * 17 + mrow) * 6144; ld_vec(modp + 2 * 1024, F.lane, gt); ld_vec(modp + 3 * 1024, F.lane, sh); ld_vec(modp + 4 * 1024, F.lane, sc); }
            const float ry = row_rinv2(y);
#pragma unroll
            for (int j = 0; j < 4; ++j) x[j] = x[j] + gt[j] * (y[j] * ry * gpost[j]);
            st_row_bf16(X + (size_t)r * DM, F.lane, x);
            const float rx = row_rinv2(x);
            f32x4 h[4];
#pragma unroll
            for (int j = 0; j < 4; ++j) h[j] = (x[j] * rx * gpre[j]) * (sc[j] + 1.0f) + sh[j];
            if constexpr (FFN_F8) {
#pragma unroll
                for (int j = 0; j < 4; ++j) *(unsigned*)((unsigned char*)H2 + (size_t)r * DM + 4 * F.lane + 256 * j) = pk4_f8(h[j][0], h[j][1], h[j][2], h[j][3]);
            } else st_row_bf16(H2 + (size_t)r * DM, F.lane, h);
            if (moe) {
                float lg[8];
#pragma unroll
                for (int e = 0; e < 8; ++e) lg[e] = 0.f;
#pragma unroll
                for (int j = 0; j < 4; ++j)
#pragma unroll
                    for (int e = 0; e < 8; ++e) { const f32x4 q = *(const LAS f32x4*)(RT + e * DM + 4 * F.lane + 256 * j); lg[e] += (h[j][0] * q[0] + h[j][1] * q[1]) + (h[j][2] * q[2] + h[j][3] * q[3]); }
#pragma unroll
                for (int e = 0; e < 8; ++e) lg[e] = wave_sum2(lg[e]);
                int e0 = 0; float v0 = lg[0];
#pragma unroll
                for (int e = 1; e < 8; ++e) if (lg[e] > v0) { v0 = lg[e]; e0 = e; }
                int e1 = -1; float v1 = -3.0e38f;
#pragma unroll
                for (int e = 0; e < 8; ++e) if (e != e0 && lg[e] > v1) { v1 = lg[e]; e1 = e; }
                const float ex = __expf(v1 - v0), w0 = 1.f / (1.f + ex), w1 = ex / (1.f + ex);
                if (F.lane == 0) {
                    const unsigned i0 = __hip_atomic_fetch_add((LAS unsigned*)&LCNT[e0], 1u, __ATOMIC_RELAXED, __HIP_MEMORY_SCOPE_WORKGROUP), i1 = __hip_atomic_fetch_add((LAS unsigned*)&LCNT[e1], 1u, __ATOMIC_RELAXED, __HIP_MEMORY_SCOPE_WORKGROUP);
                    TOPE[r] = e0 | (e1 << 8); LIDX[2 * r] = (int)i0; LIDX[2 * r + 1] = (int)i1; TOPW[2 * r] = w0; TOPW[2 * r + 1] = w1;
                }
            }
        }
    }
    if (moe) {
        __syncthreads();
        if (F.tid < 8) { const unsigned base = __hip_atomic_fetch_add((unsigned*)((gu32*)F.ws + CW_CNT + 64 * li + F.tid), LCNT[F.tid], __ATOMIC_RELAXED, __HIP_MEMORY_SCOPE_AGENT); BLKB[F.blk * 8 + F.tid] = (int)base; }
    }
#undef P7_ROW
}
__device__ __forceinline__ void moe_offsets(Frame& F, int li, int (&cnt)[8], int (&off)[9]) {
    off[0] = 0;
#pragma unroll
    for (int e = 0; e < 8; ++e) { cnt[e] = (int)__hip_atomic_load((unsigned*)(((gu32*)F.ws) + CW_CNT + 64 * li + e), __ATOMIC_RELAXED, __HIP_MEMORY_SCOPE_AGENT); off[e + 1] = off[e] + ((cnt[e] + 255) & ~255); }
}
__device__ __forceinline__ void p7b_gather(Frame& F, int l) {
    refresh(F);
    const int li = l >> 1; int cnt[8], off[9]; moe_offsets(F, li, cnt, off);
    const bf16* H2 = (const bf16*)(F.ws + WS_H2); bf16* HG = (bf16*)(F.ws + WS_HG);
    const int* TOPE = (const int*)(F.ws + WS_TOPE); const int* LIDX = (const int*)(F.ws + WS_LIDX); const float* TOPW = (const float*)(F.ws + WS_TOPW); const int* BLKB = (const int*)(F.ws + WS_BLKB);
    int* RMAP = (int*)(F.ws + WS_RMAP); float* ROWW = (float*)(F.ws + WS_ROWW);
    constexpr int RB = FFN_F8 ? DM : 2 * DM, LB = RB / 64;
    const unsigned char* H2b = (const unsigned char*)H2; unsigned char* HGb = (unsigned char*)HG;
    const bool lastl = (l == DEPTH - 1); const int NR = lastl ? NBATCH * SEQ : M;
    const int rpw = (NR + F.NGW - 1) / F.NGW, r0 = F.gw * rpw, r1 = (r0 + rpw < NR) ? r0 + rpw : NR;
    for (int ri = r0; ri < r1; ++ri) {
        const int r = lastl ? (ri / SEQ) * TPB + CTX + ri % SEQ : ri;
        const int te = TOPE[r];
        v4u a, bq = {0u, 0u, 0u, 0u}; a = *(const v4u*)(H2b + (size_t)r * RB + F.lane * LB); if constexpr (!FFN_F8) bq = *(const v4u*)(H2b + (size_t)r * RB + F.lane * LB + 16);
#pragma unroll
        for (int s = 0; s < 2; ++s) {
            const int e = (te >> (8 * s)) & 0xff;
            int o = 0;
#pragma unroll
            for (int q = 0; q < 8; ++q) o = (q == e) ? off[q] : o;
            const int pos = o + BLKB[F.blk * 8 + e] + LIDX[2 * r + s];
            *(v4u*)(HGb + (size_t)pos * RB + F.lane * LB) = a; if constexpr (!FFN_F8) *(v4u*)(HGb + (size_t)pos * RB + F.lane * LB + 16) = bq;
            if (F.lane == 0) { RMAP[pos] = r | (s << 30); ROWW[pos] = TOPW[2 * r + s]; }
        }
    }
#pragma unroll
    for (int e = 0; e < 8; ++e) {
        const int npad = off[e + 1] - off[e] - cnt[e];
        for (int i = F.gw; i < npad; i += F.NGW) { const int pos = off[e] + cnt[e] + i; const unsigned zz = (unsigned)F.z; const v4u z = {zz, zz, zz, zz};
            *(v4u*)(HGb + (size_t)pos * RB + F.lane * LB) = z; if constexpr (!FFN_F8) *(v4u*)(HGb + (size_t)pos * RB + F.lane * LB + 16) = z;
            if (F.lane == 0) { RMAP[pos] = -1; ROWW[pos] = 0.f; } }
    }
}

__global__ void __launch_bounds__(NWAVES * 64, 2) mk_fwd(Args args) {
    extern __shared__ __attribute__((aligned(16))) unsigned char lds[];
    Frame F;
    F.lds = (LAS unsigned char*)lds;
    F.MISC = (volatile LAS unsigned*)(F.lds + MISC_OFF);
    F.tid = threadIdx.x; F.lane = F.tid & 63; F.wave = __builtin_amdgcn_readfirstlane(F.tid >> 6); F.wv = F.wave;
    F.G = gridDim.x; F.blk = blockIdx.x; F.gw = F.blk * NWAVES + F.wave; F.NGW = F.G * NWAVES;
    F.ws = args.ws;
    F.A = &args;
    for (int u = F.tid; u < 128; u += NWAVES * 64) F.MISC[u] = 0u;
    __syncthreads();
    { XcdBarrier b0 = xcd_barrier_post((unsigned*)F.ws + CW_BAR, F.MISC + 8); (void)b0; }
#define GRID_BAR() do { XcdBarrier b_; b_.bar = (unsigned*)F.ws + CW_BAR; b_.x = xb_xcc_id(); b_.st = F.MISC + 8; refresh(F); xcd_barrier(b_, F.tid == 0); } while (0)

    p0_mod(F); p0_misc(F); convert_weights(F, 0);
    GRID_BAR();
    for (int l = 0; l < DEPTH; ++l) {
        const bool moe = l & 1; const int li = l >> 1;
        { unsigned char* wsp = args.ws; asm volatile("" : "+s"(wsp)); F.ws = wsp; }
        p1_rows(F, l);
        if (l > 0) convert_weights(F, l);
        GRID_BAR();
        {
            refresh(F);
            pg8::Gemm g{(const pg8::bf16_t*)(F.ws + WS_H), (const pg8::bf16_t*)(F.ws + WS_WIN), M, NP, DM};
            pg8::StaticOrder S; S.init(M, NP, F.G, F.blk);
            pg8::EpiProj E{(pg8::bf16_t*)(F.ws + WS_PROJ), (const float*)(F.ws + WS_ROPE), (const float*)(F.ws + WS_ROPE) + 1024};
            pg8::gemm_phase<pg8::EpiProj, pg8::StaticOrder, true, true>(F.lds, g, S, E, F.wave);
        }
        GRID_BAR();
        p3_mixer(F, l);
        GRID_BAR();
        p5_merge_all(F, l);
        GRID_BAR();
        {
            refresh(F);
            pg8::Gemm g{(const pg8::bf16_t*)(F.ws + WS_H), (const pg8::bf16_t*)(F.ws + WS_WOUT), M, DM, DM};
            const int lastl = (l == DEPTH - 1);
            pg8::LatOrder S; S.S.init(lastl ? NBATCH * SEQ : M, DM, F.G, F.blk); S.lat = lastl;
            pg8::EpiF32 E{(pg8::bf16_t*)(F.ws + WS_Y)};
            pg8::gemm_phase<pg8::EpiF32, pg8::LatOrder, true, true>(F.lds, g, S, E, F.wave);
        }
        GRID_BAR();
        p7_rows(F, l);
        GRID_BAR();
        if (moe) { p7b_gather(F, l); GRID_BAR(); }
        int ntiles = M / 256;
        {
            refresh(F);
            LAS int* texp = (LAS int*)(F.lds + TEXP_OFF);
            if (moe) { int cnt[8], off[9]; moe_offsets(F, li, cnt, off); ntiles = off[8] >> 8;
                for (int t = F.tid; t < ntiles; t += 512) { int e = 0;
#pragma unroll
                    for (int q = 1; q < 8; ++q) e += ((t << 8) >= off[q]) ? 1 : 0;
                    texp[t] = e; } }
            else { for (int t = F.tid; t < ntiles; t += 512) texp[t] = 0; }
            __syncthreads();
        }
        {
            refresh(F);
            pg8::Gemm g{(const pg8::bf16_t*)(F.ws + (moe ? WS_HG : WS_H2)), (const pg8::bf16_t*)(F.ws + WS_WUP), ntiles * 256, 2 * DFF, FFN_F8 ? DM / 2 : DM};
            pg8::GroupedOrder S; S.S.init(ntiles * 256, 2 * DFF, F.G, F.blk); S.texp = (const LAS int*)(F.lds + TEXP_OFF); S.nN = 22;
            pg8::EpiSwiglu E{(pg8::bf16_t*)(F.ws + WS_U)};
            pg8::gemm_phase<pg8::EpiSwiglu, pg8::GroupedOrder, true, true, FFN_F8 != 0>(F.lds, g, S, E, F.wave);
        }
        GRID_BAR();
        {
            refresh(F);
            pg8::Gemm g{(const pg8::bf16_t*)(F.ws + WS_U), (const pg8::bf16_t*)(F.ws + WS_WDN), ntiles * 256, DM, FFN_F8 ? DFF / 2 : DFF};
            pg8::GroupedOrder S; S.S.init(ntiles * 256, DM, F.G, F.blk); S.texp = (const LAS int*)(F.lds + TEXP_OFF); S.nN = 4;
            pg8::EpiDown E{(pg8::bf16_t*)(F.ws + WS_F2), (const int*)(F.ws + WS_RMAP), (const float*)(F.ws + WS_ROWW), moe ? 0 : 1};
            pg8::gemm_phase<pg8::EpiDown, pg8::GroupedOrder, true, true, FFN_F8 != 0>(F.lds, g, S, E, F.wave);
        }
        GRID_BAR();
    }
    pf_final(F);
}

extern "C" void kernel_launch(void* const* d_in, const int* in_sizes, int n_in, void* d_out, int out_size, void* d_ws, size_t ws_size, hipStream_t stream) {
    static int grid = 0;
    if (grid == 0) {
        if (n_in != 24 || out_size != NBATCH * SEQ * DM || ws_size < WS_END) { fprintf(stderr, "kernel_launch: unexpected shapes or workspace (%d inputs, out %d, ws %zu < %zu)\n", n_in, out_size, ws_size, (size_t)WS_END); grid = -1; return; }
        int dev = 0, cus = 0, per_cu = 0;
        if (hipGetDevice(&dev) != hipSuccess || hipDeviceGetAttribute(&cus, hipDeviceAttributeMultiprocessorCount, dev) != hipSuccess) { grid = -1; return; }
        if (hipFuncSetAttribute((const void*)mk_fwd, hipFuncAttributeMaxDynamicSharedMemorySize, LDS_BYTES) != hipSuccess) { grid = -1; return; }
        if (hipOccupancyMaxActiveBlocksPerMultiprocessor(&per_cu, (const void*)mk_fwd, NWAVES * 64, LDS_BYTES) != hipSuccess || per_cu < 1) { fprintf(stderr, "kernel_launch: occupancy query says %d\n", per_cu); }
        (void)hipGetLastError();
        grid = cus;
    }
    if (grid < 0) return;
    if (hipMemsetAsync((char*)d_ws + WS_CTL, 0, CTL_ZERO_BYTES, stream) != hipSuccess) return;
    Args a{};
    for (int i = 0; i < 24; ++i) a.in[i] = (const float*)d_in[i];
    a.out = (float*)d_out; a.ws = (unsigned char*)d_ws;
    hipLaunchKernelGGL(mk_fwd, dim3(grid), dim3(NWAVES * 64), LDS_BYTES, stream, a);
}
```

```cpp
#include <hip/hip_runtime.h>
#include <cstdio>
#include <cstdint>
namespace pg8 {
#define PG8_LAS __attribute__((address_space(3)))
typedef unsigned short bf16_t;
__device__ __forceinline__ int lane_id_opaque() { int l; asm volatile("v_mbcnt_lo_u32_b32 %0, -1, 0\n\tv_mbcnt_hi_u32_b32 %0, -1, %0" : "=v"(l)); return l; }
typedef short bf16x8 __attribute__((ext_vector_type(8)));
typedef float f32x4 __attribute__((ext_vector_type(4)));
typedef unsigned u32x4 __attribute__((ext_vector_type(4)));
constexpr int BM = 256, BK = 64, HALF = 128, HTB = HALF * BK * 2  , STAGE_BYTES = 8 * HTB, NXCD = 8, WGM = 8;

__host__ __device__ __forceinline__ int lds_byte(int r, int c) { const int st = (r >> 4) * 2 + (c >> 5), rr = r & 15, cc = c & 31, ob = rr * 64 + cc * 2; return st * 1024 + (ob ^ (((ob >> 9) & 1) << 5)); }
__host__ __device__ __forceinline__ void stage_rc(int b, int& R, int& C) { const int st = b / 1024, sb = b % 1024, swz = sb ^ (((sb >> 9) & 1) << 5); R = (st >> 1) * 16 + swz / 64; C = (st & 1) * 32 + (swz % 64) / 2; }
__host__ __device__ __forceinline__ int perm32(int rho) { const int n = rho >> 4, i = rho & 15; return 8 * (i >> 2) + 4 * n + (i & 3); }

struct Unit { int pm, pn; };
struct Gemm { const bf16_t* A; const bf16_t* Bt; int M, N, K; };

struct StaticOrder {
    int nM, nN, nwg, G, c;
    __host__ __device__ void init(int M, int N, int G_, int c_) { nM = M / BM; nN = N / BM; nwg = nM * nN; G = G_; c = c_; }
    __host__ __device__ bool next(int i, Unit& u) const {
        const long L = (long)i * G + c; if (L >= nwg) return false;
        int wgid = (int)L; { const int q = nwg / NXCD, r = nwg % NXCD, xcd = wgid % NXCD, off = wgid / NXCD; wgid = (xcd < r ? xcd * (q + 1) : r * (q + 1) + (xcd - r) * q) + off; }
        const int nig = WGM * nN, gid = wgid / nig, fm = gid * WGM, gsz = (nM - fm) < WGM ? (nM - fm) : WGM;
        u.pm = fm + ((wgid % nig) % gsz); u.pn = (wgid % nig) / gsz; return true;
    }
    __device__ __forceinline__ void a_ready(const Unit&) const {}
    __device__ __forceinline__ void done(const Unit&) const {}
};

__device__ __forceinline__ unsigned cvt_pk_bf16(float lo, float hi) { unsigned r; asm volatile("v_cvt_pk_bf16_f32 %0, %1, %2" : "=v"(r) : "v"(lo), "v"(hi)); return r; }
typedef float f32x2 __attribute__((ext_vector_type(2)));
template <class Epi, class Sched, bool ALIGN_EPI = false, bool SP2 = false, bool F8 = false>
__device__ __forceinline__ void gemm_phase(PG8_LAS unsigned char* lds, const Gemm g, const Sched& S, const Epi& E, const int wv  ) {
    int tid_ = wv * 64 + lane_id_opaque();
    const int tid = tid_, wid = __builtin_amdgcn_readfirstlane(tid >> 6), lane = tid & 63, wr = wid >> 2, wc = wid & 3, fr = lane & 15, fq = lane >> 4;
    const int K = g.K, nt = K / BK;
    unsigned voffA[2], voffB[2];
#pragma unroll
    for (int i = 0; i < 2; ++i) { int R, C; stage_rc(tid * 16 + i * 8192, R, C); const int Rb = Epi::PERM ? ((R & ~31) + perm32(R & 31)) : R;
        voffA[i] = (unsigned)(R * K + C) * 2u; voffB[i] = (unsigned)(Rb * K + C) * 2u; }
    const size_t kstep = (size_t)(BK * 2);
    const size_t hstep = (size_t)HALF * K * 2;
    const size_t tstep = 2 * hstep;
    const unsigned ldsw = (unsigned)wid * 1024u;
    const int aoff = lds_byte(wr * 64 + fr, fq * 8), boff = lds_byte(wc * 32 + fr, fq * 8);
#define PG8_SA(b, h) (((b) * 2 + (h)) * HTB)
#define PG8_SB(b, h) ((4 + (b) * 2 + (h)) * HTB)
#define PG8_STAGE(bufoff, gbase, voff) do { _Pragma("unroll") for (int _i = 0; _i < 2; ++_i) \
        __builtin_amdgcn_global_load_lds((const __attribute__((address_space(1))) unsigned*)((const __attribute__((address_space(1))) char*)(gbase) + (voff)[_i]), (PG8_LAS unsigned*)(lds + (bufoff) + ldsw + _i * 8192), 16, 0, 0); } while (0)
#define PG8_LDA(dst, b, h) do { _Pragma("unroll") for (int m = 0; m < 4; ++m) _Pragma("unroll") for (int k = 0; k < 2; ++k) dst[m][k] = *(const PG8_LAS bf16x8*)(lds + PG8_SA(b, h) + aoff + m * 2048 + k * 1024); } while (0)
#define PG8_LDB(dst, b, h) do { _Pragma("unroll") for (int n = 0; n < 2; ++n) _Pragma("unroll") for (int k = 0; k < 2; ++k) dst[n][k] = *(const PG8_LAS bf16x8*)(lds + PG8_SB(b, h) + boff + n * 2048 + k * 1024); } while (0)
#define PG8_MMA(ai, bj, At, Bt) do { if constexpr (F8) __builtin_amdgcn_sched_barrier(0); __builtin_amdgcn_s_setprio(1); _Pragma("unroll") for (int m = 0; m < 4; ++m) _Pragma("unroll") for (int n = 0; n < 2; ++n) { \
        if constexpr (F8) { typedef int i32x4_ __attribute__((ext_vector_type(4))); \
            acc[ai][bj][m][n] = __builtin_amdgcn_mfma_scale_f32_16x16x128_f8f6f4(__builtin_shufflevector(__builtin_bit_cast(i32x4_, Bt[n][0]), __builtin_bit_cast(i32x4_, Bt[n][1]), 0, 1, 2, 3, 4, 5, 6, 7), \
                __builtin_shufflevector(__builtin_bit_cast(i32x4_, At[m][0]), __builtin_bit_cast(i32x4_, At[m][1]), 0, 1, 2, 3, 4, 5, 6, 7), acc[ai][bj][m][n], 0, 0, 0, 0x7f7f7f7f, 0, 0x7f7f7f7f); } \
        else { _Pragma("unroll") for (int k = 0; k < 2; ++k) acc[ai][bj][m][n] = __builtin_amdgcn_mfma_f32_16x16x32_bf16(Bt[n][k], At[m][k], acc[ai][bj][m][n], 0, 0, 0); } } \
        __builtin_amdgcn_s_setprio(0); if constexpr (F8) __builtin_amdgcn_sched_barrier(0); } while (0)
#define PG8_WAIT_V(n) asm volatile("s_waitcnt vmcnt(" #n ")" ::: "memory")
#define PG8_WAIT_L(n) asm volatile("s_waitcnt lgkmcnt(" #n ")" ::: "memory")
#define PG8_BAR __builtin_amdgcn_s_barrier()
#define PG8_SCHED __builtin_amdgcn_sched_barrier(0)
    Unit cur, nxt; int ui = 0;
    if (!S.next(0, cur)) return;
    f32x4 acc[2][2][4][2];
#pragma unroll
    for (int a = 0; a < 2; ++a)
#pragma unroll
        for (int b = 0; b < 2; ++b)
#pragma unroll
            for (int m = 0; m < 4; ++m)
#pragma unroll
                for (int n = 0; n < 2; ++n) acc[a][b][m][n] = (f32x4){0.f, 0.f, 0.f, 0.f};
    bf16x8 At[4][2], B0[2][2], B1[2][2];
    const char* cA = (const char*)g.A + (size_t)cur.pm * tstep; const char* cB = (const char*)g.Bt + (size_t)cur.pn * tstep;
    S.a_ready(cur);
    if constexpr (SP2) {
        PG8_STAGE(PG8_SB(0, 0), cB, voffB); PG8_STAGE(PG8_SB(0, 1), cB + hstep, voffB); PG8_STAGE(PG8_SA(0, 0), cA, voffA); PG8_STAGE(PG8_SA(0, 1), cA + hstep, voffA);
        if (wr == 1) PG8_BAR;
        PG8_WAIT_V(2); PG8_BAR;
        PG8_STAGE(PG8_SB(1, 0), cB + kstep, voffB); PG8_STAGE(PG8_SA(1, 0), cA + kstep, voffA); PG8_STAGE(PG8_SB(1, 1), cB + hstep + kstep, voffB);
        PG8_WAIT_V(6); PG8_BAR;
    } else {
        PG8_STAGE(PG8_SB(0, 0), cB, voffB); PG8_STAGE(PG8_SA(0, 0), cA, voffA); PG8_STAGE(PG8_SB(0, 1), cB + hstep, voffB); PG8_STAGE(PG8_SA(0, 1), cA + hstep, voffA);
        if (wr == 1) PG8_BAR;
        PG8_WAIT_V(4); PG8_BAR;
        PG8_STAGE(PG8_SB(1, 0), cB + kstep, voffB); PG8_STAGE(PG8_SA(1, 0), cA + kstep, voffA); PG8_STAGE(PG8_SB(1, 1), cB + hstep + kstep, voffB);
        PG8_WAIT_V(6); PG8_BAR;
    }
    for (;;) {
        const bool has_next = S.next(ui + 1, nxt);
        const char* nA = has_next ? (const char*)g.A + (size_t)nxt.pm * tstep : cA; const char* nB = has_next ? (const char*)g.Bt + (size_t)nxt.pn * tstep : cB;
        for (int t = 0; t < nt; t += 2) {
            const bool last = (t == nt - 2);
            const char* a1 = cA + (size_t)(t + 1) * kstep;
            const char* a2 = last ? nA : cA + (size_t)(t + 2) * kstep; const char* b2 = last ? nB : cB + (size_t)(t + 2) * kstep;
            const char* a3 = a2 + kstep; const char* b3 = b2 + kstep;
            if (last && has_next) S.a_ready(nxt);
            if constexpr (SP2) {
            PG8_LDB(B0, 0, 0); PG8_LDB(B1, 0, 1); PG8_SCHED; PG8_LDA(At, 0, 0); PG8_STAGE(PG8_SA(1, 1), a1 + hstep, voffA);
            PG8_WAIT_V(8); PG8_WAIT_L(0); PG8_BAR; PG8_MMA(0, 0, At, B0); PG8_MMA(0, 1, At, B1); PG8_BAR; PG8_SCHED;
            PG8_LDA(At, 0, 1); PG8_STAGE(PG8_SB(0, 0), b2, voffB); PG8_STAGE(PG8_SB(0, 1), b2 + hstep, voffB); PG8_STAGE(PG8_SA(0, 0), a2, voffA);
            PG8_WAIT_V(8); PG8_WAIT_L(0); PG8_BAR; PG8_MMA(1, 0, At, B0); PG8_MMA(1, 1, At, B1); PG8_BAR; PG8_SCHED;
            PG8_LDB(B0, 1, 0); PG8_LDB(B1, 1, 1); PG8_SCHED; PG8_LDA(At, 1, 0); PG8_STAGE(PG8_SA(0, 1), a2 + hstep, voffA);
            PG8_WAIT_V(8); PG8_WAIT_L(0); PG8_BAR; PG8_MMA(0, 0, At, B0); PG8_MMA(0, 1, At, B1); PG8_BAR; PG8_SCHED;
            PG8_LDA(At, 1, 1); PG8_STAGE(PG8_SB(1, 0), b3, voffB); PG8_STAGE(PG8_SB(1, 1), b3 + hstep, voffB); PG8_STAGE(PG8_SA(1, 0), a3, voffA);
            PG8_WAIT_V(8); PG8_WAIT_L(0); PG8_BAR; PG8_MMA(1, 0, At, B0); PG8_MMA(1, 1, At, B1); PG8_BAR; PG8_SCHED;
            } else {
            PG8_LDB(B0, 0, 0); PG8_SCHED; PG8_LDA(At, 0, 0); PG8_STAGE(PG8_SA(1, 1), a1 + hstep, voffA);
            PG8_WAIT_L(8); PG8_BAR; PG8_WAIT_L(0); PG8_MMA(0, 0, At, B0); PG8_BAR; PG8_SCHED;
            PG8_LDB(B1, 0, 1); PG8_STAGE(PG8_SB(0, 0), b2, voffB);
            PG8_BAR; PG8_WAIT_L(0); PG8_MMA(0, 1, At, B1); PG8_BAR;
            PG8_LDA(At, 0, 1); PG8_STAGE(PG8_SA(0, 0), a2, voffA);
            PG8_BAR; PG8_WAIT_L(0); PG8_MMA(1, 0, At, B0); PG8_BAR; PG8_SCHED;
            PG8_STAGE(PG8_SB(0, 1), b2 + hstep, voffB);
            PG8_WAIT_V(6); PG8_BAR; PG8_MMA(1, 1, At, B1); PG8_BAR;
            PG8_LDB(B0, 1, 0); PG8_SCHED; PG8_LDA(At, 1, 0); PG8_STAGE(PG8_SA(0, 1), a2 + hstep, voffA);
            PG8_WAIT_L(8); PG8_BAR; PG8_WAIT_L(0); PG8_MMA(0, 0, At, B0); PG8_BAR; PG8_SCHED;
            PG8_LDB(B1, 1, 1); PG8_STAGE(PG8_SB(1, 0), b3, voffB);
            PG8_BAR; PG8_WAIT_L(0); PG8_MMA(0, 1, At, B1); PG8_BAR;
            PG8_LDA(At, 1, 1); PG8_STAGE(PG8_SA(1, 0), a3, voffA);
            PG8_BAR; PG8_WAIT_L(0); PG8_MMA(1, 0, At, B0); PG8_BAR; PG8_SCHED;
            PG8_STAGE(PG8_SB(1, 1), b3 + hstep, voffB);
            PG8_WAIT_V(6); PG8_BAR; PG8_MMA(1, 1, At, B1); PG8_BAR;
            }
        }
        if constexpr (ALIGN_EPI) { if (wr == 0) PG8_BAR; }
        if constexpr (!Epi::AFTER_DRAIN) { const int t2_ = lane_id_opaque(); const int fr_ = t2_ & 15, fq_ = (t2_ & 63) >> 4;
            E(acc, cur, wr, wc, fr_, fq_); S.done(cur); }
        if (!has_next) break;
#pragma unroll
        for (int a = 0; a < 2; ++a)
#pragma unroll
            for (int b = 0; b < 2; ++b)
#pragma unroll
                for (int m = 0; m < 4; ++m)
#pragma unroll
                    for (int n = 0; n < 2; ++n) acc[a][b][m][n] = (f32x4){0.f, 0.f, 0.f, 0.f};
        cur = nxt; cA = nA; cB = nB; ++ui;
        if constexpr (ALIGN_EPI) { if (wr == 1) PG8_BAR; }
    }
    PG8_WAIT_V(0);
    if constexpr (!ALIGN_EPI) { if (wr == 0) PG8_BAR; }
    PG8_BAR;
    if constexpr (Epi::AFTER_DRAIN) { E.fused(acc, cur, wr, wc, fr, fq, lds, wid, lane); S.done(cur); }
#undef PG8_SA
#undef PG8_SB
#undef PG8_STAGE
#undef PG8_LDA
#undef PG8_LDB
#undef PG8_MMA
#undef PG8_WAIT_V
#undef PG8_WAIT_L
#undef PG8_BAR
#undef PG8_SCHED
}
}
#define GAS __attribute__((address_space(1)))
#define LAS __attribute__((address_space(3)))
typedef unsigned short bf16;
typedef unsigned v4u __attribute__((ext_vector_type(4)));
typedef float f32x4 __attribute__((ext_vector_type(4)));
typedef short bf16x8 __attribute__((ext_vector_type(8)));
typedef GAS unsigned gu32;
typedef GAS unsigned long long gu64;
#define RLX_AGENT __ATOMIC_RELAXED, __HIP_MEMORY_SCOPE_AGENT
#define LDS_WAIT() asm volatile("s_waitcnt lgkmcnt(0)" ::: "memory")
#define VM_WAIT() asm volatile("s_waitcnt vmcnt(0)" ::: "memory")
__device__ __forceinline__ unsigned long long rt() { return __builtin_amdgcn_s_memrealtime(); }
__device__ __forceinline__ unsigned f2bf(float f) { unsigned u = __builtin_bit_cast(unsigned, f); return (u + 0x7fffu + ((u >> 16) & 1u)) >> 16; }
__device__ __forceinline__ unsigned pk2(float lo, float hi) { return f2bf(lo) | (f2bf(hi) << 16); }

#define XB_TMO      128
#define XB_XCNT(j)  (256  + 64 * (j))
#define XB_XSUB(j)  (1280 + 64 * (j))
#define XB_XGEN(j)  (2304 + 64 * (j))
#define XB_TOP      3328
#define XB_TOPGEN   3392
#define XCD_BAR_WORDS 3456
#define XB_SPIN_CAP (1u << 18)

__device__ __forceinline__ unsigned xb_ld(unsigned* p)              { return __hip_atomic_load(p, __ATOMIC_RELAXED, __HIP_MEMORY_SCOPE_AGENT); }
__device__ __forceinline__ unsigned xb_add(unsigned* p, unsigned v) { return __hip_atomic_fetch_add(p, v, __ATOMIC_RELAXED, __HIP_MEMORY_SCOPE_AGENT); }
__device__ __forceinline__ unsigned xb_xcc_id() { return (unsigned)__builtin_amdgcn_s_getreg((3 << 11) | 20) & 0xFu; }
#define XB_SPIN(cond, bar) do { unsigned _sp = 0; while (cond) { __builtin_amdgcn_s_sleep(1); \
    if ((++_sp & 255u) == 0u) { if (xb_ld(&(bar)[XB_TMO])) break; if (_sp > XB_SPIN_CAP) { atomicAdd(&(bar)[XB_TMO], 1u); break; } } } } while (0)

struct XcdBarrier {
    unsigned* bar; unsigned x;
    volatile LAS unsigned* st;
};

__device__ __forceinline__ XcdBarrier xcd_barrier_post(unsigned* bar, volatile LAS unsigned* st) {
    XcdBarrier b; b.bar = bar; b.x = xb_xcc_id(); b.st = st;
    if (threadIdx.x == 0) (void)xb_add(&bar[XB_XCNT(b.x)], 1u);
    return b;
}
__device__ __forceinline__ void xcd_barrier_complete(unsigned* bar, unsigned x, unsigned& nloc, unsigned& nx) {
    const unsigned G = gridDim.x * gridDim.y * gridDim.z;
    unsigned sum, cnt, mine, sp = 0u;
    for (;;) {
        sum = 0u; cnt = 0u; mine = 0u;
#pragma unroll
        for (unsigned j = 0; j < 16; ++j) { const unsigned c = xb_ld(&bar[XB_XCNT(j)]); sum += c; cnt += (c > 0u) ? 1u : 0u; mine = (j == x) ? c : mine; }
        if (sum == G) break;
        __builtin_amdgcn_s_sleep(1);
        if ((++sp & 255u) == 0u) { if (xb_ld(&bar[XB_TMO])) break; if (sp > XB_SPIN_CAP) { atomicAdd(&bar[XB_TMO], 1u); break; } }
    }
    nloc = mine > 0u ? mine : 1u; nx = cnt > 0u ? cnt : 1u;
}

__device__ __forceinline__ void xcd_barrier(const XcdBarrier& b, const bool leader  ) {
    asm volatile("s_waitcnt vmcnt(0)" ::: "memory");
    __syncthreads();
    if (leader) {
        unsigned* bar = b.bar; asm volatile("" : "+s"(bar));
        __builtin_amdgcn_s_waitcnt(0);
        unsigned nloc = b.st[0], nx = b.st[1];
        if (nloc == 0u) { xcd_barrier_complete(bar, b.x, nloc, nx); b.st[0] = nloc; b.st[1] = nx; }
        const unsigned old = xb_add(&bar[XB_XSUB(b.x)], 1u);
        const unsigned gen = old / nloc;
        if (old + 1u == (gen + 1u) * nloc) {
            __builtin_amdgcn_fence(__ATOMIC_RELEASE, "agent");
            asm volatile("s_waitcnt vmcnt(0)" ::: "memory");
            const unsigned og = xb_add(&bar[XB_TOP], 1u);
            const unsigned tg = og / nx;
            if (og + 1u == (tg + 1u) * nx) xb_add(&bar[XB_TOPGEN], 1u);
            else XB_SPIN(xb_ld(&bar[XB_TOPGEN]) == tg, bar);
            __builtin_amdgcn_fence(__ATOMIC_ACQUIRE, "agent");
            xb_add(&bar[XB_XGEN(b.x)], 1u);
            asm volatile("s_waitcnt vmcnt(0)" ::: "memory");
        } else {
            XB_SPIN(xb_ld(&bar[XB_XGEN(b.x)]) == gen, bar);
            __builtin_amdgcn_fence(__ATOMIC_ACQUIRE, "agent");
            asm volatile("s_waitcnt vmcnt(0)" ::: "memory");
        }
    }
    __syncthreads();
}

#ifndef FFN_F8
#define FFN_F8 1
#endif
constexpr int NWAVES = 8;
constexpr float W8S = 32.f, U8S = 4.f;
constexpr int DM = 1024, NBATCH = 16, SEQ = 2048, CTX = 256, TPB = SEQ + CTX, M = NBATCH * TPB;
constexpr int DEPTH = 4, NIN = 3104, NP = 3328, DFF = 2816, NE = 8;
constexpr int MP = 2 * M + NE * 256;
constexpr int C_Q = 0, C_K = 512, C_V = 1024, C_GQ = 1536, C_GK = 1792, C_GV = 2048, C_GG = 2560, C_GLR = 3072;
constexpr float EPS = 1e-6f;
constexpr float C2 = 0.125f * 1.4426950408889634f;
constexpr int NCH = TPB / 64;
constexpr int NGLA = NBATCH * 4 * 2 * NCH;

constexpr size_t MiB = 1u << 20;
constexpr size_t WS_CTL = 0, CTL_ZERO_BYTES = 1 * MiB;
constexpr size_t WS_MOD = 1 * MiB;
constexpr size_t WS_ROPE = 3 * MiB;
constexpr size_t WS_TOPE = 4 * MiB;
constexpr size_t WS_LIDX = WS_TOPE + 160 * 1024;
constexpr size_t WS_TOPW = WS_LIDX + 320 * 1024;
constexpr size_t WS_BLKB = WS_TOPW + 320 * 1024;
constexpr size_t WS_RMAP = WS_BLKB + 64 * 1024;
constexpr size_t WS_ROWW = WS_RMAP + 320 * 1024;
static_assert(WS_ROWW + 320 * 1024 <= 6 * MiB, "small tables");
constexpr size_t WS_X = 6 * MiB;
constexpr size_t WS_WIN = 150 * MiB;
constexpr size_t WS_WOUT = WS_WIN + 13 * MiB / 2;
constexpr size_t WS_WUP = WS_WOUT + 2 * MiB;
constexpr size_t WS_WDN = WS_WUP + 88 * MiB;
constexpr size_t WS_D = 291 * MiB;
static_assert(WS_WDN + 44 * MiB <= WS_D, "weights");
constexpr size_t WS_PROJ = WS_D;
constexpr size_t WS_OD = WS_D + 234 * MiB;
constexpr size_t WS_DS = WS_D + 306 * MiB;
constexpr size_t WS_DEC = WS_D + 450 * MiB;
constexpr size_t WS_H = WS_D + 452 * MiB;
constexpr size_t WS_Y = WS_D;
constexpr size_t WS_HG = WS_D;
constexpr size_t WS_F2 = WS_D;
constexpr size_t WS_U = WS_D + 148 * MiB;
constexpr size_t WS_H2 = WS_D + 483 * MiB;
constexpr size_t WS_END = WS_D + 555 * MiB;
static_assert((size_t)MP * DFF * 2 <= 407 * MiB && (size_t)MP * DM * 2 <= 148 * MiB && (size_t)M * NP * 2 <= 234 * MiB, "dynamic map");
static_assert((size_t)M * DFF * 2 + 148 * MiB <= 483 * MiB, "dense U clear of H2");

constexpr int CW_BAR = 4096;
constexpr int CW_CNT = 8192;

constexpr int RING_BYTES = 131072;
constexpr int TEXP_OFF = 139264;
constexpr int MISC_OFF = 146432 - 512;
constexpr int LDS_BYTES = 147456;

typedef unsigned u32x2 __attribute__((ext_vector_type(2)));

__device__ __forceinline__ float bf2f(unsigned short x) { return __uint_as_float((unsigned)x << 16); }
__device__ __forceinline__ float bflo(unsigned w) { return __uint_as_float(w << 16); }
__device__ __forceinline__ float bfhi(unsigned w) { return __uint_as_float(w & 0xffff0000u); }
__device__ __forceinline__ float siluf(float x) { return x * __builtin_amdgcn_rcpf(1.f + __expf(-x)); }
__device__ __forceinline__ float clamp8(float x) { return fminf(fmaxf(x, -448.f), 448.f); }
__device__ __forceinline__ unsigned pk4_f8(float a, float b, float c, float d) { unsigned w = 0u; w = __builtin_amdgcn_cvt_pk_fp8_f32(clamp8(a), clamp8(b), w, false); w = __builtin_amdgcn_cvt_pk_fp8_f32(clamp8(c), clamp8(d), w, true); return w; }
template <int MASK> __device__ __forceinline__ float xadd(float v) {
    if constexpr (MASK == 32) { const auto rr = __builtin_amdgcn_permlane32_swap(__float_as_uint(v), __float_as_uint(v), false, false); return __uint_as_float(rr[0]) + __uint_as_float(rr[1]); }
    else return v + __int_as_float(__builtin_amdgcn_ds_swizzle(__float_as_int(v), 0x1f | (MASK << 10)));
}
__device__ __forceinline__ float wave_sum(float v) {
    v = xadd<1>(v); v = xadd<2>(v); v = xadd<4>(v); v = xadd<8>(v); v = xadd<16>(v); v = xadd<32>(v);
    return v;
}

struct Args { const float* in[24]; float* out; unsigned char* ws; };
struct Frame {
    LAS unsigned char* lds;
    volatile LAS unsigned* MISC;
    int tid, lane, wave, G, blk, gw, NGW, z, wv;
    const Args* A;
    unsigned char* ws;
};


__device__ __forceinline__ void refresh(Frame& F) {
    int wv = F.wv; asm volatile("" : "+s"(wv));
    const int t = wv * 64 + pg8::lane_id_opaque();
    int bl = blockIdx.x, z = 0, gg = gridDim.x; asm volatile("" : "+s"(bl), "+s"(z), "+s"(gg));
    F.blk = bl; F.z = z; F.G = gg; F.NGW = gg * NWAVES;
    F.tid = t; F.lane = t & 63; F.wave = wv; F.gw = F.blk * NWAVES + F.wave;
}
#define INP(k) (F.A->in[(k) + F.z])
namespace pg8 {
struct EpiProj {
    static constexpr bool PERM = true, AFTER_DRAIN = false;
    bf16_t* P; const float* ropec; const float* ropes;
    __device__ __forceinline__ void operator()(const f32x4 (&acc)[2][2][4][2], const Unit& u, int wr, int wc, int fr, int fq) const {
        const int pn = u.pn, pm = u.pm, tb = pm % 9;
        const bool do_rope = (tb != 0) && (pn < 4);
        const float sc = (pn < 2) ? C2 : (pn == 6 ? 0.125f : 1.f);
        const bool st_ok_all = pn < 12;
#pragma unroll
        for (int ai = 0; ai < 2; ++ai)
#pragma unroll
            for (int m = 0; m < 4; ++m) {
                const int rit = ai * HALF + wr * 64 + m * 16 + fr;
                bf16_t* rowp = P + ((size_t)pm * BM + rit) * NP + pn * BM + wc * 32 + 8 * fq;
                const int s = (tb - 1) * 256 + rit;
                const int pos = (wc & 1) ? (s & 63) : (s >> 6);
                f32x4 cs = {1.f, 1.f, 1.f, 1.f}, sn = {0.f, 0.f, 0.f, 0.f};
                if (do_rope) { cs = *(const f32x4*)(ropec + pos * 16 + 4 * fq); sn = *(const f32x4*)(ropes + pos * 16 + 4 * fq); }
#pragma unroll
                for (int bj = 0; bj < 2; ++bj) {
                    f32x4 v0 = acc[ai][bj][m][0], v1 = acc[ai][bj][m][1];
                    if (do_rope) { const f32x4 a = v0 * cs - v1 * sn, b = v0 * sn + v1 * cs; v0 = a; v1 = b; }
                    v0 = v0 * sc; v1 = v1 * sc;
                    if (st_ok_all || (bj == 0 && wc == 0)) {
                        u32x4 w; w.x = cvt_pk_bf16(v0[0], v0[1]); w.y = cvt_pk_bf16(v0[2], v0[3]); w.z = cvt_pk_bf16(v1[0], v1[1]); w.w = cvt_pk_bf16(v1[2], v1[3]);
                        *(u32x4*)(rowp + bj * HALF) = w;
                    }
                }
            }
    }
};
struct EpiF32 {
    static constexpr bool PERM = true, AFTER_DRAIN = false;
    bf16_t* Y;
    __device__ __forceinline__ void operator()(const f32x4 (&acc)[2][2][4][2], const Unit& u, int wr, int wc, int fr, int fq) const {
#pragma unroll
        for (int ai = 0; ai < 2; ++ai)
#pragma unroll
            for (int m = 0; m < 4; ++m) {
                bf16_t* rowp = Y + ((size_t)u.pm * BM + ai * HALF + wr * 64 + m * 16 + fr) * DM + u.pn * BM + wc * 32 + 8 * fq;
#pragma unroll
                for (int bj = 0; bj < 2; ++bj) { const f32x4 v0 = acc[ai][bj][m][0], v1 = acc[ai][bj][m][1];
                    u32x4 w; w.x = cvt_pk_bf16(v0[0], v0[1]); w.y = cvt_pk_bf16(v0[2], v0[3]); w.z = cvt_pk_bf16(v1[0], v1[1]); w.w = cvt_pk_bf16(v1[2], v1[3]);
                    *(u32x4*)(rowp + bj * HALF) = w; }
            }
    }
};
struct EpiSwiglu {
    static constexpr bool PERM = true, AFTER_DRAIN = false;
    bf16_t* U;
    __device__ __forceinline__ void operator()(const f32x4 (&acc)[2][2][4][2], const Unit& u, int wr, int wc, int fr, int fq) const {
        const int pnl = u.pn % 22;
        const int col0 = pnl * 128 + wc * 32 + 8 * fq;
        constexpr float ws = FFN_F8 ? 1.f / W8S : 1.f, us = FFN_F8 ? U8S : 1.f, kS = ws * ws * us, kE = -ws * 1.4426950408889634f;
        const float cE = -__builtin_log2f(kS), c1 = 1.f / kS;
#pragma unroll
        for (int ai = 0; ai < 2; ++ai)
#pragma unroll
            for (int m = 0; m < 4; ++m) {
                const size_t rowi = (size_t)u.pm * BM + ai * HALF + wr * 64 + m * 16 + fr;
                f32x2 g[4], up[4], t[4], r[4];
#pragma unroll
                for (int n = 0; n < 2; ++n) { g[2 * n] = (f32x2){acc[ai][0][m][n][0], acc[ai][0][m][n][1]}; g[2 * n + 1] = (f32x2){acc[ai][0][m][n][2], acc[ai][0][m][n][3]};
                                              up[2 * n] = (f32x2){acc[ai][1][m][n][0], acc[ai][1][m][n][1]}; up[2 * n + 1] = (f32x2){acc[ai][1][m][n][2], acc[ai][1][m][n][3]}; }
#pragma unroll
                for (int q = 0; q < 4; ++q) t[q] = g[q] * kE + cE;
#pragma unroll
                for (int q = 0; q < 4; ++q) { t[q].x = __builtin_amdgcn_exp2f(t[q].x); t[q].y = __builtin_amdgcn_exp2f(t[q].y); }
#pragma unroll
                for (int q = 0; q < 4; ++q) t[q] = t[q] + c1;
#pragma unroll
                for (int q = 0; q < 4; ++q) { r[q].x = __builtin_amdgcn_rcpf(t[q].x); r[q].y = __builtin_amdgcn_rcpf(t[q].y); }
#pragma unroll
                for (int q = 0; q < 4; ++q) g[q] = (g[q] * up[q]) * r[q];
                if constexpr (FFN_F8) { u32x2 w; w.x = pk4_f8(g[0].x, g[0].y, g[1].x, g[1].y); w.y = pk4_f8(g[2].x, g[2].y, g[3].x, g[3].y); *(u32x2*)((unsigned char*)U + rowi * DFF + col0) = w; }
                else { u32x4 w; w.x = cvt_pk_bf16(g[0].x, g[0].y); w.y = cvt_pk_bf16(g[1].x, g[1].y); w.z = cvt_pk_bf16(g[2].x, g[2].y); w.w = cvt_pk_bf16(g[3].x, g[3].y); *(u32x4*)(U + rowi * DFF + col0) = w; }
            }
    }
};
struct EpiDown {
    static constexpr bool PERM = true, AFTER_DRAIN = false;
    bf16_t* F2; const int* rmap; const float* roww; int dense;
    __device__ __forceinline__ void operator()(const f32x4 (&acc)[2][2][4][2], const Unit& u, int wr, int wc, int fr, int fq) const {
        const int pnl = u.pn & 3;
        const int col0 = pnl * BM + wc * 32 + 8 * fq;
#pragma unroll
        for (int ai = 0; ai < 2; ++ai)
#pragma unroll
            for (int m = 0; m < 4; ++m) {
                const int grow = u.pm * BM + ai * HALF + wr * 64 + m * 16 + fr;
                int tok = grow, slot = 0; float w = 1.f; bool ok = true;
                if (!dense) { const int rm = rmap[grow]; ok = rm >= 0; tok = rm & 0x3fffffff; slot = (rm >> 30) & 1; w = roww[grow]; }
                if constexpr (FFN_F8) w *= 1.f / (W8S * U8S);
                if (ok) {
                    bf16_t* rowp = F2 + ((size_t)slot * M + tok) * DM + col0;
#pragma unroll
                    for (int bj = 0; bj < 2; ++bj) {
                        const f32x4 v0 = acc[ai][bj][m][0] * w, v1 = acc[ai][bj][m][1] * w;
                        u32x4 q; q.x = cvt_pk_bf16(v0[0], v0[1]); q.y = cvt_pk_bf16(v0[2], v0[3]); q.z = cvt_pk_bf16(v1[0], v1[1]); q.w = cvt_pk_bf16(v1[2], v1[3]);
                        *(u32x4*)(rowp + bj * HALF) = q;
                    }
                }
            }
    }
};
struct GroupedOrder {
    StaticOrder S; const PG8_LAS int* texp; int nN;
    __device__ __forceinline__ bool next(int i, Unit& u) const { if (!S.next(i, u)) return false; u.pn += __builtin_amdgcn_readfirstlane(texp[u.pm]) * nN; return true; }
    __device__ __forceinline__ void a_ready(const Unit&) const {}
    __device__ __forceinline__ void done(const Unit&) const {}
};
struct LatOrder {
    StaticOrder S; int lat;
    __device__ __forceinline__ bool next(int i, Unit& u) const { if (!S.next(i, u)) return false; if (lat) u.pm += (u.pm >> 3) + 1; return true; }
    __device__ __forceinline__ void a_ready(const Unit&) const {}
    __device__ __forceinline__ void done(const Unit&) const {}
};
}

__device__ __forceinline__ void ld_row_f32(const float* row, int lane, f32x4 (&v)[4]) {
#pragma unroll
    for (int j = 0; j < 4; ++j) v[j] = *(const f32x4*)(row + 4 * lane + 256 * j);
}
__device__ __forceinline__ void st_row_f32(float* row, int lane, const f32x4 (&v)[4]) {
#pragma unroll
    for (int j = 0; j < 4; ++j) *(f32x4*)(row + 4 * lane + 256 * j) = v[j];
}
__device__ __forceinline__ void ld_row_bf16(const bf16* row, int lane, f32x4 (&v)[4]) {
#pragma unroll
    for (int j = 0; j < 4; ++j) { const u32x2 w = *(const u32x2*)(row + 4 * lane + 256 * j); v[j] = (f32x4){bflo(w.x), bfhi(w.x), bflo(w.y), bfhi(w.y)}; }
}
__device__ __forceinline__ void st_row_bf16(bf16* row, int lane, const f32x4 (&v)[4]) {
#pragma unroll
    for (int j = 0; j < 4; ++j) { u32x2 w; w.x = pg8::cvt_pk_bf16(v[j][0], v[j][1]); w.y = pg8::cvt_pk_bf16(v[j][2], v[j][3]); *(u32x2*)(row + 4 * lane + 256 * j) = w; }
}
__device__ __forceinline__ float row_rinv(const f32x4 (&v)[4]) {
    float s = 0.f;
#pragma unroll
    for (int j = 0; j < 4; ++j) s += (v[j][0] * v[j][0] + v[j][1] * v[j][1]) + (v[j][2] * v[j][2] + v[j][3] * v[j][3]);
    return 1.0f / sqrtf(wave_sum(s) * (1.f / DM) + EPS);
}

__device__ __forceinline__ void transpose_tile(const float* W, int N, int k0, int n0, bf16* WT, int K, int drow0, LAS float* scr, int lane, bool ropeperm = false) {
#pragma unroll 8
    for (int i = 0; i < 32; ++i) { const int kk = 2 * i + (lane >> 5); scr[kk * 33 + (lane & 31)] = __builtin_nontemporal_load(&W[(size_t)(k0 + kk) * N + n0 + (lane & 31)]); }
    LDS_WAIT(); asm volatile("" ::: "memory");
    const int c = lane & 7;
#pragma unroll
    for (int j = 0; j < 4; ++j) { const int n = (lane >> 3) + 8 * j; const LAS float* s = scr + (8 * c) * 33 + n;
        v4u o; o.x = pk2(s[0 * 33], s[1 * 33]); o.y = pk2(s[2 * 33], s[3 * 33]); o.z = pk2(s[4 * 33], s[5 * 33]); o.w = pk2(s[6 * 33], s[7 * 33]);
        const int nd = ropeperm ? (8 * ((n >> 2) & 3) + 4 * (n >> 4) + (n & 3)) : n;
        *(GAS v4u*)(WT + (size_t)(drow0 + nd) * K + k0 + 8 * c) = o; }
    LDS_WAIT(); asm volatile("" ::: "memory");
}
__device__ __forceinline__ void transpose_tile_f8(const float* W, int N, int k0, int n0, unsigned char* WT, int Kb, int drow0, LAS float* scr, int lane, float scale) {
#pragma unroll 8
    for (int i = 0; i < 32; ++i) { const int kk = 2 * i + (lane >> 5); scr[kk * 33 + (lane & 31)] = __builtin_nontemporal_load(&W[(size_t)(k0 + kk) * N + n0 + (lane & 31)]); }
    LDS_WAIT(); asm volatile("" ::: "memory");
    const int n = lane >> 1, hf = lane & 1; const LAS float* s = scr + (hf * 32) * 33 + n;
    v4u o0, o1;
    o0.x = pk4_f8(s[0 * 33] * scale, s[1 * 33] * scale, s[2 * 33] * scale, s[3 * 33] * scale);     o0.y = pk4_f8(s[4 * 33] * scale, s[5 * 33] * scale, s[6 * 33] * scale, s[7 * 33] * scale);
    o0.z = pk4_f8(s[8 * 33] * scale, s[9 * 33] * scale, s[10 * 33] * scale, s[11 * 33] * scale);   o0.w = pk4_f8(s[12 * 33] * scale, s[13 * 33] * scale, s[14 * 33] * scale, s[15 * 33] * scale);
    o1.x = pk4_f8(s[16 * 33] * scale, s[17 * 33] * scale, s[18 * 33] * scale, s[19 * 33] * scale); o1.y = pk4_f8(s[20 * 33] * scale, s[21 * 33] * scale, s[22 * 33] * scale, s[23 * 33] * scale);
    o1.z = pk4_f8(s[24 * 33] * scale, s[25 * 33] * scale, s[26 * 33] * scale, s[27 * 33] * scale); o1.w = pk4_f8(s[28 * 33] * scale, s[29 * 33] * scale, s[30 * 33] * scale, s[31 * 33] * scale);
    GAS v4u* dst = (GAS v4u*)(WT + (size_t)(drow0 + n) * Kb + k0 + hf * 32);
    dst[0] = o0; dst[1] = o1;
    LDS_WAIT(); asm volatile("" ::: "memory");
}
__device__ __forceinline__ void convert_weights(Frame& F, int l) {
    refresh(F);
    const bool moe = l & 1; const int ne = moe ? NE : 1, li = l >> 1;
    const float* w1 = moe ? INP(21) + (size_t)li * NE * DM * DFF : INP(17) + (size_t)li * DM * DFF;
    const float* w3 = moe ? INP(22) + (size_t)li * NE * DM * DFF : INP(18) + (size_t)li * DM * DFF;
    const float* w2 = moe ? INP(23) + (size_t)li * NE * DM * DFF : INP(19) + (size_t)li * DM * DFF;
    const float* win = INP(10) + (size_t)l * DM * NIN;
    const float* wout = INP(16) + (size_t)l * DM * DM;
    bf16* WIN = (bf16*)(F.ws + WS_WIN); bf16* WOUT = (bf16*)(F.ws + WS_WOUT); bf16* WUP = (bf16*)(F.ws + WS_WUP); bf16* WDN = (bf16*)(F.ws + WS_WDN);
    LAS float* scr = (LAS float*)(F.lds + F.wave * 16384);
    const int nA = 16 * 97, nZ = NP - NIN, nB = 16 * 32, nC1 = 16 * 88, nD1 = 44 * 32;
    const int nC = ne * 2 * nC1, nD = ne * nD1, total = nA + nZ + nB + nC + nD;
    for (int it = F.gw; it < total; it += F.NGW) {
        int r = it;
        if (r < nA) { const int kb = r / 97, nb = r % 97; transpose_tile(win, NIN, 64 * kb, 32 * nb, WIN, DM, 32 * nb, scr, F.lane, nb < 32  ); continue; } r -= nA;
        if (r < nZ) { const unsigned zz = (unsigned)F.z; v4u z = {zz, zz, zz, zz}; GAS v4u* p = (GAS v4u*)(WIN + (size_t)(NIN + r) * DM) + F.lane * 2; p[0] = z; p[1] = z; continue; } r -= nZ;
        if (r < nB) { const int kb = r / 32, nb = r % 32; transpose_tile(wout, DM, 64 * kb, 32 * nb, WOUT, DM, 32 * nb, scr, F.lane); continue; } r -= nB;
        if (r < nC) { const int e = r / (2 * nC1), q = r % (2 * nC1), which = q / nC1, t = q % nC1, kb = t / 88, nb = t % 88, n0 = 32 * nb;
            const float* src = (which ? w3 : w1) + (size_t)e * DM * DFF;
            if constexpr (FFN_F8) transpose_tile_f8(src, DFF, 64 * kb, n0, (unsigned char*)WUP, DM, e * 5632 + (n0 / 128) * 256 + (n0 % 128) + which * 128, scr, F.lane, W8S);
            else transpose_tile(src, DFF, 64 * kb, n0, WUP, DM, e * 5632 + (n0 / 128) * 256 + (n0 % 128) + which * 128, scr, F.lane); continue; } r -= nC;
        { const int e = r / nD1, t = r % nD1, kb = t / 32, nb = t % 32;
            if constexpr (FFN_F8) transpose_tile_f8(w2 + (size_t)e * DFF * DM, DM, 64 * kb, 32 * nb, (unsigned char*)WDN + (size_t)e * DM * DFF, DFF, 32 * nb, scr, F.lane, W8S);
            else transpose_tile(w2 + (size_t)e * DFF * DM, DM, 64 * kb, 32 * nb, WDN + (size_t)e * DM * DFF, DFF, 32 * nb, scr, F.lane); }
    }
}

__device__ __forceinline__ void p0_mod(Frame& F) {
    refresh(F);
    LAS float* S = (LAS float*)(F.lds);
    LAS float* R = (LAS float*)(F.lds + 69632);
    const float* c = INP(1); const float* cc = INP(3); const float* wmod = INP(4); const float* bmod = INP(5);
    float* MOD = (float*)(F.ws + WS_MOD);
    for (int i = F.tid; i < 17 * 1024; i += 512) { const int b = i >> 10, k = i & 1023; const float v = b < 16 ? c[b * 1024 + k] : cc[k]; S[i] = siluf(v); }
    __syncthreads();
    const int kq = F.lane >> 4, c4 = (F.lane & 15) * 4;
    for (int item = F.blk; item < 4 * 96; item += F.G) {
        const int l = item / 96, col0 = (item % 96) * 64;
        const float* W = wmod + (size_t)l * DM * 6144;
        float acc[17][4];
#pragma unroll
        for (int b = 0; b < 17; ++b)
#pragma unroll
            for (int j = 0; j < 4; ++j) acc[b][j] = 0.f;
        for (int it = 0; it < 32; ++it) {
            const int k = F.wave * 128 + it * 4 + kq;
            const f32x4 w = *(const f32x4*)(W + (size_t)k * 6144 + col0 + c4);
#pragma unroll
            for (int b = 0; b < 17; ++b) { const float s = S[b * 1024 + k];
#pragma unroll
                for (int j = 0; j < 4; ++j) acc[b][j] += s * w[j]; }
        }
#pragma unroll
        for (int b = 0; b < 17; ++b)
#pragma unroll
            for (int j = 0; j < 4; ++j) { float v = acc[b][j]; v = xadd<16>(v); v = xadd<32>(v); acc[b][j] = v; }
        if (kq == 0) {
#pragma unroll
            for (int b = 0; b < 17; ++b)
#pragma unroll
                for (int j = 0; j < 4; ++j) R[(F.wave * 17 + b) * 64 + c4 + j] = acc[b][j];
        }
        __syncthreads();
        for (int o = F.tid; o < 17 * 64; o += 512) { const int b = o >> 6, ccx = o & 63; float s = bmod[l * 6144 + col0 + ccx];
            for (int w = 0; w < 8; ++w) s += R[(w * 17 + b) * 64 + ccx];
            MOD[((size_t)l * 17 + b) * 6144 + col0 + ccx] = s; }
        __syncthreads();
    }
}
__device__ __forceinline__ float lam_init_of(int l) { return 0.8f - 0.6f * expf(-0.3f * (float)l); }
__device__ __forceinline__ void p0_misc(Frame& F) {
    refresh(F);
    float* ropec = (float*)(F.ws + WS_ROPE); float* ropes = ropec + 1024; float* lam = (float*)(F.ws + WS_ROPE + 16384);
    if (F.blk == 0) {
        for (int i = F.tid; i < 1024; i += 512) { const int pos = i >> 4, f = i & 15; const float inv = powf(10000.f, -(float)f / 16.f); const float ang = (float)pos * inv; ropec[i] = cosf(ang); ropes[i] = sinf(ang); }
    }
    if (F.blk == (1 % F.G) && F.wave < 4) {
        const int l = F.wave; const float* lv = INP(13) + l * 256;
        const float a = wave_sum(lv[F.lane] * lv[64 + F.lane]), b = wave_sum(lv[128 + F.lane] * lv[192 + F.lane]);
        if (F.lane == 0) lam[l] = expf(a) - expf(b) + lam_init_of(l);
    }
}

namespace att {
using bf16x8 = __attribute__((ext_vector_type(8))) short;
using s16x4  = __attribute__((ext_vector_type(4))) short;
using f32x16 = __attribute__((ext_vector_type(16))) float;
using u32x4  = __attribute__((ext_vector_type(4))) unsigned;
constexpr int QBLK = 32, KVBLK = 64, NW = 8, DV = 128;
constexpr float THR = 8.f;
constexpr size_t SHM_V = KVBLK * DV * 2, SHM_K = KVBLK * 64 * 2, SHM_ATTN = 2 * SHM_V + 2 * SHM_K + NW * 64 * 4;
#define KSWZ64(row, colB) ((row) * 128 + ((colB) ^ ((((row) >> 1) & 7) << 4)))
#define SBAR() __builtin_amdgcn_sched_barrier(0)
__device__ __forceinline__ int crow(int r, int hi) { return (r & 3) + 8 * (r >> 2) + 4 * hi; }
__device__ __forceinline__ unsigned cvtpk(float lo, float hi) { unsigned r; asm volatile("v_cvt_pk_bf16_f32 %0, %1, %2" : "=v"(r) : "v"(lo), "v"(hi)); return r; }
__device__ __forceinline__ void partialSM(f32x16& p0, f32x16& p1, float& m_reg, float& mn, float& alpha) {
  float pmax = p0[0];
#pragma unroll
  for (int r = 1; r < 16; ++r) pmax = fmaxf(pmax, p0[r]);
#pragma unroll
  for (int r = 0; r < 16; ++r) pmax = fmaxf(pmax, p1[r]);
  { auto rr = __builtin_amdgcn_permlane32_swap(__float_as_uint(pmax), __float_as_uint(pmax), false, false);
    pmax = fmaxf(__uint_as_float(rr[0]), __uint_as_float(rr[1])); }
  if (__builtin_expect(__all(pmax - m_reg <= THR), 1)) { mn = m_reg; alpha = 1.f; }
  else { mn = fmaxf(m_reg, pmax); alpha = __builtin_amdgcn_exp2f(m_reg - mn); m_reg = mn; }
#pragma unroll
  for (int r = 0; r < 16; ++r) p0[r] = p0[r] - mn;
#pragma unroll
  for (int r = 0; r < 16; ++r) p1[r] = p1[r] - mn;
#pragma unroll
  for (int r = 0; r < 16; ++r) p0[r] = __builtin_amdgcn_exp2f(p0[r]);
}
__device__ __forceinline__ void finishSM(f32x16& p0, f32x16& p1, float alpha, float& l_reg, bf16x8& pa0, bf16x8& pa1, bf16x8& pa2, bf16x8& pa3) {
#pragma unroll
  for (int r = 0; r < 16; ++r) p1[r] = __builtin_amdgcn_exp2f(p1[r]);
  float ps = 0;
#pragma unroll
  for (int r = 0; r < 16; ++r) ps += p0[r];
#pragma unroll
  for (int r = 0; r < 16; ++r) ps += p1[r];
  { auto rr = __builtin_amdgcn_permlane32_swap(__float_as_uint(ps), __float_as_uint(ps), false, false);
    ps = __uint_as_float(rr[0]) + __uint_as_float(rr[1]); }
  l_reg = l_reg * alpha + ps;
#define PK4(P, BASE, OUT) do { unsigned a0 = cvtpk(P[BASE + 0], P[BASE + 1]), a1 = cvtpk(P[BASE + 2], P[BASE + 3]);   \
    unsigned b0 = cvtpk(P[BASE + 4], P[BASE + 5]), b1 = cvtpk(P[BASE + 6], P[BASE + 7]);                              \
    auto r0 = __builtin_amdgcn_permlane32_swap(a0, b0, false, false); auto r1 = __builtin_amdgcn_permlane32_swap(a1, b1, false, false); \
    u32x4 w = {r0[0], r1[0], r0[1], r1[1]}; OUT = *reinterpret_cast<bf16x8*>(&w); } while (0)
  PK4(p0, 0, pa0); PK4(p0, 8, pa1); PK4(p1, 0, pa2); PK4(p1, 8, pa3);
#undef PK4
}
__device__ __forceinline__ void pack_p(const f32x16& p0, const f32x16& p1, bf16x8& pa0, bf16x8& pa1, bf16x8& pa2, bf16x8& pa3) {
#define PK4(P, BASE, OUT) do { unsigned a0 = cvtpk(P[BASE + 0], P[BASE + 1]), a1 = cvtpk(P[BASE + 2], P[BASE + 3]);   \
    unsigned b0 = cvtpk(P[BASE + 4], P[BASE + 5]), b1 = cvtpk(P[BASE + 6], P[BASE + 7]);                              \
    auto r0 = __builtin_amdgcn_permlane32_swap(a0, b0, false, false); auto r1 = __builtin_amdgcn_permlane32_swap(a1, b1, false, false); \
    u32x4 w = {r0[0], r1[0], r0[1], r1[1]}; OUT = *reinterpret_cast<bf16x8*>(&w); } while (0)
  PK4(p0, 0, pa0); PK4(p0, 8, pa1); PK4(p1, 0, pa2); PK4(p1, 8, pa3);
#undef PK4
}
__device__ __forceinline__ void qkt(f32x16& p0, f32x16& p1, const bf16* Ks, const bf16x8* qr, int r32, int hi) {
  p0 = f32x16{}; p1 = f32x16{};
#pragma unroll
  for (int d0 = 0; d0 < 4; ++d0) { int cb = (d0 * 16 + hi * 8) * 2;
    bf16x8 b0 = *reinterpret_cast<const bf16x8*>((const char*)Ks + KSWZ64(r32, cb));
    bf16x8 b1 = *reinterpret_cast<const bf16x8*>((const char*)Ks + KSWZ64(32 + r32, cb));
    p0 = __builtin_amdgcn_mfma_f32_32x32x16_bf16(b0, qr[d0], p0, 0, 0, 0);
    p1 = __builtin_amdgcn_mfma_f32_32x32x16_bf16(b1, qr[d0], p1, 0, 0, 0); }
}
__device__ __forceinline__ int v_st(int k, int c) { const int kk = (k & ~0xC) | ((k & 4) << 1) | ((k & 8) >> 1); return ((kk >> 3) * 4 + (c >> 5)) * 512 + ((kk & 7) * 32 + (c & 31)) * 2; }
__device__ __forceinline__ int v_rd_base(int lane) { return ((lane & 3) << 3) | (((lane >> 2) & 3) << 6) | (((lane >> 4) & 1) << 5) | (((lane >> 5) & 1) << 8); }
constexpr int v_rd_off(int d0, int ks, int half) { return d0 * 512 + ks * 4096 + half * 2048; }
template <int OFF> __device__ __forceinline__ s16x4 tr_read(int vb) {
  s16x4 r; asm volatile("ds_read_b64_tr_b16 %0, %1 offset:%2" : "=&v"(r) : "v"(vb), "i"(OFF) : "memory"); return r;
}
template <int D0> __device__ __forceinline__ void pv_one(f32x16& od, int vb, bf16x8 pa0, bf16x8 pa1, bf16x8 pa2, bf16x8 pa3) {
  const s16x4 l0 = tr_read<v_rd_off(D0, 0, 0)>(vb), h0 = tr_read<v_rd_off(D0, 0, 1)>(vb), l1 = tr_read<v_rd_off(D0, 1, 0)>(vb), h1 = tr_read<v_rd_off(D0, 1, 1)>(vb);
  const s16x4 l2 = tr_read<v_rd_off(D0, 2, 0)>(vb), h2 = tr_read<v_rd_off(D0, 2, 1)>(vb), l3 = tr_read<v_rd_off(D0, 3, 0)>(vb), h3 = tr_read<v_rd_off(D0, 3, 1)>(vb);
  asm volatile("s_waitcnt lgkmcnt(0)" ::: "memory"); SBAR();
#define PK(L, H) (bf16x8){L[0], L[1], L[2], L[3], H[0], H[1], H[2], H[3]}
  od = __builtin_amdgcn_mfma_f32_32x32x16_bf16(pa0, PK(l0, h0), od, 0, 0, 0);
  od = __builtin_amdgcn_mfma_f32_32x32x16_bf16(pa1, PK(l1, h1), od, 0, 0, 0);
  od = __builtin_amdgcn_mfma_f32_32x32x16_bf16(pa2, PK(l2, h2), od, 0, 0, 0);
  od = __builtin_amdgcn_mfma_f32_32x32x16_bf16(pa3, PK(l3, h3), od, 0, 0, 0);
#undef PK
}
__device__ __forceinline__ void pv_d0(f32x16* o, int vb, bf16x8 pa0, bf16x8 pa1, bf16x8 pa2, bf16x8 pa3) {
  pv_one<0>(o[0], vb, pa0, pa1, pa2, pa3); pv_one<1>(o[1], vb, pa0, pa1, pa2, pa3); pv_one<2>(o[2], vb, pa0, pa1, pa2, pa3); pv_one<3>(o[3], vb, pa0, pa1, pa2, pa3);
}
constexpr int LDQ = NP, LDK = NP, LDO = DM;
__device__ __forceinline__ void attn_unit(const bf16* __restrict__ Qb, const bf16* __restrict__ Kh, const bf16* __restrict__ Vh, bf16* __restrict__ Ob, int seq, char* lds, int tid) {
  const int wid = tid >> 6, lane = tid & 63, r32 = lane & 31, hi = lane >> 5;
  bf16* V_lds = (bf16*)lds; bf16* K_lds = (bf16*)(lds + 2 * SHM_V);
  float* ws = (float*)(lds + 2 * SHM_V + 2 * SHM_K) + wid * 64; float* li_l = ws; float* al_l = ws + 32;
  float m_reg = -1e30f, l_reg = 0; f32x16 o[4] = {}; bf16x8 qr[4];
  const bf16* Qw = Qb + (long)(wid * QBLK + r32) * LDQ + hi * 8;
#pragma unroll
  for (int d0 = 0; d0 < 4; ++d0) qr[d0] = *(const __attribute__((address_space(1))) bf16x8*)(Qw + d0 * 16);
  const int sr = tid >> 4, sc = (tid & 15) * 8, vst0 = v_st(sr, sc), vst1 = v_st(32 + sr, sc);
  const int kr = tid >> 3, kc = (tid & 7) * 8, kst = KSWZ64(kr, kc * 2);
  const int vb0 = (int)(uintptr_t)V_lds + v_rd_base(lane);
  struct { bf16x8 vs0, vs1, ks0; } sr_[2];
#define GLD8(p) (*(const __attribute__((address_space(1))) bf16x8*)(p))
#define SLOAD(i, k0) do { sr_[i].vs0 = GLD8(&Vh[(long)((k0) + sr) * LDK + sc]); sr_[i].vs1 = GLD8(&Vh[(long)((k0) + 32 + sr) * LDK + sc]); \
    sr_[i].ks0 = GLD8(&Kh[(long)((k0) + kr) * LDK + kc]); } while (0)
#define SWRITE(b, i) do { *(bf16x8*)((char*)V_lds + (b) * SHM_V + vst0) = sr_[i].vs0; *(bf16x8*)((char*)V_lds + (b) * SHM_V + vst1) = sr_[i].vs1; \
    *(bf16x8*)((char*)K_lds + (b) * SHM_K + kst) = sr_[i].ks0; } while (0)
#define SWAIT() asm volatile("s_waitcnt vmcnt(3)" ::: "memory")
#define RESC(a) do { if (__any((a) < 1.f)) { if (hi == 0) al_l[r32] = (a); asm volatile("s_waitcnt lgkmcnt(0)" ::: "memory"); \
    _Pragma("unroll") for (int d = 0; d < 4; ++d) _Pragma("unroll") for (int r = 0; r < 16; ++r) o[d][r] *= al_l[crow(r, hi)]; } } while (0)
  f32x16 pA0, pA1, pB0, pB1; float mnA, mnB, alA, alB; bf16x8 pa0, pa1, pa2, pa3; const int NT = seq / KVBLK;
  if (__builtin_amdgcn_readfirstlane(wid) >= 4) __builtin_amdgcn_s_setprio(1);
  constexpr int SE = 0, SO = 1;
  SLOAD(SE, 0); asm volatile("s_waitcnt vmcnt(0)" ::: "memory"); SWRITE(0, SE); __syncthreads();
  qkt(pA0, pA1, K_lds, qr, r32, hi); partialSM(pA0, pA1, m_reg, mnA, alA);
  SLOAD(SO, KVBLK); if (2 < NT) SLOAD(SE, 2 * KVBLK);
  SWAIT(); SWRITE(1, SO); __syncthreads();
  for (int j = 1; j + 1 < NT; j += 2) {
    SBAR(); qkt(pB0, pB1, (bf16*)((char*)K_lds + SHM_K), qr, r32, hi);
    finishSM(pA0, pA1, alA, l_reg, pa0, pa1, pa2, pa3); SBAR();
    SLOAD(SO, (j + 2) * KVBLK); SBAR();
    pv_d0(o, vb0, pa0, pa1, pa2, pa3); partialSM(pB0, pB1, m_reg, mnB, alB);
    __syncthreads(); SWAIT(); SWRITE(0, SE);
    RESC(alB); __syncthreads();
    SBAR(); qkt(pA0, pA1, K_lds, qr, r32, hi);
    finishSM(pB0, pB1, alB, l_reg, pa0, pa1, pa2, pa3); SBAR();
    if (j + 3 < NT) SLOAD(SE, (j + 3) * KVBLK); SBAR();
    pv_d0(o, vb0 + (int)SHM_V, pa0, pa1, pa2, pa3); partialSM(pA0, pA1, m_reg, mnA, alA);
    __syncthreads(); SWAIT(); SWRITE(1, SO);
    RESC(alA); __syncthreads();
  }
  SBAR(); qkt(pB0, pB1, (bf16*)((char*)K_lds + SHM_K), qr, r32, hi);
  finishSM(pA0, pA1, alA, l_reg, pa0, pa1, pa2, pa3); SBAR();
  pv_d0(o, vb0, pa0, pa1, pa2, pa3); partialSM(pB0, pB1, m_reg, mnB, alB);
  __syncthreads(); RESC(alB);
  finishSM(pB0, pB1, alB, l_reg, pa0, pa1, pa2, pa3); SBAR();
  pv_d0(o, vb0 + (int)SHM_V, pa0, pa1, pa2, pa3);
  __builtin_amdgcn_s_setprio(0);
  if (hi == 0) li_l[r32] = l_reg; asm volatile("s_waitcnt lgkmcnt(0)" ::: "memory");
  float rli[16];
#pragma unroll
  for (int r = 0; r < 16; ++r) rli[r] = __builtin_amdgcn_rcpf(li_l[crow(r, hi)]);
  bf16* Ow = Ob + (long)(wid * QBLK) * LDO;
#pragma unroll
  for (int r = 0; r < 16; ++r) { const int orow = crow(r, hi);
#pragma unroll
    for (int d0 = 0; d0 < 4; ++d0) Ow[(long)orow * LDO + d0 * 32 + r32] = (bf16)(cvtpk(o[d0][r] * rli[r], 0.f) & 0xffffu); }
#undef SLOAD
#undef GLD8
#undef SWRITE
#undef SWAIT
#undef RESC
}
}

__device__ __forceinline__ int gla_item(int b, int h, int dir, int c) { return ((b * 4 + h) * 2 + dir) * NCH + c; }
namespace gla {
using att::bf16x8; using att::f32x16; using att::u32x4;
__device__ __forceinline__ void gates8(const bf16* P, const float* w2, const float* gb, size_t row0, int dir, int seg, int k, float (&gl)[8]) {
    float w[16];
#pragma unroll
    for (int j = 0; j < 16; ++j) w[j] = w2[j * 256 + k];
    const float bias = gb[k];
#pragma unroll
    for (int i = 0; i < 8; ++i) {
        const bf16* gp = P + (row0 + seg * 8 + i) * NP + C_GLR + dir * 16;
        const v4u a = *(const v4u*)gp, b = *(const v4u*)(gp + 8);
        float z = bias;
        z += bflo(a.x) * w[0] + bfhi(a.x) * w[1] + bflo(a.y) * w[2] + bfhi(a.y) * w[3] + bflo(a.z) * w[4] + bfhi(a.z) * w[5] + bflo(a.w) * w[6] + bfhi(a.w) * w[7];
        z += bflo(b.x) * w[8] + bfhi(b.x) * w[9] + bflo(b.y) * w[10] + bfhi(b.y) * w[11] + bflo(b.z) * w[12] + bfhi(b.z) * w[13] + bflo(b.w) * w[14] + bfhi(b.w) * w[15];
        gl[i] = (fminf(z, 0.f) - log1pf(expf(-fabsf(z)))) * (1.f / 16.f);
    }
}
__device__ __forceinline__ float lscan(const float (&gl)[8], int dir, float (&loc)[8]) {
    float run = 0.f;
    if (dir == 0) {
#pragma unroll
        for (int i = 0; i < 8; ++i) { run += gl[i]; loc[i] = run; }
    } else {
#pragma unroll
        for (int i = 7; i >= 0; --i) { run += gl[i]; loc[i] = run; }
    }
    return run;
}
__device__ __forceinline__ void stage_tile_bf16(const bf16* src, size_t pitch, char* tile, int tid) {
    const int sr = tid >> 4, sc = (tid & 15) * 8;
    const bf16x8 a = *reinterpret_cast<const bf16x8*>(src + (size_t)sr * pitch + sc), b = *reinterpret_cast<const bf16x8*>(src + (size_t)(32 + sr) * pitch + sc);
    *(bf16x8*)(tile + att::v_st(sr, sc)) = a; *(bf16x8*)(tile + att::v_st(32 + sr, sc)) = b;
}
__device__ __forceinline__ void stage_tile_f32(const float* src, char* tile, int tid) {
    const int sr = tid >> 4, sc = (tid & 15) * 8;
#pragma unroll
    for (int t = 0; t < 2; ++t) { const int row = sr + 32 * t; const f32x4 x = *(const f32x4*)(src + row * 128 + sc), y = *(const f32x4*)(src + row * 128 + sc + 4);
        u32x4 w = {att::cvtpk(x[0], x[1]), att::cvtpk(x[2], x[3]), att::cvtpk(y[0], y[1]), att::cvtpk(y[2], y[3])};
        *(u32x4*)(tile + att::v_st(row, sc)) = w; }
}
__device__ __forceinline__ void pv_sel(int d0, f32x16& o, int vb, bf16x8 a0, bf16x8 a1, bf16x8 a2, bf16x8 a3) {
    switch (d0) { case 0: att::pv_one<0>(o, vb, a0, a1, a2, a3); break; case 1: att::pv_one<1>(o, vb, a0, a1, a2, a3); break;
                  case 2: att::pv_one<2>(o, vb, a0, a1, a2, a3); break; default: att::pv_one<3>(o, vb, a0, a1, a2, a3); break; }
}
__device__ __forceinline__ void afrag4(const char* img, int row, int hi, bf16x8 (&a)[4]) {
#pragma unroll
    for (int s = 0; s < 4; ++s) a[s] = *reinterpret_cast<const bf16x8*>(img + KSWZ64(row, (s * 16 + hi * 8) * 2));
}
__device__ __forceinline__ void st_sw(char* img, int row, int col, float v) { *(unsigned short*)(img + KSWZ64(row, col * 2)) = (unsigned short)(att::cvtpk(v, 0.f) & 0xffffu); }
}

constexpr size_t WS_OG = WS_DS;
constexpr int CW_Q = 12288;
struct GlaPre { unsigned g; unsigned short q[8], k[8]; att::bf16x8 v0, v1; };
__device__ __forceinline__ void gla_prefetch(GlaPre& R, const bf16* P_, size_t row0, int h, int dir, int k, int seg, int tid) {
    const GAS bf16* P = (const GAS bf16*)P_;
    R.g = *(const GAS unsigned*)(P + (row0 + seg * 8 + (k >> 3)) * NP + C_GLR + dir * 16 + (k & 7) * 2);
#pragma unroll
    for (int i = 0; i < 8; ++i) { const GAS bf16* rp = P + (row0 + seg * 8 + i) * NP; R.q[i] = rp[C_GQ + h * 64 + k]; R.k[i] = rp[C_GK + h * 64 + k]; }
    const int sr = tid >> 4, sc = (tid & 15) * 8;
    R.v0 = *(const GAS att::bf16x8*)(P + (row0 + sr) * NP + C_GV + h * 128 + sc); R.v1 = *(const GAS att::bf16x8*)(P + (row0 + 32 + sr) * NP + C_GV + h * 128 + sc);
}
__device__ __forceinline__ void gla_chain(Frame& F, int l, int chain) {
    const int b = chain >> 3, h = (chain >> 1) & 3, dir = chain & 1;
    const bf16* P = (const bf16*)(F.ws + WS_PROJ); bf16* OG = (bf16*)(F.ws + WS_OG) + (size_t)dir * M * 512;
    char* lds = (char*)F.lds; char* Vt = lds; char* St = lds + 16384; char* KtT = lds + 32768; char* Kt = lds + 40960; char* Qt = lds + 49152; char* Qh = lds + 57344;
    float* T = (float*)(lds + 65536); float* Dec = (float*)(lds + 67584);
    const int k = F.lane, seg = F.tid >> 6, r32 = F.lane & 31, hi = F.lane >> 5, mt = F.wave >> 2, d0 = F.wave & 3;
    const int vbV = (int)(uintptr_t)Vt + att::v_rd_base(F.lane), vbS = (int)(uintptr_t)St + att::v_rd_base(F.lane);
    const int sr = F.tid >> 4, sc = (F.tid & 15) * 8;
    float w[16];
    { const float* w2 = INP(11) + (size_t)((l * 2 + dir) * 16) * 256 + h * 64;
#pragma unroll
      for (int j = 0; j < 16; ++j) w[j] = w2[j * 256 + k]; }
    const float bias = (INP(12) + (l * 2 + dir) * 256 + h * 64)[k];
    att::f32x16 S = {};
    GlaPre R, RN;
    { const int c0 = dir == 0 ? 0 : 3; gla_prefetch(RN, P, (size_t)b * TPB + c0 * 64, h, dir, k, seg, F.tid); }
    for (int j = 0; j < NCH; ++j) {
        const int c = dir == 0 ? j : (j < 4 ? 3 - j : 39 - j);
        const size_t row0 = (size_t)b * TPB + c * 64;
        R = RN;
        if (j + 1 < NCH) { const int cn = dir == 0 ? j + 1 : (j + 1 < 4 ? 2 - j : 38 - j); gla_prefetch(RN, P, (size_t)b * TPB + cn * 64, h, dir, k, seg, F.tid); }
        float gl[8], loc[8];
#pragma unroll
        for (int i = 0; i < 8; ++i) {
            float z = bias;
#pragma unroll
            for (int d = 0; d < 8; ++d) { const unsigned s = (unsigned)__builtin_amdgcn_readlane((int)R.g, i * 8 + d); z += bflo(s) * w[2 * d] + bfhi(s) * w[2 * d + 1]; }
            gl[i] = (fminf(z, 0.f) - __logf(1.f + __expf(-fabsf(z)))) * (1.f / 16.f); }
        const float segtot = gla::lscan(gl, dir, loc);
        T[seg * 64 + k] = segtot;
        *(att::bf16x8*)(Vt + att::v_st(sr, sc)) = R.v0; *(att::bf16x8*)(Vt + att::v_st(32 + sr, sc)) = R.v1;
#pragma unroll
        for (int r = 0; r < 16; ++r) *(unsigned short*)(St + att::v_st(mt * 32 + att::crow(r, hi), d0 * 32 + r32)) = (unsigned short)(att::cvtpk(S[r], 0.f) & 0xffffu);
        __syncthreads();
        float off = 0.f, tot = 0.f;
        int sg = seg; asm volatile("" : "+v"(sg));
#pragma unroll
        for (int s = 0; s < 8; ++s) { const float t = T[s * 64 + k]; tot += t; const bool inoff = dir == 0 ? (s < sg) : (s > sg); off += inoff ? t : 0.f; }
        const float etot = __expf(tot);
        float kt[8];
#pragma unroll
        for (int i = 0; i < 8; ++i) { const int tau = seg * 8 + i; const float qv = bf2f(R.q[i]), kv = bf2f(R.k[i]); const float cc = loc[i] + off;
            const float a = fmaxf(__expf(cc), 1e-30f)  , bq = __builtin_amdgcn_rcpf(a), kb = kv * bq;
            kt[i] = kb * etot;
            gla::st_sw(Qh, tau, k, qv * a); gla::st_sw(Kt, tau, k, kb); }
        { att::u32x4 wv = {att::cvtpk(kt[0], kt[1]), att::cvtpk(kt[2], kt[3]), att::cvtpk(kt[4], kt[5]), att::cvtpk(kt[6], kt[7])};
          *(att::u32x4*)(KtT + KSWZ64(k, seg * 16)) = wv; }
        if (sg == 0) Dec[k] = etot;
        __syncthreads();
        att::f32x16 o = {};
        int tau_q = mt * 32 + r32; asm volatile("" : "+v"(tau_q));
        { att::bf16x8 qr[4]; gla::afrag4(Qh, tau_q, hi, qr);
          att::f32x16 p0, p1; att::qkt(p0, p1, (const bf16*)Kt, qr, r32, hi);
#pragma unroll
          for (int r = 0; r < 16; ++r) { const int t0 = att::crow(r, hi), t1 = 32 + t0;
              const bool k0 = dir == 0 ? (t0 <= tau_q) : (t0 >= tau_q), k1 = dir == 0 ? (t1 <= tau_q) : (t1 >= tau_q);
              p0[r] = k0 ? p0[r] : 0.f; p1[r] = k1 ? p1[r] : 0.f; }
          att::bf16x8 pa0, pa1, pa2, pa3; att::pack_p(p0, p1, pa0, pa1, pa2, pa3);
          gla::pv_sel(d0, o, vbV, pa0, pa1, pa2, pa3);
          gla::pv_sel(d0, o, vbS, qr[0], qr[1], qr[2], qr[3]); }
#pragma unroll
        for (int r = 0; r < 16; ++r) S[r] *= Dec[mt * 32 + att::crow(r, hi)];
        { att::bf16x8 a[4]; gla::afrag4(KtT, mt * 32 + r32, hi, a); gla::pv_sel(d0, S, vbV, a[0], a[1], a[2], a[3]); }
        GAS bf16* op = (GAS bf16*)(OG + row0 * 512 + h * 128 + d0 * 32 + r32);
#pragma unroll
        for (int r = 0; r < 16; ++r) op[(size_t)(mt * 32 + att::crow(r, hi)) * 512] = (bf16)(att::cvtpk(o[r], 0.f) & 0xffffu);
        __syncthreads();
    }
}
__device__ __forceinline__ void p3_mixer(Frame& F, int l) {
    refresh(F);
    for (int ch = F.blk; ch < NBATCH * 8; ch += F.G) gla_chain(F, l, ch);
    const bf16* P = (const bf16*)(F.ws + WS_PROJ); bf16* OD = (bf16*)(F.ws + WS_OD);
    volatile LAS unsigned* slot = F.MISC + 24;
    int myq = F.blk & 7, tries = 0;
    for (;;) {
        __syncthreads();
        if (F.tid == 0) slot[0] = __hip_atomic_fetch_add((unsigned*)((gu32*)F.ws + CW_Q + 64 * l + 8 * 0 + myq), 1u, __ATOMIC_RELAXED, __HIP_MEMORY_SCOPE_AGENT);
        __syncthreads();
        const int u = (int)slot[0];
        if (u >= (l == DEPTH - 1 ? 128 : 144)) { if (++tries >= 8) break; myq = (myq + 1) & 7; continue; }
        int g, qt;
        if (u < 128) { const int pi = u >> 4, mp = (u >> 3) & 1; g = ((pi * 8 + myq) << 1) + mp; qt = 1 + (u & 7); }
        else { const int gi = u - 128; g = (((gi >> 1) * 8 + myq) << 1) + (gi & 1); qt = 0; }
        const int b = g >> 3, hh = g & 7;
        const size_t row0 = (size_t)b * TPB;
        att::attn_unit(P + (row0 + qt * 256) * NP + C_Q + hh * 64, P + row0 * NP + C_K + hh * 64, P + row0 * NP + C_V + (hh >> 1) * 128,
                       OD + (row0 + qt * 256) * DM + hh * 128, qt == 0 ? CTX : TPB, (char*)F.lds, F.tid);
    }
    __syncthreads();
}
__device__ __forceinline__ void p5_merge_all(Frame& F, int l) {
    refresh(F);
    const bf16* OD = (const bf16*)(F.ws + WS_OD); const bf16* OG = (const bf16*)(F.ws + WS_OG); const bf16* P = (const bf16*)(F.ws + WS_PROJ); bf16* MRG = (bf16*)(F.ws + WS_H);
    const float lam = ((const float*)(F.ws + WS_ROPE + 16384))[l]; const float omli = 1.f - lam_init_of(l);
    const float* subln = INP(14) + l * 128; const float* onorm = INP(15) + l * 128;
    const int h = F.lane >> 4, c0 = (F.lane & 15) * 8;
    const int rpw = (M + F.NGW - 1) / F.NGW, r0 = F.gw * rpw, r1 = (r0 + rpw < M) ? r0 + rpw : M;
    for (int r = r0; r < r1; ++r) {
        const v4u a = *(const v4u*)(OD + (size_t)r * DM + h * 256 + c0), bq = *(const v4u*)(OD + (size_t)r * DM + h * 256 + 128 + c0);
        const v4u gf = *(const v4u*)(OG + (size_t)r * 512 + h * 128 + c0), gbk = *(const v4u*)(OG + ((size_t)M + r) * 512 + h * 128 + c0);
        const v4u gt = *(const v4u*)(P + (size_t)r * NP + C_GG + h * 128 + c0);
        float d[8], e[8], g[8];
        d[0] = bflo(a.x) - lam * bflo(bq.x); d[1] = bfhi(a.x) - lam * bfhi(bq.x); d[2] = bflo(a.y) - lam * bflo(bq.y); d[3] = bfhi(a.y) - lam * bfhi(bq.y);
        d[4] = bflo(a.z) - lam * bflo(bq.z); d[5] = bfhi(a.z) - lam * bfhi(bq.z); d[6] = bflo(a.w) - lam * bflo(bq.w); d[7] = bfhi(a.w) - lam * bfhi(bq.w);
        e[0] = bflo(gf.x) + bflo(gbk.x); e[1] = bfhi(gf.x) + bfhi(gbk.x); e[2] = bflo(gf.y) + bflo(gbk.y); e[3] = bfhi(gf.y) + bfhi(gbk.y);
        e[4] = bflo(gf.z) + bflo(gbk.z); e[5] = bfhi(gf.z) + bfhi(gbk.z); e[6] = bflo(gf.w) + bflo(gbk.w); e[7] = bfhi(gf.w) + bfhi(gbk.w);
        g[0] = bflo(gt.x); g[1] = bfhi(gt.x); g[2] = bflo(gt.y); g[3] = bfhi(gt.y); g[4] = bflo(gt.z); g[5] = bfhi(gt.z); g[6] = bflo(gt.w); g[7] = bfhi(gt.w);
        float ss = 0.f, se = 0.f;
#pragma unroll
        for (int i = 0; i < 8; ++i) { ss += d[i] * d[i]; se += e[i] * e[i]; }
        ss = xadd<1>(ss); ss = xadd<2>(ss); ss = xadd<4>(ss); ss = xadd<8>(ss);
        se = xadd<1>(se); se = xadd<2>(se); se = xadd<4>(se); se = xadd<8>(se);
        const float sc = omli / sqrtf(ss * (1.f / 128.f) + EPS), se2 = 1.0f / sqrtf(se * (1.f / 128.f) + EPS);
#pragma unroll
        for (int i = 0; i < 8; ++i) { d[i] = d[i] * sc * subln[c0 + i]; e[i] = e[i] * se2 * onorm[c0 + i] * siluf(g[i]); }
        v4u w; w.x = pg8::cvt_pk_bf16(d[0], d[1]); w.y = pg8::cvt_pk_bf16(d[2], d[3]); w.z = pg8::cvt_pk_bf16(d[4], d[5]); w.w = pg8::cvt_pk_bf16(d[6], d[7]);
        *(v4u*)(MRG + (size_t)r * DM + h * 128 + c0) = w;
        v4u x; x.x = pg8::cvt_pk_bf16(e[0], e[1]); x.y = pg8::cvt_pk_bf16(e[2], e[3]); x.z = pg8::cvt_pk_bf16(e[4], e[5]); x.w = pg8::cvt_pk_bf16(e[6], e[7]);
        *(v4u*)(MRG + (size_t)r * DM + 512 + h * 128 + c0) = x;
    }
}

__device__ __forceinline__ float dpp_sum16(float v) {
    v += __int_as_float(__builtin_amdgcn_update_dpp(0, __float_as_int(v), 0xB1, 0xF, 0xF, true));
    v += __int_as_float(__builtin_amdgcn_update_dpp(0, __float_as_int(v), 0x4E, 0xF, 0xF, true));
    v += __int_as_float(__builtin_amdgcn_update_dpp(0, __float_as_int(v), 0x141, 0xF, 0xF, true));
    v += __int_as_float(__builtin_amdgcn_update_dpp(0, __float_as_int(v), 0x140, 0xF, 0xF, true));
    return v;
}
__device__ __forceinline__ float wave_sum2(float v) { v = dpp_sum16(v); v = xadd<16>(v); v = xadd<32>(v); return v; }
__device__ __forceinline__ float row_rinv2(const f32x4 (&v)[4]) {
    float s = 0.f;
#pragma unroll
    for (int j = 0; j < 4; ++j) s += (v[j][0] * v[j][0] + v[j][1] * v[j][1]) + (v[j][2] * v[j][2] + v[j][3] * v[j][3]);
    return __builtin_amdgcn_rsqf(wave_sum2(s) * (1.f / DM) + EPS);
}
__device__ __forceinline__ void ld_raw_bf16(const bf16* row, int lane, u32x2 (&v)[4]) {
#pragma unroll
    for (int j = 0; j < 4; ++j) v[j] = *(const u32x2*)(row + 4 * lane + 256 * j);
}
__device__ __forceinline__ f32x4 raw2f(u32x2 w) { return (f32x4){bflo(w.x), bfhi(w.x), bflo(w.y), bfhi(w.y)}; }
__device__ __forceinline__ void ld_vec(const float* p, int lane, f32x4 (&v)[4]) {
#pragma unroll
    for (int j = 0; j < 4; ++j) v[j] = *(const f32x4*)(p + 4 * lane + 256 * j);
}

__device__ __forceinline__ void p1_rows(Frame& F, int l) {
    refresh(F);
    const float* MOD = (const float*)(F.ws + WS_MOD);
    bf16* X = (bf16*)(F.ws + WS_X); bf16* H = (bf16*)(F.ws + WS_H); const bf16* F2 = (const bf16*)(F.ws + WS_F2);
    const int rpw = (M + F.NGW - 1) / F.NGW, r0 = F.gw * rpw, r1 = (r0 + rpw < M) ? r0 + rpw : M;
    if (r0 >= r1) return;
    const bool two = l > 0 && ((l - 1) & 1);
    f32x4 gpre[4], gpost[4], sh[4], sc[4], gt[4];
    ld_vec(INP(6) + l * DM, F.lane, gpre);
    if (l > 0) ld_vec(INP(9) + (l - 1) * DM, F.lane, gpost);
    int cur = -1;
    f32x4 xn[4]; u32x2 xr[4], fn[4], gn[4];
#define P1_ISSUE(r) do { const int b_ = (r) / TPB, p_ = (r) % TPB; \
        if (l == 0) ld_row_f32(p_ < CTX ? INP(2) + ((size_t)b_ * CTX + p_) * DM : INP(0) + ((size_t)b_ * SEQ + (p_ - CTX)) * DM, F.lane, xn); \
        else ld_raw_bf16(X + (size_t)(r) * DM, F.lane, xr); \
        if (l > 0) { ld_raw_bf16(F2 + (size_t)(r) * DM, F.lane, fn); if (two) ld_raw_bf16(F2 + ((size_t)M + (r)) * DM, F.lane, gn); } } while (0)
    P1_ISSUE(r0);
    for (int r = r0; r < r1; ++r) {
        f32x4 x[4]; u32x2 fr[4], gr[4];
#pragma unroll
        for (int j = 0; j < 4; ++j) { x[j] = (l == 0) ? xn[j] : raw2f(xr[j]); fr[j] = fn[j]; gr[j] = gn[j]; }
        if (r + 1 < r1) P1_ISSUE(r + 1);
        const int b = r / TPB, p = r % TPB, mrow = p < CTX ? 16 : b;
        if (mrow != cur) { cur = mrow; const float* modp = MOD + ((size_t)l * 17 + mrow) * 6144; ld_vec(modp, F.lane, sh); ld_vec(modp + 1024, F.lane, sc);
            if (l > 0) ld_vec(MOD + ((size_t)(l - 1) * 17 + mrow) * 6144 + 5 * 1024, F.lane, gt); }
        if (l > 0) {
            f32x4 f[4];
#pragma unroll
            for (int j = 0; j < 4; ++j) { f[j] = raw2f(fr[j]); if (two) f[j] = f[j] + raw2f(gr[j]); }
            const float rinv = row_rinv2(f);
#pragma unroll
            for (int j = 0; j < 4; ++j) x[j] = x[j] + gt[j] * (f[j] * rinv * gpost[j]);
        }
        st_row_bf16(X + (size_t)r * DM, F.lane, x);
        const float rinv = row_rinv2(x);
        f32x4 h[4];
#pragma unroll
        for (int j = 0; j < 4; ++j) h[j] = (x[j] * rinv * gpre[j]) * (sc[j] + 1.0f) + sh[j];
        st_row_bf16(H + (size_t)r * DM, F.lane, h);
    }
#undef P1_ISSUE
}
__device__ __forceinline__ void pf_final(Frame& F) {
    refresh(F);
    const float* MOD = (const float*)(F.ws + WS_MOD);
    const bf16* X = (const bf16*)(F.ws + WS_X); const bf16* F2 = (const bf16*)(F.ws + WS_F2);
    const int l = DEPTH - 1, NR = NBATCH * SEQ;
    const int rpw = (NR + F.NGW - 1) / F.NGW, i0 = F.gw * rpw, i1 = (i0 + rpw < NR) ? i0 + rpw : NR;
    if (i0 >= i1) return;
    f32x4 gpost[4], gt[4]; ld_vec(INP(9) + l * DM, F.lane, gpost);
    int cur = -1;
    u32x2 xn[4], fn[4], gn[4];
#define PF_ISSUE(i) do { const size_t r_ = (size_t)((i) / SEQ) * TPB + CTX + (i) % SEQ; ld_raw_bf16(X + r_ * DM, F.lane, xn); ld_raw_bf16(F2 + r_ * DM, F.lane, fn); ld_raw_bf16(F2 + ((size_t)M + r_) * DM, F.lane, gn); } while (0)
    PF_ISSUE(i0);
    for (int i = i0; i < i1; ++i) {
        f32x4 x[4], f[4];
#pragma unroll
        for (int j = 0; j < 4; ++j) { x[j] = raw2f(xn[j]); f[j] = raw2f(fn[j]) + raw2f(gn[j]); }
        if (i + 1 < i1) PF_ISSUE(i + 1);
        const int b = i / SEQ;
        if (b != cur) { cur = b; ld_vec(MOD + ((size_t)l * 17 + b) * 6144 + 5 * 1024, F.lane, gt); }
        const float rinv = row_rinv2(f);
#pragma unroll
        for (int j = 0; j < 4; ++j) x[j] = x[j] + gt[j] * (f[j] * rinv * gpost[j]);
        st_row_f32(F.A->out + (size_t)i * DM, F.lane, x);
    }
#undef PF_ISSUE
}
__device__ __forceinline__ void p7_rows(Frame& F, int l) {
    refresh(F);
    const float* MOD = (const float*)(F.ws + WS_MOD);
    bf16* X = (bf16*)(F.ws + WS_X); const bf16* Y = (const bf16*)(F.ws + WS_Y); bf16* H2 = (bf16*)(F.ws + WS_H2);
    const bool moe = l & 1; const int li = l >> 1;
    int* TOPE = (int*)(F.ws + WS_TOPE); int* LIDX = (int*)(F.ws + WS_LIDX); float* TOPW = (float*)(F.ws + WS_TOPW); int* BLKB = (int*)(F.ws + WS_BLKB);
    volatile LAS unsigned* LCNT = F.MISC + 16;
    LAS float* RT = (LAS float*)F.lds;
    if (moe) {
        const float* router = INP(20) + (size_t)li * DM * NE;
        if (F.tid < 8) LCNT[F.tid] = 0u;
        for (int i = F.tid; i < DM * NE / 4; i += 512) { const f32x4 q = *(const f32x4*)(router + 4 * i); const int c = i >> 1, e0 = (i & 1) * 4;
            RT[(e0 + 0) * DM + c] = q[0]; RT[(e0 + 1) * DM + c] = q[1]; RT[(e0 + 2) * DM + c] = q[2]; RT[(e0 + 3) * DM + c] = q[3]; }
        __syncthreads();
    }
    const bool lastl = (l == DEPTH - 1); const int NR = lastl ? NBATCH * SEQ : M;
#define P7_ROW(i) (lastl ? ((i) / SEQ) * TPB + CTX + (i) % SEQ : (i))
    const int rpw = (NR + F.NGW - 1) / F.NGW, r0 = F.gw * rpw, r1 = (r0 + rpw < NR) ? r0 + rpw : NR;
    if (r0 < r1) {
        f32x4 gpost[4], gpre[4], gt[4], sh[4], sc[4];
        ld_vec(INP(7) + l * DM, F.lane, gpost); ld_vec(INP(8) + l * DM, F.lane, gpre);
        int cur = -1;
        u32x2 xn[4], yn[4];
        ld_raw_bf16(X + (size_t)P7_ROW(r0) * DM, F.lane, xn); ld_raw_bf16(Y + (size_t)P7_ROW(r0) * DM, F.lane, yn);
        for (int ri = r0; ri < r1; ++ri) {
            const int r = P7_ROW(ri);
            f32x4 x[4], y[4];
#pragma unroll
            for (int j = 0; j < 4; ++j) { x[j] = raw2f(xn[j]); y[j] = raw2f(yn[j]); }
            if (ri + 1 < r1) { const int rn = P7_ROW(ri + 1); ld_raw_bf16(X + (size_t)rn * DM, F.lane, xn); ld_raw_bf16(Y + (size_t)rn * DM, F.lane, yn); }
            const int b = r / TPB, p = r % TPB, mrow = p < CTX ? 16 : b;
            if (mrow != cur) { cur = mrow; const float* modp = MOD + ((size_t)l * 17 + mrow) * 6144; ld_vec(modp + 2 * 1024, F.lane, gt); ld_vec(modp + 3 * 1024, F.lane, sh); ld_vec(modp + 4 * 1024, F.lane, sc); }
            const float ry = row_rinv2(y);
#pragma unroll
            for (int j = 0; j < 4; ++j) x[j] = x[j] + gt[j] * (y[j] * ry * gpost[j]);
            st_row_bf16(X + (size_t)r * DM, F.lane, x);
            const float rx = row_rinv2(x);
            f32x4 h[4];
#pragma unroll
            for (int j = 0; j < 4; ++j) h[j] = (x[j] * rx * gpre[j]) * (sc[j] + 1.0f) + sh[j];
            if constexpr (FFN_F8) {
#pragma unroll
                for (int j = 0; j < 4; ++j) *(unsigned*)((unsigned char*)H2 + (size_t)r * DM + 4 * F.lane + 256 * j) = pk4_f8(h[j][0], h[j][1], h[j][2], h[j][3]);
            } else st_row_bf16(H2 + (size_t)r * DM, F.lane, h);
            if (moe) {
                float lg[8];
#pragma unroll
                for (int e = 0; e < 8; ++e) lg[e] = 0.f;
#pragma unroll
                for (int j = 0; j < 4; ++j)
#pragma unroll
                    for (int e = 0; e < 8; ++e) { const f32x4 q = *(const LAS f32x4*)(RT + e * DM + 4 * F.lane + 256 * j); lg[e] += (h[j][0] * q[0] + h[j][1] * q[1]) + (h[j][2] * q[2] + h[j][3] * q[3]); }
#pragma unroll
                for (int e = 0; e < 8; ++e) lg[e] = wave_sum2(lg[e]);
                int e0 = 0; float v0 = lg[0];
#pragma unroll
                for (int e = 1; e < 8; ++e) if (lg[e] > v0) { v0 = lg[e]; e0 = e; }
                int e1 = -1; float v1 = -3.0e38f;
#pragma unroll
                for (int e = 0; e < 8; ++e) if (e != e0 && lg[e] > v1) { v1 = lg[e]; e1 = e; }
                const float ex = __expf(v1 - v0), w0 = 1.f / (1.f + ex), w1 = ex / (1.f + ex);
                if (F.lane == 0) {
                    const unsigned i0 = __hip_atomic_fetch_add((LAS unsigned*)&LCNT[e0], 1u, __ATOMIC_RELAXED, __HIP_MEMORY_SCOPE_WORKGROUP), i1 = __hip_atomic_fetch_add((LAS unsigned*)&LCNT[e1], 1u, __ATOMIC_RELAXED, __HIP_MEMORY_SCOPE_WORKGROUP);
                    TOPE[r] = e0 | (e1 << 8); LIDX[2 * r] = (int)i0; LIDX[2 * r + 1] = (int)i1; TOPW[2 * r] = w0; TOPW[2 * r + 1] = w1;
                }
            }
        }
    }
    if (moe) {
        __syncthreads();
        if (F.tid < 8) { const unsigned base = __hip_atomic_fetch_add((unsigned*)((gu32*)F.ws + CW_CNT + 64 * li + F.tid), LCNT[F.tid], __ATOMIC_RELAXED, __HIP_MEMORY_SCOPE_AGENT); BLKB[F.blk * 8 + F.tid] = (int)base; }
    }
#undef P7_ROW
}
__device__ __forceinline__ void moe_offsets(Frame& F, int li, int (&cnt)[8], int (&off)[9]) {
    off[0] = 0;
#pragma unroll
    for (int e = 0; e < 8; ++e) { cnt[e] = (int)__hip_atomic_load((unsigned*)(((gu32*)F.ws) + CW_CNT + 64 * li + e), __ATOMIC_RELAXED, __HIP_MEMORY_SCOPE_AGENT); off[e + 1] = off[e] + ((cnt[e] + 255) & ~255); }
}
__device__ __forceinline__ void p7b_gather(Frame& F, int l) {
    refresh(F);
    const int li = l >> 1; int cnt[8], off[9]; moe_offsets(F, li, cnt, off);
    const bf16* H2 = (const bf16*)(F.ws + WS_H2); bf16* HG = (bf16*)(F.ws + WS_HG);
    const int* TOPE = (const int*)(F.ws + WS_TOPE); const int* LIDX = (const int*)(F.ws + WS_LIDX); const float* TOPW = (const float*)(F.ws + WS_TOPW); const int* BLKB = (const int*)(F.ws + WS_BLKB);
    int* RMAP = (int*)(F.ws + WS_RMAP); float* ROWW = (float*)(F.ws + WS_ROWW);
    constexpr int RB = FFN_F8 ? DM : 2 * DM, LB = RB / 64;
    const unsigned char* H2b = (const unsigned char*)H2; unsigned char* HGb = (unsigned char*)HG;
    const bool lastl = (l == DEPTH - 1); const int NR = lastl ? NBATCH * SEQ : M;
    const int rpw = (NR + F.NGW - 1) / F.NGW, r0 = F.gw * rpw, r1 = (r0 + rpw < NR) ? r0 + rpw : NR;
    for (int ri = r0; ri < r1; ++ri) {
        const int r = lastl ? (ri / SEQ) * TPB + CTX + ri % SEQ : ri;
        const int te = TOPE[r];
        v4u a, bq = {0u, 0u, 0u, 0u}; a = *(const v4u*)(H2b + (size_t)r * RB + F.lane * LB); if constexpr (!FFN_F8) bq = *(const v4u*)(H2b + (size_t)r * RB + F.lane * LB + 16);
#pragma unroll
        for (int s = 0; s < 2; ++s) {
            const int e = (te >> (8 * s)) & 0xff;
            int o = 0;
#pragma unroll
            for (int q = 0; q < 8; ++q) o = (q == e) ? off[q] : o;
            const int pos = o + BLKB[F.blk * 8 + e] + LIDX[2 * r + s];
            *(v4u*)(HGb + (size_t)pos * RB + F.lane * LB) = a; if constexpr (!FFN_F8) *(v4u*)(HGb + (size_t)pos * RB + F.lane * LB + 16) = bq;
            if (F.lane == 0) { RMAP[pos] = r | (s << 30); ROWW[pos] = TOPW[2 * r + s]; }
        }
    }
#pragma unroll
    for (int e = 0; e < 8; ++e) {
        const int npad = off[e + 1] - off[e] - cnt[e];
        for (int i = F.gw; i < npad; i += F.NGW) { const int pos = off[e] + cnt[e] + i; const unsigned zz = (unsigned)F.z; const v4u z = {zz, zz, zz, zz};
            *(v4u*)(HGb + (size_t)pos * RB + F.lane * LB) = z; if constexpr (!FFN_F8) *(v4u*)(HGb + (size_t)pos * RB + F.lane * LB + 16) = z;
            if (F.lane == 0) { RMAP[pos] = -1; ROWW[pos] = 0.f; } }
    }
}

__global__ void __launch_bounds__(NWAVES * 64, 2) mk_fwd(Args args) {
    extern __shared__ __attribute__((aligned(16))) unsigned char lds[];
    Frame F;
    F.lds = (LAS unsigned char*)lds;
    F.MISC = (volatile LAS unsigned*)(F.lds + MISC_OFF);
    F.tid = threadIdx.x; F.lane = F.tid & 63; F.wave = __builtin_amdgcn_readfirstlane(F.tid >> 6); F.wv = F.wave;
    F.G = gridDim.x; F.blk = blockIdx.x; F.gw = F.blk * NWAVES + F.wave; F.NGW = F.G * NWAVES;
    F.ws = args.ws;
    F.A = &args;
    for (int u = F.tid; u < 128; u += NWAVES * 64) F.MISC[u] = 0u;
    __syncthreads();
    { XcdBarrier b0 = xcd_barrier_post((unsigned*)F.ws + CW_BAR, F.MISC + 8); (void)b0; }
#define GRID_BAR() do { XcdBarrier b_; b_.bar = (unsigned*)F.ws + CW_BAR; b_.x = xb_xcc_id(); b_.st = F.MISC + 8; refresh(F); xcd_barrier(b_, F.tid == 0); } while (0)

    p0_mod(F); p0_misc(F); convert_weights(F, 0);
    GRID_BAR();
    for (int l = 0; l < DEPTH; ++l) {
        const bool moe = l & 1; const int li = l >> 1;
        { unsigned char* wsp = args.ws; asm volatile("" : "+s"(wsp)); F.ws = wsp; }
        p1_rows(F, l);
        if (l > 0) convert_weights(F, l);
        GRID_BAR();
        {
            refresh(F);
            pg8::Gemm g{(const pg8::bf16_t*)(F.ws + WS_H), (const pg8::bf16_t*)(F.ws + WS_WIN), M, NP, DM};
            pg8::StaticOrder S; S.init(M, NP, F.G, F.blk);
            pg8::EpiProj E{(pg8::bf16_t*)(F.ws + WS_PROJ), (const float*)(F.ws + WS_ROPE), (const float*)(F.ws + WS_ROPE) + 1024};
            pg8::gemm_phase<pg8::EpiProj, pg8::StaticOrder, true, true>(F.lds, g, S, E, F.wave);
        }
        GRID_BAR();
        p3_mixer(F, l);
        GRID_BAR();
        p5_merge_all(F, l);
        GRID_BAR();
        {
            refresh(F);
            pg8::Gemm g{(const pg8::bf16_t*)(F.ws + WS_H), (const pg8::bf16_t*)(F.ws + WS_WOUT), M, DM, DM};
            const int lastl = (l == DEPTH - 1);
            pg8::LatOrder S; S.S.init(lastl ? NBATCH * SEQ : M, DM, F.G, F.blk); S.lat = lastl;
            pg8::EpiF32 E{(pg8::bf16_t*)(F.ws + WS_Y)};
            pg8::gemm_phase<pg8::EpiF32, pg8::LatOrder, true, true>(F.lds, g, S, E, F.wave);
        }
        GRID_BAR();
        p7_rows(F, l);
        GRID_BAR();
        if (moe) { p7b_gather(F, l); GRID_BAR(); }
        int ntiles = M / 256;
        {
            refresh(F);
            LAS int* texp = (LAS int*)(F.lds + TEXP_OFF);
            if (moe) { int cnt[8], off[9]; moe_offsets(F, li, cnt, off); ntiles = off[8] >> 8;
                for (int t = F.tid; t < ntiles; t += 512) { int e = 0;
#pragma unroll
                    for (int q = 1; q < 8; ++q) e += ((t << 8) >= off[q]) ? 1 : 0;
                    texp[t] = e; } }
            else { for (int t = F.tid; t < ntiles; t += 512) texp[t] = 0; }
            __syncthreads();
        }
        {
            refresh(F);
            pg8::Gemm g{(const pg8::bf16_t*)(F.ws + (moe ? WS_HG : WS_H2)), (const pg8::bf16_t*)(F.ws + WS_WUP), ntiles * 256, 2 * DFF, FFN_F8 ? DM / 2 : DM};
            pg8::GroupedOrder S; S.S.init(ntiles * 256, 2 * DFF, F.G, F.blk); S.texp = (const LAS int*)(F.lds + TEXP_OFF); S.nN = 22;
            pg8::EpiSwiglu E{(pg8::bf16_t*)(F.ws + WS_U)};
            pg8::gemm_phase<pg8::EpiSwiglu, pg8::GroupedOrder, true, true, FFN_F8 != 0>(F.lds, g, S, E, F.wave);
        }
        GRID_BAR();
        {
            refresh(F);
            pg8::Gemm g{(const pg8::bf16_t*)(F.ws + WS_U), (const pg8::bf16_t*)(F.ws + WS_WDN), ntiles * 256, DM, FFN_F8 ? DFF / 2 : DFF};
            pg8::GroupedOrder S; S.S.init(ntiles * 256, DM, F.G, F.blk); S.texp = (const LAS int*)(F.lds + TEXP_OFF); S.nN = 4;
            pg8::EpiDown E{(pg8::bf16_t*)(F.ws + WS_F2), (const int*)(F.ws + WS_RMAP), (const float*)(F.ws + WS_ROWW), moe ? 0 : 1};
            pg8::gemm_phase<pg8::EpiDown, pg8::GroupedOrder, true, true, FFN_F8 != 0>(F.lds, g, S, E, F.wave);
        }
        GRID_BAR();
    }
    pf_final(F);
}

extern "C" void kernel_launch(void* const* d_in, const int* in_sizes, int n_in, void* d_out, int out_size, void* d_ws, size_t ws_size, hipStream_t stream) {
    static int grid = 0;
    if (grid == 0) {
        if (n_in != 24 || out_size != NBATCH * SEQ * DM || ws_size < WS_END) { fprintf(stderr, "kernel_launch: unexpected shapes or workspace (%d inputs, out %d, ws %zu < %zu)\n", n_in, out_size, ws_size, (size_t)WS_END); grid = -1; return; }
        int dev = 0, cus = 0, per_cu = 0;
        if (hipGetDevice(&dev) != hipSuccess || hipDeviceGetAttribute(&cus, hipDeviceAttributeMultiprocessorCount, dev) != hipSuccess) { grid = -1; return; }
        if (hipFuncSetAttribute((const void*)mk_fwd, hipFuncAttributeMaxDynamicSharedMemorySize, LDS_BYTES) != hipSuccess) { grid = -1; return; }
        if (hipOccupancyMaxActiveBlocksPerMultiprocessor(&per_cu, (const void*)mk_fwd, NWAVES * 64, LDS_BYTES) != hipSuccess || per_cu < 1) { fprintf(stderr, "kernel_launch: occupancy query says %d\n", per_cu); }
        (void)hipGetLastError();
        grid = cus;
    }
    if (grid < 0) return;
    if (hipMemsetAsync((char*)d_ws + WS_CTL, 0, CTL_ZERO_BYTES, stream) != hipSuccess) return;
    Args a{};
    for (int i = 0; i < 24; ++i) a.in[i] = (const float*)d_in[i];
    a.out = (float*)d_out; a.ws = (unsigned char*)d_ws;
    hipLaunchKernelGGL(mk_fwd, dim3(grid), dim3(NWAVES * 64), LDS_BYTES, stream, a);
}
```

```cpp
#include <hip/hip_runtime.h>
#include <cstdio>
#include <cstdint>
namespace pg8 {
#define PG8_LAS __attribute__((address_space(3)))
typedef unsigned short bf16_t;
__device__ __forceinline__ int lane_id_opaque() { int l; asm volatile("v_mbcnt_lo_u32_b32 %0, -1, 0\n\tv_mbcnt_hi_u32_b32 %0, -1, %0" : "=v"(l)); return l; }
typedef short bf16x8 __attribute__((ext_vector_type(8)));
typedef float f32x4 __attribute__((ext_vector_type(4)));
typedef unsigned u32x4 __attribute__((ext_vector_type(4)));
constexpr int BM = 256, BK = 64, HALF = 128, HTB = HALF * BK * 2  , STAGE_BYTES = 8 * HTB, NXCD = 8, WGM = 8;

__host__ __device__ __forceinline__ int lds_byte(int r, int c) { const int st = (r >> 4) * 2 + (c >> 5), rr = r & 15, cc = c & 31, ob = rr * 64 + cc * 2; return st * 1024 + (ob ^ (((ob >> 9) & 1) << 5)); }
__host__ __device__ __forceinline__ void stage_rc(int b, int& R, int& C) { const int st = b / 1024, sb = b % 1024, swz = sb ^ (((sb >> 9) & 1) << 5); R = (st >> 1) * 16 + swz / 64; C = (st & 1) * 32 + (swz % 64) / 2; }
__host__ __device__ __forceinline__ int perm32(int rho) { const int n = rho >> 4, i = rho & 15; return 8 * (i >> 2) + 4 * n + (i & 3); }

struct Unit { int pm, pn; };
struct Gemm { const bf16_t* A; const bf16_t* Bt; int M, N, K; };

struct StaticOrder {
    int nM, nN, nwg, G, c;
    __host__ __device__ void init(int M, int N, int G_, int c_) { nM = M / BM; nN = N / BM; nwg = nM * nN; G = G_; c = c_; }
    __host__ __device__ bool next(int i, Unit& u) const {
        const long L = (long)i * G + c; if (L >= nwg) return false;
        int wgid = (int)L; { const int q = nwg / NXCD, r = nwg % NXCD, xcd = wgid % NXCD, off = wgid / NXCD; wgid = (xcd < r ? xcd * (q + 1) : r * (q + 1) + (xcd - r) * q) + off; }
        const int nig = WGM * nN, gid = wgid / nig, fm = gid * WGM, gsz = (nM - fm) < WGM ? (nM - fm) : WGM;
        u.pm = fm + ((wgid % nig) % gsz); u.pn = (wgid % nig) / gsz; return true;
    }
    __device__ __forceinline__ void a_ready(const Unit&) const {}
    __device__ __forceinline__ void done(const Unit&) const {}
};

__device__ __forceinline__ unsigned cvt_pk_bf16(float lo, float hi) { unsigned r; asm volatile("v_cvt_pk_bf16_f32 %0, %1, %2" : "=v"(r) : "v"(lo), "v"(hi)); return r; }
typedef float f32x2 __attribute__((ext_vector_type(2)));
template <class Epi, class Sched, bool ALIGN_EPI = false, bool SP2 = false, bool F8 = false>
__device__ __forceinline__ void gemm_phase(PG8_LAS unsigned char* lds, const Gemm g, const Sched& S, const Epi& E, const int wv  ) {
    int tid_ = wv * 64 + lane_id_opaque();
    const int tid = tid_, wid = __builtin_amdgcn_readfirstlane(tid >> 6), lane = tid & 63, wr = wid >> 2, wc = wid & 3, fr = lane & 15, fq = lane >> 4;
    const int K = g.K, nt = K / BK;
    unsigned voffA[2], voffB[2];
#pragma unroll
    for (int i = 0; i < 2; ++i) { int R, C; stage_rc(tid * 16 + i * 8192, R, C); const int Rb = Epi::PERM ? ((R & ~31) + perm32(R & 31)) : R;
        voffA[i] = (unsigned)(R * K + C) * 2u; voffB[i] = (unsigned)(Rb * K + C) * 2u; }
    const size_t kstep = (size_t)(BK * 2);
    const size_t hstep = (size_t)HALF * K * 2;
    const size_t tstep = 2 * hstep;
    const unsigned ldsw = (unsigned)wid * 1024u;
    const int aoff = lds_byte(wr * 64 + fr, fq * 8), boff = lds_byte(wc * 32 + fr, fq * 8);
#define PG8_SA(b, h) (((b) * 2 + (h)) * HTB)
#define PG8_SB(b, h) ((4 + (b) * 2 + (h)) * HTB)
#define PG8_STAGE(bufoff, gbase, voff) do { _Pragma("unroll") for (int _i = 0; _i < 2; ++_i) \
        __builtin_amdgcn_global_load_lds((const __attribute__((address_space(1))) unsigned*)((const __attribute__((address_space(1))) char*)(gbase) + (voff)[_i]), (PG8_LAS unsigned*)(lds + (bufoff) + ldsw + _i * 8192), 16, 0, 0); } while (0)
#define PG8_LDA(dst, b, h) do { _Pragma("unroll") for (int m = 0; m < 4; ++m) _Pragma("unroll") for (int k = 0; k < 2; ++k) dst[m][k] = *(const PG8_LAS bf16x8*)(lds + PG8_SA(b, h) + aoff + m * 2048 + k * 1024); } while (0)
#define PG8_LDB(dst, b, h) do { _Pragma("unroll") for (int n = 0; n < 2; ++n) _Pragma("unroll") for (int k = 0; k < 2; ++k) dst[n][k] = *(const PG8_LAS bf16x8*)(lds + PG8_SB(b, h) + boff + n * 2048 + k * 1024); } while (0)
#define PG8_MMA(ai, bj, At, Bt) do { if constexpr (F8) __builtin_amdgcn_sched_barrier(0); __builtin_amdgcn_s_setprio(1); _Pragma("unroll") for (int m = 0; m < 4; ++m) _Pragma("unroll") for (int n = 0; n < 2; ++n) { \
        if constexpr (F8) { typedef int i32x4_ __attribute__((ext_vector_type(4))); \
            acc[ai][bj][m][n] = __builtin_amdgcn_mfma_scale_f32_16x16x128_f8f6f4(__builtin_shufflevector(__builtin_bit_cast(i32x4_, Bt[n][0]), __builtin_bit_cast(i32x4_, Bt[n][1]), 0, 1, 2, 3, 4, 5, 6, 7), \
                __builtin_shufflevector(__builtin_bit_cast(i32x4_, At[m][0]), __builtin_bit_cast(i32x4_, At[m][1]), 0, 1, 2, 3, 4, 5, 6, 7), acc[ai][bj][m][n], 0, 0, 0, 0x7f7f7f7f, 0, 0x7f7f7f7f); } \
        else { _Pragma("unroll") for (int k = 0; k < 2; ++k) acc[ai][bj][m][n] = __builtin_amdgcn_mfma_f32_16x16x32_bf16(Bt[n][k], At[m][k], acc[ai][bj][m][n], 0, 0, 0); } } \
        __builtin_amdgcn_s_setprio(0); if constexpr (F8) __builtin_amdgcn_sched_barrier(0); } while (0)
#define PG8_WAIT_V(n) asm volatile("s_waitcnt vmcnt(" #n ")" ::: "memory")
#define PG8_WAIT_L(n) asm volatile("s_waitcnt lgkmcnt(" #n ")" ::: "memory")
#define PG8_BAR __builtin_amdgcn_s_barrier()
#define PG8_SCHED __builtin_amdgcn_sched_barrier(0)
    Unit cur, nxt; int ui = 0;
    if (!S.next(0, cur)) return;
    f32x4 acc[2][2][4][2];
#pragma unroll
    for (int a = 0; a < 2; ++a)
#pragma unroll
        for (int b = 0; b < 2; ++b)
#pragma unroll
            for (int m = 0; m < 4; ++m)
#pragma unroll
                for (int n = 0; n < 2; ++n) acc[a][b][m][n] = (f32x4){0.f, 0.f, 0.f, 0.f};
    bf16x8 At[4][2], B0[2][2], B1[2][2];
    const char* cA = (const char*)g.A + (size_t)cur.pm * tstep; const char* cB = (const char*)g.Bt + (size_t)cur.pn * tstep;
    S.a_ready(cur);
    if constexpr (SP2) {
        PG8_STAGE(PG8_SB(0, 0), cB, voffB); PG8_STAGE(PG8_SB(0, 1), cB + hstep, voffB); PG8_STAGE(PG8_SA(0, 0), cA, voffA); PG8_STAGE(PG8_SA(0, 1), cA + hstep, voffA);
        if (wr == 1) PG8_BAR;
        PG8_WAIT_V(2); PG8_BAR;
        PG8_STAGE(PG8_SB(1, 0), cB + kstep, voffB); PG8_STAGE(PG8_SA(1, 0), cA + kstep, voffA); PG8_STAGE(PG8_SB(1, 1), cB + hstep + kstep, voffB);
        PG8_WAIT_V(6); PG8_BAR;
    } else {
        PG8_STAGE(PG8_SB(0, 0), cB, voffB); PG8_STAGE(PG8_SA(0, 0), cA, voffA); PG8_STAGE(PG8_SB(0, 1), cB + hstep, voffB); PG8_STAGE(PG8_SA(0, 1), cA + hstep, voffA);
        if (wr == 1) PG8_BAR;
        PG8_WAIT_V(4); PG8_BAR;
        PG8_STAGE(PG8_SB(1, 0), cB + kstep, voffB); PG8_STAGE(PG8_SA(1, 0), cA + kstep, voffA); PG8_STAGE(PG8_SB(1, 1), cB + hstep + kstep, voffB);
        PG8_WAIT_V(6); PG8_BAR;
    }
    for (;;) {
        const bool has_next = S.next(ui + 1, nxt);
        const char* nA = has_next ? (const char*)g.A + (size_t)nxt.pm * tstep : cA; const char* nB = has_next ? (const char*)g.Bt + (size_t)nxt.pn * tstep : cB;
        for (int t = 0; t < nt; t += 2) {
            const bool last = (t == nt - 2);
            const char* a1 = cA + (size_t)(t + 1) * kstep;
            const char* a2 = last ? nA : cA + (size_t)(t + 2) * kstep; const char* b2 = last ? nB : cB + (size_t)(t + 2) * kstep;
            const char* a3 = a2 + kstep; const char* b3 = b2 + kstep;
            if (last && has_next) S.a_ready(nxt);
            if constexpr (SP2) {
            PG8_LDB(B0, 0, 0); PG8_LDB(B1, 0, 1); PG8_SCHED; PG8_LDA(At, 0, 0); PG8_STAGE(PG8_SA(1, 1), a1 + hstep, voffA);
            PG8_WAIT_V(8); PG8_WAIT_L(0); PG8_BAR; PG8_MMA(0, 0, At, B0); PG8_MMA(0, 1, At, B1); PG8_BAR; PG8_SCHED;
            PG8_LDA(At, 0, 1); PG8_STAGE(PG8_SB(0, 0), b2, voffB); PG8_STAGE(PG8_SB(0, 1), b2 + hstep, voffB); PG8_STAGE(PG8_SA(0, 0), a2, voffA);
            PG8_WAIT_V(8); PG8_WAIT_L(0); PG8_BAR; PG8_MMA(1, 0, At, B0); PG8_MMA(1, 1, At, B1); PG8_BAR; PG8_SCHED;
            PG8_LDB(B0, 1, 0); PG8_LDB(B1, 1, 1); PG8_SCHED; PG8_LDA(At, 1, 0); PG8_STAGE(PG8_SA(0, 1), a2 + hstep, voffA);
            PG8_WAIT_V(8); PG8_WAIT_L(0); PG8_BAR; PG8_MMA(0, 0, At, B0); PG8_MMA(0, 1, At, B1); PG8_BAR; PG8_SCHED;
            PG8_LDA(At, 1, 1); PG8_STAGE(PG8_SB(1, 0), b3, voffB); PG8_STAGE(PG8_SB(1, 1), b3 + hstep, voffB); PG8_STAGE(PG8_SA(1, 0), a3, voffA);
            PG8_WAIT_V(8); PG8_WAIT_L(0); PG8_BAR; PG8_MMA(1, 0, At, B0); PG8_MMA(1, 1, At, B1); PG8_BAR; PG8_SCHED;
            } else {
            PG8_LDB(B0, 0, 0); PG8_SCHED; PG8_LDA(At, 0, 0); PG8_STAGE(PG8_SA(1, 1), a1 + hstep, voffA);
            PG8_WAIT_L(8); PG8_BAR; PG8_WAIT_L(0); PG8_MMA(0, 0, At, B0); PG8_BAR; PG8_SCHED;
            PG8_LDB(B1, 0, 1); PG8_STAGE(PG8_SB(0, 0), b2, voffB);
            PG8_BAR; PG8_WAIT_L(0); PG8_MMA(0, 1, At, B1); PG8_BAR;
            PG8_LDA(At, 0, 1); PG8_STAGE(PG8_SA(0, 0), a2, voffA);
            PG8_BAR; PG8_WAIT_L(0); PG8_MMA(1, 0, At, B0); PG8_BAR; PG8_SCHED;
            PG8_STAGE(PG8_SB(0, 1), b2 + hstep, voffB);
            PG8_WAIT_V(6); PG8_BAR; PG8_MMA(1, 1, At, B1); PG8_BAR;
            PG8_LDB(B0, 1, 0); PG8_SCHED; PG8_LDA(At, 1, 0); PG8_STAGE(PG8_SA(0, 1), a2 + hstep, voffA);
            PG8_WAIT_L(8); PG8_BAR; PG8_WAIT_L(0); PG8_MMA(0, 0, At, B0); PG8_BAR; PG8_SCHED;
            PG8_LDB(B1, 1, 1); PG8_STAGE(PG8_SB(1, 0), b3, voffB);
            PG8_BAR; PG8_WAIT_L(0); PG8_MMA(0, 1, At, B1); PG8_BAR;
            PG8_LDA(At, 1, 1); PG8_STAGE(PG8_SA(1, 0), a3, voffA);
            PG8_BAR; PG8_WAIT_L(0); PG8_MMA(1, 0, At, B0); PG8_BAR; PG8_SCHED;
            PG8_STAGE(PG8_SB(1, 1), b3 + hstep, voffB);
            PG8_WAIT_V(6); PG8_BAR; PG8_MMA(1, 1, At, B1); PG8_BAR;
            }
        }
        if constexpr (ALIGN_EPI) { if (wr == 0) PG8_BAR; }
        if constexpr (!Epi::AFTER_DRAIN) { const int t2_ = lane_id_opaque(); const int fr_ = t2_ & 15, fq_ = (t2_ & 63) >> 4;
            E(acc, cur, wr, wc, fr_, fq_); S.done(cur); }
        if (!has_next) break;
#pragma unroll
        for (int a = 0; a < 2; ++a)
#pragma unroll
            for (int b = 0; b < 2; ++b)
#pragma unroll
                for (int m = 0; m < 4; ++m)
#pragma unroll
                    for (int n = 0; n < 2; ++n) acc[a][b][m][n] = (f32x4){0.f, 0.f, 0.f, 0.f};
        cur = nxt; cA = nA; cB = nB; ++ui;
        if constexpr (ALIGN_EPI) { if (wr == 1) PG8_BAR; }
    }
    PG8_WAIT_V(0);
    if constexpr (!ALIGN_EPI) { if (wr == 0) PG8_BAR; }
    PG8_BAR;
    if constexpr (Epi::AFTER_DRAIN) { E.fused(acc, cur, wr, wc, fr, fq, lds, wid, lane); S.done(cur); }
#undef PG8_SA
#undef PG8_SB
#undef PG8_STAGE
#undef PG8_LDA
#undef PG8_LDB
#undef PG8_MMA
#undef PG8_WAIT_V
#undef PG8_WAIT_L
#undef PG8_BAR
#undef PG8_SCHED
}
}
#define GAS __attribute__((address_space(1)))
#define LAS __attribute__((address_space(3)))
typedef unsigned short bf16;
typedef unsigned v4u __attribute__((ext_vector_type(4)));
typedef float f32x4 __attribute__((ext_vector_type(4)));
typedef short bf16x8 __attribute__((ext_vector_type(8)));
typedef GAS unsigned gu32;
typedef GAS unsigned long long gu64;
#define RLX_AGENT __ATOMIC_RELAXED, __HIP_MEMORY_SCOPE_AGENT
#define LDS_WAIT() asm volatile("s_waitcnt lgkmcnt(0)" ::: "memory")
#define VM_WAIT() asm volatile("s_waitcnt vmcnt(0)" ::: "memory")
__device__ __forceinline__ unsigned long long rt() { return __builtin_amdgcn_s_memrealtime(); }
__device__ __forceinline__ unsigned f2bf(float f) { unsigned u = __builtin_bit_cast(unsigned, f); return (u + 0x7fffu + ((u >> 16) & 1u)) >> 16; }
__device__ __forceinline__ unsigned pk2(float lo, float hi) { return f2bf(lo) | (f2bf(hi) << 16); }

#define XB_TMO      128
#define XB_XCNT(j)  (256  + 64 * (j))
#define XB_XSUB(j)  (1280 + 64 * (j))
#define XB_XGEN(j)  (2304 + 64 * (j))
#define XB_TOP      3328
#define XB_TOPGEN   3392
#define XCD_BAR_WORDS 3456
#define XB_SPIN_CAP (1u << 18)

__device__ __forceinline__ unsigned xb_ld(unsigned* p)              { return __hip_atomic_load(p, __ATOMIC_RELAXED, __HIP_MEMORY_SCOPE_AGENT); }
__device__ __forceinline__ unsigned xb_add(unsigned* p, unsigned v) { return __hip_atomic_fetch_add(p, v, __ATOMIC_RELAXED, __HIP_MEMORY_SCOPE_AGENT); }
__device__ __forceinline__ unsigned xb_xcc_id() { return (unsigned)__builtin_amdgcn_s_getreg((3 << 11) | 20) & 0xFu; }
#define XB_SPIN(cond, bar) do { unsigned _sp = 0; while (cond) { __builtin_amdgcn_s_sleep(1); \
    if ((++_sp & 255u) == 0u) { if (xb_ld(&(bar)[XB_TMO])) break; if (_sp > XB_SPIN_CAP) { atomicAdd(&(bar)[XB_TMO], 1u); break; } } } } while (0)

struct XcdBarrier {
    unsigned* bar; unsigned x;
    volatile LAS unsigned* st;
};

__device__ __forceinline__ XcdBarrier xcd_barrier_post(unsigned* bar, volatile LAS unsigned* st) {
    XcdBarrier b; b.bar = bar; b.x = xb_xcc_id(); b.st = st;
    if (threadIdx.x == 0) (void)xb_add(&bar[XB_XCNT(b.x)], 1u);
    return b;
}
__device__ __forceinline__ void xcd_barrier_complete(unsigned* bar, unsigned x, unsigned& nloc, unsigned& nx) {
    const unsigned G = gridDim.x * gridDim.y * gridDim.z;
    unsigned sum, cnt, mine, sp = 0u;
    for (;;) {
        sum = 0u; cnt = 0u; mine = 0u;
#pragma unroll
        for (unsigned j = 0; j < 16; ++j) { const unsigned c = xb_ld(&bar[XB_XCNT(j)]); sum += c; cnt += (c > 0u) ? 1u : 0u; mine = (j == x) ? c : mine; }
        if (sum == G) break;
        __builtin_amdgcn_s_sleep(1);
        if ((++sp & 255u) == 0u) { if (xb_ld(&bar[XB_TMO])) break; if (sp > XB_SPIN_CAP) { atomicAdd(&bar[XB_TMO], 1u); break; } }
    }
    nloc = mine > 0u ? mine : 1u; nx = cnt > 0u ? cnt : 1u;
}

__device__ __forceinline__ void xcd_barrier(const XcdBarrier& b, const bool leader  ) {
    asm volatile("s_waitcnt vmcnt(0)" ::: "memory");
    __syncthreads();
    if (leader) {
        unsigned* bar = b.bar; asm volatile("" : "+s"(bar));
        __builtin_amdgcn_s_waitcnt(0);
        unsigned nloc = b.st[0], nx = b.st[1];
        if (nloc == 0u) { xcd_barrier_complete(bar, b.x, nloc, nx); b.st[0] = nloc; b.st[1] = nx; }
        const unsigned old = xb_add(&bar[XB_XSUB(b.x)], 1u);
        const unsigned gen = old / nloc;
        if (old + 1u == (gen + 1u) * nloc) {
            __builtin_amdgcn_fence(__ATOMIC_RELEASE, "agent");
            asm volatile("s_waitcnt vmcnt(0)" ::: "memory");
            const unsigned og = xb_add(&bar[XB_TOP], 1u);
            const unsigned tg = og / nx;
            if (og + 1u == (tg + 1u) * nx) xb_add(&bar[XB_TOPGEN], 1u);
            else XB_SPIN(xb_ld(&bar[XB_TOPGEN]) == tg, bar);
            __builtin_amdgcn_fence(__ATOMIC_ACQUIRE, "agent");
            xb_add(&bar[XB_XGEN(b.x)], 1u);
            asm volatile("s_waitcnt vmcnt(0)" ::: "memory");
        } else {
            XB_SPIN(xb_ld(&bar[XB_XGEN(b.x)]) == gen, bar);
            __builtin_amdgcn_fence(__ATOMIC_ACQUIRE, "agent");
            asm volatile("s_waitcnt vmcnt(0)" ::: "memory");
        }
    }
    __syncthreads();
}

#ifndef FFN_F8
#define FFN_F8 1
#endif
constexpr int NWAVES = 8;
constexpr float W8S = 32.f, U8S = 4.f;
constexpr int DM = 1024, NBATCH = 16, SEQ = 2048, CTX = 256, TPB = SEQ + CTX, M = NBATCH * TPB;
constexpr int DEPTH = 4, NIN = 3104, NP = 3328, DFF = 2816, NE = 8;
constexpr int MP = 2 * M + NE * 256;
constexpr int C_Q = 0, C_K = 512, C_V = 1024, C_GQ = 1536, C_GK = 1792, C_GV = 2048, C_GG = 2560, C_GLR = 3072;
constexpr float EPS = 1e-6f;
constexpr float C2 = 0.125f * 1.4426950408889634f;
constexpr int NCH = TPB / 64;
constexpr int NGLA = NBATCH * 4 * 2 * NCH;

constexpr size_t MiB = 1u << 20;
constexpr size_t WS_CTL = 0, CTL_ZERO_BYTES = 1 * MiB;
constexpr size_t WS_MOD = 1 * MiB;
constexpr size_t WS_ROPE = 3 * MiB;
constexpr size_t WS_TOPE = 4 * MiB;
constexpr size_t WS_LIDX = WS_TOPE + 160 * 1024;
constexpr size_t WS_TOPW = WS_LIDX + 320 * 1024;
constexpr size_t WS_BLKB = WS_TOPW + 320 * 1024;
constexpr size_t WS_RMAP = WS_BLKB + 64 * 1024;
constexpr size_t WS_ROWW = WS_RMAP + 320 * 1024;
static_assert(WS_ROWW + 320 * 1024 <= 6 * MiB, "small tables");
constexpr size_t WS_X = 6 * MiB;
constexpr size_t WS_WIN = 150 * MiB;
constexpr size_t WS_WOUT = WS_WIN + 13 * MiB / 2;
constexpr size_t WS_WUP = WS_WOUT + 2 * MiB;
constexpr size_t WS_WDN = WS_WUP + 88 * MiB;
constexpr size_t WS_D = 291 * MiB;
static_assert(WS_WDN + 44 * MiB <= WS_D, "weights");
constexpr size_t WS_PROJ = WS_D;
constexpr size_t WS_OD = WS_D + 234 * MiB;
constexpr size_t WS_DS = WS_D + 306 * MiB;
constexpr size_t WS_DEC = WS_D + 450 * MiB;
constexpr size_t WS_H = WS_D + 452 * MiB;
constexpr size_t WS_Y = WS_D;
constexpr size_t WS_HG = WS_D;
constexpr size_t WS_F2 = WS_D;
constexpr size_t WS_U = WS_D + 148 * MiB;
constexpr size_t WS_H2 = WS_D + 483 * MiB;
constexpr size_t WS_END = WS_D + 555 * MiB;
static_assert((size_t)MP * DFF * 2 <= 407 * MiB && (size_t)MP * DM * 2 <= 148 * MiB && (size_t)M * NP * 2 <= 234 * MiB, "dynamic map");
static_assert((size_t)M * DFF * 2 + 148 * MiB <= 483 * MiB, "dense U clear of H2");

constexpr int CW_BAR = 4096;
constexpr int CW_CNT = 8192;

constexpr int RING_BYTES = 131072;
constexpr int TEXP_OFF = 139264;
constexpr int MISC_OFF = 146432 - 512;
constexpr int LDS_BYTES = 147456;

typedef unsigned u32x2 __attribute__((ext_vector_type(2)));

__device__ __forceinline__ float bf2f(unsigned short x) { return __uint_as_float((unsigned)x << 16); }
__device__ __forceinline__ float bflo(unsigned w) { return __uint_as_float(w << 16); }
__device__ __forceinline__ float bfhi(unsigned w) { return __uint_as_float(w & 0xffff0000u); }
__device__ __forceinline__ float siluf(float x) { return x * __builtin_amdgcn_rcpf(1.f + __expf(-x)); }
__device__ __forceinline__ float clamp8(float x) { return fminf(fmaxf(x, -448.f), 448.f); }
__device__ __forceinline__ unsigned pk4_f8(float a, float b, float c, float d) { unsigned w = 0u; w = __builtin_amdgcn_cvt_pk_fp8_f32(clamp8(a), clamp8(b), w, false); w = __builtin_amdgcn_cvt_pk_fp8_f32(clamp8(c), clamp8(d), w, true); return w; }
template <int MASK> __device__ __forceinline__ float xadd(float v) {
    if constexpr (MASK == 32) { const auto rr = __builtin_amdgcn_permlane32_swap(__float_as_uint(v), __float_as_uint(v), false, false); return __uint_as_float(rr[0]) + __uint_as_float(rr[1]); }
    else return v + __int_as_float(__builtin_amdgcn_ds_swizzle(__float_as_int(v), 0x1f | (MASK << 10)));
}
__device__ __forceinline__ float wave_sum(float v) {
    v = xadd<1>(v); v = xadd<2>(v); v = xadd<4>(v); v = xadd<8>(v); v = xadd<16>(v); v = xadd<32>(v);
    return v;
}

struct Args { const float* in[24]; float* out; unsigned char* ws; };
struct Frame {
    LAS unsigned char* lds;
    volatile LAS unsigned* MISC;
    int tid, lane, wave, G, blk, gw, NGW, z, wv;
    const Args* A;
    unsigned char* ws;
};


__device__ __forceinline__ void refresh(Frame& F) {
    int wv = F.wv; asm volatile("" : "+s"(wv));
    const int t = wv * 64 + pg8::lane_id_opaque();
    int bl = blockIdx.x, z = 0, gg = gridDim.x; asm volatile("" : "+s"(bl), "+s"(z), "+s"(gg));
    F.blk = bl; F.z = z; F.G = gg; F.NGW = gg * NWAVES;
    F.tid = t; F.lane = t & 63; F.wave = wv; F.gw = F.blk * NWAVES + F.wave;
}
#define INP(k) (F.A->in[(k) + F.z])
namespace pg8 {
struct EpiProj {
    static constexpr bool PERM = true, AFTER_DRAIN = false;
    bf16_t* P; const float* ropec; const float* ropes; unsigned* kmx;
    __device__ __forceinline__ void operator()(const f32x4 (&acc)[2][2][4][2], const Unit& u, int wr, int wc, int fr, int fq) const {
        const int pn = u.pn, pm = u.pm, tb = pm % 9;
        float kss[2] = {0.f, 0.f};
        const bool do_rope = (tb != 0) && (pn < 4);
        const float sc = (pn < 2) ? C2 : (pn == 6 ? 0.125f : 1.f);
        const bool st_ok_all = pn < 12;
#pragma unroll
        for (int ai = 0; ai < 2; ++ai)
#pragma unroll
            for (int m = 0; m < 4; ++m) {
                const int rit = ai * HALF + wr * 64 + m * 16 + fr;
                bf16_t* rowp = P + ((size_t)pm * BM + rit) * NP + pn * BM + wc * 32 + 8 * fq;
                const int s = (tb - 1) * 256 + rit;
                const int pos = (wc & 1) ? (s & 63) : (s >> 6);
                f32x4 cs = {1.f, 1.f, 1.f, 1.f}, sn = {0.f, 0.f, 0.f, 0.f};
                if (do_rope) { cs = *(const f32x4*)(ropec + pos * 16 + 4 * fq); sn = *(const f32x4*)(ropes + pos * 16 + 4 * fq); }
#pragma unroll
                for (int bj = 0; bj < 2; ++bj) {
                    f32x4 v0 = acc[ai][bj][m][0], v1 = acc[ai][bj][m][1];
                    if (do_rope) { const f32x4 a = v0 * cs - v1 * sn, b = v0 * sn + v1 * cs; v0 = a; v1 = b; }
                    v0 = v0 * sc; v1 = v1 * sc;
                    if (pn == 2 || pn == 3) { float ss = (v0[0] * v0[0] + v0[1] * v0[1]) + (v0[2] * v0[2] + v0[3] * v0[3]) + (v1[0] * v1[0] + v1[1] * v1[1]) + (v1[2] * v1[2] + v1[3] * v1[3]);
                        ss = xadd<16>(ss); ss = xadd<32>(ss); kss[bj] = fmaxf(kss[bj], ss); }
                    if (st_ok_all || (bj == 0 && wc == 0)) {
                        u32x4 w; w.x = cvt_pk_bf16(v0[0], v0[1]); w.y = cvt_pk_bf16(v0[2], v0[3]); w.z = cvt_pk_bf16(v1[0], v1[1]); w.w = cvt_pk_bf16(v1[2], v1[3]);
                        *(u32x4*)(rowp + bj * HALF) = w;
                    }
                }
            }
        if (pn == 2 || pn == 3) {
#pragma unroll
            for (int bj = 0; bj < 2; ++bj) { float v = kss[bj];
                v = fmaxf(v, __int_as_float(__builtin_amdgcn_update_dpp(0, __float_as_int(v), 0xB1, 0xF, 0xF, true)));
                v = fmaxf(v, __int_as_float(__builtin_amdgcn_update_dpp(0, __float_as_int(v), 0x4E, 0xF, 0xF, true)));
                v = fmaxf(v, __int_as_float(__builtin_amdgcn_update_dpp(0, __float_as_int(v), 0x141, 0xF, 0xF, true)));
                v = fmaxf(v, __int_as_float(__builtin_amdgcn_update_dpp(0, __float_as_int(v), 0x140, 0xF, 0xF, true)));
                if (fr == 0 && fq == 0) { const int hh = (pn - 2) * 4 + bj * 2 + (wc >> 1);
                    __hip_atomic_fetch_max(kmx + (((pm / 9) * 8 + hh) * 2 + (wc & 1)), __float_as_uint(v), __ATOMIC_RELAXED, __HIP_MEMORY_SCOPE_AGENT); } }
        }
    }
};
struct EpiF32 {
    static constexpr bool PERM = true, AFTER_DRAIN = false;
    bf16_t* Y;
    __device__ __forceinline__ void operator()(const f32x4 (&acc)[2][2][4][2], const Unit& u, int wr, int wc, int fr, int fq) const {
#pragma unroll
        for (int ai = 0; ai < 2; ++ai)
#pragma unroll
            for (int m = 0; m < 4; ++m) {
                bf16_t* rowp = Y + ((size_t)u.pm * BM + ai * HALF + wr * 64 + m * 16 + fr) * DM + u.pn * BM + wc * 32 + 8 * fq;
#pragma unroll
                for (int bj = 0; bj < 2; ++bj) { const f32x4 v0 = acc[ai][bj][m][0], v1 = acc[ai][bj][m][1];
                    u32x4 w; w.x = cvt_pk_bf16(v0[0], v0[1]); w.y = cvt_pk_bf16(v0[2], v0[3]); w.z = cvt_pk_bf16(v1[0], v1[1]); w.w = cvt_pk_bf16(v1[2], v1[3]);
                    *(u32x4*)(rowp + bj * HALF) = w; }
            }
    }
};
struct EpiSwiglu {
    static constexpr bool PERM = true, AFTER_DRAIN = false;
    bf16_t* U;
    __device__ __forceinline__ void operator()(const f32x4 (&acc)[2][2][4][2], const Unit& u, int wr, int wc, int fr, int fq) const {
        const int pnl = u.pn % 22;
        const int col0 = pnl * 128 + wc * 32 + 8 * fq;
        constexpr float ws = FFN_F8 ? 1.f / W8S : 1.f, us = FFN_F8 ? U8S : 1.f, kS = ws * ws * us, kE = -ws * 1.4426950408889634f;
        const float cE = -__builtin_log2f(kS), c1 = 1.f / kS;
#pragma unroll
        for (int ai = 0; ai < 2; ++ai)
#pragma unroll
            for (int m = 0; m < 4; ++m) {
                const size_t rowi = (size_t)u.pm * BM + ai * HALF + wr * 64 + m * 16 + fr;
                f32x2 g[4], up[4], t[4], r[4];
#pragma unroll
                for (int n = 0; n < 2; ++n) { g[2 * n] = (f32x2){acc[ai][0][m][n][0], acc[ai][0][m][n][1]}; g[2 * n + 1] = (f32x2){acc[ai][0][m][n][2], acc[ai][0][m][n][3]};
                                              up[2 * n] = (f32x2){acc[ai][1][m][n][0], acc[ai][1][m][n][1]}; up[2 * n + 1] = (f32x2){acc[ai][1][m][n][2], acc[ai][1][m][n][3]}; }
#pragma unroll
                for (int q = 0; q < 4; ++q) t[q] = g[q] * kE + cE;
#pragma unroll
                for (int q = 0; q < 4; ++q) { t[q].x = __builtin_amdgcn_exp2f(t[q].x); t[q].y = __builtin_amdgcn_exp2f(t[q].y); }
#pragma unroll
                for (int q = 0; q < 4; ++q) t[q] = t[q] + c1;
#pragma unroll
                for (int q = 0; q < 4; ++q) { r[q].x = __builtin_amdgcn_rcpf(t[q].x); r[q].y = __builtin_amdgcn_rcpf(t[q].y); }
#pragma unroll
                for (int q = 0; q < 4; ++q) g[q] = (g[q] * up[q]) * r[q];
                if constexpr (FFN_F8) { u32x2 w; w.x = pk4_f8(g[0].x, g[0].y, g[1].x, g[1].y); w.y = pk4_f8(g[2].x, g[2].y, g[3].x, g[3].y); *(u32x2*)((unsigned char*)U + rowi * DFF + col0) = w; }
                else { u32x4 w; w.x = cvt_pk_bf16(g[0].x, g[0].y); w.y = cvt_pk_bf16(g[1].x, g[1].y); w.z = cvt_pk_bf16(g[2].x, g[2].y); w.w = cvt_pk_bf16(g[3].x, g[3].y); *(u32x4*)(U + rowi * DFF + col0) = w; }
            }
    }
};
struct EpiDown {
    static constexpr bool PERM = true, AFTER_DRAIN = false;
    bf16_t* F2; const int* rmap; const float* roww; int dense;
    __device__ __forceinline__ void operator()(const f32x4 (&acc)[2][2][4][2], const Unit& u, int wr, int wc, int fr, int fq) const {
        const int pnl = u.pn & 3;
        const int col0 = pnl * BM + wc * 32 + 8 * fq;
        const __amdgpu_buffer_rsrc_t rsF = __builtin_amdgcn_make_buffer_rsrc((void*)F2, 0, 2 * M * DM * 2, 0x00020000);
        const __amdgpu_buffer_rsrc_t rsM = __builtin_amdgcn_make_buffer_rsrc((void*)rmap, 0, MP * 4, 0x00020000);
        const __amdgpu_buffer_rsrc_t rsW = __builtin_amdgcn_make_buffer_rsrc((void*)roww, 0, MP * 4, 0x00020000);
#pragma unroll
        for (int ai = 0; ai < 2; ++ai)
#pragma unroll
            for (int m = 0; m < 4; ++m) {
                const int grow = u.pm * BM + ai * HALF + wr * 64 + m * 16 + fr;
                int tok = grow, slot = 0; float w = 1.f; bool ok = true;
                if (!dense) { const int rm = (int)__builtin_amdgcn_raw_buffer_load_b32(rsM, grow * 4, 0, 0); ok = rm >= 0; tok = rm & 0x3fffffff; slot = (rm >> 30) & 1; w = __uint_as_float(__builtin_amdgcn_raw_buffer_load_b32(rsW, grow * 4, 0, 0)); }
                if constexpr (FFN_F8) w *= 1.f / (W8S * U8S);
                if (ok) {
                    const int bo = ((slot * M + tok) * DM + col0) * 2;
#pragma unroll
                    for (int bj = 0; bj < 2; ++bj) {
                        const f32x4 v0 = acc[ai][bj][m][0] * w, v1 = acc[ai][bj][m][1] * w;
                        u32x4 q; q.x = cvt_pk_bf16(v0[0], v0[1]); q.y = cvt_pk_bf16(v0[2], v0[3]); q.z = cvt_pk_bf16(v1[0], v1[1]); q.w = cvt_pk_bf16(v1[2], v1[3]);
                        __builtin_amdgcn_raw_buffer_store_b128(q, rsF, bo + bj * HALF * 2, 0, 0);
                    }
                }
            }
    }
};
struct GroupedOrder {
    StaticOrder S; const PG8_LAS int* texp; int nN;
    __device__ __forceinline__ bool next(int i, Unit& u) const { if (!S.next(i, u)) return false; u.pn += __builtin_amdgcn_readfirstlane(texp[u.pm]) * nN; return true; }
    __device__ __forceinline__ void a_ready(const Unit&) const {}
    __device__ __forceinline__ void done(const Unit&) const {}
};
struct LatOrder {
    StaticOrder S; int lat;
    __device__ __forceinline__ bool next(int i, Unit& u) const { if (!S.next(i, u)) return false; if (lat) u.pm += (u.pm >> 3) + 1; return true; }
    __device__ __forceinline__ void a_ready(const Unit&) const {}
    __device__ __forceinline__ void done(const Unit&) const {}
};
}

__device__ __forceinline__ void ld_row_f32(const float* row, int lane, f32x4 (&v)[4]) {
#pragma unroll
    for (int j = 0; j < 4; ++j) v[j] = *(const f32x4*)(row + 4 * lane + 256 * j);
}
__device__ __forceinline__ void st_row_f32(float* row, int lane, const f32x4 (&v)[4]) {
#pragma unroll
    for (int j = 0; j < 4; ++j) *(f32x4*)(row + 4 * lane + 256 * j) = v[j];
}
__device__ __forceinline__ void ld_row_bf16(const bf16* row, int lane, f32x4 (&v)[4]) {
#pragma unroll
    for (int j = 0; j < 4; ++j) { const u32x2 w = *(const u32x2*)(row + 4 * lane + 256 * j); v[j] = (f32x4){bflo(w.x), bfhi(w.x), bflo(w.y), bfhi(w.y)}; }
}
__device__ __forceinline__ void st_row_bf16(bf16* row, int lane, const f32x4 (&v)[4]) {
#pragma unroll
    for (int j = 0; j < 4; ++j) { u32x2 w; w.x = pg8::cvt_pk_bf16(v[j][0], v[j][1]); w.y = pg8::cvt_pk_bf16(v[j][2], v[j][3]); *(u32x2*)(row + 4 * lane + 256 * j) = w; }
}
__device__ __forceinline__ float row_rinv(const f32x4 (&v)[4]) {
    float s = 0.f;
#pragma unroll
    for (int j = 0; j < 4; ++j) s += (v[j][0] * v[j][0] + v[j][1] * v[j][1]) + (v[j][2] * v[j][2] + v[j][3] * v[j][3]);
    return 1.0f / sqrtf(wave_sum(s) * (1.f / DM) + EPS);
}

__device__ __forceinline__ void transpose_tile(const float* W, int N, int k0, int n0, bf16* WT, int K, int drow0, LAS float* scr, int lane, bool ropeperm = false) {
#pragma unroll 8
    for (int i = 0; i < 32; ++i) { const int kk = 2 * i + (lane >> 5); scr[kk * 33 + (lane & 31)] = __builtin_nontemporal_load(&W[(size_t)(k0 + kk) * N + n0 + (lane & 31)]); }
    LDS_WAIT(); asm volatile("" ::: "memory");
    const int c = lane & 7;
#pragma unroll
    for (int j = 0; j < 4; ++j) { const int n = (lane >> 3) + 8 * j; const LAS float* s = scr + (8 * c) * 33 + n;
        v4u o; o.x = pk2(s[0 * 33], s[1 * 33]); o.y = pk2(s[2 * 33], s[3 * 33]); o.z = pk2(s[4 * 33], s[5 * 33]); o.w = pk2(s[6 * 33], s[7 * 33]);
        const int nd = ropeperm ? (8 * ((n >> 2) & 3) + 4 * (n >> 4) + (n & 3)) : n;
        *(GAS v4u*)(WT + (size_t)(drow0 + nd) * K + k0 + 8 * c) = o; }
    LDS_WAIT(); asm volatile("" ::: "memory");
}
__device__ __forceinline__ void transpose_tile_f8(const float* W, int N, int k0, int n0, unsigned char* WT, int Kb, int drow0, LAS float* scr, int lane, float scale) {
#pragma unroll 8
    for (int i = 0; i < 32; ++i) { const int kk = 2 * i + (lane >> 5); scr[kk * 33 + (lane & 31)] = __builtin_nontemporal_load(&W[(size_t)(k0 + kk) * N + n0 + (lane & 31)]); }
    LDS_WAIT(); asm volatile("" ::: "memory");
    const int n = lane >> 1, hf = lane & 1; const LAS float* s = scr + (hf * 32) * 33 + n;
    v4u o0, o1;
    o0.x = pk4_f8(s[0 * 33] * scale, s[1 * 33] * scale, s[2 * 33] * scale, s[3 * 33] * scale);     o0.y = pk4_f8(s[4 * 33] * scale, s[5 * 33] * scale, s[6 * 33] * scale, s[7 * 33] * scale);
    o0.z = pk4_f8(s[8 * 33] * scale, s[9 * 33] * scale, s[10 * 33] * scale, s[11 * 33] * scale);   o0.w = pk4_f8(s[12 * 33] * scale, s[13 * 33] * scale, s[14 * 33] * scale, s[15 * 33] * scale);
    o1.x = pk4_f8(s[16 * 33] * scale, s[17 * 33] * scale, s[18 * 33] * scale, s[19 * 33] * scale); o1.y = pk4_f8(s[20 * 33] * scale, s[21 * 33] * scale, s[22 * 33] * scale, s[23 * 33] * scale);
    o1.z = pk4_f8(s[24 * 33] * scale, s[25 * 33] * scale, s[26 * 33] * scale, s[27 * 33] * scale); o1.w = pk4_f8(s[28 * 33] * scale, s[29 * 33] * scale, s[30 * 33] * scale, s[31 * 33] * scale);
    GAS v4u* dst = (GAS v4u*)(WT + (size_t)(drow0 + n) * Kb + k0 + hf * 32);
    dst[0] = o0; dst[1] = o1;
    LDS_WAIT(); asm volatile("" ::: "memory");
}
__device__ __forceinline__ void convert_weights(Frame& F, int l) {
    refresh(F);
    const bool moe = l & 1; const int ne = moe ? NE : 1, li = l >> 1;
    const float* w1 = moe ? INP(21) + (size_t)li * NE * DM * DFF : INP(17) + (size_t)li * DM * DFF;
    const float* w3 = moe ? INP(22) + (size_t)li * NE * DM * DFF : INP(18) + (size_t)li * DM * DFF;
    const float* w2 = moe ? INP(23) + (size_t)li * NE * DM * DFF : INP(19) + (size_t)li * DM * DFF;
    const float* win = INP(10) + (size_t)l * DM * NIN;
    const float* wout = INP(16) + (size_t)l * DM * DM;
    bf16* WIN = (bf16*)(F.ws + WS_WIN); bf16* WOUT = (bf16*)(F.ws + WS_WOUT); bf16* WUP = (bf16*)(F.ws + WS_WUP); bf16* WDN = (bf16*)(F.ws + WS_WDN);
    LAS float* scr = (LAS float*)(F.lds + F.wave * 16384);
    const int nA = 16 * 97, nZ = NP - NIN, nB = 16 * 32, nC1 = 16 * 88, nD1 = 44 * 32;
    const int nC = ne * 2 * nC1, nD = ne * nD1, total = nA + nZ + nB + nC + nD;
    for (int it = F.gw; it < total; it += F.NGW) {
        int r = it;
        if (r < nA) { const int kb = r / 97, nb = r % 97; transpose_tile(win, NIN, 64 * kb, 32 * nb, WIN, DM, 32 * nb, scr, F.lane, nb < 32  ); continue; } r -= nA;
        if (r < nZ) { const unsigned zz = (unsigned)F.z; v4u z = {zz, zz, zz, zz}; GAS v4u* p = (GAS v4u*)(WIN + (size_t)(NIN + r) * DM) + F.lane * 2; p[0] = z; p[1] = z; continue; } r -= nZ;
        if (r < nB) { const int kb = r / 32, nb = r % 32; transpose_tile(wout, DM, 64 * kb, 32 * nb, WOUT, DM, 32 * nb, scr, F.lane); continue; } r -= nB;
        if (r < nC) { const int e = r / (2 * nC1), q = r % (2 * nC1), which = q / nC1, t = q % nC1, kb = t / 88, nb = t % 88, n0 = 32 * nb;
            const float* src = (which ? w3 : w1) + (size_t)e * DM * DFF;
            if constexpr (FFN_F8) transpose_tile_f8(src, DFF, 64 * kb, n0, (unsigned char*)WUP, DM, e * 5632 + (n0 / 128) * 256 + (n0 % 128) + which * 128, scr, F.lane, W8S);
            else transpose_tile(src, DFF, 64 * kb, n0, WUP, DM, e * 5632 + (n0 / 128) * 256 + (n0 % 128) + which * 128, scr, F.lane); continue; } r -= nC;
        { const int e = r / nD1, t = r % nD1, kb = t / 32, nb = t % 32;
            if constexpr (FFN_F8) transpose_tile_f8(w2 + (size_t)e * DFF * DM, DM, 64 * kb, 32 * nb, (unsigned char*)WDN + (size_t)e * DM * DFF, DFF, 32 * nb, scr, F.lane, W8S);
            else transpose_tile(w2 + (size_t)e * DFF * DM, DM, 64 * kb, 32 * nb, WDN + (size_t)e * DM * DFF, DFF, 32 * nb, scr, F.lane); }
    }
}

__device__ __forceinline__ void p0_mod(Frame& F) {
    refresh(F);
    LAS float* S = (LAS float*)(F.lds);
    LAS float* R = (LAS float*)(F.lds + 69632);
    const float* c = INP(1); const float* cc = INP(3); const float* wmod = INP(4); const float* bmod = INP(5);
    float* MOD = (float*)(F.ws + WS_MOD);
    for (int i = F.tid; i < 17 * 1024; i += 512) { const int b = i >> 10, k = i & 1023; const float v = b < 16 ? c[b * 1024 + k] : cc[k]; S[i] = siluf(v); }
    __syncthreads();
    const int kq = F.lane >> 4, c4 = (F.lane & 15) * 4;
    for (int item = F.blk; item < 4 * 96; item += F.G) {
        const int l = item / 96, col0 = (item % 96) * 64;
        const float* W = wmod + (size_t)l * DM * 6144;
        float acc[17][4];
#pragma unroll
        for (int b = 0; b < 17; ++b)
#pragma unroll
            for (int j = 0; j < 4; ++j) acc[b][j] = 0.f;
        for (int it = 0; it < 32; ++it) {
            const int k = F.wave * 128 + it * 4 + kq;
            const f32x4 w = *(const f32x4*)(W + (size_t)k * 6144 + col0 + c4);
#pragma unroll
            for (int b = 0; b < 17; ++b) { const float s = S[b * 1024 + k];
#pragma unroll
                for (int j = 0; j < 4; ++j) acc[b][j] += s * w[j]; }
        }
#pragma unroll
        for (int b = 0; b < 17; ++b)
#pragma unroll
            for (int j = 0; j < 4; ++j) { float v = acc[b][j]; v = xadd<16>(v); v = xadd<32>(v); acc[b][j] = v; }
        if (kq == 0) {
#pragma unroll
            for (int b = 0; b < 17; ++b)
#pragma unroll
                for (int j = 0; j < 4; ++j) R[(F.wave * 17 + b) * 64 + c4 + j] = acc[b][j];
        }
        __syncthreads();
        for (int o = F.tid; o < 17 * 64; o += 512) { const int b = o >> 6, ccx = o & 63; float s = bmod[l * 6144 + col0 + ccx];
            for (int w = 0; w < 8; ++w) s += R[(w * 17 + b) * 64 + ccx];
            MOD[((size_t)l * 17 + b) * 6144 + col0 + ccx] = s; }
        __syncthreads();
    }
}
__device__ __forceinline__ float lam_init_of(int l) { return 0.8f - 0.6f * expf(-0.3f * (float)l); }
__device__ __forceinline__ void p0_misc(Frame& F) {
    refresh(F);
    float* ropec = (float*)(F.ws + WS_ROPE); float* ropes = ropec + 1024; float* lam = (float*)(F.ws + WS_ROPE + 16384);
    if (F.blk == 0) {
        for (int i = F.tid; i < 1024; i += 512) { const int pos = i >> 4, f = i & 15; const float inv = powf(10000.f, -(float)f / 16.f); const float ang = (float)pos * inv; ropec[i] = cosf(ang); ropes[i] = sinf(ang); }
    }
    if (F.blk == (1 % F.G) && F.wave < 4) {
        const int l = F.wave; const float* lv = INP(13) + l * 256;
        const float a = wave_sum(lv[F.lane] * lv[64 + F.lane]), b = wave_sum(lv[128 + F.lane] * lv[192 + F.lane]);
        if (F.lane == 0) lam[l] = expf(a) - expf(b) + lam_init_of(l);
    }
}

namespace att {
using bf16x8 = __attribute__((ext_vector_type(8))) short;
using s16x4  = __attribute__((ext_vector_type(4))) short;
using f32x16 = __attribute__((ext_vector_type(16))) float;
using u32x4  = __attribute__((ext_vector_type(4))) unsigned;
constexpr int QBLK = 32, KVBLK = 64, NW = 8, DV = 128;
constexpr float THR = 8.f;
constexpr size_t SHM_V = KVBLK * DV * 2, SHM_K = KVBLK * 64 * 2, SHM_ATTN = 2 * SHM_V + 2 * SHM_K + NW * 64 * 4;
#define KSWZ64(row, colB) ((row) * 128 + ((colB) ^ ((((row) >> 1) & 7) << 4)))
#define SBAR() __builtin_amdgcn_sched_barrier(0)
__device__ __forceinline__ int crow(int r, int hi) { return (r & 3) + 8 * (r >> 2) + 4 * hi; }
__device__ __forceinline__ unsigned cvtpk(float lo, float hi) { unsigned r; asm volatile("v_cvt_pk_bf16_f32 %0, %1, %2" : "=v"(r) : "v"(lo), "v"(hi)); return r; }
__device__ __forceinline__ void partialSM(f32x16& p0, f32x16& p1, float& m_reg, float& mn, float& alpha) {
  float pmax = p0[0];
#pragma unroll
  for (int r = 1; r < 16; ++r) pmax = fmaxf(pmax, p0[r]);
#pragma unroll
  for (int r = 0; r < 16; ++r) pmax = fmaxf(pmax, p1[r]);
  { auto rr = __builtin_amdgcn_permlane32_swap(__float_as_uint(pmax), __float_as_uint(pmax), false, false);
    pmax = fmaxf(__uint_as_float(rr[0]), __uint_as_float(rr[1])); }
  if (__builtin_expect(__all(pmax - m_reg <= THR), 1)) { mn = m_reg; alpha = 1.f; }
  else { mn = fmaxf(m_reg, pmax); alpha = __builtin_amdgcn_exp2f(m_reg - mn); m_reg = mn; }
#pragma unroll
  for (int r = 0; r < 16; ++r) p0[r] = p0[r] - mn;
#pragma unroll
  for (int r = 0; r < 16; ++r) p1[r] = p1[r] - mn;
#pragma unroll
  for (int r = 0; r < 16; ++r) p0[r] = __builtin_amdgcn_exp2f(p0[r]);
}
__device__ __forceinline__ void finishSM(f32x16& p0, f32x16& p1, float alpha, float& l_reg, bf16x8& pa0, bf16x8& pa1, bf16x8& pa2, bf16x8& pa3) {
#pragma unroll
  for (int r = 0; r < 16; ++r) p1[r] = __builtin_amdgcn_exp2f(p1[r]);
  float ps = 0;
#pragma unroll
  for (int r = 0; r < 16; ++r) ps += p0[r];
#pragma unroll
  for (int r = 0; r < 16; ++r) ps += p1[r];
  { auto rr = __builtin_amdgcn_permlane32_swap(__float_as_uint(ps), __float_as_uint(ps), false, false);
    ps = __uint_as_float(rr[0]) + __uint_as_float(rr[1]); }
  l_reg = l_reg * alpha + ps;
#define PK4(P, BASE, OUT) do { unsigned a0 = cvtpk(P[BASE + 0], P[BASE + 1]), a1 = cvtpk(P[BASE + 2], P[BASE + 3]);   \
    unsigned b0 = cvtpk(P[BASE + 4], P[BASE + 5]), b1 = cvtpk(P[BASE + 6], P[BASE + 7]);                              \
    auto r0 = __builtin_amdgcn_permlane32_swap(a0, b0, false, false); auto r1 = __builtin_amdgcn_permlane32_swap(a1, b1, false, false); \
    u32x4 w = {r0[0], r1[0], r0[1], r1[1]}; OUT = *reinterpret_cast<bf16x8*>(&w); } while (0)
  PK4(p0, 0, pa0); PK4(p0, 8, pa1); PK4(p1, 0, pa2); PK4(p1, 8, pa3);
#undef PK4
}
__device__ __forceinline__ void pack_p(const f32x16& p0, const f32x16& p1, bf16x8& pa0, bf16x8& pa1, bf16x8& pa2, bf16x8& pa3) {
#define PK4(P, BASE, OUT) do { unsigned a0 = cvtpk(P[BASE + 0], P[BASE + 1]), a1 = cvtpk(P[BASE + 2], P[BASE + 3]);   \
    unsigned b0 = cvtpk(P[BASE + 4], P[BASE + 5]), b1 = cvtpk(P[BASE + 6], P[BASE + 7]);                              \
    auto r0 = __builtin_amdgcn_permlane32_swap(a0, b0, false, false); auto r1 = __builtin_amdgcn_permlane32_swap(a1, b1, false, false); \
    u32x4 w = {r0[0], r1[0], r0[1], r1[1]}; OUT = *reinterpret_cast<bf16x8*>(&w); } while (0)
  PK4(p0, 0, pa0); PK4(p0, 8, pa1); PK4(p1, 0, pa2); PK4(p1, 8, pa3);
#undef PK4
}
__device__ __forceinline__ void qkt(f32x16& p0, f32x16& p1, const bf16* Ks, const bf16x8* qr, int r32, int hi) {
  p0 = f32x16{}; p1 = f32x16{};
#pragma unroll
  for (int d0 = 0; d0 < 4; ++d0) { int cb = (d0 * 16 + hi * 8) * 2;
    bf16x8 b0 = *reinterpret_cast<const bf16x8*>((const char*)Ks + KSWZ64(r32, cb));
    bf16x8 b1 = *reinterpret_cast<const bf16x8*>((const char*)Ks + KSWZ64(32 + r32, cb));
    p0 = __builtin_amdgcn_mfma_f32_32x32x16_bf16(b0, qr[d0], p0, 0, 0, 0);
    p1 = __builtin_amdgcn_mfma_f32_32x32x16_bf16(b1, qr[d0], p1, 0, 0, 0); }
}
__device__ __forceinline__ int v_st(int k, int c) { const int kk = (k & ~0xC) | ((k & 4) << 1) | ((k & 8) >> 1); return ((kk >> 3) * 4 + (c >> 5)) * 512 + ((kk & 7) * 32 + (c & 31)) * 2; }
__device__ __forceinline__ int v_rd_base(int lane) { return ((lane & 3) << 3) | (((lane >> 2) & 3) << 6) | (((lane >> 4) & 1) << 5) | (((lane >> 5) & 1) << 8); }
constexpr int v_rd_off(int d0, int ks, int half) { return d0 * 512 + ks * 4096 + half * 2048; }
template <int OFF> __device__ __forceinline__ s16x4 tr_read(int vb) {
  s16x4 r; asm volatile("ds_read_b64_tr_b16 %0, %1 offset:%2" : "=&v"(r) : "v"(vb), "i"(OFF) : "memory"); return r;
}
template <int D0> __device__ __forceinline__ void pv_one(f32x16& od, int vb, bf16x8 pa0, bf16x8 pa1, bf16x8 pa2, bf16x8 pa3) {
  const s16x4 l0 = tr_read<v_rd_off(D0, 0, 0)>(vb), h0 = tr_read<v_rd_off(D0, 0, 1)>(vb), l1 = tr_read<v_rd_off(D0, 1, 0)>(vb), h1 = tr_read<v_rd_off(D0, 1, 1)>(vb);
  const s16x4 l2 = tr_read<v_rd_off(D0, 2, 0)>(vb), h2 = tr_read<v_rd_off(D0, 2, 1)>(vb), l3 = tr_read<v_rd_off(D0, 3, 0)>(vb), h3 = tr_read<v_rd_off(D0, 3, 1)>(vb);
  asm volatile("s_waitcnt lgkmcnt(0)" ::: "memory"); SBAR();
#define PK(L, H) (bf16x8){L[0], L[1], L[2], L[3], H[0], H[1], H[2], H[3]}
  od = __builtin_amdgcn_mfma_f32_32x32x16_bf16(pa0, PK(l0, h0), od, 0, 0, 0);
  od = __builtin_amdgcn_mfma_f32_32x32x16_bf16(pa1, PK(l1, h1), od, 0, 0, 0);
  od = __builtin_amdgcn_mfma_f32_32x32x16_bf16(pa2, PK(l2, h2), od, 0, 0, 0);
  od = __builtin_amdgcn_mfma_f32_32x32x16_bf16(pa3, PK(l3, h3), od, 0, 0, 0);
#undef PK
}
__device__ __forceinline__ void pv_d0(f32x16* o, int vb, bf16x8 pa0, bf16x8 pa1, bf16x8 pa2, bf16x8 pa3) {
  pv_one<0>(o[0], vb, pa0, pa1, pa2, pa3); pv_one<1>(o[1], vb, pa0, pa1, pa2, pa3); pv_one<2>(o[2], vb, pa0, pa1, pa2, pa3); pv_one<3>(o[3], vb, pa0, pa1, pa2, pa3);
}
constexpr int LDQ = NP, LDK = NP, LDO = DM;
__device__ __forceinline__ void sm_first(f32x16& p0, f32x16& p1, float m) {
#pragma unroll
  for (int r = 0; r < 16; ++r) p0[r] = p0[r] - m;
#pragma unroll
  for (int r = 0; r < 16; ++r) p1[r] = p1[r] - m;
#pragma unroll
  for (int r = 0; r < 16; ++r) p0[r] = __builtin_amdgcn_exp2f(p0[r]);
}
__device__ __forceinline__ void sm_second(f32x16& p0, f32x16& p1, float& l_reg, bf16x8& pa0, bf16x8& pa1, bf16x8& pa2, bf16x8& pa3) {
#pragma unroll
  for (int r = 0; r < 16; ++r) p1[r] = __builtin_amdgcn_exp2f(p1[r]);
  float ps = 0;
#pragma unroll
  for (int r = 0; r < 16; ++r) ps += p0[r];
#pragma unroll
  for (int r = 0; r < 16; ++r) ps += p1[r];
  { auto rr = __builtin_amdgcn_permlane32_swap(__float_as_uint(ps), __float_as_uint(ps), false, false);
    ps = __uint_as_float(rr[0]) + __uint_as_float(rr[1]); }
  l_reg += ps;
  pack_p(p0, p1, pa0, pa1, pa2, pa3);
}
__device__ __forceinline__ void attn_unit(const bf16* __restrict__ Qb, const bf16* __restrict__ Kh, const bf16* __restrict__ Vh, bf16* __restrict__ Ob, int seq, char* lds, int tid, float kmax) {
  const int wid = tid >> 6, lane = tid & 63, r32 = lane & 31, hi = lane >> 5;
  bf16* V_lds = (bf16*)lds; bf16* K_lds = (bf16*)(lds + 2 * SHM_V);
  float* ws = (float*)(lds + 2 * SHM_V + 2 * SHM_K) + wid * 64; float* li_l = ws; float* al_l = ws + 32;
  float m_reg = -1e30f, l_reg = 0; f32x16 o[4] = {}; bf16x8 qr[4];
  const bf16* Qw = Qb + (long)(wid * QBLK + r32) * LDQ + hi * 8;
#pragma unroll
  for (int d0 = 0; d0 < 4; ++d0) qr[d0] = *(const __attribute__((address_space(1))) bf16x8*)(Qw + d0 * 16);
  { float qs = 0.f;
#pragma unroll
    for (int d0 = 0; d0 < 4; ++d0)
#pragma unroll
      for (int e = 0; e < 8; ++e) { const float qv = __uint_as_float((unsigned)(unsigned short)qr[d0][e] << 16); qs += qv * qv; }
    auto rr = __builtin_amdgcn_permlane32_swap(__float_as_uint(qs), __float_as_uint(qs), false, false);
    qs = __uint_as_float(rr[0]) + __uint_as_float(rr[1]);
    m_reg = sqrtf(qs) * kmax * 1.002f + 1e-3f; }
  const int sr = tid >> 4, sc = (tid & 15) * 8, vst0 = v_st(sr, sc), vst1 = v_st(32 + sr, sc);
  const int kr = tid >> 3, kc = (tid & 7) * 8, kst = KSWZ64(kr, kc * 2);
  const int vb0 = (int)(uintptr_t)V_lds + v_rd_base(lane);
  struct { bf16x8 vs0, vs1, ks0; } sr_[2];
#define GLD8(p) (*(const __attribute__((address_space(1))) bf16x8*)(p))
#define SLOAD(i, k0) do { sr_[i].vs0 = GLD8(&Vh[(long)((k0) + sr) * LDK + sc]); sr_[i].vs1 = GLD8(&Vh[(long)((k0) + 32 + sr) * LDK + sc]); \
    sr_[i].ks0 = GLD8(&Kh[(long)((k0) + kr) * LDK + kc]); } while (0)
#define SWRITE(b, i) do { *(bf16x8*)((char*)V_lds + (b) * SHM_V + vst0) = sr_[i].vs0; *(bf16x8*)((char*)V_lds + (b) * SHM_V + vst1) = sr_[i].vs1; \
    *(bf16x8*)((char*)K_lds + (b) * SHM_K + kst) = sr_[i].ks0; } while (0)
#define SWAIT() asm volatile("s_waitcnt vmcnt(3)" ::: "memory")
#define RESC(a) do { if (__any((a) < 1.f)) { if (hi == 0) al_l[r32] = (a); asm volatile("s_waitcnt lgkmcnt(0)" ::: "memory"); \
    _Pragma("unroll") for (int d = 0; d < 4; ++d) _Pragma("unroll") for (int r = 0; r < 16; ++r) o[d][r] *= al_l[crow(r, hi)]; } } while (0)
  f32x16 pA0, pA1, pB0, pB1; float mnA, mnB, alA, alB; bf16x8 pa0, pa1, pa2, pa3; const int NT = seq / KVBLK;
  if (__builtin_amdgcn_readfirstlane(wid) >= 4) __builtin_amdgcn_s_setprio(1);
  constexpr int SE = 0, SO = 1;
  SLOAD(SE, 0); asm volatile("s_waitcnt vmcnt(0)" ::: "memory"); SWRITE(0, SE); __syncthreads();
  qkt(pA0, pA1, K_lds, qr, r32, hi); sm_first(pA0, pA1, m_reg);
  SLOAD(SO, KVBLK); if (2 < NT) SLOAD(SE, 2 * KVBLK);
  SWAIT(); SWRITE(1, SO); __syncthreads();
  for (int j = 1; j + 1 < NT; j += 2) {
    SBAR(); qkt(pB0, pB1, (bf16*)((char*)K_lds + SHM_K), qr, r32, hi);
    sm_second(pA0, pA1, l_reg, pa0, pa1, pa2, pa3); SBAR();
    SLOAD(SO, (j + 2) * KVBLK); SBAR();
    pv_d0(o, vb0, pa0, pa1, pa2, pa3); sm_first(pB0, pB1, m_reg);
    __syncthreads(); SWAIT(); SWRITE(0, SE);
    __syncthreads();
    SBAR(); qkt(pA0, pA1, K_lds, qr, r32, hi);
    sm_second(pB0, pB1, l_reg, pa0, pa1, pa2, pa3); SBAR();
    if (j + 3 < NT) SLOAD(SE, (j + 3) * KVBLK); SBAR();
    pv_d0(o, vb0 + (int)SHM_V, pa0, pa1, pa2, pa3); sm_first(pA0, pA1, m_reg);
    __syncthreads(); SWAIT(); SWRITE(1, SO);
    __syncthreads();
  }
  SBAR(); qkt(pB0, pB1, (bf16*)((char*)K_lds + SHM_K), qr, r32, hi);
  sm_second(pA0, pA1, l_reg, pa0, pa1, pa2, pa3); SBAR();
  pv_d0(o, vb0, pa0, pa1, pa2, pa3); sm_first(pB0, pB1, m_reg);
  __syncthreads();
  sm_second(pB0, pB1, l_reg, pa0, pa1, pa2, pa3); SBAR();
  pv_d0(o, vb0 + (int)SHM_V, pa0, pa1, pa2, pa3);
  __builtin_amdgcn_s_setprio(0);
  if (hi == 0) li_l[r32] = l_reg; asm volatile("s_waitcnt lgkmcnt(0)" ::: "memory");
  float rli[16];
#pragma unroll
  for (int r = 0; r < 16; ++r) rli[r] = __builtin_amdgcn_rcpf(li_l[crow(r, hi)]);
  bf16* Ow = Ob + (long)(wid * QBLK) * LDO;
#pragma unroll
  for (int r = 0; r < 16; ++r) { const int orow = crow(r, hi);
#pragma unroll
    for (int d0 = 0; d0 < 4; ++d0) Ow[(long)orow * LDO + d0 * 32 + r32] = (bf16)(cvtpk(o[d0][r] * rli[r], 0.f) & 0xffffu); }
#undef SLOAD
#undef GLD8
#undef SWRITE
#undef SWAIT
#undef RESC
}
}

__device__ __forceinline__ int gla_item(int b, int h, int dir, int c) { return ((b * 4 + h) * 2 + dir) * NCH + c; }
namespace gla {
using att::bf16x8; using att::f32x16; using att::u32x4;
__device__ __forceinline__ void gates8(const bf16* P, const float* w2, const float* gb, size_t row0, int dir, int seg, int k, float (&gl)[8]) {
    float w[16];
#pragma unroll
    for (int j = 0; j < 16; ++j) w[j] = w2[j * 256 + k];
    const float bias = gb[k];
#pragma unroll
    for (int i = 0; i < 8; ++i) {
        const bf16* gp = P + (row0 + seg * 8 + i) * NP + C_GLR + dir * 16;
        const v4u a = *(const v4u*)gp, b = *(const v4u*)(gp + 8);
        float z = bias;
        z += bflo(a.x) * w[0] + bfhi(a.x) * w[1] + bflo(a.y) * w[2] + bfhi(a.y) * w[3] + bflo(a.z) * w[4] + bfhi(a.z) * w[5] + bflo(a.w) * w[6] + bfhi(a.w) * w[7];
        z += bflo(b.x) * w[8] + bfhi(b.x) * w[9] + bflo(b.y) * w[10] + bfhi(b.y) * w[11] + bflo(b.z) * w[12] + bfhi(b.z) * w[13] + bflo(b.w) * w[14] + bfhi(b.w) * w[15];
        gl[i] = (fminf(z, 0.f) - log1pf(expf(-fabsf(z)))) * (1.f / 16.f);
    }
}
__device__ __forceinline__ float lscan(const float (&gl)[8], int dir, float (&loc)[8]) {
    float run = 0.f;
    if (dir == 0) {
#pragma unroll
        for (int i = 0; i < 8; ++i) { run += gl[i]; loc[i] = run; }
    } else {
#pragma unroll
        for (int i = 7; i >= 0; --i) { run += gl[i]; loc[i] = run; }
    }
    return run;
}
__device__ __forceinline__ void stage_tile_bf16(const bf16* src, size_t pitch, char* tile, int tid) {
    const int sr = tid >> 4, sc = (tid & 15) * 8;
    const bf16x8 a = *reinterpret_cast<const bf16x8*>(src + (size_t)sr * pitch + sc), b = *reinterpret_cast<const bf16x8*>(src + (size_t)(32 + sr) * pitch + sc);
    *(bf16x8*)(tile + att::v_st(sr, sc)) = a; *(bf16x8*)(tile + att::v_st(32 + sr, sc)) = b;
}
__device__ __forceinline__ void stage_tile_f32(const float* src, char* tile, int tid) {
    const int sr = tid >> 4, sc = (tid & 15) * 8;
#pragma unroll
    for (int t = 0; t < 2; ++t) { const int row = sr + 32 * t; const f32x4 x = *(const f32x4*)(src + row * 128 + sc), y = *(const f32x4*)(src + row * 128 + sc + 4);
        u32x4 w = {att::cvtpk(x[0], x[1]), att::cvtpk(x[2], x[3]), att::cvtpk(y[0], y[1]), att::cvtpk(y[2], y[3])};
        *(u32x4*)(tile + att::v_st(row, sc)) = w; }
}
__device__ __forceinline__ void pv_sel(int d0, f32x16& o, int vb, bf16x8 a0, bf16x8 a1, bf16x8 a2, bf16x8 a3) {
    switch (d0) { case 0: att::pv_one<0>(o, vb, a0, a1, a2, a3); break; case 1: att::pv_one<1>(o, vb, a0, a1, a2, a3); break;
                  case 2: att::pv_one<2>(o, vb, a0, a1, a2, a3); break; default: att::pv_one<3>(o, vb, a0, a1, a2, a3); break; }
}
__device__ __forceinline__ void afrag4(const char* img, int row, int hi, bf16x8 (&a)[4]) {
#pragma unroll
    for (int s = 0; s < 4; ++s) a[s] = *reinterpret_cast<const bf16x8*>(img + KSWZ64(row, (s * 16 + hi * 8) * 2));
}
__device__ __forceinline__ void st_sw(char* img, int row, int col, float v) { *(unsigned short*)(img + KSWZ64(row, col * 2)) = (unsigned short)(att::cvtpk(v, 0.f) & 0xffffu); }
}

constexpr size_t WS_OG = WS_DS;
constexpr int CW_KMX = 13312;
constexpr int CW_Q = 12288;
struct GlaPre { unsigned g; unsigned short q[8], k[8]; att::bf16x8 v0, v1; };
__device__ __forceinline__ void gla_prefetch(GlaPre& R, const bf16* P_, size_t row0, int h, int dir, int k, int seg, int tid) {
    const GAS bf16* P = (const GAS bf16*)P_;
    R.g = *(const GAS unsigned*)(P + (row0 + seg * 8 + (k >> 3)) * NP + C_GLR + dir * 16 + (k & 7) * 2);
#pragma unroll
    for (int i = 0; i < 8; ++i) { const GAS bf16* rp = P + (row0 + seg * 8 + i) * NP; R.q[i] = rp[C_GQ + h * 64 + k]; R.k[i] = rp[C_GK + h * 64 + k]; }
    const int sr = tid >> 4, sc = (tid & 15) * 8;
    R.v0 = *(const GAS att::bf16x8*)(P + (row0 + sr) * NP + C_GV + h * 128 + sc); R.v1 = *(const GAS att::bf16x8*)(P + (row0 + 32 + sr) * NP + C_GV + h * 128 + sc);
}
__device__ __forceinline__ void gla_chain(Frame& F, int l, int chain) {
    const int b = chain >> 3, h = (chain >> 1) & 3, dir = chain & 1;
    const bf16* P = (const bf16*)(F.ws + WS_PROJ); bf16* OG = (bf16*)(F.ws + WS_OG) + (size_t)dir * M * 512;
    char* lds = (char*)F.lds; char* Vt = lds; char* St = lds + 16384; char* KtT = lds + 32768; char* Kt = lds + 40960; char* Qt = lds + 49152; char* Qh = lds + 57344;
    float* T = (float*)(lds + 65536); float* Dec = (float*)(lds + 67584);
    const int k = F.lane, seg = F.tid >> 6, r32 = F.lane & 31, hi = F.lane >> 5, mt = F.wave >> 2, d0 = F.wave & 3;
    const int vbV = (int)(uintptr_t)Vt + att::v_rd_base(F.lane), vbS = (int)(uintptr_t)St + att::v_rd_base(F.lane);
    const int sr = F.tid >> 4, sc = (F.tid & 15) * 8;
    float w[16];
    { const float* w2 = INP(11) + (size_t)((l * 2 + dir) * 16) * 256 + h * 64;
#pragma unroll
      for (int j = 0; j < 16; ++j) w[j] = w2[j * 256 + k]; }
    const float bias = (INP(12) + (l * 2 + dir) * 256 + h * 64)[k];
    att::f32x16 S = {};
    GlaPre R, RN;
    { const int c0 = dir == 0 ? 0 : 3; gla_prefetch(RN, P, (size_t)b * TPB + c0 * 64, h, dir, k, seg, F.tid); }
    for (int j = 0; j < NCH; ++j) {
        const int c = dir == 0 ? j : (j < 4 ? 3 - j : 39 - j);
        const size_t row0 = (size_t)b * TPB + c * 64;
        R = RN;
        if (j + 1 < NCH) { const int cn = dir == 0 ? j + 1 : (j + 1 < 4 ? 2 - j : 38 - j); gla_prefetch(RN, P, (size_t)b * TPB + cn * 64, h, dir, k, seg, F.tid); }
        float gl[8], loc[8];
#pragma unroll
        for (int i = 0; i < 8; ++i) {
            float z = bias;
#pragma unroll
            for (int d = 0; d < 8; ++d) { const unsigned s = (unsigned)__builtin_amdgcn_readlane((int)R.g, i * 8 + d); z += bflo(s) * w[2 * d] + bfhi(s) * w[2 * d + 1]; }
            gl[i] = (fminf(z, 0.f) - __logf(1.f + __expf(-fabsf(z)))) * (1.f / 16.f); }
        const float segtot = gla::lscan(gl, dir, loc);
        T[seg * 64 + k] = segtot;
        *(att::bf16x8*)(Vt + att::v_st(sr, sc)) = R.v0; *(att::bf16x8*)(Vt + att::v_st(32 + sr, sc)) = R.v1;
#pragma unroll
        for (int r = 0; r < 16; ++r) *(unsigned short*)(St + att::v_st(mt * 32 + att::crow(r, hi), d0 * 32 + r32)) = (unsigned short)(att::cvtpk(S[r], 0.f) & 0xffffu);
        __syncthreads();
        float off = 0.f, tot = 0.f;
        int sg = seg; asm volatile("" : "+v"(sg));
#pragma unroll
        for (int s = 0; s < 8; ++s) { const float t = T[s * 64 + k]; tot += t; const bool inoff = dir == 0 ? (s < sg) : (s > sg); off += inoff ? t : 0.f; }
        const float etot = __expf(tot);
        float kt[8];
#pragma unroll
        for (int i = 0; i < 8; ++i) { const int tau = seg * 8 + i; const float qv = bf2f(R.q[i]), kv = bf2f(R.k[i]); const float cc = loc[i] + off;
            const float a = fmaxf(__expf(cc), 1e-30f)  , bq = __builtin_amdgcn_rcpf(a), kb = kv * bq;
            kt[i] = kb * etot;
            gla::st_sw(Qh, tau, k, qv * a); gla::st_sw(Kt, tau, k, kb); }
        { att::u32x4 wv = {att::cvtpk(kt[0], kt[1]), att::cvtpk(kt[2], kt[3]), att::cvtpk(kt[4], kt[5]), att::cvtpk(kt[6], kt[7])};
          *(att::u32x4*)(KtT + KSWZ64(k, seg * 16)) = wv; }
        if (sg == 0) Dec[k] = etot;
        __syncthreads();
        att::f32x16 o = {};
        int tau_q = mt * 32 + r32; asm volatile("" : "+v"(tau_q));
        { att::bf16x8 qr[4]; gla::afrag4(Qh, tau_q, hi, qr);
          att::f32x16 p0, p1; att::qkt(p0, p1, (const bf16*)Kt, qr, r32, hi);
#pragma unroll
          for (int r = 0; r < 16; ++r) { const int t0 = att::crow(r, hi), t1 = 32 + t0;
              const bool k0 = dir == 0 ? (t0 <= tau_q) : (t0 >= tau_q), k1 = dir == 0 ? (t1 <= tau_q) : (t1 >= tau_q);
              p0[r] = k0 ? p0[r] : 0.f; p1[r] = k1 ? p1[r] : 0.f; }
          att::bf16x8 pa0, pa1, pa2, pa3; att::pack_p(p0, p1, pa0, pa1, pa2, pa3);
          gla::pv_sel(d0, o, vbV, pa0, pa1, pa2, pa3);
          gla::pv_sel(d0, o, vbS, qr[0], qr[1], qr[2], qr[3]); }
#pragma unroll
        for (int r = 0; r < 16; ++r) S[r] *= Dec[mt * 32 + att::crow(r, hi)];
        { att::bf16x8 a[4]; gla::afrag4(KtT, mt * 32 + r32, hi, a); gla::pv_sel(d0, S, vbV, a[0], a[1], a[2], a[3]); }
        GAS bf16* op = (GAS bf16*)(OG + row0 * 512 + h * 128 + d0 * 32 + r32);
#pragma unroll
        for (int r = 0; r < 16; ++r) op[(size_t)(mt * 32 + att::crow(r, hi)) * 512] = (bf16)(att::cvtpk(o[r], 0.f) & 0xffffu);
        __syncthreads();
    }
}
__device__ __forceinline__ void p3_mixer(Frame& F, int l) {
    refresh(F);
    for (int ch = F.blk; ch < NBATCH * 8; ch += F.G) gla_chain(F, l, ch);
    const bf16* P = (const bf16*)(F.ws + WS_PROJ); bf16* OD = (bf16*)(F.ws + WS_OD);
    const unsigned* kmxp = (const unsigned*)F.ws + CW_KMX + 256 * l;
    volatile LAS unsigned* slot = F.MISC + 24;
    int myq = F.blk & 7, tries = 0;
    for (;;) {
        __syncthreads();
        if (F.tid == 0) slot[0] = __hip_atomic_fetch_add((unsigned*)((gu32*)F.ws + CW_Q + 64 * l + 8 * 0 + myq), 1u, __ATOMIC_RELAXED, __HIP_MEMORY_SCOPE_AGENT);
        __syncthreads();
        const int u = (int)slot[0];
        if (u >= (l == DEPTH - 1 ? 128 : 144)) { if (++tries >= 8) break; myq = (myq + 1) & 7; continue; }
        int g, qt;
        if (u < 128) { const int pi = u >> 4, mp = (u >> 3) & 1; g = ((pi * 8 + myq) << 1) + mp; qt = 1 + (u & 7); }
        else { const int gi = u - 128; g = (((gi >> 1) * 8 + myq) << 1) + (gi & 1); qt = 0; }
        const int b = g >> 3, hh = g & 7;
        const size_t row0 = (size_t)b * TPB;
        att::attn_unit(P + (row0 + qt * 256) * NP + C_Q + hh * 64, P + row0 * NP + C_K + hh * 64, P + row0 * NP + C_V + (hh >> 1) * 128,
                       OD + (row0 + qt * 256) * DM + hh * 128, qt == 0 ? CTX : TPB, (char*)F.lds, F.tid,
                       sqrtf(__uint_as_float(kmxp[(b * 8 + hh) * 2]) + __uint_as_float(kmxp[(b * 8 + hh) * 2 + 1])) * 1.01f);
    }
    __syncthreads();
}
__device__ __forceinline__ void p5_merge_all(Frame& F, int l) {
    refresh(F);
    const bf16* OD = (const bf16*)(F.ws + WS_OD); const bf16* OG = (const bf16*)(F.ws + WS_OG); const bf16* P = (const bf16*)(F.ws + WS_PROJ); bf16* MRG = (bf16*)(F.ws + WS_H);
    const float lam = ((const float*)(F.ws + WS_ROPE + 16384))[l]; const float omli = 1.f - lam_init_of(l);
    const float* subln = INP(14) + l * 128; const float* onorm = INP(15) + l * 128;
    const int h = F.lane >> 4, c0 = (F.lane & 15) * 8;
    const int rpw = (M + F.NGW - 1) / F.NGW, r0 = F.gw * rpw, r1 = (r0 + rpw < M) ? r0 + rpw : M;
    for (int r = r0; r < r1; ++r) {
        const v4u a = *(const v4u*)(OD + (size_t)r * DM + h * 256 + c0), bq = *(const v4u*)(OD + (size_t)r * DM + h * 256 + 128 + c0);
        const v4u gf = *(const v4u*)(OG + (size_t)r * 512 + h * 128 + c0), gbk = *(const v4u*)(OG + ((size_t)M + r) * 512 + h * 128 + c0);
        const v4u gt = *(const v4u*)(P + (size_t)r * NP + C_GG + h * 128 + c0);
        float d[8], e[8], g[8];
        d[0] = bflo(a.x) - lam * bflo(bq.x); d[1] = bfhi(a.x) - lam * bfhi(bq.x); d[2] = bflo(a.y) - lam * bflo(bq.y); d[3] = bfhi(a.y) - lam * bfhi(bq.y);
        d[4] = bflo(a.z) - lam * bflo(bq.z); d[5] = bfhi(a.z) - lam * bfhi(bq.z); d[6] = bflo(a.w) - lam * bflo(bq.w); d[7] = bfhi(a.w) - lam * bfhi(bq.w);
        e[0] = bflo(gf.x) + bflo(gbk.x); e[1] = bfhi(gf.x) + bfhi(gbk.x); e[2] = bflo(gf.y) + bflo(gbk.y); e[3] = bfhi(gf.y) + bfhi(gbk.y);
        e[4] = bflo(gf.z) + bflo(gbk.z); e[5] = bfhi(gf.z) + bfhi(gbk.z); e[6] = bflo(gf.w) + bflo(gbk.w); e[7] = bfhi(gf.w) + bfhi(gbk.w);
        g[0] = bflo(gt.x); g[1] = bfhi(gt.x); g[2] = bflo(gt.y); g[3] = bfhi(gt.y); g[4] = bflo(gt.z); g[5] = bfhi(gt.z); g[6] = bflo(gt.w); g[7] = bfhi(gt.w);
        float ss = 0.f, se = 0.f;
#pragma unroll
        for (int i = 0; i < 8; ++i) { ss += d[i] * d[i]; se += e[i] * e[i]; }
        ss = xadd<1>(ss); ss = xadd<2>(ss); ss = xadd<4>(ss); ss = xadd<8>(ss);
        se = xadd<1>(se); se = xadd<2>(se); se = xadd<4>(se); se = xadd<8>(se);
        const float sc = omli / sqrtf(ss * (1.f / 128.f) + EPS), se2 = 1.0f / sqrtf(se * (1.f / 128.f) + EPS);
#pragma unroll
        for (int i = 0; i < 8; ++i) { d[i] = d[i] * sc * subln[c0 + i]; e[i] = e[i] * se2 * onorm[c0 + i] * siluf(g[i]); }
        v4u w; w.x = pg8::cvt_pk_bf16(d[0], d[1]); w.y = pg8::cvt_pk_bf16(d[2], d[3]); w.z = pg8::cvt_pk_bf16(d[4], d[5]); w.w = pg8::cvt_pk_bf16(d[6], d[7]);
        *(v4u*)(MRG + (size_t)r * DM + h * 128 + c0) = w;
        v4u x; x.x = pg8::cvt_pk_bf16(e[0], e[1]); x.y = pg8::cvt_pk_bf16(e[2], e[3]); x.z = pg8::cvt_pk_bf16(e[4], e[5]); x.w = pg8::cvt_pk_bf16(e[6], e[7]);
        *(v4u*)(MRG + (size_t)r * DM + 512 + h * 128 + c0) = x;
    }
}

__device__ __forceinline__ float dpp_sum16(float v) {
    v += __int_as_float(__builtin_amdgcn_update_dpp(0, __float_as_int(v), 0xB1, 0xF, 0xF, true));
    v += __int_as_float(__builtin_amdgcn_update_dpp(0, __float_as_int(v), 0x4E, 0xF, 0xF, true));
    v += __int_as_float(__builtin_amdgcn_update_dpp(0, __float_as_int(v), 0x141, 0xF, 0xF, true));
    v += __int_as_float(__builtin_amdgcn_update_dpp(0, __float_as_int(v), 0x140, 0xF, 0xF, true));
    return v;
}
__device__ __forceinline__ float wave_sum2(float v) { v = dpp_sum16(v); v = xadd<16>(v); v = xadd<32>(v); return v; }
__device__ __forceinline__ float row_rinv2(const f32x4 (&v)[4]) {
    float s = 0.f;
#pragma unroll
    for (int j = 0; j < 4; ++j) s += (v[j][0] * v[j][0] + v[j][1] * v[j][1]) + (v[j][2] * v[j][2] + v[j][3] * v[j][3]);
    return __builtin_amdgcn_rsqf(wave_sum2(s) * (1.f / DM) + EPS);
}
__device__ __forceinline__ void ld_raw_bf16(const bf16* row, int lane, u32x2 (&v)[4]) {
#pragma unroll
    for (int j = 0; j < 4; ++j) v[j] = *(const u32x2*)(row + 4 * lane + 256 * j);
}
__device__ __forceinline__ f32x4 raw2f(u32x2 w) { return (f32x4){bflo(w.x), bfhi(w.x), bflo(w.y), bfhi(w.y)}; }
__device__ __forceinline__ void ld_vec(const float* p, int lane, f32x4 (&v)[4]) {
#pragma unroll
    for (int j = 0; j < 4; ++j) v[j] = *(const f32x4*)(p + 4 * lane + 256 * j);
}

__device__ __forceinline__ void p1_rows(Frame& F, int l) {
    refresh(F);
    const float* MOD = (const float*)(F.ws + WS_MOD);
    bf16* X = (bf16*)(F.ws + WS_X); bf16* H = (bf16*)(F.ws + WS_H); const bf16* F2 = (const bf16*)(F.ws + WS_F2);
    const int rpw = (M + F.NGW - 1) / F.NGW, r0 = F.gw * rpw, r1 = (r0 + rpw < M) ? r0 + rpw : M;
    if (r0 >= r1) return;
    const bool two = l > 0 && ((l - 1) & 1);
    f32x4 gpre[4], gpost[4], sh[4], sc[4], gt[4];
    ld_vec(INP(6) + l * DM, F.lane, gpre);
    if (l > 0) ld_vec(INP(9) + (l - 1) * DM, F.lane, gpost);
    int cur = -1;
    f32x4 xn[4]; u32x2 xr[4], fn[4], gn[4];
#define P1_ISSUE(r) do { const int b_ = (r) / TPB, p_ = (r) % TPB; \
        if (l == 0) ld_row_f32(p_ < CTX ? INP(2) + ((size_t)b_ * CTX + p_) * DM : INP(0) + ((size_t)b_ * SEQ + (p_ - CTX)) * DM, F.lane, xn); \
        else ld_raw_bf16(X + (size_t)(r) * DM, F.lane, xr); \
        if (l > 0) { ld_raw_bf16(F2 + (size_t)(r) * DM, F.lane, fn); if (two) ld_raw_bf16(F2 + ((size_t)M + (r)) * DM, F.lane, gn); } } while (0)
    P1_ISSUE(r0);
    for (int r = r0; r < r1; ++r) {
        f32x4 x[4]; u32x2 fr[4], gr[4];
#pragma unroll
        for (int j = 0; j < 4; ++j) { x[j] = (l == 0) ? xn[j] : raw2f(xr[j]); fr[j] = fn[j]; gr[j] = gn[j]; }
        if (r + 1 < r1) P1_ISSUE(r + 1);
        const int b = r / TPB, p = r % TPB, mrow = p < CTX ? 16 : b;
        if (mrow != cur) { cur = mrow; const float* modp = MOD + ((size_t)l * 17 + mrow) * 6144; ld_vec(modp, F.lane, sh); ld_vec(modp + 1024, F.lane, sc);
            if (l > 0) ld_vec(MOD + ((size_t)(l - 1) * 17 + mrow) * 6144 + 5 * 1024, F.lane, gt); }
        if (l > 0) {
            f32x4 f[4];
#pragma unroll
            for (int j = 0; j < 4; ++j) { f[j] = raw2f(fr[j]); if (two) f[j] = f[j] + raw2f(gr[j]); }
            const float rinv = row_rinv2(f);
#pragma unroll
            for (int j = 0; j < 4; ++j) x[j] = x[j] + gt[j] * (f[j] * rinv * gpost[j]);
        }
        st_row_bf16(X + (size_t)r * DM, F.lane, x);
        const float rinv = row_rinv2(x);
        f32x4 h[4];
#pragma unroll
        for (int j = 0; j < 4; ++j) h[j] = (x[j] * rinv * gpre[j]) * (sc[j] + 1.0f) + sh[j];
        st_row_bf16(H + (size_t)r * DM, F.lane, h);
    }
#undef P1_ISSUE
}
__device__ __forceinline__ void pf_final(Frame& F) {
    refresh(F);
    const float* MOD = (const float*)(F.ws + WS_MOD);
    const bf16* X = (const bf16*)(F.ws + WS_X); const bf16* F2 = (const bf16*)(F.ws + WS_F2);
    const int l = DEPTH - 1, NR = NBATCH * SEQ;
    const int rpw = (NR + F.NGW - 1) / F.NGW, i0 = F.gw * rpw, i1 = (i0 + rpw < NR) ? i0 + rpw : NR;
    if (i0 >= i1) return;
    f32x4 gpost[4], gt[4]; ld_vec(INP(9) + l * DM, F.lane, gpost);
    int cur = -1;
    u32x2 xn[4], fn[4], gn[4];
#define PF_ISSUE(i) do { const size_t r_ = (size_t)((i) / SEQ) * TPB + CTX + (i) % SEQ; ld_raw_bf16(X + r_ * DM, F.lane, xn); ld_raw_bf16(F2 + r_ * DM, F.lane, fn); ld_raw_bf16(F2 + ((size_t)M + r_) * DM, F.lane, gn); } while (0)
    PF_ISSUE(i0);
    for (int i = i0; i < i1; ++i) {
        f32x4 x[4], f[4];
#pragma unroll
        for (int j = 0; j < 4; ++j) { x[j] = raw2f(xn[j]); f[j] = raw2f(fn[j]) + raw2f(gn[j]); }
        if (i + 1 < i1) PF_ISSUE(i + 1);
        const int b = i / SEQ;
        if (b != cur) { cur = b; ld_vec(MOD + ((size_t)l * 17 + b) * 6144 + 5 * 1024, F.lane, gt); }
        const float rinv = row_rinv2(f);
#pragma unroll
        for (int j = 0; j < 4; ++j) x[j] = x[j] + gt[j] * (f[j] * rinv * gpost[j]);
        st_row_f32(F.A->out + (size_t)i * DM, F.lane, x);
    }
#undef PF_ISSUE
}
__device__ __forceinline__ void p7_rows(Frame& F, int l) {
    refresh(F);
    const float* MOD = (const float*)(F.ws + WS_MOD);
    bf16* X = (bf16*)(F.ws + WS_X); const bf16* Y = (const bf16*)(F.ws + WS_Y); bf16* H2 = (bf16*)(F.ws + WS_H2);
    const bool moe = l & 1; const int li = l >> 1;
    int* TOPE = (int*)(F.ws + WS_TOPE); int* LIDX = (int*)(F.ws + WS_LIDX); float* TOPW = (float*)(F.ws + WS_TOPW); int* BLKB = (int*)(F.ws + WS_BLKB);
    volatile LAS unsigned* LCNT = F.MISC + 16;
    LAS float* RT = (LAS float*)F.lds;
    if (moe) {
        const float* router = INP(20) + (size_t)li * DM * NE;
        if (F.tid < 8) LCNT[F.tid] = 0u;
        for (int i = F.tid; i < DM * NE / 4; i += 512) { const f32x4 q = *(const f32x4*)(router + 4 * i); const int c = i >> 1, e0 = (i & 1) * 4;
            RT[(e0 + 0) * DM + c] = q[0]; RT[(e0 + 1) * DM + c] = q[1]; RT[(e0 + 2) * DM + c] = q[2]; RT[(e0 + 3) * DM + c] = q[3]; }
        __syncthreads();
    }
    const bool lastl = (l == DEPTH - 1); const int NR = lastl ? NBATCH * SEQ : M;
#define P7_ROW(i) (lastl ? ((i) / SEQ) * TPB + CTX + (i) % SEQ : (i))
    const int rpw = (NR + F.NGW - 1) / F.NGW, r0 = F.gw * rpw, r1 = (r0 + rpw < NR) ? r0 + rpw : NR;
    if (r0 < r1) {
        f32x4 gpost[4], gpre[4], gt[4], sh[4], sc[4];
        ld_vec(INP(7) + l * DM, F.lane, gpost); ld_vec(INP(8) + l * DM, F.lane, gpre);
        int cur = -1;
        u32x2 xn[4], yn[4];
        ld_raw_bf16(X + (size_t)P7_ROW(r0) * DM, F.lane, xn); ld_raw_bf16(Y + (size_t)P7_ROW(r0) * DM, F.lane, yn);
        for (int ri = r0; ri < r1; ++ri) {
            const int r = P7_ROW(ri);
            f32x4 x[4], y[4];
#pragma unroll
            for (int j = 0; j < 4; ++j) { x[j] = raw2f(xn[j]); y[j] = raw2f(yn[j]); }
            if (ri + 1 < r1) { const int rn = P7_ROW(ri + 1); ld_raw_bf16(X + (size_t)rn * DM, F.lane, xn); ld_raw_bf16(Y + (size_t)rn * DM, F.lane, yn); }
            const int b = r / TPB, p = r % TPB, mrow = p < CTX ? 16 : b;
            if (mrow != cur) { cur = mrow; const float* modp = MOD + ((size_t)l * 17 + mrow) * 6144; ld_vec(modp + 2 * 1024, F.lane, gt); ld_vec(modp + 3 * 1024, F.lane, sh); ld_vec(modp + 4 * 1024, F.lane, sc); }
            const float ry = row_rinv2(y);
#pragma unroll
            for (int j = 0; j < 4; ++j) x[j] = x[j] + gt[j] * (y[j] * ry * gpost[j]);
            st_row_bf16(X + (size_t)r * DM, F.lane, x);
            const float rx = row_rinv2(x);
            f32x4 h[4];
#pragma unroll
            for (int j = 0; j < 4; ++j) h[j] = (x[j] * rx * gpre[j]) * (sc[j] + 1.0f) + sh[j];
            if constexpr (FFN_F8) {
#pragma unroll
                for (int j = 0; j < 4; ++j) *(unsigned*)((unsigned char*)H2 + (size_t)r * DM + 4 * F.lane + 256 * j) = pk4_f8(h[j][0], h[j][1], h[j][2], h[j][3]);
            } else st_row_bf16(H2 + (size_t)r * DM, F.lane, h);
            if (moe) {
                float lg[8];
#pragma unroll
                for (int e = 0; e < 8; ++e) lg[e] = 0.f;
#pragma unroll
                for (int j = 0; j < 4; ++j)
#pragma unroll
                    for (int e = 0; e < 8; ++e) { const f32x4 q = *(const LAS f32x4*)(RT + e * DM + 4 * F.lane + 256 * j); lg[e] += (h[j][0] * q[0] + h[j][1] * q[1]) + (h[j][2] * q[2] + h[j][3] * q[3]); }
#pragma unroll
                for (int e = 0; e < 8; ++e) lg[e] = wave_sum2(lg[e]);
                int e0 = 0; float v0 = lg[0];
#pragma unroll
                for (int e = 1; e < 8; ++e) if (lg[e] > v0) { v0 = lg[e]; e0 = e; }
                int e1 = -1; float v1 = -3.0e38f;
#pragma unroll
                for (int e = 0; e < 8; ++e) if (e != e0 && lg[e] > v1) { v1 = lg[e]; e1 = e; }
                const float ex = __expf(v1 - v0), w0 = 1.f / (1.f + ex), w1 = ex / (1.f + ex);
                if (F.lane == 0) {
                    const unsigned i0 = __hip_atomic_fetch_add((LAS unsigned*)&LCNT[e0], 1u, __ATOMIC_RELAXED, __HIP_MEMORY_SCOPE_WORKGROUP), i1 = __hip_atomic_fetch_add((LAS unsigned*)&LCNT[e1], 1u, __ATOMIC_RELAXED, __HIP_MEMORY_SCOPE_WORKGROUP);
                    TOPE[r] = e0 | (e1 << 8); LIDX[2 * r] = (int)i0; LIDX[2 * r + 1] = (int)i1; TOPW[2 * r] = w0; TOPW[2 * r + 1] = w1;
                }
            }
        }
    }
    if (moe) {
        __syncthreads();
        if (F.tid < 8) { const unsigned base = __hip_atomic_fetch_add((unsigned*)((gu32*)F.ws + CW_CNT + 64 * li + F.tid), LCNT[F.tid], __ATOMIC_RELAXED, __HIP_MEMORY_SCOPE_AGENT); BLKB[F.blk * 8 + F.tid] = (int)base; }
    }
#undef P7_ROW
}
__device__ __forceinline__ void moe_offsets(Frame& F, int li, int (&cnt)[8], int (&off)[9]) {
    off[0] = 0;
#pragma unroll
    for (int e = 0; e < 8; ++e) { cnt[e] = (int)__hip_atomic_load((unsigned*)(((gu32*)F.ws) + CW_CNT + 64 * li + e), __ATOMIC_RELAXED, __HIP_MEMORY_SCOPE_AGENT); off[e + 1] = off[e] + ((cnt[e] + 255) & ~255); }
}
__device__ __forceinline__ void p7b_gather(Frame& F, int l) {
    refresh(F);
    const int li = l >> 1; int cnt[8], off[9]; moe_offsets(F, li, cnt, off);
    const bf16* H2 = (const bf16*)(F.ws + WS_H2); bf16* HG = (bf16*)(F.ws + WS_HG);
    const int* TOPE = (const int*)(F.ws + WS_TOPE); const int* LIDX = (const int*)(F.ws + WS_LIDX); const float* TOPW = (const float*)(F.ws + WS_TOPW); const int* BLKB = (const int*)(F.ws + WS_BLKB);
    int* RMAP = (int*)(F.ws + WS_RMAP); float* ROWW = (float*)(F.ws + WS_ROWW);
    constexpr int RB = FFN_F8 ? DM : 2 * DM, LB = RB / 64;
    const unsigned char* H2b = (const unsigned char*)H2; unsigned char* HGb = (unsigned char*)HG;
    const bool lastl = (l == DEPTH - 1); const int NR = lastl ? NBATCH * SEQ : M;
    const int rpw = (NR + F.NGW - 1) / F.NGW, r0 = F.gw * rpw, r1 = (r0 + rpw < NR) ? r0 + rpw : NR;
    for (int ri = r0; ri < r1; ++ri) {
        const int r = lastl ? (ri / SEQ) * TPB + CTX + ri % SEQ : ri;
        const int te = TOPE[r];
        v4u a, bq = {0u, 0u, 0u, 0u}; a = *(const v4u*)(H2b + (size_t)r * RB + F.lane * LB); if constexpr (!FFN_F8) bq = *(const v4u*)(H2b + (size_t)r * RB + F.lane * LB + 16);
#pragma unroll
        for (int s = 0; s < 2; ++s) {
            const int e = (te >> (8 * s)) & 0xff;
            int o = 0;
#pragma unroll
            for (int q = 0; q < 8; ++q) o = (q == e) ? off[q] : o;
            const int pos = o + BLKB[F.blk * 8 + e] + LIDX[2 * r + s];
            *(v4u*)(HGb + (size_t)pos * RB + F.lane * LB) = a; if constexpr (!FFN_F8) *(v4u*)(HGb + (size_t)pos * RB + F.lane * LB + 16) = bq;
            if (F.lane == 0) { RMAP[pos] = r | (s << 30); ROWW[pos] = TOPW[2 * r + s]; }
        }
    }
#pragma unroll
    for (int e = 0; e < 8; ++e) {
        const int npad = off[e + 1] - off[e] - cnt[e];
        for (int i = F.gw; i < npad; i += F.NGW) { const int pos = off[e] + cnt[e] + i; const unsigned zz = (unsigned)F.z; const v4u z = {zz, zz, zz, zz};
            *(v4u*)(HGb + (size_t)pos * RB + F.lane * LB) = z; if constexpr (!FFN_F8) *(v4u*)(HGb + (size_t)pos * RB + F.lane * LB + 16) = z;
            if (F.lane == 0) { RMAP[pos] = -1; ROWW[pos] = 0.f; } }
    }
}

__global__ void __launch_bounds__(NWAVES * 64, 2) mk_fwd(Args args) {
    extern __shared__ __attribute__((aligned(16))) unsigned char lds[];
    Frame F;
    F.lds = (LAS unsigned char*)lds;
    F.MISC = (volatile LAS unsigned*)(F.lds + MISC_OFF);
    F.tid = threadIdx.x; F.lane = F.tid & 63; F.wave = __builtin_amdgcn_readfirstlane(F.tid >> 6); F.wv = F.wave;
    F.G = gridDim.x; F.blk = blockIdx.x; F.gw = F.blk * NWAVES + F.wave; F.NGW = F.G * NWAVES;
    F.ws = args.ws;
    F.A = &args;
    for (int u = F.tid; u < 128; u += NWAVES * 64) F.MISC[u] = 0u;
    __syncthreads();
    { XcdBarrier b0 = xcd_barrier_post((unsigned*)F.ws + CW_BAR, F.MISC + 8); (void)b0; }
#define GRID_BAR() do { XcdBarrier b_; b_.bar = (unsigned*)F.ws + CW_BAR; b_.x = xb_xcc_id(); b_.st = F.MISC + 8; refresh(F); xcd_barrier(b_, F.tid == 0); } while (0)

    p0_mod(F); p0_misc(F); convert_weights(F, 0);
    GRID_BAR();
    for (int l = 0; l < DEPTH; ++l) {
        const bool moe = l & 1; const int li = l >> 1;
        { unsigned char* wsp = args.ws; asm volatile("" : "+s"(wsp)); F.ws = wsp; }
        p1_rows(F, l);
        if (l > 0) convert_weights(F, l);
        GRID_BAR();
        {
            refresh(F);
            pg8::Gemm g{(const pg8::bf16_t*)(F.ws + WS_H), (const pg8::bf16_t*)(F.ws + WS_WIN), M, NP, DM};
            pg8::StaticOrder S; S.init(M, NP, F.G, F.blk);
            pg8::EpiProj E{(pg8::bf16_t*)(F.ws + WS_PROJ), (const float*)(F.ws + WS_ROPE), (const float*)(F.ws + WS_ROPE) + 1024, (unsigned*)F.ws + CW_KMX + 256 * l};
            pg8::gemm_phase<pg8::EpiProj, pg8::StaticOrder, true, true>(F.lds, g, S, E, F.wave);
        }
        GRID_BAR();
        p3_mixer(F, l);
        GRID_BAR();
        p5_merge_all(F, l);
        GRID_BAR();
        {
            refresh(F);
            pg8::Gemm g{(const pg8::bf16_t*)(F.ws + WS_H), (const pg8::bf16_t*)(F.ws + WS_WOUT), M, DM, DM};
            const int lastl = (l == DEPTH - 1);
            pg8::LatOrder S; S.S.init(lastl ? NBATCH * SEQ : M, DM, F.G, F.blk); S.lat = lastl;
            pg8::EpiF32 E{(pg8::bf16_t*)(F.ws + WS_Y)};
            pg8::gemm_phase<pg8::EpiF32, pg8::LatOrder, true, true>(F.lds, g, S, E, F.wave);
        }
        GRID_BAR();
        p7_rows(F, l);
        GRID_BAR();
        if (moe) { p7b_gather(F, l); GRID_BAR(); }
        int ntiles = M / 256;
        {
            refresh(F);
            LAS int* texp = (LAS int*)(F.lds + TEXP_OFF);
            if (moe) { int cnt[8], off[9]; moe_offsets(F, li, cnt, off); ntiles = off[8] >> 8;
                for (int t = F.tid; t < ntiles; t += 512) { int e = 0;
#pragma unroll
                    for (int q = 1; q < 8; ++q) e += ((t << 8) >= off[q]) ? 1 : 0;
                    texp[t] = e; } }
            else { for (int t = F.tid; t < ntiles; t += 512) texp[t] = 0; }
            __syncthreads();
        }
        {
            refresh(F);
            pg8::Gemm g{(const pg8::bf16_t*)(F.ws + (moe ? WS_HG : WS_H2)), (const pg8::bf16_t*)(F.ws + WS_WUP), ntiles * 256, 2 * DFF, FFN_F8 ? DM / 2 : DM};
            pg8::GroupedOrder S; S.S.init(ntiles * 256, 2 * DFF, F.G, F.blk); S.texp = (const LAS int*)(F.lds + TEXP_OFF); S.nN = 22;
            pg8::EpiSwiglu E{(pg8::bf16_t*)(F.ws + WS_U)};
            pg8::gemm_phase<pg8::EpiSwiglu, pg8::GroupedOrder, true, true, FFN_F8 != 0>(F.lds, g, S, E, F.wave);
        }
        GRID_BAR();
        {
            refresh(F);
            pg8::Gemm g{(const pg8::bf16_t*)(F.ws + WS_U), (const pg8::bf16_t*)(F.ws + WS_WDN), ntiles * 256, DM, FFN_F8 ? DFF / 2 : DFF};
            pg8::GroupedOrder S; S.S.init(ntiles * 256, DM, F.G, F.blk); S.texp = (const LAS int*)(F.lds + TEXP_OFF); S.nN = 4;
            pg8::EpiDown E{(pg8::bf16_t*)(F.ws + WS_F2), (const int*)(F.ws + WS_RMAP), (const float*)(F.ws + WS_ROWW), moe ? 0 : 1};
            pg8::gemm_phase<pg8::EpiDown, pg8::GroupedOrder, true, true, FFN_F8 != 0>(F.lds, g, S, E, F.wave);
        }
        GRID_BAR();
    }
    pf_final(F);
}

extern "C" void kernel_launch(void* const* d_in, const int* in_sizes, int n_in, void* d_out, int out_size, void* d_ws, size_t ws_size, hipStream_t stream) {
    static int grid = 0;
    if (grid == 0) {
        if (n_in != 24 || out_size != NBATCH * SEQ * DM || ws_size < WS_END) { fprintf(stderr, "kernel_launch: unexpected shapes or workspace (%d inputs, out %d, ws %zu < %zu)\n", n_in, out_size, ws_size, (size_t)WS_END); grid = -1; return; }
        int dev = 0, cus = 0, per_cu = 0;
        if (hipGetDevice(&dev) != hipSuccess || hipDeviceGetAttribute(&cus, hipDeviceAttributeMultiprocessorCount, dev) != hipSuccess) { grid = -1; return; }
        if (hipFuncSetAttribute((const void*)mk_fwd, hipFuncAttributeMaxDynamicSharedMemorySize, LDS_BYTES) != hipSuccess) { grid = -1; return; }
        if (hipOccupancyMaxActiveBlocksPerMultiprocessor(&per_cu, (const void*)mk_fwd, NWAVES * 64, LDS_BYTES) != hipSuccess || per_cu < 1) { fprintf(stderr, "kernel_launch: occupancy query says %d\n", per_cu); }
        (void)hipGetLastError();
        grid = cus;
    }
    if (grid < 0) return;
    if (hipMemsetAsync((char*)d_ws + WS_CTL, 0, CTL_ZERO_BYTES, stream) != hipSuccess) return;
    Args a{};
    for (int i = 0; i < 24; ++i) a.in[i] = (const float*)d_in[i];
    a.out = (float*)d_out; a.ws = (unsigned char*)d_ws;
    hipLaunchKernelGGL(mk_fwd, dim3(grid), dim3(NWAVES * 64), LDS_BYTES, stream, a);
}
```

```cpp
#include <hip/hip_runtime.h>
#include <cstdio>
#include <cstdint>
namespace pg8 {
#define PG8_LAS __attribute__((address_space(3)))
typedef unsigned short bf16_t;
__device__ __forceinline__ int lane_id_opaque() { int l; asm volatile("v_mbcnt_lo_u32_b32 %0, -1, 0\n\tv_mbcnt_hi_u32_b32 %0, -1, %0" : "=v"(l)); return l; }
typedef short bf16x8 __attribute__((ext_vector_type(8)));
typedef float f32x4 __attribute__((ext_vector_type(4)));
typedef unsigned u32x4 __attribute__((ext_vector_type(4)));
constexpr int BM = 256, BK = 64, HALF = 128, HTB = HALF * BK * 2  , STAGE_BYTES = 8 * HTB, NXCD = 8, WGM = 8;

__host__ __device__ __forceinline__ int lds_byte(int r, int c) { const int st = (r >> 4) * 2 + (c >> 5), rr = r & 15, cc = c & 31, ob = rr * 64 + cc * 2; return st * 1024 + (ob ^ (((ob >> 9) & 1) << 5)); }
__host__ __device__ __forceinline__ void stage_rc(int b, int& R, int& C) { const int st = b / 1024, sb = b % 1024, swz = sb ^ (((sb >> 9) & 1) << 5); R = (st >> 1) * 16 + swz / 64; C = (st & 1) * 32 + (swz % 64) / 2; }
__host__ __device__ __forceinline__ int perm32(int rho) { const int n = rho >> 4, i = rho & 15; return 8 * (i >> 2) + 4 * n + (i & 3); }

struct Unit { int pm, pn; };
struct Gemm { const bf16_t* A; const bf16_t* Bt; int M, N, K; };

struct StaticOrder {
    int nM, nN, nwg, G, c;
    __host__ __device__ void init(int M, int N, int G_, int c_) { nM = M / BM; nN = N / BM; nwg = nM * nN; G = G_; c = c_; }
    __host__ __device__ bool next(int i, Unit& u) const {
        const long L = (long)i * G + c; if (L >= nwg) return false;
        int wgid = (int)L; { const int q = nwg / NXCD, r = nwg % NXCD, xcd = wgid % NXCD, off = wgid / NXCD; wgid = (xcd < r ? xcd * (q + 1) : r * (q + 1) + (xcd - r) * q) + off; }
        const int nig = WGM * nN, gid = wgid / nig, fm = gid * WGM, gsz = (nM - fm) < WGM ? (nM - fm) : WGM;
        u.pm = fm + ((wgid % nig) % gsz); u.pn = (wgid % nig) / gsz; return true;
    }
    __device__ __forceinline__ void a_ready(const Unit&) const {}
    __device__ __forceinline__ void done(const Unit&) const {}
};

__device__ __forceinline__ unsigned cvt_pk_bf16(float lo, float hi) { unsigned r; asm volatile("v_cvt_pk_bf16_f32 %0, %1, %2" : "=v"(r) : "v"(lo), "v"(hi)); return r; }
typedef float f32x2 __attribute__((ext_vector_type(2)));
template <class Epi, class Sched, bool ALIGN_EPI = false, bool SP2 = false, bool F8 = false>
__device__ __forceinline__ void gemm_phase(PG8_LAS unsigned char* lds, const Gemm g, const Sched& S, const Epi& E, const int wv  ) {
    int tid_ = wv * 64 + lane_id_opaque();
    const int tid = tid_, wid = __builtin_amdgcn_readfirstlane(tid >> 6), lane = tid & 63, wr = wid >> 2, wc = wid & 3, fr = lane & 15, fq = lane >> 4;
    const int K = g.K, nt = K / BK;
    unsigned voffA[2], voffB[2];
#pragma unroll
    for (int i = 0; i < 2; ++i) { int R, C; stage_rc(tid * 16 + i * 8192, R, C); const int Rb = Epi::PERM ? ((R & ~31) + perm32(R & 31)) : R;
        voffA[i] = (unsigned)(R * K + C) * 2u; voffB[i] = (unsigned)(Rb * K + C) * 2u; }
    const size_t kstep = (size_t)(BK * 2);
    const size_t hstep = (size_t)HALF * K * 2;
    const size_t tstep = 2 * hstep;
    const unsigned ldsw = (unsigned)wid * 1024u;
    const int aoff = lds_byte(wr * 64 + fr, fq * 8), boff = lds_byte(wc * 32 + fr, fq * 8);
#define PG8_SA(b, h) (((b) * 2 + (h)) * HTB)
#define PG8_SB(b, h) ((4 + (b) * 2 + (h)) * HTB)
#define PG8_STAGE(bufoff, gbase, voff) do { _Pragma("unroll") for (int _i = 0; _i < 2; ++_i) \
        __builtin_amdgcn_global_load_lds((const __attribute__((address_space(1))) unsigned*)((const __attribute__((address_space(1))) char*)(gbase) + (voff)[_i]), (PG8_LAS unsigned*)(lds + (bufoff) + ldsw + _i * 8192), 16, 0, 0); } while (0)
#define PG8_LDA(dst, b, h) do { _Pragma("unroll") for (int m = 0; m < 4; ++m) _Pragma("unroll") for (int k = 0; k < 2; ++k) dst[m][k] = *(const PG8_LAS bf16x8*)(lds + PG8_SA(b, h) + aoff + m * 2048 + k * 1024); } while (0)
#define PG8_LDB(dst, b, h) do { _Pragma("unroll") for (int n = 0; n < 2; ++n) _Pragma("unroll") for (int k = 0; k < 2; ++k) dst[n][k] = *(const PG8_LAS bf16x8*)(lds + PG8_SB(b, h) + boff + n * 2048 + k * 1024); } while (0)
#define PG8_MMA(ai, bj, At, Bt) do { if constexpr (F8) __builtin_amdgcn_sched_barrier(0); __builtin_amdgcn_s_setprio(1); _Pragma("unroll") for (int m = 0; m < 4; ++m) _Pragma("unroll") for (int n = 0; n < 2; ++n) { \
        if constexpr (F8) { typedef int i32x4_ __attribute__((ext_vector_type(4))); \
            acc[ai][bj][m][n] = __builtin_amdgcn_mfma_scale_f32_16x16x128_f8f6f4(__builtin_shufflevector(__builtin_bit_cast(i32x4_, Bt[n][0]), __builtin_bit_cast(i32x4_, Bt[n][1]), 0, 1, 2, 3, 4, 5, 6, 7), \
                __builtin_shufflevector(__builtin_bit_cast(i32x4_, At[m][0]), __builtin_bit_cast(i32x4_, At[m][1]), 0, 1, 2, 3, 4, 5, 6, 7), acc[ai][bj][m][n], 0, 0, 0, 0x7f7f7f7f, 0, 0x7f7f7f7f); } \
        else { _Pragma("unroll") for (int k = 0; k < 2; ++k) acc[ai][bj][m][n] = __builtin_amdgcn_mfma_f32_16x16x32_bf16(Bt[n][k], At[m][k], acc[ai][bj][m][n], 0, 0, 0); } } \
        __builtin_amdgcn_s_setprio(0); if constexpr (F8) __builtin_amdgcn_sched_barrier(0); } while (0)
#define PG8_WAIT_V(n) asm volatile("s_waitcnt vmcnt(" #n ")" ::: "memory")
#define PG8_WAIT_L(n) asm volatile("s_waitcnt lgkmcnt(" #n ")" ::: "memory")
#define PG8_BAR __builtin_amdgcn_s_barrier()
#define PG8_SCHED __builtin_amdgcn_sched_barrier(0)
    Unit cur, nxt; int ui = 0;
    if (!S.next(0, cur)) return;
    f32x4 acc[2][2][4][2];
#pragma unroll
    for (int a = 0; a < 2; ++a)
#pragma unroll
        for (int b = 0; b < 2; ++b)
#pragma unroll
            for (int m = 0; m < 4; ++m)
#pragma unroll
                for (int n = 0; n < 2; ++n) acc[a][b][m][n] = (f32x4){0.f, 0.f, 0.f, 0.f};
    bf16x8 At[4][2], B0[2][2], B1[2][2];
    const char* cA = (const char*)g.A + (size_t)cur.pm * tstep; const char* cB = (const char*)g.Bt + (size_t)cur.pn * tstep;
    S.a_ready(cur);
    if constexpr (SP2) {
        PG8_STAGE(PG8_SB(0, 0), cB, voffB); PG8_STAGE(PG8_SB(0, 1), cB + hstep, voffB); PG8_STAGE(PG8_SA(0, 0), cA, voffA); PG8_STAGE(PG8_SA(0, 1), cA + hstep, voffA);
        if (wr == 1) PG8_BAR;
        PG8_WAIT_V(2); PG8_BAR;
        PG8_STAGE(PG8_SB(1, 0), cB + kstep, voffB); PG8_STAGE(PG8_SA(1, 0), cA + kstep, voffA); PG8_STAGE(PG8_SB(1, 1), cB + hstep + kstep, voffB);
        PG8_WAIT_V(6); PG8_BAR;
    } else {
        PG8_STAGE(PG8_SB(0, 0), cB, voffB); PG8_STAGE(PG8_SA(0, 0), cA, voffA); PG8_STAGE(PG8_SB(0, 1), cB + hstep, voffB); PG8_STAGE(PG8_SA(0, 1), cA + hstep, voffA);
        if (wr == 1) PG8_BAR;
        PG8_WAIT_V(4); PG8_BAR;
        PG8_STAGE(PG8_SB(1, 0), cB + kstep, voffB); PG8_STAGE(PG8_SA(1, 0), cA + kstep, voffA); PG8_STAGE(PG8_SB(1, 1), cB + hstep + kstep, voffB);
        PG8_WAIT_V(6); PG8_BAR;
    }
    for (;;) {
        const bool has_next = S.next(ui + 1, nxt);
        const char* nA = has_next ? (const char*)g.A + (size_t)nxt.pm * tstep : cA; const char* nB = has_next ? (const char*)g.Bt + (size_t)nxt.pn * tstep : cB;
        for (int t = 0; t < nt; t += 2) {
            const bool last = (t == nt - 2);
            const char* a1 = cA + (size_t)(t + 1) * kstep;
            const char* a2 = last ? nA : cA + (size_t)(t + 2) * kstep; const char* b2 = last ? nB : cB + (size_t)(t + 2) * kstep;
            const char* a3 = a2 + kstep; const char* b3 = b2 + kstep;
            if (last && has_next) S.a_ready(nxt);
            if constexpr (SP2) {
            PG8_LDB(B0, 0, 0); PG8_LDB(B1, 0, 1); PG8_SCHED; PG8_LDA(At, 0, 0); PG8_STAGE(PG8_SA(1, 1), a1 + hstep, voffA);
            PG8_WAIT_V(8); PG8_WAIT_L(0); PG8_BAR; PG8_MMA(0, 0, At, B0); PG8_MMA(0, 1, At, B1); PG8_BAR; PG8_SCHED;
            PG8_LDA(At, 0, 1); PG8_STAGE(PG8_SB(0, 0), b2, voffB); PG8_STAGE(PG8_SB(0, 1), b2 + hstep, voffB); PG8_STAGE(PG8_SA(0, 0), a2, voffA);
            PG8_WAIT_V(8); PG8_WAIT_L(0); PG8_BAR; PG8_MMA(1, 0, At, B0); PG8_MMA(1, 1, At, B1); PG8_BAR; PG8_SCHED;
            PG8_LDB(B0, 1, 0); PG8_LDB(B1, 1, 1); PG8_SCHED; PG8_LDA(At, 1, 0); PG8_STAGE(PG8_SA(0, 1), a2 + hstep, voffA);
            PG8_WAIT_V(8); PG8_WAIT_L(0); PG8_BAR; PG8_MMA(0, 0, At, B0); PG8_MMA(0, 1, At, B1); PG8_BAR; PG8_SCHED;
            PG8_LDA(At, 1, 1); PG8_STAGE(PG8_SB(1, 0), b3, voffB); PG8_STAGE(PG8_SB(1, 1), b3 + hstep, voffB); PG8_STAGE(PG8_SA(1, 0), a3, voffA);
            PG8_WAIT_V(8); PG8_WAIT_L(0); PG8_BAR; PG8_MMA(1, 0, At, B0); PG8_MMA(1, 1, At, B1); PG8_BAR; PG8_SCHED;
            } else {
            PG8_LDB(B0, 0, 0); PG8_SCHED; PG8_LDA(At, 0, 0); PG8_STAGE(PG8_SA(1, 1), a1 + hstep, voffA);
            PG8_WAIT_L(8); PG8_BAR; PG8_WAIT_L(0); PG8_MMA(0, 0, At, B0); PG8_BAR; PG8_SCHED;
            PG8_LDB(B1, 0, 1); PG8_STAGE(PG8_SB(0, 0), b2, voffB);
            PG8_BAR; PG8_WAIT_L(0); PG8_MMA(0, 1, At, B1); PG8_BAR;
            PG8_LDA(At, 0, 1); PG8_STAGE(PG8_SA(0, 0), a2, voffA);
            PG8_BAR; PG8_WAIT_L(0); PG8_MMA(1, 0, At, B0); PG8_BAR; PG8_SCHED;
            PG8_STAGE(PG8_SB(0, 1), b2 + hstep, voffB);
            PG8_WAIT_V(6); PG8_BAR; PG8_MMA(1, 1, At, B1); PG8_BAR;
            PG8_LDB(B0, 1, 0); PG8_SCHED; PG8_LDA(At, 1, 0); PG8_STAGE(PG8_SA(0, 1), a2 + hstep, voffA);
            PG8_WAIT_L(8); PG8_BAR; PG8_WAIT_L(0); PG8_MMA(0, 0, At, B0); PG8_BAR; PG8_SCHED;
            PG8_LDB(B1, 1, 1); PG8_STAGE(PG8_SB(1, 0), b3, voffB);
            PG8_BAR; PG8_WAIT_L(0); PG8_MMA(0, 1, At, B1); PG8_BAR;
            PG8_LDA(At, 1, 1); PG8_STAGE(PG8_SA(1, 0), a3, voffA);
            PG8_BAR; PG8_WAIT_L(0); PG8_MMA(1, 0, At, B0); PG8_BAR; PG8_SCHED;
            PG8_STAGE(PG8_SB(1, 1), b3 + hstep, voffB);
            PG8_WAIT_V(6); PG8_BAR; PG8_MMA(1, 1, At, B1); PG8_BAR;
            }
        }
        if constexpr (ALIGN_EPI) { if (wr == 0) PG8_BAR; }
        if constexpr (!Epi::AFTER_DRAIN) { const int t2_ = lane_id_opaque(); const int fr_ = t2_ & 15, fq_ = (t2_ & 63) >> 4;
            E(acc, cur, wr, wc, fr_, fq_); S.done(cur); }
        if (!has_next) break;
#pragma unroll
        for (int a = 0; a < 2; ++a)
#pragma unroll
            for (int b = 0; b < 2; ++b)
#pragma unroll
                for (int m = 0; m < 4; ++m)
#pragma unroll
                    for (int n = 0; n < 2; ++n) acc[a][b][m][n] = (f32x4){0.f, 0.f, 0.f, 0.f};
        cur = nxt; cA = nA; cB = nB; ++ui;
        if constexpr (ALIGN_EPI) { if (wr == 1) PG8_BAR; }
    }
    PG8_WAIT_V(0);
    if constexpr (!ALIGN_EPI) { if (wr == 0) PG8_BAR; }
    PG8_BAR;
    if constexpr (Epi::AFTER_DRAIN) { E.fused(acc, cur, wr, wc, fr, fq, lds, wid, lane); S.done(cur); }
#undef PG8_SA
#undef PG8_SB
#undef PG8_STAGE
#undef PG8_LDA
#undef PG8_LDB
#undef PG8_MMA
#undef PG8_WAIT_V
#undef PG8_WAIT_L
#undef PG8_BAR
#undef PG8_SCHED
}
}
#define GAS __attribute__((address_space(1)))
#define LAS __attribute__((address_space(3)))
typedef unsigned short bf16;
typedef unsigned v4u __attribute__((ext_vector_type(4)));
typedef float f32x4 __attribute__((ext_vector_type(4)));
typedef short bf16x8 __attribute__((ext_vector_type(8)));
typedef GAS unsigned gu32;
typedef GAS unsigned long long gu64;
#define RLX_AGENT __ATOMIC_RELAXED, __HIP_MEMORY_SCOPE_AGENT
#define LDS_WAIT() asm volatile("s_waitcnt lgkmcnt(0)" ::: "memory")
#define VM_WAIT() asm volatile("s_waitcnt vmcnt(0)" ::: "memory")
__device__ __forceinline__ unsigned long long rt() { return __builtin_amdgcn_s_memrealtime(); }
__device__ __forceinline__ unsigned f2bf(float f) { unsigned u = __builtin_bit_cast(unsigned, f); return (u + 0x7fffu + ((u >> 16) & 1u)) >> 16; }
__device__ __forceinline__ unsigned pk2(float lo, float hi) { return f2bf(lo) | (f2bf(hi) << 16); }

#define XB_TMO      128
#define XB_XCNT(j)  (256  + 64 * (j))
#define XB_XSUB(j)  (1280 + 64 * (j))
#define XB_XGEN(j)  (2304 + 64 * (j))
#define XB_TOP      3328
#define XB_TOPGEN   3392
#define XCD_BAR_WORDS 3456
#define XB_SPIN_CAP (1u << 18)

__device__ __forceinline__ unsigned xb_ld(unsigned* p)              { return __hip_atomic_load(p, __ATOMIC_RELAXED, __HIP_MEMORY_SCOPE_AGENT); }
__device__ __forceinline__ unsigned xb_add(unsigned* p, unsigned v) { return __hip_atomic_fetch_add(p, v, __ATOMIC_RELAXED, __HIP_MEMORY_SCOPE_AGENT); }
__device__ __forceinline__ unsigned xb_xcc_id() { return (unsigned)__builtin_amdgcn_s_getreg((3 << 11) | 20) & 0xFu; }
#define XB_SPIN(cond, bar) do { unsigned _sp = 0; while (cond) { __builtin_amdgcn_s_sleep(1); \
    if ((++_sp & 255u) == 0u) { if (xb_ld(&(bar)[XB_TMO])) break; if (_sp > XB_SPIN_CAP) { atomicAdd(&(bar)[XB_TMO], 1u); break; } } } } while (0)

struct XcdBarrier {
    unsigned* bar; unsigned x;
    volatile LAS unsigned* st;
};

__device__ __forceinline__ XcdBarrier xcd_barrier_post(unsigned* bar, volatile LAS unsigned* st) {
    XcdBarrier b; b.bar = bar; b.x = xb_xcc_id(); b.st = st;
    if (threadIdx.x == 0) (void)xb_add(&bar[XB_XCNT(b.x)], 1u);
    return b;
}
__device__ __forceinline__ void xcd_barrier_complete(unsigned* bar, unsigned x, unsigned& nloc, unsigned& nx) {
    const unsigned G = gridDim.x * gridDim.y * gridDim.z;
    unsigned sum, cnt, mine, sp = 0u;
    for (;;) {
        sum = 0u; cnt = 0u; mine = 0u;
#pragma unroll
        for (unsigned j = 0; j < 16; ++j) { const unsigned c = xb_ld(&bar[XB_XCNT(j)]); sum += c; cnt += (c > 0u) ? 1u : 0u; mine = (j == x) ? c : mine; }
        if (sum == G) break;
        __builtin_amdgcn_s_sleep(1);
        if ((++sp & 255u) == 0u) { if (xb_ld(&bar[XB_TMO])) break; if (sp > XB_SPIN_CAP) { atomicAdd(&bar[XB_TMO], 1u); break; } }
    }
    nloc = mine > 0u ? mine : 1u; nx = cnt > 0u ? cnt : 1u;
}

__device__ __forceinline__ void xcd_barrier(const XcdBarrier& b, const bool leader  ) {
    asm volatile("s_waitcnt vmcnt(0)" ::: "memory");
    __syncthreads();
    if (leader) {
        unsigned* bar = b.bar; asm volatile("" : "+s"(bar));
        __builtin_amdgcn_s_waitcnt(0);
        unsigned nloc = b.st[0], nx = b.st[1];
        if (nloc == 0u) { xcd_barrier_complete(bar, b.x, nloc, nx); b.st[0] = nloc; b.st[1] = nx; }
        const unsigned old = xb_add(&bar[XB_XSUB(b.x)], 1u);
        const unsigned gen = old / nloc;
        if (old + 1u == (gen + 1u) * nloc) {
            __builtin_amdgcn_fence(__ATOMIC_RELEASE, "agent");
            asm volatile("s_waitcnt vmcnt(0)" ::: "memory");
            const unsigned og = xb_add(&bar[XB_TOP], 1u);
            const unsigned tg = og / nx;
            if (og + 1u == (tg + 1u) * nx) xb_add(&bar[XB_TOPGEN], 1u);
            else XB_SPIN(xb_ld(&bar[XB_TOPGEN]) == tg, bar);
            __builtin_amdgcn_fence(__ATOMIC_ACQUIRE, "agent");
            xb_add(&bar[XB_XGEN(b.x)], 1u);
            asm volatile("s_waitcnt vmcnt(0)" ::: "memory");
        } else {
            XB_SPIN(xb_ld(&bar[XB_XGEN(b.x)]) == gen, bar);
            __builtin_amdgcn_fence(__ATOMIC_ACQUIRE, "agent");
            asm volatile("s_waitcnt vmcnt(0)" ::: "memory");
        }
    }
    __syncthreads();
}

#ifndef FFN_F8
#define FFN_F8 1
#endif
constexpr int NWAVES = 8;
constexpr float W8S = 32.f, U8S = 4.f;
constexpr int DM = 1024, NBATCH = 16, SEQ = 2048, CTX = 256, TPB = SEQ + CTX, M = NBATCH * TPB;
constexpr int DEPTH = 4, NIN = 3104, NP = 3328, DFF = 2816, NE = 8;
constexpr int MP = 2 * M + NE * 256;
constexpr int C_Q = 0, C_K = 512, C_V = 1024, C_GQ = 1536, C_GK = 1792, C_GV = 2048, C_GG = 2560, C_GLR = 3072;
constexpr float EPS = 1e-6f;
constexpr float C2 = 0.125f * 1.4426950408889634f;
constexpr int NCH = TPB / 64;
constexpr int NGLA = NBATCH * 4 * 2 * NCH;

constexpr size_t MiB = 1u << 20;
constexpr size_t WS_CTL = 0, CTL_ZERO_BYTES = 1 * MiB;
constexpr size_t WS_MOD = 1 * MiB;
constexpr size_t WS_ROPE = 3 * MiB;
constexpr size_t WS_TOPE = 4 * MiB;
constexpr size_t WS_LIDX = WS_TOPE + 160 * 1024;
constexpr size_t WS_TOPW = WS_LIDX + 320 * 1024;
constexpr size_t WS_BLKB = WS_TOPW + 320 * 1024;
constexpr size_t WS_RMAP = WS_BLKB + 64 * 1024;
constexpr size_t WS_ROWW = WS_RMAP + 320 * 1024;
static_assert(WS_ROWW + 320 * 1024 <= 6 * MiB, "small tables");
constexpr size_t WS_X = 6 * MiB;
constexpr size_t WS_WIN = 150 * MiB;
constexpr size_t WS_WOUT = WS_WIN + 13 * MiB / 2;
constexpr size_t WS_WUP = WS_WOUT + 2 * MiB;
constexpr size_t WS_WDN = WS_WUP + 88 * MiB;
constexpr size_t WS_D = 291 * MiB;
static_assert(WS_WDN + 44 * MiB <= WS_D, "weights");
constexpr size_t WS_PROJ = WS_D;
constexpr size_t WS_OD = WS_D + 234 * MiB;
constexpr size_t WS_DS = WS_D + 306 * MiB;
constexpr size_t WS_DEC = WS_D + 450 * MiB;
constexpr size_t WS_H = WS_D + 452 * MiB;
constexpr size_t WS_Y = WS_D;
constexpr size_t WS_HG = WS_D;
constexpr size_t WS_F2 = WS_D;
constexpr size_t WS_U = WS_D + 148 * MiB;
constexpr size_t WS_H2 = WS_D + 483 * MiB;
constexpr size_t WS_END = WS_D + 555 * MiB;
static_assert((size_t)MP * DFF * 2 <= 407 * MiB && (size_t)MP * DM * 2 <= 148 * MiB && (size_t)M * NP * 2 <= 234 * MiB, "dynamic map");
static_assert((size_t)M * DFF * 2 + 148 * MiB <= 483 * MiB, "dense U clear of H2");

constexpr int CW_BAR = 4096;
constexpr int CW_CNT = 8192;

constexpr int RING_BYTES = 131072;
constexpr int TEXP_OFF = 139264;
constexpr int MISC_OFF = 146432 - 512;
constexpr int LDS_BYTES = 147456;

typedef unsigned u32x2 __attribute__((ext_vector_type(2)));

__device__ __forceinline__ float bf2f(unsigned short x) { return __uint_as_float((unsigned)x << 16); }
__device__ __forceinline__ float bflo(unsigned w) { return __uint_as_float(w << 16); }
__device__ __forceinline__ float bfhi(unsigned w) { return __uint_as_float(w & 0xffff0000u); }
__device__ __forceinline__ float siluf(float x) { return x * __builtin_amdgcn_rcpf(1.f + __expf(-x)); }
__device__ __forceinline__ float clamp8(float x) { return fminf(fmaxf(x, -448.f), 448.f); }
__device__ __forceinline__ unsigned pk4_f8(float a, float b, float c, float d) { unsigned w = 0u; w = __builtin_amdgcn_cvt_pk_fp8_f32(clamp8(a), clamp8(b), w, false); w = __builtin_amdgcn_cvt_pk_fp8_f32(clamp8(c), clamp8(d), w, true); return w; }
template <int MASK> __device__ __forceinline__ float xadd(float v) {
    if constexpr (MASK == 32) { const auto rr = __builtin_amdgcn_permlane32_swap(__float_as_uint(v), __float_as_uint(v), false, false); return __uint_as_float(rr[0]) + __uint_as_float(rr[1]); }
    else return v + __int_as_float(__builtin_amdgcn_ds_swizzle(__float_as_int(v), 0x1f | (MASK << 10)));
}
__device__ __forceinline__ float wave_sum(float v) {
    v = xadd<1>(v); v = xadd<2>(v); v = xadd<4>(v); v = xadd<8>(v); v = xadd<16>(v); v = xadd<32>(v);
    return v;
}

struct Args { const float* in[24]; float* out; unsigned char* ws; };
struct Frame {
    LAS unsigned char* lds;
    volatile LAS unsigned* MISC;
    int tid, lane, wave, G, blk, gw, NGW, z, wv;
    const Args* A;
    unsigned char* ws;
};


__device__ __forceinline__ void refresh(Frame& F) {
    int wv = F.wv; asm volatile("" : "+s"(wv));
    const int t = wv * 64 + pg8::lane_id_opaque();
    int bl = blockIdx.x, z = 0, gg = gridDim.x; asm volatile("" : "+s"(bl), "+s"(z), "+s"(gg));
    F.blk = bl; F.z = z; F.G = gg; F.NGW = gg * NWAVES;
    F.tid = t; F.lane = t & 63; F.wave = wv; F.gw = F.blk * NWAVES + F.wave;
}
#define INP(k) (F.A->in[(k) + F.z])
namespace pg8 {
struct EpiProj {
    static constexpr bool PERM = true, AFTER_DRAIN = false;
    bf16_t* P; const float* ropec; const float* ropes; unsigned* kmx;
    __device__ __forceinline__ void operator()(const f32x4 (&acc)[2][2][4][2], const Unit& u, int wr, int wc, int fr, int fq) const {
        const int pn = u.pn, pm = u.pm, tb = pm % 9;
        float kss[2] = {0.f, 0.f};
        const bool do_rope = (tb != 0) && (pn < 4);
        const float sc = (pn < 2) ? C2 : (pn == 6 ? 0.125f : 1.f);
        const bool st_ok_all = pn < 12;
#pragma unroll
        for (int ai = 0; ai < 2; ++ai)
#pragma unroll
            for (int m = 0; m < 4; ++m) {
                const int rit = ai * HALF + wr * 64 + m * 16 + fr;
                bf16_t* rowp = P + ((size_t)pm * BM + rit) * NP + pn * BM + wc * 32 + 8 * fq;
                const int s = (tb - 1) * 256 + rit;
                const int pos = (wc & 1) ? (s & 63) : (s >> 6);
                f32x4 cs = {1.f, 1.f, 1.f, 1.f}, sn = {0.f, 0.f, 0.f, 0.f};
                if (do_rope) { cs = *(const f32x4*)(ropec + pos * 16 + 4 * fq); sn = *(const f32x4*)(ropes + pos * 16 + 4 * fq); }
#pragma unroll
                for (int bj = 0; bj < 2; ++bj) {
                    f32x4 v0 = acc[ai][bj][m][0], v1 = acc[ai][bj][m][1];
                    if (do_rope) { const f32x4 a = v0 * cs - v1 * sn, b = v0 * sn + v1 * cs; v0 = a; v1 = b; }
                    v0 = v0 * sc; v1 = v1 * sc;
                    if (pn == 2 || pn == 3) { float ss = (v0[0] * v0[0] + v0[1] * v0[1]) + (v0[2] * v0[2] + v0[3] * v0[3]) + (v1[0] * v1[0] + v1[1] * v1[1]) + (v1[2] * v1[2] + v1[3] * v1[3]);
                        ss = xadd<16>(ss); ss = xadd<32>(ss); kss[bj] = fmaxf(kss[bj], ss); }
                    if (st_ok_all || (bj == 0 && wc == 0)) {
                        u32x4 w; w.x = cvt_pk_bf16(v0[0], v0[1]); w.y = cvt_pk_bf16(v0[2], v0[3]); w.z = cvt_pk_bf16(v1[0], v1[1]); w.w = cvt_pk_bf16(v1[2], v1[3]);
                        *(u32x4*)(rowp + bj * HALF) = w;
                    }
                }
            }
        if (pn == 2 || pn == 3) {
#pragma unroll
            for (int bj = 0; bj < 2; ++bj) { float v = kss[bj];
                v = fmaxf(v, __int_as_float(__builtin_amdgcn_update_dpp(0, __float_as_int(v), 0xB1, 0xF, 0xF, true)));
                v = fmaxf(v, __int_as_float(__builtin_amdgcn_update_dpp(0, __float_as_int(v), 0x4E, 0xF, 0xF, true)));
                v = fmaxf(v, __int_as_float(__builtin_amdgcn_update_dpp(0, __float_as_int(v), 0x141, 0xF, 0xF, true)));
                v = fmaxf(v, __int_as_float(__builtin_amdgcn_update_dpp(0, __float_as_int(v), 0x140, 0xF, 0xF, true)));
                if (fr == 0 && fq == 0) { const int hh = (pn - 2) * 4 + bj * 2 + (wc >> 1);
                    __hip_atomic_fetch_max(kmx + (((pm / 9) * 8 + hh) * 2 + (wc & 1)), __float_as_uint(v), __ATOMIC_RELAXED, __HIP_MEMORY_SCOPE_AGENT); } }
        }
    }
};
struct EpiF32 {
    static constexpr bool PERM = true, AFTER_DRAIN = false;
    bf16_t* Y;
    __device__ __forceinline__ void operator()(const f32x4 (&acc)[2][2][4][2], const Unit& u, int wr, int wc, int fr, int fq) const {
#pragma unroll
        for (int ai = 0; ai < 2; ++ai)
#pragma unroll
            for (int m = 0; m < 4; ++m) {
                bf16_t* rowp = Y + ((size_t)u.pm * BM + ai * HALF + wr * 64 + m * 16 + fr) * DM + u.pn * BM + wc * 32 + 8 * fq;
#pragma unroll
                for (int bj = 0; bj < 2; ++bj) { const f32x4 v0 = acc[ai][bj][m][0], v1 = acc[ai][bj][m][1];
                    u32x4 w; w.x = cvt_pk_bf16(v0[0], v0[1]); w.y = cvt_pk_bf16(v0[2], v0[3]); w.z = cvt_pk_bf16(v1[0], v1[1]); w.w = cvt_pk_bf16(v1[2], v1[3]);
                    *(u32x4*)(rowp + bj * HALF) = w; }
            }
    }
};
struct EpiSwiglu {
    static constexpr bool PERM = true, AFTER_DRAIN = false;
    bf16_t* U;
    __device__ __forceinline__ void operator()(const f32x4 (&acc)[2][2][4][2], const Unit& u, int wr, int wc, int fr, int fq) const {
        const int pnl = u.pn % 22;
        const int col0 = pnl * 128 + wc * 32 + 8 * fq;
        constexpr float ws = FFN_F8 ? 1.f / W8S : 1.f, us = FFN_F8 ? U8S : 1.f, kS = ws * ws * us, kE = -ws * 1.4426950408889634f;
        const float cE = -__builtin_log2f(kS), c1 = 1.f / kS;
#pragma unroll
        for (int ai = 0; ai < 2; ++ai)
#pragma unroll
            for (int m = 0; m < 4; ++m) {
                const size_t rowi = (size_t)u.pm * BM + ai * HALF + wr * 64 + m * 16 + fr;
                f32x2 g[4], up[4], t[4], r[4];
#pragma unroll
                for (int n = 0; n < 2; ++n) { g[2 * n] = (f32x2){acc[ai][0][m][n][0], acc[ai][0][m][n][1]}; g[2 * n + 1] = (f32x2){acc[ai][0][m][n][2], acc[ai][0][m][n][3]};
                                              up[2 * n] = (f32x2){acc[ai][1][m][n][0], acc[ai][1][m][n][1]}; up[2 * n + 1] = (f32x2){acc[ai][1][m][n][2], acc[ai][1][m][n][3]}; }
#pragma unroll
                for (int q = 0; q < 4; ++q) t[q] = g[q] * kE + cE;
#pragma unroll
                for (int q = 0; q < 4; ++q) { t[q].x = __builtin_amdgcn_exp2f(t[q].x); t[q].y = __builtin_amdgcn_exp2f(t[q].y); }
#pragma unroll
                for (int q = 0; q < 4; ++q) t[q] = t[q] + c1;
#pragma unroll
                for (int q = 0; q < 4; ++q) { r[q].x = __builtin_amdgcn_rcpf(t[q].x); r[q].y = __builtin_amdgcn_rcpf(t[q].y); }
#pragma unroll
                for (int q = 0; q < 4; ++q) g[q] = (g[q] * up[q]) * r[q];
                if constexpr (FFN_F8) { u32x2 w; w.x = pk4_f8(g[0].x, g[0].y, g[1].x, g[1].y); w.y = pk4_f8(g[2].x, g[2].y, g[3].x, g[3].y); *(u32x2*)((unsigned char*)U + rowi * DFF + col0) = w; }
                else { u32x4 w; w.x = cvt_pk_bf16(g[0].x, g[0].y); w.y = cvt_pk_bf16(g[1].x, g[1].y); w.z = cvt_pk_bf16(g[2].x, g[2].y); w.w = cvt_pk_bf16(g[3].x, g[3].y); *(u32x4*)(U + rowi * DFF + col0) = w; }
            }
    }
};
struct EpiDown {
    static constexpr bool PERM = true, AFTER_DRAIN = false;
    bf16_t* F2; const int* rmap; const float* roww; int dense;
    __device__ __forceinline__ void operator()(const f32x4 (&acc)[2][2][4][2], const Unit& u, int wr, int wc, int fr, int fq) const {
        const int pnl = u.pn & 3;
        const int col0 = pnl * BM + wc * 32 + 8 * fq;
        const __amdgpu_buffer_rsrc_t rsF = __builtin_amdgcn_make_buffer_rsrc((void*)F2, 0, 2 * M * DM * 2, 0x00020000);
        const __amdgpu_buffer_rsrc_t rsM = __builtin_amdgcn_make_buffer_rsrc((void*)rmap, 0, MP * 4, 0x00020000);
        const __amdgpu_buffer_rsrc_t rsW = __builtin_amdgcn_make_buffer_rsrc((void*)roww, 0, MP * 4, 0x00020000);
#pragma unroll
        for (int ai = 0; ai < 2; ++ai)
#pragma unroll
            for (int m = 0; m < 4; ++m) {
                const int grow = u.pm * BM + ai * HALF + wr * 64 + m * 16 + fr;
                int tok = grow, slot = 0; float w = 1.f; bool ok = true;
                if (!dense) { const int rm = (int)__builtin_amdgcn_raw_buffer_load_b32(rsM, grow * 4, 0, 0); ok = rm >= 0; tok = rm & 0x3fffffff; slot = (rm >> 30) & 1; w = __uint_as_float(__builtin_amdgcn_raw_buffer_load_b32(rsW, grow * 4, 0, 0)); }
                if constexpr (FFN_F8) w *= 1.f / (W8S * U8S);
                if (ok) {
                    const int bo = ((slot * M + tok) * DM + col0) * 2;
#pragma unroll
                    for (int bj = 0; bj < 2; ++bj) {
                        const f32x4 v0 = acc[ai][bj][m][0] * w, v1 = acc[ai][bj][m][1] * w;
                        u32x4 q; q.x = cvt_pk_bf16(v0[0], v0[1]); q.y = cvt_pk_bf16(v0[2], v0[3]); q.z = cvt_pk_bf16(v1[0], v1[1]); q.w = cvt_pk_bf16(v1[2], v1[3]);
                        __builtin_amdgcn_raw_buffer_store_b128(q, rsF, bo + bj * HALF * 2, 0, 0);
                    }
                }
            }
    }
};
struct GroupedOrder {
    StaticOrder S; const PG8_LAS int* texp; int nN;
    __device__ __forceinline__ bool next(int i, Unit& u) const { if (!S.next(i, u)) return false; u.pn += __builtin_amdgcn_readfirstlane(texp[u.pm]) * nN; return true; }
    __device__ __forceinline__ void a_ready(const Unit&) const {}
    __device__ __forceinline__ void done(const Unit&) const {}
};
struct LatOrder {
    StaticOrder S; int lat;
    __device__ __forceinline__ bool next(int i, Unit& u) const { if (!S.next(i, u)) return false; if (lat) u.pm += (u.pm >> 3) + 1; return true; }
    __device__ __forceinline__ void a_ready(const Unit&) const {}
    __device__ __forceinline__ void done(const Unit&) const {}
};
}

__device__ __forceinline__ void ld_row_f32(const float* row, int lane, f32x4 (&v)[4]) {
#pragma unroll
    for (int j = 0; j < 4; ++j) v[j] = *(const f32x4*)(row + 4 * lane + 256 * j);
}
__device__ __forceinline__ void st_row_f32(float* row, int lane, const f32x4 (&v)[4]) {
#pragma unroll
    for (int j = 0; j < 4; ++j) *(f32x4*)(row + 4 * lane + 256 * j) = v[j];
}
__device__ __forceinline__ void ld_row_bf16(const bf16* row, int lane, f32x4 (&v)[4]) {
#pragma unroll
    for (int j = 0; j < 4; ++j) { const u32x2 w = *(const u32x2*)(row + 4 * lane + 256 * j); v[j] = (f32x4){bflo(w.x), bfhi(w.x), bflo(w.y), bfhi(w.y)}; }
}
__device__ __forceinline__ void st_row_bf16(bf16* row, int lane, const f32x4 (&v)[4]) {
#pragma unroll
    for (int j = 0; j < 4; ++j) { u32x2 w; w.x = pg8::cvt_pk_bf16(v[j][0], v[j][1]); w.y = pg8::cvt_pk_bf16(v[j][2], v[j][3]); *(u32x2*)(row + 4 * lane + 256 * j) = w; }
}
__device__ __forceinline__ float row_rinv(const f32x4 (&v)[4]) {
    float s = 0.f;
#pragma unroll
    for (int j = 0; j < 4; ++j) s += (v[j][0] * v[j][0] + v[j][1] * v[j][1]) + (v[j][2] * v[j][2] + v[j][3] * v[j][3]);
    return 1.0f / sqrtf(wave_sum(s) * (1.f / DM) + EPS);
}

__device__ __forceinline__ void transpose_tile(const float* W, int N, int k0, int n0, bf16* WT, int K, int drow0, LAS float* scr, int lane, bool ropeperm = false) {
#pragma unroll 8
    for (int i = 0; i < 32; ++i) { const int kk = 2 * i + (lane >> 5); scr[kk * 33 + (lane & 31)] = __builtin_nontemporal_load(&W[(size_t)(k0 + kk) * N + n0 + (lane & 31)]); }
    LDS_WAIT(); asm volatile("" ::: "memory");
    const int c = lane & 7;
#pragma unroll
    for (int j = 0; j < 4; ++j) { const int n = (lane >> 3) + 8 * j; const LAS float* s = scr + (8 * c) * 33 + n;
        v4u o; o.x = pk2(s[0 * 33], s[1 * 33]); o.y = pk2(s[2 * 33], s[3 * 33]); o.z = pk2(s[4 * 33], s[5 * 33]); o.w = pk2(s[6 * 33], s[7 * 33]);
        const int nd = ropeperm ? (8 * ((n >> 2) & 3) + 4 * (n >> 4) + (n & 3)) : n;
        *(GAS v4u*)(WT + (size_t)(drow0 + nd) * K + k0 + 8 * c) = o; }
    LDS_WAIT(); asm volatile("" ::: "memory");
}
__device__ __forceinline__ void transpose_tile_f8(const float* W, int N, int k0, int n0, unsigned char* WT, int Kb, int drow0, LAS float* scr, int lane, float scale) {
#pragma unroll 8
    for (int i = 0; i < 32; ++i) { const int kk = 2 * i + (lane >> 5); scr[kk * 33 + (lane & 31)] = __builtin_nontemporal_load(&W[(size_t)(k0 + kk) * N + n0 + (lane & 31)]); }
    LDS_WAIT(); asm volatile("" ::: "memory");
    const int n = lane >> 1, hf = lane & 1; const LAS float* s = scr + (hf * 32) * 33 + n;
    v4u o0, o1;
    o0.x = pk4_f8(s[0 * 33] * scale, s[1 * 33] * scale, s[2 * 33] * scale, s[3 * 33] * scale);     o0.y = pk4_f8(s[4 * 33] * scale, s[5 * 33] * scale, s[6 * 33] * scale, s[7 * 33] * scale);
    o0.z = pk4_f8(s[8 * 33] * scale, s[9 * 33] * scale, s[10 * 33] * scale, s[11 * 33] * scale);   o0.w = pk4_f8(s[12 * 33] * scale, s[13 * 33] * scale, s[14 * 33] * scale, s[15 * 33] * scale);
    o1.x = pk4_f8(s[16 * 33] * scale, s[17 * 33] * scale, s[18 * 33] * scale, s[19 * 33] * scale); o1.y = pk4_f8(s[20 * 33] * scale, s[21 * 33] * scale, s[22 * 33] * scale, s[23 * 33] * scale);
    o1.z = pk4_f8(s[24 * 33] * scale, s[25 * 33] * scale, s[26 * 33] * scale, s[27 * 33] * scale); o1.w = pk4_f8(s[28 * 33] * scale, s[29 * 33] * scale, s[30 * 33] * scale, s[31 * 33] * scale);
    GAS v4u* dst = (GAS v4u*)(WT + (size_t)(drow0 + n) * Kb + k0 + hf * 32);
    dst[0] = o0; dst[1] = o1;
    LDS_WAIT(); asm volatile("" ::: "memory");
}
__device__ __forceinline__ void convert_weights(Frame& F, int l) {
    refresh(F);
    const bool moe = l & 1; const int ne = moe ? NE : 1, li = l >> 1;
    const float* w1 = moe ? INP(21) + (size_t)li * NE * DM * DFF : INP(17) + (size_t)li * DM * DFF;
    const float* w3 = moe ? INP(22) + (size_t)li * NE * DM * DFF : INP(18) + (size_t)li * DM * DFF;
    const float* w2 = moe ? INP(23) + (size_t)li * NE * DM * DFF : INP(19) + (size_t)li * DM * DFF;
    const float* win = INP(10) + (size_t)l * DM * NIN;
    const float* wout = INP(16) + (size_t)l * DM * DM;
    bf16* WIN = (bf16*)(F.ws + WS_WIN); bf16* WOUT = (bf16*)(F.ws + WS_WOUT); bf16* WUP = (bf16*)(F.ws + WS_WUP); bf16* WDN = (bf16*)(F.ws + WS_WDN);
    LAS float* scr = (LAS float*)(F.lds + F.wave * 16384);
    const int nA = 16 * 97, nZ = NP - NIN, nB = 16 * 32, nC1 = 16 * 88, nD1 = 44 * 32;
    const int nC = ne * 2 * nC1, nD = ne * nD1, total = nA + nZ + nB + nC + nD;
    for (int it = F.gw; it < total; it += F.NGW) {
        int r = it;
        if (r < nA) { const int kb = r / 97, nb = r % 97; transpose_tile(win, NIN, 64 * kb, 32 * nb, WIN, DM, 32 * nb, scr, F.lane, nb < 32  ); continue; } r -= nA;
        if (r < nZ) { const unsigned zz = (unsigned)F.z; v4u z = {zz, zz, zz, zz}; GAS v4u* p = (GAS v4u*)(WIN + (size_t)(NIN + r) * DM) + F.lane * 2; p[0] = z; p[1] = z; continue; } r -= nZ;
        if (r < nB) { const int kb = r / 32, nb = r % 32; transpose_tile(wout, DM, 64 * kb, 32 * nb, WOUT, DM, 32 * nb, scr, F.lane); continue; } r -= nB;
        if (r < nC) { const int e = r / (2 * nC1), q = r % (2 * nC1), which = q / nC1, t = q % nC1, kb = t / 88, nb = t % 88, n0 = 32 * nb;
            const float* src = (which ? w3 : w1) + (size_t)e * DM * DFF;
            if constexpr (FFN_F8) transpose_tile_f8(src, DFF, 64 * kb, n0, (unsigned char*)WUP, DM, e * 5632 + (n0 / 128) * 256 + (n0 % 128) + which * 128, scr, F.lane, W8S);
            else transpose_tile(src, DFF, 64 * kb, n0, WUP, DM, e * 5632 + (n0 / 128) * 256 + (n0 % 128) + which * 128, scr, F.lane); continue; } r -= nC;
        { const int e = r / nD1, t = r % nD1, kb = t / 32, nb = t % 32;
            if constexpr (FFN_F8) transpose_tile_f8(w2 + (size_t)e * DFF * DM, DM, 64 * kb, 32 * nb, (unsigned char*)WDN + (size_t)e * DM * DFF, DFF, 32 * nb, scr, F.lane, W8S);
            else transpose_tile(w2 + (size_t)e * DFF * DM, DM, 64 * kb, 32 * nb, WDN + (size_t)e * DM * DFF, DFF, 32 * nb, scr, F.lane); }
    }
}

__device__ __forceinline__ void p0_mod(Frame& F) {
    refresh(F);
    LAS float* S = (LAS float*)(F.lds);
    LAS float* R = (LAS float*)(F.lds + 69632);
    const float* c = INP(1); const float* cc = INP(3); const float* wmod = INP(4); const float* bmod = INP(5);
    float* MOD = (float*)(F.ws + WS_MOD);
    for (int i = F.tid; i < 17 * 1024; i += 512) { const int b = i >> 10, k = i & 1023; const float v = b < 16 ? c[b * 1024 + k] : cc[k]; S[i] = siluf(v); }
    __syncthreads();
    const int kq = F.lane >> 4, c4 = (F.lane & 15) * 4;
    for (int item = F.blk; item < 4 * 96; item += F.G) {
        const int l = item / 96, col0 = (item % 96) * 64;
        const float* W = wmod + (size_t)l * DM * 6144;
        float acc[17][4];
#pragma unroll
        for (int b = 0; b < 17; ++b)
#pragma unroll
            for (int j = 0; j < 4; ++j) acc[b][j] = 0.f;
        for (int it = 0; it < 32; ++it) {
            const int k = F.wave * 128 + it * 4 + kq;
            const f32x4 w = *(const f32x4*)(W + (size_t)k * 6144 + col0 + c4);
#pragma unroll
            for (int b = 0; b < 17; ++b) { const float s = S[b * 1024 + k];
#pragma unroll
                for (int j = 0; j < 4; ++j) acc[b][j] += s * w[j]; }
        }
#pragma unroll
        for (int b = 0; b < 17; ++b)
#pragma unroll
            for (int j = 0; j < 4; ++j) { float v = acc[b][j]; v = xadd<16>(v); v = xadd<32>(v); acc[b][j] = v; }
        if (kq == 0) {
#pragma unroll
            for (int b = 0; b < 17; ++b)
#pragma unroll
                for (int j = 0; j < 4; ++j) R[(F.wave * 17 + b) * 64 + c4 + j] = acc[b][j];
        }
        __syncthreads();
        for (int o = F.tid; o < 17 * 64; o += 512) { const int b = o >> 6, ccx = o & 63; float s = bmod[l * 6144 + col0 + ccx];
            for (int w = 0; w < 8; ++w) s += R[(w * 17 + b) * 64 + ccx];
            MOD[((size_t)l * 17 + b) * 6144 + col0 + ccx] = s; }
        __syncthreads();
    }
}
__device__ __forceinline__ float lam_init_of(int l) { return 0.8f - 0.6f * expf(-0.3f * (float)l); }
__device__ __forceinline__ void p0_misc(Frame& F) {
    refresh(F);
    float* ropec = (float*)(F.ws + WS_ROPE); float* ropes = ropec + 1024; float* lam = (float*)(F.ws + WS_ROPE + 16384);
    if (F.blk == 0) {
        for (int i = F.tid; i < 1024; i += 512) { const int pos = i >> 4, f = i & 15; const float inv = powf(10000.f, -(float)f / 16.f); const float ang = (float)pos * inv; ropec[i] = cosf(ang); ropes[i] = sinf(ang); }
    }
    if (F.blk == (1 % F.G) && F.wave < 4) {
        const int l = F.wave; const float* lv = INP(13) + l * 256;
        const float a = wave_sum(lv[F.lane] * lv[64 + F.lane]), b = wave_sum(lv[128 + F.lane] * lv[192 + F.lane]);
        if (F.lane == 0) lam[l] = expf(a) - expf(b) + lam_init_of(l);
    }
}

namespace att {
using bf16x8 = __attribute__((ext_vector_type(8))) short;
using s16x4  = __attribute__((ext_vector_type(4))) short;
using f32x16 = __attribute__((ext_vector_type(16))) float;
using u32x4  = __attribute__((ext_vector_type(4))) unsigned;
constexpr int QBLK = 32, KVBLK = 64, NW = 8, DV = 128;
constexpr float THR = 8.f;
constexpr size_t SHM_V = KVBLK * DV * 2, SHM_K = KVBLK * 64 * 2, SHM_ATTN = 2 * SHM_V + 2 * SHM_K + NW * 64 * 4;
#define KSWZ64(row, colB) ((row) * 128 + ((colB) ^ ((((row) >> 1) & 7) << 4)))
#define SBAR() __builtin_amdgcn_sched_barrier(0)
__device__ __forceinline__ int crow(int r, int hi) { return (r & 3) + 8 * (r >> 2) + 4 * hi; }
__device__ __forceinline__ unsigned cvtpk(float lo, float hi) { unsigned r; asm volatile("v_cvt_pk_bf16_f32 %0, %1, %2" : "=v"(r) : "v"(lo), "v"(hi)); return r; }
__device__ __forceinline__ void partialSM(f32x16& p0, f32x16& p1, float& m_reg, float& mn, float& alpha) {
  float pmax = p0[0];
#pragma unroll
  for (int r = 1; r < 16; ++r) pmax = fmaxf(pmax, p0[r]);
#pragma unroll
  for (int r = 0; r < 16; ++r) pmax = fmaxf(pmax, p1[r]);
  { auto rr = __builtin_amdgcn_permlane32_swap(__float_as_uint(pmax), __float_as_uint(pmax), false, false);
    pmax = fmaxf(__uint_as_float(rr[0]), __uint_as_float(rr[1])); }
  if (__builtin_expect(__all(pmax - m_reg <= THR), 1)) { mn = m_reg; alpha = 1.f; }
  else { mn = fmaxf(m_reg, pmax); alpha = __builtin_amdgcn_exp2f(m_reg - mn); m_reg = mn; }
#pragma unroll
  for (int r = 0; r < 16; ++r) p0[r] = p0[r] - mn;
#pragma unroll
  for (int r = 0; r < 16; ++r) p1[r] = p1[r] - mn;
#pragma unroll
  for (int r = 0; r < 16; ++r) p0[r] = __builtin_amdgcn_exp2f(p0[r]);
}
__device__ __forceinline__ void finishSM(f32x16& p0, f32x16& p1, float alpha, float& l_reg, bf16x8& pa0, bf16x8& pa1, bf16x8& pa2, bf16x8& pa3) {
#pragma unroll
  for (int r = 0; r < 16; ++r) p1[r] = __builtin_amdgcn_exp2f(p1[r]);
  float ps = 0;
#pragma unroll
  for (int r = 0; r < 16; ++r) ps += p0[r];
#pragma unroll
  for (int r = 0; r < 16; ++r) ps += p1[r];
  { auto rr = __builtin_amdgcn_permlane32_swap(__float_as_uint(ps), __float_as_uint(ps), false, false);
    ps = __uint_as_float(rr[0]) + __uint_as_float(rr[1]); }
  l_reg = l_reg * alpha + ps;
#define PK4(P, BASE, OUT) do { unsigned a0 = cvtpk(P[BASE + 0], P[BASE + 1]), a1 = cvtpk(P[BASE + 2], P[BASE + 3]);   \
    unsigned b0 = cvtpk(P[BASE + 4], P[BASE + 5]), b1 = cvtpk(P[BASE + 6], P[BASE + 7]);                              \
    auto r0 = __builtin_amdgcn_permlane32_swap(a0, b0, false, false); auto r1 = __builtin_amdgcn_permlane32_swap(a1, b1, false, false); \
    u32x4 w = {r0[0], r1[0], r0[1], r1[1]}; OUT = *reinterpret_cast<bf16x8*>(&w); } while (0)
  PK4(p0, 0, pa0); PK4(p0, 8, pa1); PK4(p1, 0, pa2); PK4(p1, 8, pa3);
#undef PK4
}
__device__ __forceinline__ void pack_p(const f32x16& p0, const f32x16& p1, bf16x8& pa0, bf16x8& pa1, bf16x8& pa2, bf16x8& pa3) {
#define PK4(P, BASE, OUT) do { unsigned a0 = cvtpk(P[BASE + 0], P[BASE + 1]), a1 = cvtpk(P[BASE + 2], P[BASE + 3]);   \
    unsigned b0 = cvtpk(P[BASE + 4], P[BASE + 5]), b1 = cvtpk(P[BASE + 6], P[BASE + 7]);                              \
    auto r0 = __builtin_amdgcn_permlane32_swap(a0, b0, false, false); auto r1 = __builtin_amdgcn_permlane32_swap(a1, b1, false, false); \
    u32x4 w = {r0[0], r1[0], r0[1], r1[1]}; OUT = *reinterpret_cast<bf16x8*>(&w); } while (0)
  PK4(p0, 0, pa0); PK4(p0, 8, pa1); PK4(p1, 0, pa2); PK4(p1, 8, pa3);
#undef PK4
}
__device__ __forceinline__ void qkt(f32x16& p0, f32x16& p1, const bf16* Ks, const bf16x8* qr, int r32, int hi) {
  p0 = f32x16{}; p1 = f32x16{};
#pragma unroll
  for (int d0 = 0; d0 < 4; ++d0) { int cb = (d0 * 16 + hi * 8) * 2;
    bf16x8 b0 = *reinterpret_cast<const bf16x8*>((const char*)Ks + KSWZ64(r32, cb));
    bf16x8 b1 = *reinterpret_cast<const bf16x8*>((const char*)Ks + KSWZ64(32 + r32, cb));
    p0 = __builtin_amdgcn_mfma_f32_32x32x16_bf16(b0, qr[d0], p0, 0, 0, 0);
    p1 = __builtin_amdgcn_mfma_f32_32x32x16_bf16(b1, qr[d0], p1, 0, 0, 0); }
}
__device__ __forceinline__ int v_st(int k, int c) { const int kk = (k & ~0xC) | ((k & 4) << 1) | ((k & 8) >> 1); return ((kk >> 3) * 4 + (c >> 5)) * 512 + ((kk & 7) * 32 + (c & 31)) * 2; }
__device__ __forceinline__ int v_rd_base(int lane) { return ((lane & 3) << 3) | (((lane >> 2) & 3) << 6) | (((lane >> 4) & 1) << 5) | (((lane >> 5) & 1) << 8); }
constexpr int v_rd_off(int d0, int ks, int half) { return d0 * 512 + ks * 4096 + half * 2048; }
template <int OFF> __device__ __forceinline__ s16x4 tr_read(int vb) {
  s16x4 r; asm volatile("ds_read_b64_tr_b16 %0, %1 offset:%2" : "=&v"(r) : "v"(vb), "i"(OFF) : "memory"); return r;
}
template <int D0> __device__ __forceinline__ void pv_one(f32x16& od, int vb, bf16x8 pa0, bf16x8 pa1, bf16x8 pa2, bf16x8 pa3) {
  const s16x4 l0 = tr_read<v_rd_off(D0, 0, 0)>(vb), h0 = tr_read<v_rd_off(D0, 0, 1)>(vb), l1 = tr_read<v_rd_off(D0, 1, 0)>(vb), h1 = tr_read<v_rd_off(D0, 1, 1)>(vb);
  const s16x4 l2 = tr_read<v_rd_off(D0, 2, 0)>(vb), h2 = tr_read<v_rd_off(D0, 2, 1)>(vb), l3 = tr_read<v_rd_off(D0, 3, 0)>(vb), h3 = tr_read<v_rd_off(D0, 3, 1)>(vb);
  asm volatile("s_waitcnt lgkmcnt(0)" ::: "memory"); SBAR();
#define PK(L, H) (bf16x8){L[0], L[1], L[2], L[3], H[0], H[1], H[2], H[3]}
  od = __builtin_amdgcn_mfma_f32_32x32x16_bf16(pa0, PK(l0, h0), od, 0, 0, 0);
  od = __builtin_amdgcn_mfma_f32_32x32x16_bf16(pa1, PK(l1, h1), od, 0, 0, 0);
  od = __builtin_amdgcn_mfma_f32_32x32x16_bf16(pa2, PK(l2, h2), od, 0, 0, 0);
  od = __builtin_amdgcn_mfma_f32_32x32x16_bf16(pa3, PK(l3, h3), od, 0, 0, 0);
#undef PK
}
__device__ __forceinline__ void pv_d0(f32x16* o, int vb, bf16x8 pa0, bf16x8 pa1, bf16x8 pa2, bf16x8 pa3) {
  pv_one<0>(o[0], vb, pa0, pa1, pa2, pa3); pv_one<1>(o[1], vb, pa0, pa1, pa2, pa3); pv_one<2>(o[2], vb, pa0, pa1, pa2, pa3); pv_one<3>(o[3], vb, pa0, pa1, pa2, pa3);
}
constexpr int LDQ = NP, LDK = NP, LDO = DM;
__device__ __forceinline__ void sm_first(f32x16& p0, f32x16& p1, float m) {
#pragma unroll
  for (int r = 0; r < 16; ++r) p0[r] = p0[r] - m;
#pragma unroll
  for (int r = 0; r < 16; ++r) p1[r] = p1[r] - m;
#pragma unroll
  for (int r = 0; r < 16; ++r) p0[r] = __builtin_amdgcn_exp2f(p0[r]);
}
__device__ __forceinline__ void sm_second(f32x16& p0, f32x16& p1, float& l_reg, bf16x8& pa0, bf16x8& pa1, bf16x8& pa2, bf16x8& pa3) {
#pragma unroll
  for (int r = 0; r < 16; ++r) p1[r] = __builtin_amdgcn_exp2f(p1[r]);
  float ps = 0;
#pragma unroll
  for (int r = 0; r < 16; ++r) ps += p0[r];
#pragma unroll
  for (int r = 0; r < 16; ++r) ps += p1[r];
  { auto rr = __builtin_amdgcn_permlane32_swap(__float_as_uint(ps), __float_as_uint(ps), false, false);
    ps = __uint_as_float(rr[0]) + __uint_as_float(rr[1]); }
  l_reg += ps;
  pack_p(p0, p1, pa0, pa1, pa2, pa3);
}
__device__ __forceinline__ void attn_unit(const bf16* __restrict__ Qb, const bf16* __restrict__ Kh, const bf16* __restrict__ Vh, bf16* __restrict__ Ob, int seq, char* lds, int tid, float kmax) {
  const int wid = tid >> 6, lane = tid & 63, r32 = lane & 31, hi = lane >> 5;
  bf16* V_lds = (bf16*)lds; bf16* K_lds = (bf16*)(lds + 2 * SHM_V);
  float* ws = (float*)(lds + 2 * SHM_V + 2 * SHM_K) + wid * 64; float* li_l = ws; float* al_l = ws + 32;
  float m_reg = -1e30f, l_reg = 0; f32x16 o[4] = {}; bf16x8 qr[4];
  const bf16* Qw = Qb + (long)(wid * QBLK + r32) * LDQ + hi * 8;
#pragma unroll
  for (int d0 = 0; d0 < 4; ++d0) qr[d0] = *(const __attribute__((address_space(1))) bf16x8*)(Qw + d0 * 16);
  { float qs = 0.f;
#pragma unroll
    for (int d0 = 0; d0 < 4; ++d0)
#pragma unroll
      for (int e = 0; e < 8; ++e) { const float qv = __uint_as_float((unsigned)(unsigned short)qr[d0][e] << 16); qs += qv * qv; }
    auto rr = __builtin_amdgcn_permlane32_swap(__float_as_uint(qs), __float_as_uint(qs), false, false);
    qs = __uint_as_float(rr[0]) + __uint_as_float(rr[1]);
    m_reg = sqrtf(qs) * kmax * 1.002f + 1e-3f; }
  const int sr = tid >> 4, sc = (tid & 15) * 8, vst0 = v_st(sr, sc), vst1 = v_st(32 + sr, sc);
  const int kr = tid >> 3, kc = (tid & 7) * 8, kst = KSWZ64(kr, kc * 2);
  const int vb0 = (int)(uintptr_t)V_lds + v_rd_base(lane);
  struct { bf16x8 vs0, vs1, ks0; } sr_[2];
#define GLD8(p) (*(const __attribute__((address_space(1))) bf16x8*)(p))
#define SLOAD(i, k0) do { sr_[i].vs0 = GLD8(&Vh[(long)((k0) + sr) * LDK + sc]); sr_[i].vs1 = GLD8(&Vh[(long)((k0) + 32 + sr) * LDK + sc]); \
    sr_[i].ks0 = GLD8(&Kh[(long)((k0) + kr) * LDK + kc]); } while (0)
#define SWRITE(b, i) do { *(bf16x8*)((char*)V_lds + (b) * SHM_V + vst0) = sr_[i].vs0; *(bf16x8*)((char*)V_lds + (b) * SHM_V + vst1) = sr_[i].vs1; \
    *(bf16x8*)((char*)K_lds + (b) * SHM_K + kst) = sr_[i].ks0; } while (0)
#define SWAIT() asm volatile("s_waitcnt vmcnt(3)" ::: "memory")
#define RESC(a) do { if (__any((a) < 1.f)) { if (hi == 0) al_l[r32] = (a); asm volatile("s_waitcnt lgkmcnt(0)" ::: "memory"); \
    _Pragma("unroll") for (int d = 0; d < 4; ++d) _Pragma("unroll") for (int r = 0; r < 16; ++r) o[d][r] *= al_l[crow(r, hi)]; } } while (0)
  f32x16 pA0, pA1, pB0, pB1; float mnA, mnB, alA, alB; bf16x8 pa0, pa1, pa2, pa3; const int NT = seq / KVBLK;
  if (__builtin_amdgcn_readfirstlane(wid) >= 4) __builtin_amdgcn_s_setprio(1);
  constexpr int SE = 0, SO = 1;
  SLOAD(SE, 0); asm volatile("s_waitcnt vmcnt(0)" ::: "memory"); SWRITE(0, SE); __syncthreads();
  qkt(pA0, pA1, K_lds, qr, r32, hi); sm_first(pA0, pA1, m_reg);
  SLOAD(SO, KVBLK); if (2 < NT) SLOAD(SE, 2 * KVBLK);
  SWAIT(); SWRITE(1, SO); __syncthreads();
  for (int j = 1; j + 1 < NT; j += 2) {
    SBAR(); qkt(pB0, pB1, (bf16*)((char*)K_lds + SHM_K), qr, r32, hi);
    sm_second(pA0, pA1, l_reg, pa0, pa1, pa2, pa3); SBAR();
    SLOAD(SO, (j + 2) * KVBLK); SBAR();
    pv_d0(o, vb0, pa0, pa1, pa2, pa3); sm_first(pB0, pB1, m_reg);
    __syncthreads(); SWAIT(); SWRITE(0, SE);
    __syncthreads();
    SBAR(); qkt(pA0, pA1, K_lds, qr, r32, hi);
    sm_second(pB0, pB1, l_reg, pa0, pa1, pa2, pa3); SBAR();
    if (j + 3 < NT) SLOAD(SE, (j + 3) * KVBLK); SBAR();
    pv_d0(o, vb0 + (int)SHM_V, pa0, pa1, pa2, pa3); sm_first(pA0, pA1, m_reg);
    __syncthreads(); SWAIT(); SWRITE(1, SO);
    __syncthreads();
  }
  SBAR(); qkt(pB0, pB1, (bf16*)((char*)K_lds + SHM_K), qr, r32, hi);
  sm_second(pA0, pA1, l_reg, pa0, pa1, pa2, pa3); SBAR();
  pv_d0(o, vb0, pa0, pa1, pa2, pa3); sm_first(pB0, pB1, m_reg);
  __syncthreads();
  sm_second(pB0, pB1, l_reg, pa0, pa1, pa2, pa3); SBAR();
  pv_d0(o, vb0 + (int)SHM_V, pa0, pa1, pa2, pa3);
  __builtin_amdgcn_s_setprio(0);
  if (hi == 0) li_l[r32] = l_reg; asm volatile("s_waitcnt lgkmcnt(0)" ::: "memory");
  float rli[16];
#pragma unroll
  for (int r = 0; r < 16; ++r) rli[r] = __builtin_amdgcn_rcpf(li_l[crow(r, hi)]);
  bf16* Ow = Ob + (long)(wid * QBLK) * LDO;
#pragma unroll
  for (int r = 0; r < 16; ++r) { const int orow = crow(r, hi);
#pragma unroll
    for (int d0 = 0; d0 < 4; ++d0) Ow[(long)orow * LDO + d0 * 32 + r32] = (bf16)(cvtpk(o[d0][r] * rli[r], 0.f) & 0xffffu); }
#undef SLOAD
#undef GLD8
#undef SWRITE
#undef SWAIT
#undef RESC
}
}

namespace att2 {
using att::bf16x8; using att::s16x4; using att::f32x16; using att::u32x4;
typedef LAS const char* lds_cptr;
typedef short v4i16_t __attribute__((ext_vector_type(4)));
typedef unsigned u32x2 __attribute__((ext_vector_type(2)));
constexpr int KSLOT = 8192, VSLOT = 16384, LDS_K = 0, LDS_V = 4 * KSLOT, KVBLK = 64;
#define A2_PIN(x) asm volatile("" : "+v"(x))
#define A2_MFMA(a, b, c) __builtin_amdgcn_mfma_f32_32x32x16_bf16(a, b, c, 0, 0, 0)
#define A2_WAIT_BAR(N) asm volatile("s_waitcnt vmcnt(" #N ") lgkmcnt(0)\n\ts_barrier" ::: "memory")
__device__ __forceinline__ unsigned cvtpk(float lo, float hi) { unsigned r; asm("v_cvt_pk_bf16_f32 %0, %1, %2" : "=v"(r) : "v"(lo), "v"(hi)); return r; }
__device__ __forceinline__ void glds16s(const char* gbase, unsigned voff, unsigned lds_base) {
    unsigned sv; asm volatile("s_mov_b32 %0, m0\n\ts_mov_b32 m0, %3\n\ts_nop 0\n\tglobal_load_lds_dwordx4 %1, %2\n\ts_mov_b32 m0, %0" : "=&s"(sv) : "v"(voff), "s"(gbase), "s"(lds_base) : "memory"); }
__device__ __forceinline__ const char* uni_ptr(const void* p) { const unsigned long long v = (unsigned long long)p;
    const unsigned lo = __builtin_amdgcn_readfirstlane((unsigned)v), hi = __builtin_amdgcn_readfirstlane((unsigned)(v >> 32)); return (const char*)(((unsigned long long)hi << 32) | lo); }
__device__ __forceinline__ void kload2(bf16x8* kf, lds_cptr kp, int d0) { kf[2 * d0] = *(const LAS bf16x8*)(kp + d0 * 2048); kf[2 * d0 + 1] = *(const LAS bf16x8*)(kp + d0 * 2048 + 512); }
__device__ __forceinline__ s16x4 vtr(lds_cptr p) { return __builtin_bit_cast(s16x4, __builtin_amdgcn_ds_read_tr16_b64_v4i16((LAS v4i16_t*)p)); }
__device__ __forceinline__ void attn_unit2(const bf16* Qb, const bf16* Kh_, const bf16* Vh_, bf16* Ob, const int NT, LAS unsigned char* lds, int tid, float kmax) {
    const int lane = tid & 63, r32 = lane & 31, hi = lane >> 5; const int wid = __builtin_amdgcn_readfirstlane(tid >> 6);
    const char* Kh = uni_ptr(Kh_); const char* Vh = uni_ptr(Vh_);
    constexpr unsigned TSTR = KVBLK * NP * 2;
    const unsigned lds0 = (unsigned)(uintptr_t)lds;
    const unsigned koff = (unsigned)(lane * NP + wid * 8) * 2;
    const unsigned voff0 = (unsigned)((16 * (wid & 3) + (lane >> 2)) * NP + (wid >> 2) * 32 + (lane & 3) * 8) * 2, voff1 = voff0 + 128;
    const unsigned kdst = lds0 + LDS_K + wid * 1024, vdst = lds0 + LDS_V + wid * 1024;
#define DMA_K(t, slotB) glds16s(Kh + (size_t)(t) * TSTR, koff, kdst + (slotB))
#define DMA_V(t, slotB) do { const char* vb_ = Vh + (size_t)(t) * TSTR; glds16s(vb_, voff0, vdst + (slotB)); glds16s(vb_, voff1, vdst + (slotB) + 8192); } while (0)
    const lds_cptr vp0 = (lds_cptr)lds + LDS_V + ((lane >> 4) & 1) * 32 + (lane & 3) * 8 + (4 * hi + ((lane & 15) >> 2)) * 64;
    const lds_cptr kp0 = (lds_cptr)lds + LDS_K + hi * 1024 + r32 * 16;
    DMA_K(0, 0); DMA_V(0, 0); DMA_K(1, KSLOT); DMA_K(2, 2 * KSLOT);
    bf16x8 qr[4];
    const bf16* Qw = Qb + (long)(wid * 32 + r32) * NP + hi * 8;
#pragma unroll
    for (int d0 = 0; d0 < 4; ++d0) qr[d0] = *(const GAS bf16x8*)(Qw + d0 * 16);
    float m_row;
    { float qs = 0.f;
#pragma unroll
      for (int d0 = 0; d0 < 4; ++d0)
#pragma unroll
        for (int e = 0; e < 8; ++e) { const float qv = __uint_as_float((unsigned)(unsigned short)qr[d0][e] << 16); qs += qv * qv; }
      auto rr = __builtin_amdgcn_permlane32_swap(__float_as_uint(qs), __float_as_uint(qs), false, false);
      qs = __uint_as_float(rr[0]) + __uint_as_float(rr[1]);
      m_row = sqrtf(qs) * kmax * 1.002f + 1e-3f; }
    f32x16 negm16;
#pragma unroll
    for (int r = 0; r < 16; ++r) negm16[r] = -m_row;
    A2_PIN(negm16);
    float l_reg = 0.f; f32x16 o[4]; o[0] = f32x16{}; o[1] = f32x16{}; o[2] = f32x16{}; o[3] = f32x16{};
    f32x16 pA0, pA1, pB0, pB1; bf16x8 kf[8]; s16x4 vlo[5], vhi[5]; u32x4 pw[4];
    if (wid >= 4) __builtin_amdgcn_s_setprio(1);
    A2_WAIT_BAR(0);
#pragma unroll
    for (int d0 = 0; d0 < 4; ++d0) kload2(kf, kp0, d0);
    pA0 = A2_MFMA(kf[0], qr[0], negm16); pA1 = A2_MFMA(kf[1], qr[0], negm16); pA0 = A2_MFMA(kf[2], qr[1], pA0); pA1 = A2_MFMA(kf[3], qr[1], pA1);
    pA0 = A2_MFMA(kf[4], qr[2], pA0); pA1 = A2_MFMA(kf[5], qr[2], pA1); pA0 = A2_MFMA(kf[6], qr[3], pA0); pA1 = A2_MFMA(kf[7], qr[3], pA1);
#pragma unroll
    for (int r = 0; r < 16; ++r) { pA0[r] = __builtin_amdgcn_exp2f(pA0[r]); pA1[r] = __builtin_amdgcn_exp2f(pA1[r]); }
    DMA_K(3, 3 * KSLOT); DMA_V(1, VSLOT);
    kload2(kf, kp0 + KSLOT, 0); kload2(kf, kp0 + KSLOT, 1);
    A2_WAIT_BAR(3);
    int kc = KSLOT, vp = 0;
#define PKW(P, i) cvtpk(P[i], P[(i) + 1])
#define VFR(s) (bf16x8){vlo[s][0], vlo[s][1], vlo[s][2], vlo[s][3], vhi[s][0], vhi[s][1], vhi[s][2], vhi[s][3]}
#define VRD(s, i) do { vlo[s] = vtr(vq_ + (((i) & 3) * 4096 + ((i) >> 2) * 1024)); vhi[s] = vtr(vq_ + (((i) & 3) * 4096 + ((i) >> 2) * 1024 + 512)); } while (0)
#define GAPA(MF, a0, a1, a2, a3, W0, W1, PW) do { MF; sacc += a0; sacc += a1; sacc += a2; sacc += a3; W0; W1; A2_PIN(PW); A2_PIN(sacc); SBAR(); } while (0)
#define GAPB(i, X, j) do { if ((i) + 4 < 16) VRD(((i) + 4) % 5, (i) + 4); if ((i) == 9) kload2(kf, kn_, 0); if ((i) == 10) kload2(kf, kn_, 1); SBAR(); \
    o[(i) & 3] = A2_MFMA(VFR((i) % 5), __builtin_bit_cast(bf16x8, pw[(i) >> 2]), o[(i) & 3]); X[j] = __builtin_amdgcn_exp2f(X[j]); X[(j) + 1] = __builtin_amdgcn_exp2f(X[(j) + 1]); A2_PIN(X); SBAR(); } while (0)
#define A2_STEP(C0, C1, P0, P1, t) do { SBAR(); \
    const lds_cptr kq_ = kp0 + kc, vq_ = vp0 + vp, kn_ = kp0 + ((kc + KSLOT) & (4 * KSLOT - 1)); \
    const int tk_ = min((t) + 3, NT - 1), tv_ = min((t) + 1, NT - 1); const int kprev_ = (kc - KSLOT) & (4 * KSLOT - 1); int vnew_ = vp + 2 * VSLOT; if (vnew_ >= 3 * VSLOT) vnew_ -= 3 * VSLOT; \
    kload2(kf, kq_, 2); SBAR(); float sacc = P0[0] + P0[1]; \
    GAPA(C0 = A2_MFMA(kf[0], qr[0], negm16), P0[2], P0[3], P0[4], P0[5],     pw[0][0] = PKW(P0, 0),  pw[0][1] = PKW(P0, 2),  pw[0]); \
    kload2(kf, kq_, 3); SBAR(); \
    GAPA(C1 = A2_MFMA(kf[1], qr[0], negm16), P0[6], P0[7], P0[8], P0[9],     pw[0][2] = PKW(P0, 4),  pw[0][3] = PKW(P0, 6),  pw[0]); \
    VRD(0, 0); SBAR(); GAPA(C0 = A2_MFMA(kf[2], qr[1], C0), P0[10], P0[11], P0[12], P0[13], pw[1][0] = PKW(P0, 8),  pw[1][1] = PKW(P0, 10), pw[1]); \
    VRD(1, 1); SBAR(); GAPA(C1 = A2_MFMA(kf[3], qr[1], C1), P0[14], P0[15], P1[0], P1[1],   pw[1][2] = PKW(P0, 12), pw[1][3] = PKW(P0, 14), pw[1]); \
    VRD(2, 2); SBAR(); GAPA(C0 = A2_MFMA(kf[4], qr[2], C0), P1[2], P1[3], P1[4], P1[5],     pw[2][0] = PKW(P1, 0),  pw[2][1] = PKW(P1, 2),  pw[2]); \
    VRD(3, 3); SBAR(); GAPA(C1 = A2_MFMA(kf[5], qr[2], C1), P1[6], P1[7], P1[8], P1[9],     pw[2][2] = PKW(P1, 4),  pw[2][3] = PKW(P1, 6),  pw[2]); \
                       GAPA(C0 = A2_MFMA(kf[6], qr[3], C0), P1[10], P1[11], P1[12], P1[13], pw[3][0] = PKW(P1, 8),  pw[3][1] = PKW(P1, 10), pw[3]); \
                       GAPA(C1 = A2_MFMA(kf[7], qr[3], C1), P1[14], P1[15], 0.f, 0.f,       pw[3][2] = PKW(P1, 12), pw[3][3] = PKW(P1, 14), pw[3]); \
    l_reg += sacc; \
    DMA_K(tk_, kprev_); DMA_V(tv_, vnew_); SBAR();                                                                   \
    GAPB(0, C0, 0);  GAPB(1, C0, 2);  GAPB(2, C0, 4);   GAPB(3, C0, 6);   GAPB(4, C0, 8);   GAPB(5, C0, 10);  GAPB(6, C0, 12);  GAPB(7, C0, 14); \
    GAPB(8, C1, 0);  GAPB(9, C1, 2);  GAPB(10, C1, 4);  GAPB(11, C1, 6);  GAPB(12, C1, 8);  GAPB(13, C1, 10); GAPB(14, C1, 12); GAPB(15, C1, 14); \
    A2_WAIT_BAR(3);                                                                                                   \
    kc = (kc + KSLOT) & (4 * KSLOT - 1); vp += VSLOT; if (vp == 3 * VSLOT) vp = 0; \
    } while (0)
    int t = 1;
    for (; t + 1 < NT; t += 2) {
        A2_STEP(pB0, pB1, pA0, pA1, t);
        A2_STEP(pA0, pA1, pB0, pB1, t + 1);
    }
    A2_STEP(pB0, pB1, pA0, pA1, NT - 1);
    asm volatile("s_waitcnt vmcnt(0)" ::: "memory");
    { float sacc = pB0[0] + pB0[1];
#pragma unroll
      for (int r = 2; r < 16; ++r) sacc += pB0[r];
#pragma unroll
      for (int r = 0; r < 16; ++r) sacc += pB1[r];
      l_reg += sacc;
      pw[0] = (u32x4){PKW(pB0, 0), PKW(pB0, 2), PKW(pB0, 4), PKW(pB0, 6)}; pw[1] = (u32x4){PKW(pB0, 8), PKW(pB0, 10), PKW(pB0, 12), PKW(pB0, 14)};
      pw[2] = (u32x4){PKW(pB1, 0), PKW(pB1, 2), PKW(pB1, 4), PKW(pB1, 6)}; pw[3] = (u32x4){PKW(pB1, 8), PKW(pB1, 10), PKW(pB1, 12), PKW(pB1, 14)};
      const lds_cptr vq_ = vp0 + vp;
#pragma unroll
      for (int kg = 0; kg < 4; ++kg) {
          VRD(0, kg * 4 + 0); VRD(1, kg * 4 + 1); VRD(2, kg * 4 + 2); VRD(3, kg * 4 + 3);
          o[0] = A2_MFMA(VFR(0), __builtin_bit_cast(bf16x8, pw[kg]), o[0]); o[1] = A2_MFMA(VFR(1), __builtin_bit_cast(bf16x8, pw[kg]), o[1]);
          o[2] = A2_MFMA(VFR(2), __builtin_bit_cast(bf16x8, pw[kg]), o[2]); o[3] = A2_MFMA(VFR(3), __builtin_bit_cast(bf16x8, pw[kg]), o[3]); } }
    __builtin_amdgcn_s_setprio(0);
    { auto rr = __builtin_amdgcn_permlane32_swap(__float_as_uint(l_reg), __float_as_uint(l_reg), false, false); l_reg = __uint_as_float(rr[0]) + __uint_as_float(rr[1]); }
    const float rli = __builtin_amdgcn_rcpf(l_reg);
    GAS bf16* Ow = (GAS bf16*)Ob + (long)(wid * 32 + r32) * DM + 4 * hi;
#pragma unroll
    for (int d = 0; d < 4; ++d)
#pragma unroll
      for (int g = 0; g < 4; ++g) { u32x2 w; w.x = cvtpk(o[d][4 * g] * rli, o[d][4 * g + 1] * rli); w.y = cvtpk(o[d][4 * g + 2] * rli, o[d][4 * g + 3] * rli);
          *(GAS u32x2*)(Ow + d * 32 + 8 * g) = w; }
#undef DMA_K
#undef DMA_V
#undef PKW
#undef VFR
#undef VRD
#undef GAPA
#undef GAPB
#undef A2_STEP
}
}

__device__ __forceinline__ int gla_item(int b, int h, int dir, int c) { return ((b * 4 + h) * 2 + dir) * NCH + c; }
namespace gla {
using att::bf16x8; using att::f32x16; using att::u32x4;
__device__ __forceinline__ void gates8(const bf16* P, const float* w2, const float* gb, size_t row0, int dir, int seg, int k, float (&gl)[8]) {
    float w[16];
#pragma unroll
    for (int j = 0; j < 16; ++j) w[j] = w2[j * 256 + k];
    const float bias = gb[k];
#pragma unroll
    for (int i = 0; i < 8; ++i) {
        const bf16* gp = P + (row0 + seg * 8 + i) * NP + C_GLR + dir * 16;
        const v4u a = *(const v4u*)gp, b = *(const v4u*)(gp + 8);
        float z = bias;
        z += bflo(a.x) * w[0] + bfhi(a.x) * w[1] + bflo(a.y) * w[2] + bfhi(a.y) * w[3] + bflo(a.z) * w[4] + bfhi(a.z) * w[5] + bflo(a.w) * w[6] + bfhi(a.w) * w[7];
        z += bflo(b.x) * w[8] + bfhi(b.x) * w[9] + bflo(b.y) * w[10] + bfhi(b.y) * w[11] + bflo(b.z) * w[12] + bfhi(b.z) * w[13] + bflo(b.w) * w[14] + bfhi(b.w) * w[15];
        gl[i] = (fminf(z, 0.f) - log1pf(expf(-fabsf(z)))) * (1.f / 16.f);
    }
}
__device__ __forceinline__ float lscan(const float (&gl)[8], int dir, float (&loc)[8]) {
    float run = 0.f;
    if (dir == 0) {
#pragma unroll
        for (int i = 0; i < 8; ++i) { run += gl[i]; loc[i] = run; }
    } else {
#pragma unroll
        for (int i = 7; i >= 0; --i) { run += gl[i]; loc[i] = run; }
    }
    return run;
}
__device__ __forceinline__ void stage_tile_bf16(const bf16* src, size_t pitch, char* tile, int tid) {
    const int sr = tid >> 4, sc = (tid & 15) * 8;
    const bf16x8 a = *reinterpret_cast<const bf16x8*>(src + (size_t)sr * pitch + sc), b = *reinterpret_cast<const bf16x8*>(src + (size_t)(32 + sr) * pitch + sc);
    *(bf16x8*)(tile + att::v_st(sr, sc)) = a; *(bf16x8*)(tile + att::v_st(32 + sr, sc)) = b;
}
__device__ __forceinline__ void stage_tile_f32(const float* src, char* tile, int tid) {
    const int sr = tid >> 4, sc = (tid & 15) * 8;
#pragma unroll
    for (int t = 0; t < 2; ++t) { const int row = sr + 32 * t; const f32x4 x = *(const f32x4*)(src + row * 128 + sc), y = *(const f32x4*)(src + row * 128 + sc + 4);
        u32x4 w = {att::cvtpk(x[0], x[1]), att::cvtpk(x[2], x[3]), att::cvtpk(y[0], y[1]), att::cvtpk(y[2], y[3])};
        *(u32x4*)(tile + att::v_st(row, sc)) = w; }
}
__device__ __forceinline__ void pv_sel(int d0, f32x16& o, int vb, bf16x8 a0, bf16x8 a1, bf16x8 a2, bf16x8 a3) {
    switch (d0) { case 0: att::pv_one<0>(o, vb, a0, a1, a2, a3); break; case 1: att::pv_one<1>(o, vb, a0, a1, a2, a3); break;
                  case 2: att::pv_one<2>(o, vb, a0, a1, a2, a3); break; default: att::pv_one<3>(o, vb, a0, a1, a2, a3); break; }
}
__device__ __forceinline__ void afrag4(const char* img, int row, int hi, bf16x8 (&a)[4]) {
#pragma unroll
    for (int s = 0; s < 4; ++s) a[s] = *reinterpret_cast<const bf16x8*>(img + KSWZ64(row, (s * 16 + hi * 8) * 2));
}
__device__ __forceinline__ void st_sw(char* img, int row, int col, float v) { *(unsigned short*)(img + KSWZ64(row, col * 2)) = (unsigned short)(att::cvtpk(v, 0.f) & 0xffffu); }
}

constexpr size_t WS_OG = WS_DS;
constexpr int CW_KMX = 13312;
constexpr int CW_Q = 12288;
struct GlaPre { unsigned g; unsigned short q[8], k[8]; att::bf16x8 v0, v1; };
__device__ __forceinline__ void gla_prefetch(GlaPre& R, const bf16* P_, size_t row0, int h, int dir, int k, int seg, int tid) {
    const GAS bf16* P = (const GAS bf16*)P_;
    R.g = *(const GAS unsigned*)(P + (row0 + seg * 8 + (k >> 3)) * NP + C_GLR + dir * 16 + (k & 7) * 2);
#pragma unroll
    for (int i = 0; i < 8; ++i) { const GAS bf16* rp = P + (row0 + seg * 8 + i) * NP; R.q[i] = rp[C_GQ + h * 64 + k]; R.k[i] = rp[C_GK + h * 64 + k]; }
    const int sr = tid >> 4, sc = (tid & 15) * 8;
    R.v0 = *(const GAS att::bf16x8*)(P + (row0 + sr) * NP + C_GV + h * 128 + sc); R.v1 = *(const GAS att::bf16x8*)(P + (row0 + 32 + sr) * NP + C_GV + h * 128 + sc);
}
__device__ __forceinline__ void gla_chain(Frame& F, int l, int chain) {
    const int b = chain >> 3, h = (chain >> 1) & 3, dir = chain & 1;
    const bf16* P = (const bf16*)(F.ws + WS_PROJ); bf16* OG = (bf16*)(F.ws + WS_OG) + (size_t)dir * M * 512;
    char* lds = (char*)F.lds; char* Vt = lds; char* St = lds + 16384; char* KtT = lds + 32768; char* Kt = lds + 40960; char* Qt = lds + 49152; char* Qh = lds + 57344;
    float* T = (float*)(lds + 65536); float* Dec = (float*)(lds + 67584);
    const int k = F.lane, seg = F.tid >> 6, r32 = F.lane & 31, hi = F.lane >> 5, mt = F.wave >> 2, d0 = F.wave & 3;
    const int vbV = (int)(uintptr_t)Vt + att::v_rd_base(F.lane), vbS = (int)(uintptr_t)St + att::v_rd_base(F.lane);
    const int sr = F.tid >> 4, sc = (F.tid & 15) * 8;
    float w[16];
    { const float* w2 = INP(11) + (size_t)((l * 2 + dir) * 16) * 256 + h * 64;
#pragma unroll
      for (int j = 0; j < 16; ++j) w[j] = w2[j * 256 + k]; }
    const float bias = (INP(12) + (l * 2 + dir) * 256 + h * 64)[k];
    att::f32x16 S = {};
    GlaPre R, RN;
    { const int c0 = dir == 0 ? 0 : 3; gla_prefetch(RN, P, (size_t)b * TPB + c0 * 64, h, dir, k, seg, F.tid); }
    for (int j = 0; j < NCH; ++j) {
        const int c = dir == 0 ? j : (j < 4 ? 3 - j : 39 - j);
        const size_t row0 = (size_t)b * TPB + c * 64;
        R = RN;
        if (j + 1 < NCH) { const int cn = dir == 0 ? j + 1 : (j + 1 < 4 ? 2 - j : 38 - j); gla_prefetch(RN, P, (size_t)b * TPB + cn * 64, h, dir, k, seg, F.tid); }
        float gl[8], loc[8];
#pragma unroll
        for (int i = 0; i < 8; ++i) {
            float z = bias;
#pragma unroll
            for (int d = 0; d < 8; ++d) { const unsigned s = (unsigned)__builtin_amdgcn_readlane((int)R.g, i * 8 + d); z += bflo(s) * w[2 * d] + bfhi(s) * w[2 * d + 1]; }
            gl[i] = (fminf(z, 0.f) - __logf(1.f + __expf(-fabsf(z)))) * (1.f / 16.f); }
        const float segtot = gla::lscan(gl, dir, loc);
        T[seg * 64 + k] = segtot;
        *(att::bf16x8*)(Vt + att::v_st(sr, sc)) = R.v0; *(att::bf16x8*)(Vt + att::v_st(32 + sr, sc)) = R.v1;
#pragma unroll
        for (int r = 0; r < 16; ++r) *(unsigned short*)(St + att::v_st(mt * 32 + att::crow(r, hi), d0 * 32 + r32)) = (unsigned short)(att::cvtpk(S[r], 0.f) & 0xffffu);
        __syncthreads();
        float off = 0.f, tot = 0.f;
        int sg = seg; asm volatile("" : "+v"(sg));
#pragma unroll
        for (int s = 0; s < 8; ++s) { const float t = T[s * 64 + k]; tot += t; const bool inoff = dir == 0 ? (s < sg) : (s > sg); off += inoff ? t : 0.f; }
        const float etot = __expf(tot);
        float kt[8];
#pragma unroll
        for (int i = 0; i < 8; ++i) { const int tau = seg * 8 + i; const float qv = bf2f(R.q[i]), kv = bf2f(R.k[i]); const float cc = loc[i] + off;
            const float a = fmaxf(__expf(cc), 1e-30f)  , bq = __builtin_amdgcn_rcpf(a), kb = kv * bq;
            kt[i] = kb * etot;
            gla::st_sw(Qh, tau, k, qv * a); gla::st_sw(Kt, tau, k, kb); }
        { att::u32x4 wv = {att::cvtpk(kt[0], kt[1]), att::cvtpk(kt[2], kt[3]), att::cvtpk(kt[4], kt[5]), att::cvtpk(kt[6], kt[7])};
          *(att::u32x4*)(KtT + KSWZ64(k, seg * 16)) = wv; }
        if (sg == 0) Dec[k] = etot;
        __syncthreads();
        att::f32x16 o = {};
        int tau_q = mt * 32 + r32; asm volatile("" : "+v"(tau_q));
        { att::bf16x8 qr[4]; gla::afrag4(Qh, tau_q, hi, qr);
          att::f32x16 p0, p1; att::qkt(p0, p1, (const bf16*)Kt, qr, r32, hi);
#pragma unroll
          for (int r = 0; r < 16; ++r) { const int t0 = att::crow(r, hi), t1 = 32 + t0;
              const bool k0 = dir == 0 ? (t0 <= tau_q) : (t0 >= tau_q), k1 = dir == 0 ? (t1 <= tau_q) : (t1 >= tau_q);
              p0[r] = k0 ? p0[r] : 0.f; p1[r] = k1 ? p1[r] : 0.f; }
          att::bf16x8 pa0, pa1, pa2, pa3; att::pack_p(p0, p1, pa0, pa1, pa2, pa3);
          gla::pv_sel(d0, o, vbV, pa0, pa1, pa2, pa3);
          gla::pv_sel(d0, o, vbS, qr[0], qr[1], qr[2], qr[3]); }
#pragma unroll
        for (int r = 0; r < 16; ++r) S[r] *= Dec[mt * 32 + att::crow(r, hi)];
        { att::bf16x8 a[4]; gla::afrag4(KtT, mt * 32 + r32, hi, a); gla::pv_sel(d0, S, vbV, a[0], a[1], a[2], a[3]); }
        GAS bf16* op = (GAS bf16*)(OG + row0 * 512 + h * 128 + d0 * 32 + r32);
#pragma unroll
        for (int r = 0; r < 16; ++r) op[(size_t)(mt * 32 + att::crow(r, hi)) * 512] = (bf16)(att::cvtpk(o[r], 0.f) & 0xffffu);
        __syncthreads();
    }
}
__device__ __forceinline__ void p3_mixer(Frame& F, int l) {
    refresh(F);
    for (int ch = F.blk; ch < NBATCH * 8; ch += F.G) gla_chain(F, l, ch);
    const bf16* P = (const bf16*)(F.ws + WS_PROJ); bf16* OD = (bf16*)(F.ws + WS_OD);
    const unsigned* kmxp = (const unsigned*)F.ws + CW_KMX + 256 * l;
    volatile LAS unsigned* slot = F.MISC + 24;
    int myq = F.blk & 7, tries = 0;
    for (;;) {
        __syncthreads();
        if (F.tid == 0) slot[0] = __hip_atomic_fetch_add((unsigned*)((gu32*)F.ws + CW_Q + 64 * l + 8 * 0 + myq), 1u, __ATOMIC_RELAXED, __HIP_MEMORY_SCOPE_AGENT);
        __syncthreads();
        const int u = __builtin_amdgcn_readfirstlane((int)slot[0]);
        if (u >= (l == DEPTH - 1 ? 128 : 144)) { if (++tries >= 8) break; myq = (myq + 1) & 7; continue; }
        int g, qt;
        if (u < 128) { const int pi = u >> 4, mp = (u >> 3) & 1; g = ((pi * 8 + myq) << 1) + mp; qt = 1 + (u & 7); }
        else { const int gi = u - 128; g = (((gi >> 1) * 8 + myq) << 1) + (gi & 1); qt = 0; }
        const int b = g >> 3, hh = g & 7;
        const size_t row0 = (size_t)b * TPB;
        att2::attn_unit2(P + (row0 + qt * 256) * NP + C_Q + hh * 64, P + row0 * NP + C_K + hh * 64, P + row0 * NP + C_V + (hh >> 1) * 128,
                         OD + (row0 + qt * 256) * DM + hh * 128, qt == 0 ? CTX / 64 : TPB / 64, F.lds, F.tid,
                         sqrtf(__uint_as_float(kmxp[(b * 8 + hh) * 2]) + __uint_as_float(kmxp[(b * 8 + hh) * 2 + 1])) * 1.01f);
    }
    __syncthreads();
}
__device__ __forceinline__ void p5_merge_all(Frame& F, int l) {
    refresh(F);
    const bf16* OD = (const bf16*)(F.ws + WS_OD); const bf16* OG = (const bf16*)(F.ws + WS_OG); const bf16* P = (const bf16*)(F.ws + WS_PROJ); bf16* MRG = (bf16*)(F.ws + WS_H);
    const float lam = ((const float*)(F.ws + WS_ROPE + 16384))[l]; const float omli = 1.f - lam_init_of(l);
    const float* subln = INP(14) + l * 128; const float* onorm = INP(15) + l * 128;
    const int h = F.lane >> 4, c0 = (F.lane & 15) * 8;
    const int rpw = (M + F.NGW - 1) / F.NGW, r0 = F.gw * rpw, r1 = (r0 + rpw < M) ? r0 + rpw : M;
    for (int r = r0; r < r1; ++r) {
        const v4u a = *(const v4u*)(OD + (size_t)r * DM + h * 256 + c0), bq = *(const v4u*)(OD + (size_t)r * DM + h * 256 + 128 + c0);
        const v4u gf = *(const v4u*)(OG + (size_t)r * 512 + h * 128 + c0), gbk = *(const v4u*)(OG + ((size_t)M + r) * 512 + h * 128 + c0);
        const v4u gt = *(const v4u*)(P + (size_t)r * NP + C_GG + h * 128 + c0);
        float d[8], e[8], g[8];
        d[0] = bflo(a.x) - lam * bflo(bq.x); d[1] = bfhi(a.x) - lam * bfhi(bq.x); d[2] = bflo(a.y) - lam * bflo(bq.y); d[3] = bfhi(a.y) - lam * bfhi(bq.y);
        d[4] = bflo(a.z) - lam * bflo(bq.z); d[5] = bfhi(a.z) - lam * bfhi(bq.z); d[6] = bflo(a.w) - lam * bflo(bq.w); d[7] = bfhi(a.w) - lam * bfhi(bq.w);
        e[0] = bflo(gf.x) + bflo(gbk.x); e[1] = bfhi(gf.x) + bfhi(gbk.x); e[2] = bflo(gf.y) + bflo(gbk.y); e[3] = bfhi(gf.y) + bfhi(gbk.y);
        e[4] = bflo(gf.z) + bflo(gbk.z); e[5] = bfhi(gf.z) + bfhi(gbk.z); e[6] = bflo(gf.w) + bflo(gbk.w); e[7] = bfhi(gf.w) + bfhi(gbk.w);
        g[0] = bflo(gt.x); g[1] = bfhi(gt.x); g[2] = bflo(gt.y); g[3] = bfhi(gt.y); g[4] = bflo(gt.z); g[5] = bfhi(gt.z); g[6] = bflo(gt.w); g[7] = bfhi(gt.w);
        float ss = 0.f, se = 0.f;
#pragma unroll
        for (int i = 0; i < 8; ++i) { ss += d[i] * d[i]; se += e[i] * e[i]; }
        ss = xadd<1>(ss); ss = xadd<2>(ss); ss = xadd<4>(ss); ss = xadd<8>(ss);
        se = xadd<1>(se); se = xadd<2>(se); se = xadd<4>(se); se = xadd<8>(se);
        const float sc = omli / sqrtf(ss * (1.f / 128.f) + EPS), se2 = 1.0f / sqrtf(se * (1.f / 128.f) + EPS);
#pragma unroll
        for (int i = 0; i < 8; ++i) { d[i] = d[i] * sc * subln[c0 + i]; e[i] = e[i] * se2 * onorm[c0 + i] * siluf(g[i]); }
        v4u w; w.x = pg8::cvt_pk_bf16(d[0], d[1]); w.y = pg8::cvt_pk_bf16(d[2], d[3]); w.z = pg8::cvt_pk_bf16(d[4], d[5]); w.w = pg8::cvt_pk_bf16(d[6], d[7]);
        *(v4u*)(MRG + (size_t)r * DM + h * 128 + c0) = w;
        v4u x; x.x = pg8::cvt_pk_bf16(e[0], e[1]); x.y = pg8::cvt_pk_bf16(e[2], e[3]); x.z = pg8::cvt_pk_bf16(e[4], e[5]); x.w = pg8::cvt_pk_bf16(e[6], e[7]);
        *(v4u*)(MRG + (size_t)r * DM + 512 + h * 128 + c0) = x;
    }
}

__device__ __forceinline__ float dpp_sum16(float v) {
    v += __int_as_float(__builtin_amdgcn_update_dpp(0, __float_as_int(v), 0xB1, 0xF, 0xF, true));
    v += __int_as_float(__builtin_amdgcn_update_dpp(0, __float_as_int(v), 0x4E, 0xF, 0xF, true));
    v += __int_as_float(__builtin_amdgcn_update_dpp(0, __float_as_int(v), 0x141, 0xF, 0xF, true));
    v += __int_as_float(__builtin_amdgcn_update_dpp(0, __float_as_int(v), 0x140, 0xF, 0xF, true));
    return v;
}
__device__ __forceinline__ float wave_sum2(float v) { v = dpp_sum16(v); v = xadd<16>(v); v = xadd<32>(v); return v; }
__device__ __forceinline__ float row_rinv2(const f32x4 (&v)[4]) {
    float s = 0.f;
#pragma unroll
    for (int j = 0; j < 4; ++j) s += (v[j][0] * v[j][0] + v[j][1] * v[j][1]) + (v[j][2] * v[j][2] + v[j][3] * v[j][3]);
    return __builtin_amdgcn_rsqf(wave_sum2(s) * (1.f / DM) + EPS);
}
__device__ __forceinline__ void ld_raw_bf16(const bf16* row, int lane, u32x2 (&v)[4]) {
#pragma unroll
    for (int j = 0; j < 4; ++j) v[j] = *(const u32x2*)(row + 4 * lane + 256 * j);
}
__device__ __forceinline__ f32x4 raw2f(u32x2 w) { return (f32x4){bflo(w.x), bfhi(w.x), bflo(w.y), bfhi(w.y)}; }
__device__ __forceinline__ void ld_vec(const float* p, int lane, f32x4 (&v)[4]) {
#pragma unroll
    for (int j = 0; j < 4; ++j) v[j] = *(const f32x4*)(p + 4 * lane + 256 * j);
}

__device__ __forceinline__ void p1_rows(Frame& F, int l) {
    refresh(F);
    const float* MOD = (const float*)(F.ws + WS_MOD);
    bf16* X = (bf16*)(F.ws + WS_X); bf16* H = (bf16*)(F.ws + WS_H); const bf16* F2 = (const bf16*)(F.ws + WS_F2);
    const int rpw = (M + F.NGW - 1) / F.NGW, r0 = F.gw * rpw, r1 = (r0 + rpw < M) ? r0 + rpw : M;
    if (r0 >= r1) return;
    const bool two = l > 0 && ((l - 1) & 1);
    f32x4 gpre[4], gpost[4], sh[4], sc[4], gt[4];
    ld_vec(INP(6) + l * DM, F.lane, gpre);
    if (l > 0) ld_vec(INP(9) + (l - 1) * DM, F.lane, gpost);
    int cur = -1;
    f32x4 xn[4]; u32x2 xr[4], fn[4], gn[4];
#define P1_ISSUE(r) do { const int b_ = (r) / TPB, p_ = (r) % TPB; \
        if (l == 0) ld_row_f32(p_ < CTX ? INP(2) + ((size_t)b_ * CTX + p_) * DM : INP(0) + ((size_t)b_ * SEQ + (p_ - CTX)) * DM, F.lane, xn); \
        else ld_raw_bf16(X + (size_t)(r) * DM, F.lane, xr); \
        if (l > 0) { ld_raw_bf16(F2 + (size_t)(r) * DM, F.lane, fn); if (two) ld_raw_bf16(F2 + ((size_t)M + (r)) * DM, F.lane, gn); } } while (0)
    P1_ISSUE(r0);
    for (int r = r0; r < r1; ++r) {
        f32x4 x[4]; u32x2 fr[4], gr[4];
#pragma unroll
        for (int j = 0; j < 4; ++j) { x[j] = (l == 0) ? xn[j] : raw2f(xr[j]); fr[j] = fn[j]; gr[j] = gn[j]; }
        if (r + 1 < r1) P1_ISSUE(r + 1);
        const int b = r / TPB, p = r % TPB, mrow = p < CTX ? 16 : b;
        if (mrow != cur) { cur = mrow; const float* modp = MOD + ((size_t)l * 17 + mrow) * 6144; ld_vec(modp, F.lane, sh); ld_vec(modp + 1024, F.lane, sc);
            if (l > 0) ld_vec(MOD + ((size_t)(l - 1) * 17 + mrow) * 6144 + 5 * 1024, F.lane, gt); }
        if (l > 0) {
            f32x4 f[4];
#pragma unroll
            for (int j = 0; j < 4; ++j) { f[j] = raw2f(fr[j]); if (two) f[j] = f[j] + raw2f(gr[j]); }
            const float rinv = row_rinv2(f);
#pragma unroll
            for (int j = 0; j < 4; ++j) x[j] = x[j] + gt[j] * (f[j] * rinv * gpost[j]);
        }
        st_row_bf16(X + (size_t)r * DM, F.lane, x);
        const float rinv = row_rinv2(x);
        f32x4 h[4];
#pragma unroll
        for (int j = 0; j < 4; ++j) h[j] = (x[j] * rinv * gpre[j]) * (sc[j] + 1.0f) + sh[j];
        st_row_bf16(H + (size_t)r * DM, F.lane, h);
    }
#undef P1_ISSUE
}
__device__ __forceinline__ void pf_final(Frame& F) {
    refresh(F);
    const float* MOD = (const float*)(F.ws + WS_MOD);
    const bf16* X = (const bf16*)(F.ws + WS_X); const bf16* F2 = (const bf16*)(F.ws + WS_F2);
    const int l = DEPTH - 1, NR = NBATCH * SEQ;
    const int rpw = (NR + F.NGW - 1) / F.NGW, i0 = F.gw * rpw, i1 = (i0 + rpw < NR) ? i0 + rpw : NR;
    if (i0 >= i1) return;
    f32x4 gpost[4], gt[4]; ld_vec(INP(9) + l * DM, F.lane, gpost);
    int cur = -1;
    u32x2 xn[4], fn[4], gn[4];
#define PF_ISSUE(i) do { const size_t r_ = (size_t)((i) / SEQ) * TPB + CTX + (i) % SEQ; ld_raw_bf16(X + r_ * DM, F.lane, xn); ld_raw_bf16(F2 + r_ * DM, F.lane, fn); ld_raw_bf16(F2 + ((size_t)M + r_) * DM, F.lane, gn); } while (0)
    PF_ISSUE(i0);
    for (int i = i0; i < i1; ++i) {
        f32x4 x[4], f[4];
#pragma unroll
        for (int j = 0; j < 4; ++j) { x[j] = raw2f(xn[j]); f[j] = raw2f(fn[j]) + raw2f(gn[j]); }
        if (i + 1 < i1) PF_ISSUE(i + 1);
        const int b = i / SEQ;
        if (b != cur) { cur = b; ld_vec(MOD + ((size_t)l * 17 + b) * 6144 + 5 * 1024, F.lane, gt); }
        const float rinv = row_rinv2(f);
#pragma unroll
        for (int j = 0; j < 4; ++j) x[j] = x[j] + gt[j] * (f[j] * rinv * gpost[j]);
        st_row_f32(F.A->out + (size_t)i * DM, F.lane, x);
    }
#undef PF_ISSUE
}
__device__ __forceinline__ void p7_rows(Frame& F, int l) {
    refresh(F);
    const float* MOD = (const float*)(F.ws + WS_MOD);
    bf16* X = (bf16*)(F.ws + WS_X); const bf16* Y = (const bf16*)(F.ws + WS_Y); bf16* H2 = (bf16*)(F.ws + WS_H2);
    const bool moe = l & 1; const int li = l >> 1;
    int* TOPE = (int*)(F.ws + WS_TOPE); int* LIDX = (int*)(F.ws + WS_LIDX); float* TOPW = (float*)(F.ws + WS_TOPW); int* BLKB = (int*)(F.ws + WS_BLKB);
    volatile LAS unsigned* LCNT = F.MISC + 16;
    LAS float* RT = (LAS float*)F.lds;
    if (moe) {
        const float* router = INP(20) + (size_t)li * DM * NE;
        if (F.tid < 8) LCNT[F.tid] = 0u;
        for (int i = F.tid; i < DM * NE / 4; i += 512) { const f32x4 q = *(const f32x4*)(router + 4 * i); const int c = i >> 1, e0 = (i & 1) * 4;
            RT[(e0 + 0) * DM + c] = q[0]; RT[(e0 + 1) * DM + c] = q[1]; RT[(e0 + 2) * DM + c] = q[2]; RT[(e0 + 3) * DM + c] = q[3]; }
        __syncthreads();
    }
    const bool lastl = (l == DEPTH - 1); const int NR = lastl ? NBATCH * SEQ : M;
#define P7_ROW(i) (lastl ? ((i) / SEQ) * TPB + CTX + (i) % SEQ : (i))
    const int rpw = (NR + F.NGW - 1) / F.NGW, r0 = F.gw * rpw, r1 = (r0 + rpw < NR) ? r0 + rpw : NR;
    if (r0 < r1) {
        f32x4 gpost[4], gpre[4], gt[4], sh[4], sc[4];
        ld_vec(INP(7) + l * DM, F.lane, gpost); ld_vec(INP(8) + l * DM, F.lane, gpre);
        int cur = -1;
        u32x2 xn[4], yn[4];
        ld_raw_bf16(X + (size_t)P7_ROW(r0) * DM, F.lane, xn); ld_raw_bf16(Y + (size_t)P7_ROW(r0) * DM, F.lane, yn);
        for (int ri = r0; ri < r1; ++ri) {
            const int r = P7_ROW(ri);
            f32x4 x[4], y[4];
#pragma unroll
            for (int j = 0; j < 4; ++j) { x[j] = raw2f(xn[j]); y[j] = raw2f(yn[j]); }
            if (ri + 1 < r1) { const int rn = P7_ROW(ri + 1); ld_raw_bf16(X + (size_t)rn * DM, F.lane, xn); ld_raw_bf16(Y + (size_t)rn * DM, F.lane, yn); }
            const int b = r / TPB, p = r % TPB, mrow = p < CTX ? 16 : b;
            if (mrow != cur) { cur = mrow; const float* modp = MOD + ((size_t)l * 17 + mrow) * 6144; ld_vec(modp + 2 * 1024, F.lane, gt); ld_vec(modp + 3 * 1024, F.lane, sh); ld_vec(modp + 4 * 1024, F.lane, sc); }
            const float ry = row_rinv2(y);
#pragma unroll
            for (int j = 0; j < 4; ++j) x[j] = x[j] + gt[j] * (y[j] * ry * gpost[j]);
            st_row_bf16(X + (size_t)r * DM, F.lane, x);
            const float rx = row_rinv2(x);
            f32x4 h[4];
#pragma unroll
            for (int j = 0; j < 4; ++j) h[j] = (x[j] * rx * gpre[j]) * (sc[j] + 1.0f) + sh[j];
            if constexpr (FFN_F8) {
#pragma unroll
                for (int j = 0; j < 4; ++j) *(unsigned*)((unsigned char*)H2 + (size_t)r * DM + 4 * F.lane + 256 * j) = pk4_f8(h[j][0], h[j][1], h[j][2], h[j][3]);
            } else st_row_bf16(H2 + (size_t)r * DM, F.lane, h);
            if (moe) {
                float lg[8];
#pragma unroll
                for (int e = 0; e < 8; ++e) lg[e] = 0.f;
#pragma unroll
                for (int j = 0; j < 4; ++j)
#pragma unroll
                    for (int e = 0; e < 8; ++e) { const f32x4 q = *(const LAS f32x4*)(RT + e * DM + 4 * F.lane + 256 * j); lg[e] += (h[j][0] * q[0] + h[j][1] * q[1]) + (h[j][2] * q[2] + h[j][3] * q[3]); }
#pragma unroll
                for (int e = 0; e < 8; ++e) lg[e] = wave_sum2(lg[e]);
                int e0 = 0; float v0 = lg[0];
#pragma unroll
                for (int e = 1; e < 8; ++e) if (lg[e] > v0) { v0 = lg[e]; e0 = e; }
                int e1 = -1; float v1 = -3.0e38f;
#pragma unroll
                for (int e = 0; e < 8; ++e) if (e != e0 && lg[e] > v1) { v1 = lg[e]; e1 = e; }
                const float ex = __expf(v1 - v0), w0 = 1.f / (1.f + ex), w1 = ex / (1.f + ex);
                if (F.lane == 0) {
                    const unsigned i0 = __hip_atomic_fetch_add((LAS unsigned*)&LCNT[e0], 1u, __ATOMIC_RELAXED, __HIP_MEMORY_SCOPE_WORKGROUP), i1 = __hip_atomic_fetch_add((LAS unsigned*)&LCNT[e1], 1u, __ATOMIC_RELAXED, __HIP_MEMORY_SCOPE_WORKGROUP);
                    TOPE[r] = e0 | (e1 << 8); LIDX[2 * r] = (int)i0; LIDX[2 * r + 1] = (int)i1; TOPW[2 * r] = w0; TOPW[2 * r + 1] = w1;
                }
            }
        }
    }
    if (moe) {
        __syncthreads();
        if (F.tid < 8) { const unsigned base = __hip_atomic_fetch_add((unsigned*)((gu32*)F.ws + CW_CNT + 64 * li + F.tid), LCNT[F.tid], __ATOMIC_RELAXED, __HIP_MEMORY_SCOPE_AGENT); BLKB[F.blk * 8 + F.tid] = (int)base; }
    }
#undef P7_ROW
}
__device__ __forceinline__ void moe_offsets(Frame& F, int li, int (&cnt)[8], int (&off)[9]) {
    off[0] = 0;
#pragma unroll
    for (int e = 0; e < 8; ++e) { cnt[e] = (int)__hip_atomic_load((unsigned*)(((gu32*)F.ws) + CW_CNT + 64 * li + e), __ATOMIC_RELAXED, __HIP_MEMORY_SCOPE_AGENT); off[e + 1] = off[e] + ((cnt[e] + 255) & ~255); }
}
__device__ __forceinline__ void p7b_gather(Frame& F, int l) {
    refresh(F);
    const int li = l >> 1; int cnt[8], off[9]; moe_offsets(F, li, cnt, off);
    const bf16* H2 = (const bf16*)(F.ws + WS_H2); bf16* HG = (bf16*)(F.ws + WS_HG);
    const int* TOPE = (const int*)(F.ws + WS_TOPE); const int* LIDX = (const int*)(F.ws + WS_LIDX); const float* TOPW = (const float*)(F.ws + WS_TOPW); const int* BLKB = (const int*)(F.ws + WS_BLKB);
    int* RMAP = (int*)(F.ws + WS_RMAP); float* ROWW = (float*)(F.ws + WS_ROWW);
    constexpr int RB = FFN_F8 ? DM : 2 * DM, LB = RB / 64;
    const unsigned char* H2b = (const unsigned char*)H2; unsigned char* HGb = (unsigned char*)HG;
    const bool lastl = (l == DEPTH - 1); const int NR = lastl ? NBATCH * SEQ : M;
    const int rpw = (NR + F.NGW - 1) / F.NGW, r0 = F.gw * rpw, r1 = (r0 + rpw < NR) ? r0 + rpw : NR;
    for (int ri = r0; ri < r1; ++ri) {
        const int r = lastl ? (ri / SEQ) * TPB + CTX + ri % SEQ : ri;
        const int te = TOPE[r];
        v4u a, bq = {0u, 0u, 0u, 0u}; a = *(const v4u*)(H2b + (size_t)r * RB + F.lane * LB); if constexpr (!FFN_F8) bq = *(const v4u*)(H2b + (size_t)r * RB + F.lane * LB + 16);
#pragma unroll
        for (int s = 0; s < 2; ++s) {
            const int e = (te >> (8 * s)) & 0xff;
            int o = 0;
#pragma unroll
            for (int q = 0; q < 8; ++q) o = (q == e) ? off[q] : o;
            const int pos = o + BLKB[F.blk * 8 + e] + LIDX[2 * r + s];
            *(v4u*)(HGb + (size_t)pos * RB + F.lane * LB) = a; if constexpr (!FFN_F8) *(v4u*)(HGb + (size_t)pos * RB + F.lane * LB + 16) = bq;
            if (F.lane == 0) { RMAP[pos] = r | (s << 30); ROWW[pos] = TOPW[2 * r + s]; }
        }
    }
#pragma unroll
    for (int e = 0; e < 8; ++e) {
        const int npad = off[e + 1] - off[e] - cnt[e];
        for (int i = F.gw; i < npad; i += F.NGW) { const int pos = off[e] + cnt[e] + i; const unsigned zz = (unsigned)F.z; const v4u z = {zz, zz, zz, zz};
            *(v4u*)(HGb + (size_t)pos * RB + F.lane * LB) = z; if constexpr (!FFN_F8) *(v4u*)(HGb + (size_t)pos * RB + F.lane * LB + 16) = z;
            if (F.lane == 0) { RMAP[pos] = -1; ROWW[pos] = 0.f; } }
    }
}

__global__ void __launch_bounds__(NWAVES * 64, 2) mk_fwd(Args args) {
    extern __shared__ __attribute__((aligned(16))) unsigned char lds[];
    Frame F;
    F.lds = (LAS unsigned char*)lds;
    F.MISC = (volatile LAS unsigned*)(F.lds + MISC_OFF);
    F.tid = threadIdx.x; F.lane = F.tid & 63; F.wave = __builtin_amdgcn_readfirstlane(F.tid >> 6); F.wv = F.wave;
    F.G = gridDim.x; F.blk = blockIdx.x; F.gw = F.blk * NWAVES + F.wave; F.NGW = F.G * NWAVES;
    F.ws = args.ws;
    F.A = &args;
    for (int u = F.tid; u < 128; u += NWAVES * 64) F.MISC[u] = 0u;
    __syncthreads();
    { XcdBarrier b0 = xcd_barrier_post((unsigned*)F.ws + CW_BAR, F.MISC + 8); (void)b0; }
#define GRID_BAR() do { XcdBarrier b_; b_.bar = (unsigned*)F.ws + CW_BAR; b_.x = xb_xcc_id(); b_.st = F.MISC + 8; refresh(F); xcd_barrier(b_, F.tid == 0); } while (0)

    p0_mod(F); p0_misc(F); convert_weights(F, 0);
    GRID_BAR();
    for (int l = 0; l < DEPTH; ++l) {
        const bool moe = l & 1; const int li = l >> 1;
        { unsigned char* wsp = args.ws; asm volatile("" : "+s"(wsp)); F.ws = wsp; }
        p1_rows(F, l);
        if (l > 0) convert_weights(F, l);
        GRID_BAR();
        {
            refresh(F);
            pg8::Gemm g{(const pg8::bf16_t*)(F.ws + WS_H), (const pg8::bf16_t*)(F.ws + WS_WIN), M, NP, DM};
            pg8::StaticOrder S; S.init(M, NP, F.G, F.blk);
            pg8::EpiProj E{(pg8::bf16_t*)(F.ws + WS_PROJ), (const float*)(F.ws + WS_ROPE), (const float*)(F.ws + WS_ROPE) + 1024, (unsigned*)F.ws + CW_KMX + 256 * l};
            pg8::gemm_phase<pg8::EpiProj, pg8::StaticOrder, true, true>(F.lds, g, S, E, F.wave);
        }
        GRID_BAR();
        p3_mixer(F, l);
        GRID_BAR();
        p5_merge_all(F, l);
        GRID_BAR();
        {
            refresh(F);
            pg8::Gemm g{(const pg8::bf16_t*)(F.ws + WS_H), (const pg8::bf16_t*)(F.ws + WS_WOUT), M, DM, DM};
            const int lastl = (l == DEPTH - 1);
            pg8::LatOrder S; S.S.init(lastl ? NBATCH * SEQ : M, DM, F.G, F.blk); S.lat = lastl;
            pg8::EpiF32 E{(pg8::bf16_t*)(F.ws + WS_Y)};
            pg8::gemm_phase<pg8::EpiF32, pg8::LatOrder, true, true>(F.lds, g, S, E, F.wave);
        }
        GRID_BAR();
        p7_rows(F, l);
        GRID_BAR();
        if (moe) { p7b_gather(F, l); GRID_BAR(); }
        int ntiles = M / 256;
        {
            refresh(F);
            LAS int* texp = (LAS int*)(F.lds + TEXP_OFF);
            if (moe) { int cnt[8], off[9]; moe_offsets(F, li, cnt, off); ntiles = off[8] >> 8;
                for (int t = F.tid; t < ntiles; t += 512) { int e = 0;
#pragma unroll
                    for (int q = 1; q < 8; ++q) e += ((t << 8) >= off[q]) ? 1 : 0;
                    texp[t] = e; } }
            else { for (int t = F.tid; t < ntiles; t += 512) texp[t] = 0; }
            __syncthreads();
        }
        {
            refresh(F);
            pg8::Gemm g{(const pg8::bf16_t*)(F.ws + (moe ? WS_HG : WS_H2)), (const pg8::bf16_t*)(F.ws + WS_WUP), ntiles * 256, 2 * DFF, FFN_F8 ? DM / 2 : DM};
            pg8::GroupedOrder S; S.S.init(ntiles * 256, 2 * DFF, F.G, F.blk); S.texp = (const LAS int*)(F.lds + TEXP_OFF); S.nN = 22;
            pg8::EpiSwiglu E{(pg8::bf16_t*)(F.ws + WS_U)};
            pg8::gemm_phase<pg8::EpiSwiglu, pg8::GroupedOrder, true, true, FFN_F8 != 0>(F.lds, g, S, E, F.wave);
        }
        GRID_BAR();
        {
            refresh(F);
            pg8::Gemm g{(const pg8::bf16_t*)(F.ws + WS_U), (const pg8::bf16_t*)(F.ws + WS_WDN), ntiles * 256, DM, FFN_F8 ? DFF / 2 : DFF};
            pg8::GroupedOrder S; S.S.init(ntiles * 256, DM, F.G, F.blk); S.texp = (const LAS int*)(F.lds + TEXP_OFF); S.nN = 4;
            pg8::EpiDown E{(pg8::bf16_t*)(F.ws + WS_F2), (const int*)(F.ws + WS_RMAP), (const float*)(F.ws + WS_ROWW), moe ? 0 : 1};
            pg8::gemm_phase<pg8::EpiDown, pg8::GroupedOrder, true, true, FFN_F8 != 0>(F.lds, g, S, E, F.wave);
        }
        GRID_BAR();
    }
    pf_final(F);
}

extern "C" void kernel_launch(void* const* d_in, const int* in_sizes, int n_in, void* d_out, int out_size, void* d_ws, size_t ws_size, hipStream_t stream) {
    static int grid = 0;
    if (grid == 0) {
        if (n_in != 24 || out_size != NBATCH * SEQ * DM || ws_size < WS_END) { fprintf(stderr, "kernel_launch: unexpected shapes or workspace (%d inputs, out %d, ws %zu < %zu)\n", n_in, out_size, ws_size, (size_t)WS_END); grid = -1; return; }
        int dev = 0, cus = 0, per_cu = 0;
        if (hipGetDevice(&dev) != hipSuccess || hipDeviceGetAttribute(&cus, hipDeviceAttributeMultiprocessorCount, dev) != hipSuccess) { grid = -1; return; }
        if (hipFuncSetAttribute((const void*)mk_fwd, hipFuncAttributeMaxDynamicSharedMemorySize, LDS_BYTES) != hipSuccess) { grid = -1; return; }
        if (hipOccupancyMaxActiveBlocksPerMultiprocessor(&per_cu, (const void*)mk_fwd, NWAVES * 64, LDS_BYTES) != hipSuccess || per_cu < 1) { fprintf(stderr, "kernel_launch: occupancy query says %d\n", per_cu); }
        (void)hipGetLastError();
        grid = cus;
    }
    if (grid < 0) return;
    if (hipMemsetAsync((char*)d_ws + WS_CTL, 0, CTL_ZERO_BYTES, stream) != hipSuccess) return;
    Args a{};
    for (int i = 0; i < 24; ++i) a.in[i] = (const float*)d_in[i];
    a.out = (float*)d_out; a.ws = (unsigned char*)d_ws;
    hipLaunchKernelGGL(mk_fwd, dim3(grid), dim3(NWAVES * 64), LDS_BYTES, stream, a);
}
```

```cpp
#include <hip/hip_runtime.h>
#include <cstdio>
#include <cstdint>
namespace pg8 {
#define PG8_LAS __attribute__((address_space(3)))
typedef unsigned short bf16_t;
__device__ __forceinline__ int lane_id_opaque() { int l; asm volatile("v_mbcnt_lo_u32_b32 %0, -1, 0\n\tv_mbcnt_hi_u32_b32 %0, -1, %0" : "=v"(l)); return l; }
typedef short bf16x8 __attribute__((ext_vector_type(8)));
typedef float f32x4 __attribute__((ext_vector_type(4)));
typedef unsigned u32x4 __attribute__((ext_vector_type(4)));
constexpr int BM = 256, BK = 64, HALF = 128, HTB = HALF * BK * 2  , STAGE_BYTES = 8 * HTB, NXCD = 8, WGM = 8;

__host__ __device__ __forceinline__ int lds_byte(int r, int c) { const int st = (r >> 4) * 2 + (c >> 5), rr = r & 15, cc = c & 31, ob = rr * 64 + cc * 2; return st * 1024 + (ob ^ (((ob >> 9) & 1) << 5)); }
__host__ __device__ __forceinline__ void stage_rc(int b, int& R, int& C) { const int st = b / 1024, sb = b % 1024, swz = sb ^ (((sb >> 9) & 1) << 5); R = (st >> 1) * 16 + swz / 64; C = (st & 1) * 32 + (swz % 64) / 2; }
__host__ __device__ __forceinline__ int perm32(int rho) { const int n = rho >> 4, i = rho & 15; return 8 * (i >> 2) + 4 * n + (i & 3); }

struct Unit { int pm, pn; };
struct Gemm { const bf16_t* A; const bf16_t* Bt; int M, N, K; };

struct StaticOrder {
    int nM, nN, nwg, G, c;
    __host__ __device__ void init(int M, int N, int G_, int c_) { nM = M / BM; nN = N / BM; nwg = nM * nN; G = G_; c = c_; }
    __host__ __device__ bool next(int i, Unit& u) const {
        const long L = (long)i * G + c; if (L >= nwg) return false;
        int wgid = (int)L; { const int q = nwg / NXCD, r = nwg % NXCD, xcd = wgid % NXCD, off = wgid / NXCD; wgid = (xcd < r ? xcd * (q + 1) : r * (q + 1) + (xcd - r) * q) + off; }
        const int nig = WGM * nN, gid = wgid / nig, fm = gid * WGM, gsz = (nM - fm) < WGM ? (nM - fm) : WGM;
        u.pm = fm + ((wgid % nig) % gsz); u.pn = (wgid % nig) / gsz; return true;
    }
    __device__ __forceinline__ void a_ready(const Unit&) const {}
    __device__ __forceinline__ void done(const Unit&) const {}
};

__device__ __forceinline__ unsigned cvt_pk_bf16(float lo, float hi) { unsigned r; asm volatile("v_cvt_pk_bf16_f32 %0, %1, %2" : "=v"(r) : "v"(lo), "v"(hi)); return r; }
typedef float f32x2 __attribute__((ext_vector_type(2)));
template <class Epi, class Sched, bool ALIGN_EPI = false, bool SP2 = false, bool F8 = false>
__device__ __forceinline__ void gemm_phase(PG8_LAS unsigned char* lds, const Gemm g, const Sched& S, const Epi& E, const int wv  ) {
    int tid_ = wv * 64 + lane_id_opaque();
    const int tid = tid_, wid = __builtin_amdgcn_readfirstlane(tid >> 6), lane = tid & 63, wr = wid >> 2, wc = wid & 3, fr = lane & 15, fq = lane >> 4;
    const int K = g.K, nt = K / BK;
    unsigned voffA[2], voffB[2];
#pragma unroll
    for (int i = 0; i < 2; ++i) { int R, C; stage_rc(tid * 16 + i * 8192, R, C); const int Rb = Epi::PERM ? ((R & ~31) + perm32(R & 31)) : R;
        voffA[i] = (unsigned)(R * K + C) * 2u; voffB[i] = (unsigned)(Rb * K + C) * 2u; }
    const size_t kstep = (size_t)(BK * 2);
    const size_t hstep = (size_t)HALF * K * 2;
    const size_t tstep = 2 * hstep;
    const unsigned ldsw = (unsigned)wid * 1024u;
    const int aoff = lds_byte(wr * 64 + fr, fq * 8), boff = lds_byte(wc * 32 + fr, fq * 8);
#define PG8_SA(b, h) (((b) * 2 + (h)) * HTB)
#define PG8_SB(b, h) ((4 + (b) * 2 + (h)) * HTB)
#define PG8_STAGE(bufoff, gbase, voff) do { _Pragma("unroll") for (int _i = 0; _i < 2; ++_i) \
        __builtin_amdgcn_global_load_lds((const __attribute__((address_space(1))) unsigned*)((const __attribute__((address_space(1))) char*)(gbase) + (voff)[_i]), (PG8_LAS unsigned*)(lds + (bufoff) + ldsw + _i * 8192), 16, 0, 0); } while (0)
#define PG8_LDA(dst, b, h) do { _Pragma("unroll") for (int m = 0; m < 4; ++m) _Pragma("unroll") for (int k = 0; k < 2; ++k) dst[m][k] = *(const PG8_LAS bf16x8*)(lds + PG8_SA(b, h) + aoff + m * 2048 + k * 1024); } while (0)
#define PG8_LDB(dst, b, h) do { _Pragma("unroll") for (int n = 0; n < 2; ++n) _Pragma("unroll") for (int k = 0; k < 2; ++k) dst[n][k] = *(const PG8_LAS bf16x8*)(lds + PG8_SB(b, h) + boff + n * 2048 + k * 1024); } while (0)
#define PG8_MMA(ai, bj, At, Bt) do { if constexpr (F8) __builtin_amdgcn_sched_barrier(0); __builtin_amdgcn_s_setprio(1); _Pragma("unroll") for (int m = 0; m < 4; ++m) _Pragma("unroll") for (int n = 0; n < 2; ++n) { \
        if constexpr (F8) { typedef int i32x4_ __attribute__((ext_vector_type(4))); \
            acc[ai][bj][m][n] = __builtin_amdgcn_mfma_scale_f32_16x16x128_f8f6f4(__builtin_shufflevector(__builtin_bit_cast(i32x4_, Bt[n][0]), __builtin_bit_cast(i32x4_, Bt[n][1]), 0, 1, 2, 3, 4, 5, 6, 7), \
                __builtin_shufflevector(__builtin_bit_cast(i32x4_, At[m][0]), __builtin_bit_cast(i32x4_, At[m][1]), 0, 1, 2, 3, 4, 5, 6, 7), acc[ai][bj][m][n], 0, 0, 0, 0x7f7f7f7f, 0, 0x7f7f7f7f); } \
        else { _Pragma("unroll") for (int k = 0; k < 2; ++k) acc[ai][bj][m][n] = __builtin_amdgcn_mfma_f32_16x16x32_bf16(Bt[n][k], At[m][k], acc[ai][bj][m][n], 0, 0, 0); } } \
        __builtin_amdgcn_s_setprio(0); if constexpr (F8) __builtin_amdgcn_sched_barrier(0); } while (0)
#define PG8_WAIT_V(n) asm volatile("s_waitcnt vmcnt(" #n ")" ::: "memory")
#define PG8_WAIT_L(n) asm volatile("s_waitcnt lgkmcnt(" #n ")" ::: "memory")
#define PG8_BAR __builtin_amdgcn_s_barrier()
#define PG8_SCHED __builtin_amdgcn_sched_barrier(0)
    Unit cur, nxt; int ui = 0;
    if (!S.next(0, cur)) return;
    f32x4 acc[2][2][4][2];
#pragma unroll
    for (int a = 0; a < 2; ++a)
#pragma unroll
        for (int b = 0; b < 2; ++b)
#pragma unroll
            for (int m = 0; m < 4; ++m)
#pragma unroll
                for (int n = 0; n < 2; ++n) acc[a][b][m][n] = (f32x4){0.f, 0.f, 0.f, 0.f};
    bf16x8 At[4][2], B0[2][2], B1[2][2];
    const char* cA = (const char*)g.A + (size_t)cur.pm * tstep; const char* cB = (const char*)g.Bt + (size_t)cur.pn * tstep;
    S.a_ready(cur);
    if constexpr (SP2) {
        PG8_STAGE(PG8_SB(0, 0), cB, voffB); PG8_STAGE(PG8_SB(0, 1), cB + hstep, voffB); PG8_STAGE(PG8_SA(0, 0), cA, voffA); PG8_STAGE(PG8_SA(0, 1), cA + hstep, voffA);
        if (wr == 1) PG8_BAR;
        PG8_WAIT_V(2); PG8_BAR;
        PG8_STAGE(PG8_SB(1, 0), cB + kstep, voffB); PG8_STAGE(PG8_SA(1, 0), cA + kstep, voffA); PG8_STAGE(PG8_SB(1, 1), cB + hstep + kstep, voffB);
        PG8_WAIT_V(6); PG8_BAR;
    } else {
        PG8_STAGE(PG8_SB(0, 0), cB, voffB); PG8_STAGE(PG8_SA(0, 0), cA, voffA); PG8_STAGE(PG8_SB(0, 1), cB + hstep, voffB); PG8_STAGE(PG8_SA(0, 1), cA + hstep, voffA);
        if (wr == 1) PG8_BAR;
        PG8_WAIT_V(4); PG8_BAR;
        PG8_STAGE(PG8_SB(1, 0), cB + kstep, voffB); PG8_STAGE(PG8_SA(1, 0), cA + kstep, voffA); PG8_STAGE(PG8_SB(1, 1), cB + hstep + kstep, voffB);
        PG8_WAIT_V(6); PG8_BAR;
    }
    for (;;) {
        const bool has_next = S.next(ui + 1, nxt);
        const char* nA = has_next ? (const char*)g.A + (size_t)nxt.pm * tstep : cA; const char* nB = has_next ? (const char*)g.Bt + (size_t)nxt.pn * tstep : cB;
        for (int t = 0; t < nt; t += 2) {
            const bool last = (t == nt - 2);
            const char* a1 = cA + (size_t)(t + 1) * kstep;
            const char* a2 = last ? nA : cA + (size_t)(t + 2) * kstep; const char* b2 = last ? nB : cB + (size_t)(t + 2) * kstep;
            const char* a3 = a2 + kstep; const char* b3 = b2 + kstep;
            if (last && has_next) S.a_ready(nxt);
            if constexpr (SP2) {
            PG8_LDB(B0, 0, 0); PG8_LDB(B1, 0, 1); PG8_SCHED; PG8_LDA(At, 0, 0); PG8_STAGE(PG8_SA(1, 1), a1 + hstep, voffA);
            PG8_WAIT_V(8); PG8_WAIT_L(0); PG8_BAR; PG8_MMA(0, 0, At, B0); PG8_MMA(0, 1, At, B1); PG8_BAR; PG8_SCHED;
            PG8_LDA(At, 0, 1); PG8_STAGE(PG8_SB(0, 0), b2, voffB); PG8_STAGE(PG8_SB(0, 1), b2 + hstep, voffB); PG8_STAGE(PG8_SA(0, 0), a2, voffA);
            PG8_WAIT_V(8); PG8_WAIT_L(0); PG8_BAR; PG8_MMA(1, 0, At, B0); PG8_MMA(1, 1, At, B1); PG8_BAR; PG8_SCHED;
            PG8_LDB(B0, 1, 0); PG8_LDB(B1, 1, 1); PG8_SCHED; PG8_LDA(At, 1, 0); PG8_STAGE(PG8_SA(0, 1), a2 + hstep, voffA);
            PG8_WAIT_V(8); PG8_WAIT_L(0); PG8_BAR; PG8_MMA(0, 0, At, B0); PG8_MMA(0, 1, At, B1); PG8_BAR; PG8_SCHED;
            PG8_LDA(At, 1, 1); PG8_STAGE(PG8_SB(1, 0), b3, voffB); PG8_STAGE(PG8_SB(1, 1), b3 + hstep, voffB); PG8_STAGE(PG8_SA(1, 0), a3, voffA);
            PG8_WAIT_V(8); PG8_WAIT_L(0); PG8_BAR; PG8_MMA(1, 0, At, B0); PG8_MMA(1, 1, At, B1); PG8_BAR; PG8_SCHED;
            } else {
            PG8_LDB(B0, 0, 0); PG8_SCHED; PG8_LDA(At, 0, 0); PG8_STAGE(PG8_SA(1, 1), a1 + hstep, voffA);
            PG8_WAIT_L(8); PG8_BAR; PG8_WAIT_L(0); PG8_MMA(0, 0, At, B0); PG8_BAR; PG8_SCHED;
            PG8_LDB(B1, 0, 1); PG8_STAGE(PG8_SB(0, 0), b2, voffB);
            PG8_BAR; PG8_WAIT_L(0); PG8_MMA(0, 1, At, B1); PG8_BAR;
            PG8_LDA(At, 0, 1); PG8_STAGE(PG8_SA(0, 0), a2, voffA);
            PG8_BAR; PG8_WAIT_L(0); PG8_MMA(1, 0, At, B0); PG8_BAR; PG8_SCHED;
            PG8_STAGE(PG8_SB(0, 1), b2 + hstep, voffB);
            PG8_WAIT_V(6); PG8_BAR; PG8_MMA(1, 1, At, B1); PG8_BAR;
            PG8_LDB(B0, 1, 0); PG8_SCHED; PG8_LDA(At, 1, 0); PG8_STAGE(PG8_SA(0, 1), a2 + hstep, voffA);
            PG8_WAIT_L(8); PG8_BAR; PG8_WAIT_L(0); PG8_MMA(0, 0, At, B0); PG8_BAR; PG8_SCHED;
            PG8_LDB(B1, 1, 1); PG8_STAGE(PG8_SB(1, 0), b3, voffB);
            PG8_BAR; PG8_WAIT_L(0); PG8_MMA(0, 1, At, B1); PG8_BAR;
            PG8_LDA(At, 1, 1); PG8_STAGE(PG8_SA(1, 0), a3, voffA);
            PG8_BAR; PG8_WAIT_L(0); PG8_MMA(1, 0, At, B0); PG8_BAR; PG8_SCHED;
            PG8_STAGE(PG8_SB(1, 1), b3 + hstep, voffB);
            PG8_WAIT_V(6); PG8_BAR; PG8_MMA(1, 1, At, B1); PG8_BAR;
            }
        }
        if constexpr (ALIGN_EPI) { if (wr == 0) PG8_BAR; }
        if constexpr (!Epi::AFTER_DRAIN) { const int t2_ = lane_id_opaque(); const int fr_ = t2_ & 15, fq_ = (t2_ & 63) >> 4;
            E(acc, cur, wr, wc, fr_, fq_); S.done(cur); }
        if (!has_next) break;
#pragma unroll
        for (int a = 0; a < 2; ++a)
#pragma unroll
            for (int b = 0; b < 2; ++b)
#pragma unroll
                for (int m = 0; m < 4; ++m)
#pragma unroll
                    for (int n = 0; n < 2; ++n) acc[a][b][m][n] = (f32x4){0.f, 0.f, 0.f, 0.f};
        cur = nxt; cA = nA; cB = nB; ++ui;
        if constexpr (ALIGN_EPI) { if (wr == 1) PG8_BAR; }
    }
    PG8_WAIT_V(0);
    if constexpr (!ALIGN_EPI) { if (wr == 0) PG8_BAR; }
    PG8_BAR;
    if constexpr (Epi::AFTER_DRAIN) { E.fused(acc, cur, wr, wc, fr, fq, lds, wid, lane); S.done(cur); }
#undef PG8_SA
#undef PG8_SB
#undef PG8_STAGE
#undef PG8_LDA
#undef PG8_LDB
#undef PG8_MMA
#undef PG8_WAIT_V
#undef PG8_WAIT_L
#undef PG8_BAR
#undef PG8_SCHED
}
}
#define GAS __attribute__((address_space(1)))
#define LAS __attribute__((address_space(3)))
typedef unsigned short bf16;
typedef unsigned v4u __attribute__((ext_vector_type(4)));
typedef float f32x4 __attribute__((ext_vector_type(4)));
typedef short bf16x8 __attribute__((ext_vector_type(8)));
typedef GAS unsigned gu32;
typedef GAS unsigned long long gu64;
#define RLX_AGENT __ATOMIC_RELAXED, __HIP_MEMORY_SCOPE_AGENT
#define LDS_WAIT() asm volatile("s_waitcnt lgkmcnt(0)" ::: "memory")
#define VM_WAIT() asm volatile("s_waitcnt vmcnt(0)" ::: "memory")
__device__ __forceinline__ unsigned long long rt() { return __builtin_amdgcn_s_memrealtime(); }
__device__ __forceinline__ unsigned f2bf(float f) { unsigned u = __builtin_bit_cast(unsigned, f); return (u + 0x7fffu + ((u >> 16) & 1u)) >> 16; }
__device__ __forceinline__ unsigned pk2(float lo, float hi) { return f2bf(lo) | (f2bf(hi) << 16); }

#define XB_TMO      128
#define XB_XCNT(j)  (256  + 64 * (j))
#define XB_XSUB(j)  (1280 + 64 * (j))
#define XB_XGEN(j)  (2304 + 64 * (j))
#define XB_TOP      3328
#define XB_TOPGEN   3392
#define XCD_BAR_WORDS 3456
#define XB_SPIN_CAP (1u << 18)

__device__ __forceinline__ unsigned xb_ld(unsigned* p)              { return __hip_atomic_load(p, __ATOMIC_RELAXED, __HIP_MEMORY_SCOPE_AGENT); }
__device__ __forceinline__ unsigned xb_add(unsigned* p, unsigned v) { return __hip_atomic_fetch_add(p, v, __ATOMIC_RELAXED, __HIP_MEMORY_SCOPE_AGENT); }
__device__ __forceinline__ unsigned xb_xcc_id() { return (unsigned)__builtin_amdgcn_s_getreg((3 << 11) | 20) & 0xFu; }
#define XB_SPIN(cond, bar) do { unsigned _sp = 0; while (cond) { __builtin_amdgcn_s_sleep(1); \
    if ((++_sp & 255u) == 0u) { if (xb_ld(&(bar)[XB_TMO])) break; if (_sp > XB_SPIN_CAP) { atomicAdd(&(bar)[XB_TMO], 1u); break; } } } } while (0)

struct XcdBarrier {
    unsigned* bar; unsigned x;
    volatile LAS unsigned* st;
};

__device__ __forceinline__ XcdBarrier xcd_barrier_post(unsigned* bar, volatile LAS unsigned* st) {
    XcdBarrier b; b.bar = bar; b.x = xb_xcc_id(); b.st = st;
    if (threadIdx.x == 0) (void)xb_add(&bar[XB_XCNT(b.x)], 1u);
    return b;
}
__device__ __forceinline__ void xcd_barrier_complete(unsigned* bar, unsigned x, unsigned& nloc, unsigned& nx) {
    const unsigned G = gridDim.x * gridDim.y * gridDim.z;
    unsigned sum, cnt, mine, sp = 0u;
    for (;;) {
        sum = 0u; cnt = 0u; mine = 0u;
#pragma unroll
        for (unsigned j = 0; j < 16; ++j) { const unsigned c = xb_ld(&bar[XB_XCNT(j)]); sum += c; cnt += (c > 0u) ? 1u : 0u; mine = (j == x) ? c : mine; }
        if (sum == G) break;
        __builtin_amdgcn_s_sleep(1);
        if ((++sp & 255u) == 0u) { if (xb_ld(&bar[XB_TMO])) break; if (sp > XB_SPIN_CAP) { atomicAdd(&bar[XB_TMO], 1u); break; } }
    }
    nloc = mine > 0u ? mine : 1u; nx = cnt > 0u ? cnt : 1u;
}

__device__ __forceinline__ void xcd_barrier(const XcdBarrier& b, const bool leader  ) {
    asm volatile("s_waitcnt vmcnt(0)" ::: "memory");
    __syncthreads();
    if (leader) {
        unsigned* bar = b.bar; asm volatile("" : "+s"(bar));
        __builtin_amdgcn_s_waitcnt(0);
        unsigned nloc = b.st[0], nx = b.st[1];
        if (nloc == 0u) { xcd_barrier_complete(bar, b.x, nloc, nx); b.st[0] = nloc; b.st[1] = nx; }
        const unsigned old = xb_add(&bar[XB_XSUB(b.x)], 1u);
        const unsigned gen = old / nloc;
        if (old + 1u == (gen + 1u) * nloc) {
            __builtin_amdgcn_fence(__ATOMIC_RELEASE, "agent");
            asm volatile("s_waitcnt vmcnt(0)" ::: "memory");
            const unsigned og = xb_add(&bar[XB_TOP], 1u);
            const unsigned tg = og / nx;
            if (og + 1u == (tg + 1u) * nx) xb_add(&bar[XB_TOPGEN], 1u);
            else XB_SPIN(xb_ld(&bar[XB_TOPGEN]) == tg, bar);
            __builtin_amdgcn_fence(__ATOMIC_ACQUIRE, "agent");
            xb_add(&bar[XB_XGEN(b.x)], 1u);
            asm volatile("s_waitcnt vmcnt(0)" ::: "memory");
        } else {
            XB_SPIN(xb_ld(&bar[XB_XGEN(b.x)]) == gen, bar);
            __builtin_amdgcn_fence(__ATOMIC_ACQUIRE, "agent");
            asm volatile("s_waitcnt vmcnt(0)" ::: "memory");
        }
    }
    __syncthreads();
}

#ifndef FFN_F8
#define FFN_F8 1
#endif
constexpr int NWAVES = 8;
constexpr float W8S = 32.f, U8S = 4.f;
constexpr int DM = 1024, NBATCH = 16, SEQ = 2048, CTX = 256, TPB = SEQ + CTX, M = NBATCH * TPB;
constexpr int DEPTH = 4, NIN = 3104, NP = 3328, DFF = 2816, NE = 8;
constexpr int MP = 2 * M + NE * 256;
constexpr int C_Q = 0, C_K = 512, C_V = 1024, C_GQ = 1536, C_GK = 1792, C_GV = 2048, C_GG = 2560, C_GLR = 3072;
constexpr float EPS = 1e-6f;
constexpr float C2 = 0.125f * 1.4426950408889634f;
constexpr int NCH = TPB / 64;
constexpr int NGLA = NBATCH * 4 * 2 * NCH;

constexpr size_t MiB = 1u << 20;
constexpr size_t WS_CTL = 0, CTL_ZERO_BYTES = 1 * MiB;
constexpr size_t WS_MOD = 1 * MiB;
constexpr size_t WS_ROPE = 3 * MiB;
constexpr size_t WS_TOPE = 4 * MiB;
constexpr size_t WS_LIDX = WS_TOPE + 160 * 1024;
constexpr size_t WS_TOPW = WS_LIDX + 320 * 1024;
constexpr size_t WS_BLKB = WS_TOPW + 320 * 1024;
constexpr size_t WS_RMAP = WS_BLKB + 64 * 1024;
constexpr size_t WS_ROWW = WS_RMAP + 320 * 1024;
static_assert(WS_ROWW + 320 * 1024 <= 6 * MiB, "small tables");
constexpr size_t WS_X = 6 * MiB;
constexpr size_t WS_WIN = 150 * MiB;
constexpr size_t WS_WOUT = WS_WIN + 13 * MiB / 2;
constexpr size_t WS_WUP = WS_WOUT + 2 * MiB;
constexpr size_t WS_WDN = WS_WUP + 88 * MiB;
constexpr size_t WS_D = 291 * MiB;
static_assert(WS_WDN + 44 * MiB <= WS_D, "weights");
constexpr size_t WS_PROJ = WS_D;
constexpr size_t WS_OD = WS_D + 234 * MiB;
constexpr size_t WS_DS = WS_D + 306 * MiB;
constexpr size_t WS_DEC = WS_D + 450 * MiB;
constexpr size_t WS_H = WS_D + 452 * MiB;
constexpr size_t WS_Y = WS_D;
constexpr size_t WS_HG = WS_D;
constexpr size_t WS_F2 = WS_D;
constexpr size_t WS_U = WS_D + 148 * MiB;
constexpr size_t WS_H2 = WS_D + 483 * MiB;
constexpr size_t WS_END = WS_D + 555 * MiB;
static_assert((size_t)MP * DFF * 2 <= 407 * MiB && (size_t)MP * DM * 2 <= 148 * MiB && (size_t)M * NP * 2 <= 234 * MiB, "dynamic map");
static_assert((size_t)M * DFF * 2 + 148 * MiB <= 483 * MiB, "dense U clear of H2");

constexpr int CW_BAR = 4096;
constexpr int CW_CNT = 8192;

constexpr int RING_BYTES = 131072;
constexpr int TEXP_OFF = 139264;
constexpr int MISC_OFF = 146432 - 512;
constexpr int LDS_BYTES = 147456;

typedef unsigned u32x2 __attribute__((ext_vector_type(2)));

__device__ __forceinline__ float bf2f(unsigned short x) { return __uint_as_float((unsigned)x << 16); }
__device__ __forceinline__ float bflo(unsigned w) { return __uint_as_float(w << 16); }
__device__ __forceinline__ float bfhi(unsigned w) { return __uint_as_float(w & 0xffff0000u); }
__device__ __forceinline__ float siluf(float x) { return x * __builtin_amdgcn_rcpf(1.f + __expf(-x)); }
__device__ __forceinline__ float clamp8(float x) { return fminf(fmaxf(x, -448.f), 448.f); }
__device__ __forceinline__ unsigned pk4_f8(float a, float b, float c, float d) { unsigned w = 0u; w = __builtin_amdgcn_cvt_pk_fp8_f32(clamp8(a), clamp8(b), w, false); w = __builtin_amdgcn_cvt_pk_fp8_f32(clamp8(c), clamp8(d), w, true); return w; }
template <int MASK> __device__ __forceinline__ float xadd(float v) {
    if constexpr (MASK == 32) { const auto rr = __builtin_amdgcn_permlane32_swap(__float_as_uint(v), __float_as_uint(v), false, false); return __uint_as_float(rr[0]) + __uint_as_float(rr[1]); }
    else return v + __int_as_float(__builtin_amdgcn_ds_swizzle(__float_as_int(v), 0x1f | (MASK << 10)));
}
__device__ __forceinline__ float wave_sum(float v) {
    v = xadd<1>(v); v = xadd<2>(v); v = xadd<4>(v); v = xadd<8>(v); v = xadd<16>(v); v = xadd<32>(v);
    return v;
}

struct Args { const float* in[24]; float* out; unsigned char* ws; };
struct Frame {
    LAS unsigned char* lds;
    volatile LAS unsigned* MISC;
    int tid, lane, wave, G, blk, gw, NGW, z, wv;
    const Args* A;
    unsigned char* ws;
};


__device__ __forceinline__ void refresh(Frame& F) {
    int wv = F.wv; asm volatile("" : "+s"(wv));
    const int t = wv * 64 + pg8::lane_id_opaque();
    int bl = blockIdx.x, z = 0, gg = gridDim.x; asm volatile("" : "+s"(bl), "+s"(z), "+s"(gg));
    F.blk = bl; F.z = z; F.G = gg; F.NGW = gg * NWAVES;
    F.tid = t; F.lane = t & 63; F.wave = wv; F.gw = F.blk * NWAVES + F.wave;
}
#define INP(k) (F.A->in[(k) + F.z])
namespace pg8 {
struct EpiProj {
    static constexpr bool PERM = true, AFTER_DRAIN = false;
    bf16_t* P; const float* ropec; const float* ropes; unsigned* kmx;
    __device__ __forceinline__ void operator()(const f32x4 (&acc)[2][2][4][2], const Unit& u, int wr, int wc, int fr, int fq) const {
        const int pn = u.pn, pm = u.pm, tb = pm % 9;
        float kss[2] = {0.f, 0.f};
        const bool do_rope = (tb != 0) && (pn < 4);
        const float sc = (pn < 2) ? C2 : (pn == 6 ? 0.125f : 1.f);
        const bool st_ok_all = pn < 12;
#pragma unroll
        for (int ai = 0; ai < 2; ++ai)
#pragma unroll
            for (int m = 0; m < 4; ++m) {
                const int rit = ai * HALF + wr * 64 + m * 16 + fr;
                bf16_t* rowp = P + ((size_t)pm * BM + rit) * NP + pn * BM + wc * 32 + 8 * fq;
                const int s = (tb - 1) * 256 + rit;
                const int pos = (wc & 1) ? (s & 63) : (s >> 6);
                f32x4 cs = {1.f, 1.f, 1.f, 1.f}, sn = {0.f, 0.f, 0.f, 0.f};
                if (do_rope) { cs = *(const f32x4*)(ropec + pos * 16 + 4 * fq); sn = *(const f32x4*)(ropes + pos * 16 + 4 * fq); }
#pragma unroll
                for (int bj = 0; bj < 2; ++bj) {
                    f32x4 v0 = acc[ai][bj][m][0], v1 = acc[ai][bj][m][1];
                    if (do_rope) { const f32x4 a = v0 * cs - v1 * sn, b = v0 * sn + v1 * cs; v0 = a; v1 = b; }
                    v0 = v0 * sc; v1 = v1 * sc;
                    if (pn == 2 || pn == 3) { float ss = (v0[0] * v0[0] + v0[1] * v0[1]) + (v0[2] * v0[2] + v0[3] * v0[3]) + (v1[0] * v1[0] + v1[1] * v1[1]) + (v1[2] * v1[2] + v1[3] * v1[3]);
                        ss = xadd<16>(ss); ss = xadd<32>(ss); kss[bj] = fmaxf(kss[bj], ss); }
                    if (st_ok_all || (bj == 0 && wc == 0)) {
                        u32x4 w; w.x = cvt_pk_bf16(v0[0], v0[1]); w.y = cvt_pk_bf16(v0[2], v0[3]); w.z = cvt_pk_bf16(v1[0], v1[1]); w.w = cvt_pk_bf16(v1[2], v1[3]);
                        *(u32x4*)(rowp + bj * HALF) = w;
                    }
                }
            }
        if (pn == 2 || pn == 3) {
#pragma unroll
            for (int bj = 0; bj < 2; ++bj) { float v = kss[bj];
                v = fmaxf(v, __int_as_float(__builtin_amdgcn_update_dpp(0, __float_as_int(v), 0xB1, 0xF, 0xF, true)));
                v = fmaxf(v, __int_as_float(__builtin_amdgcn_update_dpp(0, __float_as_int(v), 0x4E, 0xF, 0xF, true)));
                v = fmaxf(v, __int_as_float(__builtin_amdgcn_update_dpp(0, __float_as_int(v), 0x141, 0xF, 0xF, true)));
                v = fmaxf(v, __int_as_float(__builtin_amdgcn_update_dpp(0, __float_as_int(v), 0x140, 0xF, 0xF, true)));
                if (fr == 0 && fq == 0) { const int hh = (pn - 2) * 4 + bj * 2 + (wc >> 1);
                    __hip_atomic_fetch_max(kmx + (((pm / 9) * 8 + hh) * 2 + (wc & 1)), __float_as_uint(v), __ATOMIC_RELAXED, __HIP_MEMORY_SCOPE_AGENT); } }
        }
    }
};
struct EpiF32 {
    static constexpr bool PERM = true, AFTER_DRAIN = false;
    bf16_t* Y;
    __device__ __forceinline__ void operator()(const f32x4 (&acc)[2][2][4][2], const Unit& u, int wr, int wc, int fr, int fq) const {
#pragma unroll
        for (int ai = 0; ai < 2; ++ai)
#pragma unroll
            for (int m = 0; m < 4; ++m) {
                bf16_t* rowp = Y + ((size_t)u.pm * BM + ai * HALF + wr * 64 + m * 16 + fr) * DM + u.pn * BM + wc * 32 + 8 * fq;
#pragma unroll
                for (int bj = 0; bj < 2; ++bj) { const f32x4 v0 = acc[ai][bj][m][0], v1 = acc[ai][bj][m][1];
                    u32x4 w; w.x = cvt_pk_bf16(v0[0], v0[1]); w.y = cvt_pk_bf16(v0[2], v0[3]); w.z = cvt_pk_bf16(v1[0], v1[1]); w.w = cvt_pk_bf16(v1[2], v1[3]);
                    *(u32x4*)(rowp + bj * HALF) = w; }
            }
    }
};
struct EpiSwiglu {
    static constexpr bool PERM = true, AFTER_DRAIN = false;
    bf16_t* U;
    __device__ __forceinline__ void operator()(const f32x4 (&acc)[2][2][4][2], const Unit& u, int wr, int wc, int fr, int fq) const {
        const int pnl = u.pn % 22;
        const int col0 = pnl * 128 + wc * 32 + 8 * fq;
        constexpr float ws = FFN_F8 ? 1.f / W8S : 1.f, us = FFN_F8 ? U8S : 1.f, kS = ws * ws * us, kE = -ws * 1.4426950408889634f;
        const float cE = -__builtin_log2f(kS), c1 = 1.f / kS;
#pragma unroll
        for (int ai = 0; ai < 2; ++ai)
#pragma unroll
            for (int m = 0; m < 4; ++m) {
                const size_t rowi = (size_t)u.pm * BM + ai * HALF + wr * 64 + m * 16 + fr;
                f32x2 g[4], up[4], t[4], r[4];
#pragma unroll
                for (int n = 0; n < 2; ++n) { g[2 * n] = (f32x2){acc[ai][0][m][n][0], acc[ai][0][m][n][1]}; g[2 * n + 1] = (f32x2){acc[ai][0][m][n][2], acc[ai][0][m][n][3]};
                                              up[2 * n] = (f32x2){acc[ai][1][m][n][0], acc[ai][1][m][n][1]}; up[2 * n + 1] = (f32x2){acc[ai][1][m][n][2], acc[ai][1][m][n][3]}; }
#pragma unroll
                for (int q = 0; q < 4; ++q) t[q] = g[q] * kE + cE;
#pragma unroll
                for (int q = 0; q < 4; ++q) { t[q].x = __builtin_amdgcn_exp2f(t[q].x); t[q].y = __builtin_amdgcn_exp2f(t[q].y); }
#pragma unroll
                for (int q = 0; q < 4; ++q) t[q] = t[q] + c1;
#pragma unroll
                for (int q = 0; q < 4; ++q) { r[q].x = __builtin_amdgcn_rcpf(t[q].x); r[q].y = __builtin_amdgcn_rcpf(t[q].y); }
#pragma unroll
                for (int q = 0; q < 4; ++q) g[q] = (g[q] * up[q]) * r[q];
                if constexpr (FFN_F8) { u32x2 w; w.x = pk4_f8(g[0].x, g[0].y, g[1].x, g[1].y); w.y = pk4_f8(g[2].x, g[2].y, g[3].x, g[3].y); *(u32x2*)((unsigned char*)U + rowi * DFF + col0) = w; }
                else { u32x4 w; w.x = cvt_pk_bf16(g[0].x, g[0].y); w.y = cvt_pk_bf16(g[1].x, g[1].y); w.z = cvt_pk_bf16(g[2].x, g[2].y); w.w = cvt_pk_bf16(g[3].x, g[3].y); *(u32x4*)(U + rowi * DFF + col0) = w; }
            }
    }
};
struct EpiDown {
    static constexpr bool PERM = true, AFTER_DRAIN = false;
    bf16_t* F2; const int* rmap; const float* roww; int dense;
    __device__ __forceinline__ void operator()(const f32x4 (&acc)[2][2][4][2], const Unit& u, int wr, int wc, int fr, int fq) const {
        const int pnl = u.pn & 3;
        const int col0 = pnl * BM + wc * 32 + 8 * fq;
        const __amdgpu_buffer_rsrc_t rsF = __builtin_amdgcn_make_buffer_rsrc((void*)F2, 0, 2 * M * DM * 2, 0x00020000);
        const __amdgpu_buffer_rsrc_t rsM = __builtin_amdgcn_make_buffer_rsrc((void*)rmap, 0, MP * 4, 0x00020000);
        const __amdgpu_buffer_rsrc_t rsW = __builtin_amdgcn_make_buffer_rsrc((void*)roww, 0, MP * 4, 0x00020000);
#pragma unroll
        for (int ai = 0; ai < 2; ++ai)
#pragma unroll
            for (int m = 0; m < 4; ++m) {
                const int grow = u.pm * BM + ai * HALF + wr * 64 + m * 16 + fr;
                int tok = grow, slot = 0; float w = 1.f; bool ok = true;
                if (!dense) { const int rm = (int)__builtin_amdgcn_raw_buffer_load_b32(rsM, grow * 4, 0, 0); ok = rm >= 0; tok = rm & 0x3fffffff; slot = (rm >> 30) & 1; w = __uint_as_float(__builtin_amdgcn_raw_buffer_load_b32(rsW, grow * 4, 0, 0)); }
                if constexpr (FFN_F8) w *= 1.f / (W8S * U8S);
                if (ok) {
                    const int bo = ((slot * M + tok) * DM + col0) * 2;
#pragma unroll
                    for (int bj = 0; bj < 2; ++bj) {
                        const f32x4 v0 = acc[ai][bj][m][0] * w, v1 = acc[ai][bj][m][1] * w;
                        u32x4 q; q.x = cvt_pk_bf16(v0[0], v0[1]); q.y = cvt_pk_bf16(v0[2], v0[3]); q.z = cvt_pk_bf16(v1[0], v1[1]); q.w = cvt_pk_bf16(v1[2], v1[3]);
                        __builtin_amdgcn_raw_buffer_store_b128(q, rsF, bo + bj * HALF * 2, 0, 0);
                    }
                }
            }
    }
};
struct GroupedOrder {
    StaticOrder S; const PG8_LAS int* texp; int nN;
    __device__ __forceinline__ bool next(int i, Unit& u) const { if (!S.next(i, u)) return false; u.pn += __builtin_amdgcn_readfirstlane(texp[u.pm]) * nN; return true; }
    __device__ __forceinline__ void a_ready(const Unit&) const {}
    __device__ __forceinline__ void done(const Unit&) const {}
};
struct LatOrder {
    StaticOrder S; int lat;
    __device__ __forceinline__ bool next(int i, Unit& u) const { if (!S.next(i, u)) return false; if (lat) u.pm += (u.pm >> 3) + 1; return true; }
    __device__ __forceinline__ void a_ready(const Unit&) const {}
    __device__ __forceinline__ void done(const Unit&) const {}
};
}

__device__ __forceinline__ void ld_row_f32(const float* row, int lane, f32x4 (&v)[4]) {
#pragma unroll
    for (int j = 0; j < 4; ++j) v[j] = *(const f32x4*)(row + 4 * lane + 256 * j);
}
__device__ __forceinline__ void st_row_f32(float* row, int lane, const f32x4 (&v)[4]) {
#pragma unroll
    for (int j = 0; j < 4; ++j) *(f32x4*)(row + 4 * lane + 256 * j) = v[j];
}
__device__ __forceinline__ void ld_row_bf16(const bf16* row, int lane, f32x4 (&v)[4]) {
#pragma unroll
    for (int j = 0; j < 4; ++j) { const u32x2 w = *(const u32x2*)(row + 4 * lane + 256 * j); v[j] = (f32x4){bflo(w.x), bfhi(w.x), bflo(w.y), bfhi(w.y)}; }
}
__device__ __forceinline__ void st_row_bf16(bf16* row, int lane, const f32x4 (&v)[4]) {
#pragma unroll
    for (int j = 0; j < 4; ++j) { u32x2 w; w.x = pg8::cvt_pk_bf16(v[j][0], v[j][1]); w.y = pg8::cvt_pk_bf16(v[j][2], v[j][3]); *(u32x2*)(row + 4 * lane + 256 * j) = w; }
}
__device__ __forceinline__ float row_rinv(const f32x4 (&v)[4]) {
    float s = 0.f;
#pragma unroll
    for (int j = 0; j < 4; ++j) s += (v[j][0] * v[j][0] + v[j][1] * v[j][1]) + (v[j][2] * v[j][2] + v[j][3] * v[j][3]);
    return 1.0f / sqrtf(wave_sum(s) * (1.f / DM) + EPS);
}

__device__ __forceinline__ void transpose_tile(const float* W, int N, int k0, int n0, bf16* WT, int K, int drow0, LAS float* scr, int lane, bool ropeperm = false) {
#pragma unroll 8
    for (int i = 0; i < 32; ++i) { const int kk = 2 * i + (lane >> 5); scr[kk * 33 + (lane & 31)] = __builtin_nontemporal_load(&W[(size_t)(k0 + kk) * N + n0 + (lane & 31)]); }
    LDS_WAIT(); asm volatile("" ::: "memory");
    const int c = lane & 7;
#pragma unroll
    for (int j = 0; j < 4; ++j) { const int n = (lane >> 3) + 8 * j; const LAS float* s = scr + (8 * c) * 33 + n;
        v4u o; o.x = pk2(s[0 * 33], s[1 * 33]); o.y = pk2(s[2 * 33], s[3 * 33]); o.z = pk2(s[4 * 33], s[5 * 33]); o.w = pk2(s[6 * 33], s[7 * 33]);
        const int nd = ropeperm ? (8 * ((n >> 2) & 3) + 4 * (n >> 4) + (n & 3)) : n;
        *(GAS v4u*)(WT + (size_t)(drow0 + nd) * K + k0 + 8 * c) = o; }
    LDS_WAIT(); asm volatile("" ::: "memory");
}
__device__ __forceinline__ void transpose_tile_f8(const float* W, int N, int k0, int n0, unsigned char* WT, int Kb, int drow0, LAS float* scr, int lane, float scale) {
#pragma unroll 8
    for (int i = 0; i < 32; ++i) { const int kk = 2 * i + (lane >> 5); scr[kk * 33 + (lane & 31)] = __builtin_nontemporal_load(&W[(size_t)(k0 + kk) * N + n0 + (lane & 31)]); }
    LDS_WAIT(); asm volatile("" ::: "memory");
    const int n = lane >> 1, hf = lane & 1; const LAS float* s = scr + (hf * 32) * 33 + n;
    v4u o0, o1;
    o0.x = pk4_f8(s[0 * 33] * scale, s[1 * 33] * scale, s[2 * 33] * scale, s[3 * 33] * scale);     o0.y = pk4_f8(s[4 * 33] * scale, s[5 * 33] * scale, s[6 * 33] * scale, s[7 * 33] * scale);
    o0.z = pk4_f8(s[8 * 33] * scale, s[9 * 33] * scale, s[10 * 33] * scale, s[11 * 33] * scale);   o0.w = pk4_f8(s[12 * 33] * scale, s[13 * 33] * scale, s[14 * 33] * scale, s[15 * 33] * scale);
    o1.x = pk4_f8(s[16 * 33] * scale, s[17 * 33] * scale, s[18 * 33] * scale, s[19 * 33] * scale); o1.y = pk4_f8(s[20 * 33] * scale, s[21 * 33] * scale, s[22 * 33] * scale, s[23 * 33] * scale);
    o1.z = pk4_f8(s[24 * 33] * scale, s[25 * 33] * scale, s[26 * 33] * scale, s[27 * 33] * scale); o1.w = pk4_f8(s[28 * 33] * scale, s[29 * 33] * scale, s[30 * 33] * scale, s[31 * 33] * scale);
    GAS v4u* dst = (GAS v4u*)(WT + (size_t)(drow0 + n) * Kb + k0 + hf * 32);
    dst[0] = o0; dst[1] = o1;
    LDS_WAIT(); asm volatile("" ::: "memory");
}
__device__ __forceinline__ void convert_weights(Frame& F, int l) {
    refresh(F);
    const bool moe = l & 1; const int ne = moe ? NE : 1, li = l >> 1;
    const float* w1 = moe ? INP(21) + (size_t)li * NE * DM * DFF : INP(17) + (size_t)li * DM * DFF;
    const float* w3 = moe ? INP(22) + (size_t)li * NE * DM * DFF : INP(18) + (size_t)li * DM * DFF;
    const float* w2 = moe ? INP(23) + (size_t)li * NE * DM * DFF : INP(19) + (size_t)li * DM * DFF;
    const float* win = INP(10) + (size_t)l * DM * NIN;
    const float* wout = INP(16) + (size_t)l * DM * DM;
    bf16* WIN = (bf16*)(F.ws + WS_WIN); bf16* WOUT = (bf16*)(F.ws + WS_WOUT); bf16* WUP = (bf16*)(F.ws + WS_WUP); bf16* WDN = (bf16*)(F.ws + WS_WDN);
    LAS float* scr = (LAS float*)(F.lds + F.wave * 16384);
    const int nA = 16 * 97, nZ = NP - NIN, nB = 16 * 32, nC1 = 16 * 88, nD1 = 44 * 32;
    const int nC = ne * 2 * nC1, nD = ne * nD1, total = nA + nZ + nB + nC + nD;
    for (int it = F.gw; it < total; it += F.NGW) {
        int r = it;
        if (r < nA) { const int kb = r / 97, nb = r % 97; transpose_tile(win, NIN, 64 * kb, 32 * nb, WIN, DM, 32 * nb, scr, F.lane, nb < 32  ); continue; } r -= nA;
        if (r < nZ) { const unsigned zz = (unsigned)F.z; v4u z = {zz, zz, zz, zz}; GAS v4u* p = (GAS v4u*)(WIN + (size_t)(NIN + r) * DM) + F.lane * 2; p[0] = z; p[1] = z; continue; } r -= nZ;
        if (r < nB) { const int kb = r / 32, nb = r % 32; transpose_tile(wout, DM, 64 * kb, 32 * nb, WOUT, DM, 32 * nb, scr, F.lane); continue; } r -= nB;
        if (r < nC) { const int e = r / (2 * nC1), q = r % (2 * nC1), which = q / nC1, t = q % nC1, kb = t / 88, nb = t % 88, n0 = 32 * nb;
            const float* src = (which ? w3 : w1) + (size_t)e * DM * DFF;
            if constexpr (FFN_F8) transpose_tile_f8(src, DFF, 64 * kb, n0, (unsigned char*)WUP, DM, e * 5632 + (n0 / 128) * 256 + (n0 % 128) + which * 128, scr, F.lane, W8S);
            else transpose_tile(src, DFF, 64 * kb, n0, WUP, DM, e * 5632 + (n0 / 128) * 256 + (n0 % 128) + which * 128, scr, F.lane); continue; } r -= nC;
        { const int e = r / nD1, t = r % nD1, kb = t / 32, nb = t % 32;
            if constexpr (FFN_F8) transpose_tile_f8(w2 + (size_t)e * DFF * DM, DM, 64 * kb, 32 * nb, (unsigned char*)WDN + (size_t)e * DM * DFF, DFF, 32 * nb, scr, F.lane, W8S);
            else transpose_tile(w2 + (size_t)e * DFF * DM, DM, 64 * kb, 32 * nb, WDN + (size_t)e * DM * DFF, DFF, 32 * nb, scr, F.lane); }
    }
}

__device__ __forceinline__ void p0_mod(Frame& F) {
    refresh(F);
    LAS float* S = (LAS float*)(F.lds);
    LAS float* R = (LAS float*)(F.lds + 69632);
    const float* c = INP(1); const float* cc = INP(3); const float* wmod = INP(4); const float* bmod = INP(5);
    float* MOD = (float*)(F.ws + WS_MOD);
    for (int i = F.tid; i < 17 * 1024; i += 512) { const int b = i >> 10, k = i & 1023; const float v = b < 16 ? c[b * 1024 + k] : cc[k]; S[i] = siluf(v); }
    __syncthreads();
    const int kq = F.lane >> 4, c4 = (F.lane & 15) * 4;
    for (int item = F.blk; item < 4 * 96; item += F.G) {
        const int l = item / 96, col0 = (item % 96) * 64;
        const float* W = wmod + (size_t)l * DM * 6144;
        float acc[17][4];
#pragma unroll
        for (int b = 0; b < 17; ++b)
#pragma unroll
            for (int j = 0; j < 4; ++j) acc[b][j] = 0.f;
        for (int it = 0; it < 32; ++it) {
            const int k = F.wave * 128 + it * 4 + kq;
            const f32x4 w = *(const f32x4*)(W + (size_t)k * 6144 + col0 + c4);
#pragma unroll
            for (int b = 0; b < 17; ++b) { const float s = S[b * 1024 + k];
#pragma unroll
                for (int j = 0; j < 4; ++j) acc[b][j] += s * w[j]; }
        }
#pragma unroll
        for (int b = 0; b < 17; ++b)
#pragma unroll
            for (int j = 0; j < 4; ++j) { float v = acc[b][j]; v = xadd<16>(v); v = xadd<32>(v); acc[b][j] = v; }
        if (kq == 0) {
#pragma unroll
            for (int b = 0; b < 17; ++b)
#pragma unroll
                for (int j = 0; j < 4; ++j) R[(F.wave * 17 + b) * 64 + c4 + j] = acc[b][j];
        }
        __syncthreads();
        for (int o = F.tid; o < 17 * 64; o += 512) { const int b = o >> 6, ccx = o & 63; float s = bmod[l * 6144 + col0 + ccx];
            for (int w = 0; w < 8; ++w) s += R[(w * 17 + b) * 64 + ccx];
            MOD[((size_t)l * 17 + b) * 6144 + col0 + ccx] = s; }
        __syncthreads();
    }
}
__device__ __forceinline__ float lam_init_of(int l) { return 0.8f - 0.6f * expf(-0.3f * (float)l); }
__device__ __forceinline__ void p0_misc(Frame& F) {
    refresh(F);
    float* ropec = (float*)(F.ws + WS_ROPE); float* ropes = ropec + 1024; float* lam = (float*)(F.ws + WS_ROPE + 16384);
    if (F.blk == 0) {
        for (int i = F.tid; i < 1024; i += 512) { const int pos = i >> 4, f = i & 15; const float inv = powf(10000.f, -(float)f / 16.f); const float ang = (float)pos * inv; ropec[i] = cosf(ang); ropes[i] = sinf(ang); }
    }
    if (F.blk == (1 % F.G) && F.wave < 4) {
        const int l = F.wave; const float* lv = INP(13) + l * 256;
        const float a = wave_sum(lv[F.lane] * lv[64 + F.lane]), b = wave_sum(lv[128 + F.lane] * lv[192 + F.lane]);
        if (F.lane == 0) lam[l] = expf(a) - expf(b) + lam_init_of(l);
    }
}

namespace att {
using bf16x8 = __attribute__((ext_vector_type(8))) short;
using s16x4  = __attribute__((ext_vector_type(4))) short;
using f32x16 = __attribute__((ext_vector_type(16))) float;
using u32x4  = __attribute__((ext_vector_type(4))) unsigned;
constexpr int QBLK = 32, KVBLK = 64, NW = 8, DV = 128;
constexpr float THR = 8.f;
constexpr size_t SHM_V = KVBLK * DV * 2, SHM_K = KVBLK * 64 * 2, SHM_ATTN = 2 * SHM_V + 2 * SHM_K + NW * 64 * 4;
#define KSWZ64(row, colB) ((row) * 128 + ((colB) ^ ((((row) >> 1) & 7) << 4)))
#define SBAR() __builtin_amdgcn_sched_barrier(0)
__device__ __forceinline__ int crow(int r, int hi) { return (r & 3) + 8 * (r >> 2) + 4 * hi; }
__device__ __forceinline__ unsigned cvtpk(float lo, float hi) { unsigned r; asm volatile("v_cvt_pk_bf16_f32 %0, %1, %2" : "=v"(r) : "v"(lo), "v"(hi)); return r; }
__device__ __forceinline__ void partialSM(f32x16& p0, f32x16& p1, float& m_reg, float& mn, float& alpha) {
  float pmax = p0[0];
#pragma unroll
  for (int r = 1; r < 16; ++r) pmax = fmaxf(pmax, p0[r]);
#pragma unroll
  for (int r = 0; r < 16; ++r) pmax = fmaxf(pmax, p1[r]);
  { auto rr = __builtin_amdgcn_permlane32_swap(__float_as_uint(pmax), __float_as_uint(pmax), false, false);
    pmax = fmaxf(__uint_as_float(rr[0]), __uint_as_float(rr[1])); }
  if (__builtin_expect(__all(pmax - m_reg <= THR), 1)) { mn = m_reg; alpha = 1.f; }
  else { mn = fmaxf(m_reg, pmax); alpha = __builtin_amdgcn_exp2f(m_reg - mn); m_reg = mn; }
#pragma unroll
  for (int r = 0; r < 16; ++r) p0[r] = p0[r] - mn;
#pragma unroll
  for (int r = 0; r < 16; ++r) p1[r] = p1[r] - mn;
#pragma unroll
  for (int r = 0; r < 16; ++r) p0[r] = __builtin_amdgcn_exp2f(p0[r]);
}
__device__ __forceinline__ void finishSM(f32x16& p0, f32x16& p1, float alpha, float& l_reg, bf16x8& pa0, bf16x8& pa1, bf16x8& pa2, bf16x8& pa3) {
#pragma unroll
  for (int r = 0; r < 16; ++r) p1[r] = __builtin_amdgcn_exp2f(p1[r]);
  float ps = 0;
#pragma unroll
  for (int r = 0; r < 16; ++r) ps += p0[r];
#pragma unroll
  for (int r = 0; r < 16; ++r) ps += p1[r];
  { auto rr = __builtin_amdgcn_permlane32_swap(__float_as_uint(ps), __float_as_uint(ps), false, false);
    ps = __uint_as_float(rr[0]) + __uint_as_float(rr[1]); }
  l_reg = l_reg * alpha + ps;
#define PK4(P, BASE, OUT) do { unsigned a0 = cvtpk(P[BASE + 0], P[BASE + 1]), a1 = cvtpk(P[BASE + 2], P[BASE + 3]);   \
    unsigned b0 = cvtpk(P[BASE + 4], P[BASE + 5]), b1 = cvtpk(P[BASE + 6], P[BASE + 7]);                              \
    auto r0 = __builtin_amdgcn_permlane32_swap(a0, b0, false, false); auto r1 = __builtin_amdgcn_permlane32_swap(a1, b1, false, false); \
    u32x4 w = {r0[0], r1[0], r0[1], r1[1]}; OUT = *reinterpret_cast<bf16x8*>(&w); } while (0)
  PK4(p0, 0, pa0); PK4(p0, 8, pa1); PK4(p1, 0, pa2); PK4(p1, 8, pa3);
#undef PK4
}
__device__ __forceinline__ void pack_p(const f32x16& p0, const f32x16& p1, bf16x8& pa0, bf16x8& pa1, bf16x8& pa2, bf16x8& pa3) {
#define PK4(P, BASE, OUT) do { unsigned a0 = cvtpk(P[BASE + 0], P[BASE + 1]), a1 = cvtpk(P[BASE + 2], P[BASE + 3]);   \
    unsigned b0 = cvtpk(P[BASE + 4], P[BASE + 5]), b1 = cvtpk(P[BASE + 6], P[BASE + 7]);                              \
    auto r0 = __builtin_amdgcn_permlane32_swap(a0, b0, false, false); auto r1 = __builtin_amdgcn_permlane32_swap(a1, b1, false, false); \
    u32x4 w = {r0[0], r1[0], r0[1], r1[1]}; OUT = *reinterpret_cast<bf16x8*>(&w); } while (0)
  PK4(p0, 0, pa0); PK4(p0, 8, pa1); PK4(p1, 0, pa2); PK4(p1, 8, pa3);
#undef PK4
}
__device__ __forceinline__ void qkt(f32x16& p0, f32x16& p1, const bf16* Ks, const bf16x8* qr, int r32, int hi) {
  p0 = f32x16{}; p1 = f32x16{};
#pragma unroll
  for (int d0 = 0; d0 < 4; ++d0) { int cb = (d0 * 16 + hi * 8) * 2;
    bf16x8 b0 = *reinterpret_cast<const bf16x8*>((const char*)Ks + KSWZ64(r32, cb));
    bf16x8 b1 = *reinterpret_cast<const bf16x8*>((const char*)Ks + KSWZ64(32 + r32, cb));
    p0 = __builtin_amdgcn_mfma_f32_32x32x16_bf16(b0, qr[d0], p0, 0, 0, 0);
    p1 = __builtin_amdgcn_mfma_f32_32x32x16_bf16(b1, qr[d0], p1, 0, 0, 0); }
}
__device__ __forceinline__ int v_st(int k, int c) { const int kk = (k & ~0xC) | ((k & 4) << 1) | ((k & 8) >> 1); return ((kk >> 3) * 4 + (c >> 5)) * 512 + ((kk & 7) * 32 + (c & 31)) * 2; }
__device__ __forceinline__ int v_rd_base(int lane) { return ((lane & 3) << 3) | (((lane >> 2) & 3) << 6) | (((lane >> 4) & 1) << 5) | (((lane >> 5) & 1) << 8); }
constexpr int v_rd_off(int d0, int ks, int half) { return d0 * 512 + ks * 4096 + half * 2048; }
template <int OFF> __device__ __forceinline__ s16x4 tr_read(int vb) {
  s16x4 r; asm volatile("ds_read_b64_tr_b16 %0, %1 offset:%2" : "=&v"(r) : "v"(vb), "i"(OFF) : "memory"); return r;
}
template <int D0> __device__ __forceinline__ void pv_one(f32x16& od, int vb, bf16x8 pa0, bf16x8 pa1, bf16x8 pa2, bf16x8 pa3) {
  const s16x4 l0 = tr_read<v_rd_off(D0, 0, 0)>(vb), h0 = tr_read<v_rd_off(D0, 0, 1)>(vb), l1 = tr_read<v_rd_off(D0, 1, 0)>(vb), h1 = tr_read<v_rd_off(D0, 1, 1)>(vb);
  const s16x4 l2 = tr_read<v_rd_off(D0, 2, 0)>(vb), h2 = tr_read<v_rd_off(D0, 2, 1)>(vb), l3 = tr_read<v_rd_off(D0, 3, 0)>(vb), h3 = tr_read<v_rd_off(D0, 3, 1)>(vb);
  asm volatile("s_waitcnt lgkmcnt(0)" ::: "memory"); SBAR();
#define PK(L, H) (bf16x8){L[0], L[1], L[2], L[3], H[0], H[1], H[2], H[3]}
  od = __builtin_amdgcn_mfma_f32_32x32x16_bf16(pa0, PK(l0, h0), od, 0, 0, 0);
  od = __builtin_amdgcn_mfma_f32_32x32x16_bf16(pa1, PK(l1, h1), od, 0, 0, 0);
  od = __builtin_amdgcn_mfma_f32_32x32x16_bf16(pa2, PK(l2, h2), od, 0, 0, 0);
  od = __builtin_amdgcn_mfma_f32_32x32x16_bf16(pa3, PK(l3, h3), od, 0, 0, 0);
#undef PK
}
__device__ __forceinline__ void pv_d0(f32x16* o, int vb, bf16x8 pa0, bf16x8 pa1, bf16x8 pa2, bf16x8 pa3) {
  pv_one<0>(o[0], vb, pa0, pa1, pa2, pa3); pv_one<1>(o[1], vb, pa0, pa1, pa2, pa3); pv_one<2>(o[2], vb, pa0, pa1, pa2, pa3); pv_one<3>(o[3], vb, pa0, pa1, pa2, pa3);
}
constexpr int LDQ = NP, LDK = NP, LDO = DM;
__device__ __forceinline__ void sm_first(f32x16& p0, f32x16& p1, float m) {
#pragma unroll
  for (int r = 0; r < 16; ++r) p0[r] = p0[r] - m;
#pragma unroll
  for (int r = 0; r < 16; ++r) p1[r] = p1[r] - m;
#pragma unroll
  for (int r = 0; r < 16; ++r) p0[r] = __builtin_amdgcn_exp2f(p0[r]);
}
__device__ __forceinline__ void sm_second(f32x16& p0, f32x16& p1, float& l_reg, bf16x8& pa0, bf16x8& pa1, bf16x8& pa2, bf16x8& pa3) {
#pragma unroll
  for (int r = 0; r < 16; ++r) p1[r] = __builtin_amdgcn_exp2f(p1[r]);
  float ps = 0;
#pragma unroll
  for (int r = 0; r < 16; ++r) ps += p0[r];
#pragma unroll
  for (int r = 0; r < 16; ++r) ps += p1[r];
  { auto rr = __builtin_amdgcn_permlane32_swap(__float_as_uint(ps), __float_as_uint(ps), false, false);
    ps = __uint_as_float(rr[0]) + __uint_as_float(rr[1]); }
  l_reg += ps;
  pack_p(p0, p1, pa0, pa1, pa2, pa3);
}
__device__ __forceinline__ void attn_unit(const bf16* __restrict__ Qb, const bf16* __restrict__ Kh, const bf16* __restrict__ Vh, bf16* __restrict__ Ob, int seq, char* lds, int tid, float kmax) {
  const int wid = tid >> 6, lane = tid & 63, r32 = lane & 31, hi = lane >> 5;
  bf16* V_lds = (bf16*)lds; bf16* K_lds = (bf16*)(lds + 2 * SHM_V);
  float* ws = (float*)(lds + 2 * SHM_V + 2 * SHM_K) + wid * 64; float* li_l = ws; float* al_l = ws + 32;
  float m_reg = -1e30f, l_reg = 0; f32x16 o[4] = {}; bf16x8 qr[4];
  const bf16* Qw = Qb + (long)(wid * QBLK + r32) * LDQ + hi * 8;
#pragma unroll
  for (int d0 = 0; d0 < 4; ++d0) qr[d0] = *(const __attribute__((address_space(1))) bf16x8*)(Qw + d0 * 16);
  { float qs = 0.f;
#pragma unroll
    for (int d0 = 0; d0 < 4; ++d0)
#pragma unroll
      for (int e = 0; e < 8; ++e) { const float qv = __uint_as_float((unsigned)(unsigned short)qr[d0][e] << 16); qs += qv * qv; }
    auto rr = __builtin_amdgcn_permlane32_swap(__float_as_uint(qs), __float_as_uint(qs), false, false);
    qs = __uint_as_float(rr[0]) + __uint_as_float(rr[1]);
    m_reg = sqrtf(qs) * kmax * 1.002f + 1e-3f; }
  const int sr = tid >> 4, sc = (tid & 15) * 8, vst0 = v_st(sr, sc), vst1 = v_st(32 + sr, sc);
  const int kr = tid >> 3, kc = (tid & 7) * 8, kst = KSWZ64(kr, kc * 2);
  const int vb0 = (int)(uintptr_t)V_lds + v_rd_base(lane);
  struct { bf16x8 vs0, vs1, ks0; } sr_[2];
#define GLD8(p) (*(const __attribute__((address_space(1))) bf16x8*)(p))
#define SLOAD(i, k0) do { sr_[i].vs0 = GLD8(&Vh[(long)((k0) + sr) * LDK + sc]); sr_[i].vs1 = GLD8(&Vh[(long)((k0) + 32 + sr) * LDK + sc]); \
    sr_[i].ks0 = GLD8(&Kh[(long)((k0) + kr) * LDK + kc]); } while (0)
#define SWRITE(b, i) do { *(bf16x8*)((char*)V_lds + (b) * SHM_V + vst0) = sr_[i].vs0; *(bf16x8*)((char*)V_lds + (b) * SHM_V + vst1) = sr_[i].vs1; \
    *(bf16x8*)((char*)K_lds + (b) * SHM_K + kst) = sr_[i].ks0; } while (0)
#define SWAIT() asm volatile("s_waitcnt vmcnt(3)" ::: "memory")
#define RESC(a) do { if (__any((a) < 1.f)) { if (hi == 0) al_l[r32] = (a); asm volatile("s_waitcnt lgkmcnt(0)" ::: "memory"); \
    _Pragma("unroll") for (int d = 0; d < 4; ++d) _Pragma("unroll") for (int r = 0; r < 16; ++r) o[d][r] *= al_l[crow(r, hi)]; } } while (0)
  f32x16 pA0, pA1, pB0, pB1; float mnA, mnB, alA, alB; bf16x8 pa0, pa1, pa2, pa3; const int NT = seq / KVBLK;
  if (__builtin_amdgcn_readfirstlane(wid) >= 4) __builtin_amdgcn_s_setprio(1);
  constexpr int SE = 0, SO = 1;
  SLOAD(SE, 0); asm volatile("s_waitcnt vmcnt(0)" ::: "memory"); SWRITE(0, SE); __syncthreads();
  qkt(pA0, pA1, K_lds, qr, r32, hi); sm_first(pA0, pA1, m_reg);
  SLOAD(SO, KVBLK); if (2 < NT) SLOAD(SE, 2 * KVBLK);
  SWAIT(); SWRITE(1, SO); __syncthreads();
  for (int j = 1; j + 1 < NT; j += 2) {
    SBAR(); qkt(pB0, pB1, (bf16*)((char*)K_lds + SHM_K), qr, r32, hi);
    sm_second(pA0, pA1, l_reg, pa0, pa1, pa2, pa3); SBAR();
    SLOAD(SO, (j + 2) * KVBLK); SBAR();
    pv_d0(o, vb0, pa0, pa1, pa2, pa3); sm_first(pB0, pB1, m_reg);
    __syncthreads(); SWAIT(); SWRITE(0, SE);
    __syncthreads();
    SBAR(); qkt(pA0, pA1, K_lds, qr, r32, hi);
    sm_second(pB0, pB1, l_reg, pa0, pa1, pa2, pa3); SBAR();
    if (j + 3 < NT) SLOAD(SE, (j + 3) * KVBLK); SBAR();
    pv_d0(o, vb0 + (int)SHM_V, pa0, pa1, pa2, pa3); sm_first(pA0, pA1, m_reg);
    __syncthreads(); SWAIT(); SWRITE(1, SO);
    __syncthreads();
  }
  SBAR(); qkt(pB0, pB1, (bf16*)((char*)K_lds + SHM_K), qr, r32, hi);
  sm_second(pA0, pA1, l_reg, pa0, pa1, pa2, pa3); SBAR();
  pv_d0(o, vb0, pa0, pa1, pa2, pa3); sm_first(pB0, pB1, m_reg);
  __syncthreads();
  sm_second(pB0, pB1, l_reg, pa0, pa1, pa2, pa3); SBAR();
  pv_d0(o, vb0 + (int)SHM_V, pa0, pa1, pa2, pa3);
  __builtin_amdgcn_s_setprio(0);
  if (hi == 0) li_l[r32] = l_reg; asm volatile("s_waitcnt lgkmcnt(0)" ::: "memory");
  float rli[16];
#pragma unroll
  for (int r = 0; r < 16; ++r) rli[r] = __builtin_amdgcn_rcpf(li_l[crow(r, hi)]);
  bf16* Ow = Ob + (long)(wid * QBLK) * LDO;
#pragma unroll
  for (int r = 0; r < 16; ++r) { const int orow = crow(r, hi);
#pragma unroll
    for (int d0 = 0; d0 < 4; ++d0) Ow[(long)orow * LDO + d0 * 32 + r32] = (bf16)(cvtpk(o[d0][r] * rli[r], 0.f) & 0xffffu); }
#undef SLOAD
#undef GLD8
#undef SWRITE
#undef SWAIT
#undef RESC
}
}

namespace att2 {
using att::bf16x8; using att::s16x4; using att::f32x16; using att::u32x4;
typedef LAS const char* lds_cptr;
typedef short v4i16_t __attribute__((ext_vector_type(4)));
typedef unsigned u32x2 __attribute__((ext_vector_type(2)));
constexpr int KSLOT = 8192, VSLOT = 16384, LDS_K = 0, LDS_V = 4 * KSLOT, KVBLK = 64;
#define A2_PIN(x) asm volatile("" : "+v"(x))
#define A2_MFMA(a, b, c) __builtin_amdgcn_mfma_f32_32x32x16_bf16(a, b, c, 0, 0, 0)
#define A2_WAIT_BAR(N) asm volatile("s_waitcnt vmcnt(" #N ") lgkmcnt(0)\n\ts_barrier" ::: "memory")
__device__ __forceinline__ unsigned cvtpk(float lo, float hi) { unsigned r; asm("v_cvt_pk_bf16_f32 %0, %1, %2" : "=v"(r) : "v"(lo), "v"(hi)); return r; }
__device__ __forceinline__ void glds16s(const char* gbase, unsigned voff, unsigned lds_base) {
    unsigned sv; asm volatile("s_mov_b32 %0, m0\n\ts_mov_b32 m0, %3\n\ts_nop 0\n\tglobal_load_lds_dwordx4 %1, %2\n\ts_mov_b32 m0, %0" : "=&s"(sv) : "v"(voff), "s"(gbase), "s"(lds_base) : "memory"); }
__device__ __forceinline__ const char* uni_ptr(const void* p) { const unsigned long long v = (unsigned long long)p;
    const unsigned lo = __builtin_amdgcn_readfirstlane((unsigned)v), hi = __builtin_amdgcn_readfirstlane((unsigned)(v >> 32)); return (const char*)(((unsigned long long)hi << 32) | lo); }
__device__ __forceinline__ void kload2(bf16x8* kf, lds_cptr kp, int d0) { kf[2 * d0] = *(const LAS bf16x8*)(kp + d0 * 2048); kf[2 * d0 + 1] = *(const LAS bf16x8*)(kp + d0 * 2048 + 512); }
__device__ __forceinline__ s16x4 vtr(lds_cptr p) { return __builtin_bit_cast(s16x4, __builtin_amdgcn_ds_read_tr16_b64_v4i16((LAS v4i16_t*)p)); }
__device__ __forceinline__ void attn_unit2(const bf16* Qb, const bf16* Kh_, const bf16* Vh_, bf16* Ob, const int NT, LAS unsigned char* lds, int tid, float kmax) {
    const int lane = tid & 63, r32 = lane & 31, hi = lane >> 5; const int wid = __builtin_amdgcn_readfirstlane(tid >> 6);
    const char* Kh = uni_ptr(Kh_); const char* Vh = uni_ptr(Vh_);
    constexpr unsigned TSTR = KVBLK * NP * 2;
    const unsigned lds0 = (unsigned)(uintptr_t)lds;
    const unsigned koff = (unsigned)(lane * NP + wid * 8) * 2;
    const unsigned voff0 = (unsigned)((16 * (wid & 3) + (lane >> 2)) * NP + (wid >> 2) * 32 + (lane & 3) * 8) * 2, voff1 = voff0 + 128;
    const unsigned kdst = lds0 + LDS_K + wid * 1024, vdst = lds0 + LDS_V + wid * 1024;
#define DMA_K(t, slotB) glds16s(Kh + (size_t)(t) * TSTR, koff, kdst + (slotB))
#define DMA_V(t, slotB) do { const char* vb_ = Vh + (size_t)(t) * TSTR; glds16s(vb_, voff0, vdst + (slotB)); glds16s(vb_, voff1, vdst + (slotB) + 8192); } while (0)
    const lds_cptr vp0 = (lds_cptr)lds + LDS_V + ((lane >> 4) & 1) * 32 + (lane & 3) * 8 + (4 * hi + ((lane & 15) >> 2)) * 64;
    const lds_cptr kp0 = (lds_cptr)lds + LDS_K + hi * 1024 + r32 * 16;
    DMA_K(0, 0); DMA_V(0, 0); DMA_K(1, KSLOT); DMA_K(2, 2 * KSLOT);
    bf16x8 qr[4];
    const bf16* Qw = Qb + (long)(wid * 32 + r32) * NP + hi * 8;
#pragma unroll
    for (int d0 = 0; d0 < 4; ++d0) qr[d0] = *(const GAS bf16x8*)(Qw + d0 * 16);
    float m_row;
    { float qs = 0.f;
#pragma unroll
      for (int d0 = 0; d0 < 4; ++d0)
#pragma unroll
        for (int e = 0; e < 8; ++e) { const float qv = __uint_as_float((unsigned)(unsigned short)qr[d0][e] << 16); qs += qv * qv; }
      auto rr = __builtin_amdgcn_permlane32_swap(__float_as_uint(qs), __float_as_uint(qs), false, false);
      qs = __uint_as_float(rr[0]) + __uint_as_float(rr[1]);
      m_row = sqrtf(qs) * kmax * 1.002f + 1e-3f; }
    f32x16 negm16;
#pragma unroll
    for (int r = 0; r < 16; ++r) negm16[r] = -m_row;
    A2_PIN(negm16);
    float l_reg = 0.f; f32x16 o[4]; o[0] = f32x16{}; o[1] = f32x16{}; o[2] = f32x16{}; o[3] = f32x16{};
    f32x16 pA0, pA1, pB0, pB1; bf16x8 kf[8]; s16x4 vlo[5], vhi[5]; u32x4 pw[4];
    if (wid >= 4) __builtin_amdgcn_s_setprio(1);
    A2_WAIT_BAR(0);
#pragma unroll
    for (int d0 = 0; d0 < 4; ++d0) kload2(kf, kp0, d0);
    pA0 = A2_MFMA(kf[0], qr[0], negm16); pA1 = A2_MFMA(kf[1], qr[0], negm16); pA0 = A2_MFMA(kf[2], qr[1], pA0); pA1 = A2_MFMA(kf[3], qr[1], pA1);
    pA0 = A2_MFMA(kf[4], qr[2], pA0); pA1 = A2_MFMA(kf[5], qr[2], pA1); pA0 = A2_MFMA(kf[6], qr[3], pA0); pA1 = A2_MFMA(kf[7], qr[3], pA1);
#pragma unroll
    for (int r = 0; r < 16; ++r) { pA0[r] = __builtin_amdgcn_exp2f(pA0[r]); pA1[r] = __builtin_amdgcn_exp2f(pA1[r]); }
    DMA_K(3, 3 * KSLOT); DMA_V(1, VSLOT);
    kload2(kf, kp0 + KSLOT, 0); kload2(kf, kp0 + KSLOT, 1);
    A2_WAIT_BAR(3);
    int kc = KSLOT, vp = 0;
#define PKW(P, i) cvtpk(P[i], P[(i) + 1])
#define VFR(s) (bf16x8){vlo[s][0], vlo[s][1], vlo[s][2], vlo[s][3], vhi[s][0], vhi[s][1], vhi[s][2], vhi[s][3]}
#define VRD(s, i) do { vlo[s] = vtr(vq_ + (((i) & 3) * 4096 + ((i) >> 2) * 1024)); vhi[s] = vtr(vq_ + (((i) & 3) * 4096 + ((i) >> 2) * 1024 + 512)); } while (0)
#define GAPA(MF, a0, a1, a2, a3, W0, W1, PW) do { MF; W0; W1; A2_PIN(PW); SBAR(); } while (0)
#define GAPB(i, X, j, Y) do { if ((i) + 4 < 16) VRD(((i) + 4) % 5, (i) + 4); if ((i) == 9) kload2(kf, kn_, 0); if ((i) == 10) kload2(kf, kn_, 1); SBAR(); \
    o[(i) & 3] = A2_MFMA(VFR((i) % 5), __builtin_bit_cast(bf16x8, pw[(i) >> 2]), o[(i) & 3]); X[j] = __builtin_amdgcn_exp2f(X[j]); X[(j) + 1] = __builtin_amdgcn_exp2f(X[(j) + 1]); l_reg += Y[j]; l_reg += Y[(j) + 1]; A2_PIN(X); A2_PIN(l_reg); SBAR(); } while (0)
#define A2_STEP(C0, C1, P0, P1, t) do { SBAR(); \
    const lds_cptr kq_ = kp0 + kc, vq_ = vp0 + vp, kn_ = kp0 + ((kc + KSLOT) & (4 * KSLOT - 1)); \
    const int tk_ = min((t) + 3, NT - 1), tv_ = min((t) + 1, NT - 1); const int kprev_ = (kc - KSLOT) & (4 * KSLOT - 1); int vnew_ = vp + 2 * VSLOT; if (vnew_ >= 3 * VSLOT) vnew_ -= 3 * VSLOT; \
    kload2(kf, kq_, 2); SBAR(); \
    GAPA(C0 = A2_MFMA(kf[0], qr[0], negm16), P0[2], P0[3], P0[4], P0[5],     pw[0][0] = PKW(P0, 0),  pw[0][1] = PKW(P0, 2),  pw[0]); \
    kload2(kf, kq_, 3); SBAR(); \
    GAPA(C1 = A2_MFMA(kf[1], qr[0], negm16), P0[6], P0[7], P0[8], P0[9],     pw[0][2] = PKW(P0, 4),  pw[0][3] = PKW(P0, 6),  pw[0]); \
    VRD(0, 0); SBAR(); GAPA(C0 = A2_MFMA(kf[2], qr[1], C0), P0[10], P0[11], P0[12], P0[13], pw[1][0] = PKW(P0, 8),  pw[1][1] = PKW(P0, 10), pw[1]); \
    VRD(1, 1); SBAR(); GAPA(C1 = A2_MFMA(kf[3], qr[1], C1), P0[14], P0[15], P1[0], P1[1],   pw[1][2] = PKW(P0, 12), pw[1][3] = PKW(P0, 14), pw[1]); \
    VRD(2, 2); SBAR(); GAPA(C0 = A2_MFMA(kf[4], qr[2], C0), P1[2], P1[3], P1[4], P1[5],     pw[2][0] = PKW(P1, 0),  pw[2][1] = PKW(P1, 2),  pw[2]); \
    VRD(3, 3); SBAR(); GAPA(C1 = A2_MFMA(kf[5], qr[2], C1), P1[6], P1[7], P1[8], P1[9],     pw[2][2] = PKW(P1, 4),  pw[2][3] = PKW(P1, 6),  pw[2]); \
                       GAPA(C0 = A2_MFMA(kf[6], qr[3], C0), P1[10], P1[11], P1[12], P1[13], pw[3][0] = PKW(P1, 8),  pw[3][1] = PKW(P1, 10), pw[3]); \
                       GAPA(C1 = A2_MFMA(kf[7], qr[3], C1), P1[14], P1[15], 0.f, 0.f,       pw[3][2] = PKW(P1, 12), pw[3][3] = PKW(P1, 14), pw[3]); \
    DMA_K(tk_, kprev_); DMA_V(tv_, vnew_); SBAR();                                                                   \
    GAPB(0, C0, 0, P0);  GAPB(1, C0, 2, P0);  GAPB(2, C0, 4, P0);   GAPB(3, C0, 6, P0);   GAPB(4, C0, 8, P0);   GAPB(5, C0, 10, P0);  GAPB(6, C0, 12, P0);  GAPB(7, C0, 14, P0); \
    GAPB(8, C1, 0, P1);  GAPB(9, C1, 2, P1);  GAPB(10, C1, 4, P1);  GAPB(11, C1, 6, P1);  GAPB(12, C1, 8, P1);  GAPB(13, C1, 10, P1); GAPB(14, C1, 12, P1); GAPB(15, C1, 14, P1); \
    A2_WAIT_BAR(3);                                                                                                   \
    kc = (kc + KSLOT) & (4 * KSLOT - 1); vp += VSLOT; if (vp == 3 * VSLOT) vp = 0; \
    } while (0)
    int t = 1;
    for (; t + 1 < NT; t += 2) {
        A2_STEP(pB0, pB1, pA0, pA1, t);
        A2_STEP(pA0, pA1, pB0, pB1, t + 1);
    }
    A2_STEP(pB0, pB1, pA0, pA1, NT - 1);
    asm volatile("s_waitcnt vmcnt(0)" ::: "memory");
    { float sacc = pB0[0] + pB0[1];
#pragma unroll
      for (int r = 2; r < 16; ++r) sacc += pB0[r];
#pragma unroll
      for (int r = 0; r < 16; ++r) sacc += pB1[r];
      l_reg += sacc;
      pw[0] = (u32x4){PKW(pB0, 0), PKW(pB0, 2), PKW(pB0, 4), PKW(pB0, 6)}; pw[1] = (u32x4){PKW(pB0, 8), PKW(pB0, 10), PKW(pB0, 12), PKW(pB0, 14)};
      pw[2] = (u32x4){PKW(pB1, 0), PKW(pB1, 2), PKW(pB1, 4), PKW(pB1, 6)}; pw[3] = (u32x4){PKW(pB1, 8), PKW(pB1, 10), PKW(pB1, 12), PKW(pB1, 14)};
      const lds_cptr vq_ = vp0 + vp;
#pragma unroll
      for (int kg = 0; kg < 4; ++kg) {
          VRD(0, kg * 4 + 0); VRD(1, kg * 4 + 1); VRD(2, kg * 4 + 2); VRD(3, kg * 4 + 3);
          o[0] = A2_MFMA(VFR(0), __builtin_bit_cast(bf16x8, pw[kg]), o[0]); o[1] = A2_MFMA(VFR(1), __builtin_bit_cast(bf16x8, pw[kg]), o[1]);
          o[2] = A2_MFMA(VFR(2), __builtin_bit_cast(bf16x8, pw[kg]), o[2]); o[3] = A2_MFMA(VFR(3), __builtin_bit_cast(bf16x8, pw[kg]), o[3]); } }
    __builtin_amdgcn_s_setprio(0);
    { auto rr = __builtin_amdgcn_permlane32_swap(__float_as_uint(l_reg), __float_as_uint(l_reg), false, false); l_reg = __uint_as_float(rr[0]) + __uint_as_float(rr[1]); }
    const float rli = __builtin_amdgcn_rcpf(l_reg);
    GAS bf16* Ow = (GAS bf16*)Ob + (long)(wid * 32 + r32) * DM + 4 * hi;
#pragma unroll
    for (int d = 0; d < 4; ++d)
#pragma unroll
      for (int g = 0; g < 4; ++g) { u32x2 w; w.x = cvtpk(o[d][4 * g] * rli, o[d][4 * g + 1] * rli); w.y = cvtpk(o[d][4 * g + 2] * rli, o[d][4 * g + 3] * rli);
          *(GAS u32x2*)(Ow + d * 32 + 8 * g) = w; }
#undef DMA_K
#undef DMA_V
#undef PKW
#undef VFR
#undef VRD
#undef GAPA
#undef GAPB
#undef A2_STEP
}
}

__device__ __forceinline__ int gla_item(int b, int h, int dir, int c) { return ((b * 4 + h) * 2 + dir) * NCH + c; }
namespace gla {
using att::bf16x8; using att::f32x16; using att::u32x4;
__device__ __forceinline__ void gates8(const bf16* P, const float* w2, const float* gb, size_t row0, int dir, int seg, int k, float (&gl)[8]) {
    float w[16];
#pragma unroll
    for (int j = 0; j < 16; ++j) w[j] = w2[j * 256 + k];
    const float bias = gb[k];
#pragma unroll
    for (int i = 0; i < 8; ++i) {
        const bf16* gp = P + (row0 + seg * 8 + i) * NP + C_GLR + dir * 16;
        const v4u a = *(const v4u*)gp, b = *(const v4u*)(gp + 8);
        float z = bias;
        z += bflo(a.x) * w[0] + bfhi(a.x) * w[1] + bflo(a.y) * w[2] + bfhi(a.y) * w[3] + bflo(a.z) * w[4] + bfhi(a.z) * w[5] + bflo(a.w) * w[6] + bfhi(a.w) * w[7];
        z += bflo(b.x) * w[8] + bfhi(b.x) * w[9] + bflo(b.y) * w[10] + bfhi(b.y) * w[11] + bflo(b.z) * w[12] + bfhi(b.z) * w[13] + bflo(b.w) * w[14] + bfhi(b.w) * w[15];
        gl[i] = (fminf(z, 0.f) - log1pf(expf(-fabsf(z)))) * (1.f / 16.f);
    }
}
__device__ __forceinline__ float lscan(const float (&gl)[8], int dir, float (&loc)[8]) {
    float run = 0.f;
    if (dir == 0) {
#pragma unroll
        for (int i = 0; i < 8; ++i) { run += gl[i]; loc[i] = run; }
    } else {
#pragma unroll
        for (int i = 7; i >= 0; --i) { run += gl[i]; loc[i] = run; }
    }
    return run;
}
__device__ __forceinline__ void stage_tile_bf16(const bf16* src, size_t pitch, char* tile, int tid) {
    const int sr = tid >> 4, sc = (tid & 15) * 8;
    const bf16x8 a = *reinterpret_cast<const bf16x8*>(src + (size_t)sr * pitch + sc), b = *reinterpret_cast<const bf16x8*>(src + (size_t)(32 + sr) * pitch + sc);
    *(bf16x8*)(tile + att::v_st(sr, sc)) = a; *(bf16x8*)(tile + att::v_st(32 + sr, sc)) = b;
}
__device__ __forceinline__ void stage_tile_f32(const float* src, char* tile, int tid) {
    const int sr = tid >> 4, sc = (tid & 15) * 8;
#pragma unroll
    for (int t = 0; t < 2; ++t) { const int row = sr + 32 * t; const f32x4 x = *(const f32x4*)(src + row * 128 + sc), y = *(const f32x4*)(src + row * 128 + sc + 4);
        u32x4 w = {att::cvtpk(x[0], x[1]), att::cvtpk(x[2], x[3]), att::cvtpk(y[0], y[1]), att::cvtpk(y[2], y[3])};
        *(u32x4*)(tile + att::v_st(row, sc)) = w; }
}
__device__ __forceinline__ void pv_sel(int d0, f32x16& o, int vb, bf16x8 a0, bf16x8 a1, bf16x8 a2, bf16x8 a3) {
    switch (d0) { case 0: att::pv_one<0>(o, vb, a0, a1, a2, a3); break; case 1: att::pv_one<1>(o, vb, a0, a1, a2, a3); break;
                  case 2: att::pv_one<2>(o, vb, a0, a1, a2, a3); break; default: att::pv_one<3>(o, vb, a0, a1, a2, a3); break; }
}
__device__ __forceinline__ void afrag4(const char* img, int row, int hi, bf16x8 (&a)[4]) {
#pragma unroll
    for (int s = 0; s < 4; ++s) a[s] = *reinterpret_cast<const bf16x8*>(img + KSWZ64(row, (s * 16 + hi * 8) * 2));
}
__device__ __forceinline__ void st_sw(char* img, int row, int col, float v) { *(unsigned short*)(img + KSWZ64(row, col * 2)) = (unsigned short)(att::cvtpk(v, 0.f) & 0xffffu); }
}

constexpr size_t WS_OG = WS_DS;
constexpr int CW_KMX = 13312;
constexpr int CW_Q = 12288;
struct GlaPre { unsigned g; unsigned short q[8], k[8]; att::bf16x8 v0, v1; };
__device__ __forceinline__ void gla_prefetch(GlaPre& R, const bf16* P_, size_t row0, int h, int dir, int k, int seg, int tid) {
    const GAS bf16* P = (const GAS bf16*)P_;
    R.g = *(const GAS unsigned*)(P + (row0 + seg * 8 + (k >> 3)) * NP + C_GLR + dir * 16 + (k & 7) * 2);
#pragma unroll
    for (int i = 0; i < 8; ++i) { const GAS bf16* rp = P + (row0 + seg * 8 + i) * NP; R.q[i] = rp[C_GQ + h * 64 + k]; R.k[i] = rp[C_GK + h * 64 + k]; }
    const int sr = tid >> 4, sc = (tid & 15) * 8;
    R.v0 = *(const GAS att::bf16x8*)(P + (row0 + sr) * NP + C_GV + h * 128 + sc); R.v1 = *(const GAS att::bf16x8*)(P + (row0 + 32 + sr) * NP + C_GV + h * 128 + sc);
}
__device__ __forceinline__ void gla_chain(Frame& F, int l, int chain) {
    const int b = chain >> 3, h = (chain >> 1) & 3, dir = chain & 1;
    const bf16* P = (const bf16*)(F.ws + WS_PROJ); bf16* OG = (bf16*)(F.ws + WS_OG) + (size_t)dir * M * 512;
    char* lds = (char*)F.lds; char* Vt = lds; char* St = lds + 16384; char* KtT = lds + 32768; char* Kt = lds + 40960; char* Qt = lds + 49152; char* Qh = lds + 57344;
    float* T = (float*)(lds + 65536); float* Dec = (float*)(lds + 67584);
    const int k = F.lane, seg = F.tid >> 6, r32 = F.lane & 31, hi = F.lane >> 5, mt = F.wave >> 2, d0 = F.wave & 3;
    const int vbV = (int)(uintptr_t)Vt + att::v_rd_base(F.lane), vbS = (int)(uintptr_t)St + att::v_rd_base(F.lane);
    const int sr = F.tid >> 4, sc = (F.tid & 15) * 8;
    float w[16];
    { const float* w2 = INP(11) + (size_t)((l * 2 + dir) * 16) * 256 + h * 64;
#pragma unroll
      for (int j = 0; j < 16; ++j) w[j] = w2[j * 256 + k]; }
    const float bias = (INP(12) + (l * 2 + dir) * 256 + h * 64)[k];
    att::f32x16 S = {};
    GlaPre R, RN;
    { const int c0 = dir == 0 ? 0 : 3; gla_prefetch(RN, P, (size_t)b * TPB + c0 * 64, h, dir, k, seg, F.tid); }
    for (int j = 0; j < NCH; ++j) {
        const int c = dir == 0 ? j : (j < 4 ? 3 - j : 39 - j);
        const size_t row0 = (size_t)b * TPB + c * 64;
        R = RN;
        if (j + 1 < NCH) { const int cn = dir == 0 ? j + 1 : (j + 1 < 4 ? 2 - j : 38 - j); gla_prefetch(RN, P, (size_t)b * TPB + cn * 64, h, dir, k, seg, F.tid); }
        float gl[8], loc[8];
#pragma unroll
        for (int i = 0; i < 8; ++i) {
            float z = bias;
#pragma unroll
            for (int d = 0; d < 8; ++d) { const unsigned s = (unsigned)__builtin_amdgcn_readlane((int)R.g, i * 8 + d); z += bflo(s) * w[2 * d] + bfhi(s) * w[2 * d + 1]; }
            gl[i] = (fminf(z, 0.f) - __logf(1.f + __expf(-fabsf(z)))) * (1.f / 16.f); }
        const float segtot = gla::lscan(gl, dir, loc);
        T[seg * 64 + k] = segtot;
        *(att::bf16x8*)(Vt + att::v_st(sr, sc)) = R.v0; *(att::bf16x8*)(Vt + att::v_st(32 + sr, sc)) = R.v1;
#pragma unroll
        for (int r = 0; r < 16; ++r) *(unsigned short*)(St + att::v_st(mt * 32 + att::crow(r, hi), d0 * 32 + r32)) = (unsigned short)(att::cvtpk(S[r], 0.f) & 0xffffu);
        __syncthreads();
        float off = 0.f, tot = 0.f;
        int sg = seg; asm volatile("" : "+v"(sg));
#pragma unroll
        for (int s = 0; s < 8; ++s) { const float t = T[s * 64 + k]; tot += t; const bool inoff = dir == 0 ? (s < sg) : (s > sg); off += inoff ? t : 0.f; }
        const float etot = __expf(tot);
        float kt[8];
#pragma unroll
        for (int i = 0; i < 8; ++i) { const int tau = seg * 8 + i; const float qv = bf2f(R.q[i]), kv = bf2f(R.k[i]); const float cc = loc[i] + off;
            const float a = fmaxf(__expf(cc), 1e-30f)  , bq = __builtin_amdgcn_rcpf(a), kb = kv * bq;
            kt[i] = kb * etot;
            gla::st_sw(Qh, tau, k, qv * a); gla::st_sw(Kt, tau, k, kb); }
        { att::u32x4 wv = {att::cvtpk(kt[0], kt[1]), att::cvtpk(kt[2], kt[3]), att::cvtpk(kt[4], kt[5]), att::cvtpk(kt[6], kt[7])};
          *(att::u32x4*)(KtT + KSWZ64(k, seg * 16)) = wv; }
        if (sg == 0) Dec[k] = etot;
        __syncthreads();
        att::f32x16 o = {};
        int tau_q = mt * 32 + r32; asm volatile("" : "+v"(tau_q));
        { att::bf16x8 qr[4]; gla::afrag4(Qh, tau_q, hi, qr);
          att::f32x16 p0, p1; att::qkt(p0, p1, (const bf16*)Kt, qr, r32, hi);
#pragma unroll
          for (int r = 0; r < 16; ++r) { const int t0 = att::crow(r, hi), t1 = 32 + t0;
              const bool k0 = dir == 0 ? (t0 <= tau_q) : (t0 >= tau_q), k1 = dir == 0 ? (t1 <= tau_q) : (t1 >= tau_q);
              p0[r] = k0 ? p0[r] : 0.f; p1[r] = k1 ? p1[r] : 0.f; }
          att::bf16x8 pa0, pa1, pa2, pa3; att::pack_p(p0, p1, pa0, pa1, pa2, pa3);
          gla::pv_sel(d0, o, vbV, pa0, pa1, pa2, pa3);
          gla::pv_sel(d0, o, vbS, qr[0], qr[1], qr[2], qr[3]); }
#pragma unroll
        for (int r = 0; r < 16; ++r) S[r] *= Dec[mt * 32 + att::crow(r, hi)];
        { att::bf16x8 a[4]; gla::afrag4(KtT, mt * 32 + r32, hi, a); gla::pv_sel(d0, S, vbV, a[0], a[1], a[2], a[3]); }
        GAS bf16* op = (GAS bf16*)(OG + row0 * 512 + h * 128 + d0 * 32 + r32);
#pragma unroll
        for (int r = 0; r < 16; ++r) op[(size_t)(mt * 32 + att::crow(r, hi)) * 512] = (bf16)(att::cvtpk(o[r], 0.f) & 0xffffu);
        __syncthreads();
    }
}
__device__ __forceinline__ void p3_mixer(Frame& F, int l) {
    refresh(F);
    for (int ch = F.blk; ch < NBATCH * 8; ch += F.G) gla_chain(F, l, ch);
    const bf16* P = (const bf16*)(F.ws + WS_PROJ); bf16* OD = (bf16*)(F.ws + WS_OD);
    const unsigned* kmxp = (const unsigned*)F.ws + CW_KMX + 256 * l;
    volatile LAS unsigned* slot = F.MISC + 24;
    int myq = F.blk & 7, tries = 0;
    for (;;) {
        __syncthreads();
        if (F.tid == 0) slot[0] = __hip_atomic_fetch_add((unsigned*)((gu32*)F.ws + CW_Q + 64 * l + 8 * 0 + myq), 1u, __ATOMIC_RELAXED, __HIP_MEMORY_SCOPE_AGENT);
        __syncthreads();
        const int u = __builtin_amdgcn_readfirstlane((int)slot[0]);
        if (u >= (l == DEPTH - 1 ? 128 : 144)) { if (++tries >= 8) break; myq = (myq + 1) & 7; continue; }
        int g, qt;
        if (u < 128) { const int pi = u >> 4, mp = (u >> 3) & 1; g = ((pi * 8 + myq) << 1) + mp; qt = 1 + (u & 7); }
        else { const int gi = u - 128; g = (((gi >> 1) * 8 + myq) << 1) + (gi & 1); qt = 0; }
        const int b = g >> 3, hh = g & 7;
        const size_t row0 = (size_t)b * TPB;
        att2::attn_unit2(P + (row0 + qt * 256) * NP + C_Q + hh * 64, P + row0 * NP + C_K + hh * 64, P + row0 * NP + C_V + (hh >> 1) * 128,
                         OD + (row0 + qt * 256) * DM + hh * 128, qt == 0 ? CTX / 64 : TPB / 64, F.lds, F.tid,
                         sqrtf(__uint_as_float(kmxp[(b * 8 + hh) * 2]) + __uint_as_float(kmxp[(b * 8 + hh) * 2 + 1])) * 1.01f);
    }
    __syncthreads();
}
__device__ __forceinline__ void p5_merge_all(Frame& F, int l) {
    refresh(F);
    const bf16* OD = (const bf16*)(F.ws + WS_OD); const bf16* OG = (const bf16*)(F.ws + WS_OG); const bf16* P = (const bf16*)(F.ws + WS_PROJ); bf16* MRG = (bf16*)(F.ws + WS_H);
    const float lam = ((const float*)(F.ws + WS_ROPE + 16384))[l]; const float omli = 1.f - lam_init_of(l);
    const float* subln = INP(14) + l * 128; const float* onorm = INP(15) + l * 128;
    const int h = F.lane >> 4, c0 = (F.lane & 15) * 8;
    const int rpw = (M + F.NGW - 1) / F.NGW, r0 = F.gw * rpw, r1 = (r0 + rpw < M) ? r0 + rpw : M;
    for (int r = r0; r < r1; ++r) {
        const v4u a = *(const v4u*)(OD + (size_t)r * DM + h * 256 + c0), bq = *(const v4u*)(OD + (size_t)r * DM + h * 256 + 128 + c0);
        const v4u gf = *(const v4u*)(OG + (size_t)r * 512 + h * 128 + c0), gbk = *(const v4u*)(OG + ((size_t)M + r) * 512 + h * 128 + c0);
        const v4u gt = *(const v4u*)(P + (size_t)r * NP + C_GG + h * 128 + c0);
        float d[8], e[8], g[8];
        d[0] = bflo(a.x) - lam * bflo(bq.x); d[1] = bfhi(a.x) - lam * bfhi(bq.x); d[2] = bflo(a.y) - lam * bflo(bq.y); d[3] = bfhi(a.y) - lam * bfhi(bq.y);
        d[4] = bflo(a.z) - lam * bflo(bq.z); d[5] = bfhi(a.z) - lam * bfhi(bq.z); d[6] = bflo(a.w) - lam * bflo(bq.w); d[7] = bfhi(a.w) - lam * bfhi(bq.w);
        e[0] = bflo(gf.x) + bflo(gbk.x); e[1] = bfhi(gf.x) + bfhi(gbk.x); e[2] = bflo(gf.y) + bflo(gbk.y); e[3] = bfhi(gf.y) + bfhi(gbk.y);
        e[4] = bflo(gf.z) + bflo(gbk.z); e[5] = bfhi(gf.z) + bfhi(gbk.z); e[6] = bflo(gf.w) + bflo(gbk.w); e[7] = bfhi(gf.w) + bfhi(gbk.w);
        g[0] = bflo(gt.x); g[1] = bfhi(gt.x); g[2] = bflo(gt.y); g[3] = bfhi(gt.y); g[4] = bflo(gt.z); g[5] = bfhi(gt.z); g[6] = bflo(gt.w); g[7] = bfhi(gt.w);
        float ss = 0.f, se = 0.f;
#pragma unroll
        for (int i = 0; i < 8; ++i) { ss += d[i] * d[i]; se += e[i] * e[i]; }
        ss = xadd<1>(ss); ss = xadd<2>(ss); ss = xadd<4>(ss); ss = xadd<8>(ss);
        se = xadd<1>(se); se = xadd<2>(se); se = xadd<4>(se); se = xadd<8>(se);
        const float sc = omli / sqrtf(ss * (1.f / 128.f) + EPS), se2 = 1.0f / sqrtf(se * (1.f / 128.f) + EPS);
#pragma unroll
        for (int i = 0; i < 8; ++i) { d[i] = d[i] * sc * subln[c0 + i]; e[i] = e[i] * se2 * onorm[c0 + i] * siluf(g[i]); }
        v4u w; w.x = pg8::cvt_pk_bf16(d[0], d[1]); w.y = pg8::cvt_pk_bf16(d[2], d[3]); w.z = pg8::cvt_pk_bf16(d[4], d[5]); w.w = pg8::cvt_pk_bf16(d[6], d[7]);
        *(v4u*)(MRG + (size_t)r * DM + h * 128 + c0) = w;
        v4u x; x.x = pg8::cvt_pk_bf16(e[0], e[1]); x.y = pg8::cvt_pk_bf16(e[2], e[3]); x.z = pg8::cvt_pk_bf16(e[4], e[5]); x.w = pg8::cvt_pk_bf16(e[6], e[7]);
        *(v4u*)(MRG + (size_t)r * DM + 512 + h * 128 + c0) = x;
    }
}

__device__ __forceinline__ float dpp_sum16(float v) {
    v += __int_as_float(__builtin_amdgcn_update_dpp(0, __float_as_int(v), 0xB1, 0xF, 0xF, true));
    v += __int_as_float(__builtin_amdgcn_update_dpp(0, __float_as_int(v), 0x4E, 0xF, 0xF, true));
    v += __int_as_float(__builtin_amdgcn_update_dpp(0, __float_as_int(v), 0x141, 0xF, 0xF, true));
    v += __int_as_float(__builtin_amdgcn_update_dpp(0, __float_as_int(v), 0x140, 0xF, 0xF, true));
    return v;
}
__device__ __forceinline__ float wave_sum2(float v) { v = dpp_sum16(v); v = xadd<16>(v); v = xadd<32>(v); return v; }
__device__ __forceinline__ float row_rinv2(const f32x4 (&v)[4]) {
    float s = 0.f;
#pragma unroll
    for (int j = 0; j < 4; ++j) s += (v[j][0] * v[j][0] + v[j][1] * v[j][1]) + (v[j][2] * v[j][2] + v[j][3] * v[j][3]);
    return __builtin_amdgcn_rsqf(wave_sum2(s) * (1.f / DM) + EPS);
}
__device__ __forceinline__ void ld_raw_bf16(const bf16* row, int lane, u32x2 (&v)[4]) {
#pragma unroll
    for (int j = 0; j < 4; ++j) v[j] = *(const u32x2*)(row + 4 * lane + 256 * j);
}
__device__ __forceinline__ f32x4 raw2f(u32x2 w) { return (f32x4){bflo(w.x), bfhi(w.x), bflo(w.y), bfhi(w.y)}; }
__device__ __forceinline__ void ld_vec(const float* p, int lane, f32x4 (&v)[4]) {
#pragma unroll
    for (int j = 0; j < 4; ++j) v[j] = *(const f32x4*)(p + 4 * lane + 256 * j);
}

__device__ __forceinline__ void p1_rows(Frame& F, int l) {
    refresh(F);
    const float* MOD = (const float*)(F.ws + WS_MOD);
    bf16* X = (bf16*)(F.ws + WS_X); bf16* H = (bf16*)(F.ws + WS_H); const bf16* F2 = (const bf16*)(F.ws + WS_F2);
    const int rpw = (M + F.NGW - 1) / F.NGW, r0 = F.gw * rpw, r1 = (r0 + rpw < M) ? r0 + rpw : M;
    if (r0 >= r1) return;
    const bool two = l > 0 && ((l - 1) & 1);
    f32x4 gpre[4], gpost[4], sh[4], sc[4], gt[4];
    ld_vec(INP(6) + l * DM, F.lane, gpre);
    if (l > 0) ld_vec(INP(9) + (l - 1) * DM, F.lane, gpost);
    int cur = -1;
    f32x4 xn[4]; u32x2 xr[4], fn[4], gn[4];
#define P1_ISSUE(r) do { const int b_ = (r) / TPB, p_ = (r) % TPB; \
        if (l == 0) ld_row_f32(p_ < CTX ? INP(2) + ((size_t)b_ * CTX + p_) * DM : INP(0) + ((size_t)b_ * SEQ + (p_ - CTX)) * DM, F.lane, xn); \
        else ld_raw_bf16(X + (size_t)(r) * DM, F.lane, xr); \
        if (l > 0) { ld_raw_bf16(F2 + (size_t)(r) * DM, F.lane, fn); if (two) ld_raw_bf16(F2 + ((size_t)M + (r)) * DM, F.lane, gn); } } while (0)
    P1_ISSUE(r0);
    for (int r = r0; r < r1; ++r) {
        f32x4 x[4]; u32x2 fr[4], gr[4];
#pragma unroll
        for (int j = 0; j < 4; ++j) { x[j] = (l == 0) ? xn[j] : raw2f(xr[j]); fr[j] = fn[j]; gr[j] = gn[j]; }
        if (r + 1 < r1) P1_ISSUE(r + 1);
        const int b = r / TPB, p = r % TPB, mrow = p < CTX ? 16 : b;
        if (mrow != cur) { cur = mrow; const float* modp = MOD + ((size_t)l * 17 + mrow) * 6144; ld_vec(modp, F.lane, sh); ld_vec(modp + 1024, F.lane, sc);
            if (l > 0) ld_vec(MOD + ((size_t)(l - 1) * 17 + mrow) * 6144 + 5 * 1024, F.lane, gt); }
        if (l > 0) {
            f32x4 f[4];
#pragma unroll
            for (int j = 0; j < 4; ++j) { f[j] = raw2f(fr[j]); if (two) f[j] = f[j] + raw2f(gr[j]); }
            const float rinv = row_rinv2(f);
#pragma unroll
            for (int j = 0; j < 4; ++j) x[j] = x[j] + gt[j] * (f[j] * rinv * gpost[j]);
        }
        st_row_bf16(X + (size_t)r * DM, F.lane, x);
        const float rinv = row_rinv2(x);
        f32x4 h[4];
#pragma unroll
        for (int j = 0; j < 4; ++j) h[j] = (x[j] * rinv * gpre[j]) * (sc[j] + 1.0f) + sh[j];
        st_row_bf16(H + (size_t)r * DM, F.lane, h);
    }
#undef P1_ISSUE
}
__device__ __forceinline__ void pf_final(Frame& F) {
    refresh(F);
    const float* MOD = (const float*)(F.ws + WS_MOD);
    const bf16* X = (const bf16*)(F.ws + WS_X); const bf16* F2 = (const bf16*)(F.ws + WS_F2);
    const int l = DEPTH - 1, NR = NBATCH * SEQ;
    const int rpw = (NR + F.NGW - 1) / F.NGW, i0 = F.gw * rpw, i1 = (i0 + rpw < NR) ? i0 + rpw : NR;
    if (i0 >= i1) return;
    f32x4 gpost[4], gt[4]; ld_vec(INP(9) + l * DM, F.lane, gpost);
    int cur = -1;
    u32x2 xn[4], fn[4], gn[4];
#define PF_ISSUE(i) do { const size_t r_ = (size_t)((i) / SEQ) * TPB + CTX + (i) % SEQ; ld_raw_bf16(X + r_ * DM, F.lane, xn); ld_raw_bf16(F2 + r_ * DM, F.lane, fn); ld_raw_bf16(F2 + ((size_t)M + r_) * DM, F.lane, gn); } while (0)
    PF_ISSUE(i0);
    for (int i = i0; i < i1; ++i) {
        f32x4 x[4], f[4];
#pragma unroll
        for (int j = 0; j < 4; ++j) { x[j] = raw2f(xn[j]); f[j] = raw2f(fn[j]) + raw2f(gn[j]); }
        if (i + 1 < i1) PF_ISSUE(i + 1);
        const int b = i / SEQ;
        if (b != cur) { cur = b; ld_vec(MOD + ((size_t)l * 17 + b) * 6144 + 5 * 1024, F.lane, gt); }
        const float rinv = row_rinv2(f);
#pragma unroll
        for (int j = 0; j < 4; ++j) x[j] = x[j] + gt[j] * (f[j] * rinv * gpost[j]);
        st_row_f32(F.A->out + (size_t)i * DM, F.lane, x);
    }
#undef PF_ISSUE
}
__device__ __forceinline__ void p7_rows(Frame& F, int l) {
    refresh(F);
    const float* MOD = (const float*)(F.ws + WS_MOD);
    bf16* X = (bf16*)(F.ws + WS_X); const bf16* Y = (const bf16*)(F.ws + WS_Y); bf16* H2 = (bf16*)(F.ws + WS_H2);
    const bool moe = l & 1; const int li = l >> 1;
    int* TOPE = (int*)(F.ws + WS_TOPE); int* LIDX = (int*)(F.ws + WS_LIDX); float* TOPW = (float*)(F.ws + WS_TOPW); int* BLKB = (int*)(F.ws + WS_BLKB);
    volatile LAS unsigned* LCNT = F.MISC + 16;
    LAS float* RT = (LAS float*)F.lds;
    if (moe) {
        const float* router = INP(20) + (size_t)li * DM * NE;
        if (F.tid < 8) LCNT[F.tid] = 0u;
        for (int i = F.tid; i < DM * NE / 4; i += 512) { const f32x4 q = *(const f32x4*)(router + 4 * i); const int c = i >> 1, e0 = (i & 1) * 4;
            RT[(e0 + 0) * DM + c] = q[0]; RT[(e0 + 1) * DM + c] = q[1]; RT[(e0 + 2) * DM + c] = q[2]; RT[(e0 + 3) * DM + c] = q[3]; }
        __syncthreads();
    }
    const bool lastl = (l == DEPTH - 1); const int NR = lastl ? NBATCH * SEQ : M;
#define P7_ROW(i) (lastl ? ((i) / SEQ) * TPB + CTX + (i) % SEQ : (i))
    const int rpw = (NR + F.NGW - 1) / F.NGW, r0 = F.gw * rpw, r1 = (r0 + rpw < NR) ? r0 + rpw : NR;
    if (r0 < r1) {
        f32x4 gpost[4], gpre[4], gt[4], sh[4], sc[4];
        ld_vec(INP(7) + l * DM, F.lane, gpost); ld_vec(INP(8) + l * DM, F.lane, gpre);
        int cur = -1;
        u32x2 xn[4], yn[4];
        ld_raw_bf16(X + (size_t)P7_ROW(r0) * DM, F.lane, xn); ld_raw_bf16(Y + (size_t)P7_ROW(r0) * DM, F.lane, yn);
        for (int ri = r0; ri < r1; ++ri) {
            const int r = P7_ROW(ri);
            f32x4 x[4], y[4];
#pragma unroll
            for (int j = 0; j < 4; ++j) { x[j] = raw2f(xn[j]); y[j] = raw2f(yn[j]); }
            if (ri + 1 < r1) { const int rn = P7_ROW(ri + 1); ld_raw_bf16(X + (size_t)rn * DM, F.lane, xn); ld_raw_bf16(Y + (size_t)rn * DM, F.lane, yn); }
            const int b = r / TPB, p = r % TPB, mrow = p < CTX ? 16 : b;
            if (mrow != cur) { cur = mrow; const float* modp = MOD + ((size_t)l * 17 + mrow) * 6144; ld_vec(modp + 2 * 1024, F.lane, gt); ld_vec(modp + 3 * 1024, F.lane, sh); ld_vec(modp + 4 * 1024, F.lane, sc); }
            const float ry = row_rinv2(y);
#pragma unroll
            for (int j = 0; j < 4; ++j) x[j] = x[j] + gt[j] * (y[j] * ry * gpost[j]);
            st_row_bf16(X + (size_t)r * DM, F.lane, x);
            const float rx = row_rinv2(x);
            f32x4 h[4];
#pragma unroll
            for (int j = 0; j < 4; ++j) h[j] = (x[j] * rx * gpre[j]) * (sc[j] + 1.0f) + sh[j];
            if constexpr (FFN_F8) {
#pragma unroll
                for (int j = 0; j < 4; ++j) *(unsigned*)((unsigned char*)H2 + (size_t)r * DM + 4 * F.lane + 256 * j) = pk4_f8(h[j][0], h[j][1], h[j][2], h[j][3]);
            } else st_row_bf16(H2 + (size_t)r * DM, F.lane, h);
            if (moe) {
                float lg[8];
#pragma unroll
                for (int e = 0; e < 8; ++e) lg[e] = 0.f;
#pragma unroll
                for (int j = 0; j < 4; ++j)
#pragma unroll
                    for (int e = 0; e < 8; ++e) { const f32x4 q = *(const LAS f32x4*)(RT + e * DM + 4 * F.lane + 256 * j); lg[e] += (h[j][0] * q[0] + h[j][1] * q[1]) + (h[j][2] * q[2] + h[j][3] * q[3]); }
#pragma unroll
                for (int e = 0; e < 8; ++e) lg[e] = wave_sum2(lg[e]);
                int e0 = 0; float v0 = lg[0];
#pragma unroll
                for (int e = 1; e < 8; ++e) if (lg[e] > v0) { v0 = lg[e]; e0 = e; }
                int e1 = -1; float v1 = -3.0e38f;
#pragma unroll
                for (int e = 0; e < 8; ++e) if (e != e0 && lg[e] > v1) { v1 = lg[e]; e1 = e; }
                const float ex = __expf(v1 - v0), w0 = 1.f / (1.f + ex), w1 = ex / (1.f + ex);
                if (F.lane == 0) {
                    const unsigned i0 = __hip_atomic_fetch_add((LAS unsigned*)&LCNT[e0], 1u, __ATOMIC_RELAXED, __HIP_MEMORY_SCOPE_WORKGROUP), i1 = __hip_atomic_fetch_add((LAS unsigned*)&LCNT[e1], 1u, __ATOMIC_RELAXED, __HIP_MEMORY_SCOPE_WORKGROUP);
                    TOPE[r] = e0 | (e1 << 8); LIDX[2 * r] = (int)i0; LIDX[2 * r + 1] = (int)i1; TOPW[2 * r] = w0; TOPW[2 * r + 1] = w1;
                }
            }
        }
    }
    if (moe) {
        __syncthreads();
        if (F.tid < 8) { const unsigned base = __hip_atomic_fetch_add((unsigned*)((gu32*)F.ws + CW_CNT + 64 * li + F.tid), LCNT[F.tid], __ATOMIC_RELAXED, __HIP_MEMORY_SCOPE_AGENT); BLKB[F.blk * 8 + F.tid] = (int)base; }
    }
#undef P7_ROW
}
__device__ __forceinline__ void moe_offsets(Frame& F, int li, int (&cnt)[8], int (&off)[9]) {
    off[0] = 0;
#pragma unroll
    for (int e = 0; e < 8; ++e) { cnt[e] = (int)__hip_atomic_load((unsigned*)(((gu32*)F.ws) + CW_CNT + 64 * li + e), __ATOMIC_RELAXED, __HIP_MEMORY_SCOPE_AGENT); off[e + 1] = off[e] + ((cnt[e] + 255) & ~255); }
}
__device__ __forceinline__ void p7b_gather(Frame& F, int l) {
    refresh(F);
    const int li = l >> 1; int cnt[8], off[9]; moe_offsets(F, li, cnt, off);
    const bf16* H2 = (const bf16*)(F.ws + WS_H2); bf16* HG = (bf16*)(F.ws + WS_HG);
    const int* TOPE = (const int*)(F.ws + WS_TOPE); const int* LIDX = (const int*)(F.ws + WS_LIDX); const float* TOPW = (const float*)(F.ws + WS_TOPW); const int* BLKB = (const int*)(F.ws + WS_BLKB);
    int* RMAP = (int*)(F.ws + WS_RMAP); float* ROWW = (float*)(F.ws + WS_ROWW);
    constexpr int RB = FFN_F8 ? DM : 2 * DM, LB = RB / 64;
    const unsigned char* H2b = (const unsigned char*)H2; unsigned char* HGb = (unsigned char*)HG;
    const bool lastl = (l == DEPTH - 1); const int NR = lastl ? NBATCH * SEQ : M;
    const int rpw = (NR + F.NGW - 1) / F.NGW, r0 = F.gw * rpw, r1 = (r0 + rpw < NR) ? r0 + rpw : NR;
    for (int ri = r0; ri < r1; ++ri) {
        const int r = lastl ? (ri / SEQ) * TPB + CTX + ri % SEQ : ri;
        const int te = TOPE[r];
        v4u a, bq = {0u, 0u, 0u, 0u}; a = *(const v4u*)(H2b + (size_t)r * RB + F.lane * LB); if constexpr (!FFN_F8) bq = *(const v4u*)(H2b + (size_t)r * RB + F.lane * LB + 16);
#pragma unroll
        for (int s = 0; s < 2; ++s) {
            const int e = (te >> (8 * s)) & 0xff;
            int o = 0;
#pragma unroll
            for (int q = 0; q < 8; ++q) o = (q == e) ? off[q] : o;
            const int pos = o + BLKB[F.blk * 8 + e] + LIDX[2 * r + s];
            *(v4u*)(HGb + (size_t)pos * RB + F.lane * LB) = a; if constexpr (!FFN_F8) *(v4u*)(HGb + (size_t)pos * RB + F.lane * LB + 16) = bq;
            if (F.lane == 0) { RMAP[pos] = r | (s << 30); ROWW[pos] = TOPW[2 * r + s]; }
        }
    }
#pragma unroll
    for (int e = 0; e < 8; ++e) {
        const int npad = off[e + 1] - off[e] - cnt[e];
        for (int i = F.gw; i < npad; i += F.NGW) { const int pos = off[e] + cnt[e] + i; const unsigned zz = (unsigned)F.z; const v4u z = {zz, zz, zz, zz};
            *(v4u*)(HGb + (size_t)pos * RB + F.lane * LB) = z; if constexpr (!FFN_F8) *(v4u*)(HGb + (size_t)pos * RB + F.lane * LB + 16) = z;
            if (F.lane == 0) { RMAP[pos] = -1; ROWW[pos] = 0.f; } }
    }
}

__global__ void __launch_bounds__(NWAVES * 64, 2) mk_fwd(Args args) {
    extern __shared__ __attribute__((aligned(16))) unsigned char lds[];
    Frame F;
    F.lds = (LAS unsigned char*)lds;
    F.MISC = (volatile LAS unsigned*)(F.lds + MISC_OFF);
    F.tid = threadIdx.x; F.lane = F.tid & 63; F.wave = __builtin_amdgcn_readfirstlane(F.tid >> 6); F.wv = F.wave;
    F.G = gridDim.x; F.blk = blockIdx.x; F.gw = F.blk * NWAVES + F.wave; F.NGW = F.G * NWAVES;
    F.ws = args.ws;
    F.A = &args;
    for (int u = F.tid; u < 128; u += NWAVES * 64) F.MISC[u] = 0u;
    __syncthreads();
    { XcdBarrier b0 = xcd_barrier_post((unsigned*)F.ws + CW_BAR, F.MISC + 8); (void)b0; }
#define GRID_BAR() do { XcdBarrier b_; b_.bar = (unsigned*)F.ws + CW_BAR; b_.x = xb_xcc_id(); b_.st = F.MISC + 8; refresh(F); xcd_barrier(b_, F.tid == 0); } while (0)

    p0_mod(F); p0_misc(F); convert_weights(F, 0);
    GRID_BAR();
    for (int l = 0; l < DEPTH; ++l) {
        const bool moe = l & 1; const int li = l >> 1;
        { unsigned char* wsp = args.ws; asm volatile("" : "+s"(wsp)); F.ws = wsp; }
        p1_rows(F, l);
        if (l > 0) convert_weights(F, l);
        GRID_BAR();
        {
            refresh(F);
            pg8::Gemm g{(const pg8::bf16_t*)(F.ws + WS_H), (const pg8::bf16_t*)(F.ws + WS_WIN), M, NP, DM};
            pg8::StaticOrder S; S.init(M, NP, F.G, F.blk);
            pg8::EpiProj E{(pg8::bf16_t*)(F.ws + WS_PROJ), (const float*)(F.ws + WS_ROPE), (const float*)(F.ws + WS_ROPE) + 1024, (unsigned*)F.ws + CW_KMX + 256 * l};
            pg8::gemm_phase<pg8::EpiProj, pg8::StaticOrder, true, true>(F.lds, g, S, E, F.wave);
        }
        GRID_BAR();
        p3_mixer(F, l);
        GRID_BAR();
        p5_merge_all(F, l);
        GRID_BAR();
        {
            refresh(F);
            pg8::Gemm g{(const pg8::bf16_t*)(F.ws + WS_H), (const pg8::bf16_t*)(F.ws + WS_WOUT), M, DM, DM};
            const int lastl = (l == DEPTH - 1);
            pg8::LatOrder S; S.S.init(lastl ? NBATCH * SEQ : M, DM, F.G, F.blk); S.lat = lastl;
            pg8::EpiF32 E{(pg8::bf16_t*)(F.ws + WS_Y)};
            pg8::gemm_phase<pg8::EpiF32, pg8::LatOrder, true, true>(F.lds, g, S, E, F.wave);
        }
        GRID_BAR();
        p7_rows(F, l);
        GRID_BAR();
        if (moe) { p7b_gather(F, l); GRID_BAR(); }
        int ntiles = M / 256;
        {
            refresh(F);
            LAS int* texp = (LAS int*)(F.lds + TEXP_OFF);
            if (moe) { int cnt[8], off[9]; moe_offsets(F, li, cnt, off); ntiles = off[8] >> 8;
                for (int t = F.tid; t < ntiles; t += 512) { int e = 0;
#pragma unroll
                    for (int q = 1; q < 8; ++q) e += ((t << 8) >= off[q]) ? 1 : 0;
                    texp[t] = e; } }
            else { for (int t = F.tid; t < ntiles; t += 512) texp[t] = 0; }
            __syncthreads();
        }
        {
            refresh(F);
            pg8::Gemm g{(const pg8::bf16_t*)(F.ws + (moe ? WS_HG : WS_H2)), (const pg8::bf16_t*)(F.ws + WS_WUP), ntiles * 256, 2 * DFF, FFN_F8 ? DM / 2 : DM};
            pg8::GroupedOrder S; S.S.init(ntiles * 256, 2 * DFF, F.G, F.blk); S.texp = (const LAS int*)(F.lds + TEXP_OFF); S.nN = 22;
            pg8::EpiSwiglu E{(pg8::bf16_t*)(F.ws + WS_U)};
            pg8::gemm_phase<pg8::EpiSwiglu, pg8::GroupedOrder, true, true, FFN_F8 != 0>(F.lds, g, S, E, F.wave);
        }
        GRID_BAR();
        {
            refresh(F);
            pg8::Gemm g{(const pg8::bf16_t*)(F.ws + WS_U), (const pg8::bf16_t*)(F.ws + WS_WDN), ntiles * 256, DM, FFN_F8 ? DFF / 2 : DFF};
            pg8::GroupedOrder S; S.S.init(ntiles * 256, DM, F.G, F.blk); S.texp = (const LAS int*)(F.lds + TEXP_OFF); S.nN = 4;
            pg8::EpiDown E{(pg8::bf16_t*)(F.ws + WS_F2), (const int*)(F.ws + WS_RMAP), (const float*)(F.ws + WS_ROWW), moe ? 0 : 1};
            pg8::gemm_phase<pg8::EpiDown, pg8::GroupedOrder, true, true, FFN_F8 != 0>(F.lds, g, S, E, F.wave);
        }
        GRID_BAR();
    }
    pf_final(F);
}

extern "C" void kernel_launch(void* const* d_in, const int* in_sizes, int n_in, void* d_out, int out_size, void* d_ws, size_t ws_size, hipStream_t stream) {
    static int grid = 0;
    if (grid == 0) {
        if (n_in != 24 || out_size != NBATCH * SEQ * DM || ws_size < WS_END) { fprintf(stderr, "kernel_launch: unexpected shapes or workspace (%d inputs, out %d, ws %zu < %zu)\n", n_in, out_size, ws_size, (size_t)WS_END); grid = -1; return; }
        int dev = 0, cus = 0, per_cu = 0;
        if (hipGetDevice(&dev) != hipSuccess || hipDeviceGetAttribute(&cus, hipDeviceAttributeMultiprocessorCount, dev) != hipSuccess) { grid = -1; return; }
        if (hipFuncSetAttribute((const void*)mk_fwd, hipFuncAttributeMaxDynamicSharedMemorySize, LDS_BYTES) != hipSuccess) { grid = -1; return; }
        if (hipOccupancyMaxActiveBlocksPerMultiprocessor(&per_cu, (const void*)mk_fwd, NWAVES * 64, LDS_BYTES) != hipSuccess || per_cu < 1) { fprintf(stderr, "kernel_launch: occupancy query says %d\n", per_cu); }
        (void)hipGetLastError();
        grid = cus;
    }
    if (grid < 0) return;
    if (hipMemsetAsync((char*)d_ws + WS_CTL, 0, CTL_ZERO_BYTES, stream) != hipSuccess) return;
    Args a{};
    for (int i = 0; i < 24; ++i) a.in[i] = (const float*)d_in[i];
    a.out = (float*)d_out; a.ws = (unsigned char*)d_ws;
    hipLaunchKernelGGL(mk_fwd, dim3(grid), dim3(NWAVES * 64), LDS_BYTES, stream, a);
}
```

```cpp
#include <hip/hip_runtime.h>
#include <cstdio>
#include <cstdint>
namespace pg8 {
#define PG8_LAS __attribute__((address_space(3)))
typedef unsigned short bf16_t;
__device__ __forceinline__ int lane_id_opaque() { int l; asm volatile("v_mbcnt_lo_u32_b32 %0, -1, 0\n\tv_mbcnt_hi_u32_b32 %0, -1, %0" : "=v"(l)); return l; }
typedef short bf16x8 __attribute__((ext_vector_type(8)));
typedef float f32x4 __attribute__((ext_vector_type(4)));
typedef unsigned u32x4 __attribute__((ext_vector_type(4)));
constexpr int BM = 256, BK = 64, HALF = 128, HTB = HALF * BK * 2  , STAGE_BYTES = 8 * HTB, NXCD = 8, WGM = 8;

__host__ __device__ __forceinline__ int lds_byte(int r, int c) { const int st = (r >> 4) * 2 + (c >> 5), rr = r & 15, cc = c & 31, ob = rr * 64 + cc * 2; return st * 1024 + (ob ^ (((ob >> 9) & 1) << 5)); }
__host__ __device__ __forceinline__ void stage_rc(int b, int& R, int& C) { const int st = b / 1024, sb = b % 1024, swz = sb ^ (((sb >> 9) & 1) << 5); R = (st >> 1) * 16 + swz / 64; C = (st & 1) * 32 + (swz % 64) / 2; }
__host__ __device__ __forceinline__ int perm32(int rho) { const int n = rho >> 4, i = rho & 15; return 8 * (i >> 2) + 4 * n + (i & 3); }

struct Unit { int pm, pn; };
struct Gemm { const bf16_t* A; const bf16_t* Bt; int M, N, K; };

struct StaticOrder {
    int nM, nN, nwg, G, c;
    __host__ __device__ void init(int M, int N, int G_, int c_) { nM = M / BM; nN = N / BM; nwg = nM * nN; G = G_; c = c_; }
    __host__ __device__ bool next(int i, Unit& u) const {
        const long L = (long)i * G + c; if (L >= nwg) return false;
        int wgid = (int)L; { const int q = nwg / NXCD, r = nwg % NXCD, xcd = wgid % NXCD, off = wgid / NXCD; wgid = (xcd < r ? xcd * (q + 1) : r * (q + 1) + (xcd - r) * q) + off; }
        const int nig = WGM * nN, gid = wgid / nig, fm = gid * WGM, gsz = (nM - fm) < WGM ? (nM - fm) : WGM;
        u.pm = fm + ((wgid % nig) % gsz); u.pn = (wgid % nig) / gsz; return true;
    }
    __device__ __forceinline__ void a_ready(const Unit&) const {}
    __device__ __forceinline__ void done(const Unit&) const {}
};

__device__ __forceinline__ unsigned cvt_pk_bf16(float lo, float hi) { unsigned r; asm volatile("v_cvt_pk_bf16_f32 %0, %1, %2" : "=v"(r) : "v"(lo), "v"(hi)); return r; }
typedef float f32x2 __attribute__((ext_vector_type(2)));
template <class Epi, class Sched, bool ALIGN_EPI = false, bool SP2 = false, bool F8 = false>
__device__ __forceinline__ void gemm_phase(PG8_LAS unsigned char* lds, const Gemm g, const Sched& S, const Epi& E, const int wv  ) {
    int tid_ = wv * 64 + lane_id_opaque();
    const int tid = tid_, wid = __builtin_amdgcn_readfirstlane(tid >> 6), lane = tid & 63, wr = wid >> 2, wc = wid & 3, fr = lane & 15, fq = lane >> 4;
    const int K = g.K, nt = K / BK;
    unsigned voffA[2], voffB[2];
#pragma unroll
    for (int i = 0; i < 2; ++i) { int R, C; stage_rc(tid * 16 + i * 8192, R, C); const int Rb = Epi::PERM ? ((R & ~31) + perm32(R & 31)) : R;
        voffA[i] = (unsigned)(R * K + C) * 2u; voffB[i] = (unsigned)(Rb * K + C) * 2u; }
    const size_t kstep = (size_t)(BK * 2);
    const size_t hstep = (size_t)HALF * K * 2;
    const size_t tstep = 2 * hstep;
    const unsigned ldsw = (unsigned)wid * 1024u;
    const int aoff = lds_byte(wr * 64 + fr, fq * 8), boff = lds_byte(wc * 32 + fr, fq * 8);
#define PG8_SA(b, h) (((b) * 2 + (h)) * HTB)
#define PG8_SB(b, h) ((4 + (b) * 2 + (h)) * HTB)
#define PG8_STAGE(bufoff, gbase, voff) do { _Pragma("unroll") for (int _i = 0; _i < 2; ++_i) \
        __builtin_amdgcn_global_load_lds((const __attribute__((address_space(1))) unsigned*)((const __attribute__((address_space(1))) char*)(gbase) + (voff)[_i]), (PG8_LAS unsigned*)(lds + (bufoff) + ldsw + _i * 8192), 16, 0, 0); } while (0)
#define PG8_LDA(dst, b, h) do { _Pragma("unroll") for (int m = 0; m < 4; ++m) _Pragma("unroll") for (int k = 0; k < 2; ++k) dst[m][k] = *(const PG8_LAS bf16x8*)(lds + PG8_SA(b, h) + aoff + m * 2048 + k * 1024); } while (0)
#define PG8_LDB(dst, b, h) do { _Pragma("unroll") for (int n = 0; n < 2; ++n) _Pragma("unroll") for (int k = 0; k < 2; ++k) dst[n][k] = *(const PG8_LAS bf16x8*)(lds + PG8_SB(b, h) + boff + n * 2048 + k * 1024); } while (0)
#define PG8_MMA(ai, bj, At, Bt) do { if constexpr (F8) __builtin_amdgcn_sched_barrier(0); __builtin_amdgcn_s_setprio(1); _Pragma("unroll") for (int m = 0; m < 4; ++m) _Pragma("unroll") for (int n = 0; n < 2; ++n) { \
        if constexpr (F8) { typedef int i32x4_ __attribute__((ext_vector_type(4))); \
            acc[ai][bj][m][n] = __builtin_amdgcn_mfma_scale_f32_16x16x128_f8f6f4(__builtin_shufflevector(__builtin_bit_cast(i32x4_, Bt[n][0]), __builtin_bit_cast(i32x4_, Bt[n][1]), 0, 1, 2, 3, 4, 5, 6, 7), \
                __builtin_shufflevector(__builtin_bit_cast(i32x4_, At[m][0]), __builtin_bit_cast(i32x4_, At[m][1]), 0, 1, 2, 3, 4, 5, 6, 7), acc[ai][bj][m][n], 0, 0, 0, 0x7f7f7f7f, 0, 0x7f7f7f7f); } \
        else { _Pragma("unroll") for (int k = 0; k < 2; ++k) acc[ai][bj][m][n] = __builtin_amdgcn_mfma_f32_16x16x32_bf16(Bt[n][k], At[m][k], acc[ai][bj][m][n], 0, 0, 0); } } \
        __builtin_amdgcn_s_setprio(0); if constexpr (F8) __builtin_amdgcn_sched_barrier(0); } while (0)
#define PG8_WAIT_V(n) asm volatile("s_waitcnt vmcnt(" #n ")" ::: "memory")
#define PG8_WAIT_L(n) asm volatile("s_waitcnt lgkmcnt(" #n ")" ::: "memory")
#define PG8_BAR __builtin_amdgcn_s_barrier()
#define PG8_SCHED __builtin_amdgcn_sched_barrier(0)
    Unit cur, nxt; int ui = 0;
    if (!S.next(0, cur)) return;
    f32x4 acc[2][2][4][2];
#pragma unroll
    for (int a = 0; a < 2; ++a)
#pragma unroll
        for (int b = 0; b < 2; ++b)
#pragma unroll
            for (int m = 0; m < 4; ++m)
#pragma unroll
                for (int n = 0; n < 2; ++n) acc[a][b][m][n] = (f32x4){0.f, 0.f, 0.f, 0.f};
    bf16x8 At[4][2], B0[2][2], B1[2][2];
    const char* cA = (const char*)g.A + (size_t)cur.pm * tstep; const char* cB = (const char*)g.Bt + (size_t)cur.pn * tstep;
    S.a_ready(cur);
    if constexpr (SP2) {
        PG8_STAGE(PG8_SB(0, 0), cB, voffB); PG8_STAGE(PG8_SB(0, 1), cB + hstep, voffB); PG8_STAGE(PG8_SA(0, 0), cA, voffA); PG8_STAGE(PG8_SA(0, 1), cA + hstep, voffA);
        if (wr == 1) PG8_BAR;
        PG8_WAIT_V(2); PG8_BAR;
        PG8_STAGE(PG8_SB(1, 0), cB + kstep, voffB); PG8_STAGE(PG8_SA(1, 0), cA + kstep, voffA); PG8_STAGE(PG8_SB(1, 1), cB + hstep + kstep, voffB);
        PG8_WAIT_V(6); PG8_BAR;
    } else {
        PG8_STAGE(PG8_SB(0, 0), cB, voffB); PG8_STAGE(PG8_SA(0, 0), cA, voffA); PG8_STAGE(PG8_SB(0, 1), cB + hstep, voffB); PG8_STAGE(PG8_SA(0, 1), cA + hstep, voffA);
        if (wr == 1) PG8_BAR;
        PG8_WAIT_V(4); PG8_BAR;
        PG8_STAGE(PG8_SB(1, 0), cB + kstep, voffB); PG8_STAGE(PG8_SA(1, 0), cA + kstep, voffA); PG8_STAGE(PG8_SB(1, 1), cB + hstep + kstep, voffB);
        PG8_WAIT_V(6); PG8_BAR;
    }
    for (;;) {
        const bool has_next = S.next(ui + 1, nxt);
        const char* nA = has_next ? (const char*)g.A + (size_t)nxt.pm * tstep : cA; const char* nB = has_next ? (const char*)g.Bt + (size_t)nxt.pn * tstep : cB;
        for (int t = 0; t < nt; t += 2) {
            const bool last = (t == nt - 2);
            const char* a1 = cA + (size_t)(t + 1) * kstep;
            const char* a2 = last ? nA : cA + (size_t)(t + 2) * kstep; const char* b2 = last ? nB : cB + (size_t)(t + 2) * kstep;
            const char* a3 = a2 + kstep; const char* b3 = b2 + kstep;
            if (last && has_next) S.a_ready(nxt);
            if constexpr (SP2) {
            PG8_LDB(B0, 0, 0); PG8_LDB(B1, 0, 1); PG8_SCHED; PG8_LDA(At, 0, 0); PG8_STAGE(PG8_SA(1, 1), a1 + hstep, voffA);
            PG8_WAIT_V(8); PG8_WAIT_L(0); PG8_BAR; PG8_MMA(0, 0, At, B0); PG8_MMA(0, 1, At, B1); PG8_BAR; PG8_SCHED;
            PG8_LDA(At, 0, 1); PG8_STAGE(PG8_SB(0, 0), b2, voffB); PG8_STAGE(PG8_SB(0, 1), b2 + hstep, voffB); PG8_STAGE(PG8_SA(0, 0), a2, voffA);
            PG8_WAIT_V(8); PG8_WAIT_L(0); PG8_BAR; PG8_MMA(1, 0, At, B0); PG8_MMA(1, 1, At, B1); PG8_BAR; PG8_SCHED;
            PG8_LDB(B0, 1, 0); PG8_LDB(B1, 1, 1); PG8_SCHED; PG8_LDA(At, 1, 0); PG8_STAGE(PG8_SA(0, 1), a2 + hstep, voffA);
            PG8_WAIT_V(8); PG8_WAIT_L(0); PG8_BAR; PG8_MMA(0, 0, At, B0); PG8_MMA(0, 1, At, B1); PG8_BAR; PG8_SCHED;
            PG8_LDA(At, 1, 1); PG8_STAGE(PG8_SB(1, 0), b3, voffB); PG8_STAGE(PG8_SB(1, 1), b3 + hstep, voffB); PG8_STAGE(PG8_SA(1, 0), a3, voffA);
            PG8_WAIT_V(8); PG8_WAIT_L(0); PG8_BAR; PG8_MMA(1, 0, At, B0); PG8_MMA(1, 1, At, B1); PG8_BAR; PG8_SCHED;
            } else {
            PG8_LDB(B0, 0, 0); PG8_SCHED; PG8_LDA(At, 0, 0); PG8_STAGE(PG8_SA(1, 1), a1 + hstep, voffA);
            PG8_WAIT_L(8); PG8_BAR; PG8_WAIT_L(0); PG8_MMA(0, 0, At, B0); PG8_BAR; PG8_SCHED;
            PG8_LDB(B1, 0, 1); PG8_STAGE(PG8_SB(0, 0), b2, voffB);
            PG8_BAR; PG8_WAIT_L(0); PG8_MMA(0, 1, At, B1); PG8_BAR;
            PG8_LDA(At, 0, 1); PG8_STAGE(PG8_SA(0, 0), a2, voffA);
            PG8_BAR; PG8_WAIT_L(0); PG8_MMA(1, 0, At, B0); PG8_BAR; PG8_SCHED;
            PG8_STAGE(PG8_SB(0, 1), b2 + hstep, voffB);
            PG8_WAIT_V(6); PG8_BAR; PG8_MMA(1, 1, At, B1); PG8_BAR;
            PG8_LDB(B0, 1, 0); PG8_SCHED; PG8_LDA(At, 1, 0); PG8_STAGE(PG8_SA(0, 1), a2 + hstep, voffA);
            PG8_WAIT_L(8); PG8_BAR; PG8_WAIT_L(0); PG8_MMA(0, 0, At, B0); PG8_BAR; PG8_SCHED;
            PG8_LDB(B1, 1, 1); PG8_STAGE(PG8_SB(1, 0), b3, voffB);
            PG8_BAR; PG8_WAIT_L(0); PG8_MMA(0, 1, At, B1); PG8_BAR;
            PG8_LDA(At, 1, 1); PG8_STAGE(PG8_SA(1, 0), a3, voffA);
            PG8_BAR; PG8_WAIT_L(0); PG8_MMA(1, 0, At, B0); PG8_BAR; PG8_SCHED;
            PG8_STAGE(PG8_SB(1, 1), b3 + hstep, voffB);
            PG8_WAIT_V(6); PG8_BAR; PG8_MMA(1, 1, At, B1); PG8_BAR;
            }
        }
        if constexpr (ALIGN_EPI) { if (wr == 0) PG8_BAR; }
        if constexpr (!Epi::AFTER_DRAIN) { const int t2_ = lane_id_opaque(); const int fr_ = t2_ & 15, fq_ = (t2_ & 63) >> 4;
            E(acc, cur, wr, wc, fr_, fq_); S.done(cur); }
        if (!has_next) break;
#pragma unroll
        for (int a = 0; a < 2; ++a)
#pragma unroll
            for (int b = 0; b < 2; ++b)
#pragma unroll
                for (int m = 0; m < 4; ++m)
#pragma unroll
                    for (int n = 0; n < 2; ++n) acc[a][b][m][n] = (f32x4){0.f, 0.f, 0.f, 0.f};
        cur = nxt; cA = nA; cB = nB; ++ui;
        if constexpr (ALIGN_EPI) { if (wr == 1) PG8_BAR; }
    }
    PG8_WAIT_V(0);
    if constexpr (!ALIGN_EPI) { if (wr == 0) PG8_BAR; }
    PG8_BAR;
    if constexpr (Epi::AFTER_DRAIN) { E.fused(acc, cur, wr, wc, fr, fq, lds, wid, lane); S.done(cur); }
#undef PG8_SA
#undef PG8_SB
#undef PG8_STAGE
#undef PG8_LDA
#undef PG8_LDB
#undef PG8_MMA
#undef PG8_WAIT_V
#undef PG8_WAIT_L
#undef PG8_BAR
#undef PG8_SCHED
}
}
#define GAS __attribute__((address_space(1)))
#define LAS __attribute__((address_space(3)))
typedef unsigned short bf16;
typedef unsigned v4u __attribute__((ext_vector_type(4)));
typedef float f32x4 __attribute__((ext_vector_type(4)));
typedef short bf16x8 __attribute__((ext_vector_type(8)));
typedef GAS unsigned gu32;
typedef GAS unsigned long long gu64;
#define RLX_AGENT __ATOMIC_RELAXED, __HIP_MEMORY_SCOPE_AGENT
#define LDS_WAIT() asm volatile("s_waitcnt lgkmcnt(0)" ::: "memory")
#define VM_WAIT() asm volatile("s_waitcnt vmcnt(0)" ::: "memory")
__device__ __forceinline__ unsigned long long rt() { return __builtin_amdgcn_s_memrealtime(); }
__device__ __forceinline__ unsigned f2bf(float f) { unsigned u = __builtin_bit_cast(unsigned, f); return (u + 0x7fffu + ((u >> 16) & 1u)) >> 16; }
__device__ __forceinline__ unsigned pk2(float lo, float hi) { return f2bf(lo) | (f2bf(hi) << 16); }

#define XB_TMO      128
#define XB_XCNT(j)  (256  + 64 * (j))
#define XB_XSUB(j)  (1280 + 64 * (j))
#define XB_XGEN(j)  (2304 + 64 * (j))
#define XB_TOP      3328
#define XB_TOPGEN   3392
#define XCD_BAR_WORDS 3456
#define XB_SPIN_CAP (1u << 18)

__device__ __forceinline__ unsigned xb_ld(unsigned* p)              { return __hip_atomic_load(p, __ATOMIC_RELAXED, __HIP_MEMORY_SCOPE_AGENT); }
__device__ __forceinline__ unsigned xb_add(unsigned* p, unsigned v) { return __hip_atomic_fetch_add(p, v, __ATOMIC_RELAXED, __HIP_MEMORY_SCOPE_AGENT); }
__device__ __forceinline__ unsigned xb_xcc_id() { return (unsigned)__builtin_amdgcn_s_getreg((3 << 11) | 20) & 0xFu; }
#define XB_SPIN(cond, bar) do { unsigned _sp = 0; while (cond) { __builtin_amdgcn_s_sleep(1); \
    if ((++_sp & 255u) == 0u) { if (xb_ld(&(bar)[XB_TMO])) break; if (_sp > XB_SPIN_CAP) { atomicAdd(&(bar)[XB_TMO], 1u); break; } } } } while (0)

struct XcdBarrier {
    unsigned* bar; unsigned x;
    volatile LAS unsigned* st;
};

__device__ __forceinline__ XcdBarrier xcd_barrier_post(unsigned* bar, volatile LAS unsigned* st) {
    XcdBarrier b; b.bar = bar; b.x = xb_xcc_id(); b.st = st;
    if (threadIdx.x == 0) (void)xb_add(&bar[XB_XCNT(b.x)], 1u);
    return b;
}
__device__ __forceinline__ void xcd_barrier_complete(unsigned* bar, unsigned x, unsigned& nloc, unsigned& nx) {
    const unsigned G = gridDim.x * gridDim.y * gridDim.z;
    unsigned sum, cnt, mine, sp = 0u;
    for (;;) {
        sum = 0u; cnt = 0u; mine = 0u;
#pragma unroll
        for (unsigned j = 0; j < 16; ++j) { const unsigned c = xb_ld(&bar[XB_XCNT(j)]); sum += c; cnt += (c > 0u) ? 1u : 0u; mine = (j == x) ? c : mine; }
        if (sum == G) break;
        __builtin_amdgcn_s_sleep(1);
        if ((++sp & 255u) == 0u) { if (xb_ld(&bar[XB_TMO])) break; if (sp > XB_SPIN_CAP) { atomicAdd(&bar[XB_TMO], 1u); break; } }
    }
    nloc = mine > 0u ? mine : 1u; nx = cnt > 0u ? cnt : 1u;
}

__device__ __forceinline__ void xcd_barrier(const XcdBarrier& b, const bool leader  ) {
    asm volatile("s_waitcnt vmcnt(0)" ::: "memory");
    __syncthreads();
    if (leader) {
        unsigned* bar = b.bar; asm volatile("" : "+s"(bar));
        __builtin_amdgcn_s_waitcnt(0);
        unsigned nloc = b.st[0], nx = b.st[1];
        if (nloc == 0u) { xcd_barrier_complete(bar, b.x, nloc, nx); b.st[0] = nloc; b.st[1] = nx; }
        const unsigned old = xb_add(&bar[XB_XSUB(b.x)], 1u);
        const unsigned gen = old / nloc;
        if (old + 1u == (gen + 1u) * nloc) {
            __builtin_amdgcn_fence(__ATOMIC_RELEASE, "agent");
            asm volatile("s_waitcnt vmcnt(0)" ::: "memory");
            const unsigned og = xb_add(&bar[XB_TOP], 1u);
            const unsigned tg = og / nx;
            if (og + 1u == (tg + 1u) * nx) xb_add(&bar[XB_TOPGEN], 1u);
            else XB_SPIN(xb_ld(&bar[XB_TOPGEN]) == tg, bar);
            __builtin_amdgcn_fence(__ATOMIC_ACQUIRE, "agent");
            xb_add(&bar[XB_XGEN(b.x)], 1u);
            asm volatile("s_waitcnt vmcnt(0)" ::: "memory");
        } else {
            XB_SPIN(xb_ld(&bar[XB_XGEN(b.x)]) == gen, bar);
            __builtin_amdgcn_fence(__ATOMIC_ACQUIRE, "agent");
            asm volatile("s_waitcnt vmcnt(0)" ::: "memory");
        }
    }
    __syncthreads();
}

#ifndef FFN_F8
#define FFN_F8 1
#endif
constexpr int NWAVES = 8;
constexpr float W8S = 32.f, U8S = 4.f;
constexpr int DM = 1024, NBATCH = 16, SEQ = 2048, CTX = 256, TPB = SEQ + CTX, M = NBATCH * TPB;
constexpr int DEPTH = 4, NIN = 3104, NP = 3328, DFF = 2816, NE = 8;
constexpr int MP = 2 * M + NE * 256;
constexpr int C_Q = 0, C_K = 512, C_V = 1024, C_GQ = 1536, C_GK = 1792, C_GV = 2048, C_GG = 2560, C_GLR = 3072;
constexpr float EPS = 1e-6f;
constexpr float C2 = 0.125f * 1.4426950408889634f;
constexpr int NCH = TPB / 64;
constexpr int NGLA = NBATCH * 4 * 2 * NCH;

constexpr size_t MiB = 1u << 20;
constexpr size_t WS_CTL = 0, CTL_ZERO_BYTES = 1 * MiB;
constexpr size_t WS_MOD = 1 * MiB;
constexpr size_t WS_ROPE = 3 * MiB;
constexpr size_t WS_TOPE = 4 * MiB;
constexpr size_t WS_LIDX = WS_TOPE + 160 * 1024;
constexpr size_t WS_TOPW = WS_LIDX + 320 * 1024;
constexpr size_t WS_BLKB = WS_TOPW + 320 * 1024;
constexpr size_t WS_RMAP = WS_BLKB + 64 * 1024;
constexpr size_t WS_ROWW = WS_RMAP + 320 * 1024;
static_assert(WS_ROWW + 320 * 1024 <= 6 * MiB, "small tables");
constexpr size_t WS_X = 6 * MiB;
constexpr size_t WS_WIN = 150 * MiB;
constexpr size_t WS_WOUT = WS_WIN + 13 * MiB / 2;
constexpr size_t WS_WUP = WS_WOUT + 2 * MiB;
constexpr size_t WS_WDN = WS_WUP + 88 * MiB;
constexpr size_t WS_D = 291 * MiB;
static_assert(WS_WDN + 44 * MiB <= WS_D, "weights");
constexpr size_t WS_PROJ = WS_D;
constexpr size_t WS_OD = WS_D + 234 * MiB;
constexpr size_t WS_DS = WS_D + 306 * MiB;
constexpr size_t WS_DEC = WS_D + 450 * MiB;
constexpr size_t WS_H = WS_D + 452 * MiB;
constexpr size_t WS_Y = WS_D;
constexpr size_t WS_HG = WS_D;
constexpr size_t WS_F2 = WS_D;
constexpr size_t WS_U = WS_D + 148 * MiB;
constexpr size_t WS_H2 = WS_D + 483 * MiB;
constexpr size_t WS_END = WS_D + 555 * MiB;
static_assert((size_t)MP * DFF * 2 <= 407 * MiB && (size_t)MP * DM * 2 <= 148 * MiB && (size_t)M * NP * 2 <= 234 * MiB, "dynamic map");
static_assert((size_t)M * DFF * 2 + 148 * MiB <= 483 * MiB, "dense U clear of H2");

constexpr int CW_BAR = 4096;
constexpr int CW_CNT = 8192;

constexpr int RING_BYTES = 131072;
constexpr int TEXP_OFF = 139264;
constexpr int MISC_OFF = 146432 - 512;
constexpr int LDS_BYTES = 147456;

typedef unsigned u32x2 __attribute__((ext_vector_type(2)));

__device__ __forceinline__ float bf2f(unsigned short x) { return __uint_as_float((unsigned)x << 16); }
__device__ __forceinline__ float bflo(unsigned w) { return __uint_as_float(w << 16); }
__device__ __forceinline__ float bfhi(unsigned w) { return __uint_as_float(w & 0xffff0000u); }
__device__ __forceinline__ float siluf(float x) { return x * __builtin_amdgcn_rcpf(1.f + __expf(-x)); }
__device__ __forceinline__ float clamp8(float x) { return fminf(fmaxf(x, -448.f), 448.f); }
__device__ __forceinline__ unsigned pk4_f8(float a, float b, float c, float d) { unsigned w = 0u; w = __builtin_amdgcn_cvt_pk_fp8_f32(clamp8(a), clamp8(b), w, false); w = __builtin_amdgcn_cvt_pk_fp8_f32(clamp8(c), clamp8(d), w, true); return w; }
template <int MASK> __device__ __forceinline__ float xadd(float v) {
    if constexpr (MASK == 32) { const auto rr = __builtin_amdgcn_permlane32_swap(__float_as_uint(v), __float_as_uint(v), false, false); return __uint_as_float(rr[0]) + __uint_as_float(rr[1]); }
    else return v + __int_as_float(__builtin_amdgcn_ds_swizzle(__float_as_int(v), 0x1f | (MASK << 10)));
}
__device__ __forceinline__ float wave_sum(float v) {
    v = xadd<1>(v); v = xadd<2>(v); v = xadd<4>(v); v = xadd<8>(v); v = xadd<16>(v); v = xadd<32>(v);
    return v;
}

struct Args { const float* in[24]; float* out; unsigned char* ws; };
struct Frame {
    LAS unsigned char* lds;
    volatile LAS unsigned* MISC;
    int tid, lane, wave, G, blk, gw, NGW, z, wv;
    const Args* A;
    unsigned char* ws;
};


__device__ __forceinline__ void refresh(Frame& F) {
    int wv = F.wv; asm volatile("" : "+s"(wv));
    const int t = wv * 64 + pg8::lane_id_opaque();
    int bl = blockIdx.x, z = 0, gg = gridDim.x; asm volatile("" : "+s"(bl), "+s"(z), "+s"(gg));
    F.blk = bl; F.z = z; F.G = gg; F.NGW = gg * NWAVES;
    F.tid = t; F.lane = t & 63; F.wave = wv; F.gw = F.blk * NWAVES + F.wave;
}
#define INP(k) (F.A->in[(k) + F.z])
namespace pg8 {
struct EpiProj {
    static constexpr bool PERM = true, AFTER_DRAIN = false;
    bf16_t* P; const float* ropec; const float* ropes; unsigned* kmx;
    __device__ __forceinline__ void operator()(const f32x4 (&acc)[2][2][4][2], const Unit& u, int wr, int wc, int fr, int fq) const {
        const int pn = u.pn, pm = u.pm, tb = pm % 9;
        float kss[2] = {0.f, 0.f};
        const bool do_rope = (tb != 0) && (pn < 4);
        const float sc = (pn < 2) ? C2 : (pn == 6 ? 0.125f : 1.f);
        const bool st_ok_all = pn < 12;
#pragma unroll
        for (int ai = 0; ai < 2; ++ai)
#pragma unroll
            for (int m = 0; m < 4; ++m) {
                const int rit = ai * HALF + wr * 64 + m * 16 + fr;
                bf16_t* rowp = P + ((size_t)pm * BM + rit) * NP + pn * BM + wc * 32 + 8 * fq;
                const int s = (tb - 1) * 256 + rit;
                const int pos = (wc & 1) ? (s & 63) : (s >> 6);
                f32x4 cs = {1.f, 1.f, 1.f, 1.f}, sn = {0.f, 0.f, 0.f, 0.f};
                if (do_rope) { cs = *(const f32x4*)(ropec + pos * 16 + 4 * fq); sn = *(const f32x4*)(ropes + pos * 16 + 4 * fq); }
#pragma unroll
                for (int bj = 0; bj < 2; ++bj) {
                    f32x4 v0 = acc[ai][bj][m][0], v1 = acc[ai][bj][m][1];
                    if (do_rope) { const f32x4 a = v0 * cs - v1 * sn, b = v0 * sn + v1 * cs; v0 = a; v1 = b; }
                    v0 = v0 * sc; v1 = v1 * sc;
                    if (pn == 2 || pn == 3) { float ss = (v0[0] * v0[0] + v0[1] * v0[1]) + (v0[2] * v0[2] + v0[3] * v0[3]) + (v1[0] * v1[0] + v1[1] * v1[1]) + (v1[2] * v1[2] + v1[3] * v1[3]);
                        ss = xadd<16>(ss); ss = xadd<32>(ss); kss[bj] = fmaxf(kss[bj], ss); }
                    if (st_ok_all || (bj == 0 && wc == 0)) {
                        u32x4 w; w.x = cvt_pk_bf16(v0[0], v0[1]); w.y = cvt_pk_bf16(v0[2], v0[3]); w.z = cvt_pk_bf16(v1[0], v1[1]); w.w = cvt_pk_bf16(v1[2], v1[3]);
                        *(u32x4*)(rowp + bj * HALF) = w;
                    }
                }
            }
        if (pn == 2 || pn == 3) {
#pragma unroll
            for (int bj = 0; bj < 2; ++bj) { float v = kss[bj];
                v = fmaxf(v, __int_as_float(__builtin_amdgcn_update_dpp(0, __float_as_int(v), 0xB1, 0xF, 0xF, true)));
                v = fmaxf(v, __int_as_float(__builtin_amdgcn_update_dpp(0, __float_as_int(v), 0x4E, 0xF, 0xF, true)));
                v = fmaxf(v, __int_as_float(__builtin_amdgcn_update_dpp(0, __float_as_int(v), 0x141, 0xF, 0xF, true)));
                v = fmaxf(v, __int_as_float(__builtin_amdgcn_update_dpp(0, __float_as_int(v), 0x140, 0xF, 0xF, true)));
                if (fr == 0 && fq == 0) { const int hh = (pn - 2) * 4 + bj * 2 + (wc >> 1);
                    __hip_atomic_fetch_max(kmx + (((pm / 9) * 8 + hh) * 2 + (wc & 1)), __float_as_uint(v), __ATOMIC_RELAXED, __HIP_MEMORY_SCOPE_AGENT); } }
        }
    }
};
struct EpiF32 {
    static constexpr bool PERM = true, AFTER_DRAIN = false;
    bf16_t* Y;
    __device__ __forceinline__ void operator()(const f32x4 (&acc)[2][2][4][2], const Unit& u, int wr, int wc, int fr, int fq) const {
#pragma unroll
        for (int ai = 0; ai < 2; ++ai)
#pragma unroll
            for (int m = 0; m < 4; ++m) {
                bf16_t* rowp = Y + ((size_t)u.pm * BM + ai * HALF + wr * 64 + m * 16 + fr) * DM + u.pn * BM + wc * 32 + 8 * fq;
#pragma unroll
                for (int bj = 0; bj < 2; ++bj) { const f32x4 v0 = acc[ai][bj][m][0], v1 = acc[ai][bj][m][1];
                    u32x4 w; w.x = cvt_pk_bf16(v0[0], v0[1]); w.y = cvt_pk_bf16(v0[2], v0[3]); w.z = cvt_pk_bf16(v1[0], v1[1]); w.w = cvt_pk_bf16(v1[2], v1[3]);
                    *(u32x4*)(rowp + bj * HALF) = w; }
            }
    }
};
struct EpiSwiglu {
    static constexpr bool PERM = true, AFTER_DRAIN = false;
    bf16_t* U;
    __device__ __forceinline__ void operator()(const f32x4 (&acc)[2][2][4][2], const Unit& u, int wr, int wc, int fr, int fq) const {
        const int pnl = u.pn % 22;
        const int col0 = pnl * 128 + wc * 32 + 8 * fq;
        constexpr float ws = FFN_F8 ? 1.f / W8S : 1.f, us = FFN_F8 ? U8S : 1.f, kS = ws * ws * us, kE = -ws * 1.4426950408889634f;
        const float cE = -__builtin_log2f(kS), c1 = 1.f / kS;
#pragma unroll
        for (int ai = 0; ai < 2; ++ai)
#pragma unroll
            for (int m = 0; m < 4; ++m) {
                const size_t rowi = (size_t)u.pm * BM + ai * HALF + wr * 64 + m * 16 + fr;
                f32x2 g[4], up[4], t[4], r[4];
#pragma unroll
                for (int n = 0; n < 2; ++n) { g[2 * n] = (f32x2){acc[ai][0][m][n][0], acc[ai][0][m][n][1]}; g[2 * n + 1] = (f32x2){acc[ai][0][m][n][2], acc[ai][0][m][n][3]};
                                              up[2 * n] = (f32x2){acc[ai][1][m][n][0], acc[ai][1][m][n][1]}; up[2 * n + 1] = (f32x2){acc[ai][1][m][n][2], acc[ai][1][m][n][3]}; }
#pragma unroll
                for (int q = 0; q < 4; ++q) t[q] = g[q] * kE + cE;
#pragma unroll
                for (int q = 0; q < 4; ++q) { t[q].x = __builtin_amdgcn_exp2f(t[q].x); t[q].y = __builtin_amdgcn_exp2f(t[q].y); }
#pragma unroll
                for (int q = 0; q < 4; ++q) t[q] = t[q] + c1;
#pragma unroll
                for (int q = 0; q < 4; ++q) { r[q].x = __builtin_amdgcn_rcpf(t[q].x); r[q].y = __builtin_amdgcn_rcpf(t[q].y); }
#pragma unroll
                for (int q = 0; q < 4; ++q) g[q] = (g[q] * up[q]) * r[q];
                if constexpr (FFN_F8) { u32x2 w; w.x = pk4_f8(g[0].x, g[0].y, g[1].x, g[1].y); w.y = pk4_f8(g[2].x, g[2].y, g[3].x, g[3].y); *(u32x2*)((unsigned char*)U + rowi * DFF + col0) = w; }
                else { u32x4 w; w.x = cvt_pk_bf16(g[0].x, g[0].y); w.y = cvt_pk_bf16(g[1].x, g[1].y); w.z = cvt_pk_bf16(g[2].x, g[2].y); w.w = cvt_pk_bf16(g[3].x, g[3].y); *(u32x4*)(U + rowi * DFF + col0) = w; }
            }
    }
};
struct EpiDown {
    static constexpr bool PERM = true, AFTER_DRAIN = false;
    bf16_t* F2; const int* rmap; const float* roww; int dense;
    __device__ __forceinline__ void operator()(const f32x4 (&acc)[2][2][4][2], const Unit& u, int wr, int wc, int fr, int fq) const {
        const int pnl = u.pn & 3;
        const int col0 = pnl * BM + wc * 32 + 8 * fq;
        const __amdgpu_buffer_rsrc_t rsF = __builtin_amdgcn_make_buffer_rsrc((void*)F2, 0, 2 * M * DM * 2, 0x00020000);
        const __amdgpu_buffer_rsrc_t rsM = __builtin_amdgcn_make_buffer_rsrc((void*)rmap, 0, MP * 4, 0x00020000);
        const __amdgpu_buffer_rsrc_t rsW = __builtin_amdgcn_make_buffer_rsrc((void*)roww, 0, MP * 4, 0x00020000);
#pragma unroll
        for (int ai = 0; ai < 2; ++ai)
#pragma unroll
            for (int m = 0; m < 4; ++m) {
                const int grow = u.pm * BM + ai * HALF + wr * 64 + m * 16 + fr;
                int tok = grow, slot = 0; float w = 1.f; bool ok = true;
                if (!dense) { const int rm = (int)__builtin_amdgcn_raw_buffer_load_b32(rsM, grow * 4, 0, 0); ok = rm >= 0; tok = rm & 0x3fffffff; slot = (rm >> 30) & 1; w = __uint_as_float(__builtin_amdgcn_raw_buffer_load_b32(rsW, grow * 4, 0, 0)); }
                if constexpr (FFN_F8) w *= 1.f / (W8S * U8S);
                if (ok) {
                    const int bo = ((slot * M + tok) * DM + col0) * 2;
#pragma unroll
                    for (int bj = 0; bj < 2; ++bj) {
                        const f32x4 v0 = acc[ai][bj][m][0] * w, v1 = acc[ai][bj][m][1] * w;
                        u32x4 q; q.x = cvt_pk_bf16(v0[0], v0[1]); q.y = cvt_pk_bf16(v0[2], v0[3]); q.z = cvt_pk_bf16(v1[0], v1[1]); q.w = cvt_pk_bf16(v1[2], v1[3]);
                        __builtin_amdgcn_raw_buffer_store_b128(q, rsF, bo + bj * HALF * 2, 0, 0);
                    }
                }
            }
    }
};
struct GroupedOrder {
    StaticOrder S; const PG8_LAS int* texp; int nN;
    __device__ __forceinline__ bool next(int i, Unit& u) const { if (!S.next(i, u)) return false; u.pn += __builtin_amdgcn_readfirstlane(texp[u.pm]) * nN; return true; }
    __device__ __forceinline__ void a_ready(const Unit&) const {}
    __device__ __forceinline__ void done(const Unit&) const {}
};
struct LatOrder {
    StaticOrder S; int lat;
    __device__ __forceinline__ bool next(int i, Unit& u) const { if (!S.next(i, u)) return false; if (lat) u.pm += (u.pm >> 3) + 1; return true; }
    __device__ __forceinline__ void a_ready(const Unit&) const {}
    __device__ __forceinline__ void done(const Unit&) const {}
};
}

__device__ __forceinline__ void ld_row_f32(const float* row, int lane, f32x4 (&v)[4]) {
#pragma unroll
    for (int j = 0; j < 4; ++j) v[j] = *(const f32x4*)(row + 4 * lane + 256 * j);
}
__device__ __forceinline__ void st_row_f32(float* row, int lane, const f32x4 (&v)[4]) {
#pragma unroll
    for (int j = 0; j < 4; ++j) *(f32x4*)(row + 4 * lane + 256 * j) = v[j];
}
__device__ __forceinline__ void ld_row_bf16(const bf16* row, int lane, f32x4 (&v)[4]) {
#pragma unroll
    for (int j = 0; j < 4; ++j) { const u32x2 w = *(const u32x2*)(row + 4 * lane + 256 * j); v[j] = (f32x4){bflo(w.x), bfhi(w.x), bflo(w.y), bfhi(w.y)}; }
}
__device__ __forceinline__ void st_row_bf16(bf16* row, int lane, const f32x4 (&v)[4]) {
#pragma unroll
    for (int j = 0; j < 4; ++j) { u32x2 w; w.x = pg8::cvt_pk_bf16(v[j][0], v[j][1]); w.y = pg8::cvt_pk_bf16(v[j][2], v[j][3]); *(u32x2*)(row + 4 * lane + 256 * j) = w; }
}
__device__ __forceinline__ float row_rinv(const f32x4 (&v)[4]) {
    float s = 0.f;
#pragma unroll
    for (int j = 0; j < 4; ++j) s += (v[j][0] * v[j][0] + v[j][1] * v[j][1]) + (v[j][2] * v[j][2] + v[j][3] * v[j][3]);
    return 1.0f / sqrtf(wave_sum(s) * (1.f / DM) + EPS);
}

__device__ __forceinline__ void transpose_tile(const float* W, int N, int k0, int n0, bf16* WT, int K, int drow0, LAS float* scr, int lane, bool ropeperm = false) {
#pragma unroll 8
    for (int i = 0; i < 32; ++i) { const int kk = 2 * i + (lane >> 5); scr[kk * 33 + (lane & 31)] = __builtin_nontemporal_load(&W[(size_t)(k0 + kk) * N + n0 + (lane & 31)]); }
    LDS_WAIT(); asm volatile("" ::: "memory");
    const int c = lane & 7;
#pragma unroll
    for (int j = 0; j < 4; ++j) { const int n = (lane >> 3) + 8 * j; const LAS float* s = scr + (8 * c) * 33 + n;
        v4u o; o.x = pk2(s[0 * 33], s[1 * 33]); o.y = pk2(s[2 * 33], s[3 * 33]); o.z = pk2(s[4 * 33], s[5 * 33]); o.w = pk2(s[6 * 33], s[7 * 33]);
        const int nd = ropeperm ? (8 * ((n >> 2) & 3) + 4 * (n >> 4) + (n & 3)) : n;
        *(GAS v4u*)(WT + (size_t)(drow0 + nd) * K + k0 + 8 * c) = o; }
    LDS_WAIT(); asm volatile("" ::: "memory");
}
__device__ __forceinline__ void transpose_tile_f8(const float* W, int N, int k0, int n0, unsigned char* WT, int Kb, int drow0, LAS float* scr, int lane, float scale) {
#pragma unroll 8
    for (int i = 0; i < 32; ++i) { const int kk = 2 * i + (lane >> 5); scr[kk * 33 + (lane & 31)] = __builtin_nontemporal_load(&W[(size_t)(k0 + kk) * N + n0 + (lane & 31)]); }
    LDS_WAIT(); asm volatile("" ::: "memory");
    const int n = lane >> 1, hf = lane & 1; const LAS float* s = scr + (hf * 32) * 33 + n;
    v4u o0, o1;
    o0.x = pk4_f8(s[0 * 33] * scale, s[1 * 33] * scale, s[2 * 33] * scale, s[3 * 33] * scale);     o0.y = pk4_f8(s[4 * 33] * scale, s[5 * 33] * scale, s[6 * 33] * scale, s[7 * 33] * scale);
    o0.z = pk4_f8(s[8 * 33] * scale, s[9 * 33] * scale, s[10 * 33] * scale, s[11 * 33] * scale);   o0.w = pk4_f8(s[12 * 33] * scale, s[13 * 33] * scale, s[14 * 33] * scale, s[15 * 33] * scale);
    o1.x = pk4_f8(s[16 * 33] * scale, s[17 * 33] * scale, s[18 * 33] * scale, s[19 * 33] * scale); o1.y = pk4_f8(s[20 * 33] * scale, s[21 * 33] * scale, s[22 * 33] * scale, s[23 * 33] * scale);
    o1.z = pk4_f8(s[24 * 33] * scale, s[25 * 33] * scale, s[26 * 33] * scale, s[27 * 33] * scale); o1.w = pk4_f8(s[28 * 33] * scale, s[29 * 33] * scale, s[30 * 33] * scale, s[31 * 33] * scale);
    GAS v4u* dst = (GAS v4u*)(WT + (size_t)(drow0 + n) * Kb + k0 + hf * 32);
    dst[0] = o0; dst[1] = o1;
    LDS_WAIT(); asm volatile("" ::: "memory");
}
__device__ __forceinline__ void convert_weights(Frame& F, int l) {
    refresh(F);
    const bool moe = l & 1; const int ne = moe ? NE : 1, li = l >> 1;
    const float* w1 = moe ? INP(21) + (size_t)li * NE * DM * DFF : INP(17) + (size_t)li * DM * DFF;
    const float* w3 = moe ? INP(22) + (size_t)li * NE * DM * DFF : INP(18) + (size_t)li * DM * DFF;
    const float* w2 = moe ? INP(23) + (size_t)li * NE * DM * DFF : INP(19) + (size_t)li * DM * DFF;
    const float* win = INP(10) + (size_t)l * DM * NIN;
    const float* wout = INP(16) + (size_t)l * DM * DM;
    bf16* WIN = (bf16*)(F.ws + WS_WIN); bf16* WOUT = (bf16*)(F.ws + WS_WOUT); bf16* WUP = (bf16*)(F.ws + WS_WUP); bf16* WDN = (bf16*)(F.ws + WS_WDN);
    LAS float* scr = (LAS float*)(F.lds + F.wave * 16384);
    const int nA = 16 * 97, nZ = NP - NIN, nB = 16 * 32, nC1 = 16 * 88, nD1 = 44 * 32;
    const int nC = ne * 2 * nC1, nD = ne * nD1, total = nA + nZ + nB + nC + nD;
    for (int it = F.gw; it < total; it += F.NGW) {
        int r = it;
        if (r < nA) { const int kb = r / 97, nb = r % 97; transpose_tile(win, NIN, 64 * kb, 32 * nb, WIN, DM, 32 * nb, scr, F.lane, nb < 32  ); continue; } r -= nA;
        if (r < nZ) { const unsigned zz = (unsigned)F.z; v4u z = {zz, zz, zz, zz}; GAS v4u* p = (GAS v4u*)(WIN + (size_t)(NIN + r) * DM) + F.lane * 2; p[0] = z; p[1] = z; continue; } r -= nZ;
        if (r < nB) { const int kb = r / 32, nb = r % 32; transpose_tile(wout, DM, 64 * kb, 32 * nb, WOUT, DM, 32 * nb, scr, F.lane); continue; } r -= nB;
        if (r < nC) { const int e = r / (2 * nC1), q = r % (2 * nC1), which = q / nC1, t = q % nC1, kb = t / 88, nb = t % 88, n0 = 32 * nb;
            const float* src = (which ? w3 : w1) + (size_t)e * DM * DFF;
            if constexpr (FFN_F8) transpose_tile_f8(src, DFF, 64 * kb, n0, (unsigned char*)WUP, DM, e * 5632 + (n0 / 128) * 256 + (n0 % 128) + which * 128, scr, F.lane, W8S);
            else transpose_tile(src, DFF, 64 * kb, n0, WUP, DM, e * 5632 + (n0 / 128) * 256 + (n0 % 128) + which * 128, scr, F.lane); continue; } r -= nC;
        { const int e = r / nD1, t = r % nD1, kb = t / 32, nb = t % 32;
            if constexpr (FFN_F8) transpose_tile_f8(w2 + (size_t)e * DFF * DM, DM, 64 * kb, 32 * nb, (unsigned char*)WDN + (size_t)e * DM * DFF, DFF, 32 * nb, scr, F.lane, W8S);
            else transpose_tile(w2 + (size_t)e * DFF * DM, DM, 64 * kb, 32 * nb, WDN + (size_t)e * DM * DFF, DFF, 32 * nb, scr, F.lane); }
    }
}

__device__ __forceinline__ void p0_mod(Frame& F) {
    refresh(F);
    LAS float* S = (LAS float*)(F.lds);
    LAS float* R = (LAS float*)(F.lds + 69632);
    const float* c = INP(1); const float* cc = INP(3); const float* wmod = INP(4); const float* bmod = INP(5);
    float* MOD = (float*)(F.ws + WS_MOD);
    for (int i = F.tid; i < 17 * 1024; i += 512) { const int b = i >> 10, k = i & 1023; const float v = b < 16 ? c[b * 1024 + k] : cc[k]; S[i] = siluf(v); }
    __syncthreads();
    const int kq = F.lane >> 4, c4 = (F.lane & 15) * 4;
    for (int item = F.blk; item < 4 * 96; item += F.G) {
        const int l = item / 96, col0 = (item % 96) * 64;
        const float* W = wmod + (size_t)l * DM * 6144;
        float acc[17][4];
#pragma unroll
        for (int b = 0; b < 17; ++b)
#pragma unroll
            for (int j = 0; j < 4; ++j) acc[b][j] = 0.f;
        for (int it = 0; it < 32; ++it) {
            const int k = F.wave * 128 + it * 4 + kq;
            const f32x4 w = *(const f32x4*)(W + (size_t)k * 6144 + col0 + c4);
#pragma unroll
            for (int b = 0; b < 17; ++b) { const float s = S[b * 1024 + k];
#pragma unroll
                for (int j = 0; j < 4; ++j) acc[b][j] += s * w[j]; }
        }
#pragma unroll
        for (int b = 0; b < 17; ++b)
#pragma unroll
            for (int j = 0; j < 4; ++j) { float v = acc[b][j]; v = xadd<16>(v); v = xadd<32>(v); acc[b][j] = v; }
        if (kq == 0) {
#pragma unroll
            for (int b = 0; b < 17; ++b)
#pragma unroll
                for (int j = 0; j < 4; ++j) R[(F.wave * 17 + b) * 64 + c4 + j] = acc[b][j];
        }
        __syncthreads();
        for (int o = F.tid; o < 17 * 64; o += 512) { const int b = o >> 6, ccx = o & 63; float s = bmod[l * 6144 + col0 + ccx];
            for (int w = 0; w < 8; ++w) s += R[(w * 17 + b) * 64 + ccx];
            MOD[((size_t)l * 17 + b) * 6144 + col0 + ccx] = s; }
        __syncthreads();
    }
}
__device__ __forceinline__ float lam_init_of(int l) { return 0.8f - 0.6f * expf(-0.3f * (float)l); }
__device__ __forceinline__ void p0_misc(Frame& F) {
    refresh(F);
    float* ropec = (float*)(F.ws + WS_ROPE); float* ropes = ropec + 1024; float* lam = (float*)(F.ws + WS_ROPE + 16384);
    if (F.blk == 0) {
        for (int i = F.tid; i < 1024; i += 512) { const int pos = i >> 4, f = i & 15; const float inv = powf(10000.f, -(float)f / 16.f); const float ang = (float)pos * inv; ropec[i] = cosf(ang); ropes[i] = sinf(ang); }
    }
    if (F.blk == (1 % F.G) && F.wave < 4) {
        const int l = F.wave; const float* lv = INP(13) + l * 256;
        const float a = wave_sum(lv[F.lane] * lv[64 + F.lane]), b = wave_sum(lv[128 + F.lane] * lv[192 + F.lane]);
        if (F.lane == 0) lam[l] = expf(a) - expf(b) + lam_init_of(l);
    }
}

namespace att {
using bf16x8 = __attribute__((ext_vector_type(8))) short;
using s16x4  = __attribute__((ext_vector_type(4))) short;
using f32x16 = __attribute__((ext_vector_type(16))) float;
using u32x4  = __attribute__((ext_vector_type(4))) unsigned;
constexpr int QBLK = 32, KVBLK = 64, NW = 8, DV = 128;
constexpr float THR = 8.f;
constexpr size_t SHM_V = KVBLK * DV * 2, SHM_K = KVBLK * 64 * 2, SHM_ATTN = 2 * SHM_V + 2 * SHM_K + NW * 64 * 4;
#define KSWZ64(row, colB) ((row) * 128 + ((colB) ^ ((((row) >> 1) & 7) << 4)))
#define SBAR() __builtin_amdgcn_sched_barrier(0)
__device__ __forceinline__ int crow(int r, int hi) { return (r & 3) + 8 * (r >> 2) + 4 * hi; }
__device__ __forceinline__ unsigned cvtpk(float lo, float hi) { unsigned r; asm volatile("v_cvt_pk_bf16_f32 %0, %1, %2" : "=v"(r) : "v"(lo), "v"(hi)); return r; }
__device__ __forceinline__ void partialSM(f32x16& p0, f32x16& p1, float& m_reg, float& mn, float& alpha) {
  float pmax = p0[0];
#pragma unroll
  for (int r = 1; r < 16; ++r) pmax = fmaxf(pmax, p0[r]);
#pragma unroll
  for (int r = 0; r < 16; ++r) pmax = fmaxf(pmax, p1[r]);
  { auto rr = __builtin_amdgcn_permlane32_swap(__float_as_uint(pmax), __float_as_uint(pmax), false, false);
    pmax = fmaxf(__uint_as_float(rr[0]), __uint_as_float(rr[1])); }
  if (__builtin_expect(__all(pmax - m_reg <= THR), 1)) { mn = m_reg; alpha = 1.f; }
  else { mn = fmaxf(m_reg, pmax); alpha = __builtin_amdgcn_exp2f(m_reg - mn); m_reg = mn; }
#pragma unroll
  for (int r = 0; r < 16; ++r) p0[r] = p0[r] - mn;
#pragma unroll
  for (int r = 0; r < 16; ++r) p1[r] = p1[r] - mn;
#pragma unroll
  for (int r = 0; r < 16; ++r) p0[r] = __builtin_amdgcn_exp2f(p0[r]);
}
__device__ __forceinline__ void finishSM(f32x16& p0, f32x16& p1, float alpha, float& l_reg, bf16x8& pa0, bf16x8& pa1, bf16x8& pa2, bf16x8& pa3) {
#pragma unroll
  for (int r = 0; r < 16; ++r) p1[r] = __builtin_amdgcn_exp2f(p1[r]);
  float ps = 0;
#pragma unroll
  for (int r = 0; r < 16; ++r) ps += p0[r];
#pragma unroll
  for (int r = 0; r < 16; ++r) ps += p1[r];
  { auto rr = __builtin_amdgcn_permlane32_swap(__float_as_uint(ps), __float_as_uint(ps), false, false);
    ps = __uint_as_float(rr[0]) + __uint_as_float(rr[1]); }
  l_reg = l_reg * alpha + ps;
#define PK4(P, BASE, OUT) do { unsigned a0 = cvtpk(P[BASE + 0], P[BASE + 1]), a1 = cvtpk(P[BASE + 2], P[BASE + 3]);   \
    unsigned b0 = cvtpk(P[BASE + 4], P[BASE + 5]), b1 = cvtpk(P[BASE + 6], P[BASE + 7]);                              \
    auto r0 = __builtin_amdgcn_permlane32_swap(a0, b0, false, false); auto r1 = __builtin_amdgcn_permlane32_swap(a1, b1, false, false); \
    u32x4 w = {r0[0], r1[0], r0[1], r1[1]}; OUT = *reinterpret_cast<bf16x8*>(&w); } while (0)
  PK4(p0, 0, pa0); PK4(p0, 8, pa1); PK4(p1, 0, pa2); PK4(p1, 8, pa3);
#undef PK4
}
__device__ __forceinline__ void pack_p(const f32x16& p0, const f32x16& p1, bf16x8& pa0, bf16x8& pa1, bf16x8& pa2, bf16x8& pa3) {
#define PK4(P, BASE, OUT) do { unsigned a0 = cvtpk(P[BASE + 0], P[BASE + 1]), a1 = cvtpk(P[BASE + 2], P[BASE + 3]);   \
    unsigned b0 = cvtpk(P[BASE + 4], P[BASE + 5]), b1 = cvtpk(P[BASE + 6], P[BASE + 7]);                              \
    auto r0 = __builtin_amdgcn_permlane32_swap(a0, b0, false, false); auto r1 = __builtin_amdgcn_permlane32_swap(a1, b1, false, false); \
    u32x4 w = {r0[0], r1[0], r0[1], r1[1]}; OUT = *reinterpret_cast<bf16x8*>(&w); } while (0)
  PK4(p0, 0, pa0); PK4(p0, 8, pa1); PK4(p1, 0, pa2); PK4(p1, 8, pa3);
#undef PK4
}
__device__ __forceinline__ void qkt(f32x16& p0, f32x16& p1, const bf16* Ks, const bf16x8* qr, int r32, int hi) {
  p0 = f32x16{}; p1 = f32x16{};
#pragma unroll
  for (int d0 = 0; d0 < 4; ++d0) { int cb = (d0 * 16 + hi * 8) * 2;
    bf16x8 b0 = *reinterpret_cast<const bf16x8*>((const char*)Ks + KSWZ64(r32, cb));
    bf16x8 b1 = *reinterpret_cast<const bf16x8*>((const char*)Ks + KSWZ64(32 + r32, cb));
    p0 = __builtin_amdgcn_mfma_f32_32x32x16_bf16(b0, qr[d0], p0, 0, 0, 0);
    p1 = __builtin_amdgcn_mfma_f32_32x32x16_bf16(b1, qr[d0], p1, 0, 0, 0); }
}
__device__ __forceinline__ int v_st(int k, int c) { const int kk = (k & ~0xC) | ((k & 4) << 1) | ((k & 8) >> 1); return ((kk >> 3) * 4 + (c >> 5)) * 512 + ((kk & 7) * 32 + (c & 31)) * 2; }
__device__ __forceinline__ int v_rd_base(int lane) { return ((lane & 3) << 3) | (((lane >> 2) & 3) << 6) | (((lane >> 4) & 1) << 5) | (((lane >> 5) & 1) << 8); }
constexpr int v_rd_off(int d0, int ks, int half) { return d0 * 512 + ks * 4096 + half * 2048; }
template <int OFF> __device__ __forceinline__ s16x4 tr_read(int vb) {
  s16x4 r; asm volatile("ds_read_b64_tr_b16 %0, %1 offset:%2" : "=&v"(r) : "v"(vb), "i"(OFF) : "memory"); return r;
}
template <int D0> __device__ __forceinline__ void pv_one(f32x16& od, int vb, bf16x8 pa0, bf16x8 pa1, bf16x8 pa2, bf16x8 pa3) {
  const s16x4 l0 = tr_read<v_rd_off(D0, 0, 0)>(vb), h0 = tr_read<v_rd_off(D0, 0, 1)>(vb), l1 = tr_read<v_rd_off(D0, 1, 0)>(vb), h1 = tr_read<v_rd_off(D0, 1, 1)>(vb);
  const s16x4 l2 = tr_read<v_rd_off(D0, 2, 0)>(vb), h2 = tr_read<v_rd_off(D0, 2, 1)>(vb), l3 = tr_read<v_rd_off(D0, 3, 0)>(vb), h3 = tr_read<v_rd_off(D0, 3, 1)>(vb);
  asm volatile("s_waitcnt lgkmcnt(0)" ::: "memory"); SBAR();
#define PK(L, H) (bf16x8){L[0], L[1], L[2], L[3], H[0], H[1], H[2], H[3]}
  od = __builtin_amdgcn_mfma_f32_32x32x16_bf16(pa0, PK(l0, h0), od, 0, 0, 0);
  od = __builtin_amdgcn_mfma_f32_32x32x16_bf16(pa1, PK(l1, h1), od, 0, 0, 0);
  od = __builtin_amdgcn_mfma_f32_32x32x16_bf16(pa2, PK(l2, h2), od, 0, 0, 0);
  od = __builtin_amdgcn_mfma_f32_32x32x16_bf16(pa3, PK(l3, h3), od, 0, 0, 0);
#undef PK
}
__device__ __forceinline__ void pv_d0(f32x16* o, int vb, bf16x8 pa0, bf16x8 pa1, bf16x8 pa2, bf16x8 pa3) {
  pv_one<0>(o[0], vb, pa0, pa1, pa2, pa3); pv_one<1>(o[1], vb, pa0, pa1, pa2, pa3); pv_one<2>(o[2], vb, pa0, pa1, pa2, pa3); pv_one<3>(o[3], vb, pa0, pa1, pa2, pa3);
}
constexpr int LDQ = NP, LDK = NP, LDO = DM;
__device__ __forceinline__ void sm_first(f32x16& p0, f32x16& p1, float m) {
#pragma unroll
  for (int r = 0; r < 16; ++r) p0[r] = p0[r] - m;
#pragma unroll
  for (int r = 0; r < 16; ++r) p1[r] = p1[r] - m;
#pragma unroll
  for (int r = 0; r < 16; ++r) p0[r] = __builtin_amdgcn_exp2f(p0[r]);
}
__device__ __forceinline__ void sm_second(f32x16& p0, f32x16& p1, float& l_reg, bf16x8& pa0, bf16x8& pa1, bf16x8& pa2, bf16x8& pa3) {
#pragma unroll
  for (int r = 0; r < 16; ++r) p1[r] = __builtin_amdgcn_exp2f(p1[r]);
  float ps = 0;
#pragma unroll
  for (int r = 0; r < 16; ++r) ps += p0[r];
#pragma unroll
  for (int r = 0; r < 16; ++r) ps += p1[r];
  { auto rr = __builtin_amdgcn_permlane32_swap(__float_as_uint(ps), __float_as_uint(ps), false, false);
    ps = __uint_as_float(rr[0]) + __uint_as_float(rr[1]); }
  l_reg += ps;
  pack_p(p0, p1, pa0, pa1, pa2, pa3);
}
__device__ __forceinline__ void attn_unit(const bf16* __restrict__ Qb, const bf16* __restrict__ Kh, const bf16* __restrict__ Vh, bf16* __restrict__ Ob, int seq, char* lds, int tid, float kmax) {
  const int wid = tid >> 6, lane = tid & 63, r32 = lane & 31, hi = lane >> 5;
  bf16* V_lds = (bf16*)lds; bf16* K_lds = (bf16*)(lds + 2 * SHM_V);
  float* ws = (float*)(lds + 2 * SHM_V + 2 * SHM_K) + wid * 64; float* li_l = ws; float* al_l = ws + 32;
  float m_reg = -1e30f, l_reg = 0; f32x16 o[4] = {}; bf16x8 qr[4];
  const bf16* Qw = Qb + (long)(wid * QBLK + r32) * LDQ + hi * 8;
#pragma unroll
  for (int d0 = 0; d0 < 4; ++d0) qr[d0] = *(const __attribute__((address_space(1))) bf16x8*)(Qw + d0 * 16);
  { float qs = 0.f;
#pragma unroll
    for (int d0 = 0; d0 < 4; ++d0)
#pragma unroll
      for (int e = 0; e < 8; ++e) { const float qv = __uint_as_float((unsigned)(unsigned short)qr[d0][e] << 16); qs += qv * qv; }
    auto rr = __builtin_amdgcn_permlane32_swap(__float_as_uint(qs), __float_as_uint(qs), false, false);
    qs = __uint_as_float(rr[0]) + __uint_as_float(rr[1]);
    m_reg = sqrtf(qs) * kmax * 1.002f + 1e-3f; }
  const int sr = tid >> 4, sc = (tid & 15) * 8, vst0 = v_st(sr, sc), vst1 = v_st(32 + sr, sc);
  const int kr = tid >> 3, kc = (tid & 7) * 8, kst = KSWZ64(kr, kc * 2);
  const int vb0 = (int)(uintptr_t)V_lds + v_rd_base(lane);
  struct { bf16x8 vs0, vs1, ks0; } sr_[2];
#define GLD8(p) (*(const __attribute__((address_space(1))) bf16x8*)(p))
#define SLOAD(i, k0) do { sr_[i].vs0 = GLD8(&Vh[(long)((k0) + sr) * LDK + sc]); sr_[i].vs1 = GLD8(&Vh[(long)((k0) + 32 + sr) * LDK + sc]); \
    sr_[i].ks0 = GLD8(&Kh[(long)((k0) + kr) * LDK + kc]); } while (0)
#define SWRITE(b, i) do { *(bf16x8*)((char*)V_lds + (b) * SHM_V + vst0) = sr_[i].vs0; *(bf16x8*)((char*)V_lds + (b) * SHM_V + vst1) = sr_[i].vs1; \
    *(bf16x8*)((char*)K_lds + (b) * SHM_K + kst) = sr_[i].ks0; } while (0)
#define SWAIT() asm volatile("s_waitcnt vmcnt(3)" ::: "memory")
#define RESC(a) do { if (__any((a) < 1.f)) { if (hi == 0) al_l[r32] = (a); asm volatile("s_waitcnt lgkmcnt(0)" ::: "memory"); \
    _Pragma("unroll") for (int d = 0; d < 4; ++d) _Pragma("unroll") for (int r = 0; r < 16; ++r) o[d][r] *= al_l[crow(r, hi)]; } } while (0)
  f32x16 pA0, pA1, pB0, pB1; float mnA, mnB, alA, alB; bf16x8 pa0, pa1, pa2, pa3; const int NT = seq / KVBLK;
  if (__builtin_amdgcn_readfirstlane(wid) >= 4) __builtin_amdgcn_s_setprio(1);
  constexpr int SE = 0, SO = 1;
  SLOAD(SE, 0); asm volatile("s_waitcnt vmcnt(0)" ::: "memory"); SWRITE(0, SE); __syncthreads();
  qkt(pA0, pA1, K_lds, qr, r32, hi); sm_first(pA0, pA1, m_reg);
  SLOAD(SO, KVBLK); if (2 < NT) SLOAD(SE, 2 * KVBLK);
  SWAIT(); SWRITE(1, SO); __syncthreads();
  for (int j = 1; j + 1 < NT; j += 2) {
    SBAR(); qkt(pB0, pB1, (bf16*)((char*)K_lds + SHM_K), qr, r32, hi);
    sm_second(pA0, pA1, l_reg, pa0, pa1, pa2, pa3); SBAR();
    SLOAD(SO, (j + 2) * KVBLK); SBAR();
    pv_d0(o, vb0, pa0, pa1, pa2, pa3); sm_first(pB0, pB1, m_reg);
    __syncthreads(); SWAIT(); SWRITE(0, SE);
    __syncthreads();
    SBAR(); qkt(pA0, pA1, K_lds, qr, r32, hi);
    sm_second(pB0, pB1, l_reg, pa0, pa1, pa2, pa3); SBAR();
    if (j + 3 < NT) SLOAD(SE, (j + 3) * KVBLK); SBAR();
    pv_d0(o, vb0 + (int)SHM_V, pa0, pa1, pa2, pa3); sm_first(pA0, pA1, m_reg);
    __syncthreads(); SWAIT(); SWRITE(1, SO);
    __syncthreads();
  }
  SBAR(); qkt(pB0, pB1, (bf16*)((char*)K_lds + SHM_K), qr, r32, hi);
  sm_second(pA0, pA1, l_reg, pa0, pa1, pa2, pa3); SBAR();
  pv_d0(o, vb0, pa0, pa1, pa2, pa3); sm_first(pB0, pB1, m_reg);
  __syncthreads();
  sm_second(pB0, pB1, l_reg, pa0, pa1, pa2, pa3); SBAR();
  pv_d0(o, vb0 + (int)SHM_V, pa0, pa1, pa2, pa3);
  __builtin_amdgcn_s_setprio(0);
  if (hi == 0) li_l[r32] = l_reg; asm volatile("s_waitcnt lgkmcnt(0)" ::: "memory");
  float rli[16];
#pragma unroll
  for (int r = 0; r < 16; ++r) rli[r] = __builtin_amdgcn_rcpf(li_l[crow(r, hi)]);
  bf16* Ow = Ob + (long)(wid * QBLK) * LDO;
#pragma unroll
  for (int r = 0; r < 16; ++r) { const int orow = crow(r, hi);
#pragma unroll
    for (int d0 = 0; d0 < 4; ++d0) Ow[(long)orow * LDO + d0 * 32 + r32] = (bf16)(cvtpk(o[d0][r] * rli[r], 0.f) & 0xffffu); }
#undef SLOAD
#undef GLD8
#undef SWRITE
#undef SWAIT
#undef RESC
}
}

constexpr int CW_KMX = 13312;
constexpr int CW_Q = 12288;
namespace att2 {
using att::bf16x8; using att::s16x4; using att::f32x16; using att::u32x4;
typedef LAS const char* lds_cptr;
typedef short v4i16_t __attribute__((ext_vector_type(4)));
typedef unsigned u32x2 __attribute__((ext_vector_type(2)));
constexpr int KSLOT = 8192, VSLOT = 16384, LDS_K = 0, LDS_V = 4 * KSLOT, KVBLK = 64;
#define A2_PIN(x) asm volatile("" : "+v"(x))
#define A2_MFMA(a, b, c) __builtin_amdgcn_mfma_f32_32x32x16_bf16(a, b, c, 0, 0, 0)
#define A2_WAIT_BAR(N) asm volatile("s_waitcnt vmcnt(" #N ") lgkmcnt(0)\n\ts_barrier" ::: "memory")
__device__ __forceinline__ unsigned cvtpk(float lo, float hi) { unsigned r; asm("v_cvt_pk_bf16_f32 %0, %1, %2" : "=v"(r) : "v"(lo), "v"(hi)); return r; }
__device__ __forceinline__ void glds16s(const char* gbase, unsigned voff, unsigned lds_base) {
    unsigned sv; asm volatile("s_mov_b32 %0, m0\n\ts_mov_b32 m0, %3\n\ts_nop 0\n\tglobal_load_lds_dwordx4 %1, %2\n\ts_mov_b32 m0, %0" : "=&s"(sv) : "v"(voff), "s"(gbase), "s"(lds_base) : "memory"); }
__device__ __forceinline__ const char* uni_ptr(const void* p) { const unsigned long long v = (unsigned long long)p;
    const unsigned lo = __builtin_amdgcn_readfirstlane((unsigned)v), hi = __builtin_amdgcn_readfirstlane((unsigned)(v >> 32)); return (const char*)(((unsigned long long)hi << 32) | lo); }
__device__ __forceinline__ void kload2(bf16x8* kf, lds_cptr kp, int d0) { kf[2 * d0] = *(const LAS bf16x8*)(kp + d0 * 2048); kf[2 * d0 + 1] = *(const LAS bf16x8*)(kp + d0 * 2048 + 512); }
__device__ __forceinline__ s16x4 vtr(lds_cptr p) { return __builtin_bit_cast(s16x4, __builtin_amdgcn_ds_read_tr16_b64_v4i16((LAS v4i16_t*)p)); }
struct UnitP { const bf16* Q; const char* K; const char* V; bf16* O; int NT, kmi; };
__device__ __forceinline__ void decode_unit(int u, int myq, const bf16* P, bf16* OD, UnitP& U) {
    int g, qt;
    if (u < 128) { const int pi = u >> 4, mp = (u >> 3) & 1; g = ((pi * 8 + myq) << 1) + mp; qt = 1 + (u & 7); }
    else { const int gi = u - 128; g = (((gi >> 1) * 8 + myq) << 1) + (gi & 1); qt = 0; }
    const int b = g >> 3, hh = g & 7;
    const size_t row0 = (size_t)b * TPB;
    U.Q = P + (row0 + qt * 256) * NP + C_Q + hh * 64; U.K = (const char*)(P + row0 * NP + C_K + hh * 64); U.V = (const char*)(P + row0 * NP + C_V + (hh >> 1) * 128);
    U.O = OD + (row0 + qt * 256) * DM + hh * 128; U.NT = qt == 0 ? CTX / 64 : TPB / 64;
    U.kmi = (b * 8 + hh) * 2;
}
__device__ __forceinline__ void attn_stream(Frame& F, int l) {
    const bf16* P = (const bf16*)(F.ws + WS_PROJ); bf16* OD = (bf16*)(F.ws + WS_OD);
    const unsigned* kmxp = (const unsigned*)F.ws + CW_KMX + 256 * l;
    gu32* qheads = (gu32*)F.ws + CW_Q + 64 * l;
    volatile LAS unsigned* slot = F.MISC + 24;
    const int limit = (l == DEPTH - 1 ? 128 : 144);
    LAS unsigned char* lds = F.lds; const int tid = F.tid;
    const int lane = tid & 63, r32 = lane & 31, hi = lane >> 5; const int wid = __builtin_amdgcn_readfirstlane(tid >> 6);
    constexpr unsigned TSTR = KVBLK * NP * 2;
    const unsigned lds0 = (unsigned)(uintptr_t)lds;
    const unsigned koff = (unsigned)(lane * NP + wid * 8) * 2;
    const unsigned voff0 = (unsigned)((16 * (wid & 3) + (lane >> 2)) * NP + (wid >> 2) * 32 + (lane & 3) * 8) * 2, voff1 = voff0 + 128;
    const unsigned kdst = lds0 + LDS_K + wid * 1024, vdst = lds0 + LDS_V + wid * 1024;
#define DMA_K(src, slotB) glds16s((src), koff, kdst + (slotB))
#define DMA_V(src, slotB) do { const char* vb_ = (src); glds16s(vb_, voff0, vdst + (slotB)); glds16s(vb_, voff1, vdst + (slotB) + 8192); } while (0)
    const lds_cptr vp0 = (lds_cptr)lds + LDS_V + ((lane >> 4) & 1) * 32 + (lane & 3) * 8 + (4 * hi + ((lane & 15) >> 2)) * 64;
    const lds_cptr kp0 = (lds_cptr)lds + LDS_K + hi * 1024 + r32 * 16;
    if (wid >= 4) __builtin_amdgcn_s_setprio(1);
    int myq = F.blk & 7, tries = 0, vstart = 0; bool warm = false; UnitP cur, nx;
    for (;;) {
        if (!warm) {
            int u;
            for (;;) {
                __syncthreads();
                if (tid == 0) slot[0] = __hip_atomic_fetch_add((unsigned*)(qheads + myq), 1u, __ATOMIC_RELAXED, __HIP_MEMORY_SCOPE_AGENT);
                __syncthreads();
                u = __builtin_amdgcn_readfirstlane((int)slot[0]);
                if (u < limit) break;
                if (++tries >= 8) { u = -1; break; }
                myq = (myq + 1) & 7;
            }
            if (u < 0) break;
            decode_unit(u, myq, P, OD, cur);
            const char* Kc = uni_ptr(cur.K); const char* Vc = uni_ptr(cur.V);
            DMA_K(Kc, 0); DMA_V(Vc, 0); DMA_K(Kc + TSTR, KSLOT); DMA_K(Kc + 2 * (size_t)TSTR, 2 * KSLOT); vstart = 0;
        }
        const char* Kh = uni_ptr(cur.K); const char* Vh = uni_ptr(cur.V); const int NT = cur.NT;
        const int tpop = NT - 5;
        unsigned nxt = 0xffffffffu;
        if (NT < 8 && tid == 0) nxt = __hip_atomic_fetch_add((unsigned*)(qheads + myq), 1u, __ATOMIC_RELAXED, __HIP_MEMORY_SCOPE_AGENT);
        bf16x8 qr[4];
        const bf16* Qw = cur.Q + (long)(wid * 32 + r32) * NP + hi * 8;
#pragma unroll
        for (int d0 = 0; d0 < 4; ++d0) qr[d0] = *(const GAS bf16x8*)(Qw + d0 * 16);
        const float kmax = sqrtf(__uint_as_float(kmxp[cur.kmi]) + __uint_as_float(kmxp[cur.kmi + 1])) * 1.01f;
        float m_row;
        { float qs = 0.f;
#pragma unroll
          for (int d0 = 0; d0 < 4; ++d0)
#pragma unroll
            for (int e = 0; e < 8; ++e) { const float qv = __uint_as_float((unsigned)(unsigned short)qr[d0][e] << 16); qs += qv * qv; }
          auto rr = __builtin_amdgcn_permlane32_swap(__float_as_uint(qs), __float_as_uint(qs), false, false);
          qs = __uint_as_float(rr[0]) + __uint_as_float(rr[1]);
          m_row = sqrtf(qs) * kmax * 1.002f + 1e-3f; }
        f32x16 negm16;
#pragma unroll
        for (int r = 0; r < 16; ++r) negm16[r] = -m_row;
        A2_PIN(negm16);
        float l_reg = 0.f; f32x16 o[4]; o[0] = f32x16{}; o[1] = f32x16{}; o[2] = f32x16{}; o[3] = f32x16{};
        f32x16 pA0, pA1, pB0, pB1; bf16x8 kf[8]; s16x4 vlo[5], vhi[5]; u32x4 pw[4];
        asm volatile("s_waitcnt vmcnt(0)" ::: "memory");
        if (NT < 8 && tid == 0) slot[1] = nxt;
        asm volatile("s_waitcnt lgkmcnt(0)\n\ts_barrier" ::: "memory");
        bool hasn = false; const char* KhN = Kh; const char* VhN = Vh;
#define GET_NEXT() do { const int un_ = __builtin_amdgcn_readfirstlane((int)slot[1]); hasn = un_ < limit; if (hasn) { decode_unit(un_, myq, P, OD, nx); KhN = uni_ptr(nx.K); VhN = uni_ptr(nx.V); } } while (0)
        if (NT < 8) GET_NEXT();
#pragma unroll
        for (int d0 = 0; d0 < 4; ++d0) kload2(kf, kp0, d0);
        pA0 = A2_MFMA(kf[0], qr[0], negm16); pA1 = A2_MFMA(kf[1], qr[0], negm16); pA0 = A2_MFMA(kf[2], qr[1], pA0); pA1 = A2_MFMA(kf[3], qr[1], pA1);
        pA0 = A2_MFMA(kf[4], qr[2], pA0); pA1 = A2_MFMA(kf[5], qr[2], pA1); pA0 = A2_MFMA(kf[6], qr[3], pA0); pA1 = A2_MFMA(kf[7], qr[3], pA1);
#pragma unroll
        for (int r = 0; r < 16; ++r) { pA0[r] = __builtin_amdgcn_exp2f(pA0[r]); pA1[r] = __builtin_amdgcn_exp2f(pA1[r]); }
        int vp = vstart;
        { int v1 = vp + VSLOT; if (v1 == 3 * VSLOT) v1 = 0; DMA_K(Kh + 3 * (size_t)TSTR, 3 * KSLOT); DMA_V(Vh + TSTR, v1); }
        kload2(kf, kp0 + KSLOT, 0); kload2(kf, kp0 + KSLOT, 1);
        A2_WAIT_BAR(3);
        int kc = KSLOT;
#define PKW(P, i) cvtpk(P[i], P[(i) + 1])
#define VFR(s) (bf16x8){vlo[s][0], vlo[s][1], vlo[s][2], vlo[s][3], vhi[s][0], vhi[s][1], vhi[s][2], vhi[s][3]}
#define VRD(s, i) do { vlo[s] = vtr(vq_ + (((i) & 3) * 4096 + ((i) >> 2) * 1024)); vhi[s] = vtr(vq_ + (((i) & 3) * 4096 + ((i) >> 2) * 1024 + 512)); } while (0)
#define GAPA(MF, W0, W1, PW) do { MF; W0; W1; A2_PIN(PW); SBAR(); } while (0)
#define GAPB(i, X, j, Y) do { if ((i) + 4 < 16) VRD(((i) + 4) % 5, (i) + 4); if ((i) == 9) kload2(kf, kn_, 0); if ((i) == 10) kload2(kf, kn_, 1); SBAR(); \
    o[(i) & 3] = A2_MFMA(VFR((i) % 5), __builtin_bit_cast(bf16x8, pw[(i) >> 2]), o[(i) & 3]); X[j] = __builtin_amdgcn_exp2f(X[j]); X[(j) + 1] = __builtin_amdgcn_exp2f(X[(j) + 1]); l_reg += Y[j]; l_reg += Y[(j) + 1]; A2_PIN(X); A2_PIN(l_reg); SBAR(); } while (0)
#define A2_STEP(C0, C1, P0, P1, t) do { \
    if ((t) == tpop) { if (tid == 0) slot[1] = __hip_atomic_fetch_add((unsigned*)(qheads + myq), 1u, __ATOMIC_RELAXED, __HIP_MEMORY_SCOPE_AGENT); } \
    if ((t) == tpop + 1) GET_NEXT();                                                                                 \
    SBAR(); \
    const lds_cptr kq_ = kp0 + kc, vq_ = vp0 + vp, kn_ = kp0 + ((kc + KSLOT) & (4 * KSLOT - 1)); \
    const int ik_ = (t) + 3, iv_ = (t) + 1; \
    const char* ks_ = ik_ < NT ? Kh + (size_t)ik_ * TSTR : KhN + (size_t)(ik_ - NT) * TSTR;                            \
    const char* vs_ = iv_ < NT ? Vh + (size_t)iv_ * TSTR : VhN; \
    const int kprev_ = (kc - KSLOT) & (4 * KSLOT - 1); int vnew_ = vp + 2 * VSLOT; if (vnew_ >= 3 * VSLOT) vnew_ -= 3 * VSLOT; \
    kload2(kf, kq_, 2); SBAR(); \
    GAPA(C0 = A2_MFMA(kf[0], qr[0], negm16), pw[0][0] = PKW(P0, 0),  pw[0][1] = PKW(P0, 2),  pw[0]); \
    kload2(kf, kq_, 3); SBAR(); \
    GAPA(C1 = A2_MFMA(kf[1], qr[0], negm16), pw[0][2] = PKW(P0, 4),  pw[0][3] = PKW(P0, 6),  pw[0]); \
    VRD(0, 0); SBAR(); GAPA(C0 = A2_MFMA(kf[2], qr[1], C0), pw[1][0] = PKW(P0, 8),  pw[1][1] = PKW(P0, 10), pw[1]); \
    VRD(1, 1); SBAR(); GAPA(C1 = A2_MFMA(kf[3], qr[1], C1), pw[1][2] = PKW(P0, 12), pw[1][3] = PKW(P0, 14), pw[1]); \
    VRD(2, 2); SBAR(); GAPA(C0 = A2_MFMA(kf[4], qr[2], C0), pw[2][0] = PKW(P1, 0),  pw[2][1] = PKW(P1, 2),  pw[2]); \
    VRD(3, 3); SBAR(); GAPA(C1 = A2_MFMA(kf[5], qr[2], C1), pw[2][2] = PKW(P1, 4),  pw[2][3] = PKW(P1, 6),  pw[2]); \
                       GAPA(C0 = A2_MFMA(kf[6], qr[3], C0), pw[3][0] = PKW(P1, 8),  pw[3][1] = PKW(P1, 10), pw[3]); \
                       GAPA(C1 = A2_MFMA(kf[7], qr[3], C1), pw[3][2] = PKW(P1, 12), pw[3][3] = PKW(P1, 14), pw[3]); \
    DMA_K(ks_, kprev_); DMA_V(vs_, vnew_); SBAR();                                                                   \
    GAPB(0, C0, 0, P0);  GAPB(1, C0, 2, P0);  GAPB(2, C0, 4, P0);   GAPB(3, C0, 6, P0);   GAPB(4, C0, 8, P0);   GAPB(5, C0, 10, P0);  GAPB(6, C0, 12, P0);  GAPB(7, C0, 14, P0); \
    GAPB(8, C1, 0, P1);  GAPB(9, C1, 2, P1);  GAPB(10, C1, 4, P1);  GAPB(11, C1, 6, P1);  GAPB(12, C1, 8, P1);  GAPB(13, C1, 10, P1); GAPB(14, C1, 12, P1); GAPB(15, C1, 14, P1); \
    A2_WAIT_BAR(3);                                                                                                   \
    kc = (kc + KSLOT) & (4 * KSLOT - 1); vp += VSLOT; if (vp == 3 * VSLOT) vp = 0; \
    } while (0)
        int t = 1;
        for (; t + 1 < NT; t += 2) {
            A2_STEP(pB0, pB1, pA0, pA1, t);
            A2_STEP(pA0, pA1, pB0, pB1, t + 1);
        }
        A2_STEP(pB0, pB1, pA0, pA1, NT - 1);
        { float sacc = pB0[0] + pB0[1];
#pragma unroll
          for (int r = 2; r < 16; ++r) sacc += pB0[r];
#pragma unroll
          for (int r = 0; r < 16; ++r) sacc += pB1[r];
          l_reg += sacc;
          pw[0] = (u32x4){PKW(pB0, 0), PKW(pB0, 2), PKW(pB0, 4), PKW(pB0, 6)}; pw[1] = (u32x4){PKW(pB0, 8), PKW(pB0, 10), PKW(pB0, 12), PKW(pB0, 14)};
          pw[2] = (u32x4){PKW(pB1, 0), PKW(pB1, 2), PKW(pB1, 4), PKW(pB1, 6)}; pw[3] = (u32x4){PKW(pB1, 8), PKW(pB1, 10), PKW(pB1, 12), PKW(pB1, 14)};
          const lds_cptr vq_ = vp0 + vp;
#pragma unroll
          for (int kg = 0; kg < 4; ++kg) {
              VRD(0, kg * 4 + 0); VRD(1, kg * 4 + 1); VRD(2, kg * 4 + 2); VRD(3, kg * 4 + 3);
              o[0] = A2_MFMA(VFR(0), __builtin_bit_cast(bf16x8, pw[kg]), o[0]); o[1] = A2_MFMA(VFR(1), __builtin_bit_cast(bf16x8, pw[kg]), o[1]);
              o[2] = A2_MFMA(VFR(2), __builtin_bit_cast(bf16x8, pw[kg]), o[2]); o[3] = A2_MFMA(VFR(3), __builtin_bit_cast(bf16x8, pw[kg]), o[3]); } }
        { auto rr = __builtin_amdgcn_permlane32_swap(__float_as_uint(l_reg), __float_as_uint(l_reg), false, false); l_reg = __uint_as_float(rr[0]) + __uint_as_float(rr[1]); }
        const float rli = __builtin_amdgcn_rcpf(l_reg);
        GAS bf16* Ow = (GAS bf16*)cur.O + (long)(wid * 32 + r32) * DM + 4 * hi;
#pragma unroll
        for (int d = 0; d < 4; ++d)
#pragma unroll
          for (int g = 0; g < 4; ++g) { u32x2 w; w.x = cvtpk(o[d][4 * g] * rli, o[d][4 * g + 1] * rli); w.y = cvtpk(o[d][4 * g + 2] * rli, o[d][4 * g + 3] * rli);
              *(GAS u32x2*)(Ow + d * 32 + 8 * g) = w; }
        vstart = vp + VSLOT; if (vstart == 3 * VSLOT) vstart = 0;
        if (hasn) { cur = nx; warm = true; }
        else { asm volatile("s_waitcnt vmcnt(0)" ::: "memory"); warm = false; }
    }
    __builtin_amdgcn_s_setprio(0);
    __syncthreads();
#undef DMA_K
#undef DMA_V
#undef PKW
#undef VFR
#undef VRD
#undef GAPA
#undef GAPB
#undef A2_STEP
#undef GET_NEXT
}
}

__device__ __forceinline__ int gla_item(int b, int h, int dir, int c) { return ((b * 4 + h) * 2 + dir) * NCH + c; }
namespace gla {
using att::bf16x8; using att::f32x16; using att::u32x4;
__device__ __forceinline__ void gates8(const bf16* P, const float* w2, const float* gb, size_t row0, int dir, int seg, int k, float (&gl)[8]) {
    float w[16];
#pragma unroll
    for (int j = 0; j < 16; ++j) w[j] = w2[j * 256 + k];
    const float bias = gb[k];
#pragma unroll
    for (int i = 0; i < 8; ++i) {
        const bf16* gp = P + (row0 + seg * 8 + i) * NP + C_GLR + dir * 16;
        const v4u a = *(const v4u*)gp, b = *(const v4u*)(gp + 8);
        float z = bias;
        z += bflo(a.x) * w[0] + bfhi(a.x) * w[1] + bflo(a.y) * w[2] + bfhi(a.y) * w[3] + bflo(a.z) * w[4] + bfhi(a.z) * w[5] + bflo(a.w) * w[6] + bfhi(a.w) * w[7];
        z += bflo(b.x) * w[8] + bfhi(b.x) * w[9] + bflo(b.y) * w[10] + bfhi(b.y) * w[11] + bflo(b.z) * w[12] + bfhi(b.z) * w[13] + bflo(b.w) * w[14] + bfhi(b.w) * w[15];
        gl[i] = (fminf(z, 0.f) - log1pf(expf(-fabsf(z)))) * (1.f / 16.f);
    }
}
__device__ __forceinline__ float lscan(const float (&gl)[8], int dir, float (&loc)[8]) {
    float run = 0.f;
    if (dir == 0) {
#pragma unroll
        for (int i = 0; i < 8; ++i) { run += gl[i]; loc[i] = run; }
    } else {
#pragma unroll
        for (int i = 7; i >= 0; --i) { run += gl[i]; loc[i] = run; }
    }
    return run;
}
__device__ __forceinline__ void stage_tile_bf16(const bf16* src, size_t pitch, char* tile, int tid) {
    const int sr = tid >> 4, sc = (tid & 15) * 8;
    const bf16x8 a = *reinterpret_cast<const bf16x8*>(src + (size_t)sr * pitch + sc), b = *reinterpret_cast<const bf16x8*>(src + (size_t)(32 + sr) * pitch + sc);
    *(bf16x8*)(tile + att::v_st(sr, sc)) = a; *(bf16x8*)(tile + att::v_st(32 + sr, sc)) = b;
}
__device__ __forceinline__ void stage_tile_f32(const float* src, char* tile, int tid) {
    const int sr = tid >> 4, sc = (tid & 15) * 8;
#pragma unroll
    for (int t = 0; t < 2; ++t) { const int row = sr + 32 * t; const f32x4 x = *(const f32x4*)(src + row * 128 + sc), y = *(const f32x4*)(src + row * 128 + sc + 4);
        u32x4 w = {att::cvtpk(x[0], x[1]), att::cvtpk(x[2], x[3]), att::cvtpk(y[0], y[1]), att::cvtpk(y[2], y[3])};
        *(u32x4*)(tile + att::v_st(row, sc)) = w; }
}
__device__ __forceinline__ void pv_sel(int d0, f32x16& o, int vb, bf16x8 a0, bf16x8 a1, bf16x8 a2, bf16x8 a3) {
    switch (d0) { case 0: att::pv_one<0>(o, vb, a0, a1, a2, a3); break; case 1: att::pv_one<1>(o, vb, a0, a1, a2, a3); break;
                  case 2: att::pv_one<2>(o, vb, a0, a1, a2, a3); break; default: att::pv_one<3>(o, vb, a0, a1, a2, a3); break; }
}
__device__ __forceinline__ void afrag4(const char* img, int row, int hi, bf16x8 (&a)[4]) {
#pragma unroll
    for (int s = 0; s < 4; ++s) a[s] = *reinterpret_cast<const bf16x8*>(img + KSWZ64(row, (s * 16 + hi * 8) * 2));
}
__device__ __forceinline__ void st_sw(char* img, int row, int col, float v) { *(unsigned short*)(img + KSWZ64(row, col * 2)) = (unsigned short)(att::cvtpk(v, 0.f) & 0xffffu); }
}

constexpr size_t WS_OG = WS_DS;
struct GlaPre { unsigned g; unsigned short q[8], k[8]; att::bf16x8 v0, v1; };
__device__ __forceinline__ void gla_prefetch(GlaPre& R, const bf16* P_, size_t row0, int h, int dir, int k, int seg, int tid) {
    const GAS bf16* P = (const GAS bf16*)P_;
    R.g = *(const GAS unsigned*)(P + (row0 + seg * 8 + (k >> 3)) * NP + C_GLR + dir * 16 + (k & 7) * 2);
#pragma unroll
    for (int i = 0; i < 8; ++i) { const GAS bf16* rp = P + (row0 + seg * 8 + i) * NP; R.q[i] = rp[C_GQ + h * 64 + k]; R.k[i] = rp[C_GK + h * 64 + k]; }
    const int sr = tid >> 4, sc = (tid & 15) * 8;
    R.v0 = *(const GAS att::bf16x8*)(P + (row0 + sr) * NP + C_GV + h * 128 + sc); R.v1 = *(const GAS att::bf16x8*)(P + (row0 + 32 + sr) * NP + C_GV + h * 128 + sc);
}
__device__ __forceinline__ void gla_chain(Frame& F, int l, int chain) {
    const int b = chain >> 3, h = (chain >> 1) & 3, dir = chain & 1;
    const bf16* P = (const bf16*)(F.ws + WS_PROJ); bf16* OG = (bf16*)(F.ws + WS_OG) + (size_t)dir * M * 512;
    char* lds = (char*)F.lds; char* Vt = lds; char* St = lds + 16384; char* KtT = lds + 32768; char* Kt = lds + 40960; char* Qt = lds + 49152; char* Qh = lds + 57344;
    float* T = (float*)(lds + 65536); float* Dec = (float*)(lds + 67584);
    const int k = F.lane, seg = F.tid >> 6, r32 = F.lane & 31, hi = F.lane >> 5, mt = F.wave >> 2, d0 = F.wave & 3;
    const int vbV = (int)(uintptr_t)Vt + att::v_rd_base(F.lane), vbS = (int)(uintptr_t)St + att::v_rd_base(F.lane);
    const int sr = F.tid >> 4, sc = (F.tid & 15) * 8;
    float w[16];
    { const float* w2 = INP(11) + (size_t)((l * 2 + dir) * 16) * 256 + h * 64;
#pragma unroll
      for (int j = 0; j < 16; ++j) w[j] = w2[j * 256 + k]; }
    const float bias = (INP(12) + (l * 2 + dir) * 256 + h * 64)[k];
    att::f32x16 S = {};
    GlaPre R, RN;
    { const int c0 = dir == 0 ? 0 : 3; gla_prefetch(RN, P, (size_t)b * TPB + c0 * 64, h, dir, k, seg, F.tid); }
    for (int j = 0; j < NCH; ++j) {
        const int c = dir == 0 ? j : (j < 4 ? 3 - j : 39 - j);
        const size_t row0 = (size_t)b * TPB + c * 64;
        R = RN;
        if (j + 1 < NCH) { const int cn = dir == 0 ? j + 1 : (j + 1 < 4 ? 2 - j : 38 - j); gla_prefetch(RN, P, (size_t)b * TPB + cn * 64, h, dir, k, seg, F.tid); }
        float gl[8], loc[8];
#pragma unroll
        for (int i = 0; i < 8; ++i) {
            float z = bias;
#pragma unroll
            for (int d = 0; d < 8; ++d) { const unsigned s = (unsigned)__builtin_amdgcn_readlane((int)R.g, i * 8 + d); z += bflo(s) * w[2 * d] + bfhi(s) * w[2 * d + 1]; }
            gl[i] = (fminf(z, 0.f) - __logf(1.f + __expf(-fabsf(z)))) * (1.f / 16.f); }
        const float segtot = gla::lscan(gl, dir, loc);
        T[seg * 64 + k] = segtot;
        *(att::bf16x8*)(Vt + att::v_st(sr, sc)) = R.v0; *(att::bf16x8*)(Vt + att::v_st(32 + sr, sc)) = R.v1;
#pragma unroll
        for (int r = 0; r < 16; ++r) *(unsigned short*)(St + att::v_st(mt * 32 + att::crow(r, hi), d0 * 32 + r32)) = (unsigned short)(att::cvtpk(S[r], 0.f) & 0xffffu);
        __syncthreads();
        float off = 0.f, tot = 0.f;
        int sg = seg; asm volatile("" : "+v"(sg));
#pragma unroll
        for (int s = 0; s < 8; ++s) { const float t = T[s * 64 + k]; tot += t; const bool inoff = dir == 0 ? (s < sg) : (s > sg); off += inoff ? t : 0.f; }
        const float etot = __expf(tot);
        float kt[8];
#pragma unroll
        for (int i = 0; i < 8; ++i) { const int tau = seg * 8 + i; const float qv = bf2f(R.q[i]), kv = bf2f(R.k[i]); const float cc = loc[i] + off;
            const float a = fmaxf(__expf(cc), 1e-30f)  , bq = __builtin_amdgcn_rcpf(a), kb = kv * bq;
            kt[i] = kb * etot;
            gla::st_sw(Qh, tau, k, qv * a); gla::st_sw(Kt, tau, k, kb); }
        { att::u32x4 wv = {att::cvtpk(kt[0], kt[1]), att::cvtpk(kt[2], kt[3]), att::cvtpk(kt[4], kt[5]), att::cvtpk(kt[6], kt[7])};
          *(att::u32x4*)(KtT + KSWZ64(k, seg * 16)) = wv; }
        if (sg == 0) Dec[k] = etot;
        __syncthreads();
        att::f32x16 o = {};
        int tau_q = mt * 32 + r32; asm volatile("" : "+v"(tau_q));
        { att::bf16x8 qr[4]; gla::afrag4(Qh, tau_q, hi, qr);
          att::f32x16 p0, p1; att::qkt(p0, p1, (const bf16*)Kt, qr, r32, hi);
#pragma unroll
          for (int r = 0; r < 16; ++r) { const int t0 = att::crow(r, hi), t1 = 32 + t0;
              const bool k0 = dir == 0 ? (t0 <= tau_q) : (t0 >= tau_q), k1 = dir == 0 ? (t1 <= tau_q) : (t1 >= tau_q);
              p0[r] = k0 ? p0[r] : 0.f; p1[r] = k1 ? p1[r] : 0.f; }
          att::bf16x8 pa0, pa1, pa2, pa3; att::pack_p(p0, p1, pa0, pa1, pa2, pa3);
          gla::pv_sel(d0, o, vbV, pa0, pa1, pa2, pa3);
          gla::pv_sel(d0, o, vbS, qr[0], qr[1], qr[2], qr[3]); }
#pragma unroll
        for (int r = 0; r < 16; ++r) S[r] *= Dec[mt * 32 + att::crow(r, hi)];
        { att::bf16x8 a[4]; gla::afrag4(KtT, mt * 32 + r32, hi, a); gla::pv_sel(d0, S, vbV, a[0], a[1], a[2], a[3]); }
        GAS bf16* op = (GAS bf16*)(OG + row0 * 512 + h * 128 + d0 * 32 + r32);
#pragma unroll
        for (int r = 0; r < 16; ++r) op[(size_t)(mt * 32 + att::crow(r, hi)) * 512] = (bf16)(att::cvtpk(o[r], 0.f) & 0xffffu);
        __syncthreads();
    }
}
__device__ __forceinline__ void p3_mixer(Frame& F, int l) {
    refresh(F);
    for (int ch = F.blk; ch < NBATCH * 8; ch += F.G) gla_chain(F, l, ch);
    att2::attn_stream(F, l);
}
__device__ __forceinline__ void p5_merge_all(Frame& F, int l) {
    refresh(F);
    const bf16* OD = (const bf16*)(F.ws + WS_OD); const bf16* OG = (const bf16*)(F.ws + WS_OG); const bf16* P = (const bf16*)(F.ws + WS_PROJ); bf16* MRG = (bf16*)(F.ws + WS_H);
    const float lam = ((const float*)(F.ws + WS_ROPE + 16384))[l]; const float omli = 1.f - lam_init_of(l);
    const float* subln = INP(14) + l * 128; const float* onorm = INP(15) + l * 128;
    const int h = F.lane >> 4, c0 = (F.lane & 15) * 8;
    const int rpw = (M + F.NGW - 1) / F.NGW, r0 = F.gw * rpw, r1 = (r0 + rpw < M) ? r0 + rpw : M;
    for (int r = r0; r < r1; ++r) {
        const v4u a = *(const v4u*)(OD + (size_t)r * DM + h * 256 + c0), bq = *(const v4u*)(OD + (size_t)r * DM + h * 256 + 128 + c0);
        const v4u gf = *(const v4u*)(OG + (size_t)r * 512 + h * 128 + c0), gbk = *(const v4u*)(OG + ((size_t)M + r) * 512 + h * 128 + c0);
        const v4u gt = *(const v4u*)(P + (size_t)r * NP + C_GG + h * 128 + c0);
        float d[8], e[8], g[8];
        d[0] = bflo(a.x) - lam * bflo(bq.x); d[1] = bfhi(a.x) - lam * bfhi(bq.x); d[2] = bflo(a.y) - lam * bflo(bq.y); d[3] = bfhi(a.y) - lam * bfhi(bq.y);
        d[4] = bflo(a.z) - lam * bflo(bq.z); d[5] = bfhi(a.z) - lam * bfhi(bq.z); d[6] = bflo(a.w) - lam * bflo(bq.w); d[7] = bfhi(a.w) - lam * bfhi(bq.w);
        e[0] = bflo(gf.x) + bflo(gbk.x); e[1] = bfhi(gf.x) + bfhi(gbk.x); e[2] = bflo(gf.y) + bflo(gbk.y); e[3] = bfhi(gf.y) + bfhi(gbk.y);
        e[4] = bflo(gf.z) + bflo(gbk.z); e[5] = bfhi(gf.z) + bfhi(gbk.z); e[6] = bflo(gf.w) + bflo(gbk.w); e[7] = bfhi(gf.w) + bfhi(gbk.w);
        g[0] = bflo(gt.x); g[1] = bfhi(gt.x); g[2] = bflo(gt.y); g[3] = bfhi(gt.y); g[4] = bflo(gt.z); g[5] = bfhi(gt.z); g[6] = bflo(gt.w); g[7] = bfhi(gt.w);
        float ss = 0.f, se = 0.f;
#pragma unroll
        for (int i = 0; i < 8; ++i) { ss += d[i] * d[i]; se += e[i] * e[i]; }
        ss = xadd<1>(ss); ss = xadd<2>(ss); ss = xadd<4>(ss); ss = xadd<8>(ss);
        se = xadd<1>(se); se = xadd<2>(se); se = xadd<4>(se); se = xadd<8>(se);
        const float sc = omli / sqrtf(ss * (1.f / 128.f) + EPS), se2 = 1.0f / sqrtf(se * (1.f / 128.f) + EPS);
#pragma unroll
        for (int i = 0; i < 8; ++i) { d[i] = d[i] * sc * subln[c0 + i]; e[i] = e[i] * se2 * onorm[c0 + i] * siluf(g[i]); }
        v4u w; w.x = pg8::cvt_pk_bf16(d[0], d[1]); w.y = pg8::cvt_pk_bf16(d[2], d[3]); w.z = pg8::cvt_pk_bf16(d[4], d[5]); w.w = pg8::cvt_pk_bf16(d[6], d[7]);
        *(v4u*)(MRG + (size_t)r * DM + h * 128 + c0) = w;
        v4u x; x.x = pg8::cvt_pk_bf16(e[0], e[1]); x.y = pg8::cvt_pk_bf16(e[2], e[3]); x.z = pg8::cvt_pk_bf16(e[4], e[5]); x.w = pg8::cvt_pk_bf16(e[6], e[7]);
        *(v4u*)(MRG + (size_t)r * DM + 512 + h * 128 + c0) = x;
    }
}

__device__ __forceinline__ float dpp_sum16(float v) {
    v += __int_as_float(__builtin_amdgcn_update_dpp(0, __float_as_int(v), 0xB1, 0xF, 0xF, true));
    v += __int_as_float(__builtin_amdgcn_update_dpp(0, __float_as_int(v), 0x4E, 0xF, 0xF, true));
    v += __int_as_float(__builtin_amdgcn_update_dpp(0, __float_as_int(v), 0x141, 0xF, 0xF, true));
    v += __int_as_float(__builtin_amdgcn_update_dpp(0, __float_as_int(v), 0x140, 0xF, 0xF, true));
    return v;
}
__device__ __forceinline__ float wave_sum2(float v) { v = dpp_sum16(v); v = xadd<16>(v); v = xadd<32>(v); return v; }
__device__ __forceinline__ float row_rinv2(const f32x4 (&v)[4]) {
    float s = 0.f;
#pragma unroll
    for (int j = 0; j < 4; ++j) s += (v[j][0] * v[j][0] + v[j][1] * v[j][1]) + (v[j][2] * v[j][2] + v[j][3] * v[j][3]);
    return __builtin_amdgcn_rsqf(wave_sum2(s) * (1.f / DM) + EPS);
}
__device__ __forceinline__ void ld_raw_bf16(const bf16* row, int lane, u32x2 (&v)[4]) {
#pragma unroll
    for (int j = 0; j < 4; ++j) v[j] = *(const u32x2*)(row + 4 * lane + 256 * j);
}
__device__ __forceinline__ f32x4 raw2f(u32x2 w) { return (f32x4){bflo(w.x), bfhi(w.x), bflo(w.y), bfhi(w.y)}; }
__device__ __forceinline__ void ld_vec(const float* p, int lane, f32x4 (&v)[4]) {
#pragma unroll
    for (int j = 0; j < 4; ++j) v[j] = *(const f32x4*)(p + 4 * lane + 256 * j);
}

__device__ __forceinline__ void p1_rows(Frame& F, int l) {
    refresh(F);
    const float* MOD = (const float*)(F.ws + WS_MOD);
    bf16* X = (bf16*)(F.ws + WS_X); bf16* H = (bf16*)(F.ws + WS_H); const bf16* F2 = (const bf16*)(F.ws + WS_F2);
    const int rpw = (M + F.NGW - 1) / F.NGW, r0 = F.gw * rpw, r1 = (r0 + rpw < M) ? r0 + rpw : M;
    if (r0 >= r1) return;
    const bool two = l > 0 && ((l - 1) & 1);
    f32x4 gpre[4], gpost[4], sh[4], sc[4], gt[4];
    ld_vec(INP(6) + l * DM, F.lane, gpre);
    if (l > 0) ld_vec(INP(9) + (l - 1) * DM, F.lane, gpost);
    int cur = -1;
    f32x4 xn[4]; u32x2 xr[4], fn[4], gn[4];
#define P1_ISSUE(r) do { const int b_ = (r) / TPB, p_ = (r) % TPB; \
        if (l == 0) ld_row_f32(p_ < CTX ? INP(2) + ((size_t)b_ * CTX + p_) * DM : INP(0) + ((size_t)b_ * SEQ + (p_ - CTX)) * DM, F.lane, xn); \
        else ld_raw_bf16(X + (size_t)(r) * DM, F.lane, xr); \
        if (l > 0) { ld_raw_bf16(F2 + (size_t)(r) * DM, F.lane, fn); if (two) ld_raw_bf16(F2 + ((size_t)M + (r)) * DM, F.lane, gn); } } while (0)
    P1_ISSUE(r0);
    for (int r = r0; r < r1; ++r) {
        f32x4 x[4]; u32x2 fr[4], gr[4];
#pragma unroll
        for (int j = 0; j < 4; ++j) { x[j] = (l == 0) ? xn[j] : raw2f(xr[j]); fr[j] = fn[j]; gr[j] = gn[j]; }
        if (r + 1 < r1) P1_ISSUE(r + 1);
        const int b = r / TPB, p = r % TPB, mrow = p < CTX ? 16 : b;
        if (mrow != cur) { cur = mrow; const float* modp = MOD + ((size_t)l * 17 + mrow) * 6144; ld_vec(modp, F.lane, sh); ld_vec(modp + 1024, F.lane, sc);
            if (l > 0) ld_vec(MOD + ((size_t)(l - 1) * 17 + mrow) * 6144 + 5 * 1024, F.lane, gt); }
        if (l > 0) {
            f32x4 f[4];
#pragma unroll
            for (int j = 0; j < 4; ++j) { f[j] = raw2f(fr[j]); if (two) f[j] = f[j] + raw2f(gr[j]); }
            const float rinv = row_rinv2(f);
#pragma unroll
            for (int j = 0; j < 4; ++j) x[j] = x[j] + gt[j] * (f[j] * rinv * gpost[j]);
        }
        st_row_bf16(X + (size_t)r * DM, F.lane, x);
        const float rinv = row_rinv2(x);
        f32x4 h[4];
#pragma unroll
        for (int j = 0; j < 4; ++j) h[j] = (x[j] * rinv * gpre[j]) * (sc[j] + 1.0f) + sh[j];
        st_row_bf16(H + (size_t)r * DM, F.lane, h);
    }
#undef P1_ISSUE
}
__device__ __forceinline__ void pf_final(Frame& F) {
    refresh(F);
    const float* MOD = (const float*)(F.ws + WS_MOD);
    const bf16* X = (const bf16*)(F.ws + WS_X); const bf16* F2 = (const bf16*)(F.ws + WS_F2);
    const int l = DEPTH - 1, NR = NBATCH * SEQ;
    const int rpw = (NR + F.NGW - 1) / F.NGW, i0 = F.gw * rpw, i1 = (i0 + rpw < NR) ? i0 + rpw : NR;
    if (i0 >= i1) return;
    f32x4 gpost[4], gt[4]; ld_vec(INP(9) + l * DM, F.lane, gpost);
    int cur = -1;
    u32x2 xn[4], fn[4], gn[4];
#define PF_ISSUE(i) do { const size_t r_ = (size_t)((i) / SEQ) * TPB + CTX + (i) % SEQ; ld_raw_bf16(X + r_ * DM, F.lane, xn); ld_raw_bf16(F2 + r_ * DM, F.lane, fn); ld_raw_bf16(F2 + ((size_t)M + r_) * DM, F.lane, gn); } while (0)
    PF_ISSUE(i0);
    for (int i = i0; i < i1; ++i) {
        f32x4 x[4], f[4];
#pragma unroll
        for (int j = 0; j < 4; ++j) { x[j] = raw2f(xn[j]); f[j] = raw2f(fn[j]) + raw2f(gn[j]); }
        if (i + 1 < i1) PF_ISSUE(i + 1);
        const int b = i / SEQ;
        if (b != cur) { cur = b; ld_vec(MOD + ((size_t)l * 17 + b) * 6144 + 5 * 1024, F.lane, gt); }
        const float rinv = row_rinv2(f);
#pragma unroll
        for (int j = 0; j < 4; ++j) x[j] = x[j] + gt[j] * (f[j] * rinv * gpost[j]);
        st_row_f32(F.A->out + (size_t)i * DM, F.lane, x);
    }
#undef PF_ISSUE
}
__device__ __forceinline__ void p7_rows(Frame& F, int l) {
    refresh(F);
    const float* MOD = (const float*)(F.ws + WS_MOD);
    bf16* X = (bf16*)(F.ws + WS_X); const bf16* Y = (const bf16*)(F.ws + WS_Y); bf16* H2 = (bf16*)(F.ws + WS_H2);
    const bool moe = l & 1; const int li = l >> 1;
    int* TOPE = (int*)(F.ws + WS_TOPE); int* LIDX = (int*)(F.ws + WS_LIDX); float* TOPW = (float*)(F.ws + WS_TOPW); int* BLKB = (int*)(F.ws + WS_BLKB);
    volatile LAS unsigned* LCNT = F.MISC + 16;
    LAS float* RT = (LAS float*)F.lds;
    if (moe) {
        const float* router = INP(20) + (size_t)li * DM * NE;
        if (F.tid < 8) LCNT[F.tid] = 0u;
        for (int i = F.tid; i < DM * NE / 4; i += 512) { const f32x4 q = *(const f32x4*)(router + 4 * i); const int c = i >> 1, e0 = (i & 1) * 4;
            RT[(e0 + 0) * DM + c] = q[0]; RT[(e0 + 1) * DM + c] = q[1]; RT[(e0 + 2) * DM + c] = q[2]; RT[(e0 + 3) * DM + c] = q[3]; }
        __syncthreads();
    }
    const bool lastl = (l == DEPTH - 1); const int NR = lastl ? NBATCH * SEQ : M;
#define P7_ROW(i) (lastl ? ((i) / SEQ) * TPB + CTX + (i) % SEQ : (i))
    const int rpw = (NR + F.NGW - 1) / F.NGW, r0 = F.gw * rpw, r1 = (r0 + rpw < NR) ? r0 + rpw : NR;
    if (r0 < r1) {
        f32x4 gpost[4], gpre[4], gt[4], sh[4], sc[4];
        ld_vec(INP(7) + l * DM, F.lane, gpost); ld_vec(INP(8) + l * DM, F.lane, gpre);
        int cur = -1;
        u32x2 xn[4], yn[4];
        ld_raw_bf16(X + (size_t)P7_ROW(r0) * DM, F.lane, xn); ld_raw_bf16(Y + (size_t)P7_ROW(r0) * DM, F.lane, yn);
        for (int ri = r0; ri < r1; ++ri) {
            const int r = P7_ROW(ri);
            f32x4 x[4], y[4];
#pragma unroll
            for (int j = 0; j < 4; ++j) { x[j] = raw2f(xn[j]); y[j] = raw2f(yn[j]); }
            if (ri + 1 < r1) { const int rn = P7_ROW(ri + 1); ld_raw_bf16(X + (size_t)rn * DM, F.lane, xn); ld_raw_bf16(Y + (size_t)rn * DM, F.lane, yn); }
            const int b = r / TPB, p = r % TPB, mrow = p < CTX ? 16 : b;
            if (mrow != cur) { cur = mrow; const float* modp = MOD + ((size_t)l * 17 + mrow) * 6144; ld_vec(modp + 2 * 1024, F.lane, gt); ld_vec(modp + 3 * 1024, F.lane, sh); ld_vec(modp + 4 * 1024, F.lane, sc); }
            const float ry = row_rinv2(y);
#pragma unroll
            for (int j = 0; j < 4; ++j) x[j] = x[j] + gt[j] * (y[j] * ry * gpost[j]);
            st_row_bf16(X + (size_t)r * DM, F.lane, x);
            const float rx = row_rinv2(x);
            f32x4 h[4];
#pragma unroll
            for (int j = 0; j < 4; ++j) h[j] = (x[j] * rx * gpre[j]) * (sc[j] + 1.0f) + sh[j];
            if constexpr (FFN_F8) {
#pragma unroll
                for (int j = 0; j < 4; ++j) *(unsigned*)((unsigned char*)H2 + (size_t)r * DM + 4 * F.lane + 256 * j) = pk4_f8(h[j][0], h[j][1], h[j][2], h[j][3]);
            } else st_row_bf16(H2 + (size_t)r * DM, F.lane, h);
            if (moe) {
                float lg[8];
#pragma unroll
                for (int e = 0; e < 8; ++e) lg[e] = 0.f;
#pragma unroll
                for (int j = 0; j < 4; ++j)
#pragma unroll
                    for (int e = 0; e < 8; ++e) { const f32x4 q = *(const LAS f32x4*)(RT + e * DM + 4 * F.lane + 256 * j); lg[e] += (h[j][0] * q[0] + h[j][1] * q[1]) + (h[j][2] * q[2] + h[j][3] * q[3]); }
#pragma unroll
                for (int e = 0; e < 8; ++e) lg[e] = wave_sum2(lg[e]);
                int e0 = 0; float v0 = lg[0];
#pragma unroll
                for (int e = 1; e < 8; ++e) if (lg[e] > v0) { v0 = lg[e]; e0 = e; }
                int e1 = -1; float v1 = -3.0e38f;
#pragma unroll
                for (int e = 0; e < 8; ++e) if (e != e0 && lg[e] > v1) { v1 = lg[e]; e1 = e; }
                const float ex = __expf(v1 - v0), w0 = 1.f / (1.f + ex), w1 = ex / (1.f + ex);
                if (F.lane == 0) {
                    const unsigned i0 = __hip_atomic_fetch_add((LAS unsigned*)&LCNT[e0], 1u, __ATOMIC_RELAXED, __HIP_MEMORY_SCOPE_WORKGROUP), i1 = __hip_atomic_fetch_add((LAS unsigned*)&LCNT[e1], 1u, __ATOMIC_RELAXED, __HIP_MEMORY_SCOPE_WORKGROUP);
                    TOPE[r] = e0 | (e1 << 8); LIDX[2 * r] = (int)i0; LIDX[2 * r + 1] = (int)i1; TOPW[2 * r] = w0; TOPW[2 * r + 1] = w1;
                }
            }
        }
    }
    if (moe) {
        __syncthreads();
        if (F.tid < 8) { const unsigned base = __hip_atomic_fetch_add((unsigned*)((gu32*)F.ws + CW_CNT + 64 * li + F.tid), LCNT[F.tid], __ATOMIC_RELAXED, __HIP_MEMORY_SCOPE_AGENT); BLKB[F.blk * 8 + F.tid] = (int)base; }
    }
#undef P7_ROW
}
__device__ __forceinline__ void moe_offsets(Frame& F, int li, int (&cnt)[8], int (&off)[9]) {
    off[0] = 0;
#pragma unroll
    for (int e = 0; e < 8; ++e) { cnt[e] = (int)__hip_atomic_load((unsigned*)(((gu32*)F.ws) + CW_CNT + 64 * li + e), __ATOMIC_RELAXED, __HIP_MEMORY_SCOPE_AGENT); off[e + 1] = off[e] + ((cnt[e] + 255) & ~255); }
}
__device__ __forceinline__ void p7b_gather(Frame& F, int l) {
    refresh(F);
    const int li = l >> 1; int cnt[8], off[9]; moe_offsets(F, li, cnt, off);
    const bf16* H2 = (const bf16*)(F.ws + WS_H2); bf16* HG = (bf16*)(F.ws + WS_HG);
    const int* TOPE = (const int*)(F.ws + WS_TOPE); const int* LIDX = (const int*)(F.ws + WS_LIDX); const float* TOPW = (const float*)(F.ws + WS_TOPW); const int* BLKB = (const int*)(F.ws + WS_BLKB);
    int* RMAP = (int*)(F.ws + WS_RMAP); float* ROWW = (float*)(F.ws + WS_ROWW);
    constexpr int RB = FFN_F8 ? DM : 2 * DM, LB = RB / 64;
    const unsigned char* H2b = (const unsigned char*)H2; unsigned char* HGb = (unsigned char*)HG;
    const bool lastl = (l == DEPTH - 1); const int NR = lastl ? NBATCH * SEQ : M;
    const int rpw = (NR + F.NGW - 1) / F.NGW, r0 = F.gw * rpw, r1 = (r0 + rpw < NR) ? r0 + rpw : NR;
    for (int ri = r0; ri < r1; ++ri) {
        const int r = lastl ? (ri / SEQ) * TPB + CTX + ri % SEQ : ri;
        const int te = TOPE[r];
        v4u a, bq = {0u, 0u, 0u, 0u}; a = *(const v4u*)(H2b + (size_t)r * RB + F.lane * LB); if constexpr (!FFN_F8) bq = *(const v4u*)(H2b + (size_t)r * RB + F.lane * LB + 16);
#pragma unroll
        for (int s = 0; s < 2; ++s) {
            const int e = (te >> (8 * s)) & 0xff;
            int o = 0;
#pragma unroll
            for (int q = 0; q < 8; ++q) o = (q == e) ? off[q] : o;
            const int pos = o + BLKB[F.blk * 8 + e] + LIDX[2 * r + s];
            *(v4u*)(HGb + (size_t)pos * RB + F.lane * LB) = a; if constexpr (!FFN_F8) *(v4u*)(HGb + (size_t)pos * RB + F.lane * LB + 16) = bq;
            if (F.lane == 0) { RMAP[pos] = r | (s << 30); ROWW[pos] = TOPW[2 * r + s]; }
        }
    }
#pragma unroll
    for (int e = 0; e < 8; ++e) {
        const int npad = off[e + 1] - off[e] - cnt[e];
        for (int i = F.gw; i < npad; i += F.NGW) { const int pos = off[e] + cnt[e] + i; const unsigned zz = (unsigned)F.z; const v4u z = {zz, zz, zz, zz};
            *(v4u*)(HGb + (size_t)pos * RB + F.lane * LB) = z; if constexpr (!FFN_F8) *(v4u*)(HGb + (size_t)pos * RB + F.lane * LB + 16) = z;
            if (F.lane == 0) { RMAP[pos] = -1; ROWW[pos] = 0.f; } }
    }
}

__global__ void __launch_bounds__(NWAVES * 64, 2) mk_fwd(Args args) {
    extern __shared__ __attribute__((aligned(16))) unsigned char lds[];
    Frame F;
    F.lds = (LAS unsigned char*)lds;
    F.MISC = (volatile LAS unsigned*)(F.lds + MISC_OFF);
    F.tid = threadIdx.x; F.lane = F.tid & 63; F.wave = __builtin_amdgcn_readfirstlane(F.tid >> 6); F.wv = F.wave;
    F.G = gridDim.x; F.blk = blockIdx.x; F.gw = F.blk * NWAVES + F.wave; F.NGW = F.G * NWAVES;
    F.ws = args.ws;
    F.A = &args;
    for (int u = F.tid; u < 128; u += NWAVES * 64) F.MISC[u] = 0u;
    __syncthreads();
    { XcdBarrier b0 = xcd_barrier_post((unsigned*)F.ws + CW_BAR, F.MISC + 8); (void)b0; }
#define GRID_BAR() do { XcdBarrier b_; b_.bar = (unsigned*)F.ws + CW_BAR; b_.x = xb_xcc_id(); b_.st = F.MISC + 8; refresh(F); xcd_barrier(b_, F.tid == 0); } while (0)

    p0_mod(F); p0_misc(F); convert_weights(F, 0);
    GRID_BAR();
    for (int l = 0; l < DEPTH; ++l) {
        const bool moe = l & 1; const int li = l >> 1;
        { unsigned char* wsp = args.ws; asm volatile("" : "+s"(wsp)); F.ws = wsp; }
        p1_rows(F, l);
        if (l > 0) convert_weights(F, l);
        GRID_BAR();
        {
            refresh(F);
            pg8::Gemm g{(const pg8::bf16_t*)(F.ws + WS_H), (const pg8::bf16_t*)(F.ws + WS_WIN), M, NP, DM};
            pg8::StaticOrder S; S.init(M, NP, F.G, F.blk);
            pg8::EpiProj E{(pg8::bf16_t*)(F.ws + WS_PROJ), (const float*)(F.ws + WS_ROPE), (const float*)(F.ws + WS_ROPE) + 1024, (unsigned*)F.ws + CW_KMX + 256 * l};
            pg8::gemm_phase<pg8::EpiProj, pg8::StaticOrder, true, true>(F.lds, g, S, E, F.wave);
        }
        GRID_BAR();
        p3_mixer(F, l);
        GRID_BAR();
        p5_merge_all(F, l);
        GRID_BAR();
        {
            refresh(F);
            pg8::Gemm g{(const pg8::bf16_t*)(F.ws + WS_H), (const pg8::bf16_t*)(F.ws + WS_WOUT), M, DM, DM};
            const int lastl = (l == DEPTH - 1);
            pg8::LatOrder S; S.S.init(lastl ? NBATCH * SEQ : M, DM, F.G, F.blk); S.lat = lastl;
            pg8::EpiF32 E{(pg8::bf16_t*)(F.ws + WS_Y)};
            pg8::gemm_phase<pg8::EpiF32, pg8::LatOrder, true, true>(F.lds, g, S, E, F.wave);
        }
        GRID_BAR();
        p7_rows(F, l);
        GRID_BAR();
        if (moe) { p7b_gather(F, l); GRID_BAR(); }
        int ntiles = M / 256;
        {
            refresh(F);
            LAS int* texp = (LAS int*)(F.lds + TEXP_OFF);
            if (moe) { int cnt[8], off[9]; moe_offsets(F, li, cnt, off); ntiles = off[8] >> 8;
                for (int t = F.tid; t < ntiles; t += 512) { int e = 0;
#pragma unroll
                    for (int q = 1; q < 8; ++q) e += ((t << 8) >= off[q]) ? 1 : 0;
                    texp[t] = e; } }
            else { for (int t = F.tid; t < ntiles; t += 512) texp[t] = 0; }
            __syncthreads();
        }
        {
            refresh(F);
            pg8::Gemm g{(const pg8::bf16_t*)(F.ws + (moe ? WS_HG : WS_H2)), (const pg8::bf16_t*)(F.ws + WS_WUP), ntiles * 256, 2 * DFF, FFN_F8 ? DM / 2 : DM};
            pg8::GroupedOrder S; S.S.init(ntiles * 256, 2 * DFF, F.G, F.blk); S.texp = (const LAS int*)(F.lds + TEXP_OFF); S.nN = 22;
            pg8::EpiSwiglu E{(pg8::bf16_t*)(F.ws + WS_U)};
            pg8::gemm_phase<pg8::EpiSwiglu, pg8::GroupedOrder, true, true, FFN_F8 != 0>(F.lds, g, S, E, F.wave);
        }
        GRID_BAR();
        {
            refresh(F);
            pg8::Gemm g{(const pg8::bf16_t*)(F.ws + WS_U), (const pg8::bf16_t*)(F.ws + WS_WDN), ntiles * 256, DM, FFN_F8 ? DFF / 2 : DFF};
            pg8::GroupedOrder S; S.S.init(ntiles * 256, DM, F.G, F.blk); S.texp = (const LAS int*)(F.lds + TEXP_OFF); S.nN = 4;
            pg8::EpiDown E{(pg8::bf16_t*)(F.ws + WS_F2), (const int*)(F.ws + WS_RMAP), (const float*)(F.ws + WS_ROWW), moe ? 0 : 1};
            pg8::gemm_phase<pg8::EpiDown, pg8::GroupedOrder, true, true, FFN_F8 != 0>(F.lds, g, S, E, F.wave);
        }
        GRID_BAR();
    }
    pf_final(F);
}

extern "C" void kernel_launch(void* const* d_in, const int* in_sizes, int n_in, void* d_out, int out_size, void* d_ws, size_t ws_size, hipStream_t stream) {
    static int grid = 0;
    if (grid == 0) {
        if (n_in != 24 || out_size != NBATCH * SEQ * DM || ws_size < WS_END) { fprintf(stderr, "kernel_launch: unexpected shapes or workspace (%d inputs, out %d, ws %zu < %zu)\n", n_in, out_size, ws_size, (size_t)WS_END); grid = -1; return; }
        int dev = 0, cus = 0, per_cu = 0;
        if (hipGetDevice(&dev) != hipSuccess || hipDeviceGetAttribute(&cus, hipDeviceAttributeMultiprocessorCount, dev) != hipSuccess) { grid = -1; return; }
        if (hipFuncSetAttribute((const void*)mk_fwd, hipFuncAttributeMaxDynamicSharedMemorySize, LDS_BYTES) != hipSuccess) { grid = -1; return; }
        if (hipOccupancyMaxActiveBlocksPerMultiprocessor(&per_cu, (const void*)mk_fwd, NWAVES * 64, LDS_BYTES) != hipSuccess || per_cu < 1) { fprintf(stderr, "kernel_launch: occupancy query says %d\n", per_cu); }
        (void)hipGetLastError();
        grid = cus;
    }
    if (grid < 0) return;
    if (hipMemsetAsync((char*)d_ws + WS_CTL, 0, CTL_ZERO_BYTES, stream) != hipSuccess) return;
    Args a{};
    for (int i = 0; i < 24; ++i) a.in[i] = (const float*)d_in[i];
    a.out = (float*)d_out; a.ws = (unsigned char*)d_ws;
    hipLaunchKernelGGL(mk_fwd, dim3(grid), dim3(NWAVES * 64), LDS_BYTES, stream, a);
}
```

```cpp
#include <hip/hip_runtime.h>
#include <cstdio>
#include <cstdint>
namespace pg8 {
#define PG8_LAS __attribute__((address_space(3)))
typedef unsigned short bf16_t;
__device__ __forceinline__ int lane_id_opaque() { int l; asm volatile("v_mbcnt_lo_u32_b32 %0, -1, 0\n\tv_mbcnt_hi_u32_b32 %0, -1, %0" : "=v"(l)); return l; }
typedef short bf16x8 __attribute__((ext_vector_type(8)));
typedef float f32x4 __attribute__((ext_vector_type(4)));
typedef unsigned u32x4 __attribute__((ext_vector_type(4)));
constexpr int BM = 256, BK = 64, HALF = 128, HTB = HALF * BK * 2  , STAGE_BYTES = 8 * HTB, NXCD = 8, WGM = 8;

__host__ __device__ __forceinline__ int lds_byte(int r, int c) { const int st = (r >> 4) * 2 + (c >> 5), rr = r & 15, cc = c & 31, ob = rr * 64 + cc * 2; return st * 1024 + (ob ^ (((ob >> 9) & 1) << 5)); }
__host__ __device__ __forceinline__ void stage_rc(int b, int& R, int& C) { const int st = b / 1024, sb = b % 1024, swz = sb ^ (((sb >> 9) & 1) << 5); R = (st >> 1) * 16 + swz / 64; C = (st & 1) * 32 + (swz % 64) / 2; }
__host__ __device__ __forceinline__ int perm32(int rho) { const int n = rho >> 4, i = rho & 15; return 8 * (i >> 2) + 4 * n + (i & 3); }

struct Unit { int pm, pn; };
struct Gemm { const bf16_t* A; const bf16_t* Bt; int M, N, K; };

struct StaticOrder {
    int nM, nN, nwg, G, c;
    __host__ __device__ void init(int M, int N, int G_, int c_) { nM = M / BM; nN = N / BM; nwg = nM * nN; G = G_; c = c_; }
    __host__ __device__ bool next(int i, Unit& u) const {
        const long L = (long)i * G + c; if (L >= nwg) return false;
        int wgid = (int)L; { const int q = nwg / NXCD, r = nwg % NXCD, xcd = wgid % NXCD, off = wgid / NXCD; wgid = (xcd < r ? xcd * (q + 1) : r * (q + 1) + (xcd - r) * q) + off; }
        const int nig = WGM * nN, gid = wgid / nig, fm = gid * WGM, gsz = (nM - fm) < WGM ? (nM - fm) : WGM;
        u.pm = fm + ((wgid % nig) % gsz); u.pn = (wgid % nig) / gsz; return true;
    }
    __device__ __forceinline__ void a_ready(const Unit&) const {}
    __device__ __forceinline__ void done(const Unit&) const {}
};

__device__ __forceinline__ unsigned cvt_pk_bf16(float lo, float hi) { unsigned r; asm volatile("v_cvt_pk_bf16_f32 %0, %1, %2" : "=v"(r) : "v"(lo), "v"(hi)); return r; }
typedef float f32x2 __attribute__((ext_vector_type(2)));
template <class Epi, class Sched, bool ALIGN_EPI = false, bool SP2 = false, bool F8 = false>
__device__ __forceinline__ void gemm_phase(PG8_LAS unsigned char* lds, const Gemm g, const Sched& S, const Epi& E, const int wv  ) {
    int tid_ = wv * 64 + lane_id_opaque();
    const int tid = tid_, wid = __builtin_amdgcn_readfirstlane(tid >> 6), lane = tid & 63, wr = wid >> 2, wc = wid & 3, fr = lane & 15, fq = lane >> 4;
    const int K = g.K, nt = K / BK;
    unsigned voffA[2], voffB[2];
#pragma unroll
    for (int i = 0; i < 2; ++i) { int R, C; stage_rc(tid * 16 + i * 8192, R, C); const int Rb = Epi::PERM ? ((R & ~31) + perm32(R & 31)) : R;
        voffA[i] = (unsigned)(R * K + C) * 2u; voffB[i] = (unsigned)(Rb * K + C) * 2u; }
    const size_t kstep = (size_t)(BK * 2);
    const size_t hstep = (size_t)HALF * K * 2;
    const size_t tstep = 2 * hstep;
    const unsigned ldsw = (unsigned)wid * 1024u;
    const int aoff = lds_byte(wr * 64 + fr, fq * 8), boff = lds_byte(wc * 32 + fr, fq * 8);
#define PG8_SA(b, h) (((b) * 2 + (h)) * HTB)
#define PG8_SB(b, h) ((4 + (b) * 2 + (h)) * HTB)
#define PG8_STAGE(bufoff, gbase, voff) do { _Pragma("unroll") for (int _i = 0; _i < 2; ++_i) \
        __builtin_amdgcn_global_load_lds((const __attribute__((address_space(1))) unsigned*)((const __attribute__((address_space(1))) char*)(gbase) + (voff)[_i]), (PG8_LAS unsigned*)(lds + (bufoff) + ldsw + _i * 8192), 16, 0, 0); } while (0)
#define PG8_LDA(dst, b, h) do { _Pragma("unroll") for (int m = 0; m < 4; ++m) _Pragma("unroll") for (int k = 0; k < 2; ++k) dst[m][k] = *(const PG8_LAS bf16x8*)(lds + PG8_SA(b, h) + aoff + m * 2048 + k * 1024); } while (0)
#define PG8_LDB(dst, b, h) do { _Pragma("unroll") for (int n = 0; n < 2; ++n) _Pragma("unroll") for (int k = 0; k < 2; ++k) dst[n][k] = *(const PG8_LAS bf16x8*)(lds + PG8_SB(b, h) + boff + n * 2048 + k * 1024); } while (0)
#define PG8_MMA(ai, bj, At, Bt) do { if constexpr (F8) __builtin_amdgcn_sched_barrier(0); __builtin_amdgcn_s_setprio(1); _Pragma("unroll") for (int m = 0; m < 4; ++m) _Pragma("unroll") for (int n = 0; n < 2; ++n) { \
        if constexpr (F8) { typedef int i32x4_ __attribute__((ext_vector_type(4))); \
            acc[ai][bj][m][n] = __builtin_amdgcn_mfma_scale_f32_16x16x128_f8f6f4(__builtin_shufflevector(__builtin_bit_cast(i32x4_, Bt[n][0]), __builtin_bit_cast(i32x4_, Bt[n][1]), 0, 1, 2, 3, 4, 5, 6, 7), \
                __builtin_shufflevector(__builtin_bit_cast(i32x4_, At[m][0]), __builtin_bit_cast(i32x4_, At[m][1]), 0, 1, 2, 3, 4, 5, 6, 7), acc[ai][bj][m][n], 0, 0, 0, 0x7f7f7f7f, 0, 0x7f7f7f7f); } \
        else { _Pragma("unroll") for (int k = 0; k < 2; ++k) acc[ai][bj][m][n] = __builtin_amdgcn_mfma_f32_16x16x32_bf16(Bt[n][k], At[m][k], acc[ai][bj][m][n], 0, 0, 0); } } \
        __builtin_amdgcn_s_setprio(0); if constexpr (F8) __builtin_amdgcn_sched_barrier(0); } while (0)
#define PG8_WAIT_V(n) asm volatile("s_waitcnt vmcnt(" #n ")" ::: "memory")
#define PG8_WAIT_L(n) asm volatile("s_waitcnt lgkmcnt(" #n ")" ::: "memory")
#define PG8_BAR __builtin_amdgcn_s_barrier()
#define PG8_SCHED __builtin_amdgcn_sched_barrier(0)
    Unit cur, nxt; int ui = 0;
    if (!S.next(0, cur)) return;
    f32x4 acc[2][2][4][2];
#pragma unroll
    for (int a = 0; a < 2; ++a)
#pragma unroll
        for (int b = 0; b < 2; ++b)
#pragma unroll
            for (int m = 0; m < 4; ++m)
#pragma unroll
                for (int n = 0; n < 2; ++n) acc[a][b][m][n] = (f32x4){0.f, 0.f, 0.f, 0.f};
    bf16x8 At[4][2], B0[2][2], B1[2][2];
    const char* cA = (const char*)g.A + (size_t)cur.pm * tstep; const char* cB = (const char*)g.Bt + (size_t)cur.pn * tstep;
    S.a_ready(cur);
    if constexpr (SP2) {
        PG8_STAGE(PG8_SB(0, 0), cB, voffB); PG8_STAGE(PG8_SB(0, 1), cB + hstep, voffB); PG8_STAGE(PG8_SA(0, 0), cA, voffA); PG8_STAGE(PG8_SA(0, 1), cA + hstep, voffA);
        if (wr == 1) PG8_BAR;
        PG8_WAIT_V(2); PG8_BAR;
        PG8_STAGE(PG8_SB(1, 0), cB + kstep, voffB); PG8_STAGE(PG8_SA(1, 0), cA + kstep, voffA); PG8_STAGE(PG8_SB(1, 1), cB + hstep + kstep, voffB);
        PG8_WAIT_V(6); PG8_BAR;
    } else {
        PG8_STAGE(PG8_SB(0, 0), cB, voffB); PG8_STAGE(PG8_SA(0, 0), cA, voffA); PG8_STAGE(PG8_SB(0, 1), cB + hstep, voffB); PG8_STAGE(PG8_SA(0, 1), cA + hstep, voffA);
        if (wr == 1) PG8_BAR;
        PG8_WAIT_V(4); PG8_BAR;
        PG8_STAGE(PG8_SB(1, 0), cB + kstep, voffB); PG8_STAGE(PG8_SA(1, 0), cA + kstep, voffA); PG8_STAGE(PG8_SB(1, 1), cB + hstep + kstep, voffB);
        PG8_WAIT_V(6); PG8_BAR;
    }
    for (;;) {
        const bool has_next = S.next(ui + 1, nxt);
        const char* nA = has_next ? (const char*)g.A + (size_t)nxt.pm * tstep : cA; const char* nB = has_next ? (const char*)g.Bt + (size_t)nxt.pn * tstep : cB;
        for (int t = 0; t < nt; t += 2) {
            const bool last = (t == nt - 2);
            const char* a1 = cA + (size_t)(t + 1) * kstep;
            const char* a2 = last ? nA : cA + (size_t)(t + 2) * kstep; const char* b2 = last ? nB : cB + (size_t)(t + 2) * kstep;
            const char* a3 = a2 + kstep; const char* b3 = b2 + kstep;
            if (last && has_next) S.a_ready(nxt);
            if constexpr (SP2) {
            PG8_LDB(B0, 0, 0); PG8_LDB(B1, 0, 1); PG8_SCHED; PG8_LDA(At, 0, 0); PG8_STAGE(PG8_SA(1, 1), a1 + hstep, voffA);
            PG8_WAIT_V(8); PG8_WAIT_L(0); PG8_BAR; PG8_MMA(0, 0, At, B0); PG8_MMA(0, 1, At, B1); PG8_BAR; PG8_SCHED;
            PG8_LDA(At, 0, 1); PG8_STAGE(PG8_SB(0, 0), b2, voffB); PG8_STAGE(PG8_SB(0, 1), b2 + hstep, voffB); PG8_STAGE(PG8_SA(0, 0), a2, voffA);
            PG8_WAIT_V(8); PG8_WAIT_L(0); PG8_BAR; PG8_MMA(1, 0, At, B0); PG8_MMA(1, 1, At, B1); PG8_BAR; PG8_SCHED;
            PG8_LDB(B0, 1, 0); PG8_LDB(B1, 1, 1); PG8_SCHED; PG8_LDA(At, 1, 0); PG8_STAGE(PG8_SA(0, 1), a2 + hstep, voffA);
            PG8_WAIT_V(8); PG8_WAIT_L(0); PG8_BAR; PG8_MMA(0, 0, At, B0); PG8_MMA(0, 1, At, B1); PG8_BAR; PG8_SCHED;
            PG8_LDA(At, 1, 1); PG8_STAGE(PG8_SB(1, 0), b3, voffB); PG8_STAGE(PG8_SB(1, 1), b3 + hstep, voffB); PG8_STAGE(PG8_SA(1, 0), a3, voffA);
            PG8_WAIT_V(8); PG8_WAIT_L(0); PG8_BAR; PG8_MMA(1, 0, At, B0); PG8_MMA(1, 1, At, B1); PG8_BAR; PG8_SCHED;
            } else {
            PG8_LDB(B0, 0, 0); PG8_SCHED; PG8_LDA(At, 0, 0); PG8_STAGE(PG8_SA(1, 1), a1 + hstep, voffA);
            PG8_WAIT_L(8); PG8_BAR; PG8_WAIT_L(0); PG8_MMA(0, 0, At, B0); PG8_BAR; PG8_SCHED;
            PG8_LDB(B1, 0, 1); PG8_STAGE(PG8_SB(0, 0), b2, voffB);
            PG8_BAR; PG8_WAIT_L(0); PG8_MMA(0, 1, At, B1); PG8_BAR;
            PG8_LDA(At, 0, 1); PG8_STAGE(PG8_SA(0, 0), a2, voffA);
            PG8_BAR; PG8_WAIT_L(0); PG8_MMA(1, 0, At, B0); PG8_BAR; PG8_SCHED;
            PG8_STAGE(PG8_SB(0, 1), b2 + hstep, voffB);
            PG8_WAIT_V(6); PG8_BAR; PG8_MMA(1, 1, At, B1); PG8_BAR;
            PG8_LDB(B0, 1, 0); PG8_SCHED; PG8_LDA(At, 1, 0); PG8_STAGE(PG8_SA(0, 1), a2 + hstep, voffA);
            PG8_WAIT_L(8); PG8_BAR; PG8_WAIT_L(0); PG8_MMA(0, 0, At, B0); PG8_BAR; PG8_SCHED;
            PG8_LDB(B1, 1, 1); PG8_STAGE(PG8_SB(1, 0), b3, voffB);
            PG8_BAR; PG8_WAIT_L(0); PG8_MMA(0, 1, At, B1); PG8_BAR;
            PG8_LDA(At, 1, 1); PG8_STAGE(PG8_SA(1, 0), a3, voffA);
            PG8_BAR; PG8_WAIT_L(0); PG8_MMA(1, 0, At, B0); PG8_BAR; PG8_SCHED;
            PG8_STAGE(PG8_SB(1, 1), b3 + hstep, voffB);
            PG8_WAIT_V(6); PG8_BAR; PG8_MMA(1, 1, At, B1); PG8_BAR;
            }
        }
        if constexpr (ALIGN_EPI) { if (wr == 0) PG8_BAR; }
        if constexpr (!Epi::AFTER_DRAIN) { const int t2_ = lane_id_opaque(); const int fr_ = t2_ & 15, fq_ = (t2_ & 63) >> 4;
            E(acc, cur, wr, wc, fr_, fq_); S.done(cur); }
        if (!has_next) break;
#pragma unroll
        for (int a = 0; a < 2; ++a)
#pragma unroll
            for (int b = 0; b < 2; ++b)
#pragma unroll
                for (int m = 0; m < 4; ++m)
#pragma unroll
                    for (int n = 0; n < 2; ++n) acc[a][b][m][n] = (f32x4){0.f, 0.f, 0.f, 0.f};
        cur = nxt; cA = nA; cB = nB; ++ui;
        if constexpr (ALIGN_EPI) { if (wr == 1) PG8_BAR; }
    }
    PG8_WAIT_V(0);
    if constexpr (!ALIGN_EPI) { if (wr == 0) PG8_BAR; }
    PG8_BAR;
    if constexpr (Epi::AFTER_DRAIN) { E.fused(acc, cur, wr, wc, fr, fq, lds, wid, lane); S.done(cur); }
#undef PG8_SA
#undef PG8_SB
#undef PG8_STAGE
#undef PG8_LDA
#undef PG8_LDB
#undef PG8_MMA
#undef PG8_WAIT_V
#undef PG8_WAIT_L
#undef PG8_BAR
#undef PG8_SCHED
}
}
#define GAS __attribute__((address_space(1)))
#define LAS __attribute__((address_space(3)))
typedef unsigned short bf16;
typedef unsigned v4u __attribute__((ext_vector_type(4)));
typedef float f32x4 __attribute__((ext_vector_type(4)));
typedef short bf16x8 __attribute__((ext_vector_type(8)));
typedef GAS unsigned gu32;
typedef GAS unsigned long long gu64;
#define RLX_AGENT __ATOMIC_RELAXED, __HIP_MEMORY_SCOPE_AGENT
#define LDS_WAIT() asm volatile("s_waitcnt lgkmcnt(0)" ::: "memory")
#define VM_WAIT() asm volatile("s_waitcnt vmcnt(0)" ::: "memory")
__device__ __forceinline__ unsigned long long rt() { return __builtin_amdgcn_s_memrealtime(); }
__device__ __forceinline__ unsigned f2bf(float f) { unsigned u = __builtin_bit_cast(unsigned, f); return (u + 0x7fffu + ((u >> 16) & 1u)) >> 16; }
__device__ __forceinline__ unsigned pk2(float lo, float hi) { return f2bf(lo) | (f2bf(hi) << 16); }

#define XB_TMO      128
#define XB_XCNT(j)  (256  + 64 * (j))
#define XB_XSUB(j)  (1280 + 64 * (j))
#define XB_XGEN(j)  (2304 + 64 * (j))
#define XB_TOP      3328
#define XB_TOPGEN   3392
#define XCD_BAR_WORDS 3456
#define XB_SPIN_CAP (1u << 18)

__device__ __forceinline__ unsigned xb_ld(unsigned* p)              { return __hip_atomic_load(p, __ATOMIC_RELAXED, __HIP_MEMORY_SCOPE_AGENT); }
__device__ __forceinline__ unsigned xb_add(unsigned* p, unsigned v) { return __hip_atomic_fetch_add(p, v, __ATOMIC_RELAXED, __HIP_MEMORY_SCOPE_AGENT); }
__device__ __forceinline__ unsigned xb_xcc_id() { return (unsigned)__builtin_amdgcn_s_getreg((3 << 11) | 20) & 0xFu; }
#define XB_SPIN(cond, bar) do { unsigned _sp = 0; while (cond) { __builtin_amdgcn_s_sleep(1); \
    if ((++_sp & 255u) == 0u) { if (xb_ld(&(bar)[XB_TMO])) break; if (_sp > XB_SPIN_CAP) { atomicAdd(&(bar)[XB_TMO], 1u); break; } } } } while (0)

struct XcdBarrier {
    unsigned* bar; unsigned x;
    volatile LAS unsigned* st;
};

__device__ __forceinline__ XcdBarrier xcd_barrier_post(unsigned* bar, volatile LAS unsigned* st) {
    XcdBarrier b; b.bar = bar; b.x = xb_xcc_id(); b.st = st;
    if (threadIdx.x == 0) (void)xb_add(&bar[XB_XCNT(b.x)], 1u);
    return b;
}
__device__ __forceinline__ void xcd_barrier_complete(unsigned* bar, unsigned x, unsigned& nloc, unsigned& nx) {
    const unsigned G = gridDim.x * gridDim.y * gridDim.z;
    unsigned sum, cnt, mine, sp = 0u;
    for (;;) {
        sum = 0u; cnt = 0u; mine = 0u;
#pragma unroll
        for (unsigned j = 0; j < 16; ++j) { const unsigned c = xb_ld(&bar[XB_XCNT(j)]); sum += c; cnt += (c > 0u) ? 1u : 0u; mine = (j == x) ? c : mine; }
        if (sum == G) break;
        __builtin_amdgcn_s_sleep(1);
        if ((++sp & 255u) == 0u) { if (xb_ld(&bar[XB_TMO])) break; if (sp > XB_SPIN_CAP) { atomicAdd(&bar[XB_TMO], 1u); break; } }
    }
    nloc = mine > 0u ? mine : 1u; nx = cnt > 0u ? cnt : 1u;
}

__device__ __forceinline__ void xcd_barrier(const XcdBarrier& b, const bool leader  ) {
    asm volatile("s_waitcnt vmcnt(0)" ::: "memory");
    __syncthreads();
    if (leader) {
        unsigned* bar = b.bar; asm volatile("" : "+s"(bar));
        __builtin_amdgcn_s_waitcnt(0);
        unsigned nloc = b.st[0], nx = b.st[1];
        if (nloc == 0u) { xcd_barrier_complete(bar, b.x, nloc, nx); b.st[0] = nloc; b.st[1] = nx; }
        const unsigned old = xb_add(&bar[XB_XSUB(b.x)], 1u);
        const unsigned gen = old / nloc;
        if (old + 1u == (gen + 1u) * nloc) {
            __builtin_amdgcn_fence(__ATOMIC_RELEASE, "agent");
            asm volatile("s_waitcnt vmcnt(0)" ::: "memory");
            const unsigned og = xb_add(&bar[XB_TOP], 1u);
            const unsigned tg = og / nx;
            if (og + 1u == (tg + 1u) * nx) xb_add(&bar[XB_TOPGEN], 1u);
            else XB_SPIN(xb_ld(&bar[XB_TOPGEN]) == tg, bar);
            __builtin_amdgcn_fence(__ATOMIC_ACQUIRE, "agent");
            xb_add(&bar[XB_XGEN(b.x)], 1u);
            asm volatile("s_waitcnt vmcnt(0)" ::: "memory");
        } else {
            XB_SPIN(xb_ld(&bar[XB_XGEN(b.x)]) == gen, bar);
            __builtin_amdgcn_fence(__ATOMIC_ACQUIRE, "agent");
            asm volatile("s_waitcnt vmcnt(0)" ::: "memory");
        }
    }
    __syncthreads();
}

#ifndef FFN_F8
#define FFN_F8 1
#endif
constexpr int NWAVES = 8;
constexpr float W8S = 32.f, U8S = 4.f;
constexpr int DM = 1024, NBATCH = 16, SEQ = 2048, CTX = 256, TPB = SEQ + CTX, M = NBATCH * TPB;
constexpr int DEPTH = 4, NIN = 3104, NP = 3328, DFF = 2816, NE = 8;
constexpr int MP = 2 * M + NE * 256;
constexpr int C_Q = 0, C_K = 512, C_V = 1024, C_GQ = 1536, C_GK = 1792, C_GV = 2048, C_GG = 2560, C_GLR = 3072;
constexpr float EPS = 1e-6f;
constexpr float C2 = 0.125f * 1.4426950408889634f;
constexpr int NCH = TPB / 64;
constexpr int NGLA = NBATCH * 4 * 2 * NCH;

constexpr size_t MiB = 1u << 20;
constexpr size_t WS_CTL = 0, CTL_ZERO_BYTES = 1 * MiB;
constexpr size_t WS_MOD = 1 * MiB;
constexpr size_t WS_ROPE = 3 * MiB;
constexpr size_t WS_TOPE = 4 * MiB;
constexpr size_t WS_LIDX = WS_TOPE + 160 * 1024;
constexpr size_t WS_TOPW = WS_LIDX + 320 * 1024;
constexpr size_t WS_BLKB = WS_TOPW + 320 * 1024;
constexpr size_t WS_RMAP = WS_BLKB + 64 * 1024;
constexpr size_t WS_ROWW = WS_RMAP + 320 * 1024;
static_assert(WS_ROWW + 320 * 1024 <= 6 * MiB, "small tables");
constexpr size_t WS_X = 6 * MiB;
constexpr size_t WS_WIN = 150 * MiB;
constexpr size_t WS_WOUT = WS_WIN + 13 * MiB / 2;
constexpr size_t WS_WUP = WS_WOUT + 2 * MiB;
constexpr size_t WS_WDN = WS_WUP + 88 * MiB;
constexpr size_t WS_D = 291 * MiB;
static_assert(WS_WDN + 44 * MiB <= WS_D, "weights");
constexpr size_t WS_PROJ = WS_D;
constexpr size_t WS_OD = WS_D + 234 * MiB;
constexpr size_t WS_DS = WS_D + 306 * MiB;
constexpr size_t WS_DEC = WS_D + 450 * MiB;
constexpr size_t WS_H = WS_D + 452 * MiB;
constexpr size_t WS_Y = WS_D;
constexpr size_t WS_HG = WS_D;
constexpr size_t WS_F2 = WS_D;
constexpr size_t WS_U = WS_D + 148 * MiB;
constexpr size_t WS_H2 = WS_D + 483 * MiB;
constexpr size_t WS_END = WS_D + 555 * MiB;
static_assert((size_t)MP * DFF * 2 <= 407 * MiB && (size_t)MP * DM * 2 <= 148 * MiB && (size_t)M * NP * 2 <= 234 * MiB, "dynamic map");
static_assert((size_t)M * DFF * 2 + 148 * MiB <= 483 * MiB, "dense U clear of H2");

constexpr int CW_BAR = 4096;
constexpr int CW_CNT = 8192;

constexpr int RING_BYTES = 131072;
constexpr int TEXP_OFF = 139264;
constexpr int MISC_OFF = 146432 - 512;
constexpr int LDS_BYTES = 147456;

typedef unsigned u32x2 __attribute__((ext_vector_type(2)));

__device__ __forceinline__ float bf2f(unsigned short x) { return __uint_as_float((unsigned)x << 16); }
__device__ __forceinline__ float bflo(unsigned w) { return __uint_as_float(w << 16); }
__device__ __forceinline__ float bfhi(unsigned w) { return __uint_as_float(w & 0xffff0000u); }
__device__ __forceinline__ float siluf(float x) { return x * __builtin_amdgcn_rcpf(1.f + __expf(-x)); }
__device__ __forceinline__ float clamp8(float x) { return fminf(fmaxf(x, -448.f), 448.f); }
__device__ __forceinline__ unsigned pk4_f8(float a, float b, float c, float d) { unsigned w = 0u; w = __builtin_amdgcn_cvt_pk_fp8_f32(clamp8(a), clamp8(b), w, false); w = __builtin_amdgcn_cvt_pk_fp8_f32(clamp8(c), clamp8(d), w, true); return w; }
template <int MASK> __device__ __forceinline__ float xadd(float v) {
    if constexpr (MASK == 32) { const auto rr = __builtin_amdgcn_permlane32_swap(__float_as_uint(v), __float_as_uint(v), false, false); return __uint_as_float(rr[0]) + __uint_as_float(rr[1]); }
    else return v + __int_as_float(__builtin_amdgcn_ds_swizzle(__float_as_int(v), 0x1f | (MASK << 10)));
}
__device__ __forceinline__ float wave_sum(float v) {
    v = xadd<1>(v); v = xadd<2>(v); v = xadd<4>(v); v = xadd<8>(v); v = xadd<16>(v); v = xadd<32>(v);
    return v;
}

struct Args { const float* in[24]; float* out; unsigned char* ws; };
struct Frame {
    LAS unsigned char* lds;
    volatile LAS unsigned* MISC;
    int tid, lane, wave, G, blk, gw, NGW, z, wv;
    const Args* A;
    unsigned char* ws;
};


__device__ __forceinline__ void refresh(Frame& F) {
    int wv = F.wv; asm volatile("" : "+s"(wv));
    const int t = wv * 64 + pg8::lane_id_opaque();
    int bl = blockIdx.x, z = 0, gg = gridDim.x; asm volatile("" : "+s"(bl), "+s"(z), "+s"(gg));
    F.blk = bl; F.z = z; F.G = gg; F.NGW = gg * NWAVES;
    F.tid = t; F.lane = t & 63; F.wave = wv; F.gw = F.blk * NWAVES + F.wave;
}
#define INP(k) (F.A->in[(k) + F.z])
namespace pg8 {
struct EpiProj {
    static constexpr bool PERM = true, AFTER_DRAIN = false;
    bf16_t* P; const float* ropec; const float* ropes; unsigned* kmx;
    __device__ __forceinline__ void operator()(const f32x4 (&acc)[2][2][4][2], const Unit& u, int wr, int wc, int fr, int fq) const {
        const int pn = u.pn, pm = u.pm, tb = pm % 9;
        float kss[2] = {0.f, 0.f};
        const bool do_rope = (tb != 0) && (pn < 4);
        const float sc = (pn < 2) ? C2 : (pn == 6 ? 0.125f : 1.f);
        const bool st_ok_all = pn < 12;
#pragma unroll
        for (int ai = 0; ai < 2; ++ai)
#pragma unroll
            for (int m = 0; m < 4; ++m) {
                const int rit = ai * HALF + wr * 64 + m * 16 + fr;
                bf16_t* rowp = P + ((size_t)pm * BM + rit) * NP + pn * BM + wc * 32 + 8 * fq;
                const int s = (tb - 1) * 256 + rit;
                const int pos = (wc & 1) ? (s & 63) : (s >> 6);
                f32x4 cs = {1.f, 1.f, 1.f, 1.f}, sn = {0.f, 0.f, 0.f, 0.f};
                if (do_rope) { cs = *(const f32x4*)(ropec + pos * 16 + 4 * fq); sn = *(const f32x4*)(ropes + pos * 16 + 4 * fq); }
#pragma unroll
                for (int bj = 0; bj < 2; ++bj) {
                    f32x4 v0 = acc[ai][bj][m][0], v1 = acc[ai][bj][m][1];
                    if (do_rope) { const f32x4 a = v0 * cs - v1 * sn, b = v0 * sn + v1 * cs; v0 = a; v1 = b; }
                    v0 = v0 * sc; v1 = v1 * sc;
                    if (pn == 2 || pn == 3) { float ss = (v0[0] * v0[0] + v0[1] * v0[1]) + (v0[2] * v0[2] + v0[3] * v0[3]) + (v1[0] * v1[0] + v1[1] * v1[1]) + (v1[2] * v1[2] + v1[3] * v1[3]);
                        ss = xadd<16>(ss); ss = xadd<32>(ss); kss[bj] = fmaxf(kss[bj], ss); }
                    if (st_ok_all || (bj == 0 && wc == 0)) {
                        u32x4 w; w.x = cvt_pk_bf16(v0[0], v0[1]); w.y = cvt_pk_bf16(v0[2], v0[3]); w.z = cvt_pk_bf16(v1[0], v1[1]); w.w = cvt_pk_bf16(v1[2], v1[3]);
                        *(u32x4*)(rowp + bj * HALF) = w;
                    }
                }
            }
        if (pn == 2 || pn == 3) {
#pragma unroll
            for (int bj = 0; bj < 2; ++bj) { float v = kss[bj];
                v = fmaxf(v, __int_as_float(__builtin_amdgcn_update_dpp(0, __float_as_int(v), 0xB1, 0xF, 0xF, true)));
                v = fmaxf(v, __int_as_float(__builtin_amdgcn_update_dpp(0, __float_as_int(v), 0x4E, 0xF, 0xF, true)));
                v = fmaxf(v, __int_as_float(__builtin_amdgcn_update_dpp(0, __float_as_int(v), 0x141, 0xF, 0xF, true)));
                v = fmaxf(v, __int_as_float(__builtin_amdgcn_update_dpp(0, __float_as_int(v), 0x140, 0xF, 0xF, true)));
                if (fr == 0 && fq == 0) { const int hh = (pn - 2) * 4 + bj * 2 + (wc >> 1);
                    __hip_atomic_fetch_max(kmx + (((pm / 9) * 8 + hh) * 2 + (wc & 1)), __float_as_uint(v), __ATOMIC_RELAXED, __HIP_MEMORY_SCOPE_AGENT); } }
        }
    }
};
struct EpiF32 {
    static constexpr bool PERM = true, AFTER_DRAIN = false;
    bf16_t* Y;
    __device__ __forceinline__ void operator()(const f32x4 (&acc)[2][2][4][2], const Unit& u, int wr, int wc, int fr, int fq) const {
#pragma unroll
        for (int ai = 0; ai < 2; ++ai)
#pragma unroll
            for (int m = 0; m < 4; ++m) {
                bf16_t* rowp = Y + ((size_t)u.pm * BM + ai * HALF + wr * 64 + m * 16 + fr) * DM + u.pn * BM + wc * 32 + 8 * fq;
#pragma unroll
                for (int bj = 0; bj < 2; ++bj) { const f32x4 v0 = acc[ai][bj][m][0], v1 = acc[ai][bj][m][1];
                    u32x4 w; w.x = cvt_pk_bf16(v0[0], v0[1]); w.y = cvt_pk_bf16(v0[2], v0[3]); w.z = cvt_pk_bf16(v1[0], v1[1]); w.w = cvt_pk_bf16(v1[2], v1[3]);
                    *(u32x4*)(rowp + bj * HALF) = w; }
            }
    }
};
struct EpiSwiglu {
    static constexpr bool PERM = true, AFTER_DRAIN = false;
    bf16_t* U;
    __device__ __forceinline__ void operator()(const f32x4 (&acc)[2][2][4][2], const Unit& u, int wr, int wc, int fr, int fq) const {
        const int pnl = u.pn % 22;
        const int col0 = pnl * 128 + wc * 32 + 8 * fq;
        constexpr float ws = FFN_F8 ? 1.f / W8S : 1.f, us = FFN_F8 ? U8S : 1.f, kS = ws * ws * us, kE = -ws * 1.4426950408889634f;
        const float cE = -__builtin_log2f(kS), c1 = 1.f / kS;
#pragma unroll
        for (int ai = 0; ai < 2; ++ai)
#pragma unroll
            for (int m = 0; m < 4; ++m) {
                const size_t rowi = (size_t)u.pm * BM + ai * HALF + wr * 64 + m * 16 + fr;
                f32x2 g[4], up[4], t[4], r[4];
#pragma unroll
                for (int n = 0; n < 2; ++n) { g[2 * n] = (f32x2){acc[ai][0][m][n][0], acc[ai][0][m][n][1]}; g[2 * n + 1] = (f32x2){acc[ai][0][m][n][2], acc[ai][0][m][n][3]};
                                              up[2 * n] = (f32x2){acc[ai][1][m][n][0], acc[ai][1][m][n][1]}; up[2 * n + 1] = (f32x2){acc[ai][1][m][n][2], acc[ai][1][m][n][3]}; }
#pragma unroll
                for (int q = 0; q < 4; ++q) t[q] = g[q] * kE + cE;
#pragma unroll
                for (int q = 0; q < 4; ++q) { t[q].x = __builtin_amdgcn_exp2f(t[q].x); t[q].y = __builtin_amdgcn_exp2f(t[q].y); }
#pragma unroll
                for (int q = 0; q < 4; ++q) t[q] = t[q] + c1;
#pragma unroll
                for (int q = 0; q < 4; ++q) { r[q].x = __builtin_amdgcn_rcpf(t[q].x); r[q].y = __builtin_amdgcn_rcpf(t[q].y); }
#pragma unroll
                for (int q = 0; q < 4; ++q) g[q] = (g[q] * up[q]) * r[q];
                if constexpr (FFN_F8) { u32x2 w; w.x = pk4_f8(g[0].x, g[0].y, g[1].x, g[1].y); w.y = pk4_f8(g[2].x, g[2].y, g[3].x, g[3].y); *(u32x2*)((unsigned char*)U + rowi * DFF + col0) = w; }
                else { u32x4 w; w.x = cvt_pk_bf16(g[0].x, g[0].y); w.y = cvt_pk_bf16(g[1].x, g[1].y); w.z = cvt_pk_bf16(g[2].x, g[2].y); w.w = cvt_pk_bf16(g[3].x, g[3].y); *(u32x4*)(U + rowi * DFF + col0) = w; }
            }
    }
};
struct EpiDown {
    static constexpr bool PERM = true, AFTER_DRAIN = false;
    bf16_t* F2; const int* rmap; const float* roww; int dense;
    __device__ __forceinline__ void operator()(const f32x4 (&acc)[2][2][4][2], const Unit& u, int wr, int wc, int fr, int fq) const {
        const int pnl = u.pn & 3;
        const int col0 = pnl * BM + wc * 32 + 8 * fq;
        const __amdgpu_buffer_rsrc_t rsF = __builtin_amdgcn_make_buffer_rsrc((void*)F2, 0, 2 * M * DM * 2, 0x00020000);
        const __amdgpu_buffer_rsrc_t rsM = __builtin_amdgcn_make_buffer_rsrc((void*)rmap, 0, MP * 4, 0x00020000);
        const __amdgpu_buffer_rsrc_t rsW = __builtin_amdgcn_make_buffer_rsrc((void*)roww, 0, MP * 4, 0x00020000);
#pragma unroll
        for (int ai = 0; ai < 2; ++ai)
#pragma unroll
            for (int m = 0; m < 4; ++m) {
                const int grow = u.pm * BM + ai * HALF + wr * 64 + m * 16 + fr;
                int tok = grow, slot = 0; float w = 1.f; bool ok = true;
                if (!dense) { const int rm = (int)__builtin_amdgcn_raw_buffer_load_b32(rsM, grow * 4, 0, 0); ok = rm >= 0; tok = rm & 0x3fffffff; slot = (rm >> 30) & 1; w = __uint_as_float(__builtin_amdgcn_raw_buffer_load_b32(rsW, grow * 4, 0, 0)); }
                if constexpr (FFN_F8) w *= 1.f / (W8S * U8S);
                if (ok) {
                    const int bo = ((slot * M + tok) * DM + col0) * 2;
#pragma unroll
                    for (int bj = 0; bj < 2; ++bj) {
                        const f32x4 v0 = acc[ai][bj][m][0] * w, v1 = acc[ai][bj][m][1] * w;
                        u32x4 q; q.x = cvt_pk_bf16(v0[0], v0[1]); q.y = cvt_pk_bf16(v0[2], v0[3]); q.z = cvt_pk_bf16(v1[0], v1[1]); q.w = cvt_pk_bf16(v1[2], v1[3]);
                        __builtin_amdgcn_raw_buffer_store_b128(q, rsF, bo + bj * HALF * 2, 0, 0);
                    }
                }
            }
    }
};
struct GroupedOrder {
    StaticOrder S; const PG8_LAS int* texp; int nN;
    __device__ __forceinline__ bool next(int i, Unit& u) const { if (!S.next(i, u)) return false; u.pn += __builtin_amdgcn_readfirstlane(texp[u.pm]) * nN; return true; }
    __device__ __forceinline__ void a_ready(const Unit&) const {}
    __device__ __forceinline__ void done(const Unit&) const {}
};
struct LatOrder {
    StaticOrder S; int lat;
    __device__ __forceinline__ bool next(int i, Unit& u) const { if (!S.next(i, u)) return false; if (lat) u.pm += (u.pm >> 3) + 1; return true; }
    __device__ __forceinline__ void a_ready(const Unit&) const {}
    __device__ __forceinline__ void done(const Unit&) const {}
};
}

__device__ __forceinline__ void ld_row_f32(const float* row, int lane, f32x4 (&v)[4]) {
#pragma unroll
    for (int j = 0; j < 4; ++j) v[j] = *(const f32x4*)(row + 4 * lane + 256 * j);
}
__device__ __forceinline__ void st_row_f32(float* row, int lane, const f32x4 (&v)[4]) {
#pragma unroll
    for (int j = 0; j < 4; ++j) *(f32x4*)(row + 4 * lane + 256 * j) = v[j];
}
__device__ __forceinline__ void ld_row_bf16(const bf16* row, int lane, f32x4 (&v)[4]) {
#pragma unroll
    for (int j = 0; j < 4; ++j) { const u32x2 w = *(const u32x2*)(row + 4 * lane + 256 * j); v[j] = (f32x4){bflo(w.x), bfhi(w.x), bflo(w.y), bfhi(w.y)}; }
}
__device__ __forceinline__ void st_row_bf16(bf16* row, int lane, const f32x4 (&v)[4]) {
#pragma unroll
    for (int j = 0; j < 4; ++j) { u32x2 w; w.x = pg8::cvt_pk_bf16(v[j][0], v[j][1]); w.y = pg8::cvt_pk_bf16(v[j][2], v[j][3]); *(u32x2*)(row + 4 * lane + 256 * j) = w; }
}
__device__ __forceinline__ float row_rinv(const f32x4 (&v)[4]) {
    float s = 0.f;
#pragma unroll
    for (int j = 0; j < 4; ++j) s += (v[j][0] * v[j][0] + v[j][1] * v[j][1]) + (v[j][2] * v[j][2] + v[j][3] * v[j][3]);
    return 1.0f / sqrtf(wave_sum(s) * (1.f / DM) + EPS);
}

__device__ __forceinline__ void transpose_tile(const float* W, int N, int k0, int n0, bf16* WT, int K, int drow0, LAS float* scr, int lane, bool ropeperm = false) {
    { f32x4 v[8];
#pragma unroll
      for (int j = 0; j < 8; ++j) v[j] = __builtin_nontemporal_load((const f32x4*)&W[(size_t)(k0 + 8 * j + (lane >> 3)) * N + n0 + 4 * (lane & 7)]);
#pragma unroll
      for (int j = 0; j < 8; ++j) { LAS float* d = scr + (8 * j + (lane >> 3)) * 33 + 4 * (lane & 7); d[0] = v[j][0]; d[1] = v[j][1]; d[2] = v[j][2]; d[3] = v[j][3]; } }
    LDS_WAIT(); asm volatile("" ::: "memory");
    const int c = lane & 7;
#pragma unroll
    for (int j = 0; j < 4; ++j) { const int n = (lane >> 3) + 8 * j; const LAS float* s = scr + (8 * c) * 33 + n;
        v4u o; o.x = pk2(s[0 * 33], s[1 * 33]); o.y = pk2(s[2 * 33], s[3 * 33]); o.z = pk2(s[4 * 33], s[5 * 33]); o.w = pk2(s[6 * 33], s[7 * 33]);
        const int nd = ropeperm ? (8 * ((n >> 2) & 3) + 4 * (n >> 4) + (n & 3)) : n;
        *(GAS v4u*)(WT + (size_t)(drow0 + nd) * K + k0 + 8 * c) = o; }
    LDS_WAIT(); asm volatile("" ::: "memory");
}
__device__ __forceinline__ void transpose_tile_f8(const float* W, int N, int k0, int n0, unsigned char* WT, int Kb, int drow0, LAS float* scr, int lane, float scale) {
    { f32x4 v[8];
#pragma unroll
      for (int j = 0; j < 8; ++j) v[j] = __builtin_nontemporal_load((const f32x4*)&W[(size_t)(k0 + 8 * j + (lane >> 3)) * N + n0 + 4 * (lane & 7)]);
#pragma unroll
      for (int j = 0; j < 8; ++j) { LAS float* d = scr + (8 * j + (lane >> 3)) * 33 + 4 * (lane & 7); d[0] = v[j][0]; d[1] = v[j][1]; d[2] = v[j][2]; d[3] = v[j][3]; } }
    LDS_WAIT(); asm volatile("" ::: "memory");
    const int n = lane >> 1, hf = lane & 1; const LAS float* s = scr + (hf * 32) * 33 + n;
    v4u o0, o1;
    o0.x = pk4_f8(s[0 * 33] * scale, s[1 * 33] * scale, s[2 * 33] * scale, s[3 * 33] * scale);     o0.y = pk4_f8(s[4 * 33] * scale, s[5 * 33] * scale, s[6 * 33] * scale, s[7 * 33] * scale);
    o0.z = pk4_f8(s[8 * 33] * scale, s[9 * 33] * scale, s[10 * 33] * scale, s[11 * 33] * scale);   o0.w = pk4_f8(s[12 * 33] * scale, s[13 * 33] * scale, s[14 * 33] * scale, s[15 * 33] * scale);
    o1.x = pk4_f8(s[16 * 33] * scale, s[17 * 33] * scale, s[18 * 33] * scale, s[19 * 33] * scale); o1.y = pk4_f8(s[20 * 33] * scale, s[21 * 33] * scale, s[22 * 33] * scale, s[23 * 33] * scale);
    o1.z = pk4_f8(s[24 * 33] * scale, s[25 * 33] * scale, s[26 * 33] * scale, s[27 * 33] * scale); o1.w = pk4_f8(s[28 * 33] * scale, s[29 * 33] * scale, s[30 * 33] * scale, s[31 * 33] * scale);
    GAS v4u* dst = (GAS v4u*)(WT + (size_t)(drow0 + n) * Kb + k0 + hf * 32);
    dst[0] = o0; dst[1] = o1;
    LDS_WAIT(); asm volatile("" ::: "memory");
}
__device__ __forceinline__ void convert_weights(Frame& F, int l) {
    refresh(F);
    const bool moe = l & 1; const int ne = moe ? NE : 1, li = l >> 1;
    const float* w1 = moe ? INP(21) + (size_t)li * NE * DM * DFF : INP(17) + (size_t)li * DM * DFF;
    const float* w3 = moe ? INP(22) + (size_t)li * NE * DM * DFF : INP(18) + (size_t)li * DM * DFF;
    const float* w2 = moe ? INP(23) + (size_t)li * NE * DM * DFF : INP(19) + (size_t)li * DM * DFF;
    const float* win = INP(10) + (size_t)l * DM * NIN;
    const float* wout = INP(16) + (size_t)l * DM * DM;
    bf16* WIN = (bf16*)(F.ws + WS_WIN); bf16* WOUT = (bf16*)(F.ws + WS_WOUT); bf16* WUP = (bf16*)(F.ws + WS_WUP); bf16* WDN = (bf16*)(F.ws + WS_WDN);
    LAS float* scr = (LAS float*)(F.lds + F.wave * 16384);
    const int nA = 16 * 97, nZ = NP - NIN, nB = 16 * 32, nC1 = 16 * 88, nD1 = 44 * 32;
    const int nC = ne * 2 * nC1, nD = ne * nD1, total = nA + nZ + nB + nC + nD;
    for (int it = F.gw; it < total; it += F.NGW) {
        int r = it;
        if (r < nA) { const int kb = r / 97, nb = r % 97; transpose_tile(win, NIN, 64 * kb, 32 * nb, WIN, DM, 32 * nb, scr, F.lane, nb < 32  ); continue; } r -= nA;
        if (r < nZ) { const unsigned zz = (unsigned)F.z; v4u z = {zz, zz, zz, zz}; GAS v4u* p = (GAS v4u*)(WIN + (size_t)(NIN + r) * DM) + F.lane * 2; p[0] = z; p[1] = z; continue; } r -= nZ;
        if (r < nB) { const int kb = r / 32, nb = r % 32; transpose_tile(wout, DM, 64 * kb, 32 * nb, WOUT, DM, 32 * nb, scr, F.lane); continue; } r -= nB;
        if (r < nC) { const int e = r / (2 * nC1), q = r % (2 * nC1), which = q / nC1, t = q % nC1, kb = t / 88, nb = t % 88, n0 = 32 * nb;
            const float* src = (which ? w3 : w1) + (size_t)e * DM * DFF;
            if constexpr (FFN_F8) transpose_tile_f8(src, DFF, 64 * kb, n0, (unsigned char*)WUP, DM, e * 5632 + (n0 / 128) * 256 + (n0 % 128) + which * 128, scr, F.lane, W8S);
            else transpose_tile(src, DFF, 64 * kb, n0, WUP, DM, e * 5632 + (n0 / 128) * 256 + (n0 % 128) + which * 128, scr, F.lane); continue; } r -= nC;
        { const int e = r / nD1, t = r % nD1, kb = t / 32, nb = t % 32;
            if constexpr (FFN_F8) transpose_tile_f8(w2 + (size_t)e * DFF * DM, DM, 64 * kb, 32 * nb, (unsigned char*)WDN + (size_t)e * DM * DFF, DFF, 32 * nb, scr, F.lane, W8S);
            else transpose_tile(w2 + (size_t)e * DFF * DM, DM, 64 * kb, 32 * nb, WDN + (size_t)e * DM * DFF, DFF, 32 * nb, scr, F.lane); }
    }
}

__device__ __forceinline__ void p0_mod(Frame& F) {
    refresh(F);
    LAS float* S = (LAS float*)(F.lds);
    LAS float* R = (LAS float*)(F.lds + 69632);
    const float* c = INP(1); const float* cc = INP(3); const float* wmod = INP(4); const float* bmod = INP(5);
    float* MOD = (float*)(F.ws + WS_MOD);
    for (int i = F.tid; i < 17 * 1024; i += 512) { const int b = i >> 10, k = i & 1023; const float v = b < 16 ? c[b * 1024 + k] : cc[k]; S[i] = siluf(v); }
    __syncthreads();
    const int kq = F.lane >> 4, c4 = (F.lane & 15) * 4;
    for (int item = F.blk; item < 4 * 96; item += F.G) {
        const int l = item / 96, col0 = (item % 96) * 64;
        const float* W = wmod + (size_t)l * DM * 6144;
        float acc[17][4];
#pragma unroll
        for (int b = 0; b < 17; ++b)
#pragma unroll
            for (int j = 0; j < 4; ++j) acc[b][j] = 0.f;
        for (int it = 0; it < 32; ++it) {
            const int k = F.wave * 128 + it * 4 + kq;
            const f32x4 w = *(const f32x4*)(W + (size_t)k * 6144 + col0 + c4);
#pragma unroll
            for (int b = 0; b < 17; ++b) { const float s = S[b * 1024 + k];
#pragma unroll
                for (int j = 0; j < 4; ++j) acc[b][j] += s * w[j]; }
        }
#pragma unroll
        for (int b = 0; b < 17; ++b)
#pragma unroll
            for (int j = 0; j < 4; ++j) { float v = acc[b][j]; v = xadd<16>(v); v = xadd<32>(v); acc[b][j] = v; }
        if (kq == 0) {
#pragma unroll
            for (int b = 0; b < 17; ++b)
#pragma unroll
                for (int j = 0; j < 4; ++j) R[(F.wave * 17 + b) * 64 + c4 + j] = acc[b][j];
        }
        __syncthreads();
        for (int o = F.tid; o < 17 * 64; o += 512) { const int b = o >> 6, ccx = o & 63; float s = bmod[l * 6144 + col0 + ccx];
            for (int w = 0; w < 8; ++w) s += R[(w * 17 + b) * 64 + ccx];
            MOD[((size_t)l * 17 + b) * 6144 + col0 + ccx] = s; }
        __syncthreads();
    }
}
__device__ __forceinline__ float lam_init_of(int l) { return 0.8f - 0.6f * expf(-0.3f * (float)l); }
__device__ __forceinline__ void p0_misc(Frame& F) {
    refresh(F);
    float* ropec = (float*)(F.ws + WS_ROPE); float* ropes = ropec + 1024; float* lam = (float*)(F.ws + WS_ROPE + 16384);
    if (F.blk == 0) {
        for (int i = F.tid; i < 1024; i += 512) { const int pos = i >> 4, f = i & 15; const float inv = powf(10000.f, -(float)f / 16.f); const float ang = (float)pos * inv; ropec[i] = cosf(ang); ropes[i] = sinf(ang); }
    }
    if (F.blk == (1 % F.G) && F.wave < 4) {
        const int l = F.wave; const float* lv = INP(13) + l * 256;
        const float a = wave_sum(lv[F.lane] * lv[64 + F.lane]), b = wave_sum(lv[128 + F.lane] * lv[192 + F.lane]);
        if (F.lane == 0) lam[l] = expf(a) - expf(b) + lam_init_of(l);
    }
}

namespace att {
using bf16x8 = __attribute__((ext_vector_type(8))) short;
using s16x4  = __attribute__((ext_vector_type(4))) short;
using f32x16 = __attribute__((ext_vector_type(16))) float;
using u32x4  = __attribute__((ext_vector_type(4))) unsigned;
constexpr int QBLK = 32, KVBLK = 64, NW = 8, DV = 128;
constexpr float THR = 8.f;
constexpr size_t SHM_V = KVBLK * DV * 2, SHM_K = KVBLK * 64 * 2, SHM_ATTN = 2 * SHM_V + 2 * SHM_K + NW * 64 * 4;
#define KSWZ64(row, colB) ((row) * 128 + ((colB) ^ ((((row) >> 1) & 7) << 4)))
#define SBAR() __builtin_amdgcn_sched_barrier(0)
__device__ __forceinline__ int crow(int r, int hi) { return (r & 3) + 8 * (r >> 2) + 4 * hi; }
__device__ __forceinline__ unsigned cvtpk(float lo, float hi) { unsigned r; asm volatile("v_cvt_pk_bf16_f32 %0, %1, %2" : "=v"(r) : "v"(lo), "v"(hi)); return r; }
__device__ __forceinline__ void partialSM(f32x16& p0, f32x16& p1, float& m_reg, float& mn, float& alpha) {
  float pmax = p0[0];
#pragma unroll
  for (int r = 1; r < 16; ++r) pmax = fmaxf(pmax, p0[r]);
#pragma unroll
  for (int r = 0; r < 16; ++r) pmax = fmaxf(pmax, p1[r]);
  { auto rr = __builtin_amdgcn_permlane32_swap(__float_as_uint(pmax), __float_as_uint(pmax), false, false);
    pmax = fmaxf(__uint_as_float(rr[0]), __uint_as_float(rr[1])); }
  if (__builtin_expect(__all(pmax - m_reg <= THR), 1)) { mn = m_reg; alpha = 1.f; }
  else { mn = fmaxf(m_reg, pmax); alpha = __builtin_amdgcn_exp2f(m_reg - mn); m_reg = mn; }
#pragma unroll
  for (int r = 0; r < 16; ++r) p0[r] = p0[r] - mn;
#pragma unroll
  for (int r = 0; r < 16; ++r) p1[r] = p1[r] - mn;
#pragma unroll
  for (int r = 0; r < 16; ++r) p0[r] = __builtin_amdgcn_exp2f(p0[r]);
}
__device__ __forceinline__ void finishSM(f32x16& p0, f32x16& p1, float alpha, float& l_reg, bf16x8& pa0, bf16x8& pa1, bf16x8& pa2, bf16x8& pa3) {
#pragma unroll
  for (int r = 0; r < 16; ++r) p1[r] = __builtin_amdgcn_exp2f(p1[r]);
  float ps = 0;
#pragma unroll
  for (int r = 0; r < 16; ++r) ps += p0[r];
#pragma unroll
  for (int r = 0; r < 16; ++r) ps += p1[r];
  { auto rr = __builtin_amdgcn_permlane32_swap(__float_as_uint(ps), __float_as_uint(ps), false, false);
    ps = __uint_as_float(rr[0]) + __uint_as_float(rr[1]); }
  l_reg = l_reg * alpha + ps;
#define PK4(P, BASE, OUT) do { unsigned a0 = cvtpk(P[BASE + 0], P[BASE + 1]), a1 = cvtpk(P[BASE + 2], P[BASE + 3]);   \
    unsigned b0 = cvtpk(P[BASE + 4], P[BASE + 5]), b1 = cvtpk(P[BASE + 6], P[BASE + 7]);                              \
    auto r0 = __builtin_amdgcn_permlane32_swap(a0, b0, false, false); auto r1 = __builtin_amdgcn_permlane32_swap(a1, b1, false, false); \
    u32x4 w = {r0[0], r1[0], r0[1], r1[1]}; OUT = *reinterpret_cast<bf16x8*>(&w); } while (0)
  PK4(p0, 0, pa0); PK4(p0, 8, pa1); PK4(p1, 0, pa2); PK4(p1, 8, pa3);
#undef PK4
}
__device__ __forceinline__ void pack_p(const f32x16& p0, const f32x16& p1, bf16x8& pa0, bf16x8& pa1, bf16x8& pa2, bf16x8& pa3) {
#define PK4(P, BASE, OUT) do { unsigned a0 = cvtpk(P[BASE + 0], P[BASE + 1]), a1 = cvtpk(P[BASE + 2], P[BASE + 3]);   \
    unsigned b0 = cvtpk(P[BASE + 4], P[BASE + 5]), b1 = cvtpk(P[BASE + 6], P[BASE + 7]);                              \
    auto r0 = __builtin_amdgcn_permlane32_swap(a0, b0, false, false); auto r1 = __builtin_amdgcn_permlane32_swap(a1, b1, false, false); \
    u32x4 w = {r0[0], r1[0], r0[1], r1[1]}; OUT = *reinterpret_cast<bf16x8*>(&w); } while (0)
  PK4(p0, 0, pa0); PK4(p0, 8, pa1); PK4(p1, 0, pa2); PK4(p1, 8, pa3);
#undef PK4
}
__device__ __forceinline__ void qkt(f32x16& p0, f32x16& p1, const bf16* Ks, const bf16x8* qr, int r32, int hi) {
  p0 = f32x16{}; p1 = f32x16{};
#pragma unroll
  for (int d0 = 0; d0 < 4; ++d0) { int cb = (d0 * 16 + hi * 8) * 2;
    bf16x8 b0 = *reinterpret_cast<const bf16x8*>((const char*)Ks + KSWZ64(r32, cb));
    bf16x8 b1 = *reinterpret_cast<const bf16x8*>((const char*)Ks + KSWZ64(32 + r32, cb));
    p0 = __builtin_amdgcn_mfma_f32_32x32x16_bf16(b0, qr[d0], p0, 0, 0, 0);
    p1 = __builtin_amdgcn_mfma_f32_32x32x16_bf16(b1, qr[d0], p1, 0, 0, 0); }
}
__device__ __forceinline__ int v_st(int k, int c) { const int kk = (k & ~0xC) | ((k & 4) << 1) | ((k & 8) >> 1); return ((kk >> 3) * 4 + (c >> 5)) * 512 + ((kk & 7) * 32 + (c & 31)) * 2; }
__device__ __forceinline__ int v_rd_base(int lane) { return ((lane & 3) << 3) | (((lane >> 2) & 3) << 6) | (((lane >> 4) & 1) << 5) | (((lane >> 5) & 1) << 8); }
constexpr int v_rd_off(int d0, int ks, int half) { return d0 * 512 + ks * 4096 + half * 2048; }
template <int OFF> __device__ __forceinline__ s16x4 tr_read(int vb) {
  s16x4 r; asm volatile("ds_read_b64_tr_b16 %0, %1 offset:%2" : "=&v"(r) : "v"(vb), "i"(OFF) : "memory"); return r;
}
template <int D0> __device__ __forceinline__ void pv_one(f32x16& od, int vb, bf16x8 pa0, bf16x8 pa1, bf16x8 pa2, bf16x8 pa3) {
  const s16x4 l0 = tr_read<v_rd_off(D0, 0, 0)>(vb), h0 = tr_read<v_rd_off(D0, 0, 1)>(vb), l1 = tr_read<v_rd_off(D0, 1, 0)>(vb), h1 = tr_read<v_rd_off(D0, 1, 1)>(vb);
  const s16x4 l2 = tr_read<v_rd_off(D0, 2, 0)>(vb), h2 = tr_read<v_rd_off(D0, 2, 1)>(vb), l3 = tr_read<v_rd_off(D0, 3, 0)>(vb), h3 = tr_read<v_rd_off(D0, 3, 1)>(vb);
  asm volatile("s_waitcnt lgkmcnt(0)" ::: "memory"); SBAR();
#define PK(L, H) (bf16x8){L[0], L[1], L[2], L[3], H[0], H[1], H[2], H[3]}
  od = __builtin_amdgcn_mfma_f32_32x32x16_bf16(pa0, PK(l0, h0), od, 0, 0, 0);
  od = __builtin_amdgcn_mfma_f32_32x32x16_bf16(pa1, PK(l1, h1), od, 0, 0, 0);
  od = __builtin_amdgcn_mfma_f32_32x32x16_bf16(pa2, PK(l2, h2), od, 0, 0, 0);
  od = __builtin_amdgcn_mfma_f32_32x32x16_bf16(pa3, PK(l3, h3), od, 0, 0, 0);
#undef PK
}
__device__ __forceinline__ void pv_d0(f32x16* o, int vb, bf16x8 pa0, bf16x8 pa1, bf16x8 pa2, bf16x8 pa3) {
  pv_one<0>(o[0], vb, pa0, pa1, pa2, pa3); pv_one<1>(o[1], vb, pa0, pa1, pa2, pa3); pv_one<2>(o[2], vb, pa0, pa1, pa2, pa3); pv_one<3>(o[3], vb, pa0, pa1, pa2, pa3);
}
constexpr int LDQ = NP, LDK = NP, LDO = DM;
__device__ __forceinline__ void sm_first(f32x16& p0, f32x16& p1, float m) {
#pragma unroll
  for (int r = 0; r < 16; ++r) p0[r] = p0[r] - m;
#pragma unroll
  for (int r = 0; r < 16; ++r) p1[r] = p1[r] - m;
#pragma unroll
  for (int r = 0; r < 16; ++r) p0[r] = __builtin_amdgcn_exp2f(p0[r]);
}
__device__ __forceinline__ void sm_second(f32x16& p0, f32x16& p1, float& l_reg, bf16x8& pa0, bf16x8& pa1, bf16x8& pa2, bf16x8& pa3) {
#pragma unroll
  for (int r = 0; r < 16; ++r) p1[r] = __builtin_amdgcn_exp2f(p1[r]);
  float ps = 0;
#pragma unroll
  for (int r = 0; r < 16; ++r) ps += p0[r];
#pragma unroll
  for (int r = 0; r < 16; ++r) ps += p1[r];
  { auto rr = __builtin_amdgcn_permlane32_swap(__float_as_uint(ps), __float_as_uint(ps), false, false);
    ps = __uint_as_float(rr[0]) + __uint_as_float(rr[1]); }
  l_reg += ps;
  pack_p(p0, p1, pa0, pa1, pa2, pa3);
}
__device__ __forceinline__ void attn_unit(const bf16* __restrict__ Qb, const bf16* __restrict__ Kh, const bf16* __restrict__ Vh, bf16* __restrict__ Ob, int seq, char* lds, int tid, float kmax) {
  const int wid = tid >> 6, lane = tid & 63, r32 = lane & 31, hi = lane >> 5;
  bf16* V_lds = (bf16*)lds; bf16* K_lds = (bf16*)(lds + 2 * SHM_V);
  float* ws = (float*)(lds + 2 * SHM_V + 2 * SHM_K) + wid * 64; float* li_l = ws; float* al_l = ws + 32;
  float m_reg = -1e30f, l_reg = 0; f32x16 o[4] = {}; bf16x8 qr[4];
  const bf16* Qw = Qb + (long)(wid * QBLK + r32) * LDQ + hi * 8;
#pragma unroll
  for (int d0 = 0; d0 < 4; ++d0) qr[d0] = *(const __attribute__((address_space(1))) bf16x8*)(Qw + d0 * 16);
  { float qs = 0.f;
#pragma unroll
    for (int d0 = 0; d0 < 4; ++d0)
#pragma unroll
      for (int e = 0; e < 8; ++e) { const float qv = __uint_as_float((unsigned)(unsigned short)qr[d0][e] << 16); qs += qv * qv; }
    auto rr = __builtin_amdgcn_permlane32_swap(__float_as_uint(qs), __float_as_uint(qs), false, false);
    qs = __uint_as_float(rr[0]) + __uint_as_float(rr[1]);
    m_reg = sqrtf(qs) * kmax * 1.002f + 1e-3f; }
  const int sr = tid >> 4, sc = (tid & 15) * 8, vst0 = v_st(sr, sc), vst1 = v_st(32 + sr, sc);
  const int kr = tid >> 3, kc = (tid & 7) * 8, kst = KSWZ64(kr, kc * 2);
  const int vb0 = (int)(uintptr_t)V_lds + v_rd_base(lane);
  struct { bf16x8 vs0, vs1, ks0; } sr_[2];
#define GLD8(p) (*(const __attribute__((address_space(1))) bf16x8*)(p))
#define SLOAD(i, k0) do { sr_[i].vs0 = GLD8(&Vh[(long)((k0) + sr) * LDK + sc]); sr_[i].vs1 = GLD8(&Vh[(long)((k0) + 32 + sr) * LDK + sc]); \
    sr_[i].ks0 = GLD8(&Kh[(long)((k0) + kr) * LDK + kc]); } while (0)
#define SWRITE(b, i) do { *(bf16x8*)((char*)V_lds + (b) * SHM_V + vst0) = sr_[i].vs0; *(bf16x8*)((char*)V_lds + (b) * SHM_V + vst1) = sr_[i].vs1; \
    *(bf16x8*)((char*)K_lds + (b) * SHM_K + kst) = sr_[i].ks0; } while (0)
#define SWAIT() asm volatile("s_waitcnt vmcnt(3)" ::: "memory")
#define RESC(a) do { if (__any((a) < 1.f)) { if (hi == 0) al_l[r32] = (a); asm volatile("s_waitcnt lgkmcnt(0)" ::: "memory"); \
    _Pragma("unroll") for (int d = 0; d < 4; ++d) _Pragma("unroll") for (int r = 0; r < 16; ++r) o[d][r] *= al_l[crow(r, hi)]; } } while (0)
  f32x16 pA0, pA1, pB0, pB1; float mnA, mnB, alA, alB; bf16x8 pa0, pa1, pa2, pa3; const int NT = seq / KVBLK;
  if (__builtin_amdgcn_readfirstlane(wid) >= 4) __builtin_amdgcn_s_setprio(1);
  constexpr int SE = 0, SO = 1;
  SLOAD(SE, 0); asm volatile("s_waitcnt vmcnt(0)" ::: "memory"); SWRITE(0, SE); __syncthreads();
  qkt(pA0, pA1, K_lds, qr, r32, hi); sm_first(pA0, pA1, m_reg);
  SLOAD(SO, KVBLK); if (2 < NT) SLOAD(SE, 2 * KVBLK);
  SWAIT(); SWRITE(1, SO); __syncthreads();
  for (int j = 1; j + 1 < NT; j += 2) {
    SBAR(); qkt(pB0, pB1, (bf16*)((char*)K_lds + SHM_K), qr, r32, hi);
    sm_second(pA0, pA1, l_reg, pa0, pa1, pa2, pa3); SBAR();
    SLOAD(SO, (j + 2) * KVBLK); SBAR();
    pv_d0(o, vb0, pa0, pa1, pa2, pa3); sm_first(pB0, pB1, m_reg);
    __syncthreads(); SWAIT(); SWRITE(0, SE);
    __syncthreads();
    SBAR(); qkt(pA0, pA1, K_lds, qr, r32, hi);
    sm_second(pB0, pB1, l_reg, pa0, pa1, pa2, pa3); SBAR();
    if (j + 3 < NT) SLOAD(SE, (j + 3) * KVBLK); SBAR();
    pv_d0(o, vb0 + (int)SHM_V, pa0, pa1, pa2, pa3); sm_first(pA0, pA1, m_reg);
    __syncthreads(); SWAIT(); SWRITE(1, SO);
    __syncthreads();
  }
  SBAR(); qkt(pB0, pB1, (bf16*)((char*)K_lds + SHM_K), qr, r32, hi);
  sm_second(pA0, pA1, l_reg, pa0, pa1, pa2, pa3); SBAR();
  pv_d0(o, vb0, pa0, pa1, pa2, pa3); sm_first(pB0, pB1, m_reg);
  __syncthreads();
  sm_second(pB0, pB1, l_reg, pa0, pa1, pa2, pa3); SBAR();
  pv_d0(o, vb0 + (int)SHM_V, pa0, pa1, pa2, pa3);
  __builtin_amdgcn_s_setprio(0);
  if (hi == 0) li_l[r32] = l_reg; asm volatile("s_waitcnt lgkmcnt(0)" ::: "memory");
  float rli[16];
#pragma unroll
  for (int r = 0; r < 16; ++r) rli[r] = __builtin_amdgcn_rcpf(li_l[crow(r, hi)]);
  bf16* Ow = Ob + (long)(wid * QBLK) * LDO;
#pragma unroll
  for (int r = 0; r < 16; ++r) { const int orow = crow(r, hi);
#pragma unroll
    for (int d0 = 0; d0 < 4; ++d0) Ow[(long)orow * LDO + d0 * 32 + r32] = (bf16)(cvtpk(o[d0][r] * rli[r], 0.f) & 0xffffu); }
#undef SLOAD
#undef GLD8
#undef SWRITE
#undef SWAIT
#undef RESC
}
}

constexpr int CW_KMX = 13312;
constexpr int CW_Q = 12288;
namespace att2 {
using att::bf16x8; using att::s16x4; using att::f32x16; using att::u32x4;
typedef LAS const char* lds_cptr;
typedef short v4i16_t __attribute__((ext_vector_type(4)));
typedef unsigned u32x2 __attribute__((ext_vector_type(2)));
constexpr int KSLOT = 8192, VSLOT = 16384, LDS_K = 0, LDS_V = 4 * KSLOT, KVBLK = 64;
#define A2_PIN(x) asm volatile("" : "+v"(x))
#define A2_MFMA(a, b, c) __builtin_amdgcn_mfma_f32_32x32x16_bf16(a, b, c, 0, 0, 0)
#define A2_WAIT_BAR(N) asm volatile("s_waitcnt vmcnt(" #N ") lgkmcnt(0)\n\ts_barrier" ::: "memory")
__device__ __forceinline__ unsigned cvtpk(float lo, float hi) { unsigned r; asm("v_cvt_pk_bf16_f32 %0, %1, %2" : "=v"(r) : "v"(lo), "v"(hi)); return r; }
__device__ __forceinline__ void glds16s(const char* gbase, unsigned voff, unsigned lds_base) {
    unsigned sv; asm volatile("s_mov_b32 %0, m0\n\ts_mov_b32 m0, %3\n\ts_nop 0\n\tglobal_load_lds_dwordx4 %1, %2\n\ts_mov_b32 m0, %0" : "=&s"(sv) : "v"(voff), "s"(gbase), "s"(lds_base) : "memory"); }
__device__ __forceinline__ const char* uni_ptr(const void* p) { const unsigned long long v = (unsigned long long)p;
    const unsigned lo = __builtin_amdgcn_readfirstlane((unsigned)v), hi = __builtin_amdgcn_readfirstlane((unsigned)(v >> 32)); return (const char*)(((unsigned long long)hi << 32) | lo); }
__device__ __forceinline__ void kload2(bf16x8* kf, lds_cptr kp, int d0) { kf[2 * d0] = *(const LAS bf16x8*)(kp + d0 * 2048); kf[2 * d0 + 1] = *(const LAS bf16x8*)(kp + d0 * 2048 + 512); }
__device__ __forceinline__ s16x4 vtr(lds_cptr p) { return __builtin_bit_cast(s16x4, __builtin_amdgcn_ds_read_tr16_b64_v4i16((LAS v4i16_t*)p)); }
struct UnitP { const bf16* Q; const char* K; const char* V; bf16* O; int NT, kmi; };
__device__ __forceinline__ void decode_unit(int u, int myq, const bf16* P, bf16* OD, UnitP& U) {
    int g, qt;
    if (u < 128) { const int pi = u >> 4, mp = (u >> 3) & 1; g = ((pi * 8 + myq) << 1) + mp; qt = 1 + (u & 7); }
    else { const int gi = u - 128; g = (((gi >> 1) * 8 + myq) << 1) + (gi & 1); qt = 0; }
    const int b = g >> 3, hh = g & 7;
    const size_t row0 = (size_t)b * TPB;
    U.Q = P + (row0 + qt * 256) * NP + C_Q + hh * 64; U.K = (const char*)(P + row0 * NP + C_K + hh * 64); U.V = (const char*)(P + row0 * NP + C_V + (hh >> 1) * 128);
    U.O = OD + (row0 + qt * 256) * DM + hh * 128; U.NT = qt == 0 ? CTX / 64 : TPB / 64;
    U.kmi = (b * 8 + hh) * 2;
}
__device__ __forceinline__ void attn_stream(Frame& F, int l) {
    const bf16* P = (const bf16*)(F.ws + WS_PROJ); bf16* OD = (bf16*)(F.ws + WS_OD);
    const unsigned* kmxp = (const unsigned*)F.ws + CW_KMX + 256 * l;
    gu32* qheads = (gu32*)F.ws + CW_Q + 64 * l;
    volatile LAS unsigned* slot = F.MISC + 24;
    const int limit = (l == DEPTH - 1 ? 128 : 144);
    LAS unsigned char* lds = F.lds; const int tid = F.tid;
    const int lane = tid & 63, r32 = lane & 31, hi = lane >> 5; const int wid = __builtin_amdgcn_readfirstlane(tid >> 6);
    constexpr unsigned TSTR = KVBLK * NP * 2;
    const unsigned lds0 = (unsigned)(uintptr_t)lds;
    const unsigned koff = (unsigned)(lane * NP + wid * 8) * 2;
    const unsigned voff0 = (unsigned)((16 * (wid & 3) + (lane >> 2)) * NP + (wid >> 2) * 32 + (lane & 3) * 8) * 2, voff1 = voff0 + 128;
    const unsigned kdst = lds0 + LDS_K + wid * 1024, vdst = lds0 + LDS_V + wid * 1024;
#define DMA_K(src, slotB) glds16s((src), koff, kdst + (slotB))
#define DMA_V(src, slotB) do { const char* vb_ = (src); glds16s(vb_, voff0, vdst + (slotB)); glds16s(vb_, voff1, vdst + (slotB) + 8192); } while (0)
    const lds_cptr vp0 = (lds_cptr)lds + LDS_V + ((lane >> 4) & 1) * 32 + (lane & 3) * 8 + (4 * hi + ((lane & 15) >> 2)) * 64;
    const lds_cptr kp0 = (lds_cptr)lds + LDS_K + hi * 1024 + r32 * 16;
    if (wid >= 4) __builtin_amdgcn_s_setprio(1);
    int myq = F.blk & 7, tries = 0, vstart = 0; bool warm = false; UnitP cur, nx;
    for (;;) {
        if (!warm) {
            int u;
            for (;;) {
                __syncthreads();
                if (tid == 0) slot[0] = __hip_atomic_fetch_add((unsigned*)(qheads + myq), 1u, __ATOMIC_RELAXED, __HIP_MEMORY_SCOPE_AGENT);
                __syncthreads();
                u = __builtin_amdgcn_readfirstlane((int)slot[0]);
                if (u < limit) break;
                if (++tries >= 8) { u = -1; break; }
                myq = (myq + 1) & 7;
            }
            if (u < 0) break;
            decode_unit(u, myq, P, OD, cur);
            const char* Kc = uni_ptr(cur.K); const char* Vc = uni_ptr(cur.V);
            DMA_K(Kc, 0); DMA_V(Vc, 0); DMA_K(Kc + TSTR, KSLOT); DMA_K(Kc + 2 * (size_t)TSTR, 2 * KSLOT); vstart = 0;
        }
        const char* Kh = uni_ptr(cur.K); const char* Vh = uni_ptr(cur.V); const int NT = cur.NT;
        const int tpop = NT - 5;
        unsigned nxt = 0xffffffffu;
        if (NT < 8 && tid == 0) nxt = __hip_atomic_fetch_add((unsigned*)(qheads + myq), 1u, __ATOMIC_RELAXED, __HIP_MEMORY_SCOPE_AGENT);
        bf16x8 qr[4];
        const bf16* Qw = cur.Q + (long)(wid * 32 + r32) * NP + hi * 8;
#pragma unroll
        for (int d0 = 0; d0 < 4; ++d0) qr[d0] = *(const GAS bf16x8*)(Qw + d0 * 16);
        const float kmax = sqrtf(__uint_as_float(kmxp[cur.kmi]) + __uint_as_float(kmxp[cur.kmi + 1])) * 1.01f;
        float m_row;
        { float qs = 0.f;
#pragma unroll
          for (int d0 = 0; d0 < 4; ++d0)
#pragma unroll
            for (int e = 0; e < 8; ++e) { const float qv = __uint_as_float((unsigned)(unsigned short)qr[d0][e] << 16); qs += qv * qv; }
          auto rr = __builtin_amdgcn_permlane32_swap(__float_as_uint(qs), __float_as_uint(qs), false, false);
          qs = __uint_as_float(rr[0]) + __uint_as_float(rr[1]);
          m_row = sqrtf(qs) * kmax * 1.002f + 1e-3f; }
        f32x16 negm16;
#pragma unroll
        for (int r = 0; r < 16; ++r) negm16[r] = -m_row;
        A2_PIN(negm16);
        float l_reg = 0.f; f32x16 o[4]; o[0] = f32x16{}; o[1] = f32x16{}; o[2] = f32x16{}; o[3] = f32x16{};
        f32x16 pA0, pA1, pB0, pB1; bf16x8 kf[8]; s16x4 vlo[5], vhi[5]; u32x4 pw[4];
        asm volatile("s_waitcnt vmcnt(0)" ::: "memory");
        if (NT < 8 && tid == 0) slot[1] = nxt;
        asm volatile("s_waitcnt lgkmcnt(0)\n\ts_barrier" ::: "memory");
        bool hasn = false; const char* KhN = Kh; const char* VhN = Vh;
#define GET_NEXT() do { const int un_ = __builtin_amdgcn_readfirstlane((int)slot[1]); hasn = un_ < limit; if (hasn) { decode_unit(un_, myq, P, OD, nx); KhN = uni_ptr(nx.K); VhN = uni_ptr(nx.V); } } while (0)
        if (NT < 8) GET_NEXT();
#pragma unroll
        for (int d0 = 0; d0 < 4; ++d0) kload2(kf, kp0, d0);
        pA0 = A2_MFMA(kf[0], qr[0], negm16); pA1 = A2_MFMA(kf[1], qr[0], negm16); pA0 = A2_MFMA(kf[2], qr[1], pA0); pA1 = A2_MFMA(kf[3], qr[1], pA1);
        pA0 = A2_MFMA(kf[4], qr[2], pA0); pA1 = A2_MFMA(kf[5], qr[2], pA1); pA0 = A2_MFMA(kf[6], qr[3], pA0); pA1 = A2_MFMA(kf[7], qr[3], pA1);
#pragma unroll
        for (int r = 0; r < 16; ++r) { pA0[r] = __builtin_amdgcn_exp2f(pA0[r]); pA1[r] = __builtin_amdgcn_exp2f(pA1[r]); }
        int vp = vstart;
        { int v1 = vp + VSLOT; if (v1 == 3 * VSLOT) v1 = 0; DMA_K(Kh + 3 * (size_t)TSTR, 3 * KSLOT); DMA_V(Vh + TSTR, v1); }
        kload2(kf, kp0 + KSLOT, 0); kload2(kf, kp0 + KSLOT, 1);
        A2_WAIT_BAR(3);
        int kc = KSLOT;
#define PKW(P, i) cvtpk(P[i], P[(i) + 1])
#define VFR(s) (bf16x8){vlo[s][0], vlo[s][1], vlo[s][2], vlo[s][3], vhi[s][0], vhi[s][1], vhi[s][2], vhi[s][3]}
#define VRD(s, i) do { vlo[s] = vtr(vq_ + (((i) & 3) * 4096 + ((i) >> 2) * 1024)); vhi[s] = vtr(vq_ + (((i) & 3) * 4096 + ((i) >> 2) * 1024 + 512)); } while (0)
#define GAPA(MF, W0, W1, PW) do { MF; W0; W1; A2_PIN(PW); SBAR(); } while (0)
#define GAPB(i, X, j, Y) do { if ((i) + 4 < 16) VRD(((i) + 4) % 5, (i) + 4); if ((i) == 9) kload2(kf, kn_, 0); if ((i) == 10) kload2(kf, kn_, 1); SBAR(); \
    o[(i) & 3] = A2_MFMA(VFR((i) % 5), __builtin_bit_cast(bf16x8, pw[(i) >> 2]), o[(i) & 3]); X[j] = __builtin_amdgcn_exp2f(X[j]); X[(j) + 1] = __builtin_amdgcn_exp2f(X[(j) + 1]); l_reg += Y[j]; l_reg += Y[(j) + 1]; A2_PIN(X); A2_PIN(l_reg); SBAR(); } while (0)
#define A2_STEP(C0, C1, P0, P1, t) do { \
    if ((t) == tpop) { if (tid == 0) slot[1] = __hip_atomic_fetch_add((unsigned*)(qheads + myq), 1u, __ATOMIC_RELAXED, __HIP_MEMORY_SCOPE_AGENT); } \
    if ((t) == tpop + 1) GET_NEXT();                                                                                 \
    SBAR(); \
    const lds_cptr kq_ = kp0 + kc, vq_ = vp0 + vp, kn_ = kp0 + ((kc + KSLOT) & (4 * KSLOT - 1)); \
    const int ik_ = (t) + 3, iv_ = (t) + 1; \
    const char* ks_ = ik_ < NT ? Kh + (size_t)ik_ * TSTR : KhN + (size_t)(ik_ - NT) * TSTR;                            \
    const char* vs_ = iv_ < NT ? Vh + (size_t)iv_ * TSTR : VhN; \
    const int kprev_ = (kc - KSLOT) & (4 * KSLOT - 1); int vnew_ = vp + 2 * VSLOT; if (vnew_ >= 3 * VSLOT) vnew_ -= 3 * VSLOT; \
    kload2(kf, kq_, 2); SBAR(); \
    GAPA(C0 = A2_MFMA(kf[0], qr[0], negm16), pw[0][0] = PKW(P0, 0),  pw[0][1] = PKW(P0, 2),  pw[0]); \
    kload2(kf, kq_, 3); SBAR(); \
    GAPA(C1 = A2_MFMA(kf[1], qr[0], negm16), pw[0][2] = PKW(P0, 4),  pw[0][3] = PKW(P0, 6),  pw[0]); \
    VRD(0, 0); SBAR(); GAPA(C0 = A2_MFMA(kf[2], qr[1], C0), pw[1][0] = PKW(P0, 8),  pw[1][1] = PKW(P0, 10), pw[1]); \
    VRD(1, 1); SBAR(); GAPA(C1 = A2_MFMA(kf[3], qr[1], C1), pw[1][2] = PKW(P0, 12), pw[1][3] = PKW(P0, 14), pw[1]); \
    VRD(2, 2); SBAR(); GAPA(C0 = A2_MFMA(kf[4], qr[2], C0), pw[2][0] = PKW(P1, 0),  pw[2][1] = PKW(P1, 2),  pw[2]); \
    VRD(3, 3); SBAR(); GAPA(C1 = A2_MFMA(kf[5], qr[2], C1), pw[2][2] = PKW(P1, 4),  pw[2][3] = PKW(P1, 6),  pw[2]); \
                       GAPA(C0 = A2_MFMA(kf[6], qr[3], C0), pw[3][0] = PKW(P1, 8),  pw[3][1] = PKW(P1, 10), pw[3]); \
                       GAPA(C1 = A2_MFMA(kf[7], qr[3], C1), pw[3][2] = PKW(P1, 12), pw[3][3] = PKW(P1, 14), pw[3]); \
    DMA_K(ks_, kprev_); DMA_V(vs_, vnew_); SBAR();                                                                   \
    GAPB(0, C0, 0, P0);  GAPB(1, C0, 2, P0);  GAPB(2, C0, 4, P0);   GAPB(3, C0, 6, P0);   GAPB(4, C0, 8, P0);   GAPB(5, C0, 10, P0);  GAPB(6, C0, 12, P0);  GAPB(7, C0, 14, P0); \
    GAPB(8, C1, 0, P1);  GAPB(9, C1, 2, P1);  GAPB(10, C1, 4, P1);  GAPB(11, C1, 6, P1);  GAPB(12, C1, 8, P1);  GAPB(13, C1, 10, P1); GAPB(14, C1, 12, P1); GAPB(15, C1, 14, P1); \
    A2_WAIT_BAR(3);                                                                                                   \
    kc = (kc + KSLOT) & (4 * KSLOT - 1); vp += VSLOT; if (vp == 3 * VSLOT) vp = 0; \
    } while (0)
        int t = 1;
        for (; t + 1 < NT; t += 2) {
            A2_STEP(pB0, pB1, pA0, pA1, t);
            A2_STEP(pA0, pA1, pB0, pB1, t + 1);
        }
        A2_STEP(pB0, pB1, pA0, pA1, NT - 1);
        { float sacc = pB0[0] + pB0[1];
#pragma unroll
          for (int r = 2; r < 16; ++r) sacc += pB0[r];
#pragma unroll
          for (int r = 0; r < 16; ++r) sacc += pB1[r];
          l_reg += sacc;
          pw[0] = (u32x4){PKW(pB0, 0), PKW(pB0, 2), PKW(pB0, 4), PKW(pB0, 6)}; pw[1] = (u32x4){PKW(pB0, 8), PKW(pB0, 10), PKW(pB0, 12), PKW(pB0, 14)};
          pw[2] = (u32x4){PKW(pB1, 0), PKW(pB1, 2), PKW(pB1, 4), PKW(pB1, 6)}; pw[3] = (u32x4){PKW(pB1, 8), PKW(pB1, 10), PKW(pB1, 12), PKW(pB1, 14)};
          const lds_cptr vq_ = vp0 + vp;
#pragma unroll
          for (int kg = 0; kg < 4; ++kg) {
              VRD(0, kg * 4 + 0); VRD(1, kg * 4 + 1); VRD(2, kg * 4 + 2); VRD(3, kg * 4 + 3);
              o[0] = A2_MFMA(VFR(0), __builtin_bit_cast(bf16x8, pw[kg]), o[0]); o[1] = A2_MFMA(VFR(1), __builtin_bit_cast(bf16x8, pw[kg]), o[1]);
              o[2] = A2_MFMA(VFR(2), __builtin_bit_cast(bf16x8, pw[kg]), o[2]); o[3] = A2_MFMA(VFR(3), __builtin_bit_cast(bf16x8, pw[kg]), o[3]); } }
        { auto rr = __builtin_amdgcn_permlane32_swap(__float_as_uint(l_reg), __float_as_uint(l_reg), false, false); l_reg = __uint_as_float(rr[0]) + __uint_as_float(rr[1]); }
        const float rli = __builtin_amdgcn_rcpf(l_reg);
        GAS bf16* Ow = (GAS bf16*)cur.O + (long)(wid * 32 + r32) * DM + 4 * hi;
#pragma unroll
        for (int d = 0; d < 4; ++d)
#pragma unroll
          for (int g = 0; g < 4; ++g) { u32x2 w; w.x = cvtpk(o[d][4 * g] * rli, o[d][4 * g + 1] * rli); w.y = cvtpk(o[d][4 * g + 2] * rli, o[d][4 * g + 3] * rli);
              *(GAS u32x2*)(Ow + d * 32 + 8 * g) = w; }
        vstart = vp + VSLOT; if (vstart == 3 * VSLOT) vstart = 0;
        if (hasn) { cur = nx; warm = true; }
        else { asm volatile("s_waitcnt vmcnt(0)" ::: "memory"); warm = false; }
    }
    __builtin_amdgcn_s_setprio(0);
    __syncthreads();
#undef DMA_K
#undef DMA_V
#undef PKW
#undef VFR
#undef VRD
#undef GAPA
#undef GAPB
#undef A2_STEP
#undef GET_NEXT
}
}

__device__ __forceinline__ int gla_item(int b, int h, int dir, int c) { return ((b * 4 + h) * 2 + dir) * NCH + c; }
namespace gla {
using att::bf16x8; using att::f32x16; using att::u32x4;
__device__ __forceinline__ void gates8(const bf16* P, const float* w2, const float* gb, size_t row0, int dir, int seg, int k, float (&gl)[8]) {
    float w[16];
#pragma unroll
    for (int j = 0; j < 16; ++j) w[j] = w2[j * 256 + k];
    const float bias = gb[k];
#pragma unroll
    for (int i = 0; i < 8; ++i) {
        const bf16* gp = P + (row0 + seg * 8 + i) * NP + C_GLR + dir * 16;
        const v4u a = *(const v4u*)gp, b = *(const v4u*)(gp + 8);
        float z = bias;
        z += bflo(a.x) * w[0] + bfhi(a.x) * w[1] + bflo(a.y) * w[2] + bfhi(a.y) * w[3] + bflo(a.z) * w[4] + bfhi(a.z) * w[5] + bflo(a.w) * w[6] + bfhi(a.w) * w[7];
        z += bflo(b.x) * w[8] + bfhi(b.x) * w[9] + bflo(b.y) * w[10] + bfhi(b.y) * w[11] + bflo(b.z) * w[12] + bfhi(b.z) * w[13] + bflo(b.w) * w[14] + bfhi(b.w) * w[15];
        gl[i] = (fminf(z, 0.f) - log1pf(expf(-fabsf(z)))) * (1.f / 16.f);
    }
}
__device__ __forceinline__ float lscan(const float (&gl)[8], int dir, float (&loc)[8]) {
    float run = 0.f;
    if (dir == 0) {
#pragma unroll
        for (int i = 0; i < 8; ++i) { run += gl[i]; loc[i] = run; }
    } else {
#pragma unroll
        for (int i = 7; i >= 0; --i) { run += gl[i]; loc[i] = run; }
    }
    return run;
}
__device__ __forceinline__ void stage_tile_bf16(const bf16* src, size_t pitch, char* tile, int tid) {
    const int sr = tid >> 4, sc = (tid & 15) * 8;
    const bf16x8 a = *reinterpret_cast<const bf16x8*>(src + (size_t)sr * pitch + sc), b = *reinterpret_cast<const bf16x8*>(src + (size_t)(32 + sr) * pitch + sc);
    *(bf16x8*)(tile + att::v_st(sr, sc)) = a; *(bf16x8*)(tile + att::v_st(32 + sr, sc)) = b;
}
__device__ __forceinline__ void stage_tile_f32(const float* src, char* tile, int tid) {
    const int sr = tid >> 4, sc = (tid & 15) * 8;
#pragma unroll
    for (int t = 0; t < 2; ++t) { const int row = sr + 32 * t; const f32x4 x = *(const f32x4*)(src + row * 128 + sc), y = *(const f32x4*)(src + row * 128 + sc + 4);
        u32x4 w = {att::cvtpk(x[0], x[1]), att::cvtpk(x[2], x[3]), att::cvtpk(y[0], y[1]), att::cvtpk(y[2], y[3])};
        *(u32x4*)(tile + att::v_st(row, sc)) = w; }
}
__device__ __forceinline__ void pv_sel(int d0, f32x16& o, int vb, bf16x8 a0, bf16x8 a1, bf16x8 a2, bf16x8 a3) {
    switch (d0) { case 0: att::pv_one<0>(o, vb, a0, a1, a2, a3); break; case 1: att::pv_one<1>(o, vb, a0, a1, a2, a3); break;
                  case 2: att::pv_one<2>(o, vb, a0, a1, a2, a3); break; default: att::pv_one<3>(o, vb, a0, a1, a2, a3); break; }
}
__device__ __forceinline__ void afrag4(const char* img, int row, int hi, bf16x8 (&a)[4]) {
#pragma unroll
    for (int s = 0; s < 4; ++s) a[s] = *reinterpret_cast<const bf16x8*>(img + KSWZ64(row, (s * 16 + hi * 8) * 2));
}
__device__ __forceinline__ void st_sw(char* img, int row, int col, float v) { *(unsigned short*)(img + KSWZ64(row, col * 2)) = (unsigned short)(att::cvtpk(v, 0.f) & 0xffffu); }
}

constexpr size_t WS_OG = WS_DS;
struct GlaPre { unsigned g; unsigned short q[8], k[8]; att::bf16x8 v0, v1; };
__device__ __forceinline__ void gla_prefetch(GlaPre& R, const bf16* P_, size_t row0, int h, int dir, int k, int seg, int tid) {
    const GAS bf16* P = (const GAS bf16*)P_;
    R.g = *(const GAS unsigned*)(P + (row0 + seg * 8 + (k >> 3)) * NP + C_GLR + dir * 16 + (k & 7) * 2);
#pragma unroll
    for (int i = 0; i < 8; ++i) { const GAS bf16* rp = P + (row0 + seg * 8 + i) * NP; R.q[i] = rp[C_GQ + h * 64 + k]; R.k[i] = rp[C_GK + h * 64 + k]; }
    const int sr = tid >> 4, sc = (tid & 15) * 8;
    R.v0 = *(const GAS att::bf16x8*)(P + (row0 + sr) * NP + C_GV + h * 128 + sc); R.v1 = *(const GAS att::bf16x8*)(P + (row0 + 32 + sr) * NP + C_GV + h * 128 + sc);
}
__device__ __forceinline__ void gla_chain(Frame& F, int l, int chain) {
    const int b = chain >> 3, h = (chain >> 1) & 3, dir = chain & 1;
    const bf16* P = (const bf16*)(F.ws + WS_PROJ); bf16* OG = (bf16*)(F.ws + WS_OG) + (size_t)dir * M * 512;
    char* lds = (char*)F.lds; char* Vt = lds; char* St = lds + 16384; char* KtT = lds + 32768; char* Kt = lds + 40960; char* Qt = lds + 49152; char* Qh = lds + 57344;
    float* T = (float*)(lds + 65536); float* Dec = (float*)(lds + 67584);
    const int k = F.lane, seg = F.tid >> 6, r32 = F.lane & 31, hi = F.lane >> 5, mt = F.wave >> 2, d0 = F.wave & 3;
    const int vbV = (int)(uintptr_t)Vt + att::v_rd_base(F.lane), vbS = (int)(uintptr_t)St + att::v_rd_base(F.lane);
    const int sr = F.tid >> 4, sc = (F.tid & 15) * 8;
    float w[16];
    { const float* w2 = INP(11) + (size_t)((l * 2 + dir) * 16) * 256 + h * 64;
#pragma unroll
      for (int j = 0; j < 16; ++j) w[j] = w2[j * 256 + k]; }
    const float bias = (INP(12) + (l * 2 + dir) * 256 + h * 64)[k];
    att::f32x16 S = {};
    GlaPre R, RN;
    { const int c0 = dir == 0 ? 0 : 3; gla_prefetch(RN, P, (size_t)b * TPB + c0 * 64, h, dir, k, seg, F.tid); }
    for (int j = 0; j < NCH; ++j) {
        const int c = dir == 0 ? j : (j < 4 ? 3 - j : 39 - j);
        const size_t row0 = (size_t)b * TPB + c * 64;
        R = RN;
        if (j + 1 < NCH) { const int cn = dir == 0 ? j + 1 : (j + 1 < 4 ? 2 - j : 38 - j); gla_prefetch(RN, P, (size_t)b * TPB + cn * 64, h, dir, k, seg, F.tid); }
        float gl[8], loc[8];
#pragma unroll
        for (int i = 0; i < 8; ++i) {
            float z = bias;
#pragma unroll
            for (int d = 0; d < 8; ++d) { const unsigned s = (unsigned)__builtin_amdgcn_readlane((int)R.g, i * 8 + d); z += bflo(s) * w[2 * d] + bfhi(s) * w[2 * d + 1]; }
            gl[i] = (fminf(z, 0.f) - __logf(1.f + __expf(-fabsf(z)))) * (1.f / 16.f); }
        const float segtot = gla::lscan(gl, dir, loc);
        T[seg * 64 + k] = segtot;
        *(att::bf16x8*)(Vt + att::v_st(sr, sc)) = R.v0; *(att::bf16x8*)(Vt + att::v_st(32 + sr, sc)) = R.v1;
#pragma unroll
        for (int r = 0; r < 16; ++r) *(unsigned short*)(St + att::v_st(mt * 32 + att::crow(r, hi), d0 * 32 + r32)) = (unsigned short)(att::cvtpk(S[r], 0.f) & 0xffffu);
        __syncthreads();
        float off = 0.f, tot = 0.f;
        int sg = seg; asm volatile("" : "+v"(sg));
#pragma unroll
        for (int s = 0; s < 8; ++s) { const float t = T[s * 64 + k]; tot += t; const bool inoff = dir == 0 ? (s < sg) : (s > sg); off += inoff ? t : 0.f; }
        const float etot = __expf(tot);
        float kt[8];
#pragma unroll
        for (int i = 0; i < 8; ++i) { const int tau = seg * 8 + i; const float qv = bf2f(R.q[i]), kv = bf2f(R.k[i]); const float cc = loc[i] + off;
            const float a = fmaxf(__expf(cc), 1e-30f)  , bq = __builtin_amdgcn_rcpf(a), kb = kv * bq;
            kt[i] = kb * etot;
            gla::st_sw(Qh, tau, k, qv * a); gla::st_sw(Kt, tau, k, kb); }
        { att::u32x4 wv = {att::cvtpk(kt[0], kt[1]), att::cvtpk(kt[2], kt[3]), att::cvtpk(kt[4], kt[5]), att::cvtpk(kt[6], kt[7])};
          *(att::u32x4*)(KtT + KSWZ64(k, seg * 16)) = wv; }
        if (sg == 0) Dec[k] = etot;
        __syncthreads();
        att::f32x16 o = {};
        int tau_q = mt * 32 + r32; asm volatile("" : "+v"(tau_q));
        { att::bf16x8 qr[4]; gla::afrag4(Qh, tau_q, hi, qr);
          att::f32x16 p0, p1; att::qkt(p0, p1, (const bf16*)Kt, qr, r32, hi);
#pragma unroll
          for (int r = 0; r < 16; ++r) { const int t0 = att::crow(r, hi), t1 = 32 + t0;
              const bool k0 = dir == 0 ? (t0 <= tau_q) : (t0 >= tau_q), k1 = dir == 0 ? (t1 <= tau_q) : (t1 >= tau_q);
              p0[r] = k0 ? p0[r] : 0.f; p1[r] = k1 ? p1[r] : 0.f; }
          att::bf16x8 pa0, pa1, pa2, pa3; att::pack_p(p0, p1, pa0, pa1, pa2, pa3);
          gla::pv_sel(d0, o, vbV, pa0, pa1, pa2, pa3);
          gla::pv_sel(d0, o, vbS, qr[0], qr[1], qr[2], qr[3]); }
#pragma unroll
        for (int r = 0; r < 16; ++r) S[r] *= Dec[mt * 32 + att::crow(r, hi)];
        { att::bf16x8 a[4]; gla::afrag4(KtT, mt * 32 + r32, hi, a); gla::pv_sel(d0, S, vbV, a[0], a[1], a[2], a[3]); }
        GAS bf16* op = (GAS bf16*)(OG + row0 * 512 + h * 128 + d0 * 32 + r32);
#pragma unroll
        for (int r = 0; r < 16; ++r) op[(size_t)(mt * 32 + att::crow(r, hi)) * 512] = (bf16)(att::cvtpk(o[r], 0.f) & 0xffffu);
        __syncthreads();
    }
}
__device__ __forceinline__ void p3_mixer(Frame& F, int l) {
    refresh(F);
    for (int ch = F.blk; ch < NBATCH * 8; ch += F.G) gla_chain(F, l, ch);
    att2::attn_stream(F, l);
}
__device__ __forceinline__ void p5_merge_all(Frame& F, int l) {
    refresh(F);
    const bf16* OD = (const bf16*)(F.ws + WS_OD); const bf16* OG = (const bf16*)(F.ws + WS_OG); const bf16* P = (const bf16*)(F.ws + WS_PROJ); bf16* MRG = (bf16*)(F.ws + WS_H);
    const float lam = ((const float*)(F.ws + WS_ROPE + 16384))[l]; const float omli = 1.f - lam_init_of(l);
    const float* subln = INP(14) + l * 128; const float* onorm = INP(15) + l * 128;
    const int h = F.lane >> 4, c0 = (F.lane & 15) * 8;
    const int rpw = (M + F.NGW - 1) / F.NGW, r0 = F.gw * rpw, r1 = (r0 + rpw < M) ? r0 + rpw : M;
    for (int r = r0; r < r1; ++r) {
        const v4u a = *(const v4u*)(OD + (size_t)r * DM + h * 256 + c0), bq = *(const v4u*)(OD + (size_t)r * DM + h * 256 + 128 + c0);
        const v4u gf = *(const v4u*)(OG + (size_t)r * 512 + h * 128 + c0), gbk = *(const v4u*)(OG + ((size_t)M + r) * 512 + h * 128 + c0);
        const v4u gt = *(const v4u*)(P + (size_t)r * NP + C_GG + h * 128 + c0);
        float d[8], e[8], g[8];
        d[0] = bflo(a.x) - lam * bflo(bq.x); d[1] = bfhi(a.x) - lam * bfhi(bq.x); d[2] = bflo(a.y) - lam * bflo(bq.y); d[3] = bfhi(a.y) - lam * bfhi(bq.y);
        d[4] = bflo(a.z) - lam * bflo(bq.z); d[5] = bfhi(a.z) - lam * bfhi(bq.z); d[6] = bflo(a.w) - lam * bflo(bq.w); d[7] = bfhi(a.w) - lam * bfhi(bq.w);
        e[0] = bflo(gf.x) + bflo(gbk.x); e[1] = bfhi(gf.x) + bfhi(gbk.x); e[2] = bflo(gf.y) + bflo(gbk.y); e[3] = bfhi(gf.y) + bfhi(gbk.y);
        e[4] = bflo(gf.z) + bflo(gbk.z); e[5] = bfhi(gf.z) + bfhi(gbk.z); e[6] = bflo(gf.w) + bflo(gbk.w); e[7] = bfhi(gf.w) + bfhi(gbk.w);
        g[0] = bflo(gt.x); g[1] = bfhi(gt.x); g[2] = bflo(gt.y); g[3] = bfhi(gt.y); g[4] = bflo(gt.z); g[5] = bfhi(gt.z); g[6] = bflo(gt.w); g[7] = bfhi(gt.w);
        float ss = 0.f, se = 0.f;
#pragma unroll
        for (int i = 0; i < 8; ++i) { ss += d[i] * d[i]; se += e[i] * e[i]; }
        ss = xadd<1>(ss); ss = xadd<2>(ss); ss = xadd<4>(ss); ss = xadd<8>(ss);
        se = xadd<1>(se); se = xadd<2>(se); se = xadd<4>(se); se = xadd<8>(se);
        const float sc = omli / sqrtf(ss * (1.f / 128.f) + EPS), se2 = 1.0f / sqrtf(se * (1.f / 128.f) + EPS);
#pragma unroll
        for (int i = 0; i < 8; ++i) { d[i] = d[i] * sc * subln[c0 + i]; e[i] = e[i] * se2 * onorm[c0 + i] * siluf(g[i]); }
        v4u w; w.x = pg8::cvt_pk_bf16(d[0], d[1]); w.y = pg8::cvt_pk_bf16(d[2], d[3]); w.z = pg8::cvt_pk_bf16(d[4], d[5]); w.w = pg8::cvt_pk_bf16(d[6], d[7]);
        *(v4u*)(MRG + (size_t)r * DM + h * 128 + c0) = w;
        v4u x; x.x = pg8::cvt_pk_bf16(e[0], e[1]); x.y = pg8::cvt_pk_bf16(e[2], e[3]); x.z = pg8::cvt_pk_bf16(e[4], e[5]); x.w = pg8::cvt_pk_bf16(e[6], e[7]);
        *(v4u*)(MRG + (size_t)r * DM + 512 + h * 128 + c0) = x;
    }
}

__device__ __forceinline__ float dpp_sum16(float v) {
    v += __int_as_float(__builtin_amdgcn_update_dpp(0, __float_as_int(v), 0xB1, 0xF, 0xF, true));
    v += __int_as_float(__builtin_amdgcn_update_dpp(0, __float_as_int(v), 0x4E, 0xF, 0xF, true));
    v += __int_as_float(__builtin_amdgcn_update_dpp(0, __float_as_int(v), 0x141, 0xF, 0xF, true));
    v += __int_as_float(__builtin_amdgcn_update_dpp(0, __float_as_int(v), 0x140, 0xF, 0xF, true));
    return v;
}
__device__ __forceinline__ float wave_sum2(float v) { v = dpp_sum16(v); v = xadd<16>(v); v = xadd<32>(v); return v; }
__device__ __forceinline__ float row_rinv2(const f32x4 (&v)[4]) {
    float s = 0.f;
#pragma unroll
    for (int j = 0; j < 4; ++j) s += (v[j][0] * v[j][0] + v[j][1] * v[j][1]) + (v[j][2] * v[j][2] + v[j][3] * v[j][3]);
    return __builtin_amdgcn_rsqf(wave_sum2(s) * (1.f / DM) + EPS);
}
__device__ __forceinline__ void ld_raw_bf16(const bf16* row, int lane, u32x2 (&v)[4]) {
#pragma unroll
    for (int j = 0; j < 4; ++j) v[j] = *(const u32x2*)(row + 4 * lane + 256 * j);
}
__device__ __forceinline__ f32x4 raw2f(u32x2 w) { return (f32x4){bflo(w.x), bfhi(w.x), bflo(w.y), bfhi(w.y)}; }
__device__ __forceinline__ void ld_vec(const float* p, int lane, f32x4 (&v)[4]) {
#pragma unroll
    for (int j = 0; j < 4; ++j) v[j] = *(const f32x4*)(p + 4 * lane + 256 * j);
}

__device__ __forceinline__ void p1_rows(Frame& F, int l) {
    refresh(F);
    const float* MOD = (const float*)(F.ws + WS_MOD);
    bf16* X = (bf16*)(F.ws + WS_X); bf16* H = (bf16*)(F.ws + WS_H); const bf16* F2 = (const bf16*)(F.ws + WS_F2);
    const int rpw = (M + F.NGW - 1) / F.NGW, r0 = F.gw * rpw, r1 = (r0 + rpw < M) ? r0 + rpw : M;
    if (r0 >= r1) return;
    const bool two = l > 0 && ((l - 1) & 1);
    f32x4 gpre[4], gpost[4], sh[4], sc[4], gt[4];
    ld_vec(INP(6) + l * DM, F.lane, gpre);
    if (l > 0) ld_vec(INP(9) + (l - 1) * DM, F.lane, gpost);
    int cur = -1;
    f32x4 xn[4]; u32x2 xr[4], fn[4], gn[4];
#define P1_ISSUE(r) do { const int b_ = (r) / TPB, p_ = (r) % TPB; \
        if (l == 0) ld_row_f32(p_ < CTX ? INP(2) + ((size_t)b_ * CTX + p_) * DM : INP(0) + ((size_t)b_ * SEQ + (p_ - CTX)) * DM, F.lane, xn); \
        else ld_raw_bf16(X + (size_t)(r) * DM, F.lane, xr); \
        if (l > 0) { ld_raw_bf16(F2 + (size_t)(r) * DM, F.lane, fn); if (two) ld_raw_bf16(F2 + ((size_t)M + (r)) * DM, F.lane, gn); } } while (0)
    P1_ISSUE(r0);
    for (int r = r0; r < r1; ++r) {
        f32x4 x[4]; u32x2 fr[4], gr[4];
#pragma unroll
        for (int j = 0; j < 4; ++j) { x[j] = (l == 0) ? xn[j] : raw2f(xr[j]); fr[j] = fn[j]; gr[j] = gn[j]; }
        if (r + 1 < r1) P1_ISSUE(r + 1);
        const int b = r / TPB, p = r % TPB, mrow = p < CTX ? 16 : b;
        if (mrow != cur) { cur = mrow; const float* modp = MOD + ((size_t)l * 17 + mrow) * 6144; ld_vec(modp, F.lane, sh); ld_vec(modp + 1024, F.lane, sc);
            if (l > 0) ld_vec(MOD + ((size_t)(l - 1) * 17 + mrow) * 6144 + 5 * 1024, F.lane, gt); }
        if (l > 0) {
            f32x4 f[4];
#pragma unroll
            for (int j = 0; j < 4; ++j) { f[j] = raw2f(fr[j]); if (two) f[j] = f[j] + raw2f(gr[j]); }
            const float rinv = row_rinv2(f);
#pragma unroll
            for (int j = 0; j < 4; ++j) x[j] = x[j] + gt[j] * (f[j] * rinv * gpost[j]);
        }
        st_row_bf16(X + (size_t)r * DM, F.lane, x);
        const float rinv = row_rinv2(x);
        f32x4 h[4];
#pragma unroll
        for (int j = 0; j < 4; ++j) h[j] = (x[j] * rinv * gpre[j]) * (sc[j] + 1.0f) + sh[j];
        st_row_bf16(H + (size_t)r * DM, F.lane, h);
    }
#undef P1_ISSUE
}
__device__ __forceinline__ void pf_final(Frame& F) {
    refresh(F);
    const float* MOD = (const float*)(F.ws + WS_MOD);
    const bf16* X = (const bf16*)(F.ws + WS_X); const bf16* F2 = (const bf16*)(F.ws + WS_F2);
    const int l = DEPTH - 1, NR = NBATCH * SEQ;
    const int rpw = (NR + F.NGW - 1) / F.NGW, i0 = F.gw * rpw, i1 = (i0 + rpw < NR) ? i0 + rpw : NR;
    if (i0 >= i1) return;
    f32x4 gpost[4], gt[4]; ld_vec(INP(9) + l * DM, F.lane, gpost);
    int cur = -1;
    u32x2 xn[4], fn[4], gn[4];
#define PF_ISSUE(i) do { const size_t r_ = (size_t)((i) / SEQ) * TPB + CTX + (i) % SEQ; ld_raw_bf16(X + r_ * DM, F.lane, xn); ld_raw_bf16(F2 + r_ * DM, F.lane, fn); ld_raw_bf16(F2 + ((size_t)M + r_) * DM, F.lane, gn); } while (0)
    PF_ISSUE(i0);
    for (int i = i0; i < i1; ++i) {
        f32x4 x[4], f[4];
#pragma unroll
        for (int j = 0; j < 4; ++j) { x[j] = raw2f(xn[j]); f[j] = raw2f(fn[j]) + raw2f(gn[j]); }
        if (i + 1 < i1) PF_ISSUE(i + 1);
        const int b = i / SEQ;
        if (b != cur) { cur = b; ld_vec(MOD + ((size_t)l * 17 + b) * 6144 + 5 * 1024, F.lane, gt); }
        const float rinv = row_rinv2(f);
#pragma unroll
        for (int j = 0; j < 4; ++j) x[j] = x[j] + gt[j] * (f[j] * rinv * gpost[j]);
        st_row_f32(F.A->out + (size_t)i * DM, F.lane, x);
    }
#undef PF_ISSUE
}
__device__ __forceinline__ void p7_rows(Frame& F, int l) {
    refresh(F);
    const float* MOD = (const float*)(F.ws + WS_MOD);
    bf16* X = (bf16*)(F.ws + WS_X); const bf16* Y = (const bf16*)(F.ws + WS_Y); bf16* H2 = (bf16*)(F.ws + WS_H2);
    const bool moe = l & 1; const int li = l >> 1;
    int* TOPE = (int*)(F.ws + WS_TOPE); int* LIDX = (int*)(F.ws + WS_LIDX); float* TOPW = (float*)(F.ws + WS_TOPW); int* BLKB = (int*)(F.ws + WS_BLKB);
    volatile LAS unsigned* LCNT = F.MISC + 16;
    LAS float* RT = (LAS float*)F.lds;
    if (moe) {
        const float* router = INP(20) + (size_t)li * DM * NE;
        if (F.tid < 8) LCNT[F.tid] = 0u;
        for (int i = F.tid; i < DM * NE / 4; i += 512) { const f32x4 q = *(const f32x4*)(router + 4 * i); const int c = i >> 1, e0 = (i & 1) * 4;
            RT[(e0 + 0) * DM + c] = q[0]; RT[(e0 + 1) * DM + c] = q[1]; RT[(e0 + 2) * DM + c] = q[2]; RT[(e0 + 3) * DM + c] = q[3]; }
        __syncthreads();
    }
    const bool lastl = (l == DEPTH - 1); const int NR = lastl ? NBATCH * SEQ : M;
#define P7_ROW(i) (lastl ? ((i) / SEQ) * TPB + CTX + (i) % SEQ : (i))
    const int rpw = (NR + F.NGW - 1) / F.NGW, r0 = F.gw * rpw, r1 = (r0 + rpw < NR) ? r0 + rpw : NR;
    if (r0 < r1) {
        f32x4 gpost[4], gpre[4], gt[4], sh[4], sc[4];
        ld_vec(INP(7) + l * DM, F.lane, gpost); ld_vec(INP(8) + l * DM, F.lane, gpre);
        int cur = -1;
        u32x2 xn[4], yn[4];
        ld_raw_bf16(X + (size_t)P7_ROW(r0) * DM, F.lane, xn); ld_raw_bf16(Y + (size_t)P7_ROW(r0) * DM, F.lane, yn);
        for (int ri = r0; ri < r1; ++ri) {
            const int r = P7_ROW(ri);
            f32x4 x[4], y[4];
#pragma unroll
            for (int j = 0; j < 4; ++j) { x[j] = raw2f(xn[j]); y[j] = raw2f(yn[j]); }
            if (ri + 1 < r1) { const int rn = P7_ROW(ri + 1); ld_raw_bf16(X + (size_t)rn * DM, F.lane, xn); ld_raw_bf16(Y + (size_t)rn * DM, F.lane, yn); }
            const int b = r / TPB, p = r % TPB, mrow = p < CTX ? 16 : b;
            if (mrow != cur) { cur = mrow; const float* modp = MOD + ((size_t)l * 17 + mrow) * 6144; ld_vec(modp + 2 * 1024, F.lane, gt); ld_vec(modp + 3 * 1024, F.lane, sh); ld_vec(modp + 4 * 1024, F.lane, sc); }
            const float ry = row_rinv2(y);
#pragma unroll
            for (int j = 0; j < 4; ++j) x[j] = x[j] + gt[j] * (y[j] * ry * gpost[j]);
            st_row_bf16(X + (size_t)r * DM, F.lane, x);
            const float rx = row_rinv2(x);
            f32x4 h[4];
#pragma unroll
            for (int j = 0; j < 4; ++j) h[j] = (x[j] * rx * gpre[j]) * (sc[j] + 1.0f) + sh[j];
            if constexpr (FFN_F8) {
#pragma unroll
                for (int j = 0; j < 4; ++j) *(unsigned*)((unsigned char*)H2 + (size_t)r * DM + 4 * F.lane + 256 * j) = pk4_f8(h[j][0], h[j][1], h[j][2], h[j][3]);
            } else st_row_bf16(H2 + (size_t)r * DM, F.lane, h);
            if (moe) {
                float lg[8];
#pragma unroll
                for (int e = 0; e < 8; ++e) lg[e] = 0.f;
#pragma unroll
                for (int j = 0; j < 4; ++j)
#pragma unroll
                    for (int e = 0; e < 8; ++e) { const f32x4 q = *(const LAS f32x4*)(RT + e * DM + 4 * F.lane + 256 * j); lg[e] += (h[j][0] * q[0] + h[j][1] * q[1]) + (h[j][2] * q[2] + h[j][3] * q[3]); }
#pragma unroll
                for (int e = 0; e < 8; ++e) lg[e] = wave_sum2(lg[e]);
                int e0 = 0; float v0 = lg[0];
#pragma unroll
                for (int e = 1; e < 8; ++e) if (lg[e] > v0) { v0 = lg[e]; e0 = e; }
                int e1 = -1; float v1 = -3.0e38f;
#pragma unroll
                for (int e = 0; e < 8; ++e) if (e != e0 && lg[e] > v1) { v1 = lg[e]; e1 = e; }
                const float ex = __expf(v1 - v0), w0 = 1.f / (1.f + ex), w1 = ex / (1.f + ex);
                if (F.lane == 0) {
                    const unsigned i0 = __hip_atomic_fetch_add((LAS unsigned*)&LCNT[e0], 1u, __ATOMIC_RELAXED, __HIP_MEMORY_SCOPE_WORKGROUP), i1 = __hip_atomic_fetch_add((LAS unsigned*)&LCNT[e1], 1u, __ATOMIC_RELAXED, __HIP_MEMORY_SCOPE_WORKGROUP);
                    TOPE[r] = e0 | (e1 << 8); LIDX[2 * r] = (int)i0; LIDX[2 * r + 1] = (int)i1; TOPW[2 * r] = w0; TOPW[2 * r + 1] = w1;
                }
            }
        }
    }
    if (moe) {
        __syncthreads();
        if (F.tid < 8) { const unsigned base = __hip_atomic_fetch_add((unsigned*)((gu32*)F.ws + CW_CNT + 64 * li + F.tid), LCNT[F.tid], __ATOMIC_RELAXED, __HIP_MEMORY_SCOPE_AGENT); BLKB[F.blk * 8 + F.tid] = (int)base; }
    }
#undef P7_ROW
}
__device__ __forceinline__ void moe_offsets(Frame& F, int li, int (&cnt)[8], int (&off)[9]) {
    off[0] = 0;
#pragma unroll
    for (int e = 0; e < 8; ++e) { cnt[e] = (int)__hip_atomic_load((unsigned*)(((gu32*)F.ws) + CW_CNT + 64 * li + e), __ATOMIC_RELAXED, __HIP_MEMORY_SCOPE_AGENT); off[e + 1] = off[e] + ((cnt[e] + 255) & ~255); }
}
__device__ __forceinline__ void p7b_gather(Frame& F, int l) {
    refresh(F);
    const int li = l >> 1; int cnt[8], off[9]; moe_offsets(F, li, cnt, off);
    const bf16* H2 = (const bf16*)(F.ws + WS_H2); bf16* HG = (bf16*)(F.ws + WS_HG);
    const int* TOPE = (const int*)(F.ws + WS_TOPE); const int* LIDX = (const int*)(F.ws + WS_LIDX); const float* TOPW = (const float*)(F.ws + WS_TOPW); const int* BLKB = (const int*)(F.ws + WS_BLKB);
    int* RMAP = (int*)(F.ws + WS_RMAP); float* ROWW = (float*)(F.ws + WS_ROWW);
    constexpr int RB = FFN_F8 ? DM : 2 * DM, LB = RB / 64;
    const unsigned char* H2b = (const unsigned char*)H2; unsigned char* HGb = (unsigned char*)HG;
    const bool lastl = (l == DEPTH - 1); const int NR = lastl ? NBATCH * SEQ : M;
    const int rpw = (NR + F.NGW - 1) / F.NGW, r0 = F.gw * rpw, r1 = (r0 + rpw < NR) ? r0 + rpw : NR;
    for (int ri = r0; ri < r1; ++ri) {
        const int r = lastl ? (ri / SEQ) * TPB + CTX + ri % SEQ : ri;
        const int te = TOPE[r];
        v4u a, bq = {0u, 0u, 0u, 0u}; a = *(const v4u*)(H2b + (size_t)r * RB + F.lane * LB); if constexpr (!FFN_F8) bq = *(const v4u*)(H2b + (size_t)r * RB + F.lane * LB + 16);
#pragma unroll
        for (int s = 0; s < 2; ++s) {
            const int e = (te >> (8 * s)) & 0xff;
            int o = 0;
#pragma unroll
            for (int q = 0; q < 8; ++q) o = (q == e) ? off[q] : o;
            const int pos = o + BLKB[F.blk * 8 + e] + LIDX[2 * r + s];
            *(v4u*)(HGb + (size_t)pos * RB + F.lane * LB) = a; if constexpr (!FFN_F8) *(v4u*)(HGb + (size_t)pos * RB + F.lane * LB + 16) = bq;
            if (F.lane == 0) { RMAP[pos] = r | (s << 30); ROWW[pos] = TOPW[2 * r + s]; }
        }
    }
#pragma unroll
    for (int e = 0; e < 8; ++e) {
        const int npad = off[e + 1] - off[e] - cnt[e];
        for (int i = F.gw; i < npad; i += F.NGW) { const int pos = off[e] + cnt[e] + i; const unsigned zz = (unsigned)F.z; const v4u z = {zz, zz, zz, zz};
            *(v4u*)(HGb + (size_t)pos * RB + F.lane * LB) = z; if constexpr (!FFN_F8) *(v4u*)(HGb + (size_t)pos * RB + F.lane * LB + 16) = z;
            if (F.lane == 0) { RMAP[pos] = -1; ROWW[pos] = 0.f; } }
    }
}

__global__ void __launch_bounds__(NWAVES * 64, 2) mk_fwd(Args args) {
    extern __shared__ __attribute__((aligned(16))) unsigned char lds[];
    Frame F;
    F.lds = (LAS unsigned char*)lds;
    F.MISC = (volatile LAS unsigned*)(F.lds + MISC_OFF);
    F.tid = threadIdx.x; F.lane = F.tid & 63; F.wave = __builtin_amdgcn_readfirstlane(F.tid >> 6); F.wv = F.wave;
    F.G = gridDim.x; F.blk = blockIdx.x; F.gw = F.blk * NWAVES + F.wave; F.NGW = F.G * NWAVES;
    F.ws = args.ws;
    F.A = &args;
    for (int u = F.tid; u < 128; u += NWAVES * 64) F.MISC[u] = 0u;
    __syncthreads();
    { XcdBarrier b0 = xcd_barrier_post((unsigned*)F.ws + CW_BAR, F.MISC + 8); (void)b0; }
#define GRID_BAR() do { XcdBarrier b_; b_.bar = (unsigned*)F.ws + CW_BAR; b_.x = xb_xcc_id(); b_.st = F.MISC + 8; refresh(F); xcd_barrier(b_, F.tid == 0); } while (0)

    p0_mod(F); p0_misc(F); convert_weights(F, 0);
    GRID_BAR();
    for (int l = 0; l < DEPTH; ++l) {
        const bool moe = l & 1; const int li = l >> 1;
        { unsigned char* wsp = args.ws; asm volatile("" : "+s"(wsp)); F.ws = wsp; }
        p1_rows(F, l);
        if (l > 0) convert_weights(F, l);
        GRID_BAR();
        {
            refresh(F);
            pg8::Gemm g{(const pg8::bf16_t*)(F.ws + WS_H), (const pg8::bf16_t*)(F.ws + WS_WIN), M, NP, DM};
            pg8::StaticOrder S; S.init(M, NP, F.G, F.blk);
            pg8::EpiProj E{(pg8::bf16_t*)(F.ws + WS_PROJ), (const float*)(F.ws + WS_ROPE), (const float*)(F.ws + WS_ROPE) + 1024, (unsigned*)F.ws + CW_KMX + 256 * l};
            pg8::gemm_phase<pg8::EpiProj, pg8::StaticOrder, true, true>(F.lds, g, S, E, F.wave);
        }
        GRID_BAR();
        p3_mixer(F, l);
        GRID_BAR();
        p5_merge_all(F, l);
        GRID_BAR();
        {
            refresh(F);
            pg8::Gemm g{(const pg8::bf16_t*)(F.ws + WS_H), (const pg8::bf16_t*)(F.ws + WS_WOUT), M, DM, DM};
            const int lastl = (l == DEPTH - 1);
            pg8::LatOrder S; S.S.init(lastl ? NBATCH * SEQ : M, DM, F.G, F.blk); S.lat = lastl;
            pg8::EpiF32 E{(pg8::bf16_t*)(F.ws + WS_Y)};
            pg8::gemm_phase<pg8::EpiF32, pg8::LatOrder, true, true>(F.lds, g, S, E, F.wave);
        }
        GRID_BAR();
        p7_rows(F, l);
        GRID_BAR();
        if (moe) { p7b_gather(F, l); GRID_BAR(); }
        int ntiles = M / 256;
        {
            refresh(F);
            LAS int* texp = (LAS int*)(F.lds + TEXP_OFF);
            if (moe) { int cnt[8], off[9]; moe_offsets(F, li, cnt, off); ntiles = off[8] >> 8;
                for (int t = F.tid; t < ntiles; t += 512) { int e = 0;
#pragma unroll
                    for (int q = 1; q < 8; ++q) e += ((t << 8) >= off[q]) ? 1 : 0;
                    texp[t] = e; } }
            else { for (int t = F.tid; t < ntiles; t += 512) texp[t] = 0; }
            __syncthreads();
        }
        {
            refresh(F);
            pg8::Gemm g{(const pg8::bf16_t*)(F.ws + (moe ? WS_HG : WS_H2)), (const pg8::bf16_t*)(F.ws + WS_WUP), ntiles * 256, 2 * DFF, FFN_F8 ? DM / 2 : DM};
            pg8::GroupedOrder S; S.S.init(ntiles * 256, 2 * DFF, F.G, F.blk); S.texp = (const LAS int*)(F.lds + TEXP_OFF); S.nN = 22;
            pg8::EpiSwiglu E{(pg8::bf16_t*)(F.ws + WS_U)};
            pg8::gemm_phase<pg8::EpiSwiglu, pg8::GroupedOrder, true, true, FFN_F8 != 0>(F.lds, g, S, E, F.wave);
        }
        GRID_BAR();
        {
            refresh(F);
            pg8::Gemm g{(const pg8::bf16_t*)(F.ws + WS_U), (const pg8::bf16_t*)(F.ws + WS_WDN), ntiles * 256, DM, FFN_F8 ? DFF / 2 : DFF};
            pg8::GroupedOrder S; S.S.init(ntiles * 256, DM, F.G, F.blk); S.texp = (const LAS int*)(F.lds + TEXP_OFF); S.nN = 4;
            pg8::EpiDown E{(pg8::bf16_t*)(F.ws + WS_F2), (const int*)(F.ws + WS_RMAP), (const float*)(F.ws + WS_ROWW), moe ? 0 : 1};
            pg8::gemm_phase<pg8::EpiDown, pg8::GroupedOrder, true, true, FFN_F8 != 0>(F.lds, g, S, E, F.wave);
        }
        GRID_BAR();
    }
    pf_final(F);
}

extern "C" void kernel_launch(void* const* d_in, const int* in_sizes, int n_in, void* d_out, int out_size, void* d_ws, size_t ws_size, hipStream_t stream) {
    static int grid = 0;
    if (grid == 0) {
        if (n_in != 24 || out_size != NBATCH * SEQ * DM || ws_size < WS_END) { fprintf(stderr, "kernel_launch: unexpected shapes or workspace (%d inputs, out %d, ws %zu < %zu)\n", n_in, out_size, ws_size, (size_t)WS_END); grid = -1; return; }
        int dev = 0, cus = 0, per_cu = 0;
        if (hipGetDevice(&dev) != hipSuccess || hipDeviceGetAttribute(&cus, hipDeviceAttributeMultiprocessorCount, dev) != hipSuccess) { grid = -1; return; }
        if (hipFuncSetAttribute((const void*)mk_fwd, hipFuncAttributeMaxDynamicSharedMemorySize, LDS_BYTES) != hipSuccess) { grid = -1; return; }
        if (hipOccupancyMaxActiveBlocksPerMultiprocessor(&per_cu, (const void*)mk_fwd, NWAVES * 64, LDS_BYTES) != hipSuccess || per_cu < 1) { fprintf(stderr, "kernel_launch: occupancy query says %d\n", per_cu); }
        (void)hipGetLastError();
        grid = cus;
    }
    if (grid < 0) return;
    if (hipMemsetAsync((char*)d_ws + WS_CTL, 0, CTL_ZERO_BYTES, stream) != hipSuccess) return;
    Args a{};
    for (int i = 0; i < 24; ++i) a.in[i] = (const float*)d_in[i];
    a.out = (float*)d_out; a.ws = (unsigned char*)d_ws;
    hipLaunchKernelGGL(mk_fwd, dim3(grid), dim3(NWAVES * 64), LDS_BYTES, stream, a);
}
```

```cpp
#include <hip/hip_runtime.h>
#include <cstdio>
#include <cstdint>
namespace pg8 {
#define PG8_LAS __attribute__((address_space(3)))
typedef unsigned short bf16_t;
__device__ __forceinline__ int lane_id_opaque() { int l; asm volatile("v_mbcnt_lo_u32_b32 %0, -1, 0\n\tv_mbcnt_hi_u32_b32 %0, -1, %0" : "=v"(l)); return l; }
typedef short bf16x8 __attribute__((ext_vector_type(8)));
typedef float f32x4 __attribute__((ext_vector_type(4)));
typedef unsigned u32x4 __attribute__((ext_vector_type(4)));
constexpr int BM = 256, BK = 64, HALF = 128, HTB = HALF * BK * 2  , STAGE_BYTES = 8 * HTB, NXCD = 8, WGM = 8;

__host__ __device__ __forceinline__ int lds_byte(int r, int c) { const int st = (r >> 4) * 2 + (c >> 5), rr = r & 15, cc = c & 31, ob = rr * 64 + cc * 2; return st * 1024 + (ob ^ (((ob >> 9) & 1) << 5)); }
__host__ __device__ __forceinline__ void stage_rc(int b, int& R, int& C) { const int st = b / 1024, sb = b % 1024, swz = sb ^ (((sb >> 9) & 1) << 5); R = (st >> 1) * 16 + swz / 64; C = (st & 1) * 32 + (swz % 64) / 2; }
__host__ __device__ __forceinline__ int perm32(int rho) { const int n = rho >> 4, i = rho & 15; return 8 * (i >> 2) + 4 * n + (i & 3); }

struct Unit { int pm, pn; };
struct Gemm { const bf16_t* A; const bf16_t* Bt; int M, N, K; };

struct StaticOrder {
    int nM, nN, nwg, G, c;
    __host__ __device__ void init(int M, int N, int G_, int c_) { nM = M / BM; nN = N / BM; nwg = nM * nN; G = G_; c = c_; }
    __host__ __device__ bool next(int i, Unit& u) const {
        const long L = (long)i * G + c; if (L >= nwg) return false;
        int wgid = (int)L; { const int q = nwg / NXCD, r = nwg % NXCD, xcd = wgid % NXCD, off = wgid / NXCD; wgid = (xcd < r ? xcd * (q + 1) : r * (q + 1) + (xcd - r) * q) + off; }
        const int nig = WGM * nN, gid = wgid / nig, fm = gid * WGM, gsz = (nM - fm) < WGM ? (nM - fm) : WGM;
        u.pm = fm + ((wgid % nig) % gsz); u.pn = (wgid % nig) / gsz; return true;
    }
    __device__ __forceinline__ void a_ready(const Unit&) const {}
    __device__ __forceinline__ void done(const Unit&) const {}
};

__device__ __forceinline__ unsigned cvt_pk_bf16(float lo, float hi) { unsigned r; asm volatile("v_cvt_pk_bf16_f32 %0, %1, %2" : "=v"(r) : "v"(lo), "v"(hi)); return r; }
typedef float f32x2 __attribute__((ext_vector_type(2)));
template <class Epi, class Sched, bool ALIGN_EPI = false, bool SP2 = false, bool F8 = false>
__device__ __forceinline__ void gemm_phase(PG8_LAS unsigned char* lds, const Gemm g, const Sched& S, const Epi& E, const int wv  ) {
    int tid_ = wv * 64 + lane_id_opaque();
    const int tid = tid_, wid = __builtin_amdgcn_readfirstlane(tid >> 6), lane = tid & 63, wr = wid >> 2, wc = wid & 3, fr = lane & 15, fq = lane >> 4;
    const int K = g.K, nt = K / BK;
    unsigned voffA[2], voffB[2];
#pragma unroll
    for (int i = 0; i < 2; ++i) { int R, C; stage_rc(tid * 16 + i * 8192, R, C); const int Rb = Epi::PERM ? ((R & ~31) + perm32(R & 31)) : R;
        voffA[i] = (unsigned)(R * K + C) * 2u; voffB[i] = (unsigned)(Rb * K + C) * 2u; }
    const size_t kstep = (size_t)(BK * 2);
    const size_t hstep = (size_t)HALF * K * 2;
    const size_t tstep = 2 * hstep;
    const unsigned ldsw = (unsigned)wid * 1024u;
    const int aoff = lds_byte(wr * 64 + fr, fq * 8), boff = lds_byte(wc * 32 + fr, fq * 8);
#define PG8_SA(b, h) (((b) * 2 + (h)) * HTB)
#define PG8_SB(b, h) ((4 + (b) * 2 + (h)) * HTB)
#define PG8_STAGE(bufoff, gbase, voff) do { _Pragma("unroll") for (int _i = 0; _i < 2; ++_i) \
        __builtin_amdgcn_global_load_lds((const __attribute__((address_space(1))) unsigned*)((const __attribute__((address_space(1))) char*)(gbase) + (voff)[_i]), (PG8_LAS unsigned*)(lds + (bufoff) + ldsw + _i * 8192), 16, 0, 0); } while (0)
#define PG8_LDA(dst, b, h) do { _Pragma("unroll") for (int m = 0; m < 4; ++m) _Pragma("unroll") for (int k = 0; k < 2; ++k) dst[m][k] = *(const PG8_LAS bf16x8*)(lds + PG8_SA(b, h) + aoff + m * 2048 + k * 1024); } while (0)
#define PG8_LDB(dst, b, h) do { _Pragma("unroll") for (int n = 0; n < 2; ++n) _Pragma("unroll") for (int k = 0; k < 2; ++k) dst[n][k] = *(const PG8_LAS bf16x8*)(lds + PG8_SB(b, h) + boff + n * 2048 + k * 1024); } while (0)
#define PG8_MMA(ai, bj, At, Bt) do { if constexpr (F8) __builtin_amdgcn_sched_barrier(0); __builtin_amdgcn_s_setprio(1); _Pragma("unroll") for (int m = 0; m < 4; ++m) _Pragma("unroll") for (int n = 0; n < 2; ++n) { \
        if constexpr (F8) { typedef int i32x4_ __attribute__((ext_vector_type(4))); \
            acc[ai][bj][m][n] = __builtin_amdgcn_mfma_scale_f32_16x16x128_f8f6f4(__builtin_shufflevector(__builtin_bit_cast(i32x4_, Bt[n][0]), __builtin_bit_cast(i32x4_, Bt[n][1]), 0, 1, 2, 3, 4, 5, 6, 7), \
                __builtin_shufflevector(__builtin_bit_cast(i32x4_, At[m][0]), __builtin_bit_cast(i32x4_, At[m][1]), 0, 1, 2, 3, 4, 5, 6, 7), acc[ai][bj][m][n], 0, 0, 0, 0x7f7f7f7f, 0, 0x7f7f7f7f); } \
        else { _Pragma("unroll") for (int k = 0; k < 2; ++k) acc[ai][bj][m][n] = __builtin_amdgcn_mfma_f32_16x16x32_bf16(Bt[n][k], At[m][k], acc[ai][bj][m][n], 0, 0, 0); } } \
        __builtin_amdgcn_s_setprio(0); if constexpr (F8) __builtin_amdgcn_sched_barrier(0); } while (0)
#define PG8_WAIT_V(n) asm volatile("s_waitcnt vmcnt(" #n ")" ::: "memory")
#define PG8_WAIT_L(n) asm volatile("s_waitcnt lgkmcnt(" #n ")" ::: "memory")
#define PG8_BAR __builtin_amdgcn_s_barrier()
#define PG8_SCHED __builtin_amdgcn_sched_barrier(0)
    Unit cur, nxt; int ui = 0;
    if (!S.next(0, cur)) return;
    f32x4 acc[2][2][4][2];
#pragma unroll
    for (int a = 0; a < 2; ++a)
#pragma unroll
        for (int b = 0; b < 2; ++b)
#pragma unroll
            for (int m = 0; m < 4; ++m)
#pragma unroll
                for (int n = 0; n < 2; ++n) acc[a][b][m][n] = (f32x4){0.f, 0.f, 0.f, 0.f};
    bf16x8 At[4][2], B0[2][2], B1[2][2];
    const char* cA = (const char*)g.A + (size_t)cur.pm * tstep; const char* cB = (const char*)g.Bt + (size_t)cur.pn * tstep;
    S.a_ready(cur);
    if constexpr (SP2) {
        PG8_STAGE(PG8_SB(0, 0), cB, voffB); PG8_STAGE(PG8_SB(0, 1), cB + hstep, voffB); PG8_STAGE(PG8_SA(0, 0), cA, voffA); PG8_STAGE(PG8_SA(0, 1), cA + hstep, voffA);
        if (wr == 1) PG8_BAR;
        PG8_WAIT_V(2); PG8_BAR;
        PG8_STAGE(PG8_SB(1, 0), cB + kstep, voffB); PG8_STAGE(PG8_SA(1, 0), cA + kstep, voffA); PG8_STAGE(PG8_SB(1, 1), cB + hstep + kstep, voffB);
        PG8_WAIT_V(6); PG8_BAR;
    } else {
        PG8_STAGE(PG8_SB(0, 0), cB, voffB); PG8_STAGE(PG8_SA(0, 0), cA, voffA); PG8_STAGE(PG8_SB(0, 1), cB + hstep, voffB); PG8_STAGE(PG8_SA(0, 1), cA + hstep, voffA);
        if (wr == 1) PG8_BAR;
        PG8_WAIT_V(4); PG8_BAR;
        PG8_STAGE(PG8_SB(1, 0), cB + kstep, voffB); PG8_STAGE(PG8_SA(1, 0), cA + kstep, voffA); PG8_STAGE(PG8_SB(1, 1), cB + hstep + kstep, voffB);
        PG8_WAIT_V(6); PG8_BAR;
    }
    for (;;) {
        const bool has_next = S.next(ui + 1, nxt);
        const char* nA = has_next ? (const char*)g.A + (size_t)nxt.pm * tstep : cA; const char* nB = has_next ? (const char*)g.Bt + (size_t)nxt.pn * tstep : cB;
        for (int t = 0; t < nt; t += 2) {
            const bool last = (t == nt - 2);
            const char* a1 = cA + (size_t)(t + 1) * kstep;
            const char* a2 = last ? nA : cA + (size_t)(t + 2) * kstep; const char* b2 = last ? nB : cB + (size_t)(t + 2) * kstep;
            const char* a3 = a2 + kstep; const char* b3 = b2 + kstep;
            if (last && has_next) S.a_ready(nxt);
            if constexpr (SP2) {
            PG8_LDB(B0, 0, 0); PG8_LDB(B1, 0, 1); PG8_SCHED; PG8_LDA(At, 0, 0); PG8_STAGE(PG8_SA(1, 1), a1 + hstep, voffA);
            PG8_WAIT_V(8); PG8_WAIT_L(0); PG8_BAR; PG8_MMA(0, 0, At, B0); PG8_MMA(0, 1, At, B1); PG8_BAR; PG8_SCHED;
            PG8_LDA(At, 0, 1); PG8_STAGE(PG8_SB(0, 0), b2, voffB); PG8_STAGE(PG8_SB(0, 1), b2 + hstep, voffB); PG8_STAGE(PG8_SA(0, 0), a2, voffA);
            PG8_WAIT_V(8); PG8_WAIT_L(0); PG8_BAR; PG8_MMA(1, 0, At, B0); PG8_MMA(1, 1, At, B1); PG8_BAR; PG8_SCHED;
            PG8_LDB(B0, 1, 0); PG8_LDB(B1, 1, 1); PG8_SCHED; PG8_LDA(At, 1, 0); PG8_STAGE(PG8_SA(0, 1), a2 + hstep, voffA);
            PG8_WAIT_V(8); PG8_WAIT_L(0); PG8_BAR; PG8_MMA(0, 0, At, B0); PG8_MMA(0, 1, At, B1); PG8_BAR; PG8_SCHED;
            PG8_LDA(At, 1, 1); PG8_STAGE(PG8_SB(1, 0), b3, voffB); PG8_STAGE(PG8_SB(1, 1), b3 + hstep, voffB); PG8_STAGE(PG8_SA(1, 0), a3, voffA);
            PG8_WAIT_V(8); PG8_WAIT_L(0); PG8_BAR; PG8_MMA(1, 0, At, B0); PG8_MMA(1, 1, At, B1); PG8_BAR; PG8_SCHED;
            } else {
            PG8_LDB(B0, 0, 0); PG8_SCHED; PG8_LDA(At, 0, 0); PG8_STAGE(PG8_SA(1, 1), a1 + hstep, voffA);
            PG8_WAIT_L(8); PG8_BAR; PG8_WAIT_L(0); PG8_MMA(0, 0, At, B0); PG8_BAR; PG8_SCHED;
            PG8_LDB(B1, 0, 1); PG8_STAGE(PG8_SB(0, 0), b2, voffB);
            PG8_BAR; PG8_WAIT_L(0); PG8_MMA(0, 1, At, B1); PG8_BAR;
            PG8_LDA(At, 0, 1); PG8_STAGE(PG8_SA(0, 0), a2, voffA);
            PG8_BAR; PG8_WAIT_L(0); PG8_MMA(1, 0, At, B0); PG8_BAR; PG8_SCHED;
            PG8_STAGE(PG8_SB(0, 1), b2 + hstep, voffB);
            PG8_WAIT_V(6); PG8_BAR; PG8_MMA(1, 1, At, B1); PG8_BAR;
            PG8_LDB(B0, 1, 0); PG8_SCHED; PG8_LDA(At, 1, 0); PG8_STAGE(PG8_SA(0, 1), a2 + hstep, voffA);
            PG8_WAIT_L(8); PG8_BAR; PG8_WAIT_L(0); PG8_MMA(0, 0, At, B0); PG8_BAR; PG8_SCHED;
            PG8_LDB(B1, 1, 1); PG8_STAGE(PG8_SB(1, 0), b3, voffB);
            PG8_BAR; PG8_WAIT_L(0); PG8_MMA(0, 1, At, B1); PG8_BAR;
            PG8_LDA(At, 1, 1); PG8_STAGE(PG8_SA(1, 0), a3, voffA);
            PG8_BAR; PG8_WAIT_L(0); PG8_MMA(1, 0, At, B0); PG8_BAR; PG8_SCHED;
            PG8_STAGE(PG8_SB(1, 1), b3 + hstep, voffB);
            PG8_WAIT_V(6); PG8_BAR; PG8_MMA(1, 1, At, B1); PG8_BAR;
            }
        }
        if constexpr (ALIGN_EPI) { if (wr == 0) PG8_BAR; }
        if constexpr (!Epi::AFTER_DRAIN) { const int t2_ = lane_id_opaque(); const int fr_ = t2_ & 15, fq_ = (t2_ & 63) >> 4;
            E(acc, cur, wr, wc, fr_, fq_); S.done(cur); }
        if (!has_next) break;
#pragma unroll
        for (int a = 0; a < 2; ++a)
#pragma unroll
            for (int b = 0; b < 2; ++b)
#pragma unroll
                for (int m = 0; m < 4; ++m)
#pragma unroll
                    for (int n = 0; n < 2; ++n) acc[a][b][m][n] = (f32x4){0.f, 0.f, 0.f, 0.f};
        cur = nxt; cA = nA; cB = nB; ++ui;
        if constexpr (ALIGN_EPI) { if (wr == 1) PG8_BAR; }
    }
    PG8_WAIT_V(0);
    if constexpr (!ALIGN_EPI) { if (wr == 0) PG8_BAR; }
    PG8_BAR;
    if constexpr (Epi::AFTER_DRAIN) { E.fused(acc, cur, wr, wc, fr, fq, lds, wid, lane); S.done(cur); }
#undef PG8_SA
#undef PG8_SB
#undef PG8_STAGE
#undef PG8_LDA
#undef PG8_LDB
#undef PG8_MMA
#undef PG8_WAIT_V
#undef PG8_WAIT_L
#undef PG8_BAR
#undef PG8_SCHED
}
}
#define GAS __attribute__((address_space(1)))
#define LAS __attribute__((address_space(3)))
typedef unsigned short bf16;
typedef unsigned v4u __attribute__((ext_vector_type(4)));
typedef float f32x4 __attribute__((ext_vector_type(4)));
typedef short bf16x8 __attribute__((ext_vector_type(8)));
typedef GAS unsigned gu32;
typedef GAS unsigned long long gu64;
#define RLX_AGENT __ATOMIC_RELAXED, __HIP_MEMORY_SCOPE_AGENT
#define LDS_WAIT() asm volatile("s_waitcnt lgkmcnt(0)" ::: "memory")
#define VM_WAIT() asm volatile("s_waitcnt vmcnt(0)" ::: "memory")
__device__ __forceinline__ unsigned long long rt() { return __builtin_amdgcn_s_memrealtime(); }
__device__ __forceinline__ unsigned f2bf(float f) { unsigned u = __builtin_bit_cast(unsigned, f); return (u + 0x7fffu + ((u >> 16) & 1u)) >> 16; }
__device__ __forceinline__ unsigned pk2(float lo, float hi) { return f2bf(lo) | (f2bf(hi) << 16); }

#define XB_TMO      128
#define XB_XCNT(j)  (256  + 64 * (j))
#define XB_XSUB(j)  (1280 + 64 * (j))
#define XB_XGEN(j)  (2304 + 64 * (j))
#define XB_TOP      3328
#define XB_TOPGEN   3392
#define XCD_BAR_WORDS 3456
#define XB_SPIN_CAP (1u << 18)

__device__ __forceinline__ unsigned xb_ld(unsigned* p)              { return __hip_atomic_load(p, __ATOMIC_RELAXED, __HIP_MEMORY_SCOPE_AGENT); }
__device__ __forceinline__ unsigned xb_add(unsigned* p, unsigned v) { return __hip_atomic_fetch_add(p, v, __ATOMIC_RELAXED, __HIP_MEMORY_SCOPE_AGENT); }
__device__ __forceinline__ unsigned xb_xcc_id() { return (unsigned)__builtin_amdgcn_s_getreg((3 << 11) | 20) & 0xFu; }
#define XB_SPIN(cond, bar) do { unsigned _sp = 0; while (cond) { __builtin_amdgcn_s_sleep(1); \
    if ((++_sp & 255u) == 0u) { if (xb_ld(&(bar)[XB_TMO])) break; if (_sp > XB_SPIN_CAP) { atomicAdd(&(bar)[XB_TMO], 1u); break; } } } } while (0)

struct XcdBarrier {
    unsigned* bar; unsigned x;
    volatile LAS unsigned* st;
};

__device__ __forceinline__ XcdBarrier xcd_barrier_post(unsigned* bar, volatile LAS unsigned* st) {
    XcdBarrier b; b.bar = bar; b.x = xb_xcc_id(); b.st = st;
    if (threadIdx.x == 0) (void)xb_add(&bar[XB_XCNT(b.x)], 1u);
    return b;
}
__device__ __forceinline__ void xcd_barrier_complete(unsigned* bar, unsigned x, unsigned& nloc, unsigned& nx) {
    const unsigned G = gridDim.x * gridDim.y * gridDim.z;
    unsigned sum, cnt, mine, sp = 0u;
    for (;;) {
        sum = 0u; cnt = 0u; mine = 0u;
#pragma unroll
        for (unsigned j = 0; j < 16; ++j) { const unsigned c = xb_ld(&bar[XB_XCNT(j)]); sum += c; cnt += (c > 0u) ? 1u : 0u; mine = (j == x) ? c : mine; }
        if (sum == G) break;
        __builtin_amdgcn_s_sleep(1);
        if ((++sp & 255u) == 0u) { if (xb_ld(&bar[XB_TMO])) break; if (sp > XB_SPIN_CAP) { atomicAdd(&bar[XB_TMO], 1u); break; } }
    }
    nloc = mine > 0u ? mine : 1u; nx = cnt > 0u ? cnt : 1u;
}

__device__ __forceinline__ void xcd_barrier(const XcdBarrier& b, const bool leader  ) {
    asm volatile("s_waitcnt vmcnt(0)" ::: "memory");
    __syncthreads();
    if (leader) {
        unsigned* bar = b.bar; asm volatile("" : "+s"(bar));
        __builtin_amdgcn_s_waitcnt(0);
        unsigned nloc = b.st[0], nx = b.st[1];
        if (nloc == 0u) { xcd_barrier_complete(bar, b.x, nloc, nx); b.st[0] = nloc; b.st[1] = nx; }
        const unsigned old = xb_add(&bar[XB_XSUB(b.x)], 1u);
        const unsigned gen = old / nloc;
        if (old + 1u == (gen + 1u) * nloc) {
            __builtin_amdgcn_fence(__ATOMIC_RELEASE, "agent");
            asm volatile("s_waitcnt vmcnt(0)" ::: "memory");
            const unsigned og = xb_add(&bar[XB_TOP], 1u);
            const unsigned tg = og / nx;
            if (og + 1u == (tg + 1u) * nx) xb_add(&bar[XB_TOPGEN], 1u);
            else XB_SPIN(xb_ld(&bar[XB_TOPGEN]) == tg, bar);
            __builtin_amdgcn_fence(__ATOMIC_ACQUIRE, "agent");
            xb_add(&bar[XB_XGEN(b.x)], 1u);
            asm volatile("s_waitcnt vmcnt(0)" ::: "memory");
        } else {
            XB_SPIN(xb_ld(&bar[XB_XGEN(b.x)]) == gen, bar);
            __builtin_amdgcn_fence(__ATOMIC_ACQUIRE, "agent");
            asm volatile("s_waitcnt vmcnt(0)" ::: "memory");
        }
    }
    __syncthreads();
}

#ifndef FFN_F8
#define FFN_F8 1
#endif
constexpr int NWAVES = 8;
constexpr float W8S = 32.f, U8S = 4.f;
constexpr int DM = 1024, NBATCH = 16, SEQ = 2048, CTX = 256, TPB = SEQ + CTX, M = NBATCH * TPB;
constexpr int DEPTH = 4, NIN = 3104, NP = 3328, DFF = 2816, NE = 8;
constexpr int MP = 2 * M + NE * 256;
constexpr int C_Q = 0, C_K = 512, C_V = 1024, C_GQ = 1536, C_GK = 1792, C_GV = 2048, C_GG = 2560, C_GLR = 3072;
constexpr float EPS = 1e-6f;
constexpr float C2 = 0.125f * 1.4426950408889634f;
constexpr int NCH = TPB / 64;
constexpr int NGLA = NBATCH * 4 * 2 * NCH;

constexpr size_t MiB = 1u << 20;
constexpr size_t WS_CTL = 0, CTL_ZERO_BYTES = 1 * MiB;
constexpr size_t WS_MOD = 1 * MiB;
constexpr size_t WS_ROPE = 3 * MiB;
constexpr size_t WS_TOPE = 4 * MiB;
constexpr size_t WS_LIDX = WS_TOPE + 160 * 1024;
constexpr size_t WS_TOPW = WS_LIDX + 320 * 1024;
constexpr size_t WS_BLKB = WS_TOPW + 320 * 1024;
constexpr size_t WS_RMAP = WS_BLKB + 64 * 1024;
constexpr size_t WS_ROWW = WS_RMAP + 320 * 1024;
static_assert(WS_ROWW + 320 * 1024 <= 6 * MiB, "small tables");
constexpr size_t WS_X = 6 * MiB;
constexpr size_t WS_WIN = 150 * MiB;
constexpr size_t WS_WOUT = WS_WIN + 13 * MiB / 2;
constexpr size_t WS_WUP = WS_WOUT + 2 * MiB;
constexpr size_t WS_WDN = WS_WUP + 88 * MiB;
constexpr size_t WS_D = 291 * MiB;
static_assert(WS_WDN + 44 * MiB <= WS_D, "weights");
constexpr size_t WS_PROJ = WS_D;
constexpr size_t WS_OD = WS_D + 234 * MiB;
constexpr size_t WS_DS = WS_D + 306 * MiB;
constexpr size_t WS_DEC = WS_D + 450 * MiB;
constexpr size_t WS_H = WS_D + 452 * MiB;
constexpr size_t WS_Y = WS_D;
constexpr size_t WS_HG = WS_D;
constexpr size_t WS_F2 = WS_D;
constexpr size_t WS_U = WS_D + 148 * MiB;
constexpr size_t WS_H2 = WS_D + 483 * MiB;
constexpr size_t WS_END = WS_D + 555 * MiB;
static_assert((size_t)MP * DFF * 2 <= 407 * MiB && (size_t)MP * DM * 2 <= 148 * MiB && (size_t)M * NP * 2 <= 234 * MiB, "dynamic map");
static_assert((size_t)M * DFF * 2 + 148 * MiB <= 483 * MiB, "dense U clear of H2");

constexpr int CW_BAR = 4096;
constexpr int CW_CNT = 8192;

constexpr int RING_BYTES = 131072;
constexpr int TEXP_OFF = 139264;
constexpr int MISC_OFF = 146432 - 512;
constexpr int LDS_BYTES = 147456;

typedef unsigned u32x2 __attribute__((ext_vector_type(2)));

__device__ __forceinline__ float bf2f(unsigned short x) { return __uint_as_float((unsigned)x << 16); }
__device__ __forceinline__ float bflo(unsigned w) { return __uint_as_float(w << 16); }
__device__ __forceinline__ float bfhi(unsigned w) { return __uint_as_float(w & 0xffff0000u); }
__device__ __forceinline__ float siluf(float x) { return x * __builtin_amdgcn_rcpf(1.f + __expf(-x)); }
__device__ __forceinline__ float clamp8(float x) { return fminf(fmaxf(x, -448.f), 448.f); }
__device__ __forceinline__ unsigned pk4_f8(float a, float b, float c, float d) { unsigned w = 0u; w = __builtin_amdgcn_cvt_pk_fp8_f32(clamp8(a), clamp8(b), w, false); w = __builtin_amdgcn_cvt_pk_fp8_f32(clamp8(c), clamp8(d), w, true); return w; }
template <int MASK> __device__ __forceinline__ float xadd(float v) {
    if constexpr (MASK == 32) { const auto rr = __builtin_amdgcn_permlane32_swap(__float_as_uint(v), __float_as_uint(v), false, false); return __uint_as_float(rr[0]) + __uint_as_float(rr[1]); }
    else return v + __int_as_float(__builtin_amdgcn_ds_swizzle(__float_as_int(v), 0x1f | (MASK << 10)));
}
__device__ __forceinline__ float wave_sum(float v) {
    v = xadd<1>(v); v = xadd<2>(v); v = xadd<4>(v); v = xadd<8>(v); v = xadd<16>(v); v = xadd<32>(v);
    return v;
}

struct Args { const float* in[24]; float* out; unsigned char* ws; };
struct Frame {
    LAS unsigned char* lds;
    volatile LAS unsigned* MISC;
    int tid, lane, wave, G, blk, gw, NGW, z, wv;
    const Args* A;
    unsigned char* ws;
};


__device__ __forceinline__ void refresh(Frame& F) {
    int wv = F.wv; asm volatile("" : "+s"(wv));
    const int t = wv * 64 + pg8::lane_id_opaque();
    int bl = blockIdx.x, z = 0, gg = gridDim.x; asm volatile("" : "+s"(bl), "+s"(z), "+s"(gg));
    F.blk = bl; F.z = z; F.G = gg; F.NGW = gg * NWAVES;
    F.tid = t; F.lane = t & 63; F.wave = wv; F.gw = F.blk * NWAVES + F.wave;
}
#define INP(k) (F.A->in[(k) + F.z])
namespace pg8 {
struct EpiProj {
    static constexpr bool PERM = true, AFTER_DRAIN = false;
    bf16_t* P; const float* ropec; const float* ropes; unsigned* kmx;
    __device__ __forceinline__ void operator()(const f32x4 (&acc)[2][2][4][2], const Unit& u, int wr, int wc, int fr, int fq) const {
        const int pn = u.pn, pm = u.pm, tb = pm % 9;
        float kss[2] = {0.f, 0.f};
        const bool do_rope = (tb != 0) && (pn < 4);
        const float sc = (pn < 2) ? C2 : (pn == 6 ? 0.125f : 1.f);
        const bool st_ok_all = pn < 12;
#pragma unroll
        for (int ai = 0; ai < 2; ++ai)
#pragma unroll
            for (int m = 0; m < 4; ++m) {
                const int rit = ai * HALF + wr * 64 + m * 16 + fr;
                bf16_t* rowp = P + ((size_t)pm * BM + rit) * NP + pn * BM + wc * 32 + 8 * fq;
                const int s = (tb - 1) * 256 + rit;
                const int pos = (wc & 1) ? (s & 63) : (s >> 6);
                f32x4 cs = {1.f, 1.f, 1.f, 1.f}, sn = {0.f, 0.f, 0.f, 0.f};
                if (do_rope) { cs = *(const f32x4*)(ropec + pos * 16 + 4 * fq); sn = *(const f32x4*)(ropes + pos * 16 + 4 * fq); }
#pragma unroll
                for (int bj = 0; bj < 2; ++bj) {
                    f32x4 v0 = acc[ai][bj][m][0], v1 = acc[ai][bj][m][1];
                    if (do_rope) { const f32x4 a = v0 * cs - v1 * sn, b = v0 * sn + v1 * cs; v0 = a; v1 = b; }
                    v0 = v0 * sc; v1 = v1 * sc;
                    if (pn == 2 || pn == 3) { float ss = (v0[0] * v0[0] + v0[1] * v0[1]) + (v0[2] * v0[2] + v0[3] * v0[3]) + (v1[0] * v1[0] + v1[1] * v1[1]) + (v1[2] * v1[2] + v1[3] * v1[3]);
                        ss = xadd<16>(ss); ss = xadd<32>(ss); kss[bj] = fmaxf(kss[bj], ss); }
                    if (st_ok_all || (bj == 0 && wc == 0)) {
                        u32x4 w; w.x = cvt_pk_bf16(v0[0], v0[1]); w.y = cvt_pk_bf16(v0[2], v0[3]); w.z = cvt_pk_bf16(v1[0], v1[1]); w.w = cvt_pk_bf16(v1[2], v1[3]);
                        *(u32x4*)(rowp + bj * HALF) = w;
                    }
                }
            }
        if (pn == 2 || pn == 3) {
#pragma unroll
            for (int bj = 0; bj < 2; ++bj) { float v = kss[bj];
                v = fmaxf(v, __int_as_float(__builtin_amdgcn_update_dpp(0, __float_as_int(v), 0xB1, 0xF, 0xF, true)));
                v = fmaxf(v, __int_as_float(__builtin_amdgcn_update_dpp(0, __float_as_int(v), 0x4E, 0xF, 0xF, true)));
                v = fmaxf(v, __int_as_float(__builtin_amdgcn_update_dpp(0, __float_as_int(v), 0x141, 0xF, 0xF, true)));
                v = fmaxf(v, __int_as_float(__builtin_amdgcn_update_dpp(0, __float_as_int(v), 0x140, 0xF, 0xF, true)));
                if (fr == 0 && fq == 0) { const int hh = (pn - 2) * 4 + bj * 2 + (wc >> 1);
                    __hip_atomic_fetch_max(kmx + (((pm / 9) * 8 + hh) * 2 + (wc & 1)), __float_as_uint(v), __ATOMIC_RELAXED, __HIP_MEMORY_SCOPE_AGENT); } }
        }
    }
};
struct EpiF32 {
    static constexpr bool PERM = true, AFTER_DRAIN = false;
    bf16_t* Y;
    __device__ __forceinline__ void operator()(const f32x4 (&acc)[2][2][4][2], const Unit& u, int wr, int wc, int fr, int fq) const {
#pragma unroll
        for (int ai = 0; ai < 2; ++ai)
#pragma unroll
            for (int m = 0; m < 4; ++m) {
                bf16_t* rowp = Y + ((size_t)u.pm * BM + ai * HALF + wr * 64 + m * 16 + fr) * DM + u.pn * BM + wc * 32 + 8 * fq;
#pragma unroll
                for (int bj = 0; bj < 2; ++bj) { const f32x4 v0 = acc[ai][bj][m][0], v1 = acc[ai][bj][m][1];
                    u32x4 w; w.x = cvt_pk_bf16(v0[0], v0[1]); w.y = cvt_pk_bf16(v0[2], v0[3]); w.z = cvt_pk_bf16(v1[0], v1[1]); w.w = cvt_pk_bf16(v1[2], v1[3]);
                    *(u32x4*)(rowp + bj * HALF) = w; }
            }
    }
};
struct EpiSwiglu {
    static constexpr bool PERM = true, AFTER_DRAIN = false;
    bf16_t* U;
    __device__ __forceinline__ void operator()(const f32x4 (&acc)[2][2][4][2], const Unit& u, int wr, int wc, int fr, int fq) const {
        const int pnl = u.pn % 22;
        const int col0 = pnl * 128 + wc * 32 + 8 * fq;
        constexpr float ws = FFN_F8 ? 1.f / W8S : 1.f, us = FFN_F8 ? U8S : 1.f, kS = ws * ws * us, kE = -ws * 1.4426950408889634f;
        const float cE = -__builtin_log2f(kS), c1 = 1.f / kS;
#pragma unroll
        for (int ai = 0; ai < 2; ++ai)
#pragma unroll
            for (int m = 0; m < 4; ++m) {
                const size_t rowi = (size_t)u.pm * BM + ai * HALF + wr * 64 + m * 16 + fr;
                f32x2 g[4], up[4], t[4], r[4];
#pragma unroll
                for (int n = 0; n < 2; ++n) { g[2 * n] = (f32x2){acc[ai][0][m][n][0], acc[ai][0][m][n][1]}; g[2 * n + 1] = (f32x2){acc[ai][0][m][n][2], acc[ai][0][m][n][3]};
                                              up[2 * n] = (f32x2){acc[ai][1][m][n][0], acc[ai][1][m][n][1]}; up[2 * n + 1] = (f32x2){acc[ai][1][m][n][2], acc[ai][1][m][n][3]}; }
#pragma unroll
                for (int q = 0; q < 4; ++q) t[q] = g[q] * kE + cE;
#pragma unroll
                for (int q = 0; q < 4; ++q) { t[q].x = __builtin_amdgcn_exp2f(t[q].x); t[q].y = __builtin_amdgcn_exp2f(t[q].y); }
#pragma unroll
                for (int q = 0; q < 4; ++q) t[q] = t[q] + c1;
#pragma unroll
                for (int q = 0; q < 4; ++q) { r[q].x = __builtin_amdgcn_rcpf(t[q].x); r[q].y = __builtin_amdgcn_rcpf(t[q].y); }
#pragma unroll
                for (int q = 0; q < 4; ++q) g[q] = (g[q] * up[q]) * r[q];
                if constexpr (FFN_F8) { u32x2 w; w.x = pk4_f8(g[0].x, g[0].y, g[1].x, g[1].y); w.y = pk4_f8(g[2].x, g[2].y, g[3].x, g[3].y); *(u32x2*)((unsigned char*)U + rowi * DFF + col0) = w; }
                else { u32x4 w; w.x = cvt_pk_bf16(g[0].x, g[0].y); w.y = cvt_pk_bf16(g[1].x, g[1].y); w.z = cvt_pk_bf16(g[2].x, g[2].y); w.w = cvt_pk_bf16(g[3].x, g[3].y); *(u32x4*)(U + rowi * DFF + col0) = w; }
            }
    }
};
struct EpiDown {
    static constexpr bool PERM = true, AFTER_DRAIN = false;
    bf16_t* F2; const int* rmap; const float* roww; int dense;
    __device__ __forceinline__ void operator()(const f32x4 (&acc)[2][2][4][2], const Unit& u, int wr, int wc, int fr, int fq) const {
        const int pnl = u.pn & 3;
        const int col0 = pnl * BM + wc * 32 + 8 * fq;
        const __amdgpu_buffer_rsrc_t rsF = __builtin_amdgcn_make_buffer_rsrc((void*)F2, 0, 2 * M * DM * 2, 0x00020000);
        const __amdgpu_buffer_rsrc_t rsM = __builtin_amdgcn_make_buffer_rsrc((void*)rmap, 0, MP * 4, 0x00020000);
        const __amdgpu_buffer_rsrc_t rsW = __builtin_amdgcn_make_buffer_rsrc((void*)roww, 0, MP * 4, 0x00020000);
#pragma unroll
        for (int ai = 0; ai < 2; ++ai)
#pragma unroll
            for (int m = 0; m < 4; ++m) {
                const int grow = u.pm * BM + ai * HALF + wr * 64 + m * 16 + fr;
                int tok = grow, slot = 0; float w = 1.f; bool ok = true;
                if (!dense) { const int rm = (int)__builtin_amdgcn_raw_buffer_load_b32(rsM, grow * 4, 0, 0); ok = rm >= 0; tok = rm & 0x3fffffff; slot = (rm >> 30) & 1; w = __uint_as_float(__builtin_amdgcn_raw_buffer_load_b32(rsW, grow * 4, 0, 0)); }
                if constexpr (FFN_F8) w *= 1.f / (W8S * U8S);
                if (ok) {
                    const int bo = ((slot * M + tok) * DM + col0) * 2;
#pragma unroll
                    for (int bj = 0; bj < 2; ++bj) {
                        const f32x4 v0 = acc[ai][bj][m][0] * w, v1 = acc[ai][bj][m][1] * w;
                        u32x4 q; q.x = cvt_pk_bf16(v0[0], v0[1]); q.y = cvt_pk_bf16(v0[2], v0[3]); q.z = cvt_pk_bf16(v1[0], v1[1]); q.w = cvt_pk_bf16(v1[2], v1[3]);
                        __builtin_amdgcn_raw_buffer_store_b128(q, rsF, bo + bj * HALF * 2, 0, 0);
                    }
                }
            }
    }
};
struct GroupedOrder {
    StaticOrder S; const PG8_LAS int* texp; int nN;
    __device__ __forceinline__ bool next(int i, Unit& u) const { if (!S.next(i, u)) return false; u.pn += __builtin_amdgcn_readfirstlane(texp[u.pm]) * nN; return true; }
    __device__ __forceinline__ void a_ready(const Unit&) const {}
    __device__ __forceinline__ void done(const Unit&) const {}
};
struct LatOrder {
    StaticOrder S; int lat;
    __device__ __forceinline__ bool next(int i, Unit& u) const { if (!S.next(i, u)) return false; if (lat) u.pm += (u.pm >> 3) + 1; return true; }
    __device__ __forceinline__ void a_ready(const Unit&) const {}
    __device__ __forceinline__ void done(const Unit&) const {}
};
}

__device__ __forceinline__ void ld_row_f32(const float* row, int lane, f32x4 (&v)[4]) {
#pragma unroll
    for (int j = 0; j < 4; ++j) v[j] = *(const f32x4*)(row + 4 * lane + 256 * j);
}
__device__ __forceinline__ void st_row_f32(float* row, int lane, const f32x4 (&v)[4]) {
#pragma unroll
    for (int j = 0; j < 4; ++j) *(f32x4*)(row + 4 * lane + 256 * j) = v[j];
}
__device__ __forceinline__ void ld_row_bf16(const bf16* row, int lane, f32x4 (&v)[4]) {
#pragma unroll
    for (int j = 0; j < 4; ++j) { const u32x2 w = *(const u32x2*)(row + 4 * lane + 256 * j); v[j] = (f32x4){bflo(w.x), bfhi(w.x), bflo(w.y), bfhi(w.y)}; }
}
__device__ __forceinline__ void st_row_bf16(bf16* row, int lane, const f32x4 (&v)[4]) {
#pragma unroll
    for (int j = 0; j < 4; ++j) { u32x2 w; w.x = pg8::cvt_pk_bf16(v[j][0], v[j][1]); w.y = pg8::cvt_pk_bf16(v[j][2], v[j][3]); *(u32x2*)(row + 4 * lane + 256 * j) = w; }
}
__device__ __forceinline__ float row_rinv(const f32x4 (&v)[4]) {
    float s = 0.f;
#pragma unroll
    for (int j = 0; j < 4; ++j) s += (v[j][0] * v[j][0] + v[j][1] * v[j][1]) + (v[j][2] * v[j][2] + v[j][3] * v[j][3]);
    return 1.0f / sqrtf(wave_sum(s) * (1.f / DM) + EPS);
}

__device__ __forceinline__ void transpose_tile(const float* W, int N, int k0, int n0, bf16* WT, int K, int drow0, LAS float* scr, int lane, bool ropeperm = false) {
    { f32x4 v[8];
#pragma unroll
      for (int j = 0; j < 8; ++j) v[j] = __builtin_nontemporal_load((const f32x4*)&W[(size_t)(k0 + 8 * j + (lane >> 3)) * N + n0 + 4 * (lane & 7)]);
#pragma unroll
      for (int j = 0; j < 8; ++j) { LAS float* d = scr + (8 * j + (lane >> 3)) * 33 + 4 * (lane & 7); d[0] = v[j][0]; d[1] = v[j][1]; d[2] = v[j][2]; d[3] = v[j][3]; } }
    LDS_WAIT(); asm volatile("" ::: "memory");
    const int c = lane & 7;
#pragma unroll
    for (int j = 0; j < 4; ++j) { const int n = (lane >> 3) + 8 * j; const LAS float* s = scr + (8 * c) * 33 + n;
        v4u o; o.x = pk2(s[0 * 33], s[1 * 33]); o.y = pk2(s[2 * 33], s[3 * 33]); o.z = pk2(s[4 * 33], s[5 * 33]); o.w = pk2(s[6 * 33], s[7 * 33]);
        const int nd = ropeperm ? (8 * ((n >> 2) & 3) + 4 * (n >> 4) + (n & 3)) : n;
        *(GAS v4u*)(WT + (size_t)(drow0 + nd) * K + k0 + 8 * c) = o; }
    LDS_WAIT(); asm volatile("" ::: "memory");
}
__device__ __forceinline__ void transpose_tile_f8(const float* W, int N, int k0, int n0, unsigned char* WT, int Kb, int drow0, LAS float* scr, int lane, float scale) {
    { f32x4 v[8];
#pragma unroll
      for (int j = 0; j < 8; ++j) v[j] = __builtin_nontemporal_load((const f32x4*)&W[(size_t)(k0 + 8 * j + (lane >> 3)) * N + n0 + 4 * (lane & 7)]);
#pragma unroll
      for (int j = 0; j < 8; ++j) { LAS float* d = scr + (8 * j + (lane >> 3)) * 33 + 4 * (lane & 7); d[0] = v[j][0]; d[1] = v[j][1]; d[2] = v[j][2]; d[3] = v[j][3]; } }
    LDS_WAIT(); asm volatile("" ::: "memory");
    const int n = lane >> 1, hf = lane & 1; const LAS float* s = scr + (hf * 32) * 33 + n;
    v4u o0, o1;
    o0.x = pk4_f8(s[0 * 33] * scale, s[1 * 33] * scale, s[2 * 33] * scale, s[3 * 33] * scale);     o0.y = pk4_f8(s[4 * 33] * scale, s[5 * 33] * scale, s[6 * 33] * scale, s[7 * 33] * scale);
    o0.z = pk4_f8(s[8 * 33] * scale, s[9 * 33] * scale, s[10 * 33] * scale, s[11 * 33] * scale);   o0.w = pk4_f8(s[12 * 33] * scale, s[13 * 33] * scale, s[14 * 33] * scale, s[15 * 33] * scale);
    o1.x = pk4_f8(s[16 * 33] * scale, s[17 * 33] * scale, s[18 * 33] * scale, s[19 * 33] * scale); o1.y = pk4_f8(s[20 * 33] * scale, s[21 * 33] * scale, s[22 * 33] * scale, s[23 * 33] * scale);
    o1.z = pk4_f8(s[24 * 33] * scale, s[25 * 33] * scale, s[26 * 33] * scale, s[27 * 33] * scale); o1.w = pk4_f8(s[28 * 33] * scale, s[29 * 33] * scale, s[30 * 33] * scale, s[31 * 33] * scale);
    GAS v4u* dst = (GAS v4u*)(WT + (size_t)(drow0 + n) * Kb + k0 + hf * 32);
    dst[0] = o0; dst[1] = o1;
    LDS_WAIT(); asm volatile("" ::: "memory");
}
__device__ __forceinline__ void convert_weights(Frame& F, int l) {
    refresh(F);
    const bool moe = l & 1; const int ne = moe ? NE : 1, li = l >> 1;
    const float* w1 = moe ? INP(21) + (size_t)li * NE * DM * DFF : INP(17) + (size_t)li * DM * DFF;
    const float* w3 = moe ? INP(22) + (size_t)li * NE * DM * DFF : INP(18) + (size_t)li * DM * DFF;
    const float* w2 = moe ? INP(23) + (size_t)li * NE * DM * DFF : INP(19) + (size_t)li * DM * DFF;
    const float* win = INP(10) + (size_t)l * DM * NIN;
    const float* wout = INP(16) + (size_t)l * DM * DM;
    bf16* WIN = (bf16*)(F.ws + WS_WIN); bf16* WOUT = (bf16*)(F.ws + WS_WOUT); bf16* WUP = (bf16*)(F.ws + WS_WUP); bf16* WDN = (bf16*)(F.ws + WS_WDN);
    LAS float* scr = (LAS float*)(F.lds + F.wave * 16384);
    const int nA = 16 * 97, nZ = NP - NIN, nB = 16 * 32, nC1 = 16 * 88, nD1 = 44 * 32;
    const int nC = ne * 2 * nC1, nD = ne * nD1, total = nA + nZ + nB + nC + nD;
    for (int it = F.gw; it < total; it += F.NGW) {
        int r = it;
        if (r < nA) { const int kb = r / 97, nb = r % 97; transpose_tile(win, NIN, 64 * kb, 32 * nb, WIN, DM, 32 * nb, scr, F.lane, nb < 32  ); continue; } r -= nA;
        if (r < nZ) { const unsigned zz = (unsigned)F.z; v4u z = {zz, zz, zz, zz}; GAS v4u* p = (GAS v4u*)(WIN + (size_t)(NIN + r) * DM) + F.lane * 2; p[0] = z; p[1] = z; continue; } r -= nZ;
        if (r < nB) { const int kb = r / 32, nb = r % 32; transpose_tile(wout, DM, 64 * kb, 32 * nb, WOUT, DM, 32 * nb, scr, F.lane); continue; } r -= nB;
        if (r < nC) { const int e = r / (2 * nC1), q = r % (2 * nC1), which = q / nC1, t = q % nC1, kb = t / 88, nb = t % 88, n0 = 32 * nb;
            const float* src = (which ? w3 : w1) + (size_t)e * DM * DFF;
            if constexpr (FFN_F8) transpose_tile_f8(src, DFF, 64 * kb, n0, (unsigned char*)WUP, DM, e * 5632 + (n0 / 128) * 256 + (n0 % 128) + which * 128, scr, F.lane, W8S);
            else transpose_tile(src, DFF, 64 * kb, n0, WUP, DM, e * 5632 + (n0 / 128) * 256 + (n0 % 128) + which * 128, scr, F.lane); continue; } r -= nC;
        { const int e = r / nD1, t = r % nD1, kb = t / 32, nb = t % 32;
            if constexpr (FFN_F8) transpose_tile_f8(w2 + (size_t)e * DFF * DM, DM, 64 * kb, 32 * nb, (unsigned char*)WDN + (size_t)e * DM * DFF, DFF, 32 * nb, scr, F.lane, W8S);
            else transpose_tile(w2 + (size_t)e * DFF * DM, DM, 64 * kb, 32 * nb, WDN + (size_t)e * DM * DFF, DFF, 32 * nb, scr, F.lane); }
    }
}

__device__ __forceinline__ void p0_mod(Frame& F) {
    refresh(F);
    LAS float* S = (LAS float*)(F.lds);
    LAS float* R = (LAS float*)(F.lds + 69632);
    const float* c = INP(1); const float* cc = INP(3); const float* wmod = INP(4); const float* bmod = INP(5);
    float* MOD = (float*)(F.ws + WS_MOD);
    for (int i = F.tid; i < 17 * 1024; i += 512) { const int b = i >> 10, k = i & 1023; const float v = b < 16 ? c[b * 1024 + k] : cc[k]; S[i] = siluf(v); }
    __syncthreads();
    const int kq = F.lane >> 4, c4 = (F.lane & 15) * 4;
    for (int item = F.blk; item < 4 * 96; item += F.G) {
        const int l = item / 96, col0 = (item % 96) * 64;
        const float* W = wmod + (size_t)l * DM * 6144;
        float acc[17][4];
#pragma unroll
        for (int b = 0; b < 17; ++b)
#pragma unroll
            for (int j = 0; j < 4; ++j) acc[b][j] = 0.f;
        for (int it0 = 0; it0 < 32; it0 += 4) {
            f32x4 w[4];
#pragma unroll
            for (int u = 0; u < 4; ++u) w[u] = __builtin_nontemporal_load((const f32x4*)(W + (size_t)(F.wave * 128 + (it0 + u) * 4 + kq) * 6144 + col0 + c4));
#pragma unroll
            for (int u = 0; u < 4; ++u) { const int k = F.wave * 128 + (it0 + u) * 4 + kq;
#pragma unroll
                for (int b = 0; b < 17; ++b) { const float s = S[b * 1024 + k];
#pragma unroll
                    for (int j = 0; j < 4; ++j) acc[b][j] += s * w[u][j]; } }
        }
#pragma unroll
        for (int b = 0; b < 17; ++b)
#pragma unroll
            for (int j = 0; j < 4; ++j) { float v = acc[b][j]; v = xadd<16>(v); v = xadd<32>(v); acc[b][j] = v; }
        if (kq == 0) {
#pragma unroll
            for (int b = 0; b < 17; ++b)
#pragma unroll
                for (int j = 0; j < 4; ++j) R[(F.wave * 17 + b) * 64 + c4 + j] = acc[b][j];
        }
        __syncthreads();
        for (int o = F.tid; o < 17 * 64; o += 512) { const int b = o >> 6, ccx = o & 63; float s = bmod[l * 6144 + col0 + ccx];
            for (int w = 0; w < 8; ++w) s += R[(w * 17 + b) * 64 + ccx];
            MOD[((size_t)l * 17 + b) * 6144 + col0 + ccx] = s; }
        __syncthreads();
    }
}
__device__ __forceinline__ float lam_init_of(int l) { return 0.8f - 0.6f * expf(-0.3f * (float)l); }
__device__ __forceinline__ void p0_misc(Frame& F) {
    refresh(F);
    float* ropec = (float*)(F.ws + WS_ROPE); float* ropes = ropec + 1024; float* lam = (float*)(F.ws + WS_ROPE + 16384);
    if (F.blk == 0) {
        for (int i = F.tid; i < 1024; i += 512) { const int pos = i >> 4, f = i & 15; const float inv = powf(10000.f, -(float)f / 16.f); const float ang = (float)pos * inv; ropec[i] = cosf(ang); ropes[i] = sinf(ang); }
    }
    if (F.blk == (1 % F.G) && F.wave < 4) {
        const int l = F.wave; const float* lv = INP(13) + l * 256;
        const float a = wave_sum(lv[F.lane] * lv[64 + F.lane]), b = wave_sum(lv[128 + F.lane] * lv[192 + F.lane]);
        if (F.lane == 0) lam[l] = expf(a) - expf(b) + lam_init_of(l);
    }
}

namespace att {
using bf16x8 = __attribute__((ext_vector_type(8))) short;
using s16x4  = __attribute__((ext_vector_type(4))) short;
using f32x16 = __attribute__((ext_vector_type(16))) float;
using u32x4  = __attribute__((ext_vector_type(4))) unsigned;
constexpr int QBLK = 32, KVBLK = 64, NW = 8, DV = 128;
constexpr float THR = 8.f;
constexpr size_t SHM_V = KVBLK * DV * 2, SHM_K = KVBLK * 64 * 2, SHM_ATTN = 2 * SHM_V + 2 * SHM_K + NW * 64 * 4;
#define KSWZ64(row, colB) ((row) * 128 + ((colB) ^ ((((row) >> 1) & 7) << 4)))
#define SBAR() __builtin_amdgcn_sched_barrier(0)
__device__ __forceinline__ int crow(int r, int hi) { return (r & 3) + 8 * (r >> 2) + 4 * hi; }
__device__ __forceinline__ unsigned cvtpk(float lo, float hi) { unsigned r; asm volatile("v_cvt_pk_bf16_f32 %0, %1, %2" : "=v"(r) : "v"(lo), "v"(hi)); return r; }
__device__ __forceinline__ void partialSM(f32x16& p0, f32x16& p1, float& m_reg, float& mn, float& alpha) {
  float pmax = p0[0];
#pragma unroll
  for (int r = 1; r < 16; ++r) pmax = fmaxf(pmax, p0[r]);
#pragma unroll
  for (int r = 0; r < 16; ++r) pmax = fmaxf(pmax, p1[r]);
  { auto rr = __builtin_amdgcn_permlane32_swap(__float_as_uint(pmax), __float_as_uint(pmax), false, false);
    pmax = fmaxf(__uint_as_float(rr[0]), __uint_as_float(rr[1])); }
  if (__builtin_expect(__all(pmax - m_reg <= THR), 1)) { mn = m_reg; alpha = 1.f; }
  else { mn = fmaxf(m_reg, pmax); alpha = __builtin_amdgcn_exp2f(m_reg - mn); m_reg = mn; }
#pragma unroll
  for (int r = 0; r < 16; ++r) p0[r] = p0[r] - mn;
#pragma unroll
  for (int r = 0; r < 16; ++r) p1[r] = p1[r] - mn;
#pragma unroll
  for (int r = 0; r < 16; ++r) p0[r] = __builtin_amdgcn_exp2f(p0[r]);
}
__device__ __forceinline__ void finishSM(f32x16& p0, f32x16& p1, float alpha, float& l_reg, bf16x8& pa0, bf16x8& pa1, bf16x8& pa2, bf16x8& pa3) {
#pragma unroll
  for (int r = 0; r < 16; ++r) p1[r] = __builtin_amdgcn_exp2f(p1[r]);
  float ps = 0;
#pragma unroll
  for (int r = 0; r < 16; ++r) ps += p0[r];
#pragma unroll
  for (int r = 0; r < 16; ++r) ps += p1[r];
  { auto rr = __builtin_amdgcn_permlane32_swap(__float_as_uint(ps), __float_as_uint(ps), false, false);
    ps = __uint_as_float(rr[0]) + __uint_as_float(rr[1]); }
  l_reg = l_reg * alpha + ps;
#define PK4(P, BASE, OUT) do { unsigned a0 = cvtpk(P[BASE + 0], P[BASE + 1]), a1 = cvtpk(P[BASE + 2], P[BASE + 3]);   \
    unsigned b0 = cvtpk(P[BASE + 4], P[BASE + 5]), b1 = cvtpk(P[BASE + 6], P[BASE + 7]);                              \
    auto r0 = __builtin_amdgcn_permlane32_swap(a0, b0, false, false); auto r1 = __builtin_amdgcn_permlane32_swap(a1, b1, false, false); \
    u32x4 w = {r0[0], r1[0], r0[1], r1[1]}; OUT = *reinterpret_cast<bf16x8*>(&w); } while (0)
  PK4(p0, 0, pa0); PK4(p0, 8, pa1); PK4(p1, 0, pa2); PK4(p1, 8, pa3);
#undef PK4
}
__device__ __forceinline__ void pack_p(const f32x16& p0, const f32x16& p1, bf16x8& pa0, bf16x8& pa1, bf16x8& pa2, bf16x8& pa3) {
#define PK4(P, BASE, OUT) do { unsigned a0 = cvtpk(P[BASE + 0], P[BASE + 1]), a1 = cvtpk(P[BASE + 2], P[BASE + 3]);   \
    unsigned b0 = cvtpk(P[BASE + 4], P[BASE + 5]), b1 = cvtpk(P[BASE + 6], P[BASE + 7]);                              \
    auto r0 = __builtin_amdgcn_permlane32_swap(a0, b0, false, false); auto r1 = __builtin_amdgcn_permlane32_swap(a1, b1, false, false); \
    u32x4 w = {r0[0], r1[0], r0[1], r1[1]}; OUT = *reinterpret_cast<bf16x8*>(&w); } while (0)
  PK4(p0, 0, pa0); PK4(p0, 8, pa1); PK4(p1, 0, pa2); PK4(p1, 8, pa3);
#undef PK4
}
__device__ __forceinline__ void qkt(f32x16& p0, f32x16& p1, const bf16* Ks, const bf16x8* qr, int r32, int hi) {
  p0 = f32x16{}; p1 = f32x16{};
#pragma unroll
  for (int d0 = 0; d0 < 4; ++d0) { int cb = (d0 * 16 + hi * 8) * 2;
    bf16x8 b0 = *reinterpret_cast<const bf16x8*>((const char*)Ks + KSWZ64(r32, cb));
    bf16x8 b1 = *reinterpret_cast<const bf16x8*>((const char*)Ks + KSWZ64(32 + r32, cb));
    p0 = __builtin_amdgcn_mfma_f32_32x32x16_bf16(b0, qr[d0], p0, 0, 0, 0);
    p1 = __builtin_amdgcn_mfma_f32_32x32x16_bf16(b1, qr[d0], p1, 0, 0, 0); }
}
__device__ __forceinline__ int v_st(int k, int c) { const int kk = (k & ~0xC) | ((k & 4) << 1) | ((k & 8) >> 1); return ((kk >> 3) * 4 + (c >> 5)) * 512 + ((kk & 7) * 32 + (c & 31)) * 2; }
__device__ __forceinline__ int v_rd_base(int lane) { return ((lane & 3) << 3) | (((lane >> 2) & 3) << 6) | (((lane >> 4) & 1) << 5) | (((lane >> 5) & 1) << 8); }
constexpr int v_rd_off(int d0, int ks, int half) { return d0 * 512 + ks * 4096 + half * 2048; }
template <int OFF> __device__ __forceinline__ s16x4 tr_read(int vb) {
  s16x4 r; asm volatile("ds_read_b64_tr_b16 %0, %1 offset:%2" : "=&v"(r) : "v"(vb), "i"(OFF) : "memory"); return r;
}
template <int D0> __device__ __forceinline__ void pv_one(f32x16& od, int vb, bf16x8 pa0, bf16x8 pa1, bf16x8 pa2, bf16x8 pa3) {
  const s16x4 l0 = tr_read<v_rd_off(D0, 0, 0)>(vb), h0 = tr_read<v_rd_off(D0, 0, 1)>(vb), l1 = tr_read<v_rd_off(D0, 1, 0)>(vb), h1 = tr_read<v_rd_off(D0, 1, 1)>(vb);
  const s16x4 l2 = tr_read<v_rd_off(D0, 2, 0)>(vb), h2 = tr_read<v_rd_off(D0, 2, 1)>(vb), l3 = tr_read<v_rd_off(D0, 3, 0)>(vb), h3 = tr_read<v_rd_off(D0, 3, 1)>(vb);
  asm volatile("s_waitcnt lgkmcnt(0)" ::: "memory"); SBAR();
#define PK(L, H) (bf16x8){L[0], L[1], L[2], L[3], H[0], H[1], H[2], H[3]}
  od = __builtin_amdgcn_mfma_f32_32x32x16_bf16(pa0, PK(l0, h0), od, 0, 0, 0);
  od = __builtin_amdgcn_mfma_f32_32x32x16_bf16(pa1, PK(l1, h1), od, 0, 0, 0);
  od = __builtin_amdgcn_mfma_f32_32x32x16_bf16(pa2, PK(l2, h2), od, 0, 0, 0);
  od = __builtin_amdgcn_mfma_f32_32x32x16_bf16(pa3, PK(l3, h3), od, 0, 0, 0);
#undef PK
}
__device__ __forceinline__ void pv_d0(f32x16* o, int vb, bf16x8 pa0, bf16x8 pa1, bf16x8 pa2, bf16x8 pa3) {
  pv_one<0>(o[0], vb, pa0, pa1, pa2, pa3); pv_one<1>(o[1], vb, pa0, pa1, pa2, pa3); pv_one<2>(o[2], vb, pa0, pa1, pa2, pa3); pv_one<3>(o[3], vb, pa0, pa1, pa2, pa3);
}
constexpr int LDQ = NP, LDK = NP, LDO = DM;
__device__ __forceinline__ void sm_first(f32x16& p0, f32x16& p1, float m) {
#pragma unroll
  for (int r = 0; r < 16; ++r) p0[r] = p0[r] - m;
#pragma unroll
  for (int r = 0; r < 16; ++r) p1[r] = p1[r] - m;
#pragma unroll
  for (int r = 0; r < 16; ++r) p0[r] = __builtin_amdgcn_exp2f(p0[r]);
}
__device__ __forceinline__ void sm_second(f32x16& p0, f32x16& p1, float& l_reg, bf16x8& pa0, bf16x8& pa1, bf16x8& pa2, bf16x8& pa3) {
#pragma unroll
  for (int r = 0; r < 16; ++r) p1[r] = __builtin_amdgcn_exp2f(p1[r]);
  float ps = 0;
#pragma unroll
  for (int r = 0; r < 16; ++r) ps += p0[r];
#pragma unroll
  for (int r = 0; r < 16; ++r) ps += p1[r];
  { auto rr = __builtin_amdgcn_permlane32_swap(__float_as_uint(ps), __float_as_uint(ps), false, false);
    ps = __uint_as_float(rr[0]) + __uint_as_float(rr[1]); }
  l_reg += ps;
  pack_p(p0, p1, pa0, pa1, pa2, pa3);
}
__device__ __forceinline__ void attn_unit(const bf16* __restrict__ Qb, const bf16* __restrict__ Kh, const bf16* __restrict__ Vh, bf16* __restrict__ Ob, int seq, char* lds, int tid, float kmax) {
  const int wid = tid >> 6, lane = tid & 63, r32 = lane & 31, hi = lane >> 5;
  bf16* V_lds = (bf16*)lds; bf16* K_lds = (bf16*)(lds + 2 * SHM_V);
  float* ws = (float*)(lds + 2 * SHM_V + 2 * SHM_K) + wid * 64; float* li_l = ws; float* al_l = ws + 32;
  float m_reg = -1e30f, l_reg = 0; f32x16 o[4] = {}; bf16x8 qr[4];
  const bf16* Qw = Qb + (long)(wid * QBLK + r32) * LDQ + hi * 8;
#pragma unroll
  for (int d0 = 0; d0 < 4; ++d0) qr[d0] = *(const __attribute__((address_space(1))) bf16x8*)(Qw + d0 * 16);
  { float qs = 0.f;
#pragma unroll
    for (int d0 = 0; d0 < 4; ++d0)
#pragma unroll
      for (int e = 0; e < 8; ++e) { const float qv = __uint_as_float((unsigned)(unsigned short)qr[d0][e] << 16); qs += qv * qv; }
    auto rr = __builtin_amdgcn_permlane32_swap(__float_as_uint(qs), __float_as_uint(qs), false, false);
    qs = __uint_as_float(rr[0]) + __uint_as_float(rr[1]);
    m_reg = sqrtf(qs) * kmax * 1.002f + 1e-3f; }
  const int sr = tid >> 4, sc = (tid & 15) * 8, vst0 = v_st(sr, sc), vst1 = v_st(32 + sr, sc);
  const int kr = tid >> 3, kc = (tid & 7) * 8, kst = KSWZ64(kr, kc * 2);
  const int vb0 = (int)(uintptr_t)V_lds + v_rd_base(lane);
  struct { bf16x8 vs0, vs1, ks0; } sr_[2];
#define GLD8(p) (*(const __attribute__((address_space(1))) bf16x8*)(p))
#define SLOAD(i, k0) do { sr_[i].vs0 = GLD8(&Vh[(long)((k0) + sr) * LDK + sc]); sr_[i].vs1 = GLD8(&Vh[(long)((k0) + 32 + sr) * LDK + sc]); \
    sr_[i].ks0 = GLD8(&Kh[(long)((k0) + kr) * LDK + kc]); } while (0)
#define SWRITE(b, i) do { *(bf16x8*)((char*)V_lds + (b) * SHM_V + vst0) = sr_[i].vs0; *(bf16x8*)((char*)V_lds + (b) * SHM_V + vst1) = sr_[i].vs1; \
    *(bf16x8*)((char*)K_lds + (b) * SHM_K + kst) = sr_[i].ks0; } while (0)
#define SWAIT() asm volatile("s_waitcnt vmcnt(3)" ::: "memory")
#define RESC(a) do { if (__any((a) < 1.f)) { if (hi == 0) al_l[r32] = (a); asm volatile("s_waitcnt lgkmcnt(0)" ::: "memory"); \
    _Pragma("unroll") for (int d = 0; d < 4; ++d) _Pragma("unroll") for (int r = 0; r < 16; ++r) o[d][r] *= al_l[crow(r, hi)]; } } while (0)
  f32x16 pA0, pA1, pB0, pB1; float mnA, mnB, alA, alB; bf16x8 pa0, pa1, pa2, pa3; const int NT = seq / KVBLK;
  if (__builtin_amdgcn_readfirstlane(wid) >= 4) __builtin_amdgcn_s_setprio(1);
  constexpr int SE = 0, SO = 1;
  SLOAD(SE, 0); asm volatile("s_waitcnt vmcnt(0)" ::: "memory"); SWRITE(0, SE); __syncthreads();
  qkt(pA0, pA1, K_lds, qr, r32, hi); sm_first(pA0, pA1, m_reg);
  SLOAD(SO, KVBLK); if (2 < NT) SLOAD(SE, 2 * KVBLK);
  SWAIT(); SWRITE(1, SO); __syncthreads();
  for (int j = 1; j + 1 < NT; j += 2) {
    SBAR(); qkt(pB0, pB1, (bf16*)((char*)K_lds + SHM_K), qr, r32, hi);
    sm_second(pA0, pA1, l_reg, pa0, pa1, pa2, pa3); SBAR();
    SLOAD(SO, (j + 2) * KVBLK); SBAR();
    pv_d0(o, vb0, pa0, pa1, pa2, pa3); sm_first(pB0, pB1, m_reg);
    __syncthreads(); SWAIT(); SWRITE(0, SE);
    __syncthreads();
    SBAR(); qkt(pA0, pA1, K_lds, qr, r32, hi);
    sm_second(pB0, pB1, l_reg, pa0, pa1, pa2, pa3); SBAR();
    if (j + 3 < NT) SLOAD(SE, (j + 3) * KVBLK); SBAR();
    pv_d0(o, vb0 + (int)SHM_V, pa0, pa1, pa2, pa3); sm_first(pA0, pA1, m_reg);
    __syncthreads(); SWAIT(); SWRITE(1, SO);
    __syncthreads();
  }
  SBAR(); qkt(pB0, pB1, (bf16*)((char*)K_lds + SHM_K), qr, r32, hi);
  sm_second(pA0, pA1, l_reg, pa0, pa1, pa2, pa3); SBAR();
  pv_d0(o, vb0, pa0, pa1, pa2, pa3); sm_first(pB0, pB1, m_reg);
  __syncthreads();
  sm_second(pB0, pB1, l_reg, pa0, pa1, pa2, pa3); SBAR();
  pv_d0(o, vb0 + (int)SHM_V, pa0, pa1, pa2, pa3);
  __builtin_amdgcn_s_setprio(0);
  if (hi == 0) li_l[r32] = l_reg; asm volatile("s_waitcnt lgkmcnt(0)" ::: "memory");
  float rli[16];
#pragma unroll
  for (int r = 0; r < 16; ++r) rli[r] = __builtin_amdgcn_rcpf(li_l[crow(r, hi)]);
  bf16* Ow = Ob + (long)(wid * QBLK) * LDO;
#pragma unroll
  for (int r = 0; r < 16; ++r) { const int orow = crow(r, hi);
#pragma unroll
    for (int d0 = 0; d0 < 4; ++d0) Ow[(long)orow * LDO + d0 * 32 + r32] = (bf16)(cvtpk(o[d0][r] * rli[r], 0.f) & 0xffffu); }
#undef SLOAD
#undef GLD8
#undef SWRITE
#undef SWAIT
#undef RESC
}
}

constexpr int CW_KMX = 13312;
constexpr int CW_Q = 12288;
namespace att2 {
using att::bf16x8; using att::s16x4; using att::f32x16; using att::u32x4;
typedef LAS const char* lds_cptr;
typedef short v4i16_t __attribute__((ext_vector_type(4)));
typedef unsigned u32x2 __attribute__((ext_vector_type(2)));
constexpr int KSLOT = 8192, VSLOT = 16384, LDS_K = 0, LDS_V = 4 * KSLOT, KVBLK = 64;
#define A2_PIN(x) asm volatile("" : "+v"(x))
#define A2_MFMA(a, b, c) __builtin_amdgcn_mfma_f32_32x32x16_bf16(a, b, c, 0, 0, 0)
#define A2_WAIT_BAR(N) asm volatile("s_waitcnt vmcnt(" #N ") lgkmcnt(0)\n\ts_barrier" ::: "memory")
__device__ __forceinline__ unsigned cvtpk(float lo, float hi) { unsigned r; asm("v_cvt_pk_bf16_f32 %0, %1, %2" : "=v"(r) : "v"(lo), "v"(hi)); return r; }
__device__ __forceinline__ void glds16s(const char* gbase, unsigned voff, unsigned lds_base) {
    unsigned sv; asm volatile("s_mov_b32 %0, m0\n\ts_mov_b32 m0, %3\n\ts_nop 0\n\tglobal_load_lds_dwordx4 %1, %2\n\ts_mov_b32 m0, %0" : "=&s"(sv) : "v"(voff), "s"(gbase), "s"(lds_base) : "memory"); }
__device__ __forceinline__ const char* uni_ptr(const void* p) { const unsigned long long v = (unsigned long long)p;
    const unsigned lo = __builtin_amdgcn_readfirstlane((unsigned)v), hi = __builtin_amdgcn_readfirstlane((unsigned)(v >> 32)); return (const char*)(((unsigned long long)hi << 32) | lo); }
__device__ __forceinline__ void kload2(bf16x8* kf, lds_cptr kp, int d0) { kf[2 * d0] = *(const LAS bf16x8*)(kp + d0 * 2048); kf[2 * d0 + 1] = *(const LAS bf16x8*)(kp + d0 * 2048 + 512); }
__device__ __forceinline__ s16x4 vtr(lds_cptr p) { return __builtin_bit_cast(s16x4, __builtin_amdgcn_ds_read_tr16_b64_v4i16((LAS v4i16_t*)p)); }
struct UnitP { const bf16* Q; const char* K; const char* V; bf16* O; int NT, kmi; };
__device__ __forceinline__ void decode_unit(int u, int myq, const bf16* P, bf16* OD, UnitP& U) {
    int g, qt;
    if (u < 128) { const int pi = u >> 4, mp = (u >> 3) & 1; g = ((pi * 8 + myq) << 1) + mp; qt = 1 + (u & 7); }
    else { const int gi = u - 128; g = (((gi >> 1) * 8 + myq) << 1) + (gi & 1); qt = 0; }
    const int b = g >> 3, hh = g & 7;
    const size_t row0 = (size_t)b * TPB;
    U.Q = P + (row0 + qt * 256) * NP + C_Q + hh * 64; U.K = (const char*)(P + row0 * NP + C_K + hh * 64); U.V = (const char*)(P + row0 * NP + C_V + (hh >> 1) * 128);
    U.O = OD + (row0 + qt * 256) * DM + hh * 128; U.NT = qt == 0 ? CTX / 64 : TPB / 64;
    U.kmi = (b * 8 + hh) * 2;
}
__device__ __forceinline__ void attn_stream(Frame& F, int l) {
    const bf16* P = (const bf16*)(F.ws + WS_PROJ); bf16* OD = (bf16*)(F.ws + WS_OD);
    const unsigned* kmxp = (const unsigned*)F.ws + CW_KMX + 256 * l;
    gu32* qheads = (gu32*)F.ws + CW_Q + 64 * l;
    volatile LAS unsigned* slot = F.MISC + 24;
    const int limit = (l == DEPTH - 1 ? 128 : 144);
    LAS unsigned char* lds = F.lds; const int tid = F.tid;
    const int lane = tid & 63, r32 = lane & 31, hi = lane >> 5; const int wid = __builtin_amdgcn_readfirstlane(tid >> 6);
    constexpr unsigned TSTR = KVBLK * NP * 2;
    const unsigned lds0 = (unsigned)(uintptr_t)lds;
    const unsigned koff = (unsigned)(lane * NP + wid * 8) * 2;
    const unsigned voff0 = (unsigned)((16 * (wid & 3) + (lane >> 2)) * NP + (wid >> 2) * 32 + (lane & 3) * 8) * 2, voff1 = voff0 + 128;
    const unsigned kdst = lds0 + LDS_K + wid * 1024, vdst = lds0 + LDS_V + wid * 1024;
#define DMA_K(src, slotB) glds16s((src), koff, kdst + (slotB))
#define DMA_V(src, slotB) do { const char* vb_ = (src); glds16s(vb_, voff0, vdst + (slotB)); glds16s(vb_, voff1, vdst + (slotB) + 8192); } while (0)
    const lds_cptr vp0 = (lds_cptr)lds + LDS_V + ((lane >> 4) & 1) * 32 + (lane & 3) * 8 + (4 * hi + ((lane & 15) >> 2)) * 64;
    const lds_cptr kp0 = (lds_cptr)lds + LDS_K + hi * 1024 + r32 * 16;
    if (wid >= 4) __builtin_amdgcn_s_setprio(1);
    int myq = F.blk & 7, tries = 0, vstart = 0; bool warm = false; UnitP cur, nx;
    for (;;) {
        if (!warm) {
            int u;
            for (;;) {
                __syncthreads();
                if (tid == 0) slot[0] = __hip_atomic_fetch_add((unsigned*)(qheads + myq), 1u, __ATOMIC_RELAXED, __HIP_MEMORY_SCOPE_AGENT);
                __syncthreads();
                u = __builtin_amdgcn_readfirstlane((int)slot[0]);
                if (u < limit) break;
                if (++tries >= 8) { u = -1; break; }
                myq = (myq + 1) & 7;
            }
            if (u < 0) break;
            decode_unit(u, myq, P, OD, cur);
            const char* Kc = uni_ptr(cur.K); const char* Vc = uni_ptr(cur.V);
            DMA_K(Kc, 0); DMA_V(Vc, 0); DMA_K(Kc + TSTR, KSLOT); DMA_K(Kc + 2 * (size_t)TSTR, 2 * KSLOT); vstart = 0;
        }
        const char* Kh = uni_ptr(cur.K); const char* Vh = uni_ptr(cur.V); const int NT = cur.NT;
        const int tpop = NT - 5;
        unsigned nxt = 0xffffffffu;
        if (NT < 8 && tid == 0) nxt = __hip_atomic_fetch_add((unsigned*)(qheads + myq), 1u, __ATOMIC_RELAXED, __HIP_MEMORY_SCOPE_AGENT);
        bf16x8 qr[4];
        const bf16* Qw = cur.Q + (long)(wid * 32 + r32) * NP + hi * 8;
#pragma unroll
        for (int d0 = 0; d0 < 4; ++d0) qr[d0] = *(const GAS bf16x8*)(Qw + d0 * 16);
        const float kmax = sqrtf(__uint_as_float(kmxp[cur.kmi]) + __uint_as_float(kmxp[cur.kmi + 1])) * 1.01f;
        float m_row;
        { float qs = 0.f;
#pragma unroll
          for (int d0 = 0; d0 < 4; ++d0)
#pragma unroll
            for (int e = 0; e < 8; ++e) { const float qv = __uint_as_float((unsigned)(unsigned short)qr[d0][e] << 16); qs += qv * qv; }
          auto rr = __builtin_amdgcn_permlane32_swap(__float_as_uint(qs), __float_as_uint(qs), false, false);
          qs = __uint_as_float(rr[0]) + __uint_as_float(rr[1]);
          m_row = sqrtf(qs) * kmax * 1.002f + 1e-3f; }
        f32x16 negm16;
#pragma unroll
        for (int r = 0; r < 16; ++r) negm16[r] = -m_row;
        A2_PIN(negm16);
        float l_reg = 0.f; f32x16 o[4]; o[0] = f32x16{}; o[1] = f32x16{}; o[2] = f32x16{}; o[3] = f32x16{};
        f32x16 pA0, pA1, pB0, pB1; bf16x8 kf[8]; s16x4 vlo[5], vhi[5]; u32x4 pw[4];
        asm volatile("s_waitcnt vmcnt(0)" ::: "memory");
        if (NT < 8 && tid == 0) slot[1] = nxt;
        asm volatile("s_waitcnt lgkmcnt(0)\n\ts_barrier" ::: "memory");
        bool hasn = false; const char* KhN = Kh; const char* VhN = Vh;
#define GET_NEXT() do { const int un_ = __builtin_amdgcn_readfirstlane((int)slot[1]); hasn = un_ < limit; if (hasn) { decode_unit(un_, myq, P, OD, nx); KhN = uni_ptr(nx.K); VhN = uni_ptr(nx.V); } } while (0)
        if (NT < 8) GET_NEXT();
#pragma unroll
        for (int d0 = 0; d0 < 4; ++d0) kload2(kf, kp0, d0);
        pA0 = A2_MFMA(kf[0], qr[0], negm16); pA1 = A2_MFMA(kf[1], qr[0], negm16); pA0 = A2_MFMA(kf[2], qr[1], pA0); pA1 = A2_MFMA(kf[3], qr[1], pA1);
        pA0 = A2_MFMA(kf[4], qr[2], pA0); pA1 = A2_MFMA(kf[5], qr[2], pA1); pA0 = A2_MFMA(kf[6], qr[3], pA0); pA1 = A2_MFMA(kf[7], qr[3], pA1);
#pragma unroll
        for (int r = 0; r < 16; ++r) { pA0[r] = __builtin_amdgcn_exp2f(pA0[r]); pA1[r] = __builtin_amdgcn_exp2f(pA1[r]); }
        int vp = vstart;
        { int v1 = vp + VSLOT; if (v1 == 3 * VSLOT) v1 = 0; DMA_K(Kh + 3 * (size_t)TSTR, 3 * KSLOT); DMA_V(Vh + TSTR, v1); }
        kload2(kf, kp0 + KSLOT, 0); kload2(kf, kp0 + KSLOT, 1);
        A2_WAIT_BAR(3);
        int kc = KSLOT;
#define PKW(P, i) cvtpk(P[i], P[(i) + 1])
#define VFR(s) (bf16x8){vlo[s][0], vlo[s][1], vlo[s][2], vlo[s][3], vhi[s][0], vhi[s][1], vhi[s][2], vhi[s][3]}
#define VRD(s, i) do { vlo[s] = vtr(vq_ + (((i) & 3) * 4096 + ((i) >> 2) * 1024)); vhi[s] = vtr(vq_ + (((i) & 3) * 4096 + ((i) >> 2) * 1024 + 512)); } while (0)
#define GAPA(MF, W0, W1, PW) do { MF; W0; W1; A2_PIN(PW); SBAR(); } while (0)
#define GAPB(i, X, j, Y) do { if ((i) + 4 < 16) VRD(((i) + 4) % 5, (i) + 4); if ((i) == 9) kload2(kf, kn_, 0); if ((i) == 10) kload2(kf, kn_, 1); SBAR(); \
    o[(i) & 3] = A2_MFMA(VFR((i) % 5), __builtin_bit_cast(bf16x8, pw[(i) >> 2]), o[(i) & 3]); X[j] = __builtin_amdgcn_exp2f(X[j]); X[(j) + 1] = __builtin_amdgcn_exp2f(X[(j) + 1]); l_reg += Y[j]; l_reg += Y[(j) + 1]; A2_PIN(X); A2_PIN(l_reg); SBAR(); } while (0)
#define A2_STEP(C0, C1, P0, P1, t) do { \
    if ((t) == tpop) { if (tid == 0) slot[1] = __hip_atomic_fetch_add((unsigned*)(qheads + myq), 1u, __ATOMIC_RELAXED, __HIP_MEMORY_SCOPE_AGENT); } \
    if ((t) == tpop + 1) GET_NEXT();                                                                                 \
    SBAR(); \
    const lds_cptr kq_ = kp0 + kc, vq_ = vp0 + vp, kn_ = kp0 + ((kc + KSLOT) & (4 * KSLOT - 1)); \
    const int ik_ = (t) + 3, iv_ = (t) + 1; \
    const char* ks_ = ik_ < NT ? Kh + (size_t)ik_ * TSTR : KhN + (size_t)(ik_ - NT) * TSTR;                            \
    const char* vs_ = iv_ < NT ? Vh + (size_t)iv_ * TSTR : VhN; \
    const int kprev_ = (kc - KSLOT) & (4 * KSLOT - 1); int vnew_ = vp + 2 * VSLOT; if (vnew_ >= 3 * VSLOT) vnew_ -= 3 * VSLOT; \
    kload2(kf, kq_, 2); SBAR(); \
    GAPA(C0 = A2_MFMA(kf[0], qr[0], negm16), pw[0][0] = PKW(P0, 0),  pw[0][1] = PKW(P0, 2),  pw[0]); \
    kload2(kf, kq_, 3); SBAR(); \
    GAPA(C1 = A2_MFMA(kf[1], qr[0], negm16), pw[0][2] = PKW(P0, 4),  pw[0][3] = PKW(P0, 6),  pw[0]); \
    VRD(0, 0); SBAR(); GAPA(C0 = A2_MFMA(kf[2], qr[1], C0), pw[1][0] = PKW(P0, 8),  pw[1][1] = PKW(P0, 10), pw[1]); \
    VRD(1, 1); SBAR(); GAPA(C1 = A2_MFMA(kf[3], qr[1], C1), pw[1][2] = PKW(P0, 12), pw[1][3] = PKW(P0, 14), pw[1]); \
    VRD(2, 2); SBAR(); GAPA(C0 = A2_MFMA(kf[4], qr[2], C0), pw[2][0] = PKW(P1, 0),  pw[2][1] = PKW(P1, 2),  pw[2]); \
    VRD(3, 3); SBAR(); GAPA(C1 = A2_MFMA(kf[5], qr[2], C1), pw[2][2] = PKW(P1, 4),  pw[2][3] = PKW(P1, 6),  pw[2]); \
                       GAPA(C0 = A2_MFMA(kf[6], qr[3], C0), pw[3][0] = PKW(P1, 8),  pw[3][1] = PKW(P1, 10), pw[3]); \
                       GAPA(C1 = A2_MFMA(kf[7], qr[3], C1), pw[3][2] = PKW(P1, 12), pw[3][3] = PKW(P1, 14), pw[3]); \
    DMA_K(ks_, kprev_); DMA_V(vs_, vnew_); SBAR();                                                                   \
    GAPB(0, C0, 0, P0);  GAPB(1, C0, 2, P0);  GAPB(2, C0, 4, P0);   GAPB(3, C0, 6, P0);   GAPB(4, C0, 8, P0);   GAPB(5, C0, 10, P0);  GAPB(6, C0, 12, P0);  GAPB(7, C0, 14, P0); \
    GAPB(8, C1, 0, P1);  GAPB(9, C1, 2, P1);  GAPB(10, C1, 4, P1);  GAPB(11, C1, 6, P1);  GAPB(12, C1, 8, P1);  GAPB(13, C1, 10, P1); GAPB(14, C1, 12, P1); GAPB(15, C1, 14, P1); \
    A2_WAIT_BAR(3);                                                                                                   \
    kc = (kc + KSLOT) & (4 * KSLOT - 1); vp += VSLOT; if (vp == 3 * VSLOT) vp = 0; \
    } while (0)
        int t = 1;
        for (; t + 1 < NT; t += 2) {
            A2_STEP(pB0, pB1, pA0, pA1, t);
            A2_STEP(pA0, pA1, pB0, pB1, t + 1);
        }
        A2_STEP(pB0, pB1, pA0, pA1, NT - 1);
        { float sacc = pB0[0] + pB0[1];
#pragma unroll
          for (int r = 2; r < 16; ++r) sacc += pB0[r];
#pragma unroll
          for (int r = 0; r < 16; ++r) sacc += pB1[r];
          l_reg += sacc;
          pw[0] = (u32x4){PKW(pB0, 0), PKW(pB0, 2), PKW(pB0, 4), PKW(pB0, 6)}; pw[1] = (u32x4){PKW(pB0, 8), PKW(pB0, 10), PKW(pB0, 12), PKW(pB0, 14)};
          pw[2] = (u32x4){PKW(pB1, 0), PKW(pB1, 2), PKW(pB1, 4), PKW(pB1, 6)}; pw[3] = (u32x4){PKW(pB1, 8), PKW(pB1, 10), PKW(pB1, 12), PKW(pB1, 14)};
          const lds_cptr vq_ = vp0 + vp;
#pragma unroll
          for (int kg = 0; kg < 4; ++kg) {
              VRD(0, kg * 4 + 0); VRD(1, kg * 4 + 1); VRD(2, kg * 4 + 2); VRD(3, kg * 4 + 3);
              o[0] = A2_MFMA(VFR(0), __builtin_bit_cast(bf16x8, pw[kg]), o[0]); o[1] = A2_MFMA(VFR(1), __builtin_bit_cast(bf16x8, pw[kg]), o[1]);
              o[2] = A2_MFMA(VFR(2), __builtin_bit_cast(bf16x8, pw[kg]), o[2]); o[3] = A2_MFMA(VFR(3), __builtin_bit_cast(bf16x8, pw[kg]), o[3]); } }
        { auto rr = __builtin_amdgcn_permlane32_swap(__float_as_uint(l_reg), __float_as_uint(l_reg), false, false); l_reg = __uint_as_float(rr[0]) + __uint_as_float(rr[1]); }
        const float rli = __builtin_amdgcn_rcpf(l_reg);
        GAS bf16* Ow = (GAS bf16*)cur.O + (long)(wid * 32 + r32) * DM + 4 * hi;
#pragma unroll
        for (int d = 0; d < 4; ++d)
#pragma unroll
          for (int g = 0; g < 4; ++g) { u32x2 w; w.x = cvtpk(o[d][4 * g] * rli, o[d][4 * g + 1] * rli); w.y = cvtpk(o[d][4 * g + 2] * rli, o[d][4 * g + 3] * rli);
              *(GAS u32x2*)(Ow + d * 32 + 8 * g) = w; }
        vstart = vp + VSLOT; if (vstart == 3 * VSLOT) vstart = 0;
        if (hasn) { cur = nx; warm = true; }
        else { asm volatile("s_waitcnt vmcnt(0)" ::: "memory"); warm = false; }
    }
    __builtin_amdgcn_s_setprio(0);
    __syncthreads();
#undef DMA_K
#undef DMA_V
#undef PKW
#undef VFR
#undef VRD
#undef GAPA
#undef GAPB
#undef A2_STEP
#undef GET_NEXT
}
}

__device__ __forceinline__ int gla_item(int b, int h, int dir, int c) { return ((b * 4 + h) * 2 + dir) * NCH + c; }
namespace gla {
using att::bf16x8; using att::f32x16; using att::u32x4;
__device__ __forceinline__ void gates8(const bf16* P, const float* w2, const float* gb, size_t row0, int dir, int seg, int k, float (&gl)[8]) {
    float w[16];
#pragma unroll
    for (int j = 0; j < 16; ++j) w[j] = w2[j * 256 + k];
    const float bias = gb[k];
#pragma unroll
    for (int i = 0; i < 8; ++i) {
        const bf16* gp = P + (row0 + seg * 8 + i) * NP + C_GLR + dir * 16;
        const v4u a = *(const v4u*)gp, b = *(const v4u*)(gp + 8);
        float z = bias;
        z += bflo(a.x) * w[0] + bfhi(a.x) * w[1] + bflo(a.y) * w[2] + bfhi(a.y) * w[3] + bflo(a.z) * w[4] + bfhi(a.z) * w[5] + bflo(a.w) * w[6] + bfhi(a.w) * w[7];
        z += bflo(b.x) * w[8] + bfhi(b.x) * w[9] + bflo(b.y) * w[10] + bfhi(b.y) * w[11] + bflo(b.z) * w[12] + bfhi(b.z) * w[13] + bflo(b.w) * w[14] + bfhi(b.w) * w[15];
        gl[i] = (fminf(z, 0.f) - log1pf(expf(-fabsf(z)))) * (1.f / 16.f);
    }
}
__device__ __forceinline__ float lscan(const float (&gl)[8], int dir, float (&loc)[8]) {
    float run = 0.f;
    if (dir == 0) {
#pragma unroll
        for (int i = 0; i < 8; ++i) { run += gl[i]; loc[i] = run; }
    } else {
#pragma unroll
        for (int i = 7; i >= 0; --i) { run += gl[i]; loc[i] = run; }
    }
    return run;
}
__device__ __forceinline__ void stage_tile_bf16(const bf16* src, size_t pitch, char* tile, int tid) {
    const int sr = tid >> 4, sc = (tid & 15) * 8;
    const bf16x8 a = *reinterpret_cast<const bf16x8*>(src + (size_t)sr * pitch + sc), b = *reinterpret_cast<const bf16x8*>(src + (size_t)(32 + sr) * pitch + sc);
    *(bf16x8*)(tile + att::v_st(sr, sc)) = a; *(bf16x8*)(tile + att::v_st(32 + sr, sc)) = b;
}
__device__ __forceinline__ void stage_tile_f32(const float* src, char* tile, int tid) {
    const int sr = tid >> 4, sc = (tid & 15) * 8;
#pragma unroll
    for (int t = 0; t < 2; ++t) { const int row = sr + 32 * t; const f32x4 x = *(const f32x4*)(src + row * 128 + sc), y = *(const f32x4*)(src + row * 128 + sc + 4);
        u32x4 w = {att::cvtpk(x[0], x[1]), att::cvtpk(x[2], x[3]), att::cvtpk(y[0], y[1]), att::cvtpk(y[2], y[3])};
        *(u32x4*)(tile + att::v_st(row, sc)) = w; }
}
__device__ __forceinline__ void pv_sel(int d0, f32x16& o, int vb, bf16x8 a0, bf16x8 a1, bf16x8 a2, bf16x8 a3) {
    switch (d0) { case 0: att::pv_one<0>(o, vb, a0, a1, a2, a3); break; case 1: att::pv_one<1>(o, vb, a0, a1, a2, a3); break;
                  case 2: att::pv_one<2>(o, vb, a0, a1, a2, a3); break; default: att::pv_one<3>(o, vb, a0, a1, a2, a3); break; }
}
__device__ __forceinline__ void afrag4(const char* img, int row, int hi, bf16x8 (&a)[4]) {
#pragma unroll
    for (int s = 0; s < 4; ++s) a[s] = *reinterpret_cast<const bf16x8*>(img + KSWZ64(row, (s * 16 + hi * 8) * 2));
}
__device__ __forceinline__ void st_sw(char* img, int row, int col, float v) { *(unsigned short*)(img + KSWZ64(row, col * 2)) = (unsigned short)(att::cvtpk(v, 0.f) & 0xffffu); }
}

constexpr size_t WS_OG = WS_DS;
struct GlaPre { unsigned g; unsigned short q[8], k[8]; att::bf16x8 v0, v1; };
__device__ __forceinline__ void gla_prefetch(GlaPre& R, const bf16* P_, size_t row0, int h, int dir, int k, int seg, int tid) {
    const GAS bf16* P = (const GAS bf16*)P_;
    R.g = *(const GAS unsigned*)(P + (row0 + seg * 8 + (k >> 3)) * NP + C_GLR + dir * 16 + (k & 7) * 2);
#pragma unroll
    for (int i = 0; i < 8; ++i) { const GAS bf16* rp = P + (row0 + seg * 8 + i) * NP; R.q[i] = rp[C_GQ + h * 64 + k]; R.k[i] = rp[C_GK + h * 64 + k]; }
    const int sr = tid >> 4, sc = (tid & 15) * 8;
    R.v0 = *(const GAS att::bf16x8*)(P + (row0 + sr) * NP + C_GV + h * 128 + sc); R.v1 = *(const GAS att::bf16x8*)(P + (row0 + 32 + sr) * NP + C_GV + h * 128 + sc);
}
__device__ __forceinline__ void gla_chain(Frame& F, int l, int chain) {
    const int b = chain >> 3, h = (chain >> 1) & 3, dir = chain & 1;
    const bf16* P = (const bf16*)(F.ws + WS_PROJ); bf16* OG = (bf16*)(F.ws + WS_OG) + (size_t)dir * M * 512;
    char* lds = (char*)F.lds; char* Vt = lds; char* St = lds + 16384; char* KtT = lds + 32768; char* Kt = lds + 40960; char* Qt = lds + 49152; char* Qh = lds + 57344;
    float* T = (float*)(lds + 65536); float* Dec = (float*)(lds + 67584);
    const int k = F.lane, seg = F.tid >> 6, r32 = F.lane & 31, hi = F.lane >> 5, mt = F.wave >> 2, d0 = F.wave & 3;
    const int vbV = (int)(uintptr_t)Vt + att::v_rd_base(F.lane), vbS = (int)(uintptr_t)St + att::v_rd_base(F.lane);
    const int sr = F.tid >> 4, sc = (F.tid & 15) * 8;
    float w[16];
    { const float* w2 = INP(11) + (size_t)((l * 2 + dir) * 16) * 256 + h * 64;
#pragma unroll
      for (int j = 0; j < 16; ++j) w[j] = w2[j * 256 + k]; }
    const float bias = (INP(12) + (l * 2 + dir) * 256 + h * 64)[k];
    att::f32x16 S = {};
    GlaPre R, RN;
    { const int c0 = dir == 0 ? 0 : 3; gla_prefetch(RN, P, (size_t)b * TPB + c0 * 64, h, dir, k, seg, F.tid); }
    for (int j = 0; j < NCH; ++j) {
        const int c = dir == 0 ? j : (j < 4 ? 3 - j : 39 - j);
        const size_t row0 = (size_t)b * TPB + c * 64;
        R = RN;
        if (j + 1 < NCH) { const int cn = dir == 0 ? j + 1 : (j + 1 < 4 ? 2 - j : 38 - j); gla_prefetch(RN, P, (size_t)b * TPB + cn * 64, h, dir, k, seg, F.tid); }
        float gl[8], loc[8];
#pragma unroll
        for (int i = 0; i < 8; ++i) {
            float z = bias;
#pragma unroll
            for (int d = 0; d < 8; ++d) { const unsigned s = (unsigned)__builtin_amdgcn_readlane((int)R.g, i * 8 + d); z += bflo(s) * w[2 * d] + bfhi(s) * w[2 * d + 1]; }
            gl[i] = (fminf(z, 0.f) - __logf(1.f + __expf(-fabsf(z)))) * (1.f / 16.f); }
        const float segtot = gla::lscan(gl, dir, loc);
        T[seg * 64 + k] = segtot;
        *(att::bf16x8*)(Vt + att::v_st(sr, sc)) = R.v0; *(att::bf16x8*)(Vt + att::v_st(32 + sr, sc)) = R.v1;
#pragma unroll
        for (int r = 0; r < 16; ++r) *(unsigned short*)(St + att::v_st(mt * 32 + att::crow(r, hi), d0 * 32 + r32)) = (unsigned short)(att::cvtpk(S[r], 0.f) & 0xffffu);
        __syncthreads();
        float off = 0.f, tot = 0.f;
        int sg = seg; asm volatile("" : "+v"(sg));
#pragma unroll
        for (int s = 0; s < 8; ++s) { const float t = T[s * 64 + k]; tot += t; const bool inoff = dir == 0 ? (s < sg) : (s > sg); off += inoff ? t : 0.f; }
        const float etot = __expf(tot);
        float kt[8];
#pragma unroll
        for (int i = 0; i < 8; ++i) { const int tau = seg * 8 + i; const float qv = bf2f(R.q[i]), kv = bf2f(R.k[i]); const float cc = loc[i] + off;
            const float a = fmaxf(__expf(cc), 1e-30f)  , bq = __builtin_amdgcn_rcpf(a), kb = kv * bq;
            kt[i] = kb * etot;
            gla::st_sw(Qh, tau, k, qv * a); gla::st_sw(Kt, tau, k, kb); }
        { att::u32x4 wv = {att::cvtpk(kt[0], kt[1]), att::cvtpk(kt[2], kt[3]), att::cvtpk(kt[4], kt[5]), att::cvtpk(kt[6], kt[7])};
          *(att::u32x4*)(KtT + KSWZ64(k, seg * 16)) = wv; }
        if (sg == 0) Dec[k] = etot;
        __syncthreads();
        att::f32x16 o = {};
        int tau_q = mt * 32 + r32; asm volatile("" : "+v"(tau_q));
        { att::bf16x8 qr[4]; gla::afrag4(Qh, tau_q, hi, qr);
          att::f32x16 p0, p1; att::qkt(p0, p1, (const bf16*)Kt, qr, r32, hi);
#pragma unroll
          for (int r = 0; r < 16; ++r) { const int t0 = att::crow(r, hi), t1 = 32 + t0;
              const bool k0 = dir == 0 ? (t0 <= tau_q) : (t0 >= tau_q), k1 = dir == 0 ? (t1 <= tau_q) : (t1 >= tau_q);
              p0[r] = k0 ? p0[r] : 0.f; p1[r] = k1 ? p1[r] : 0.f; }
          att::bf16x8 pa0, pa1, pa2, pa3; att::pack_p(p0, p1, pa0, pa1, pa2, pa3);
          gla::pv_sel(d0, o, vbV, pa0, pa1, pa2, pa3);
          gla::pv_sel(d0, o, vbS, qr[0], qr[1], qr[2], qr[3]); }
#pragma unroll
        for (int r = 0; r < 16; ++r) S[r] *= Dec[mt * 32 + att::crow(r, hi)];
        { att::bf16x8 a[4]; gla::afrag4(KtT, mt * 32 + r32, hi, a); gla::pv_sel(d0, S, vbV, a[0], a[1], a[2], a[3]); }
        GAS bf16* op = (GAS bf16*)(OG + row0 * 512 + h * 128 + d0 * 32 + r32);
#pragma unroll
        for (int r = 0; r < 16; ++r) op[(size_t)(mt * 32 + att::crow(r, hi)) * 512] = (bf16)(att::cvtpk(o[r], 0.f) & 0xffffu);
        __syncthreads();
    }
}
__device__ __forceinline__ void p3_mixer(Frame& F, int l) {
    refresh(F);
    for (int ch = F.blk; ch < NBATCH * 8; ch += F.G) gla_chain(F, l, ch);
    att2::attn_stream(F, l);
}
__device__ __forceinline__ void p5_merge_all(Frame& F, int l) {
    refresh(F);
    const bf16* OD = (const bf16*)(F.ws + WS_OD); const bf16* OG = (const bf16*)(F.ws + WS_OG); const bf16* P = (const bf16*)(F.ws + WS_PROJ); bf16* MRG = (bf16*)(F.ws + WS_H);
    const float lam = ((const float*)(F.ws + WS_ROPE + 16384))[l]; const float omli = 1.f - lam_init_of(l);
    const float* subln = INP(14) + l * 128; const float* onorm = INP(15) + l * 128;
    const int h = F.lane >> 4, c0 = (F.lane & 15) * 8;
    const int rpw = (M + F.NGW - 1) / F.NGW, r0 = F.gw * rpw, r1 = (r0 + rpw < M) ? r0 + rpw : M;
    for (int r = r0; r < r1; ++r) {
        const v4u a = *(const v4u*)(OD + (size_t)r * DM + h * 256 + c0), bq = *(const v4u*)(OD + (size_t)r * DM + h * 256 + 128 + c0);
        const v4u gf = *(const v4u*)(OG + (size_t)r * 512 + h * 128 + c0), gbk = *(const v4u*)(OG + ((size_t)M + r) * 512 + h * 128 + c0);
        const v4u gt = *(const v4u*)(P + (size_t)r * NP + C_GG + h * 128 + c0);
        float d[8], e[8], g[8];
        d[0] = bflo(a.x) - lam * bflo(bq.x); d[1] = bfhi(a.x) - lam * bfhi(bq.x); d[2] = bflo(a.y) - lam * bflo(bq.y); d[3] = bfhi(a.y) - lam * bfhi(bq.y);
        d[4] = bflo(a.z) - lam * bflo(bq.z); d[5] = bfhi(a.z) - lam * bfhi(bq.z); d[6] = bflo(a.w) - lam * bflo(bq.w); d[7] = bfhi(a.w) - lam * bfhi(bq.w);
        e[0] = bflo(gf.x) + bflo(gbk.x); e[1] = bfhi(gf.x) + bfhi(gbk.x); e[2] = bflo(gf.y) + bflo(gbk.y); e[3] = bfhi(gf.y) + bfhi(gbk.y);
        e[4] = bflo(gf.z) + bflo(gbk.z); e[5] = bfhi(gf.z) + bfhi(gbk.z); e[6] = bflo(gf.w) + bflo(gbk.w); e[7] = bfhi(gf.w) + bfhi(gbk.w);
        g[0] = bflo(gt.x); g[1] = bfhi(gt.x); g[2] = bflo(gt.y); g[3] = bfhi(gt.y); g[4] = bflo(gt.z); g[5] = bfhi(gt.z); g[6] = bflo(gt.w); g[7] = bfhi(gt.w);
        float ss = 0.f, se = 0.f;
#pragma unroll
        for (int i = 0; i < 8; ++i) { ss += d[i] * d[i]; se += e[i] * e[i]; }
        ss = xadd<1>(ss); ss = xadd<2>(ss); ss = xadd<4>(ss); ss = xadd<8>(ss);
        se = xadd<1>(se); se = xadd<2>(se); se = xadd<4>(se); se = xadd<8>(se);
        const float sc = omli / sqrtf(ss * (1.f / 128.f) + EPS), se2 = 1.0f / sqrtf(se * (1.f / 128.f) + EPS);
#pragma unroll
        for (int i = 0; i < 8; ++i) { d[i] = d[i] * sc * subln[c0 + i]; e[i] = e[i] * se2 * onorm[c0 + i] * siluf(g[i]); }
        v4u w; w.x = pg8::cvt_pk_bf16(d[0], d[1]); w.y = pg8::cvt_pk_bf16(d[2], d[3]); w.z = pg8::cvt_pk_bf16(d[4], d[5]); w.w = pg8::cvt_pk_bf16(d[6], d[7]);
        *(v4u*)(MRG + (size_t)r * DM + h * 128 + c0) = w;
        v4u x; x.x = pg8::cvt_pk_bf16(e[0], e[1]); x.y = pg8::cvt_pk_bf16(e[2], e[3]); x.z = pg8::cvt_pk_bf16(e[4], e[5]); x.w = pg8::cvt_pk_bf16(e[6], e[7]);
        *(v4u*)(MRG + (size_t)r * DM + 512 + h * 128 + c0) = x;
    }
}

__device__ __forceinline__ float dpp_sum16(float v) {
    v += __int_as_float(__builtin_amdgcn_update_dpp(0, __float_as_int(v), 0xB1, 0xF, 0xF, true));
    v += __int_as_float(__builtin_amdgcn_update_dpp(0, __float_as_int(v), 0x4E, 0xF, 0xF, true));
    v += __int_as_float(__builtin_amdgcn_update_dpp(0, __float_as_int(v), 0x141, 0xF, 0xF, true));
    v += __int_as_float(__builtin_amdgcn_update_dpp(0, __float_as_int(v), 0x140, 0xF, 0xF, true));
    return v;
}
__device__ __forceinline__ float wave_sum2(float v) { v = dpp_sum16(v); v = xadd<16>(v); v = xadd<32>(v); return v; }
__device__ __forceinline__ float row_rinv2(const f32x4 (&v)[4]) {
    float s = 0.f;
#pragma unroll
    for (int j = 0; j < 4; ++j) s += (v[j][0] * v[j][0] + v[j][1] * v[j][1]) + (v[j][2] * v[j][2] + v[j][3] * v[j][3]);
    return __builtin_amdgcn_rsqf(wave_sum2(s) * (1.f / DM) + EPS);
}
__device__ __forceinline__ void ld_raw_bf16(const bf16* row, int lane, u32x2 (&v)[4]) {
#pragma unroll
    for (int j = 0; j < 4; ++j) v[j] = *(const u32x2*)(row + 4 * lane + 256 * j);
}
__device__ __forceinline__ f32x4 raw2f(u32x2 w) { return (f32x4){bflo(w.x), bfhi(w.x), bflo(w.y), bfhi(w.y)}; }
__device__ __forceinline__ void ld_vec(const float* p, int lane, f32x4 (&v)[4]) {
#pragma unroll
    for (int j = 0; j < 4; ++j) v[j] = *(const f32x4*)(p + 4 * lane + 256 * j);
}

__device__ __forceinline__ void p1_rows(Frame& F, int l) {
    refresh(F);
    const float* MOD = (const float*)(F.ws + WS_MOD);
    bf16* X = (bf16*)(F.ws + WS_X); bf16* H = (bf16*)(F.ws + WS_H); const bf16* F2 = (const bf16*)(F.ws + WS_F2);
    const int rpw = (M + F.NGW - 1) / F.NGW, r0 = F.gw * rpw, r1 = (r0 + rpw < M) ? r0 + rpw : M;
    if (r0 >= r1) return;
    const bool two = l > 0 && ((l - 1) & 1);
    f32x4 gpre[4], gpost[4], sh[4], sc[4], gt[4];
    ld_vec(INP(6) + l * DM, F.lane, gpre);
    if (l > 0) ld_vec(INP(9) + (l - 1) * DM, F.lane, gpost);
    int cur = -1;
    f32x4 xn[4]; u32x2 xr[4], fn[4], gn[4];
#define P1_ISSUE(r) do { const int b_ = (r) / TPB, p_ = (r) % TPB; \
        if (l == 0) ld_row_f32(p_ < CTX ? INP(2) + ((size_t)b_ * CTX + p_) * DM : INP(0) + ((size_t)b_ * SEQ + (p_ - CTX)) * DM, F.lane, xn); \
        else ld_raw_bf16(X + (size_t)(r) * DM, F.lane, xr); \
        if (l > 0) { ld_raw_bf16(F2 + (size_t)(r) * DM, F.lane, fn); if (two) ld_raw_bf16(F2 + ((size_t)M + (r)) * DM, F.lane, gn); } } while (0)
    P1_ISSUE(r0);
    for (int r = r0; r < r1; ++r) {
        f32x4 x[4]; u32x2 fr[4], gr[4];
#pragma unroll
        for (int j = 0; j < 4; ++j) { x[j] = (l == 0) ? xn[j] : raw2f(xr[j]); fr[j] = fn[j]; gr[j] = gn[j]; }
        if (r + 1 < r1) P1_ISSUE(r + 1);
        const int b = r / TPB, p = r % TPB, mrow = p < CTX ? 16 : b;
        if (mrow != cur) { cur = mrow; const float* modp = MOD + ((size_t)l * 17 + mrow) * 6144; ld_vec(modp, F.lane, sh); ld_vec(modp + 1024, F.lane, sc);
            if (l > 0) ld_vec(MOD + ((size_t)(l - 1) * 17 + mrow) * 6144 + 5 * 1024, F.lane, gt); }
        if (l > 0) {
            f32x4 f[4];
#pragma unroll
            for (int j = 0; j < 4; ++j) { f[j] = raw2f(fr[j]); if (two) f[j] = f[j] + raw2f(gr[j]); }
            const float rinv = row_rinv2(f);
#pragma unroll
            for (int j = 0; j < 4; ++j) x[j] = x[j] + gt[j] * (f[j] * rinv * gpost[j]);
        }
        st_row_bf16(X + (size_t)r * DM, F.lane, x);
        const float rinv = row_rinv2(x);
        f32x4 h[4];
#pragma unroll
        for (int j = 0; j < 4; ++j) h[j] = (x[j] * rinv * gpre[j]) * (sc[j] + 1.0f) + sh[j];
        st_row_bf16(H + (size_t)r * DM, F.lane, h);
    }
#undef P1_ISSUE
}
__device__ __forceinline__ void pf_final(Frame& F) {
    refresh(F);
    const float* MOD = (const float*)(F.ws + WS_MOD);
    const bf16* X = (const bf16*)(F.ws + WS_X); const bf16* F2 = (const bf16*)(F.ws + WS_F2);
    const int l = DEPTH - 1, NR = NBATCH * SEQ;
    const int rpw = (NR + F.NGW - 1) / F.NGW, i0 = F.gw * rpw, i1 = (i0 + rpw < NR) ? i0 + rpw : NR;
    if (i0 >= i1) return;
    f32x4 gpost[4], gt[4]; ld_vec(INP(9) + l * DM, F.lane, gpost);
    int cur = -1;
    u32x2 xn[4], fn[4], gn[4];
#define PF_ISSUE(i) do { const size_t r_ = (size_t)((i) / SEQ) * TPB + CTX + (i) % SEQ; ld_raw_bf16(X + r_ * DM, F.lane, xn); ld_raw_bf16(F2 + r_ * DM, F.lane, fn); ld_raw_bf16(F2 + ((size_t)M + r_) * DM, F.lane, gn); } while (0)
    PF_ISSUE(i0);
    for (int i = i0; i < i1; ++i) {
        f32x4 x[4], f[4];
#pragma unroll
        for (int j = 0; j < 4; ++j) { x[j] = raw2f(xn[j]); f[j] = raw2f(fn[j]) + raw2f(gn[j]); }
        if (i + 1 < i1) PF_ISSUE(i + 1);
        const int b = i / SEQ;
        if (b != cur) { cur = b; ld_vec(MOD + ((size_t)l * 17 + b) * 6144 + 5 * 1024, F.lane, gt); }
        const float rinv = row_rinv2(f);
#pragma unroll
        for (int j = 0; j < 4; ++j) x[j] = x[j] + gt[j] * (f[j] * rinv * gpost[j]);
        st_row_f32(F.A->out + (size_t)i * DM, F.lane, x);
    }
#undef PF_ISSUE
}
__device__ __forceinline__ void p7_rows(Frame& F, int l) {
    refresh(F);
    const float* MOD = (const float*)(F.ws + WS_MOD);
    bf16* X = (bf16*)(F.ws + WS_X); const bf16* Y = (const bf16*)(F.ws + WS_Y); bf16* H2 = (bf16*)(F.ws + WS_H2);
    const bool moe = l & 1; const int li = l >> 1;
    int* TOPE = (int*)(F.ws + WS_TOPE); int* LIDX = (int*)(F.ws + WS_LIDX); float* TOPW = (float*)(F.ws + WS_TOPW); int* BLKB = (int*)(F.ws + WS_BLKB);
    volatile LAS unsigned* LCNT = F.MISC + 16;
    LAS float* RT = (LAS float*)F.lds;
    if (moe) {
        const float* router = INP(20) + (size_t)li * DM * NE;
        if (F.tid < 8) LCNT[F.tid] = 0u;
        for (int i = F.tid; i < DM * NE / 4; i += 512) { const f32x4 q = *(const f32x4*)(router + 4 * i); const int c = i >> 1, e0 = (i & 1) * 4;
            RT[(e0 + 0) * DM + c] = q[0]; RT[(e0 + 1) * DM + c] = q[1]; RT[(e0 + 2) * DM + c] = q[2]; RT[(e0 + 3) * DM + c] = q[3]; }
        __syncthreads();
    }
    const bool lastl = (l == DEPTH - 1); const int NR = lastl ? NBATCH * SEQ : M;
#define P7_ROW(i) (lastl ? ((i) / SEQ) * TPB + CTX + (i) % SEQ : (i))
    const int rpw = (NR + F.NGW - 1) / F.NGW, r0 = F.gw * rpw, r1 = (r0 + rpw < NR) ? r0 + rpw : NR;
    if (r0 < r1) {
        f32x4 gpost[4], gpre[4], gt[4], sh[4], sc[4];
        ld_vec(INP(7) + l * DM, F.lane, gpost); ld_vec(INP(8) + l * DM, F.lane, gpre);
        int cur = -1;
        u32x2 xn[4], yn[4];
        ld_raw_bf16(X + (size_t)P7_ROW(r0) * DM, F.lane, xn); ld_raw_bf16(Y + (size_t)P7_ROW(r0) * DM, F.lane, yn);
        for (int ri = r0; ri < r1; ++ri) {
            const int r = P7_ROW(ri);
            f32x4 x[4], y[4];
#pragma unroll
            for (int j = 0; j < 4; ++j) { x[j] = raw2f(xn[j]); y[j] = raw2f(yn[j]); }
            if (ri + 1 < r1) { const int rn = P7_ROW(ri + 1); ld_raw_bf16(X + (size_t)rn * DM, F.lane, xn); ld_raw_bf16(Y + (size_t)rn * DM, F.lane, yn); }
            const int b = r / TPB, p = r % TPB, mrow = p < CTX ? 16 : b;
            if (mrow != cur) { cur = mrow; const float* modp = MOD + ((size_t)l * 17 + mrow) * 6144; ld_vec(modp + 2 * 1024, F.lane, gt); ld_vec(modp + 3 * 1024, F.lane, sh); ld_vec(modp + 4 * 1024, F.lane, sc); }
            const float ry = row_rinv2(y);
#pragma unroll
            for (int j = 0; j < 4; ++j) x[j] = x[j] + gt[j] * (y[j] * ry * gpost[j]);
            st_row_bf16(X + (size_t)r * DM, F.lane, x);
            const float rx = row_rinv2(x);
            f32x4 h[4];
#pragma unroll
            for (int j = 0; j < 4; ++j) h[j] = (x[j] * rx * gpre[j]) * (sc[j] + 1.0f) + sh[j];
            if constexpr (FFN_F8) {
#pragma unroll
                for (int j = 0; j < 4; ++j) *(unsigned*)((unsigned char*)H2 + (size_t)r * DM + 4 * F.lane + 256 * j) = pk4_f8(h[j][0], h[j][1], h[j][2], h[j][3]);
            } else st_row_bf16(H2 + (size_t)r * DM, F.lane, h);
            if (moe) {
                float lg[8];
#pragma unroll
                for (int e = 0; e < 8; ++e) lg[e] = 0.f;
#pragma unroll
                for (int j = 0; j < 4; ++j)
#pragma unroll
                    for (int e = 0; e < 8; ++e) { const f32x4 q = *(const LAS f32x4*)(RT + e * DM + 4 * F.lane + 256 * j); lg[e] += (h[j][0] * q[0] + h[j][1] * q[1]) + (h[j][2] * q[2] + h[j][3] * q[3]); }
#pragma unroll
                for (int e = 0; e < 8; ++e) lg[e] = wave_sum2(lg[e]);
                int e0 = 0; float v0 = lg[0];
#pragma unroll
                for (int e = 1; e < 8; ++e) if (lg[e] > v0) { v0 = lg[e]; e0 = e; }
                int e1 = -1; float v1 = -3.0e38f;
#pragma unroll
                for (int e = 0; e < 8; ++e) if (e != e0 && lg[e] > v1) { v1 = lg[e]; e1 = e; }
                const float ex = __expf(v1 - v0), w0 = 1.f / (1.f + ex), w1 = ex / (1.f + ex);
                if (F.lane == 0) {
                    const unsigned i0 = __hip_atomic_fetch_add((LAS unsigned*)&LCNT[e0], 1u, __ATOMIC_RELAXED, __HIP_MEMORY_SCOPE_WORKGROUP), i1 = __hip_atomic_fetch_add((LAS unsigned*)&LCNT[e1], 1u, __ATOMIC_RELAXED, __HIP_MEMORY_SCOPE_WORKGROUP);
                    TOPE[r] = e0 | (e1 << 8); LIDX[2 * r] = (int)i0; LIDX[2 * r + 1] = (int)i1; TOPW[2 * r] = w0; TOPW[2 * r + 1] = w1;
                }
            }
        }
    }
    if (moe) {
        __syncthreads();
        if (F.tid < 8) { const unsigned base = __hip_atomic_fetch_add((unsigned*)((gu32*)F.ws + CW_CNT + 64 * li + F.tid), LCNT[F.tid], __ATOMIC_RELAXED, __HIP_MEMORY_SCOPE_AGENT); BLKB[F.blk * 8 + F.tid] = (int)base; }
    }
#undef P7_ROW
}
__device__ __forceinline__ void moe_offsets(Frame& F, int li, int (&cnt)[8], int (&off)[9]) {
    off[0] = 0;
#pragma unroll
    for (int e = 0; e < 8; ++e) { cnt[e] = (int)__hip_atomic_load((unsigned*)(((gu32*)F.ws) + CW_CNT + 64 * li + e), __ATOMIC_RELAXED, __HIP_MEMORY_SCOPE_AGENT); off[e + 1] = off[e] + ((cnt[e] + 255) & ~255); }
}
__device__ __forceinline__ void p7b_gather(Frame& F, int l) {
    refresh(F);
    const int li = l >> 1; int cnt[8], off[9]; moe_offsets(F, li, cnt, off);
    const bf16* H2 = (const bf16*)(F.ws + WS_H2); bf16* HG = (bf16*)(F.ws + WS_HG);
    const int* TOPE = (const int*)(F.ws + WS_TOPE); const int* LIDX = (const int*)(F.ws + WS_LIDX); const float* TOPW = (const float*)(F.ws + WS_TOPW); const int* BLKB = (const int*)(F.ws + WS_BLKB);
    int* RMAP = (int*)(F.ws + WS_RMAP); float* ROWW = (float*)(F.ws + WS_ROWW);
    constexpr int RB = FFN_F8 ? DM : 2 * DM, LB = RB / 64;
    const unsigned char* H2b = (const unsigned char*)H2; unsigned char* HGb = (unsigned char*)HG;
    const bool lastl = (l == DEPTH - 1); const int NR = lastl ? NBATCH * SEQ : M;
    const int rpw = (NR + F.NGW - 1) / F.NGW, r0 = F.gw * rpw, r1 = (r0 + rpw < NR) ? r0 + rpw : NR;
    for (int ri = r0; ri < r1; ++ri) {
        const int r = lastl ? (ri / SEQ) * TPB + CTX + ri % SEQ : ri;
        const int te = TOPE[r];
        v4u a, bq = {0u, 0u, 0u, 0u}; a = *(const v4u*)(H2b + (size_t)r * RB + F.lane * LB); if constexpr (!FFN_F8) bq = *(const v4u*)(H2b + (size_t)r * RB + F.lane * LB + 16);
#pragma unroll
        for (int s = 0; s < 2; ++s) {
            const int e = (te >> (8 * s)) & 0xff;
            int o = 0;
#pragma unroll
            for (int q = 0; q < 8; ++q) o = (q == e) ? off[q] : o;
            const int pos = o + BLKB[F.blk * 8 + e] + LIDX[2 * r + s];
            *(v4u*)(HGb + (size_t)pos * RB + F.lane * LB) = a; if constexpr (!FFN_F8) *(v4u*)(HGb + (size_t)pos * RB + F.lane * LB + 16) = bq;
            if (F.lane == 0) { RMAP[pos] = r | (s << 30); ROWW[pos] = TOPW[2 * r + s]; }
        }
    }
#pragma unroll
    for (int e = 0; e < 8; ++e) {
        const int npad = off[e + 1] - off[e] - cnt[e];
        for (int i = F.gw; i < npad; i += F.NGW) { const int pos = off[e] + cnt[e] + i; const unsigned zz = (unsigned)F.z; const v4u z = {zz, zz, zz, zz};
            *(v4u*)(HGb + (size_t)pos * RB + F.lane * LB) = z; if constexpr (!FFN_F8) *(v4u*)(HGb + (size_t)pos * RB + F.lane * LB + 16) = z;
            if (F.lane == 0) { RMAP[pos] = -1; ROWW[pos] = 0.f; } }
    }
}

__global__ void __launch_bounds__(NWAVES * 64, 2) mk_fwd(Args args) {
    extern __shared__ __attribute__((aligned(16))) unsigned char lds[];
    Frame F;
    F.lds = (LAS unsigned char*)lds;
    F.MISC = (volatile LAS unsigned*)(F.lds + MISC_OFF);
    F.tid = threadIdx.x; F.lane = F.tid & 63; F.wave = __builtin_amdgcn_readfirstlane(F.tid >> 6); F.wv = F.wave;
    F.G = gridDim.x; F.blk = blockIdx.x; F.gw = F.blk * NWAVES + F.wave; F.NGW = F.G * NWAVES;
    F.ws = args.ws;
    F.A = &args;
    for (int u = F.tid; u < 128; u += NWAVES * 64) F.MISC[u] = 0u;
    __syncthreads();
    { XcdBarrier b0 = xcd_barrier_post((unsigned*)F.ws + CW_BAR, F.MISC + 8); (void)b0; }
#define GRID_BAR() do { XcdBarrier b_; b_.bar = (unsigned*)F.ws + CW_BAR; b_.x = xb_xcc_id(); b_.st = F.MISC + 8; refresh(F); xcd_barrier(b_, F.tid == 0); } while (0)

    p0_mod(F); p0_misc(F); convert_weights(F, 0);
    GRID_BAR();
    for (int l = 0; l < DEPTH; ++l) {
        const bool moe = l & 1; const int li = l >> 1;
        { unsigned char* wsp = args.ws; asm volatile("" : "+s"(wsp)); F.ws = wsp; }
        p1_rows(F, l);
        if (l > 0) convert_weights(F, l);
        GRID_BAR();
        {
            refresh(F);
            pg8::Gemm g{(const pg8::bf16_t*)(F.ws + WS_H), (const pg8::bf16_t*)(F.ws + WS_WIN), M, NP, DM};
            pg8::StaticOrder S; S.init(M, NP, F.G, F.blk);
            pg8::EpiProj E{(pg8::bf16_t*)(F.ws + WS_PROJ), (const float*)(F.ws + WS_ROPE), (const float*)(F.ws + WS_ROPE) + 1024, (unsigned*)F.ws + CW_KMX + 256 * l};
            pg8::gemm_phase<pg8::EpiProj, pg8::StaticOrder, true, true>(F.lds, g, S, E, F.wave);
        }
        GRID_BAR();
        p3_mixer(F, l);
        GRID_BAR();
        p5_merge_all(F, l);
        GRID_BAR();
        {
            refresh(F);
            pg8::Gemm g{(const pg8::bf16_t*)(F.ws + WS_H), (const pg8::bf16_t*)(F.ws + WS_WOUT), M, DM, DM};
            const int lastl = (l == DEPTH - 1);
            pg8::LatOrder S; S.S.init(lastl ? NBATCH * SEQ : M, DM, F.G, F.blk); S.lat = lastl;
            pg8::EpiF32 E{(pg8::bf16_t*)(F.ws + WS_Y)};
            pg8::gemm_phase<pg8::EpiF32, pg8::LatOrder, true, true>(F.lds, g, S, E, F.wave);
        }
        GRID_BAR();
        p7_rows(F, l);
        GRID_BAR();
        if (moe) { p7b_gather(F, l); GRID_BAR(); }
        int ntiles = M / 256;
        {
            refresh(F);
            LAS int* texp = (LAS int*)(F.lds + TEXP_OFF);
            if (moe) { int cnt[8], off[9]; moe_offsets(F, li, cnt, off); ntiles = off[8] >> 8;
                for (int t = F.tid; t < ntiles; t += 512) { int e = 0;
#pragma unroll
                    for (int q = 1; q < 8; ++q) e += ((t << 8) >= off[q]) ? 1 : 0;
                    texp[t] = e; } }
            else { for (int t = F.tid; t < ntiles; t += 512) texp[t] = 0; }
            __syncthreads();
        }
        {
            refresh(F);
            pg8::Gemm g{(const pg8::bf16_t*)(F.ws + (moe ? WS_HG : WS_H2)), (const pg8::bf16_t*)(F.ws + WS_WUP), ntiles * 256, 2 * DFF, FFN_F8 ? DM / 2 : DM};
            pg8::GroupedOrder S; S.S.init(ntiles * 256, 2 * DFF, F.G, F.blk); S.texp = (const LAS int*)(F.lds + TEXP_OFF); S.nN = 22;
            pg8::EpiSwiglu E{(pg8::bf16_t*)(F.ws + WS_U)};
            pg8::gemm_phase<pg8::EpiSwiglu, pg8::GroupedOrder, true, true, FFN_F8 != 0>(F.lds, g, S, E, F.wave);
        }
        GRID_BAR();
        {
            refresh(F);
            pg8::Gemm g{(const pg8::bf16_t*)(F.ws + WS_U), (const pg8::bf16_t*)(F.ws + WS_WDN), ntiles * 256, DM, FFN_F8 ? DFF / 2 : DFF};
            pg8::GroupedOrder S; S.S.init(ntiles * 256, DM, F.G, F.blk); S.texp = (const LAS int*)(F.lds + TEXP_OFF); S.nN = 4;
            pg8::EpiDown E{(pg8::bf16_t*)(F.ws + WS_F2), (const int*)(F.ws + WS_RMAP), (const float*)(F.ws + WS_ROWW), moe ? 0 : 1};
            pg8::gemm_phase<pg8::EpiDown, pg8::GroupedOrder, true, true, FFN_F8 != 0>(F.lds, g, S, E, F.wave);
        }
        GRID_BAR();
    }
    pf_final(F);
}

extern "C" void kernel_launch(void* const* d_in, const int* in_sizes, int n_in, void* d_out, int out_size, void* d_ws, size_t ws_size, hipStream_t stream) {
    static int grid = 0;
    if (grid == 0) {
        if (n_in != 24 || out_size != NBATCH * SEQ * DM || ws_size < WS_END) { fprintf(stderr, "kernel_launch: unexpected shapes or workspace (%d inputs, out %d, ws %zu < %zu)\n", n_in, out_size, ws_size, (size_t)WS_END); grid = -1; return; }
        int dev = 0, cus = 0, per_cu = 0;
        if (hipGetDevice(&dev) != hipSuccess || hipDeviceGetAttribute(&cus, hipDeviceAttributeMultiprocessorCount, dev) != hipSuccess) { grid = -1; return; }
        if (hipFuncSetAttribute((const void*)mk_fwd, hipFuncAttributeMaxDynamicSharedMemorySize, LDS_BYTES) != hipSuccess) { grid = -1; return; }
        if (hipOccupancyMaxActiveBlocksPerMultiprocessor(&per_cu, (const void*)mk_fwd, NWAVES * 64, LDS_BYTES) != hipSuccess || per_cu < 1) { fprintf(stderr, "kernel_launch: occupancy query says %d\n", per_cu); }
        (void)hipGetLastError();
        grid = cus;
    }
    if (grid < 0) return;
    if (hipMemsetAsync((char*)d_ws + WS_CTL, 0, CTL_ZERO_BYTES, stream) != hipSuccess) return;
    Args a{};
    for (int i = 0; i < 24; ++i) a.in[i] = (const float*)d_in[i];
    a.out = (float*)d_out; a.ws = (unsigned char*)d_ws;
    hipLaunchKernelGGL(mk_fwd, dim3(grid), dim3(NWAVES * 64), LDS_BYTES, stream, a);
}
```

```cpp
#include <hip/hip_runtime.h>
#include <cstdio>
#include <cstdint>
namespace pg8 {
#define PG8_LAS __attribute__((address_space(3)))
typedef unsigned short bf16_t;
__device__ __forceinline__ int lane_id_opaque() { int l; asm volatile("v_mbcnt_lo_u32_b32 %0, -1, 0\n\tv_mbcnt_hi_u32_b32 %0, -1, %0" : "=v"(l)); return l; }
typedef short bf16x8 __attribute__((ext_vector_type(8)));
typedef float f32x4 __attribute__((ext_vector_type(4)));
typedef unsigned u32x4 __attribute__((ext_vector_type(4)));
constexpr int BM = 256, BK = 64, HALF = 128, HTB = HALF * BK * 2  , STAGE_BYTES = 8 * HTB, NXCD = 8, WGM = 8;

__host__ __device__ __forceinline__ int lds_byte(int r, int c) { const int st = (r >> 4) * 2 + (c >> 5), rr = r & 15, cc = c & 31, ob = rr * 64 + cc * 2; return st * 1024 + (ob ^ (((ob >> 9) & 1) << 5)); }
__host__ __device__ __forceinline__ void stage_rc(int b, int& R, int& C) { const int st = b / 1024, sb = b % 1024, swz = sb ^ (((sb >> 9) & 1) << 5); R = (st >> 1) * 16 + swz / 64; C = (st & 1) * 32 + (swz % 64) / 2; }
__host__ __device__ __forceinline__ int perm32(int rho) { const int n = rho >> 4, i = rho & 15; return 8 * (i >> 2) + 4 * n + (i & 3); }

struct Unit { int pm, pn; };
struct Gemm { const bf16_t* A; const bf16_t* Bt; int M, N, K; };

struct StaticOrder {
    int nM, nN, nwg, G, c;
    __host__ __device__ void init(int M, int N, int G_, int c_) { nM = M / BM; nN = N / BM; nwg = nM * nN; G = G_; c = c_; }
    __host__ __device__ bool next(int i, Unit& u) const {
        const long L = (long)i * G + c; if (L >= nwg) return false;
        int wgid = (int)L; { const int q = nwg / NXCD, r = nwg % NXCD, xcd = wgid % NXCD, off = wgid / NXCD; wgid = (xcd < r ? xcd * (q + 1) : r * (q + 1) + (xcd - r) * q) + off; }
        const int nig = WGM * nN, gid = wgid / nig, fm = gid * WGM, gsz = (nM - fm) < WGM ? (nM - fm) : WGM;
        u.pm = fm + ((wgid % nig) % gsz); u.pn = (wgid % nig) / gsz; return true;
    }
    __device__ __forceinline__ void a_ready(const Unit&) const {}
    __device__ __forceinline__ void done(const Unit&) const {}
};

__device__ __forceinline__ unsigned cvt_pk_bf16(float lo, float hi) { unsigned r; asm volatile("v_cvt_pk_bf16_f32 %0, %1, %2" : "=v"(r) : "v"(lo), "v"(hi)); return r; }
typedef float f32x2 __attribute__((ext_vector_type(2)));
template <class Epi, class Sched, bool ALIGN_EPI = false, bool SP2 = false, bool F8 = false>
__device__ __forceinline__ void gemm_phase(PG8_LAS unsigned char* lds, const Gemm g, const Sched& S, const Epi& E, const int wv  ) {
    int tid_ = wv * 64 + lane_id_opaque();
    const int tid = tid_, wid = __builtin_amdgcn_readfirstlane(tid >> 6), lane = tid & 63, wr = wid >> 2, wc = wid & 3, fr = lane & 15, fq = lane >> 4;
    const int K = g.K, nt = K / BK;
    unsigned voffA[2], voffB[2];
#pragma unroll
    for (int i = 0; i < 2; ++i) { int R, C; stage_rc(tid * 16 + i * 8192, R, C); const int Rb = Epi::PERM ? ((R & ~31) + perm32(R & 31)) : R;
        voffA[i] = (unsigned)(R * K + C) * 2u; voffB[i] = (unsigned)(Rb * K + C) * 2u; }
    const size_t kstep = (size_t)(BK * 2);
    const size_t hstep = (size_t)HALF * K * 2;
    const size_t tstep = 2 * hstep;
    const unsigned ldsw = (unsigned)wid * 1024u;
    const int aoff = lds_byte(wr * 64 + fr, fq * 8), boff = lds_byte(wc * 32 + fr, fq * 8);
#define PG8_SA(b, h) (((b) * 2 + (h)) * HTB)
#define PG8_SB(b, h) ((4 + (b) * 2 + (h)) * HTB)
#define PG8_STAGE(bufoff, gbase, voff) do { _Pragma("unroll") for (int _i = 0; _i < 2; ++_i) \
        __builtin_amdgcn_global_load_lds((const __attribute__((address_space(1))) unsigned*)((const __attribute__((address_space(1))) char*)(gbase) + (voff)[_i]), (PG8_LAS unsigned*)(lds + (bufoff) + ldsw + _i * 8192), 16, 0, 0); } while (0)
#define PG8_LDA(dst, b, h) do { _Pragma("unroll") for (int m = 0; m < 4; ++m) _Pragma("unroll") for (int k = 0; k < 2; ++k) dst[m][k] = *(const PG8_LAS bf16x8*)(lds + PG8_SA(b, h) + aoff + m * 2048 + k * 1024); } while (0)
#define PG8_LDB(dst, b, h) do { _Pragma("unroll") for (int n = 0; n < 2; ++n) _Pragma("unroll") for (int k = 0; k < 2; ++k) dst[n][k] = *(const PG8_LAS bf16x8*)(lds + PG8_SB(b, h) + boff + n * 2048 + k * 1024); } while (0)
#define PG8_MMA(ai, bj, At, Bt) do { if constexpr (F8) __builtin_amdgcn_sched_barrier(0); __builtin_amdgcn_s_setprio(1); _Pragma("unroll") for (int m = 0; m < 4; ++m) _Pragma("unroll") for (int n = 0; n < 2; ++n) { \
        if constexpr (F8) { typedef int i32x4_ __attribute__((ext_vector_type(4))); \
            acc[ai][bj][m][n] = __builtin_amdgcn_mfma_scale_f32_16x16x128_f8f6f4(__builtin_shufflevector(__builtin_bit_cast(i32x4_, Bt[n][0]), __builtin_bit_cast(i32x4_, Bt[n][1]), 0, 1, 2, 3, 4, 5, 6, 7), \
                __builtin_shufflevector(__builtin_bit_cast(i32x4_, At[m][0]), __builtin_bit_cast(i32x4_, At[m][1]), 0, 1, 2, 3, 4, 5, 6, 7), acc[ai][bj][m][n], 0, 0, 0, 0x7f7f7f7f, 0, 0x7f7f7f7f); } \
        else { _Pragma("unroll") for (int k = 0; k < 2; ++k) acc[ai][bj][m][n] = __builtin_amdgcn_mfma_f32_16x16x32_bf16(Bt[n][k], At[m][k], acc[ai][bj][m][n], 0, 0, 0); } } \
        __builtin_amdgcn_s_setprio(0); if constexpr (F8) __builtin_amdgcn_sched_barrier(0); } while (0)
#define PG8_WAIT_V(n) asm volatile("s_waitcnt vmcnt(" #n ")" ::: "memory")
#define PG8_WAIT_L(n) asm volatile("s_waitcnt lgkmcnt(" #n ")" ::: "memory")
#define PG8_BAR __builtin_amdgcn_s_barrier()
#define PG8_SCHED __builtin_amdgcn_sched_barrier(0)
    Unit cur, nxt; int ui = 0;
    if (!S.next(0, cur)) return;
    f32x4 acc[2][2][4][2];
#pragma unroll
    for (int a = 0; a < 2; ++a)
#pragma unroll
        for (int b = 0; b < 2; ++b)
#pragma unroll
            for (int m = 0; m < 4; ++m)
#pragma unroll
                for (int n = 0; n < 2; ++n) acc[a][b][m][n] = (f32x4){0.f, 0.f, 0.f, 0.f};
    bf16x8 At[4][2], B0[2][2], B1[2][2];
    const char* cA = (const char*)g.A + (size_t)cur.pm * tstep; const char* cB = (const char*)g.Bt + (size_t)cur.pn * tstep;
    S.a_ready(cur);
    if constexpr (SP2) {
        PG8_STAGE(PG8_SB(0, 0), cB, voffB); PG8_STAGE(PG8_SB(0, 1), cB + hstep, voffB); PG8_STAGE(PG8_SA(0, 0), cA, voffA); PG8_STAGE(PG8_SA(0, 1), cA + hstep, voffA);
        if (wr == 1) PG8_BAR;
        PG8_WAIT_V(2); PG8_BAR;
        PG8_STAGE(PG8_SB(1, 0), cB + kstep, voffB); PG8_STAGE(PG8_SA(1, 0), cA + kstep, voffA); PG8_STAGE(PG8_SB(1, 1), cB + hstep + kstep, voffB);
        PG8_WAIT_V(6); PG8_BAR;
    } else {
        PG8_STAGE(PG8_SB(0, 0), cB, voffB); PG8_STAGE(PG8_SA(0, 0), cA, voffA); PG8_STAGE(PG8_SB(0, 1), cB + hstep, voffB); PG8_STAGE(PG8_SA(0, 1), cA + hstep, voffA);
        if (wr == 1) PG8_BAR;
        PG8_WAIT_V(4); PG8_BAR;
        PG8_STAGE(PG8_SB(1, 0), cB + kstep, voffB); PG8_STAGE(PG8_SA(1, 0), cA + kstep, voffA); PG8_STAGE(PG8_SB(1, 1), cB + hstep + kstep, voffB);
        PG8_WAIT_V(6); PG8_BAR;
    }
    for (;;) {
        const bool has_next = S.next(ui + 1, nxt);
        const char* nA = has_next ? (const char*)g.A + (size_t)nxt.pm * tstep : cA; const char* nB = has_next ? (const char*)g.Bt + (size_t)nxt.pn * tstep : cB;
        for (int t = 0; t < nt; t += 2) {
            const bool last = (t == nt - 2);
            const char* a1 = cA + (size_t)(t + 1) * kstep;
            const char* a2 = last ? nA : cA + (size_t)(t + 2) * kstep; const char* b2 = last ? nB : cB + (size_t)(t + 2) * kstep;
            const char* a3 = a2 + kstep; const char* b3 = b2 + kstep;
            if (last && has_next) S.a_ready(nxt);
            if constexpr (SP2) {
            PG8_LDB(B0, 0, 0); PG8_LDB(B1, 0, 1); PG8_SCHED; PG8_LDA(At, 0, 0); PG8_STAGE(PG8_SA(1, 1), a1 + hstep, voffA);
            PG8_WAIT_V(8); PG8_WAIT_L(0); PG8_BAR; PG8_MMA(0, 0, At, B0); PG8_MMA(0, 1, At, B1); PG8_BAR; PG8_SCHED;
            PG8_LDA(At, 0, 1); PG8_STAGE(PG8_SB(0, 0), b2, voffB); PG8_STAGE(PG8_SB(0, 1), b2 + hstep, voffB); PG8_STAGE(PG8_SA(0, 0), a2, voffA);
            PG8_WAIT_V(8); PG8_WAIT_L(0); PG8_BAR; PG8_MMA(1, 0, At, B0); PG8_MMA(1, 1, At, B1); PG8_BAR; PG8_SCHED;
            PG8_LDB(B0, 1, 0); PG8_LDB(B1, 1, 1); PG8_SCHED; PG8_LDA(At, 1, 0); PG8_STAGE(PG8_SA(0, 1), a2 + hstep, voffA);
            PG8_WAIT_V(8); PG8_WAIT_L(0); PG8_BAR; PG8_MMA(0, 0, At, B0); PG8_MMA(0, 1, At, B1); PG8_BAR; PG8_SCHED;
            PG8_LDA(At, 1, 1); PG8_STAGE(PG8_SB(1, 0), b3, voffB); PG8_STAGE(PG8_SB(1, 1), b3 + hstep, voffB); PG8_STAGE(PG8_SA(1, 0), a3, voffA);
            PG8_WAIT_V(8); PG8_WAIT_L(0); PG8_BAR; PG8_MMA(1, 0, At, B0); PG8_MMA(1, 1, At, B1); PG8_BAR; PG8_SCHED;
            } else {
            PG8_LDB(B0, 0, 0); PG8_SCHED; PG8_LDA(At, 0, 0); PG8_STAGE(PG8_SA(1, 1), a1 + hstep, voffA);
            PG8_WAIT_L(8); PG8_BAR; PG8_WAIT_L(0); PG8_MMA(0, 0, At, B0); PG8_BAR; PG8_SCHED;
            PG8_LDB(B1, 0, 1); PG8_STAGE(PG8_SB(0, 0), b2, voffB);
            PG8_BAR; PG8_WAIT_L(0); PG8_MMA(0, 1, At, B1); PG8_BAR;
            PG8_LDA(At, 0, 1); PG8_STAGE(PG8_SA(0, 0), a2, voffA);
            PG8_BAR; PG8_WAIT_L(0); PG8_MMA(1, 0, At, B0); PG8_BAR; PG8_SCHED;
            PG8_STAGE(PG8_SB(0, 1), b2 + hstep, voffB);
            PG8_WAIT_V(6); PG8_BAR; PG8_MMA(1, 1, At, B1); PG8_BAR;
            PG8_LDB(B0, 1, 0); PG8_SCHED; PG8_LDA(At, 1, 0); PG8_STAGE(PG8_SA(0, 1), a2 + hstep, voffA);
            PG8_WAIT_L(8); PG8_BAR; PG8_WAIT_L(0); PG8_MMA(0, 0, At, B0); PG8_BAR; PG8_SCHED;
            PG8_LDB(B1, 1, 1); PG8_STAGE(PG8_SB(1, 0), b3, voffB);
            PG8_BAR; PG8_WAIT_L(0); PG8_MMA(0, 1, At, B1); PG8_BAR;
            PG8_LDA(At, 1, 1); PG8_STAGE(PG8_SA(1, 0), a3, voffA);
            PG8_BAR; PG8_WAIT_L(0); PG8_MMA(1, 0, At, B0); PG8_BAR; PG8_SCHED;
            PG8_STAGE(PG8_SB(1, 1), b3 + hstep, voffB);
            PG8_WAIT_V(6); PG8_BAR; PG8_MMA(1, 1, At, B1); PG8_BAR;
            }
        }
        if constexpr (ALIGN_EPI) { if (wr == 0) PG8_BAR; }
        if constexpr (!Epi::AFTER_DRAIN) { const int t2_ = lane_id_opaque(); const int fr_ = t2_ & 15, fq_ = (t2_ & 63) >> 4;
            E(acc, cur, wr, wc, fr_, fq_); S.done(cur); }
        if (!has_next) break;
#pragma unroll
        for (int a = 0; a < 2; ++a)
#pragma unroll
            for (int b = 0; b < 2; ++b)
#pragma unroll
                for (int m = 0; m < 4; ++m)
#pragma unroll
                    for (int n = 0; n < 2; ++n) acc[a][b][m][n] = (f32x4){0.f, 0.f, 0.f, 0.f};
        cur = nxt; cA = nA; cB = nB; ++ui;
        if constexpr (ALIGN_EPI) { if (wr == 1) PG8_BAR; }
    }
    PG8_WAIT_V(0);
    if constexpr (!ALIGN_EPI) { if (wr == 0) PG8_BAR; }
    PG8_BAR;
    if constexpr (Epi::AFTER_DRAIN) { E.fused(acc, cur, wr, wc, fr, fq, lds, wid, lane); S.done(cur); }
#undef PG8_SA
#undef PG8_SB
#undef PG8_STAGE
#undef PG8_LDA
#undef PG8_LDB
#undef PG8_MMA
#undef PG8_WAIT_V
#undef PG8_WAIT_L
#undef PG8_BAR
#undef PG8_SCHED
}
}
#define GAS __attribute__((address_space(1)))
#define LAS __attribute__((address_space(3)))
typedef unsigned short bf16;
typedef unsigned v4u __attribute__((ext_vector_type(4)));
typedef float f32x4 __attribute__((ext_vector_type(4)));
typedef short bf16x8 __attribute__((ext_vector_type(8)));
typedef GAS unsigned gu32;
typedef GAS unsigned long long gu64;
#define RLX_AGENT __ATOMIC_RELAXED, __HIP_MEMORY_SCOPE_AGENT
#define LDS_WAIT() asm volatile("s_waitcnt lgkmcnt(0)" ::: "memory")
#define VM_WAIT() asm volatile("s_waitcnt vmcnt(0)" ::: "memory")
__device__ __forceinline__ unsigned long long rt() { return __builtin_amdgcn_s_memrealtime(); }
__device__ __forceinline__ unsigned f2bf(float f) { unsigned u = __builtin_bit_cast(unsigned, f); return (u + 0x7fffu + ((u >> 16) & 1u)) >> 16; }
__device__ __forceinline__ unsigned pk2(float lo, float hi) { return f2bf(lo) | (f2bf(hi) << 16); }

#define XB_TMO      128
#define XB_XCNT(j)  (256  + 64 * (j))
#define XB_XSUB(j)  (1280 + 64 * (j))
#define XB_XGEN(j)  (2304 + 64 * (j))
#define XB_TOP      3328
#define XB_TOPGEN   3392
#define XCD_BAR_WORDS 3456
#define XB_SPIN_CAP (1u << 18)

__device__ __forceinline__ unsigned xb_ld(unsigned* p)              { return __hip_atomic_load(p, __ATOMIC_RELAXED, __HIP_MEMORY_SCOPE_AGENT); }
__device__ __forceinline__ unsigned xb_add(unsigned* p, unsigned v) { return __hip_atomic_fetch_add(p, v, __ATOMIC_RELAXED, __HIP_MEMORY_SCOPE_AGENT); }
__device__ __forceinline__ unsigned xb_xcc_id() { return (unsigned)__builtin_amdgcn_s_getreg((3 << 11) | 20) & 0xFu; }
#define XB_SPIN(cond, bar) do { unsigned _sp = 0; while (cond) { __builtin_amdgcn_s_sleep(1); \
    if ((++_sp & 255u) == 0u) { if (xb_ld(&(bar)[XB_TMO])) break; if (_sp > XB_SPIN_CAP) { atomicAdd(&(bar)[XB_TMO], 1u); break; } } } } while (0)

struct XcdBarrier {
    unsigned* bar; unsigned x;
    volatile LAS unsigned* st;
};

__device__ __forceinline__ XcdBarrier xcd_barrier_post(unsigned* bar, volatile LAS unsigned* st) {
    XcdBarrier b; b.bar = bar; b.x = xb_xcc_id(); b.st = st;
    if (threadIdx.x == 0) (void)xb_add(&bar[XB_XCNT(b.x)], 1u);
    return b;
}
__device__ __forceinline__ void xcd_barrier_complete(unsigned* bar, unsigned x, unsigned& nloc, unsigned& nx) {
    const unsigned G = gridDim.x * gridDim.y * gridDim.z;
    unsigned sum, cnt, mine, sp = 0u;
    for (;;) {
        sum = 0u; cnt = 0u; mine = 0u;
#pragma unroll
        for (unsigned j = 0; j < 16; ++j) { const unsigned c = xb_ld(&bar[XB_XCNT(j)]); sum += c; cnt += (c > 0u) ? 1u : 0u; mine = (j == x) ? c : mine; }
        if (sum == G) break;
        __builtin_amdgcn_s_sleep(1);
        if ((++sp & 255u) == 0u) { if (xb_ld(&bar[XB_TMO])) break; if (sp > XB_SPIN_CAP) { atomicAdd(&bar[XB_TMO], 1u); break; } }
    }
    nloc = mine > 0u ? mine : 1u; nx = cnt > 0u ? cnt : 1u;
}

__device__ __forceinline__ void xcd_barrier(const XcdBarrier& b, const bool leader  ) {
    asm volatile("s_waitcnt vmcnt(0)" ::: "memory");
    __syncthreads();
    if (leader) {
        unsigned* bar = b.bar; asm volatile("" : "+s"(bar));
        __builtin_amdgcn_s_waitcnt(0);
        unsigned nloc = b.st[0], nx = b.st[1];
        if (nloc == 0u) { xcd_barrier_complete(bar, b.x, nloc, nx); b.st[0] = nloc; b.st[1] = nx; }
        const unsigned old = xb_add(&bar[XB_XSUB(b.x)], 1u);
        const unsigned gen = old / nloc;
        if (old + 1u == (gen + 1u) * nloc) {
            __builtin_amdgcn_fence(__ATOMIC_RELEASE, "agent");
            asm volatile("s_waitcnt vmcnt(0)" ::: "memory");
            const unsigned og = xb_add(&bar[XB_TOP], 1u);
            const unsigned tg = og / nx;
            if (og + 1u == (tg + 1u) * nx) xb_add(&bar[XB_TOPGEN], 1u);
            else XB_SPIN(xb_ld(&bar[XB_TOPGEN]) == tg, bar);
            __builtin_amdgcn_fence(__ATOMIC_ACQUIRE, "agent");
            xb_add(&bar[XB_XGEN(b.x)], 1u);
            asm volatile("s_waitcnt vmcnt(0)" ::: "memory");
        } else {
            XB_SPIN(xb_ld(&bar[XB_XGEN(b.x)]) == gen, bar);
            __builtin_amdgcn_fence(__ATOMIC_ACQUIRE, "agent");
            asm volatile("s_waitcnt vmcnt(0)" ::: "memory");
        }
    }
    __syncthreads();
}

#ifndef FFN_F8
#define FFN_F8 1
#endif
constexpr int NWAVES = 8;
constexpr float W8S = 32.f, U8S = 4.f;
constexpr int DM = 1024, NBATCH = 16, SEQ = 2048, CTX = 256, TPB = SEQ + CTX, M = NBATCH * TPB;
constexpr int DEPTH = 4, NIN = 3104, NP = 3328, DFF = 2816, NE = 8;
constexpr int MP = 2 * M + NE * 256;
constexpr int C_Q = 0, C_K = 512, C_V = 1024, C_GQ = 1536, C_GK = 1792, C_GV = 2048, C_GG = 2560, C_GLR = 3072;
constexpr float EPS = 1e-6f;
constexpr float C2 = 0.125f * 1.4426950408889634f;
constexpr int NCH = TPB / 64;
constexpr int NGLA = NBATCH * 4 * 2 * NCH;

constexpr size_t MiB = 1u << 20;
constexpr size_t WS_CTL = 0, CTL_ZERO_BYTES = 1 * MiB;
constexpr size_t WS_MOD = 1 * MiB;
constexpr size_t WS_ROPE = 3 * MiB;
constexpr size_t WS_TOPE = 4 * MiB;
constexpr size_t WS_LIDX = WS_TOPE + 160 * 1024;
constexpr size_t WS_TOPW = WS_LIDX + 320 * 1024;
constexpr size_t WS_BLKB = WS_TOPW + 320 * 1024;
constexpr size_t WS_RMAP = WS_BLKB + 64 * 1024;
constexpr size_t WS_ROWW = WS_RMAP + 320 * 1024;
static_assert(WS_ROWW + 320 * 1024 <= 6 * MiB, "small tables");
constexpr size_t WS_X = 6 * MiB;
constexpr size_t WS_WIN = 150 * MiB;
constexpr size_t WS_WOUT = WS_WIN + 13 * MiB / 2;
constexpr size_t WS_WUP = WS_WOUT + 2 * MiB;
constexpr size_t WS_WDN = WS_WUP + 88 * MiB;
constexpr size_t WS_D = 291 * MiB;
static_assert(WS_WDN + 44 * MiB <= WS_D, "weights");
constexpr size_t WS_PROJ = WS_D;
constexpr size_t WS_OD = WS_D + 234 * MiB;
constexpr size_t WS_DS = WS_D + 306 * MiB;
constexpr size_t WS_DEC = WS_D + 450 * MiB;
constexpr size_t WS_H = WS_D + 452 * MiB;
constexpr size_t WS_Y = WS_D;
constexpr size_t WS_HG = WS_D;
constexpr size_t WS_F2 = WS_D;
constexpr size_t WS_U = WS_D + 148 * MiB;
constexpr size_t WS_H2 = WS_D + 483 * MiB;
constexpr size_t WS_END = WS_D + 555 * MiB;
static_assert((size_t)MP * DFF * 2 <= 407 * MiB && (size_t)MP * DM * 2 <= 148 * MiB && (size_t)M * NP * 2 <= 234 * MiB, "dynamic map");
static_assert((size_t)M * DFF * 2 + 148 * MiB <= 483 * MiB, "dense U clear of H2");

constexpr int CW_BAR = 4096;
constexpr int CW_CNT = 8192;

constexpr int RING_BYTES = 131072;
constexpr int TEXP_OFF = 139264;
constexpr int MISC_OFF = 146432 - 512;
constexpr int LDS_BYTES = 147456;

typedef unsigned u32x2 __attribute__((ext_vector_type(2)));

__device__ __forceinline__ float bf2f(unsigned short x) { return __uint_as_float((unsigned)x << 16); }
__device__ __forceinline__ float bflo(unsigned w) { return __uint_as_float(w << 16); }
__device__ __forceinline__ float bfhi(unsigned w) { return __uint_as_float(w & 0xffff0000u); }
__device__ __forceinline__ float siluf(float x) { return x * __builtin_amdgcn_rcpf(1.f + __expf(-x)); }
__device__ __forceinline__ float clamp8(float x) { return fminf(fmaxf(x, -448.f), 448.f); }
__device__ __forceinline__ unsigned pk4_f8(float a, float b, float c, float d) { unsigned w = 0u; w = __builtin_amdgcn_cvt_pk_fp8_f32(clamp8(a), clamp8(b), w, false); w = __builtin_amdgcn_cvt_pk_fp8_f32(clamp8(c), clamp8(d), w, true); return w; }
template <int MASK> __device__ __forceinline__ float xadd(float v) {
    if constexpr (MASK == 32) { const auto rr = __builtin_amdgcn_permlane32_swap(__float_as_uint(v), __float_as_uint(v), false, false); return __uint_as_float(rr[0]) + __uint_as_float(rr[1]); }
    else return v + __int_as_float(__builtin_amdgcn_ds_swizzle(__float_as_int(v), 0x1f | (MASK << 10)));
}
__device__ __forceinline__ float wave_sum(float v) {
    v = xadd<1>(v); v = xadd<2>(v); v = xadd<4>(v); v = xadd<8>(v); v = xadd<16>(v); v = xadd<32>(v);
    return v;
}

struct Args { const float* in[24]; float* out; unsigned char* ws; };
struct Frame {
    LAS unsigned char* lds;
    volatile LAS unsigned* MISC;
    int tid, lane, wave, G, blk, gw, NGW, z, wv;
    const Args* A;
    unsigned char* ws;
};


__device__ __forceinline__ void refresh(Frame& F) {
    int wv = F.wv; asm volatile("" : "+s"(wv));
    const int t = wv * 64 + pg8::lane_id_opaque();
    int bl = blockIdx.x, z = 0, gg = gridDim.x; asm volatile("" : "+s"(bl), "+s"(z), "+s"(gg));
    F.blk = bl; F.z = z; F.G = gg; F.NGW = gg * NWAVES;
    F.tid = t; F.lane = t & 63; F.wave = wv; F.gw = F.blk * NWAVES + F.wave;
}
#define INP(k) (F.A->in[(k) + F.z])
namespace pg8 {
struct EpiProj {
    static constexpr bool PERM = true, AFTER_DRAIN = false;
    bf16_t* P; const float* ropec; const float* ropes; unsigned* kmx;
    __device__ __forceinline__ void operator()(const f32x4 (&acc)[2][2][4][2], const Unit& u, int wr, int wc, int fr, int fq) const {
        const int pn = u.pn, pm = u.pm, tb = pm % 9;
        float kss[2] = {0.f, 0.f};
        const bool do_rope = (tb != 0) && (pn < 4);
        const float sc = (pn < 2) ? C2 : (pn == 6 ? 0.125f : 1.f);
        const bool st_ok_all = pn < 12;
#pragma unroll
        for (int ai = 0; ai < 2; ++ai)
#pragma unroll
            for (int m = 0; m < 4; ++m) {
                const int rit = ai * HALF + wr * 64 + m * 16 + fr;
                bf16_t* rowp = P + ((size_t)pm * BM + rit) * NP + pn * BM + wc * 32 + 8 * fq;
                const int s = (tb - 1) * 256 + rit;
                const int pos = (wc & 1) ? (s & 63) : (s >> 6);
                f32x4 cs = {1.f, 1.f, 1.f, 1.f}, sn = {0.f, 0.f, 0.f, 0.f};
                if (do_rope) { cs = *(const f32x4*)(ropec + pos * 16 + 4 * fq); sn = *(const f32x4*)(ropes + pos * 16 + 4 * fq); }
#pragma unroll
                for (int bj = 0; bj < 2; ++bj) {
                    f32x4 v0 = acc[ai][bj][m][0], v1 = acc[ai][bj][m][1];
                    if (do_rope) { const f32x4 a = v0 * cs - v1 * sn, b = v0 * sn + v1 * cs; v0 = a; v1 = b; }
                    v0 = v0 * sc; v1 = v1 * sc;
                    if (pn == 2 || pn == 3) { float ss = (v0[0] * v0[0] + v0[1] * v0[1]) + (v0[2] * v0[2] + v0[3] * v0[3]) + (v1[0] * v1[0] + v1[1] * v1[1]) + (v1[2] * v1[2] + v1[3] * v1[3]);
                        ss = xadd<16>(ss); ss = xadd<32>(ss); kss[bj] = fmaxf(kss[bj], ss); }
                    if (st_ok_all || (bj == 0 && wc == 0)) {
                        u32x4 w; w.x = cvt_pk_bf16(v0[0], v0[1]); w.y = cvt_pk_bf16(v0[2], v0[3]); w.z = cvt_pk_bf16(v1[0], v1[1]); w.w = cvt_pk_bf16(v1[2], v1[3]);
                        *(u32x4*)(rowp + bj * HALF) = w;
                    }
                }
            }
        if (pn == 2 || pn == 3) {
#pragma unroll
            for (int bj = 0; bj < 2; ++bj) { float v = kss[bj];
                v = fmaxf(v, __int_as_float(__builtin_amdgcn_update_dpp(0, __float_as_int(v), 0xB1, 0xF, 0xF, true)));
                v = fmaxf(v, __int_as_float(__builtin_amdgcn_update_dpp(0, __float_as_int(v), 0x4E, 0xF, 0xF, true)));
                v = fmaxf(v, __int_as_float(__builtin_amdgcn_update_dpp(0, __float_as_int(v), 0x141, 0xF, 0xF, true)));
                v = fmaxf(v, __int_as_float(__builtin_amdgcn_update_dpp(0, __float_as_int(v), 0x140, 0xF, 0xF, true)));
                if (fr == 0 && fq == 0) { const int hh = (pn - 2) * 4 + bj * 2 + (wc >> 1);
                    __hip_atomic_fetch_max(kmx + (((pm / 9) * 8 + hh) * 2 + (wc & 1)), __float_as_uint(v), __ATOMIC_RELAXED, __HIP_MEMORY_SCOPE_AGENT); } }
        }
    }
};
struct EpiF32 {
    static constexpr bool PERM = true, AFTER_DRAIN = false;
    bf16_t* Y;
    __device__ __forceinline__ void operator()(const f32x4 (&acc)[2][2][4][2], const Unit& u, int wr, int wc, int fr, int fq) const {
#pragma unroll
        for (int ai = 0; ai < 2; ++ai)
#pragma unroll
            for (int m = 0; m < 4; ++m) {
                bf16_t* rowp = Y + ((size_t)(u.pm * 16 + ai * 8 + wr * 4 + m) * (DM / 32) + (u.pn * 8 + wc)) * 512 + fr * 32 + 8 * fq;
#pragma unroll
                for (int bj = 0; bj < 2; ++bj) { const f32x4 v0 = acc[ai][bj][m][0], v1 = acc[ai][bj][m][1];
                    u32x4 w; w.x = cvt_pk_bf16(v0[0], v0[1]); w.y = cvt_pk_bf16(v0[2], v0[3]); w.z = cvt_pk_bf16(v1[0], v1[1]); w.w = cvt_pk_bf16(v1[2], v1[3]);
                    *(u32x4*)(rowp + bj * (4 * 512)) = w; }
            }
    }
};
struct EpiSwiglu {
    static constexpr bool PERM = true, AFTER_DRAIN = false;
    bf16_t* U;
    __device__ __forceinline__ void operator()(const f32x4 (&acc)[2][2][4][2], const Unit& u, int wr, int wc, int fr, int fq) const {
        const int pnl = u.pn % 22;
        const int col0 = pnl * 128 + wc * 32 + 8 * fq;
        constexpr float ws = FFN_F8 ? 1.f / W8S : 1.f, us = FFN_F8 ? U8S : 1.f, kS = ws * ws * us, kE = -ws * 1.4426950408889634f;
        const float cE = -__builtin_log2f(kS), c1 = 1.f / kS;
#pragma unroll
        for (int ai = 0; ai < 2; ++ai)
#pragma unroll
            for (int m = 0; m < 4; ++m) {
                const size_t rowi = (size_t)u.pm * BM + ai * HALF + wr * 64 + m * 16 + fr;
                f32x2 g[4], up[4], t[4], r[4];
#pragma unroll
                for (int n = 0; n < 2; ++n) { g[2 * n] = (f32x2){acc[ai][0][m][n][0], acc[ai][0][m][n][1]}; g[2 * n + 1] = (f32x2){acc[ai][0][m][n][2], acc[ai][0][m][n][3]};
                                              up[2 * n] = (f32x2){acc[ai][1][m][n][0], acc[ai][1][m][n][1]}; up[2 * n + 1] = (f32x2){acc[ai][1][m][n][2], acc[ai][1][m][n][3]}; }
#pragma unroll
                for (int q = 0; q < 4; ++q) t[q] = g[q] * kE + cE;
#pragma unroll
                for (int q = 0; q < 4; ++q) { t[q].x = __builtin_amdgcn_exp2f(t[q].x); t[q].y = __builtin_amdgcn_exp2f(t[q].y); }
#pragma unroll
                for (int q = 0; q < 4; ++q) t[q] = t[q] + c1;
#pragma unroll
                for (int q = 0; q < 4; ++q) { r[q].x = __builtin_amdgcn_rcpf(t[q].x); r[q].y = __builtin_amdgcn_rcpf(t[q].y); }
#pragma unroll
                for (int q = 0; q < 4; ++q) g[q] = (g[q] * up[q]) * r[q];
                if constexpr (FFN_F8) { u32x2 w; w.x = pk4_f8(g[0].x, g[0].y, g[1].x, g[1].y); w.y = pk4_f8(g[2].x, g[2].y, g[3].x, g[3].y); *(u32x2*)((unsigned char*)U + rowi * DFF + col0) = w; }
                else { u32x4 w; w.x = cvt_pk_bf16(g[0].x, g[0].y); w.y = cvt_pk_bf16(g[1].x, g[1].y); w.z = cvt_pk_bf16(g[2].x, g[2].y); w.w = cvt_pk_bf16(g[3].x, g[3].y); *(u32x4*)(U + rowi * DFF + col0) = w; }
            }
    }
};
struct EpiDown {
    static constexpr bool PERM = true, AFTER_DRAIN = false;
    bf16_t* F2; const int* rmap; const float* roww; int dense;
    __device__ __forceinline__ void operator()(const f32x4 (&acc)[2][2][4][2], const Unit& u, int wr, int wc, int fr, int fq) const {
        const int pnl = u.pn & 3;
        const int col0 = pnl * BM + wc * 32 + 8 * fq;
        const __amdgpu_buffer_rsrc_t rsF = __builtin_amdgcn_make_buffer_rsrc((void*)F2, 0, 2 * M * DM * 2, 0x00020000);
        const __amdgpu_buffer_rsrc_t rsM = __builtin_amdgcn_make_buffer_rsrc((void*)rmap, 0, MP * 4, 0x00020000);
        const __amdgpu_buffer_rsrc_t rsW = __builtin_amdgcn_make_buffer_rsrc((void*)roww, 0, MP * 4, 0x00020000);
#pragma unroll
        for (int ai = 0; ai < 2; ++ai)
#pragma unroll
            for (int m = 0; m < 4; ++m) {
                const int grow = u.pm * BM + ai * HALF + wr * 64 + m * 16 + fr;
                int tok = grow, slot = 0; float w = 1.f; bool ok = true;
                if (!dense) { const int rm = (int)__builtin_amdgcn_raw_buffer_load_b32(rsM, grow * 4, 0, 0); ok = rm >= 0; tok = rm & 0x3fffffff; slot = (rm >> 30) & 1; w = __uint_as_float(__builtin_amdgcn_raw_buffer_load_b32(rsW, grow * 4, 0, 0)); }
                if constexpr (FFN_F8) w *= 1.f / (W8S * U8S);
                if (ok) {
                    const int bo = ((slot * M + tok) * DM + col0) * 2;
#pragma unroll
                    for (int bj = 0; bj < 2; ++bj) {
                        const f32x4 v0 = acc[ai][bj][m][0] * w, v1 = acc[ai][bj][m][1] * w;
                        u32x4 q; q.x = cvt_pk_bf16(v0[0], v0[1]); q.y = cvt_pk_bf16(v0[2], v0[3]); q.z = cvt_pk_bf16(v1[0], v1[1]); q.w = cvt_pk_bf16(v1[2], v1[3]);
                        __builtin_amdgcn_raw_buffer_store_b128(q, rsF, bo + bj * HALF * 2, 0, 0);
                    }
                }
            }
    }
};
struct GroupedOrder {
    StaticOrder S; const PG8_LAS int* texp; int nN;
    __device__ __forceinline__ bool next(int i, Unit& u) const { if (!S.next(i, u)) return false; u.pn += __builtin_amdgcn_readfirstlane(texp[u.pm]) * nN; return true; }
    __device__ __forceinline__ void a_ready(const Unit&) const {}
    __device__ __forceinline__ void done(const Unit&) const {}
};
struct LatOrder {
    StaticOrder S; int lat;
    __device__ __forceinline__ bool next(int i, Unit& u) const { if (!S.next(i, u)) return false; if (lat) u.pm += (u.pm >> 3) + 1; return true; }
    __device__ __forceinline__ void a_ready(const Unit&) const {}
    __device__ __forceinline__ void done(const Unit&) const {}
};
}

__device__ __forceinline__ void ld_row_f32(const float* row, int lane, f32x4 (&v)[4]) {
#pragma unroll
    for (int j = 0; j < 4; ++j) v[j] = *(const f32x4*)(row + 4 * lane + 256 * j);
}
__device__ __forceinline__ void st_row_f32(float* row, int lane, const f32x4 (&v)[4]) {
#pragma unroll
    for (int j = 0; j < 4; ++j) *(f32x4*)(row + 4 * lane + 256 * j) = v[j];
}
__device__ __forceinline__ void ld_row_bf16(const bf16* row, int lane, f32x4 (&v)[4]) {
#pragma unroll
    for (int j = 0; j < 4; ++j) { const u32x2 w = *(const u32x2*)(row + 4 * lane + 256 * j); v[j] = (f32x4){bflo(w.x), bfhi(w.x), bflo(w.y), bfhi(w.y)}; }
}
__device__ __forceinline__ void st_row_bf16(bf16* row, int lane, const f32x4 (&v)[4]) {
#pragma unroll
    for (int j = 0; j < 4; ++j) { u32x2 w; w.x = pg8::cvt_pk_bf16(v[j][0], v[j][1]); w.y = pg8::cvt_pk_bf16(v[j][2], v[j][3]); *(u32x2*)(row + 4 * lane + 256 * j) = w; }
}
__device__ __forceinline__ float row_rinv(const f32x4 (&v)[4]) {
    float s = 0.f;
#pragma unroll
    for (int j = 0; j < 4; ++j) s += (v[j][0] * v[j][0] + v[j][1] * v[j][1]) + (v[j][2] * v[j][2] + v[j][3] * v[j][3]);
    return 1.0f / sqrtf(wave_sum(s) * (1.f / DM) + EPS);
}

__device__ __forceinline__ void transpose_tile(const float* W, int N, int k0, int n0, bf16* WT, int K, int drow0, LAS float* scr, int lane, bool ropeperm = false) {
    { f32x4 v[8];
#pragma unroll
      for (int j = 0; j < 8; ++j) v[j] = __builtin_nontemporal_load((const f32x4*)&W[(size_t)(k0 + 8 * j + (lane >> 3)) * N + n0 + 4 * (lane & 7)]);
#pragma unroll
      for (int j = 0; j < 8; ++j) { LAS float* d = scr + (8 * j + (lane >> 3)) * 33 + 4 * (lane & 7); d[0] = v[j][0]; d[1] = v[j][1]; d[2] = v[j][2]; d[3] = v[j][3]; } }
    LDS_WAIT(); asm volatile("" ::: "memory");
    const int c = lane & 7;
#pragma unroll
    for (int j = 0; j < 4; ++j) { const int n = (lane >> 3) + 8 * j; const LAS float* s = scr + (8 * c) * 33 + n;
        v4u o; o.x = pk2(s[0 * 33], s[1 * 33]); o.y = pk2(s[2 * 33], s[3 * 33]); o.z = pk2(s[4 * 33], s[5 * 33]); o.w = pk2(s[6 * 33], s[7 * 33]);
        const int nd = ropeperm ? (8 * ((n >> 2) & 3) + 4 * (n >> 4) + (n & 3)) : n;
        *(GAS v4u*)(WT + (size_t)(drow0 + nd) * K + k0 + 8 * c) = o; }
    LDS_WAIT(); asm volatile("" ::: "memory");
}
__device__ __forceinline__ void transpose_tile_f8(const float* W, int N, int k0, int n0, unsigned char* WT, int Kb, int drow0, LAS float* scr, int lane, float scale) {
    { f32x4 v[8];
#pragma unroll
      for (int j = 0; j < 8; ++j) v[j] = __builtin_nontemporal_load((const f32x4*)&W[(size_t)(k0 + 8 * j + (lane >> 3)) * N + n0 + 4 * (lane & 7)]);
#pragma unroll
      for (int j = 0; j < 8; ++j) { LAS float* d = scr + (8 * j + (lane >> 3)) * 33 + 4 * (lane & 7); d[0] = v[j][0]; d[1] = v[j][1]; d[2] = v[j][2]; d[3] = v[j][3]; } }
    LDS_WAIT(); asm volatile("" ::: "memory");
    const int n = lane >> 1, hf = lane & 1; const LAS float* s = scr + (hf * 32) * 33 + n;
    v4u o0, o1;
    o0.x = pk4_f8(s[0 * 33] * scale, s[1 * 33] * scale, s[2 * 33] * scale, s[3 * 33] * scale);     o0.y = pk4_f8(s[4 * 33] * scale, s[5 * 33] * scale, s[6 * 33] * scale, s[7 * 33] * scale);
    o0.z = pk4_f8(s[8 * 33] * scale, s[9 * 33] * scale, s[10 * 33] * scale, s[11 * 33] * scale);   o0.w = pk4_f8(s[12 * 33] * scale, s[13 * 33] * scale, s[14 * 33] * scale, s[15 * 33] * scale);
    o1.x = pk4_f8(s[16 * 33] * scale, s[17 * 33] * scale, s[18 * 33] * scale, s[19 * 33] * scale); o1.y = pk4_f8(s[20 * 33] * scale, s[21 * 33] * scale, s[22 * 33] * scale, s[23 * 33] * scale);
    o1.z = pk4_f8(s[24 * 33] * scale, s[25 * 33] * scale, s[26 * 33] * scale, s[27 * 33] * scale); o1.w = pk4_f8(s[28 * 33] * scale, s[29 * 33] * scale, s[30 * 33] * scale, s[31 * 33] * scale);
    GAS v4u* dst = (GAS v4u*)(WT + (size_t)(drow0 + n) * Kb + k0 + hf * 32);
    dst[0] = o0; dst[1] = o1;
    LDS_WAIT(); asm volatile("" ::: "memory");
}
__device__ __forceinline__ void convert_weights(Frame& F, int l) {
    refresh(F);
    const bool moe = l & 1; const int ne = moe ? NE : 1, li = l >> 1;
    const float* w1 = moe ? INP(21) + (size_t)li * NE * DM * DFF : INP(17) + (size_t)li * DM * DFF;
    const float* w3 = moe ? INP(22) + (size_t)li * NE * DM * DFF : INP(18) + (size_t)li * DM * DFF;
    const float* w2 = moe ? INP(23) + (size_t)li * NE * DM * DFF : INP(19) + (size_t)li * DM * DFF;
    const float* win = INP(10) + (size_t)l * DM * NIN;
    const float* wout = INP(16) + (size_t)l * DM * DM;
    bf16* WIN = (bf16*)(F.ws + WS_WIN); bf16* WOUT = (bf16*)(F.ws + WS_WOUT); bf16* WUP = (bf16*)(F.ws + WS_WUP); bf16* WDN = (bf16*)(F.ws + WS_WDN);
    LAS float* scr = (LAS float*)(F.lds + F.wave * 16384);
    const int nA = 16 * 97, nZ = NP - NIN, nB = 16 * 32, nC1 = 16 * 88, nD1 = 44 * 32;
    const int nC = ne * 2 * nC1, nD = ne * nD1, total = nA + nZ + nB + nC + nD;
    for (int it = F.gw; it < total; it += F.NGW) {
        int r = it;
        if (r < nA) { const int kb = r / 97, nb = r % 97; transpose_tile(win, NIN, 64 * kb, 32 * nb, WIN, DM, 32 * nb, scr, F.lane, nb < 32  ); continue; } r -= nA;
        if (r < nZ) { const unsigned zz = (unsigned)F.z; v4u z = {zz, zz, zz, zz}; GAS v4u* p = (GAS v4u*)(WIN + (size_t)(NIN + r) * DM) + F.lane * 2; p[0] = z; p[1] = z; continue; } r -= nZ;
        if (r < nB) { const int kb = r / 32, nb = r % 32; transpose_tile(wout, DM, 64 * kb, 32 * nb, WOUT, DM, 32 * nb, scr, F.lane); continue; } r -= nB;
        if (r < nC) { const int e = r / (2 * nC1), q = r % (2 * nC1), which = q / nC1, t = q % nC1, kb = t / 88, nb = t % 88, n0 = 32 * nb;
            const float* src = (which ? w3 : w1) + (size_t)e * DM * DFF;
            if constexpr (FFN_F8) transpose_tile_f8(src, DFF, 64 * kb, n0, (unsigned char*)WUP, DM, e * 5632 + (n0 / 128) * 256 + (n0 % 128) + which * 128, scr, F.lane, W8S);
            else transpose_tile(src, DFF, 64 * kb, n0, WUP, DM, e * 5632 + (n0 / 128) * 256 + (n0 % 128) + which * 128, scr, F.lane); continue; } r -= nC;
        { const int e = r / nD1, t = r % nD1, kb = t / 32, nb = t % 32;
            if constexpr (FFN_F8) transpose_tile_f8(w2 + (size_t)e * DFF * DM, DM, 64 * kb, 32 * nb, (unsigned char*)WDN + (size_t)e * DM * DFF, DFF, 32 * nb, scr, F.lane, W8S);
            else transpose_tile(w2 + (size_t)e * DFF * DM, DM, 64 * kb, 32 * nb, WDN + (size_t)e * DM * DFF, DFF, 32 * nb, scr, F.lane); }
    }
}

__device__ __forceinline__ void p0_mod(Frame& F) {
    refresh(F);
    LAS float* S = (LAS float*)(F.lds);
    LAS float* R = (LAS float*)(F.lds + 69632);
    const float* c = INP(1); const float* cc = INP(3); const float* wmod = INP(4); const float* bmod = INP(5);
    float* MOD = (float*)(F.ws + WS_MOD);
    for (int i = F.tid; i < 17 * 1024; i += 512) { const int b = i >> 10, k = i & 1023; const float v = b < 16 ? c[b * 1024 + k] : cc[k]; S[i] = siluf(v); }
    __syncthreads();
    const int kq = F.lane >> 4, c4 = (F.lane & 15) * 4;
    for (int item = F.blk; item < 4 * 96; item += F.G) {
        const int l = item / 96, col0 = (item % 96) * 64;
        const float* W = wmod + (size_t)l * DM * 6144;
        float acc[17][4];
#pragma unroll
        for (int b = 0; b < 17; ++b)
#pragma unroll
            for (int j = 0; j < 4; ++j) acc[b][j] = 0.f;
        for (int it0 = 0; it0 < 32; it0 += 4) {
            f32x4 w[4];
#pragma unroll
            for (int u = 0; u < 4; ++u) w[u] = __builtin_nontemporal_load((const f32x4*)(W + (size_t)(F.wave * 128 + (it0 + u) * 4 + kq) * 6144 + col0 + c4));
#pragma unroll
            for (int u = 0; u < 4; ++u) { const int k = F.wave * 128 + (it0 + u) * 4 + kq;
#pragma unroll
                for (int b = 0; b < 17; ++b) { const float s = S[b * 1024 + k];
#pragma unroll
                    for (int j = 0; j < 4; ++j) acc[b][j] += s * w[u][j]; } }
        }
#pragma unroll
        for (int b = 0; b < 17; ++b)
#pragma unroll
            for (int j = 0; j < 4; ++j) { float v = acc[b][j]; v = xadd<16>(v); v = xadd<32>(v); acc[b][j] = v; }
        if (kq == 0) {
#pragma unroll
            for (int b = 0; b < 17; ++b)
#pragma unroll
                for (int j = 0; j < 4; ++j) R[(F.wave * 17 + b) * 64 + c4 + j] = acc[b][j];
        }
        __syncthreads();
        for (int o = F.tid; o < 17 * 64; o += 512) { const int b = o >> 6, ccx = o & 63; float s = bmod[l * 6144 + col0 + ccx];
            for (int w = 0; w < 8; ++w) s += R[(w * 17 + b) * 64 + ccx];
            MOD[((size_t)l * 17 + b) * 6144 + col0 + ccx] = s; }
        __syncthreads();
    }
}
__device__ __forceinline__ float lam_init_of(int l) { return 0.8f - 0.6f * expf(-0.3f * (float)l); }
__device__ __forceinline__ void p0_misc(Frame& F) {
    refresh(F);
    float* ropec = (float*)(F.ws + WS_ROPE); float* ropes = ropec + 1024; float* lam = (float*)(F.ws + WS_ROPE + 16384);
    if (F.blk == 0) {
        for (int i = F.tid; i < 1024; i += 512) { const int pos = i >> 4, f = i & 15; const float inv = powf(10000.f, -(float)f / 16.f); const float ang = (float)pos * inv; ropec[i] = cosf(ang); ropes[i] = sinf(ang); }
    }
    if (F.blk == (1 % F.G) && F.wave < 4) {
        const int l = F.wave; const float* lv = INP(13) + l * 256;
        const float a = wave_sum(lv[F.lane] * lv[64 + F.lane]), b = wave_sum(lv[128 + F.lane] * lv[192 + F.lane]);
        if (F.lane == 0) lam[l] = expf(a) - expf(b) + lam_init_of(l);
    }
}

namespace att {
using bf16x8 = __attribute__((ext_vector_type(8))) short;
using s16x4  = __attribute__((ext_vector_type(4))) short;
using f32x16 = __attribute__((ext_vector_type(16))) float;
using u32x4  = __attribute__((ext_vector_type(4))) unsigned;
constexpr int QBLK = 32, KVBLK = 64, NW = 8, DV = 128;
constexpr float THR = 8.f;
constexpr size_t SHM_V = KVBLK * DV * 2, SHM_K = KVBLK * 64 * 2, SHM_ATTN = 2 * SHM_V + 2 * SHM_K + NW * 64 * 4;
#define KSWZ64(row, colB) ((row) * 128 + ((colB) ^ ((((row) >> 1) & 7) << 4)))
#define SBAR() __builtin_amdgcn_sched_barrier(0)
__device__ __forceinline__ int crow(int r, int hi) { return (r & 3) + 8 * (r >> 2) + 4 * hi; }
__device__ __forceinline__ unsigned cvtpk(float lo, float hi) { unsigned r; asm volatile("v_cvt_pk_bf16_f32 %0, %1, %2" : "=v"(r) : "v"(lo), "v"(hi)); return r; }
__device__ __forceinline__ void partialSM(f32x16& p0, f32x16& p1, float& m_reg, float& mn, float& alpha) {
  float pmax = p0[0];
#pragma unroll
  for (int r = 1; r < 16; ++r) pmax = fmaxf(pmax, p0[r]);
#pragma unroll
  for (int r = 0; r < 16; ++r) pmax = fmaxf(pmax, p1[r]);
  { auto rr = __builtin_amdgcn_permlane32_swap(__float_as_uint(pmax), __float_as_uint(pmax), false, false);
    pmax = fmaxf(__uint_as_float(rr[0]), __uint_as_float(rr[1])); }
  if (__builtin_expect(__all(pmax - m_reg <= THR), 1)) { mn = m_reg; alpha = 1.f; }
  else { mn = fmaxf(m_reg, pmax); alpha = __builtin_amdgcn_exp2f(m_reg - mn); m_reg = mn; }
#pragma unroll
  for (int r = 0; r < 16; ++r) p0[r] = p0[r] - mn;
#pragma unroll
  for (int r = 0; r < 16; ++r) p1[r] = p1[r] - mn;
#pragma unroll
  for (int r = 0; r < 16; ++r) p0[r] = __builtin_amdgcn_exp2f(p0[r]);
}
__device__ __forceinline__ void finishSM(f32x16& p0, f32x16& p1, float alpha, float& l_reg, bf16x8& pa0, bf16x8& pa1, bf16x8& pa2, bf16x8& pa3) {
#pragma unroll
  for (int r = 0; r < 16; ++r) p1[r] = __builtin_amdgcn_exp2f(p1[r]);
  float ps = 0;
#pragma unroll
  for (int r = 0; r < 16; ++r) ps += p0[r];
#pragma unroll
  for (int r = 0; r < 16; ++r) ps += p1[r];
  { auto rr = __builtin_amdgcn_permlane32_swap(__float_as_uint(ps), __float_as_uint(ps), false, false);
    ps = __uint_as_float(rr[0]) + __uint_as_float(rr[1]); }
  l_reg = l_reg * alpha + ps;
#define PK4(P, BASE, OUT) do { unsigned a0 = cvtpk(P[BASE + 0], P[BASE + 1]), a1 = cvtpk(P[BASE + 2], P[BASE + 3]);   \
    unsigned b0 = cvtpk(P[BASE + 4], P[BASE + 5]), b1 = cvtpk(P[BASE + 6], P[BASE + 7]);                              \
    auto r0 = __builtin_amdgcn_permlane32_swap(a0, b0, false, false); auto r1 = __builtin_amdgcn_permlane32_swap(a1, b1, false, false); \
    u32x4 w = {r0[0], r1[0], r0[1], r1[1]}; OUT = *reinterpret_cast<bf16x8*>(&w); } while (0)
  PK4(p0, 0, pa0); PK4(p0, 8, pa1); PK4(p1, 0, pa2); PK4(p1, 8, pa3);
#undef PK4
}
__device__ __forceinline__ void pack_p(const f32x16& p0, const f32x16& p1, bf16x8& pa0, bf16x8& pa1, bf16x8& pa2, bf16x8& pa3) {
#define PK4(P, BASE, OUT) do { unsigned a0 = cvtpk(P[BASE + 0], P[BASE + 1]), a1 = cvtpk(P[BASE + 2], P[BASE + 3]);   \
    unsigned b0 = cvtpk(P[BASE + 4], P[BASE + 5]), b1 = cvtpk(P[BASE + 6], P[BASE + 7]);                              \
    auto r0 = __builtin_amdgcn_permlane32_swap(a0, b0, false, false); auto r1 = __builtin_amdgcn_permlane32_swap(a1, b1, false, false); \
    u32x4 w = {r0[0], r1[0], r0[1], r1[1]}; OUT = *reinterpret_cast<bf16x8*>(&w); } while (0)
  PK4(p0, 0, pa0); PK4(p0, 8, pa1); PK4(p1, 0, pa2); PK4(p1, 8, pa3);
#undef PK4
}
__device__ __forceinline__ void qkt(f32x16& p0, f32x16& p1, const bf16* Ks, const bf16x8* qr, int r32, int hi) {
  p0 = f32x16{}; p1 = f32x16{};
#pragma unroll
  for (int d0 = 0; d0 < 4; ++d0) { int cb = (d0 * 16 + hi * 8) * 2;
    bf16x8 b0 = *reinterpret_cast<const bf16x8*>((const char*)Ks + KSWZ64(r32, cb));
    bf16x8 b1 = *reinterpret_cast<const bf16x8*>((const char*)Ks + KSWZ64(32 + r32, cb));
    p0 = __builtin_amdgcn_mfma_f32_32x32x16_bf16(b0, qr[d0], p0, 0, 0, 0);
    p1 = __builtin_amdgcn_mfma_f32_32x32x16_bf16(b1, qr[d0], p1, 0, 0, 0); }
}
__device__ __forceinline__ int v_st(int k, int c) { const int kk = (k & ~0xC) | ((k & 4) << 1) | ((k & 8) >> 1); return ((kk >> 3) * 4 + (c >> 5)) * 512 + ((kk & 7) * 32 + (c & 31)) * 2; }
__device__ __forceinline__ int v_rd_base(int lane) { return ((lane & 3) << 3) | (((lane >> 2) & 3) << 6) | (((lane >> 4) & 1) << 5) | (((lane >> 5) & 1) << 8); }
constexpr int v_rd_off(int d0, int ks, int half) { return d0 * 512 + ks * 4096 + half * 2048; }
template <int OFF> __device__ __forceinline__ s16x4 tr_read(int vb) {
  s16x4 r; asm volatile("ds_read_b64_tr_b16 %0, %1 offset:%2" : "=&v"(r) : "v"(vb), "i"(OFF) : "memory"); return r;
}
template <int D0> __device__ __forceinline__ void pv_one(f32x16& od, int vb, bf16x8 pa0, bf16x8 pa1, bf16x8 pa2, bf16x8 pa3) {
  const s16x4 l0 = tr_read<v_rd_off(D0, 0, 0)>(vb), h0 = tr_read<v_rd_off(D0, 0, 1)>(vb), l1 = tr_read<v_rd_off(D0, 1, 0)>(vb), h1 = tr_read<v_rd_off(D0, 1, 1)>(vb);
  const s16x4 l2 = tr_read<v_rd_off(D0, 2, 0)>(vb), h2 = tr_read<v_rd_off(D0, 2, 1)>(vb), l3 = tr_read<v_rd_off(D0, 3, 0)>(vb), h3 = tr_read<v_rd_off(D0, 3, 1)>(vb);
  asm volatile("s_waitcnt lgkmcnt(0)" ::: "memory"); SBAR();
#define PK(L, H) (bf16x8){L[0], L[1], L[2], L[3], H[0], H[1], H[2], H[3]}
  od = __builtin_amdgcn_mfma_f32_32x32x16_bf16(pa0, PK(l0, h0), od, 0, 0, 0);
  od = __builtin_amdgcn_mfma_f32_32x32x16_bf16(pa1, PK(l1, h1), od, 0, 0, 0);
  od = __builtin_amdgcn_mfma_f32_32x32x16_bf16(pa2, PK(l2, h2), od, 0, 0, 0);
  od = __builtin_amdgcn_mfma_f32_32x32x16_bf16(pa3, PK(l3, h3), od, 0, 0, 0);
#undef PK
}
__device__ __forceinline__ void pv_d0(f32x16* o, int vb, bf16x8 pa0, bf16x8 pa1, bf16x8 pa2, bf16x8 pa3) {
  pv_one<0>(o[0], vb, pa0, pa1, pa2, pa3); pv_one<1>(o[1], vb, pa0, pa1, pa2, pa3); pv_one<2>(o[2], vb, pa0, pa1, pa2, pa3); pv_one<3>(o[3], vb, pa0, pa1, pa2, pa3);
}
constexpr int LDQ = NP, LDK = NP, LDO = DM;
__device__ __forceinline__ void sm_first(f32x16& p0, f32x16& p1, float m) {
#pragma unroll
  for (int r = 0; r < 16; ++r) p0[r] = p0[r] - m;
#pragma unroll
  for (int r = 0; r < 16; ++r) p1[r] = p1[r] - m;
#pragma unroll
  for (int r = 0; r < 16; ++r) p0[r] = __builtin_amdgcn_exp2f(p0[r]);
}
__device__ __forceinline__ void sm_second(f32x16& p0, f32x16& p1, float& l_reg, bf16x8& pa0, bf16x8& pa1, bf16x8& pa2, bf16x8& pa3) {
#pragma unroll
  for (int r = 0; r < 16; ++r) p1[r] = __builtin_amdgcn_exp2f(p1[r]);
  float ps = 0;
#pragma unroll
  for (int r = 0; r < 16; ++r) ps += p0[r];
#pragma unroll
  for (int r = 0; r < 16; ++r) ps += p1[r];
  { auto rr = __builtin_amdgcn_permlane32_swap(__float_as_uint(ps), __float_as_uint(ps), false, false);
    ps = __uint_as_float(rr[0]) + __uint_as_float(rr[1]); }
  l_reg += ps;
  pack_p(p0, p1, pa0, pa1, pa2, pa3);
}
__device__ __forceinline__ void attn_unit(const bf16* __restrict__ Qb, const bf16* __restrict__ Kh, const bf16* __restrict__ Vh, bf16* __restrict__ Ob, int seq, char* lds, int tid, float kmax) {
  const int wid = tid >> 6, lane = tid & 63, r32 = lane & 31, hi = lane >> 5;
  bf16* V_lds = (bf16*)lds; bf16* K_lds = (bf16*)(lds + 2 * SHM_V);
  float* ws = (float*)(lds + 2 * SHM_V + 2 * SHM_K) + wid * 64; float* li_l = ws; float* al_l = ws + 32;
  float m_reg = -1e30f, l_reg = 0; f32x16 o[4] = {}; bf16x8 qr[4];
  const bf16* Qw = Qb + (long)(wid * QBLK + r32) * LDQ + hi * 8;
#pragma unroll
  for (int d0 = 0; d0 < 4; ++d0) qr[d0] = *(const __attribute__((address_space(1))) bf16x8*)(Qw + d0 * 16);
  { float qs = 0.f;
#pragma unroll
    for (int d0 = 0; d0 < 4; ++d0)
#pragma unroll
      for (int e = 0; e < 8; ++e) { const float qv = __uint_as_float((unsigned)(unsigned short)qr[d0][e] << 16); qs += qv * qv; }
    auto rr = __builtin_amdgcn_permlane32_swap(__float_as_uint(qs), __float_as_uint(qs), false, false);
    qs = __uint_as_float(rr[0]) + __uint_as_float(rr[1]);
    m_reg = sqrtf(qs) * kmax * 1.002f + 1e-3f; }
  const int sr = tid >> 4, sc = (tid & 15) * 8, vst0 = v_st(sr, sc), vst1 = v_st(32 + sr, sc);
  const int kr = tid >> 3, kc = (tid & 7) * 8, kst = KSWZ64(kr, kc * 2);
  const int vb0 = (int)(uintptr_t)V_lds + v_rd_base(lane);
  struct { bf16x8 vs0, vs1, ks0; } sr_[2];
#define GLD8(p) (*(const __attribute__((address_space(1))) bf16x8*)(p))
#define SLOAD(i, k0) do { sr_[i].vs0 = GLD8(&Vh[(long)((k0) + sr) * LDK + sc]); sr_[i].vs1 = GLD8(&Vh[(long)((k0) + 32 + sr) * LDK + sc]); \
    sr_[i].ks0 = GLD8(&Kh[(long)((k0) + kr) * LDK + kc]); } while (0)
#define SWRITE(b, i) do { *(bf16x8*)((char*)V_lds + (b) * SHM_V + vst0) = sr_[i].vs0; *(bf16x8*)((char*)V_lds + (b) * SHM_V + vst1) = sr_[i].vs1; \
    *(bf16x8*)((char*)K_lds + (b) * SHM_K + kst) = sr_[i].ks0; } while (0)
#define SWAIT() asm volatile("s_waitcnt vmcnt(3)" ::: "memory")
#define RESC(a) do { if (__any((a) < 1.f)) { if (hi == 0) al_l[r32] = (a); asm volatile("s_waitcnt lgkmcnt(0)" ::: "memory"); \
    _Pragma("unroll") for (int d = 0; d < 4; ++d) _Pragma("unroll") for (int r = 0; r < 16; ++r) o[d][r] *= al_l[crow(r, hi)]; } } while (0)
  f32x16 pA0, pA1, pB0, pB1; float mnA, mnB, alA, alB; bf16x8 pa0, pa1, pa2, pa3; const int NT = seq / KVBLK;
  if (__builtin_amdgcn_readfirstlane(wid) >= 4) __builtin_amdgcn_s_setprio(1);
  constexpr int SE = 0, SO = 1;
  SLOAD(SE, 0); asm volatile("s_waitcnt vmcnt(0)" ::: "memory"); SWRITE(0, SE); __syncthreads();
  qkt(pA0, pA1, K_lds, qr, r32, hi); sm_first(pA0, pA1, m_reg);
  SLOAD(SO, KVBLK); if (2 < NT) SLOAD(SE, 2 * KVBLK);
  SWAIT(); SWRITE(1, SO); __syncthreads();
  for (int j = 1; j + 1 < NT; j += 2) {
    SBAR(); qkt(pB0, pB1, (bf16*)((char*)K_lds + SHM_K), qr, r32, hi);
    sm_second(pA0, pA1, l_reg, pa0, pa1, pa2, pa3); SBAR();
    SLOAD(SO, (j + 2) * KVBLK); SBAR();
    pv_d0(o, vb0, pa0, pa1, pa2, pa3); sm_first(pB0, pB1, m_reg);
    __syncthreads(); SWAIT(); SWRITE(0, SE);
    __syncthreads();
    SBAR(); qkt(pA0, pA1, K_lds, qr, r32, hi);
    sm_second(pB0, pB1, l_reg, pa0, pa1, pa2, pa3); SBAR();
    if (j + 3 < NT) SLOAD(SE, (j + 3) * KVBLK); SBAR();
    pv_d0(o, vb0 + (int)SHM_V, pa0, pa1, pa2, pa3); sm_first(pA0, pA1, m_reg);
    __syncthreads(); SWAIT(); SWRITE(1, SO);
    __syncthreads();
  }
  SBAR(); qkt(pB0, pB1, (bf16*)((char*)K_lds + SHM_K), qr, r32, hi);
  sm_second(pA0, pA1, l_reg, pa0, pa1, pa2, pa3); SBAR();
  pv_d0(o, vb0, pa0, pa1, pa2, pa3); sm_first(pB0, pB1, m_reg);
  __syncthreads();
  sm_second(pB0, pB1, l_reg, pa0, pa1, pa2, pa3); SBAR();
  pv_d0(o, vb0 + (int)SHM_V, pa0, pa1, pa2, pa3);
  __builtin_amdgcn_s_setprio(0);
  if (hi == 0) li_l[r32] = l_reg; asm volatile("s_waitcnt lgkmcnt(0)" ::: "memory");
  float rli[16];
#pragma unroll
  for (int r = 0; r < 16; ++r) rli[r] = __builtin_amdgcn_rcpf(li_l[crow(r, hi)]);
  bf16* Ow = Ob + (long)(wid * QBLK) * LDO;
#pragma unroll
  for (int r = 0; r < 16; ++r) { const int orow = crow(r, hi);
#pragma unroll
    for (int d0 = 0; d0 < 4; ++d0) Ow[(long)orow * LDO + d0 * 32 + r32] = (bf16)(cvtpk(o[d0][r] * rli[r], 0.f) & 0xffffu); }
#undef SLOAD
#undef GLD8
#undef SWRITE
#undef SWAIT
#undef RESC
}
}

constexpr int CW_KMX = 13312;
constexpr int CW_Q = 12288;
namespace att2 {
using att::bf16x8; using att::s16x4; using att::f32x16; using att::u32x4;
typedef LAS const char* lds_cptr;
typedef short v4i16_t __attribute__((ext_vector_type(4)));
typedef unsigned u32x2 __attribute__((ext_vector_type(2)));
constexpr int KSLOT = 8192, VSLOT = 16384, LDS_K = 0, LDS_V = 4 * KSLOT, KVBLK = 64;
#define A2_PIN(x) asm volatile("" : "+v"(x))
#define A2_MFMA(a, b, c) __builtin_amdgcn_mfma_f32_32x32x16_bf16(a, b, c, 0, 0, 0)
#define A2_WAIT_BAR(N) asm volatile("s_waitcnt vmcnt(" #N ") lgkmcnt(0)\n\ts_barrier" ::: "memory")
__device__ __forceinline__ unsigned cvtpk(float lo, float hi) { unsigned r; asm("v_cvt_pk_bf16_f32 %0, %1, %2" : "=v"(r) : "v"(lo), "v"(hi)); return r; }
__device__ __forceinline__ void glds16s(const char* gbase, unsigned voff, unsigned lds_base) {
    unsigned sv; asm volatile("s_mov_b32 %0, m0\n\ts_mov_b32 m0, %3\n\ts_nop 0\n\tglobal_load_lds_dwordx4 %1, %2\n\ts_mov_b32 m0, %0" : "=&s"(sv) : "v"(voff), "s"(gbase), "s"(lds_base) : "memory"); }
__device__ __forceinline__ const char* uni_ptr(const void* p) { const unsigned long long v = (unsigned long long)p;
    const unsigned lo = __builtin_amdgcn_readfirstlane((unsigned)v), hi = __builtin_amdgcn_readfirstlane((unsigned)(v >> 32)); return (const char*)(((unsigned long long)hi << 32) | lo); }
__device__ __forceinline__ void kload2(bf16x8* kf, lds_cptr kp, int d0) { kf[2 * d0] = *(const LAS bf16x8*)(kp + d0 * 2048); kf[2 * d0 + 1] = *(const LAS bf16x8*)(kp + d0 * 2048 + 512); }
__device__ __forceinline__ s16x4 vtr(lds_cptr p) { return __builtin_bit_cast(s16x4, __builtin_amdgcn_ds_read_tr16_b64_v4i16((LAS v4i16_t*)p)); }
struct UnitP { const bf16* Q; const char* K; const char* V; bf16* O; int NT, kmi; };
__device__ __forceinline__ void decode_unit(int u, int myq, const bf16* P, bf16* OD, UnitP& U) {
    int g, qt;
    if (u < 128) { const int pi = u >> 4, mp = (u >> 3) & 1; g = ((pi * 8 + myq) << 1) + mp; qt = 1 + (u & 7); }
    else { const int gi = u - 128; g = (((gi >> 1) * 8 + myq) << 1) + (gi & 1); qt = 0; }
    const int b = g >> 3, hh = g & 7;
    const size_t row0 = (size_t)b * TPB;
    U.Q = P + (row0 + qt * 256) * NP + C_Q + hh * 64; U.K = (const char*)(P + row0 * NP + C_K + hh * 64); U.V = (const char*)(P + row0 * NP + C_V + (hh >> 1) * 128);
    U.O = OD + (row0 + qt * 256) * DM + hh * 128; U.NT = qt == 0 ? CTX / 64 : TPB / 64;
    U.kmi = (b * 8 + hh) * 2;
}
__device__ __forceinline__ void attn_stream(Frame& F, int l) {
    const bf16* P = (const bf16*)(F.ws + WS_PROJ); bf16* OD = (bf16*)(F.ws + WS_OD);
    const unsigned* kmxp = (const unsigned*)F.ws + CW_KMX + 256 * l;
    gu32* qheads = (gu32*)F.ws + CW_Q + 64 * l;
    volatile LAS unsigned* slot = F.MISC + 24;
    const int limit = (l == DEPTH - 1 ? 128 : 144);
    LAS unsigned char* lds = F.lds; const int tid = F.tid;
    const int lane = tid & 63, r32 = lane & 31, hi = lane >> 5; const int wid = __builtin_amdgcn_readfirstlane(tid >> 6);
    constexpr unsigned TSTR = KVBLK * NP * 2;
    const unsigned lds0 = (unsigned)(uintptr_t)lds;
    const unsigned koff = (unsigned)(lane * NP + wid * 8) * 2;
    const unsigned voff0 = (unsigned)((16 * (wid & 3) + (lane >> 2)) * NP + (wid >> 2) * 32 + (lane & 3) * 8) * 2, voff1 = voff0 + 128;
    const unsigned kdst = lds0 + LDS_K + wid * 1024, vdst = lds0 + LDS_V + wid * 1024;
#define DMA_K(src, slotB) glds16s((src), koff, kdst + (slotB))
#define DMA_V(src, slotB) do { const char* vb_ = (src); glds16s(vb_, voff0, vdst + (slotB)); glds16s(vb_, voff1, vdst + (slotB) + 8192); } while (0)
    const lds_cptr vp0 = (lds_cptr)lds + LDS_V + ((lane >> 4) & 1) * 32 + (lane & 3) * 8 + (4 * hi + ((lane & 15) >> 2)) * 64;
    const lds_cptr kp0 = (lds_cptr)lds + LDS_K + hi * 1024 + r32 * 16;
    if (wid >= 4) __builtin_amdgcn_s_setprio(1);
    int myq = F.blk & 7, tries = 0, vstart = 0; bool warm = false; UnitP cur, nx;
    for (;;) {
        if (!warm) {
            int u;
            for (;;) {
                __syncthreads();
                if (tid == 0) slot[0] = __hip_atomic_fetch_add((unsigned*)(qheads + myq), 1u, __ATOMIC_RELAXED, __HIP_MEMORY_SCOPE_AGENT);
                __syncthreads();
                u = __builtin_amdgcn_readfirstlane((int)slot[0]);
                if (u < limit) break;
                if (++tries >= 8) { u = -1; break; }
                myq = (myq + 1) & 7;
            }
            if (u < 0) break;
            decode_unit(u, myq, P, OD, cur);
            const char* Kc = uni_ptr(cur.K); const char* Vc = uni_ptr(cur.V);
            DMA_K(Kc, 0); DMA_V(Vc, 0); DMA_K(Kc + TSTR, KSLOT); DMA_K(Kc + 2 * (size_t)TSTR, 2 * KSLOT); vstart = 0;
        }
        const char* Kh = uni_ptr(cur.K); const char* Vh = uni_ptr(cur.V); const int NT = cur.NT;
        const int tpop = NT - 5;
        unsigned nxt = 0xffffffffu;
        if (NT < 8 && tid == 0) nxt = __hip_atomic_fetch_add((unsigned*)(qheads + myq), 1u, __ATOMIC_RELAXED, __HIP_MEMORY_SCOPE_AGENT);
        bf16x8 qr[4];
        const bf16* Qw = cur.Q + (long)(wid * 32 + r32) * NP + hi * 8;
#pragma unroll
        for (int d0 = 0; d0 < 4; ++d0) qr[d0] = *(const GAS bf16x8*)(Qw + d0 * 16);
        const float kmax = sqrtf(__uint_as_float(kmxp[cur.kmi]) + __uint_as_float(kmxp[cur.kmi + 1])) * 1.01f;
        float m_row;
        { float qs = 0.f;
#pragma unroll
          for (int d0 = 0; d0 < 4; ++d0)
#pragma unroll
            for (int e = 0; e < 8; ++e) { const float qv = __uint_as_float((unsigned)(unsigned short)qr[d0][e] << 16); qs += qv * qv; }
          auto rr = __builtin_amdgcn_permlane32_swap(__float_as_uint(qs), __float_as_uint(qs), false, false);
          qs = __uint_as_float(rr[0]) + __uint_as_float(rr[1]);
          m_row = sqrtf(qs) * kmax * 1.002f + 1e-3f; }
        f32x16 negm16;
#pragma unroll
        for (int r = 0; r < 16; ++r) negm16[r] = -m_row;
        A2_PIN(negm16);
        float l_reg = 0.f; f32x16 o[4]; o[0] = f32x16{}; o[1] = f32x16{}; o[2] = f32x16{}; o[3] = f32x16{};
        f32x16 pA0, pA1, pB0, pB1; bf16x8 kf[8]; s16x4 vlo[5], vhi[5]; u32x4 pw[4];
        asm volatile("s_waitcnt vmcnt(0)" ::: "memory");
        if (NT < 8 && tid == 0) slot[1] = nxt;
        asm volatile("s_waitcnt lgkmcnt(0)\n\ts_barrier" ::: "memory");
        bool hasn = false; const char* KhN = Kh; const char* VhN = Vh;
#define GET_NEXT() do { const int un_ = __builtin_amdgcn_readfirstlane((int)slot[1]); hasn = un_ < limit; if (hasn) { decode_unit(un_, myq, P, OD, nx); KhN = uni_ptr(nx.K); VhN = uni_ptr(nx.V); } } while (0)
        if (NT < 8) GET_NEXT();
#pragma unroll
        for (int d0 = 0; d0 < 4; ++d0) kload2(kf, kp0, d0);
        pA0 = A2_MFMA(kf[0], qr[0], negm16); pA1 = A2_MFMA(kf[1], qr[0], negm16); pA0 = A2_MFMA(kf[2], qr[1], pA0); pA1 = A2_MFMA(kf[3], qr[1], pA1);
        pA0 = A2_MFMA(kf[4], qr[2], pA0); pA1 = A2_MFMA(kf[5], qr[2], pA1); pA0 = A2_MFMA(kf[6], qr[3], pA0); pA1 = A2_MFMA(kf[7], qr[3], pA1);
#pragma unroll
        for (int r = 0; r < 16; ++r) { pA0[r] = __builtin_amdgcn_exp2f(pA0[r]); pA1[r] = __builtin_amdgcn_exp2f(pA1[r]); }
        int vp = vstart;
        { int v1 = vp + VSLOT; if (v1 == 3 * VSLOT) v1 = 0; DMA_K(Kh + 3 * (size_t)TSTR, 3 * KSLOT); DMA_V(Vh + TSTR, v1); }
        kload2(kf, kp0 + KSLOT, 0); kload2(kf, kp0 + KSLOT, 1);
        A2_WAIT_BAR(3);
        int kc = KSLOT;
#define PKW(P, i) cvtpk(P[i], P[(i) + 1])
#define VFR(s) (bf16x8){vlo[s][0], vlo[s][1], vlo[s][2], vlo[s][3], vhi[s][0], vhi[s][1], vhi[s][2], vhi[s][3]}
#define VRD(s, i) do { vlo[s] = vtr(vq_ + (((i) & 3) * 4096 + ((i) >> 2) * 1024)); vhi[s] = vtr(vq_ + (((i) & 3) * 4096 + ((i) >> 2) * 1024 + 512)); } while (0)
#define GAPA(MF, W0, W1, PW) do { MF; W0; W1; A2_PIN(PW); SBAR(); } while (0)
#define GAPB(i, X, j, Y) do { if ((i) + 4 < 16) VRD(((i) + 4) % 5, (i) + 4); if ((i) == 9) kload2(kf, kn_, 0); if ((i) == 10) kload2(kf, kn_, 1); SBAR(); \
    o[(i) & 3] = A2_MFMA(VFR((i) % 5), __builtin_bit_cast(bf16x8, pw[(i) >> 2]), o[(i) & 3]); X[j] = __builtin_amdgcn_exp2f(X[j]); X[(j) + 1] = __builtin_amdgcn_exp2f(X[(j) + 1]); l_reg += Y[j]; l_reg += Y[(j) + 1]; A2_PIN(X); A2_PIN(l_reg); SBAR(); } while (0)
#define A2_STEP(C0, C1, P0, P1, t) do { \
    if ((t) == tpop) { if (tid == 0) slot[1] = __hip_atomic_fetch_add((unsigned*)(qheads + myq), 1u, __ATOMIC_RELAXED, __HIP_MEMORY_SCOPE_AGENT); } \
    if ((t) == tpop + 1) GET_NEXT();                                                                                 \
    SBAR(); \
    const lds_cptr kq_ = kp0 + kc, vq_ = vp0 + vp, kn_ = kp0 + ((kc + KSLOT) & (4 * KSLOT - 1)); \
    const int ik_ = (t) + 3, iv_ = (t) + 1; \
    const char* ks_ = ik_ < NT ? Kh + (size_t)ik_ * TSTR : KhN + (size_t)(ik_ - NT) * TSTR;                            \
    const char* vs_ = iv_ < NT ? Vh + (size_t)iv_ * TSTR : VhN; \
    const int kprev_ = (kc - KSLOT) & (4 * KSLOT - 1); int vnew_ = vp + 2 * VSLOT; if (vnew_ >= 3 * VSLOT) vnew_ -= 3 * VSLOT; \
    kload2(kf, kq_, 2); SBAR(); \
    GAPA(C0 = A2_MFMA(kf[0], qr[0], negm16), pw[0][0] = PKW(P0, 0),  pw[0][1] = PKW(P0, 2),  pw[0]); \
    kload2(kf, kq_, 3); SBAR(); \
    GAPA(C1 = A2_MFMA(kf[1], qr[0], negm16), pw[0][2] = PKW(P0, 4),  pw[0][3] = PKW(P0, 6),  pw[0]); \
    VRD(0, 0); SBAR(); GAPA(C0 = A2_MFMA(kf[2], qr[1], C0), pw[1][0] = PKW(P0, 8),  pw[1][1] = PKW(P0, 10), pw[1]); \
    VRD(1, 1); SBAR(); GAPA(C1 = A2_MFMA(kf[3], qr[1], C1), pw[1][2] = PKW(P0, 12), pw[1][3] = PKW(P0, 14), pw[1]); \
    VRD(2, 2); SBAR(); GAPA(C0 = A2_MFMA(kf[4], qr[2], C0), pw[2][0] = PKW(P1, 0),  pw[2][1] = PKW(P1, 2),  pw[2]); \
    VRD(3, 3); SBAR(); GAPA(C1 = A2_MFMA(kf[5], qr[2], C1), pw[2][2] = PKW(P1, 4),  pw[2][3] = PKW(P1, 6),  pw[2]); \
                       GAPA(C0 = A2_MFMA(kf[6], qr[3], C0), pw[3][0] = PKW(P1, 8),  pw[3][1] = PKW(P1, 10), pw[3]); \
                       GAPA(C1 = A2_MFMA(kf[7], qr[3], C1), pw[3][2] = PKW(P1, 12), pw[3][3] = PKW(P1, 14), pw[3]); \
    DMA_K(ks_, kprev_); DMA_V(vs_, vnew_); SBAR();                                                                   \
    GAPB(0, C0, 0, P0);  GAPB(1, C0, 2, P0);  GAPB(2, C0, 4, P0);   GAPB(3, C0, 6, P0);   GAPB(4, C0, 8, P0);   GAPB(5, C0, 10, P0);  GAPB(6, C0, 12, P0);  GAPB(7, C0, 14, P0); \
    GAPB(8, C1, 0, P1);  GAPB(9, C1, 2, P1);  GAPB(10, C1, 4, P1);  GAPB(11, C1, 6, P1);  GAPB(12, C1, 8, P1);  GAPB(13, C1, 10, P1); GAPB(14, C1, 12, P1); GAPB(15, C1, 14, P1); \
    A2_WAIT_BAR(3);                                                                                                   \
    kc = (kc + KSLOT) & (4 * KSLOT - 1); vp += VSLOT; if (vp == 3 * VSLOT) vp = 0; \
    } while (0)
        int t = 1;
        for (; t + 1 < NT; t += 2) {
            A2_STEP(pB0, pB1, pA0, pA1, t);
            A2_STEP(pA0, pA1, pB0, pB1, t + 1);
        }
        A2_STEP(pB0, pB1, pA0, pA1, NT - 1);
        { float sacc = pB0[0] + pB0[1];
#pragma unroll
          for (int r = 2; r < 16; ++r) sacc += pB0[r];
#pragma unroll
          for (int r = 0; r < 16; ++r) sacc += pB1[r];
          l_reg += sacc;
          pw[0] = (u32x4){PKW(pB0, 0), PKW(pB0, 2), PKW(pB0, 4), PKW(pB0, 6)}; pw[1] = (u32x4){PKW(pB0, 8), PKW(pB0, 10), PKW(pB0, 12), PKW(pB0, 14)};
          pw[2] = (u32x4){PKW(pB1, 0), PKW(pB1, 2), PKW(pB1, 4), PKW(pB1, 6)}; pw[3] = (u32x4){PKW(pB1, 8), PKW(pB1, 10), PKW(pB1, 12), PKW(pB1, 14)};
          const lds_cptr vq_ = vp0 + vp;
#pragma unroll
          for (int kg = 0; kg < 4; ++kg) {
              VRD(0, kg * 4 + 0); VRD(1, kg * 4 + 1); VRD(2, kg * 4 + 2); VRD(3, kg * 4 + 3);
              o[0] = A2_MFMA(VFR(0), __builtin_bit_cast(bf16x8, pw[kg]), o[0]); o[1] = A2_MFMA(VFR(1), __builtin_bit_cast(bf16x8, pw[kg]), o[1]);
              o[2] = A2_MFMA(VFR(2), __builtin_bit_cast(bf16x8, pw[kg]), o[2]); o[3] = A2_MFMA(VFR(3), __builtin_bit_cast(bf16x8, pw[kg]), o[3]); } }
        { auto rr = __builtin_amdgcn_permlane32_swap(__float_as_uint(l_reg), __float_as_uint(l_reg), false, false); l_reg = __uint_as_float(rr[0]) + __uint_as_float(rr[1]); }
        const float rli = __builtin_amdgcn_rcpf(l_reg);
        GAS bf16* Ow = (GAS bf16*)cur.O + (long)(wid * 32 + r32) * DM + 4 * hi;
#pragma unroll
        for (int d = 0; d < 4; ++d)
#pragma unroll
          for (int g = 0; g < 4; ++g) { u32x2 w; w.x = cvtpk(o[d][4 * g] * rli, o[d][4 * g + 1] * rli); w.y = cvtpk(o[d][4 * g + 2] * rli, o[d][4 * g + 3] * rli);
              *(GAS u32x2*)(Ow + d * 32 + 8 * g) = w; }
        vstart = vp + VSLOT; if (vstart == 3 * VSLOT) vstart = 0;
        if (hasn) { cur = nx; warm = true; }
        else { asm volatile("s_waitcnt vmcnt(0)" ::: "memory"); warm = false; }
    }
    __builtin_amdgcn_s_setprio(0);
    __syncthreads();
#undef DMA_K
#undef DMA_V
#undef PKW
#undef VFR
#undef VRD
#undef GAPA
#undef GAPB
#undef A2_STEP
#undef GET_NEXT
}
}

__device__ __forceinline__ int gla_item(int b, int h, int dir, int c) { return ((b * 4 + h) * 2 + dir) * NCH + c; }
namespace gla {
using att::bf16x8; using att::f32x16; using att::u32x4;
__device__ __forceinline__ void gates8(const bf16* P, const float* w2, const float* gb, size_t row0, int dir, int seg, int k, float (&gl)[8]) {
    float w[16];
#pragma unroll
    for (int j = 0; j < 16; ++j) w[j] = w2[j * 256 + k];
    const float bias = gb[k];
#pragma unroll
    for (int i = 0; i < 8; ++i) {
        const bf16* gp = P + (row0 + seg * 8 + i) * NP + C_GLR + dir * 16;
        const v4u a = *(const v4u*)gp, b = *(const v4u*)(gp + 8);
        float z = bias;
        z += bflo(a.x) * w[0] + bfhi(a.x) * w[1] + bflo(a.y) * w[2] + bfhi(a.y) * w[3] + bflo(a.z) * w[4] + bfhi(a.z) * w[5] + bflo(a.w) * w[6] + bfhi(a.w) * w[7];
        z += bflo(b.x) * w[8] + bfhi(b.x) * w[9] + bflo(b.y) * w[10] + bfhi(b.y) * w[11] + bflo(b.z) * w[12] + bfhi(b.z) * w[13] + bflo(b.w) * w[14] + bfhi(b.w) * w[15];
        gl[i] = (fminf(z, 0.f) - log1pf(expf(-fabsf(z)))) * (1.f / 16.f);
    }
}
__device__ __forceinline__ float lscan(const float (&gl)[8], int dir, float (&loc)[8]) {
    float run = 0.f;
    if (dir == 0) {
#pragma unroll
        for (int i = 0; i < 8; ++i) { run += gl[i]; loc[i] = run; }
    } else {
#pragma unroll
        for (int i = 7; i >= 0; --i) { run += gl[i]; loc[i] = run; }
    }
    return run;
}
__device__ __forceinline__ void stage_tile_bf16(const bf16* src, size_t pitch, char* tile, int tid) {
    const int sr = tid >> 4, sc = (tid & 15) * 8;
    const bf16x8 a = *reinterpret_cast<const bf16x8*>(src + (size_t)sr * pitch + sc), b = *reinterpret_cast<const bf16x8*>(src + (size_t)(32 + sr) * pitch + sc);
    *(bf16x8*)(tile + att::v_st(sr, sc)) = a; *(bf16x8*)(tile + att::v_st(32 + sr, sc)) = b;
}
__device__ __forceinline__ void stage_tile_f32(const float* src, char* tile, int tid) {
    const int sr = tid >> 4, sc = (tid & 15) * 8;
#pragma unroll
    for (int t = 0; t < 2; ++t) { const int row = sr + 32 * t; const f32x4 x = *(const f32x4*)(src + row * 128 + sc), y = *(const f32x4*)(src + row * 128 + sc + 4);
        u32x4 w = {att::cvtpk(x[0], x[1]), att::cvtpk(x[2], x[3]), att::cvtpk(y[0], y[1]), att::cvtpk(y[2], y[3])};
        *(u32x4*)(tile + att::v_st(row, sc)) = w; }
}
__device__ __forceinline__ void pv_sel(int d0, f32x16& o, int vb, bf16x8 a0, bf16x8 a1, bf16x8 a2, bf16x8 a3) {
    switch (d0) { case 0: att::pv_one<0>(o, vb, a0, a1, a2, a3); break; case 1: att::pv_one<1>(o, vb, a0, a1, a2, a3); break;
                  case 2: att::pv_one<2>(o, vb, a0, a1, a2, a3); break; default: att::pv_one<3>(o, vb, a0, a1, a2, a3); break; }
}
__device__ __forceinline__ void afrag4(const char* img, int row, int hi, bf16x8 (&a)[4]) {
#pragma unroll
    for (int s = 0; s < 4; ++s) a[s] = *reinterpret_cast<const bf16x8*>(img + KSWZ64(row, (s * 16 + hi * 8) * 2));
}
__device__ __forceinline__ void st_sw(char* img, int row, int col, float v) { *(unsigned short*)(img + KSWZ64(row, col * 2)) = (unsigned short)(att::cvtpk(v, 0.f) & 0xffffu); }
}

constexpr size_t WS_OG = WS_DS;
struct GlaPre { unsigned g; unsigned short q[8], k[8]; att::bf16x8 v0, v1; };
__device__ __forceinline__ void gla_prefetch(GlaPre& R, const bf16* P_, size_t row0, int h, int dir, int k, int seg, int tid) {
    const GAS bf16* P = (const GAS bf16*)P_;
    R.g = *(const GAS unsigned*)(P + (row0 + seg * 8 + (k >> 3)) * NP + C_GLR + dir * 16 + (k & 7) * 2);
#pragma unroll
    for (int i = 0; i < 8; ++i) { const GAS bf16* rp = P + (row0 + seg * 8 + i) * NP; R.q[i] = rp[C_GQ + h * 64 + k]; R.k[i] = rp[C_GK + h * 64 + k]; }
    const int sr = tid >> 4, sc = (tid & 15) * 8;
    R.v0 = *(const GAS att::bf16x8*)(P + (row0 + sr) * NP + C_GV + h * 128 + sc); R.v1 = *(const GAS att::bf16x8*)(P + (row0 + 32 + sr) * NP + C_GV + h * 128 + sc);
}
__device__ __forceinline__ void gla_chain(Frame& F, int l, int chain) {
    const int b = chain >> 3, h = (chain >> 1) & 3, dir = chain & 1;
    const bf16* P = (const bf16*)(F.ws + WS_PROJ); bf16* OG = (bf16*)(F.ws + WS_OG) + (size_t)dir * M * 512;
    char* lds = (char*)F.lds; char* Vt = lds; char* St = lds + 16384; char* KtT = lds + 32768; char* Kt = lds + 40960; char* Qt = lds + 49152; char* Qh = lds + 57344;
    float* T = (float*)(lds + 65536); float* Dec = (float*)(lds + 67584);
    const int k = F.lane, seg = F.tid >> 6, r32 = F.lane & 31, hi = F.lane >> 5, mt = F.wave >> 2, d0 = F.wave & 3;
    const int vbV = (int)(uintptr_t)Vt + att::v_rd_base(F.lane), vbS = (int)(uintptr_t)St + att::v_rd_base(F.lane);
    const int sr = F.tid >> 4, sc = (F.tid & 15) * 8;
    float w[16];
    { const float* w2 = INP(11) + (size_t)((l * 2 + dir) * 16) * 256 + h * 64;
#pragma unroll
      for (int j = 0; j < 16; ++j) w[j] = w2[j * 256 + k]; }
    const float bias = (INP(12) + (l * 2 + dir) * 256 + h * 64)[k];
    att::f32x16 S = {};
    GlaPre R, RN;
    { const int c0 = dir == 0 ? 0 : 3; gla_prefetch(RN, P, (size_t)b * TPB + c0 * 64, h, dir, k, seg, F.tid); }
    for (int j = 0; j < NCH; ++j) {
        const int c = dir == 0 ? j : (j < 4 ? 3 - j : 39 - j);
        const size_t row0 = (size_t)b * TPB + c * 64;
        R = RN;
        if (j + 1 < NCH) { const int cn = dir == 0 ? j + 1 : (j + 1 < 4 ? 2 - j : 38 - j); gla_prefetch(RN, P, (size_t)b * TPB + cn * 64, h, dir, k, seg, F.tid); }
        float gl[8], loc[8];
#pragma unroll
        for (int i = 0; i < 8; ++i) {
            float z = bias;
#pragma unroll
            for (int d = 0; d < 8; ++d) { const unsigned s = (unsigned)__builtin_amdgcn_readlane((int)R.g, i * 8 + d); z += bflo(s) * w[2 * d] + bfhi(s) * w[2 * d + 1]; }
            gl[i] = (fminf(z, 0.f) - __logf(1.f + __expf(-fabsf(z)))) * (1.f / 16.f); }
        const float segtot = gla::lscan(gl, dir, loc);
        T[seg * 64 + k] = segtot;
        *(att::bf16x8*)(Vt + att::v_st(sr, sc)) = R.v0; *(att::bf16x8*)(Vt + att::v_st(32 + sr, sc)) = R.v1;
#pragma unroll
        for (int r = 0; r < 16; ++r) *(unsigned short*)(St + att::v_st(mt * 32 + att::crow(r, hi), d0 * 32 + r32)) = (unsigned short)(att::cvtpk(S[r], 0.f) & 0xffffu);
        __syncthreads();
        float off = 0.f, tot = 0.f;
        int sg = seg; asm volatile("" : "+v"(sg));
#pragma unroll
        for (int s = 0; s < 8; ++s) { const float t = T[s * 64 + k]; tot += t; const bool inoff = dir == 0 ? (s < sg) : (s > sg); off += inoff ? t : 0.f; }
        const float etot = __expf(tot);
        float kt[8];
#pragma unroll
        for (int i = 0; i < 8; ++i) { const int tau = seg * 8 + i; const float qv = bf2f(R.q[i]), kv = bf2f(R.k[i]); const float cc = loc[i] + off;
            const float a = fmaxf(__expf(cc), 1e-30f)  , bq = __builtin_amdgcn_rcpf(a), kb = kv * bq;
            kt[i] = kb * etot;
            gla::st_sw(Qh, tau, k, qv * a); gla::st_sw(Kt, tau, k, kb); }
        { att::u32x4 wv = {att::cvtpk(kt[0], kt[1]), att::cvtpk(kt[2], kt[3]), att::cvtpk(kt[4], kt[5]), att::cvtpk(kt[6], kt[7])};
          *(att::u32x4*)(KtT + KSWZ64(k, seg * 16)) = wv; }
        if (sg == 0) Dec[k] = etot;
        __syncthreads();
        att::f32x16 o = {};
        int tau_q = mt * 32 + r32; asm volatile("" : "+v"(tau_q));
        { att::bf16x8 qr[4]; gla::afrag4(Qh, tau_q, hi, qr);
          att::f32x16 p0, p1; att::qkt(p0, p1, (const bf16*)Kt, qr, r32, hi);
#pragma unroll
          for (int r = 0; r < 16; ++r) { const int t0 = att::crow(r, hi), t1 = 32 + t0;
              const bool k0 = dir == 0 ? (t0 <= tau_q) : (t0 >= tau_q), k1 = dir == 0 ? (t1 <= tau_q) : (t1 >= tau_q);
              p0[r] = k0 ? p0[r] : 0.f; p1[r] = k1 ? p1[r] : 0.f; }
          att::bf16x8 pa0, pa1, pa2, pa3; att::pack_p(p0, p1, pa0, pa1, pa2, pa3);
          gla::pv_sel(d0, o, vbV, pa0, pa1, pa2, pa3);
          gla::pv_sel(d0, o, vbS, qr[0], qr[1], qr[2], qr[3]); }
#pragma unroll
        for (int r = 0; r < 16; ++r) S[r] *= Dec[mt * 32 + att::crow(r, hi)];
        { att::bf16x8 a[4]; gla::afrag4(KtT, mt * 32 + r32, hi, a); gla::pv_sel(d0, S, vbV, a[0], a[1], a[2], a[3]); }
        GAS bf16* op = (GAS bf16*)(OG + row0 * 512 + h * 128 + d0 * 32 + r32);
#pragma unroll
        for (int r = 0; r < 16; ++r) op[(size_t)(mt * 32 + att::crow(r, hi)) * 512] = (bf16)(att::cvtpk(o[r], 0.f) & 0xffffu);
        __syncthreads();
    }
}
__device__ __forceinline__ void p3_mixer(Frame& F, int l) {
    refresh(F);
    for (int ch = F.blk; ch < NBATCH * 8; ch += F.G) gla_chain(F, l, ch);
    att2::attn_stream(F, l);
}
__device__ __forceinline__ void p5_merge_all(Frame& F, int l) {
    refresh(F);
    const bf16* OD = (const bf16*)(F.ws + WS_OD); const bf16* OG = (const bf16*)(F.ws + WS_OG); const bf16* P = (const bf16*)(F.ws + WS_PROJ); bf16* MRG = (bf16*)(F.ws + WS_H);
    const float lam = ((const float*)(F.ws + WS_ROPE + 16384))[l]; const float omli = 1.f - lam_init_of(l);
    const float* subln = INP(14) + l * 128; const float* onorm = INP(15) + l * 128;
    const int h = F.lane >> 4, c0 = (F.lane & 15) * 8;
    const int rpw = (M + F.NGW - 1) / F.NGW, r0 = F.gw * rpw, r1 = (r0 + rpw < M) ? r0 + rpw : M;
    for (int r = r0; r < r1; ++r) {
        const v4u a = *(const v4u*)(OD + (size_t)r * DM + h * 256 + c0), bq = *(const v4u*)(OD + (size_t)r * DM + h * 256 + 128 + c0);
        const v4u gf = *(const v4u*)(OG + (size_t)r * 512 + h * 128 + c0), gbk = *(const v4u*)(OG + ((size_t)M + r) * 512 + h * 128 + c0);
        const v4u gt = *(const v4u*)(P + (size_t)r * NP + C_GG + h * 128 + c0);
        float d[8], e[8], g[8];
        d[0] = bflo(a.x) - lam * bflo(bq.x); d[1] = bfhi(a.x) - lam * bfhi(bq.x); d[2] = bflo(a.y) - lam * bflo(bq.y); d[3] = bfhi(a.y) - lam * bfhi(bq.y);
        d[4] = bflo(a.z) - lam * bflo(bq.z); d[5] = bfhi(a.z) - lam * bfhi(bq.z); d[6] = bflo(a.w) - lam * bflo(bq.w); d[7] = bfhi(a.w) - lam * bfhi(bq.w);
        e[0] = bflo(gf.x) + bflo(gbk.x); e[1] = bfhi(gf.x) + bfhi(gbk.x); e[2] = bflo(gf.y) + bflo(gbk.y); e[3] = bfhi(gf.y) + bfhi(gbk.y);
        e[4] = bflo(gf.z) + bflo(gbk.z); e[5] = bfhi(gf.z) + bfhi(gbk.z); e[6] = bflo(gf.w) + bflo(gbk.w); e[7] = bfhi(gf.w) + bfhi(gbk.w);
        g[0] = bflo(gt.x); g[1] = bfhi(gt.x); g[2] = bflo(gt.y); g[3] = bfhi(gt.y); g[4] = bflo(gt.z); g[5] = bfhi(gt.z); g[6] = bflo(gt.w); g[7] = bfhi(gt.w);
        float ss = 0.f, se = 0.f;
#pragma unroll
        for (int i = 0; i < 8; ++i) { ss += d[i] * d[i]; se += e[i] * e[i]; }
        ss = xadd<1>(ss); ss = xadd<2>(ss); ss = xadd<4>(ss); ss = xadd<8>(ss);
        se = xadd<1>(se); se = xadd<2>(se); se = xadd<4>(se); se = xadd<8>(se);
        const float sc = omli / sqrtf(ss * (1.f / 128.f) + EPS), se2 = 1.0f / sqrtf(se * (1.f / 128.f) + EPS);
#pragma unroll
        for (int i = 0; i < 8; ++i) { d[i] = d[i] * sc * subln[c0 + i]; e[i] = e[i] * se2 * onorm[c0 + i] * siluf(g[i]); }
        v4u w; w.x = pg8::cvt_pk_bf16(d[0], d[1]); w.y = pg8::cvt_pk_bf16(d[2], d[3]); w.z = pg8::cvt_pk_bf16(d[4], d[5]); w.w = pg8::cvt_pk_bf16(d[6], d[7]);
        *(v4u*)(MRG + (size_t)r * DM + h * 128 + c0) = w;
        v4u x; x.x = pg8::cvt_pk_bf16(e[0], e[1]); x.y = pg8::cvt_pk_bf16(e[2], e[3]); x.z = pg8::cvt_pk_bf16(e[4], e[5]); x.w = pg8::cvt_pk_bf16(e[6], e[7]);
        *(v4u*)(MRG + (size_t)r * DM + 512 + h * 128 + c0) = x;
    }
}

__device__ __forceinline__ float dpp_sum16(float v) {
    v += __int_as_float(__builtin_amdgcn_update_dpp(0, __float_as_int(v), 0xB1, 0xF, 0xF, true));
    v += __int_as_float(__builtin_amdgcn_update_dpp(0, __float_as_int(v), 0x4E, 0xF, 0xF, true));
    v += __int_as_float(__builtin_amdgcn_update_dpp(0, __float_as_int(v), 0x141, 0xF, 0xF, true));
    v += __int_as_float(__builtin_amdgcn_update_dpp(0, __float_as_int(v), 0x140, 0xF, 0xF, true));
    return v;
}
__device__ __forceinline__ float wave_sum2(float v) { v = dpp_sum16(v); v = xadd<16>(v); v = xadd<32>(v); return v; }
__device__ __forceinline__ float row_rinv2(const f32x4 (&v)[4]) {
    float s = 0.f;
#pragma unroll
    for (int j = 0; j < 4; ++j) s += (v[j][0] * v[j][0] + v[j][1] * v[j][1]) + (v[j][2] * v[j][2] + v[j][3] * v[j][3]);
    return __builtin_amdgcn_rsqf(wave_sum2(s) * (1.f / DM) + EPS);
}
__device__ __forceinline__ void ld_raw_bf16(const bf16* row, int lane, u32x2 (&v)[4]) {
#pragma unroll
    for (int j = 0; j < 4; ++j) v[j] = *(const u32x2*)(row + 4 * lane + 256 * j);
}
__device__ __forceinline__ void ld_raw_bf16_blk(const bf16* base, int row, int lane, u32x2 (&v)[4]) {
    const bf16* p = base + ((size_t)(row >> 4) * 32 + (lane >> 3)) * 512 + (row & 15) * 32 + (lane & 7) * 4;
#pragma unroll
    for (int j = 0; j < 4; ++j) v[j] = *(const u32x2*)(p + j * (8 * 512));
}
__device__ __forceinline__ f32x4 raw2f(u32x2 w) { return (f32x4){bflo(w.x), bfhi(w.x), bflo(w.y), bfhi(w.y)}; }
__device__ __forceinline__ void ld_vec(const float* p, int lane, f32x4 (&v)[4]) {
#pragma unroll
    for (int j = 0; j < 4; ++j) v[j] = *(const f32x4*)(p + 4 * lane + 256 * j);
}

__device__ __forceinline__ void p1_rows(Frame& F, int l) {
    refresh(F);
    const float* MOD = (const float*)(F.ws + WS_MOD);
    bf16* X = (bf16*)(F.ws + WS_X); bf16* H = (bf16*)(F.ws + WS_H); const bf16* F2 = (const bf16*)(F.ws + WS_F2);
    const int rpw = (M + F.NGW - 1) / F.NGW, r0 = F.gw * rpw, r1 = (r0 + rpw < M) ? r0 + rpw : M;
    if (r0 >= r1) return;
    const bool two = l > 0 && ((l - 1) & 1);
    f32x4 gpre[4], gpost[4], sh[4], sc[4], gt[4];
    ld_vec(INP(6) + l * DM, F.lane, gpre);
    if (l > 0) ld_vec(INP(9) + (l - 1) * DM, F.lane, gpost);
    int cur = -1;
    f32x4 xn[4]; u32x2 xr[4], fn[4], gn[4];
#define P1_ISSUE(r) do { const int b_ = (r) / TPB, p_ = (r) % TPB; \
        if (l == 0) ld_row_f32(p_ < CTX ? INP(2) + ((size_t)b_ * CTX + p_) * DM : INP(0) + ((size_t)b_ * SEQ + (p_ - CTX)) * DM, F.lane, xn); \
        else ld_raw_bf16(X + (size_t)(r) * DM, F.lane, xr); \
        if (l > 0) { ld_raw_bf16(F2 + (size_t)(r) * DM, F.lane, fn); if (two) ld_raw_bf16(F2 + ((size_t)M + (r)) * DM, F.lane, gn); } } while (0)
    P1_ISSUE(r0);
    for (int r = r0; r < r1; ++r) {
        f32x4 x[4]; u32x2 fr[4], gr[4];
#pragma unroll
        for (int j = 0; j < 4; ++j) { x[j] = (l == 0) ? xn[j] : raw2f(xr[j]); fr[j] = fn[j]; gr[j] = gn[j]; }
        if (r + 1 < r1) P1_ISSUE(r + 1);
        const int b = r / TPB, p = r % TPB, mrow = p < CTX ? 16 : b;
        if (mrow != cur) { cur = mrow; const float* modp = MOD + ((size_t)l * 17 + mrow) * 6144; ld_vec(modp, F.lane, sh); ld_vec(modp + 1024, F.lane, sc);
            if (l > 0) ld_vec(MOD + ((size_t)(l - 1) * 17 + mrow) * 6144 + 5 * 1024, F.lane, gt); }
        if (l > 0) {
            f32x4 f[4];
#pragma unroll
            for (int j = 0; j < 4; ++j) { f[j] = raw2f(fr[j]); if (two) f[j] = f[j] + raw2f(gr[j]); }
            const float rinv = row_rinv2(f);
#pragma unroll
            for (int j = 0; j < 4; ++j) x[j] = x[j] + gt[j] * (f[j] * rinv * gpost[j]);
        }
        st_row_bf16(X + (size_t)r * DM, F.lane, x);
        const float rinv = row_rinv2(x);
        f32x4 h[4];
#pragma unroll
        for (int j = 0; j < 4; ++j) h[j] = (x[j] * rinv * gpre[j]) * (sc[j] + 1.0f) + sh[j];
        st_row_bf16(H + (size_t)r * DM, F.lane, h);
    }
#undef P1_ISSUE
}
__device__ __forceinline__ void pf_final(Frame& F) {
    refresh(F);
    const float* MOD = (const float*)(F.ws + WS_MOD);
    const bf16* X = (const bf16*)(F.ws + WS_X); const bf16* F2 = (const bf16*)(F.ws + WS_F2);
    const int l = DEPTH - 1, NR = NBATCH * SEQ;
    const int rpw = (NR + F.NGW - 1) / F.NGW, i0 = F.gw * rpw, i1 = (i0 + rpw < NR) ? i0 + rpw : NR;
    if (i0 >= i1) return;
    f32x4 gpost[4], gt[4]; ld_vec(INP(9) + l * DM, F.lane, gpost);
    int cur = -1;
    u32x2 xn[4], fn[4], gn[4];
#define PF_ISSUE(i) do { const size_t r_ = (size_t)((i) / SEQ) * TPB + CTX + (i) % SEQ; ld_raw_bf16(X + r_ * DM, F.lane, xn); ld_raw_bf16(F2 + r_ * DM, F.lane, fn); ld_raw_bf16(F2 + ((size_t)M + r_) * DM, F.lane, gn); } while (0)
    PF_ISSUE(i0);
    for (int i = i0; i < i1; ++i) {
        f32x4 x[4], f[4];
#pragma unroll
        for (int j = 0; j < 4; ++j) { x[j] = raw2f(xn[j]); f[j] = raw2f(fn[j]) + raw2f(gn[j]); }
        if (i + 1 < i1) PF_ISSUE(i + 1);
        const int b = i / SEQ;
        if (b != cur) { cur = b; ld_vec(MOD + ((size_t)l * 17 + b) * 6144 + 5 * 1024, F.lane, gt); }
        const float rinv = row_rinv2(f);
#pragma unroll
        for (int j = 0; j < 4; ++j) x[j] = x[j] + gt[j] * (f[j] * rinv * gpost[j]);
        st_row_f32(F.A->out + (size_t)i * DM, F.lane, x);
    }
#undef PF_ISSUE
}
__device__ __forceinline__ void p7_rows(Frame& F, int l) {
    refresh(F);
    const float* MOD = (const float*)(F.ws + WS_MOD);
    bf16* X = (bf16*)(F.ws + WS_X); const bf16* Y = (const bf16*)(F.ws + WS_Y); bf16* H2 = (bf16*)(F.ws + WS_H2);
    const bool moe = l & 1; const int li = l >> 1;
    int* TOPE = (int*)(F.ws + WS_TOPE); int* LIDX = (int*)(F.ws + WS_LIDX); float* TOPW = (float*)(F.ws + WS_TOPW); int* BLKB = (int*)(F.ws + WS_BLKB);
    volatile LAS unsigned* LCNT = F.MISC + 16;
    LAS float* RT = (LAS float*)F.lds;
    if (moe) {
        const float* router = INP(20) + (size_t)li * DM * NE;
        if (F.tid < 8) LCNT[F.tid] = 0u;
        for (int i = F.tid; i < DM * NE / 4; i += 512) { const f32x4 q = *(const f32x4*)(router + 4 * i); const int c = i >> 1, e0 = (i & 1) * 4;
            RT[(e0 + 0) * DM + c] = q[0]; RT[(e0 + 1) * DM + c] = q[1]; RT[(e0 + 2) * DM + c] = q[2]; RT[(e0 + 3) * DM + c] = q[3]; }
        __syncthreads();
    }
    const bool lastl = (l == DEPTH - 1); const int NR = lastl ? NBATCH * SEQ : M;
#define P7_ROW(i) (lastl ? ((i) / SEQ) * TPB + CTX + (i) % SEQ : (i))
    const int rpw = (NR + F.NGW - 1) / F.NGW, r0 = F.gw * rpw, r1 = (r0 + rpw < NR) ? r0 + rpw : NR;
    if (r0 < r1) {
        f32x4 gpost[4], gpre[4], gt[4], sh[4], sc[4];
        ld_vec(INP(7) + l * DM, F.lane, gpost); ld_vec(INP(8) + l * DM, F.lane, gpre);
        int cur = -1;
        u32x2 xn[4], yn[4];
        ld_raw_bf16(X + (size_t)P7_ROW(r0) * DM, F.lane, xn); ld_raw_bf16_blk(Y, P7_ROW(r0), F.lane, yn);
        for (int ri = r0; ri < r1; ++ri) {
            const int r = P7_ROW(ri);
            f32x4 x[4], y[4];
#pragma unroll
            for (int j = 0; j < 4; ++j) { x[j] = raw2f(xn[j]); y[j] = raw2f(yn[j]); }
            if (ri + 1 < r1) { const int rn = P7_ROW(ri + 1); ld_raw_bf16(X + (size_t)rn * DM, F.lane, xn); ld_raw_bf16_blk(Y, rn, F.lane, yn); }
            const int b = r / TPB, p = r % TPB, mrow = p < CTX ? 16 : b;
            if (mrow != cur) { cur = mrow; const float* modp = MOD + ((size_t)l * 17 + mrow) * 6144; ld_vec(modp + 2 * 1024, F.lane, gt); ld_vec(modp + 3 * 1024, F.lane, sh); ld_vec(modp + 4 * 1024, F.lane, sc); }
            const float ry = row_rinv2(y);
#pragma unroll
            for (int j = 0; j < 4; ++j) x[j] = x[j] + gt[j] * (y[j] * ry * gpost[j]);
            st_row_bf16(X + (size_t)r * DM, F.lane, x);
            const float rx = row_rinv2(x);
            f32x4 h[4];
#pragma unroll
            for (int j = 0; j < 4; ++j) h[j] = (x[j] * rx * gpre[j]) * (sc[j] + 1.0f) + sh[j];
            if constexpr (FFN_F8) {
#pragma unroll
                for (int j = 0; j < 4; ++j) *(unsigned*)((unsigned char*)H2 + (size_t)r * DM + 4 * F.lane + 256 * j) = pk4_f8(h[j][0], h[j][1], h[j][2], h[j][3]);
            } else st_row_bf16(H2 + (size_t)r * DM, F.lane, h);
            if (moe) {
                float lg[8];
#pragma unroll
                for (int e = 0; e < 8; ++e) lg[e] = 0.f;
#pragma unroll
                for (int j = 0; j < 4; ++j)
#pragma unroll
                    for (int e = 0; e < 8; ++e) { const f32x4 q = *(const LAS f32x4*)(RT + e * DM + 4 * F.lane + 256 * j); lg[e] += (h[j][0] * q[0] + h[j][1] * q[1]) + (h[j][2] * q[2] + h[j][3] * q[3]); }
#pragma unroll
                for (int e = 0; e < 8; ++e) lg[e] = wave_sum2(lg[e]);
                int e0 = 0; float v0 = lg[0];
#pragma unroll
                for (int e = 1; e < 8; ++e) if (lg[e] > v0) { v0 = lg[e]; e0 = e; }
                int e1 = -1; float v1 = -3.0e38f;
#pragma unroll
                for (int e = 0; e < 8; ++e) if (e != e0 && lg[e] > v1) { v1 = lg[e]; e1 = e; }
                const float ex = __expf(v1 - v0), w0 = 1.f / (1.f + ex), w1 = ex / (1.f + ex);
                if (F.lane == 0) {
                    const unsigned i0 = __hip_atomic_fetch_add((LAS unsigned*)&LCNT[e0], 1u, __ATOMIC_RELAXED, __HIP_MEMORY_SCOPE_WORKGROUP), i1 = __hip_atomic_fetch_add((LAS unsigned*)&LCNT[e1], 1u, __ATOMIC_RELAXED, __HIP_MEMORY_SCOPE_WORKGROUP);
                    TOPE[r] = e0 | (e1 << 8); LIDX[2 * r] = (int)i0; LIDX[2 * r + 1] = (int)i1; TOPW[2 * r] = w0; TOPW[2 * r + 1] = w1;
                }
            }
        }
    }
    if (moe) {
        __syncthreads();
        if (F.tid < 8) { const unsigned base = __hip_atomic_fetch_add((unsigned*)((gu32*)F.ws + CW_CNT + 64 * li + F.tid), LCNT[F.tid], __ATOMIC_RELAXED, __HIP_MEMORY_SCOPE_AGENT); BLKB[F.blk * 8 + F.tid] = (int)base; }
    }
#undef P7_ROW
}
__device__ __forceinline__ void moe_offsets(Frame& F, int li, int (&cnt)[8], int (&off)[9]) {
    off[0] = 0;
#pragma unroll
    for (int e = 0; e < 8; ++e) { cnt[e] = (int)__hip_atomic_load((unsigned*)(((gu32*)F.ws) + CW_CNT + 64 * li + e), __ATOMIC_RELAXED, __HIP_MEMORY_SCOPE_AGENT); off[e + 1] = off[e] + ((cnt[e] + 255) & ~255); }
}
__device__ __forceinline__ void p7b_gather(Frame& F, int l) {
    refresh(F);
    const int li = l >> 1; int cnt[8], off[9]; moe_offsets(F, li, cnt, off);
    const bf16* H2 = (const bf16*)(F.ws + WS_H2); bf16* HG = (bf16*)(F.ws + WS_HG);
    const int* TOPE = (const int*)(F.ws + WS_TOPE); const int* LIDX = (const int*)(F.ws + WS_LIDX); const float* TOPW = (const float*)(F.ws + WS_TOPW); const int* BLKB = (const int*)(F.ws + WS_BLKB);
    int* RMAP = (int*)(F.ws + WS_RMAP); float* ROWW = (float*)(F.ws + WS_ROWW);
    constexpr int RB = FFN_F8 ? DM : 2 * DM, LB = RB / 64;
    const unsigned char* H2b = (const unsigned char*)H2; unsigned char* HGb = (unsigned char*)HG;
    const bool lastl = (l == DEPTH - 1); const int NR = lastl ? NBATCH * SEQ : M;
    const int rpw = (NR + F.NGW - 1) / F.NGW, r0 = F.gw * rpw, r1 = (r0 + rpw < NR) ? r0 + rpw : NR;
    for (int ri = r0; ri < r1; ++ri) {
        const int r = lastl ? (ri / SEQ) * TPB + CTX + ri % SEQ : ri;
        const int te = TOPE[r];
        v4u a, bq = {0u, 0u, 0u, 0u}; a = *(const v4u*)(H2b + (size_t)r * RB + F.lane * LB); if constexpr (!FFN_F8) bq = *(const v4u*)(H2b + (size_t)r * RB + F.lane * LB + 16);
#pragma unroll
        for (int s = 0; s < 2; ++s) {
            const int e = (te >> (8 * s)) & 0xff;
            int o = 0;
#pragma unroll
            for (int q = 0; q < 8; ++q) o = (q == e) ? off[q] : o;
            const int pos = o + BLKB[F.blk * 8 + e] + LIDX[2 * r + s];
            *(v4u*)(HGb + (size_t)pos * RB + F.lane * LB) = a; if constexpr (!FFN_F8) *(v4u*)(HGb + (size_t)pos * RB + F.lane * LB + 16) = bq;
            if (F.lane == 0) { RMAP[pos] = r | (s << 30); ROWW[pos] = TOPW[2 * r + s]; }
        }
    }
#pragma unroll
    for (int e = 0; e < 8; ++e) {
        const int npad = off[e + 1] - off[e] - cnt[e];
        for (int i = F.gw; i < npad; i += F.NGW) { const int pos = off[e] + cnt[e] + i; const unsigned zz = (unsigned)F.z; const v4u z = {zz, zz, zz, zz};
            *(v4u*)(HGb + (size_t)pos * RB + F.lane * LB) = z; if constexpr (!FFN_F8) *(v4u*)(HGb + (size_t)pos * RB + F.lane * LB + 16) = z;
            if (F.lane == 0) { RMAP[pos] = -1; ROWW[pos] = 0.f; } }
    }
}

__global__ void __launch_bounds__(NWAVES * 64, 2) mk_fwd(Args args) {
    extern __shared__ __attribute__((aligned(16))) unsigned char lds[];
    Frame F;
    F.lds = (LAS unsigned char*)lds;
    F.MISC = (volatile LAS unsigned*)(F.lds + MISC_OFF);
    F.tid = threadIdx.x; F.lane = F.tid & 63; F.wave = __builtin_amdgcn_readfirstlane(F.tid >> 6); F.wv = F.wave;
    F.G = gridDim.x; F.blk = blockIdx.x; F.gw = F.blk * NWAVES + F.wave; F.NGW = F.G * NWAVES;
    F.ws = args.ws;
    F.A = &args;
    for (int u = F.tid; u < 128; u += NWAVES * 64) F.MISC[u] = 0u;
    __syncthreads();
    { XcdBarrier b0 = xcd_barrier_post((unsigned*)F.ws + CW_BAR, F.MISC + 8); (void)b0; }
#define GRID_BAR() do { XcdBarrier b_; b_.bar = (unsigned*)F.ws + CW_BAR; b_.x = xb_xcc_id(); b_.st = F.MISC + 8; refresh(F); xcd_barrier(b_, F.tid == 0); } while (0)

    p0_mod(F); p0_misc(F); convert_weights(F, 0);
    GRID_BAR();
    for (int l = 0; l < DEPTH; ++l) {
        const bool moe = l & 1; const int li = l >> 1;
        { unsigned char* wsp = args.ws; asm volatile("" : "+s"(wsp)); F.ws = wsp; }
        p1_rows(F, l);
        if (l > 0) convert_weights(F, l);
        GRID_BAR();
        {
            refresh(F);
            pg8::Gemm g{(const pg8::bf16_t*)(F.ws + WS_H), (const pg8::bf16_t*)(F.ws + WS_WIN), M, NP, DM};
            pg8::StaticOrder S; S.init(M, NP, F.G, F.blk);
            pg8::EpiProj E{(pg8::bf16_t*)(F.ws + WS_PROJ), (const float*)(F.ws + WS_ROPE), (const float*)(F.ws + WS_ROPE) + 1024, (unsigned*)F.ws + CW_KMX + 256 * l};
            pg8::gemm_phase<pg8::EpiProj, pg8::StaticOrder, true, true>(F.lds, g, S, E, F.wave);
        }
        GRID_BAR();
        p3_mixer(F, l);
        GRID_BAR();
        p5_merge_all(F, l);
        GRID_BAR();
        {
            refresh(F);
            pg8::Gemm g{(const pg8::bf16_t*)(F.ws + WS_H), (const pg8::bf16_t*)(F.ws + WS_WOUT), M, DM, DM};
            const int lastl = (l == DEPTH - 1);
            pg8::LatOrder S; S.S.init(lastl ? NBATCH * SEQ : M, DM, F.G, F.blk); S.lat = lastl;
            pg8::EpiF32 E{(pg8::bf16_t*)(F.ws + WS_Y)};
            pg8::gemm_phase<pg8::EpiF32, pg8::LatOrder, true, true>(F.lds, g, S, E, F.wave);
        }
        GRID_BAR();
        p7_rows(F, l);
        GRID_BAR();
        if (moe) { p7b_gather(F, l); GRID_BAR(); }
        int ntiles = M / 256;
        {
            refresh(F);
            LAS int* texp = (LAS int*)(F.lds + TEXP_OFF);
            if (moe) { int cnt[8], off[9]; moe_offsets(F, li, cnt, off); ntiles = off[8] >> 8;
                for (int t = F.tid; t < ntiles; t += 512) { int e = 0;
#pragma unroll
                    for (int q = 1; q < 8; ++q) e += ((t << 8) >= off[q]) ? 1 : 0;
                    texp[t] = e; } }
            else { for (int t = F.tid; t < ntiles; t += 512) texp[t] = 0; }
            __syncthreads();
        }
        {
            refresh(F);
            pg8::Gemm g{(const pg8::bf16_t*)(F.ws + (moe ? WS_HG : WS_H2)), (const pg8::bf16_t*)(F.ws + WS_WUP), ntiles * 256, 2 * DFF, FFN_F8 ? DM / 2 : DM};
            pg8::GroupedOrder S; S.S.init(ntiles * 256, 2 * DFF, F.G, F.blk); S.texp = (const LAS int*)(F.lds + TEXP_OFF); S.nN = 22;
            pg8::EpiSwiglu E{(pg8::bf16_t*)(F.ws + WS_U)};
            pg8::gemm_phase<pg8::EpiSwiglu, pg8::GroupedOrder, true, true, FFN_F8 != 0>(F.lds, g, S, E, F.wave);
        }
        GRID_BAR();
        {
            refresh(F);
            pg8::Gemm g{(const pg8::bf16_t*)(F.ws + WS_U), (const pg8::bf16_t*)(F.ws + WS_WDN), ntiles * 256, DM, FFN_F8 ? DFF / 2 : DFF};
            pg8::GroupedOrder S; S.S.init(ntiles * 256, DM, F.G, F.blk); S.texp = (const LAS int*)(F.lds + TEXP_OFF); S.nN = 4;
            pg8::EpiDown E{(pg8::bf16_t*)(F.ws + WS_F2), (const int*)(F.ws + WS_RMAP), (const float*)(F.ws + WS_ROWW), moe ? 0 : 1};
            pg8::gemm_phase<pg8::EpiDown, pg8::GroupedOrder, true, true, FFN_F8 != 0>(F.lds, g, S, E, F.wave);
        }
        GRID_BAR();
    }
    pf_final(F);
}

extern "C" void kernel_launch(void* const* d_in, const int* in_sizes, int n_in, void* d_out, int out_size, void* d_ws, size_t ws_size, hipStream_t stream) {
    static int grid = 0;
    if (grid == 0) {
        if (n_in != 24 || out_size != NBATCH * SEQ * DM || ws_size < WS_END) { fprintf(stderr, "kernel_launch: unexpected shapes or workspace (%d inputs, out %d, ws %zu < %zu)\n", n_in, out_size, ws_size, (size_t)WS_END); grid = -1; return; }
        int dev = 0, cus = 0, per_cu = 0;
        if (hipGetDevice(&dev) != hipSuccess || hipDeviceGetAttribute(&cus, hipDeviceAttributeMultiprocessorCount, dev) != hipSuccess) { grid = -1; return; }
        if (hipFuncSetAttribute((const void*)mk_fwd, hipFuncAttributeMaxDynamicSharedMemorySize, LDS_BYTES) != hipSuccess) { grid = -1; return; }
        if (hipOccupancyMaxActiveBlocksPerMultiprocessor(&per_cu, (const void*)mk_fwd, NWAVES * 64, LDS_BYTES) != hipSuccess || per_cu < 1) { fprintf(stderr, "kernel_launch: occupancy query says %d\n", per_cu); }
        (void)hipGetLastError();
        grid = cus;
    }
    if (grid < 0) return;
    if (hipMemsetAsync((char*)d_ws + WS_CTL, 0, CTL_ZERO_BYTES, stream) != hipSuccess) return;
    Args a{};
    for (int i = 0; i < 24; ++i) a.in[i] = (const float*)d_in[i];
    a.out = (float*)d_out; a.ws = (unsigned char*)d_ws;
    hipLaunchKernelGGL(mk_fwd, dim3(grid), dim3(NWAVES * 64), LDS_BYTES, stream, a);
}
```

```cpp
#include <hip/hip_runtime.h>
#include <cstdio>
#include <cstdint>
namespace pg8 {
#define PG8_LAS __attribute__((address_space(3)))
typedef unsigned short bf16_t;
__device__ __forceinline__ int lane_id_opaque() { int l; asm volatile("v_mbcnt_lo_u32_b32 %0, -1, 0\n\tv_mbcnt_hi_u32_b32 %0, -1, %0" : "=v"(l)); return l; }
typedef short bf16x8 __attribute__((ext_vector_type(8)));
typedef float f32x4 __attribute__((ext_vector_type(4)));
typedef unsigned u32x4 __attribute__((ext_vector_type(4)));
constexpr int BM = 256, BK = 64, HALF = 128, HTB = HALF * BK * 2  , STAGE_BYTES = 8 * HTB, NXCD = 8, WGM = 8;

__host__ __device__ __forceinline__ int lds_byte(int r, int c) { const int st = (r >> 4) * 2 + (c >> 5), rr = r & 15, cc = c & 31, ob = rr * 64 + cc * 2; return st * 1024 + (ob ^ (((ob >> 9) & 1) << 5)); }
__host__ __device__ __forceinline__ void stage_rc(int b, int& R, int& C) { const int st = b / 1024, sb = b % 1024, swz = sb ^ (((sb >> 9) & 1) << 5); R = (st >> 1) * 16 + swz / 64; C = (st & 1) * 32 + (swz % 64) / 2; }
__host__ __device__ __forceinline__ int perm32(int rho) { const int n = rho >> 4, i = rho & 15; return 8 * (i >> 2) + 4 * n + (i & 3); }

struct Unit { int pm, pn; };
struct Gemm { const bf16_t* A; const bf16_t* Bt; int M, N, K; };

struct StaticOrder {
    int nM, nN, nwg, G, c;
    __host__ __device__ void init(int M, int N, int G_, int c_) { nM = M / BM; nN = N / BM; nwg = nM * nN; G = G_; c = c_; }
    __host__ __device__ bool next(int i, Unit& u) const {
        const long L = (long)i * G + c; if (L >= nwg) return false;
        int wgid = (int)L; { const int q = nwg / NXCD, r = nwg % NXCD, xcd = wgid % NXCD, off = wgid / NXCD; wgid = (xcd < r ? xcd * (q + 1) : r * (q + 1) + (xcd - r) * q) + off; }
        const int nig = WGM * nN, gid = wgid / nig, fm = gid * WGM, gsz = (nM - fm) < WGM ? (nM - fm) : WGM;
        u.pm = fm + ((wgid % nig) % gsz); u.pn = (wgid % nig) / gsz; return true;
    }
    __device__ __forceinline__ void a_ready(const Unit&) const {}
    __device__ __forceinline__ void done(const Unit&) const {}
};

__device__ __forceinline__ unsigned cvt_pk_bf16(float lo, float hi) { unsigned r; asm volatile("v_cvt_pk_bf16_f32 %0, %1, %2" : "=v"(r) : "v"(lo), "v"(hi)); return r; }
typedef float f32x2 __attribute__((ext_vector_type(2)));
template <class Epi, class Sched, bool ALIGN_EPI = false, bool SP2 = false, bool F8 = false>
__device__ __forceinline__ void gemm_phase(PG8_LAS unsigned char* lds, const Gemm g, const Sched& S, const Epi& E, const int wv  ) {
    int tid_ = wv * 64 + lane_id_opaque();
    const int tid = tid_, wid = __builtin_amdgcn_readfirstlane(tid >> 6), lane = tid & 63, wr = wid >> 2, wc = wid & 3, fr = lane & 15, fq = lane >> 4;
    const int K = g.K, nt = K / BK;
    unsigned voffA[2], voffB[2];
#pragma unroll
    for (int i = 0; i < 2; ++i) { int R, C; stage_rc(tid * 16 + i * 8192, R, C); const int Rb = Epi::PERM ? ((R & ~31) + perm32(R & 31)) : R;
        voffA[i] = (unsigned)(R * K + C) * 2u; voffB[i] = (unsigned)(Rb * K + C) * 2u; }
    const size_t kstep = (size_t)(BK * 2);
    const size_t hstep = (size_t)HALF * K * 2;
    const size_t tstep = 2 * hstep;
    const unsigned ldsw = (unsigned)wid * 1024u;
    const int aoff = lds_byte(wr * 64 + fr, fq * 8), boff = lds_byte(wc * 32 + fr, fq * 8);
#define PG8_SA(b, h) (((b) * 2 + (h)) * HTB)
#define PG8_SB(b, h) ((4 + (b) * 2 + (h)) * HTB)
#define PG8_STAGE(bufoff, gbase, voff) do { _Pragma("unroll") for (int _i = 0; _i < 2; ++_i) \
        __builtin_amdgcn_global_load_lds((const __attribute__((address_space(1))) unsigned*)((const __attribute__((address_space(1))) char*)(gbase) + (voff)[_i]), (PG8_LAS unsigned*)(lds + (bufoff) + ldsw + _i * 8192), 16, 0, 0); } while (0)
#define PG8_LDA(dst, b, h) do { _Pragma("unroll") for (int m = 0; m < 4; ++m) _Pragma("unroll") for (int k = 0; k < 2; ++k) dst[m][k] = *(const PG8_LAS bf16x8*)(lds + PG8_SA(b, h) + aoff + m * 2048 + k * 1024); } while (0)
#define PG8_LDB(dst, b, h) do { _Pragma("unroll") for (int n = 0; n < 2; ++n) _Pragma("unroll") for (int k = 0; k < 2; ++k) dst[n][k] = *(const PG8_LAS bf16x8*)(lds + PG8_SB(b, h) + boff + n * 2048 + k * 1024); } while (0)
#define PG8_MMA(ai, bj, At, Bt) do { if constexpr (F8) __builtin_amdgcn_sched_barrier(0); __builtin_amdgcn_s_setprio(1); _Pragma("unroll") for (int m = 0; m < 4; ++m) _Pragma("unroll") for (int n = 0; n < 2; ++n) { \
        if constexpr (F8) { typedef int i32x4_ __attribute__((ext_vector_type(4))); \
            acc[ai][bj][m][n] = __builtin_amdgcn_mfma_scale_f32_16x16x128_f8f6f4(__builtin_shufflevector(__builtin_bit_cast(i32x4_, Bt[n][0]), __builtin_bit_cast(i32x4_, Bt[n][1]), 0, 1, 2, 3, 4, 5, 6, 7), \
                __builtin_shufflevector(__builtin_bit_cast(i32x4_, At[m][0]), __builtin_bit_cast(i32x4_, At[m][1]), 0, 1, 2, 3, 4, 5, 6, 7), acc[ai][bj][m][n], 0, 0, 0, 0x7f7f7f7f, 0, 0x7f7f7f7f); } \
        else { _Pragma("unroll") for (int k = 0; k < 2; ++k) acc[ai][bj][m][n] = __builtin_amdgcn_mfma_f32_16x16x32_bf16(Bt[n][k], At[m][k], acc[ai][bj][m][n], 0, 0, 0); } } \
        __builtin_amdgcn_s_setprio(0); if constexpr (F8) __builtin_amdgcn_sched_barrier(0); } while (0)
#define PG8_WAIT_V(n) asm volatile("s_waitcnt vmcnt(" #n ")" ::: "memory")
#define PG8_WAIT_L(n) asm volatile("s_waitcnt lgkmcnt(" #n ")" ::: "memory")
#define PG8_BAR __builtin_amdgcn_s_barrier()
#define PG8_SCHED __builtin_amdgcn_sched_barrier(0)
    Unit cur, nxt; int ui = 0;
    if (!S.next(0, cur)) return;
    f32x4 acc[2][2][4][2];
#pragma unroll
    for (int a = 0; a < 2; ++a)
#pragma unroll
        for (int b = 0; b < 2; ++b)
#pragma unroll
            for (int m = 0; m < 4; ++m)
#pragma unroll
                for (int n = 0; n < 2; ++n) acc[a][b][m][n] = (f32x4){0.f, 0.f, 0.f, 0.f};
    bf16x8 At[4][2], B0[2][2], B1[2][2];
    const char* cA = (const char*)g.A + (size_t)cur.pm * tstep; const char* cB = (const char*)g.Bt + (size_t)cur.pn * tstep;
    S.a_ready(cur);
    if constexpr (SP2) {
        PG8_STAGE(PG8_SB(0, 0), cB, voffB); PG8_STAGE(PG8_SB(0, 1), cB + hstep, voffB); PG8_STAGE(PG8_SA(0, 0), cA, voffA); PG8_STAGE(PG8_SA(0, 1), cA + hstep, voffA);
        if (wr == 1) PG8_BAR;
        PG8_WAIT_V(2); PG8_BAR;
        PG8_STAGE(PG8_SB(1, 0), cB + kstep, voffB); PG8_STAGE(PG8_SA(1, 0), cA + kstep, voffA); PG8_STAGE(PG8_SB(1, 1), cB + hstep + kstep, voffB);
        PG8_WAIT_V(6); PG8_BAR;
    } else {
        PG8_STAGE(PG8_SB(0, 0), cB, voffB); PG8_STAGE(PG8_SA(0, 0), cA, voffA); PG8_STAGE(PG8_SB(0, 1), cB + hstep, voffB); PG8_STAGE(PG8_SA(0, 1), cA + hstep, voffA);
        if (wr == 1) PG8_BAR;
        PG8_WAIT_V(4); PG8_BAR;
        PG8_STAGE(PG8_SB(1, 0), cB + kstep, voffB); PG8_STAGE(PG8_SA(1, 0), cA + kstep, voffA); PG8_STAGE(PG8_SB(1, 1), cB + hstep + kstep, voffB);
        PG8_WAIT_V(6); PG8_BAR;
    }
    for (;;) {
        const bool has_next = S.next(ui + 1, nxt);
        const char* nA = has_next ? (const char*)g.A + (size_t)nxt.pm * tstep : cA; const char* nB = has_next ? (const char*)g.Bt + (size_t)nxt.pn * tstep : cB;
        for (int t = 0; t < nt; t += 2) {
            const bool last = (t == nt - 2);
            const char* a1 = cA + (size_t)(t + 1) * kstep;
            const char* a2 = last ? nA : cA + (size_t)(t + 2) * kstep; const char* b2 = last ? nB : cB + (size_t)(t + 2) * kstep;
            const char* a3 = a2 + kstep; const char* b3 = b2 + kstep;
            if (last && has_next) S.a_ready(nxt);
            if constexpr (SP2) {
            PG8_LDB(B0, 0, 0); PG8_LDB(B1, 0, 1); PG8_SCHED; PG8_LDA(At, 0, 0); PG8_STAGE(PG8_SA(1, 1), a1 + hstep, voffA);
            PG8_WAIT_V(8); PG8_WAIT_L(0); PG8_BAR; PG8_MMA(0, 0, At, B0); PG8_MMA(0, 1, At, B1); PG8_BAR; PG8_SCHED;
            PG8_LDA(At, 0, 1); PG8_STAGE(PG8_SB(0, 0), b2, voffB); PG8_STAGE(PG8_SB(0, 1), b2 + hstep, voffB); PG8_STAGE(PG8_SA(0, 0), a2, voffA);
            PG8_WAIT_V(8); PG8_WAIT_L(0); PG8_BAR; PG8_MMA(1, 0, At, B0); PG8_MMA(1, 1, At, B1); PG8_BAR; PG8_SCHED;
            PG8_LDB(B0, 1, 0); PG8_LDB(B1, 1, 1); PG8_SCHED; PG8_LDA(At, 1, 0); PG8_STAGE(PG8_SA(0, 1), a2 + hstep, voffA);
            PG8_WAIT_V(8); PG8_WAIT_L(0); PG8_BAR; PG8_MMA(0, 0, At, B0); PG8_MMA(0, 1, At, B1); PG8_BAR; PG8_SCHED;
            PG8_LDA(At, 1, 1); PG8_STAGE(PG8_SB(1, 0), b3, voffB); PG8_STAGE(PG8_SB(1, 1), b3 + hstep, voffB); PG8_STAGE(PG8_SA(1, 0), a3, voffA);
            PG8_WAIT_V(8); PG8_WAIT_L(0); PG8_BAR; PG8_MMA(1, 0, At, B0); PG8_MMA(1, 1, At, B1); PG8_BAR; PG8_SCHED;
            } else {
            PG8_LDB(B0, 0, 0); PG8_SCHED; PG8_LDA(At, 0, 0); PG8_STAGE(PG8_SA(1, 1), a1 + hstep, voffA);
            PG8_WAIT_L(8); PG8_BAR; PG8_WAIT_L(0); PG8_MMA(0, 0, At, B0); PG8_BAR; PG8_SCHED;
            PG8_LDB(B1, 0, 1); PG8_STAGE(PG8_SB(0, 0), b2, voffB);
            PG8_BAR; PG8_WAIT_L(0); PG8_MMA(0, 1, At, B1); PG8_BAR;
            PG8_LDA(At, 0, 1); PG8_STAGE(PG8_SA(0, 0), a2, voffA);
            PG8_BAR; PG8_WAIT_L(0); PG8_MMA(1, 0, At, B0); PG8_BAR; PG8_SCHED;
            PG8_STAGE(PG8_SB(0, 1), b2 + hstep, voffB);
            PG8_WAIT_V(6); PG8_BAR; PG8_MMA(1, 1, At, B1); PG8_BAR;
            PG8_LDB(B0, 1, 0); PG8_SCHED; PG8_LDA(At, 1, 0); PG8_STAGE(PG8_SA(0, 1), a2 + hstep, voffA);
            PG8_WAIT_L(8); PG8_BAR; PG8_WAIT_L(0); PG8_MMA(0, 0, At, B0); PG8_BAR; PG8_SCHED;
            PG8_LDB(B1, 1, 1); PG8_STAGE(PG8_SB(1, 0), b3, voffB);
            PG8_BAR; PG8_WAIT_L(0); PG8_MMA(0, 1, At, B1); PG8_BAR;
            PG8_LDA(At, 1, 1); PG8_STAGE(PG8_SA(1, 0), a3, voffA);
            PG8_BAR; PG8_WAIT_L(0); PG8_MMA(1, 0, At, B0); PG8_BAR; PG8_SCHED;
            PG8_STAGE(PG8_SB(1, 1), b3 + hstep, voffB);
            PG8_WAIT_V(6); PG8_BAR; PG8_MMA(1, 1, At, B1); PG8_BAR;
            }
        }
        if constexpr (ALIGN_EPI) { if (wr == 0) PG8_BAR; }
        if constexpr (!Epi::AFTER_DRAIN) { const int t2_ = lane_id_opaque(); const int fr_ = t2_ & 15, fq_ = (t2_ & 63) >> 4;
            E(acc, cur, wr, wc, fr_, fq_); S.done(cur); }
        if (!has_next) break;
#pragma unroll
        for (int a = 0; a < 2; ++a)
#pragma unroll
            for (int b = 0; b < 2; ++b)
#pragma unroll
                for (int m = 0; m < 4; ++m)
#pragma unroll
                    for (int n = 0; n < 2; ++n) acc[a][b][m][n] = (f32x4){0.f, 0.f, 0.f, 0.f};
        cur = nxt; cA = nA; cB = nB; ++ui;
        if constexpr (ALIGN_EPI) { if (wr == 1) PG8_BAR; }
    }
    PG8_WAIT_V(0);
    if constexpr (!ALIGN_EPI) { if (wr == 0) PG8_BAR; }
    PG8_BAR;
    if constexpr (Epi::AFTER_DRAIN) { E.fused(acc, cur, wr, wc, fr, fq, lds, wid, lane); S.done(cur); }
#undef PG8_SA
#undef PG8_SB
#undef PG8_STAGE
#undef PG8_LDA
#undef PG8_LDB
#undef PG8_MMA
#undef PG8_WAIT_V
#undef PG8_WAIT_L
#undef PG8_BAR
#undef PG8_SCHED
}
}
#define GAS __attribute__((address_space(1)))
#define LAS __attribute__((address_space(3)))
typedef unsigned short bf16;
typedef unsigned v4u __attribute__((ext_vector_type(4)));
typedef float f32x4 __attribute__((ext_vector_type(4)));
typedef short bf16x8 __attribute__((ext_vector_type(8)));
typedef GAS unsigned gu32;
typedef GAS unsigned long long gu64;
#define RLX_AGENT __ATOMIC_RELAXED, __HIP_MEMORY_SCOPE_AGENT
#define LDS_WAIT() asm volatile("s_waitcnt lgkmcnt(0)" ::: "memory")
#define VM_WAIT() asm volatile("s_waitcnt vmcnt(0)" ::: "memory")
__device__ __forceinline__ unsigned long long rt() { return __builtin_amdgcn_s_memrealtime(); }
__device__ __forceinline__ unsigned f2bf(float f) { unsigned u = __builtin_bit_cast(unsigned, f); return (u + 0x7fffu + ((u >> 16) & 1u)) >> 16; }
__device__ __forceinline__ unsigned pk2(float lo, float hi) { return f2bf(lo) | (f2bf(hi) << 16); }

#define XB_TMO      128
#define XB_XCNT(j)  (256  + 64 * (j))
#define XB_XSUB(j)  (1280 + 64 * (j))
#define XB_XGEN(j)  (2304 + 64 * (j))
#define XB_TOP      3328
#define XB_TOPGEN   3392
#define XCD_BAR_WORDS 3456
#define XB_SPIN_CAP (1u << 18)

__device__ __forceinline__ unsigned xb_ld(unsigned* p)              { return __hip_atomic_load(p, __ATOMIC_RELAXED, __HIP_MEMORY_SCOPE_AGENT); }
__device__ __forceinline__ unsigned xb_add(unsigned* p, unsigned v) { return __hip_atomic_fetch_add(p, v, __ATOMIC_RELAXED, __HIP_MEMORY_SCOPE_AGENT); }
__device__ __forceinline__ unsigned xb_xcc_id() { return (unsigned)__builtin_amdgcn_s_getreg((3 << 11) | 20) & 0xFu; }
#define XB_SPIN(cond, bar) do { unsigned _sp = 0; while (cond) { __builtin_amdgcn_s_sleep(1); \
    if ((++_sp & 255u) == 0u) { if (xb_ld(&(bar)[XB_TMO])) break; if (_sp > XB_SPIN_CAP) { atomicAdd(&(bar)[XB_TMO], 1u); break; } } } } while (0)

struct XcdBarrier {
    unsigned* bar; unsigned x;
    volatile LAS unsigned* st;
};

__device__ __forceinline__ XcdBarrier xcd_barrier_post(unsigned* bar, volatile LAS unsigned* st) {
    XcdBarrier b; b.bar = bar; b.x = xb_xcc_id(); b.st = st;
    if (threadIdx.x == 0) (void)xb_add(&bar[XB_XCNT(b.x)], 1u);
    return b;
}
__device__ __forceinline__ void xcd_barrier_complete(unsigned* bar, unsigned x, unsigned& nloc, unsigned& nx) {
    const unsigned G = gridDim.x * gridDim.y * gridDim.z;
    unsigned sum, cnt, mine, sp = 0u;
    for (;;) {
        sum = 0u; cnt = 0u; mine = 0u;
#pragma unroll
        for (unsigned j = 0; j < 16; ++j) { const unsigned c = xb_ld(&bar[XB_XCNT(j)]); sum += c; cnt += (c > 0u) ? 1u : 0u; mine = (j == x) ? c : mine; }
        if (sum == G) break;
        __builtin_amdgcn_s_sleep(1);
        if ((++sp & 255u) == 0u) { if (xb_ld(&bar[XB_TMO])) break; if (sp > XB_SPIN_CAP) { atomicAdd(&bar[XB_TMO], 1u); break; } }
    }
    nloc = mine > 0u ? mine : 1u; nx = cnt > 0u ? cnt : 1u;
}

__device__ __forceinline__ void xcd_barrier(const XcdBarrier& b, const bool leader  ) {
    asm volatile("s_waitcnt vmcnt(0)" ::: "memory");
    __syncthreads();
    if (leader) {
        unsigned* bar = b.bar; asm volatile("" : "+s"(bar));
        __builtin_amdgcn_s_waitcnt(0);
        unsigned nloc = b.st[0], nx = b.st[1];
        if (nloc == 0u) { xcd_barrier_complete(bar, b.x, nloc, nx); b.st[0] = nloc; b.st[1] = nx; }
        const unsigned old = xb_add(&bar[XB_XSUB(b.x)], 1u);
        const unsigned gen = old / nloc;
        if (old + 1u == (gen + 1u) * nloc) {
            __builtin_amdgcn_fence(__ATOMIC_RELEASE, "agent");
            asm volatile("s_waitcnt vmcnt(0)" ::: "memory");
            const unsigned og = xb_add(&bar[XB_TOP], 1u);
            const unsigned tg = og / nx;
            if (og + 1u == (tg + 1u) * nx) xb_add(&bar[XB_TOPGEN], 1u);
            else XB_SPIN(xb_ld(&bar[XB_TOPGEN]) == tg, bar);
            __builtin_amdgcn_fence(__ATOMIC_ACQUIRE, "agent");
            xb_add(&bar[XB_XGEN(b.x)], 1u);
            asm volatile("s_waitcnt vmcnt(0)" ::: "memory");
        } else {
            XB_SPIN(xb_ld(&bar[XB_XGEN(b.x)]) == gen, bar);
            __builtin_amdgcn_fence(__ATOMIC_ACQUIRE, "agent");
            asm volatile("s_waitcnt vmcnt(0)" ::: "memory");
        }
    }
    __syncthreads();
}

#ifndef FFN_F8
#define FFN_F8 1
#endif
constexpr int NWAVES = 8;
constexpr float W8S = 32.f, U8S = 4.f;
constexpr int DM = 1024, NBATCH = 16, SEQ = 2048, CTX = 256, TPB = SEQ + CTX, M = NBATCH * TPB;
constexpr int DEPTH = 4, NIN = 3104, NP = 3328, DFF = 2816, NE = 8;
constexpr int MP = 2 * M + NE * 256;
constexpr int C_Q = 0, C_K = 512, C_V = 1024, C_GQ = 1536, C_GK = 1792, C_GV = 2048, C_GG = 2560, C_GLR = 3072;
constexpr float EPS = 1e-6f;
__host__ __device__ constexpr size_t poff(size_t row, int col) { return ((row >> 4) * (size_t)(NP / 32) + (size_t)(col >> 5)) * 512 + (row & 15) * 32 + (col & 31); }
constexpr float C2 = 0.125f * 1.4426950408889634f;
constexpr int NCH = TPB / 64;
constexpr int NGLA = NBATCH * 4 * 2 * NCH;

constexpr size_t MiB = 1u << 20;
constexpr size_t WS_CTL = 0, CTL_ZERO_BYTES = 1 * MiB;
constexpr size_t WS_MOD = 1 * MiB;
constexpr size_t WS_ROPE = 3 * MiB;
constexpr size_t WS_TOPE = 4 * MiB;
constexpr size_t WS_LIDX = WS_TOPE + 160 * 1024;
constexpr size_t WS_TOPW = WS_LIDX + 320 * 1024;
constexpr size_t WS_BLKB = WS_TOPW + 320 * 1024;
constexpr size_t WS_RMAP = WS_BLKB + 64 * 1024;
constexpr size_t WS_ROWW = WS_RMAP + 320 * 1024;
static_assert(WS_ROWW + 320 * 1024 <= 6 * MiB, "small tables");
constexpr size_t WS_X = 6 * MiB;
constexpr size_t WS_WIN = 150 * MiB;
constexpr size_t WS_WOUT = WS_WIN + 13 * MiB / 2;
constexpr size_t WS_WUP = WS_WOUT + 2 * MiB;
constexpr size_t WS_WDN = WS_WUP + 88 * MiB;
constexpr size_t WS_D = 291 * MiB;
static_assert(WS_WDN + 44 * MiB <= WS_D, "weights");
constexpr size_t WS_PROJ = WS_D;
constexpr size_t WS_OD = WS_D + 234 * MiB;
constexpr size_t WS_DS = WS_D + 306 * MiB;
constexpr size_t WS_DEC = WS_D + 450 * MiB;
constexpr size_t WS_H = WS_D + 452 * MiB;
constexpr size_t WS_Y = WS_D;
constexpr size_t WS_HG = WS_D;
constexpr size_t WS_F2 = WS_D;
constexpr size_t WS_U = WS_D + 148 * MiB;
constexpr size_t WS_H2 = WS_D + 483 * MiB;
constexpr size_t WS_END = WS_D + 555 * MiB;
static_assert((size_t)MP * DFF * 2 <= 407 * MiB && (size_t)MP * DM * 2 <= 148 * MiB && (size_t)M * NP * 2 <= 234 * MiB, "dynamic map");
static_assert((size_t)M * DFF * 2 + 148 * MiB <= 483 * MiB, "dense U clear of H2");

constexpr int CW_BAR = 4096;
constexpr int CW_CNT = 8192;

constexpr int RING_BYTES = 131072;
constexpr int TEXP_OFF = 139264;
constexpr int MISC_OFF = 146432 - 512;
constexpr int LDS_BYTES = 147456;

typedef unsigned u32x2 __attribute__((ext_vector_type(2)));

__device__ __forceinline__ float bf2f(unsigned short x) { return __uint_as_float((unsigned)x << 16); }
__device__ __forceinline__ float bflo(unsigned w) { return __uint_as_float(w << 16); }
__device__ __forceinline__ float bfhi(unsigned w) { return __uint_as_float(w & 0xffff0000u); }
__device__ __forceinline__ float siluf(float x) { return x * __builtin_amdgcn_rcpf(1.f + __expf(-x)); }
__device__ __forceinline__ float clamp8(float x) { return fminf(fmaxf(x, -448.f), 448.f); }
__device__ __forceinline__ unsigned pk4_f8(float a, float b, float c, float d) { unsigned w = 0u; w = __builtin_amdgcn_cvt_pk_fp8_f32(clamp8(a), clamp8(b), w, false); w = __builtin_amdgcn_cvt_pk_fp8_f32(clamp8(c), clamp8(d), w, true); return w; }
template <int MASK> __device__ __forceinline__ float xadd(float v) {
    if constexpr (MASK == 32) { const auto rr = __builtin_amdgcn_permlane32_swap(__float_as_uint(v), __float_as_uint(v), false, false); return __uint_as_float(rr[0]) + __uint_as_float(rr[1]); }
    else return v + __int_as_float(__builtin_amdgcn_ds_swizzle(__float_as_int(v), 0x1f | (MASK << 10)));
}
__device__ __forceinline__ float wave_sum(float v) {
    v = xadd<1>(v); v = xadd<2>(v); v = xadd<4>(v); v = xadd<8>(v); v = xadd<16>(v); v = xadd<32>(v);
    return v;
}

struct Args { const float* in[24]; float* out; unsigned char* ws; };
struct Frame {
    LAS unsigned char* lds;
    volatile LAS unsigned* MISC;
    int tid, lane, wave, G, blk, gw, NGW, z, wv;
    const Args* A;
    unsigned char* ws;
};


__device__ __forceinline__ void refresh(Frame& F) {
    int wv = F.wv; asm volatile("" : "+s"(wv));
    const int t = wv * 64 + pg8::lane_id_opaque();
    int bl = blockIdx.x, z = 0, gg = gridDim.x; asm volatile("" : "+s"(bl), "+s"(z), "+s"(gg));
    F.blk = bl; F.z = z; F.G = gg; F.NGW = gg * NWAVES;
    F.tid = t; F.lane = t & 63; F.wave = wv; F.gw = F.blk * NWAVES + F.wave;
}
#define INP(k) (F.A->in[(k) + F.z])
namespace pg8 {
struct EpiProj {
    static constexpr bool PERM = true, AFTER_DRAIN = false;
    bf16_t* P; const float* ropec; const float* ropes; unsigned* kmx;
    __device__ __forceinline__ void operator()(const f32x4 (&acc)[2][2][4][2], const Unit& u, int wr, int wc, int fr, int fq) const {
        const int pn = u.pn, pm = u.pm, tb = pm % 9;
        float kss[2] = {0.f, 0.f};
        const bool do_rope = (tb != 0) && (pn < 4);
        const float sc = (pn < 2) ? C2 : (pn == 6 ? 0.125f : 1.f);
        const bool st_ok_all = pn < 12;
#pragma unroll
        for (int ai = 0; ai < 2; ++ai)
#pragma unroll
            for (int m = 0; m < 4; ++m) {
                const int rit = ai * HALF + wr * 64 + m * 16 + fr;
                bf16_t* rowp = P + ((size_t)(pm * 16 + ai * 8 + wr * 4 + m) * (NP / 32) + (pn * 8 + wc)) * 512 + fr * 32 + 8 * fq;
                const int s = (tb - 1) * 256 + rit;
                const int pos = (wc & 1) ? (s & 63) : (s >> 6);
                f32x4 cs = {1.f, 1.f, 1.f, 1.f}, sn = {0.f, 0.f, 0.f, 0.f};
                if (do_rope) { cs = *(const f32x4*)(ropec + pos * 16 + 4 * fq); sn = *(const f32x4*)(ropes + pos * 16 + 4 * fq); }
#pragma unroll
                for (int bj = 0; bj < 2; ++bj) {
                    f32x4 v0 = acc[ai][bj][m][0], v1 = acc[ai][bj][m][1];
                    if (do_rope) { const f32x4 a = v0 * cs - v1 * sn, b = v0 * sn + v1 * cs; v0 = a; v1 = b; }
                    v0 = v0 * sc; v1 = v1 * sc;
                    if (pn == 2 || pn == 3) { float ss = (v0[0] * v0[0] + v0[1] * v0[1]) + (v0[2] * v0[2] + v0[3] * v0[3]) + (v1[0] * v1[0] + v1[1] * v1[1]) + (v1[2] * v1[2] + v1[3] * v1[3]);
                        ss = xadd<16>(ss); ss = xadd<32>(ss); kss[bj] = fmaxf(kss[bj], ss); }
                    if (st_ok_all || (bj == 0 && wc == 0)) {
                        u32x4 w; w.x = cvt_pk_bf16(v0[0], v0[1]); w.y = cvt_pk_bf16(v0[2], v0[3]); w.z = cvt_pk_bf16(v1[0], v1[1]); w.w = cvt_pk_bf16(v1[2], v1[3]);
                        *(u32x4*)(rowp + bj * (4 * 512)) = w;
                    }
                }
            }
        if (pn == 2 || pn == 3) {
#pragma unroll
            for (int bj = 0; bj < 2; ++bj) { float v = kss[bj];
                v = fmaxf(v, __int_as_float(__builtin_amdgcn_update_dpp(0, __float_as_int(v), 0xB1, 0xF, 0xF, true)));
                v = fmaxf(v, __int_as_float(__builtin_amdgcn_update_dpp(0, __float_as_int(v), 0x4E, 0xF, 0xF, true)));
                v = fmaxf(v, __int_as_float(__builtin_amdgcn_update_dpp(0, __float_as_int(v), 0x141, 0xF, 0xF, true)));
                v = fmaxf(v, __int_as_float(__builtin_amdgcn_update_dpp(0, __float_as_int(v), 0x140, 0xF, 0xF, true)));
                if (fr == 0 && fq == 0) { const int hh = (pn - 2) * 4 + bj * 2 + (wc >> 1);
                    __hip_atomic_fetch_max(kmx + (((pm / 9) * 8 + hh) * 2 + (wc & 1)), __float_as_uint(v), __ATOMIC_RELAXED, __HIP_MEMORY_SCOPE_AGENT); } }
        }
    }
};
struct EpiF32 {
    static constexpr bool PERM = true, AFTER_DRAIN = false;
    bf16_t* Y;
    __device__ __forceinline__ void operator()(const f32x4 (&acc)[2][2][4][2], const Unit& u, int wr, int wc, int fr, int fq) const {
#pragma unroll
        for (int ai = 0; ai < 2; ++ai)
#pragma unroll
            for (int m = 0; m < 4; ++m) {
                bf16_t* rowp = Y + ((size_t)(u.pm * 16 + ai * 8 + wr * 4 + m) * (DM / 32) + (u.pn * 8 + wc)) * 512 + fr * 32 + 8 * fq;
#pragma unroll
                for (int bj = 0; bj < 2; ++bj) { const f32x4 v0 = acc[ai][bj][m][0], v1 = acc[ai][bj][m][1];
                    u32x4 w; w.x = cvt_pk_bf16(v0[0], v0[1]); w.y = cvt_pk_bf16(v0[2], v0[3]); w.z = cvt_pk_bf16(v1[0], v1[1]); w.w = cvt_pk_bf16(v1[2], v1[3]);
                    *(u32x4*)(rowp + bj * (4 * 512)) = w; }
            }
    }
};
struct EpiSwiglu {
    static constexpr bool PERM = true, AFTER_DRAIN = false;
    bf16_t* U;
    __device__ __forceinline__ void operator()(const f32x4 (&acc)[2][2][4][2], const Unit& u, int wr, int wc, int fr, int fq) const {
        const int pnl = u.pn % 22;
        const int col0 = pnl * 128 + wc * 32 + 8 * fq;
        constexpr float ws = FFN_F8 ? 1.f / W8S : 1.f, us = FFN_F8 ? U8S : 1.f, kS = ws * ws * us, kE = -ws * 1.4426950408889634f;
        const float cE = -__builtin_log2f(kS), c1 = 1.f / kS;
#pragma unroll
        for (int ai = 0; ai < 2; ++ai)
#pragma unroll
            for (int m = 0; m < 4; ++m) {
                const size_t rowi = (size_t)u.pm * BM + ai * HALF + wr * 64 + m * 16 + fr;
                f32x2 g[4], up[4], t[4], r[4];
#pragma unroll
                for (int n = 0; n < 2; ++n) { g[2 * n] = (f32x2){acc[ai][0][m][n][0], acc[ai][0][m][n][1]}; g[2 * n + 1] = (f32x2){acc[ai][0][m][n][2], acc[ai][0][m][n][3]};
                                              up[2 * n] = (f32x2){acc[ai][1][m][n][0], acc[ai][1][m][n][1]}; up[2 * n + 1] = (f32x2){acc[ai][1][m][n][2], acc[ai][1][m][n][3]}; }
#pragma unroll
                for (int q = 0; q < 4; ++q) t[q] = g[q] * kE + cE;
#pragma unroll
                for (int q = 0; q < 4; ++q) { t[q].x = __builtin_amdgcn_exp2f(t[q].x); t[q].y = __builtin_amdgcn_exp2f(t[q].y); }
#pragma unroll
                for (int q = 0; q < 4; ++q) t[q] = t[q] + c1;
#pragma unroll
                for (int q = 0; q < 4; ++q) { r[q].x = __builtin_amdgcn_rcpf(t[q].x); r[q].y = __builtin_amdgcn_rcpf(t[q].y); }
#pragma unroll
                for (int q = 0; q < 4; ++q) g[q] = (g[q] * up[q]) * r[q];
                if constexpr (FFN_F8) { u32x2 w; w.x = pk4_f8(g[0].x, g[0].y, g[1].x, g[1].y); w.y = pk4_f8(g[2].x, g[2].y, g[3].x, g[3].y); *(u32x2*)((unsigned char*)U + rowi * DFF + col0) = w; }
                else { u32x4 w; w.x = cvt_pk_bf16(g[0].x, g[0].y); w.y = cvt_pk_bf16(g[1].x, g[1].y); w.z = cvt_pk_bf16(g[2].x, g[2].y); w.w = cvt_pk_bf16(g[3].x, g[3].y); *(u32x4*)(U + rowi * DFF + col0) = w; }
            }
    }
};
struct EpiDown {
    static constexpr bool PERM = true, AFTER_DRAIN = false;
    bf16_t* F2; const int* rmap; const float* roww; int dense;
    __device__ __forceinline__ void operator()(const f32x4 (&acc)[2][2][4][2], const Unit& u, int wr, int wc, int fr, int fq) const {
        const int pnl = u.pn & 3;
        const int col0 = pnl * BM + wc * 32 + 8 * fq;
        const __amdgpu_buffer_rsrc_t rsF = __builtin_amdgcn_make_buffer_rsrc((void*)F2, 0, 2 * M * DM * 2, 0x00020000);
        const __amdgpu_buffer_rsrc_t rsM = __builtin_amdgcn_make_buffer_rsrc((void*)rmap, 0, MP * 4, 0x00020000);
        const __amdgpu_buffer_rsrc_t rsW = __builtin_amdgcn_make_buffer_rsrc((void*)roww, 0, MP * 4, 0x00020000);
#pragma unroll
        for (int ai = 0; ai < 2; ++ai)
#pragma unroll
            for (int m = 0; m < 4; ++m) {
                const int grow = u.pm * BM + ai * HALF + wr * 64 + m * 16 + fr;
                int tok = grow, slot = 0; float w = 1.f; bool ok = true;
                if (!dense) { const int rm = (int)__builtin_amdgcn_raw_buffer_load_b32(rsM, grow * 4, 0, 0); ok = rm >= 0; tok = rm & 0x3fffffff; slot = (rm >> 30) & 1; w = __uint_as_float(__builtin_amdgcn_raw_buffer_load_b32(rsW, grow * 4, 0, 0)); }
                if constexpr (FFN_F8) w *= 1.f / (W8S * U8S);
                if (ok) {
                    const int bo = ((slot * M + tok) * DM + col0) * 2;
#pragma unroll
                    for (int bj = 0; bj < 2; ++bj) {
                        const f32x4 v0 = acc[ai][bj][m][0] * w, v1 = acc[ai][bj][m][1] * w;
                        u32x4 q; q.x = cvt_pk_bf16(v0[0], v0[1]); q.y = cvt_pk_bf16(v0[2], v0[3]); q.z = cvt_pk_bf16(v1[0], v1[1]); q.w = cvt_pk_bf16(v1[2], v1[3]);
                        __builtin_amdgcn_raw_buffer_store_b128(q, rsF, bo + bj * HALF * 2, 0, 0);
                    }
                }
            }
    }
};
struct GroupedOrder {
    StaticOrder S; const PG8_LAS int* texp; int nN;
    __device__ __forceinline__ bool next(int i, Unit& u) const { if (!S.next(i, u)) return false; u.pn += __builtin_amdgcn_readfirstlane(texp[u.pm]) * nN; return true; }
    __device__ __forceinline__ void a_ready(const Unit&) const {}
    __device__ __forceinline__ void done(const Unit&) const {}
};
struct LatOrder {
    StaticOrder S; int lat;
    __device__ __forceinline__ bool next(int i, Unit& u) const { if (!S.next(i, u)) return false; if (lat) u.pm += (u.pm >> 3) + 1; return true; }
    __device__ __forceinline__ void a_ready(const Unit&) const {}
    __device__ __forceinline__ void done(const Unit&) const {}
};
}

__device__ __forceinline__ void ld_row_f32(const float* row, int lane, f32x4 (&v)[4]) {
#pragma unroll
    for (int j = 0; j < 4; ++j) v[j] = *(const f32x4*)(row + 4 * lane + 256 * j);
}
__device__ __forceinline__ void st_row_f32(float* row, int lane, const f32x4 (&v)[4]) {
#pragma unroll
    for (int j = 0; j < 4; ++j) *(f32x4*)(row + 4 * lane + 256 * j) = v[j];
}
__device__ __forceinline__ void ld_row_bf16(const bf16* row, int lane, f32x4 (&v)[4]) {
#pragma unroll
    for (int j = 0; j < 4; ++j) { const u32x2 w = *(const u32x2*)(row + 4 * lane + 256 * j); v[j] = (f32x4){bflo(w.x), bfhi(w.x), bflo(w.y), bfhi(w.y)}; }
}
__device__ __forceinline__ void st_row_bf16(bf16* row, int lane, const f32x4 (&v)[4]) {
#pragma unroll
    for (int j = 0; j < 4; ++j) { u32x2 w; w.x = pg8::cvt_pk_bf16(v[j][0], v[j][1]); w.y = pg8::cvt_pk_bf16(v[j][2], v[j][3]); *(u32x2*)(row + 4 * lane + 256 * j) = w; }
}
__device__ __forceinline__ float row_rinv(const f32x4 (&v)[4]) {
    float s = 0.f;
#pragma unroll
    for (int j = 0; j < 4; ++j) s += (v[j][0] * v[j][0] + v[j][1] * v[j][1]) + (v[j][2] * v[j][2] + v[j][3] * v[j][3]);
    return 1.0f / sqrtf(wave_sum(s) * (1.f / DM) + EPS);
}

__device__ __forceinline__ void transpose_tile(const float* W, int N, int k0, int n0, bf16* WT, int K, int drow0, LAS float* scr, int lane, bool ropeperm = false) {
    { f32x4 v[8];
#pragma unroll
      for (int j = 0; j < 8; ++j) v[j] = __builtin_nontemporal_load((const f32x4*)&W[(size_t)(k0 + 8 * j + (lane >> 3)) * N + n0 + 4 * (lane & 7)]);
#pragma unroll
      for (int j = 0; j < 8; ++j) { LAS float* d = scr + (8 * j + (lane >> 3)) * 33 + 4 * (lane & 7); d[0] = v[j][0]; d[1] = v[j][1]; d[2] = v[j][2]; d[3] = v[j][3]; } }
    LDS_WAIT(); asm volatile("" ::: "memory");
    const int c = lane & 7;
#pragma unroll
    for (int j = 0; j < 4; ++j) { const int n = (lane >> 3) + 8 * j; const LAS float* s = scr + (8 * c) * 33 + n;
        v4u o; o.x = pk2(s[0 * 33], s[1 * 33]); o.y = pk2(s[2 * 33], s[3 * 33]); o.z = pk2(s[4 * 33], s[5 * 33]); o.w = pk2(s[6 * 33], s[7 * 33]);
        const int nd = ropeperm ? (8 * ((n >> 2) & 3) + 4 * (n >> 4) + (n & 3)) : n;
        *(GAS v4u*)(WT + (size_t)(drow0 + nd) * K + k0 + 8 * c) = o; }
    LDS_WAIT(); asm volatile("" ::: "memory");
}
__device__ __forceinline__ void transpose_tile_f8(const float* W, int N, int k0, int n0, unsigned char* WT, int Kb, int drow0, LAS float* scr, int lane, float scale) {
    { f32x4 v[8];
#pragma unroll
      for (int j = 0; j < 8; ++j) v[j] = __builtin_nontemporal_load((const f32x4*)&W[(size_t)(k0 + 8 * j + (lane >> 3)) * N + n0 + 4 * (lane & 7)]);
#pragma unroll
      for (int j = 0; j < 8; ++j) { LAS float* d = scr + (8 * j + (lane >> 3)) * 33 + 4 * (lane & 7); d[0] = v[j][0]; d[1] = v[j][1]; d[2] = v[j][2]; d[3] = v[j][3]; } }
    LDS_WAIT(); asm volatile("" ::: "memory");
    const int n = lane >> 1, hf = lane & 1; const LAS float* s = scr + (hf * 32) * 33 + n;
    v4u o0, o1;
    o0.x = pk4_f8(s[0 * 33] * scale, s[1 * 33] * scale, s[2 * 33] * scale, s[3 * 33] * scale);     o0.y = pk4_f8(s[4 * 33] * scale, s[5 * 33] * scale, s[6 * 33] * scale, s[7 * 33] * scale);
    o0.z = pk4_f8(s[8 * 33] * scale, s[9 * 33] * scale, s[10 * 33] * scale, s[11 * 33] * scale);   o0.w = pk4_f8(s[12 * 33] * scale, s[13 * 33] * scale, s[14 * 33] * scale, s[15 * 33] * scale);
    o1.x = pk4_f8(s[16 * 33] * scale, s[17 * 33] * scale, s[18 * 33] * scale, s[19 * 33] * scale); o1.y = pk4_f8(s[20 * 33] * scale, s[21 * 33] * scale, s[22 * 33] * scale, s[23 * 33] * scale);
    o1.z = pk4_f8(s[24 * 33] * scale, s[25 * 33] * scale, s[26 * 33] * scale, s[27 * 33] * scale); o1.w = pk4_f8(s[28 * 33] * scale, s[29 * 33] * scale, s[30 * 33] * scale, s[31 * 33] * scale);
    GAS v4u* dst = (GAS v4u*)(WT + (size_t)(drow0 + n) * Kb + k0 + hf * 32);
    dst[0] = o0; dst[1] = o1;
    LDS_WAIT(); asm volatile("" ::: "memory");
}
__device__ __forceinline__ void convert_weights(Frame& F, int l) {
    refresh(F);
    const bool moe = l & 1; const int ne = moe ? NE : 1, li = l >> 1;
    const float* w1 = moe ? INP(21) + (size_t)li * NE * DM * DFF : INP(17) + (size_t)li * DM * DFF;
    const float* w3 = moe ? INP(22) + (size_t)li * NE * DM * DFF : INP(18) + (size_t)li * DM * DFF;
    const float* w2 = moe ? INP(23) + (size_t)li * NE * DM * DFF : INP(19) + (size_t)li * DM * DFF;
    const float* win = INP(10) + (size_t)l * DM * NIN;
    const float* wout = INP(16) + (size_t)l * DM * DM;
    bf16* WIN = (bf16*)(F.ws + WS_WIN); bf16* WOUT = (bf16*)(F.ws + WS_WOUT); bf16* WUP = (bf16*)(F.ws + WS_WUP); bf16* WDN = (bf16*)(F.ws + WS_WDN);
    LAS float* scr = (LAS float*)(F.lds + F.wave * 16384);
    const int nA = 16 * 97, nZ = NP - NIN, nB = 16 * 32, nC1 = 16 * 88, nD1 = 44 * 32;
    const int nC = ne * 2 * nC1, nD = ne * nD1, total = nA + nZ + nB + nC + nD;
    for (int it = F.gw; it < total; it += F.NGW) {
        int r = it;
        if (r < nA) { const int kb = r / 97, nb = r % 97; transpose_tile(win, NIN, 64 * kb, 32 * nb, WIN, DM, 32 * nb, scr, F.lane, nb < 32  ); continue; } r -= nA;
        if (r < nZ) { const unsigned zz = (unsigned)F.z; v4u z = {zz, zz, zz, zz}; GAS v4u* p = (GAS v4u*)(WIN + (size_t)(NIN + r) * DM) + F.lane * 2; p[0] = z; p[1] = z; continue; } r -= nZ;
        if (r < nB) { const int kb = r / 32, nb = r % 32; transpose_tile(wout, DM, 64 * kb, 32 * nb, WOUT, DM, 32 * nb, scr, F.lane); continue; } r -= nB;
        if (r < nC) { const int e = r / (2 * nC1), q = r % (2 * nC1), which = q / nC1, t = q % nC1, kb = t / 88, nb = t % 88, n0 = 32 * nb;
            const float* src = (which ? w3 : w1) + (size_t)e * DM * DFF;
            if constexpr (FFN_F8) transpose_tile_f8(src, DFF, 64 * kb, n0, (unsigned char*)WUP, DM, e * 5632 + (n0 / 128) * 256 + (n0 % 128) + which * 128, scr, F.lane, W8S);
            else transpose_tile(src, DFF, 64 * kb, n0, WUP, DM, e * 5632 + (n0 / 128) * 256 + (n0 % 128) + which * 128, scr, F.lane); continue; } r -= nC;
        { const int e = r / nD1, t = r % nD1, kb = t / 32, nb = t % 32;
            if constexpr (FFN_F8) transpose_tile_f8(w2 + (size_t)e * DFF * DM, DM, 64 * kb, 32 * nb, (unsigned char*)WDN + (size_t)e * DM * DFF, DFF, 32 * nb, scr, F.lane, W8S);
            else transpose_tile(w2 + (size_t)e * DFF * DM, DM, 64 * kb, 32 * nb, WDN + (size_t)e * DM * DFF, DFF, 32 * nb, scr, F.lane); }
    }
}

__device__ __forceinline__ void p0_mod(Frame& F) {
    refresh(F);
    LAS float* S = (LAS float*)(F.lds);
    LAS float* R = (LAS float*)(F.lds + 69632);
    const float* c = INP(1); const float* cc = INP(3); const float* wmod = INP(4); const float* bmod = INP(5);
    float* MOD = (float*)(F.ws + WS_MOD);
    for (int i = F.tid; i < 17 * 1024; i += 512) { const int b = i >> 10, k = i & 1023; const float v = b < 16 ? c[b * 1024 + k] : cc[k]; S[i] = siluf(v); }
    __syncthreads();
    const int kq = F.lane >> 4, c4 = (F.lane & 15) * 4;
    for (int item = F.blk; item < 4 * 96; item += F.G) {
        const int l = item / 96, col0 = (item % 96) * 64;
        const float* W = wmod + (size_t)l * DM * 6144;
        float acc[17][4];
#pragma unroll
        for (int b = 0; b < 17; ++b)
#pragma unroll
            for (int j = 0; j < 4; ++j) acc[b][j] = 0.f;
        for (int it0 = 0; it0 < 32; it0 += 4) {
            f32x4 w[4];
#pragma unroll
            for (int u = 0; u < 4; ++u) w[u] = __builtin_nontemporal_load((const f32x4*)(W + (size_t)(F.wave * 128 + (it0 + u) * 4 + kq) * 6144 + col0 + c4));
#pragma unroll
            for (int u = 0; u < 4; ++u) { const int k = F.wave * 128 + (it0 + u) * 4 + kq;
#pragma unroll
                for (int b = 0; b < 17; ++b) { const float s = S[b * 1024 + k];
#pragma unroll
                    for (int j = 0; j < 4; ++j) acc[b][j] += s * w[u][j]; } }
        }
#pragma unroll
        for (int b = 0; b < 17; ++b)
#pragma unroll
            for (int j = 0; j < 4; ++j) { float v = acc[b][j]; v = xadd<16>(v); v = xadd<32>(v); acc[b][j] = v; }
        if (kq == 0) {
#pragma unroll
            for (int b = 0; b < 17; ++b)
#pragma unroll
                for (int j = 0; j < 4; ++j) R[(F.wave * 17 + b) * 64 + c4 + j] = acc[b][j];
        }
        __syncthreads();
        for (int o = F.tid; o < 17 * 64; o += 512) { const int b = o >> 6, ccx = o & 63; float s = bmod[l * 6144 + col0 + ccx];
            for (int w = 0; w < 8; ++w) s += R[(w * 17 + b) * 64 + ccx];
            MOD[((size_t)l * 17 + b) * 6144 + col0 + ccx] = s; }
        __syncthreads();
    }
}
__device__ __forceinline__ float lam_init_of(int l) { return 0.8f - 0.6f * expf(-0.3f * (float)l); }
__device__ __forceinline__ void p0_misc(Frame& F) {
    refresh(F);
    float* ropec = (float*)(F.ws + WS_ROPE); float* ropes = ropec + 1024; float* lam = (float*)(F.ws + WS_ROPE + 16384);
    if (F.blk == 0) {
        for (int i = F.tid; i < 1024; i += 512) { const int pos = i >> 4, f = i & 15; const float inv = powf(10000.f, -(float)f / 16.f); const float ang = (float)pos * inv; ropec[i] = cosf(ang); ropes[i] = sinf(ang); }
    }
    if (F.blk == (1 % F.G) && F.wave < 4) {
        const int l = F.wave; const float* lv = INP(13) + l * 256;
        const float a = wave_sum(lv[F.lane] * lv[64 + F.lane]), b = wave_sum(lv[128 + F.lane] * lv[192 + F.lane]);
        if (F.lane == 0) lam[l] = expf(a) - expf(b) + lam_init_of(l);
    }
}

namespace att {
using bf16x8 = __attribute__((ext_vector_type(8))) short;
using s16x4  = __attribute__((ext_vector_type(4))) short;
using f32x16 = __attribute__((ext_vector_type(16))) float;
using u32x4  = __attribute__((ext_vector_type(4))) unsigned;
constexpr int QBLK = 32, KVBLK = 64, NW = 8, DV = 128;
constexpr float THR = 8.f;
constexpr size_t SHM_V = KVBLK * DV * 2, SHM_K = KVBLK * 64 * 2, SHM_ATTN = 2 * SHM_V + 2 * SHM_K + NW * 64 * 4;
#define KSWZ64(row, colB) ((row) * 128 + ((colB) ^ ((((row) >> 1) & 7) << 4)))
#define SBAR() __builtin_amdgcn_sched_barrier(0)
__device__ __forceinline__ int crow(int r, int hi) { return (r & 3) + 8 * (r >> 2) + 4 * hi; }
__device__ __forceinline__ unsigned cvtpk(float lo, float hi) { unsigned r; asm volatile("v_cvt_pk_bf16_f32 %0, %1, %2" : "=v"(r) : "v"(lo), "v"(hi)); return r; }
__device__ __forceinline__ void partialSM(f32x16& p0, f32x16& p1, float& m_reg, float& mn, float& alpha) {
  float pmax = p0[0];
#pragma unroll
  for (int r = 1; r < 16; ++r) pmax = fmaxf(pmax, p0[r]);
#pragma unroll
  for (int r = 0; r < 16; ++r) pmax = fmaxf(pmax, p1[r]);
  { auto rr = __builtin_amdgcn_permlane32_swap(__float_as_uint(pmax), __float_as_uint(pmax), false, false);
    pmax = fmaxf(__uint_as_float(rr[0]), __uint_as_float(rr[1])); }
  if (__builtin_expect(__all(pmax - m_reg <= THR), 1)) { mn = m_reg; alpha = 1.f; }
  else { mn = fmaxf(m_reg, pmax); alpha = __builtin_amdgcn_exp2f(m_reg - mn); m_reg = mn; }
#pragma unroll
  for (int r = 0; r < 16; ++r) p0[r] = p0[r] - mn;
#pragma unroll
  for (int r = 0; r < 16; ++r) p1[r] = p1[r] - mn;
#pragma unroll
  for (int r = 0; r < 16; ++r) p0[r] = __builtin_amdgcn_exp2f(p0[r]);
}
__device__ __forceinline__ void finishSM(f32x16& p0, f32x16& p1, float alpha, float& l_reg, bf16x8& pa0, bf16x8& pa1, bf16x8& pa2, bf16x8& pa3) {
#pragma unroll
  for (int r = 0; r < 16; ++r) p1[r] = __builtin_amdgcn_exp2f(p1[r]);
  float ps = 0;
#pragma unroll
  for (int r = 0; r < 16; ++r) ps += p0[r];
#pragma unroll
  for (int r = 0; r < 16; ++r) ps += p1[r];
  { auto rr = __builtin_amdgcn_permlane32_swap(__float_as_uint(ps), __float_as_uint(ps), false, false);
    ps = __uint_as_float(rr[0]) + __uint_as_float(rr[1]); }
  l_reg = l_reg * alpha + ps;
#define PK4(P, BASE, OUT) do { unsigned a0 = cvtpk(P[BASE + 0], P[BASE + 1]), a1 = cvtpk(P[BASE + 2], P[BASE + 3]);   \
    unsigned b0 = cvtpk(P[BASE + 4], P[BASE + 5]), b1 = cvtpk(P[BASE + 6], P[BASE + 7]);                              \
    auto r0 = __builtin_amdgcn_permlane32_swap(a0, b0, false, false); auto r1 = __builtin_amdgcn_permlane32_swap(a1, b1, false, false); \
    u32x4 w = {r0[0], r1[0], r0[1], r1[1]}; OUT = *reinterpret_cast<bf16x8*>(&w); } while (0)
  PK4(p0, 0, pa0); PK4(p0, 8, pa1); PK4(p1, 0, pa2); PK4(p1, 8, pa3);
#undef PK4
}
__device__ __forceinline__ void pack_p(const f32x16& p0, const f32x16& p1, bf16x8& pa0, bf16x8& pa1, bf16x8& pa2, bf16x8& pa3) {
#define PK4(P, BASE, OUT) do { unsigned a0 = cvtpk(P[BASE + 0], P[BASE + 1]), a1 = cvtpk(P[BASE + 2], P[BASE + 3]);   \
    unsigned b0 = cvtpk(P[BASE + 4], P[BASE + 5]), b1 = cvtpk(P[BASE + 6], P[BASE + 7]);                              \
    auto r0 = __builtin_amdgcn_permlane32_swap(a0, b0, false, false); auto r1 = __builtin_amdgcn_permlane32_swap(a1, b1, false, false); \
    u32x4 w = {r0[0], r1[0], r0[1], r1[1]}; OUT = *reinterpret_cast<bf16x8*>(&w); } while (0)
  PK4(p0, 0, pa0); PK4(p0, 8, pa1); PK4(p1, 0, pa2); PK4(p1, 8, pa3);
#undef PK4
}
__device__ __forceinline__ void qkt(f32x16& p0, f32x16& p1, const bf16* Ks, const bf16x8* qr, int r32, int hi) {
  p0 = f32x16{}; p1 = f32x16{};
#pragma unroll
  for (int d0 = 0; d0 < 4; ++d0) { int cb = (d0 * 16 + hi * 8) * 2;
    bf16x8 b0 = *reinterpret_cast<const bf16x8*>((const char*)Ks + KSWZ64(r32, cb));
    bf16x8 b1 = *reinterpret_cast<const bf16x8*>((const char*)Ks + KSWZ64(32 + r32, cb));
    p0 = __builtin_amdgcn_mfma_f32_32x32x16_bf16(b0, qr[d0], p0, 0, 0, 0);
    p1 = __builtin_amdgcn_mfma_f32_32x32x16_bf16(b1, qr[d0], p1, 0, 0, 0); }
}
__device__ __forceinline__ int v_st(int k, int c) { const int kk = (k & ~0xC) | ((k & 4) << 1) | ((k & 8) >> 1); return ((kk >> 3) * 4 + (c >> 5)) * 512 + ((kk & 7) * 32 + (c & 31)) * 2; }
__device__ __forceinline__ int v_rd_base(int lane) { return ((lane & 3) << 3) | (((lane >> 2) & 3) << 6) | (((lane >> 4) & 1) << 5) | (((lane >> 5) & 1) << 8); }
constexpr int v_rd_off(int d0, int ks, int half) { return d0 * 512 + ks * 4096 + half * 2048; }
template <int OFF> __device__ __forceinline__ s16x4 tr_read(int vb) {
  s16x4 r; asm volatile("ds_read_b64_tr_b16 %0, %1 offset:%2" : "=&v"(r) : "v"(vb), "i"(OFF) : "memory"); return r;
}
template <int D0> __device__ __forceinline__ void pv_one(f32x16& od, int vb, bf16x8 pa0, bf16x8 pa1, bf16x8 pa2, bf16x8 pa3) {
  const s16x4 l0 = tr_read<v_rd_off(D0, 0, 0)>(vb), h0 = tr_read<v_rd_off(D0, 0, 1)>(vb), l1 = tr_read<v_rd_off(D0, 1, 0)>(vb), h1 = tr_read<v_rd_off(D0, 1, 1)>(vb);
  const s16x4 l2 = tr_read<v_rd_off(D0, 2, 0)>(vb), h2 = tr_read<v_rd_off(D0, 2, 1)>(vb), l3 = tr_read<v_rd_off(D0, 3, 0)>(vb), h3 = tr_read<v_rd_off(D0, 3, 1)>(vb);
  asm volatile("s_waitcnt lgkmcnt(0)" ::: "memory"); SBAR();
#define PK(L, H) (bf16x8){L[0], L[1], L[2], L[3], H[0], H[1], H[2], H[3]}
  od = __builtin_amdgcn_mfma_f32_32x32x16_bf16(pa0, PK(l0, h0), od, 0, 0, 0);
  od = __builtin_amdgcn_mfma_f32_32x32x16_bf16(pa1, PK(l1, h1), od, 0, 0, 0);
  od = __builtin_amdgcn_mfma_f32_32x32x16_bf16(pa2, PK(l2, h2), od, 0, 0, 0);
  od = __builtin_amdgcn_mfma_f32_32x32x16_bf16(pa3, PK(l3, h3), od, 0, 0, 0);
#undef PK
}
__device__ __forceinline__ void pv_d0(f32x16* o, int vb, bf16x8 pa0, bf16x8 pa1, bf16x8 pa2, bf16x8 pa3) {
  pv_one<0>(o[0], vb, pa0, pa1, pa2, pa3); pv_one<1>(o[1], vb, pa0, pa1, pa2, pa3); pv_one<2>(o[2], vb, pa0, pa1, pa2, pa3); pv_one<3>(o[3], vb, pa0, pa1, pa2, pa3);
}
constexpr int LDQ = NP, LDK = NP, LDO = DM;
__device__ __forceinline__ void sm_first(f32x16& p0, f32x16& p1, float m) {
#pragma unroll
  for (int r = 0; r < 16; ++r) p0[r] = p0[r] - m;
#pragma unroll
  for (int r = 0; r < 16; ++r) p1[r] = p1[r] - m;
#pragma unroll
  for (int r = 0; r < 16; ++r) p0[r] = __builtin_amdgcn_exp2f(p0[r]);
}
__device__ __forceinline__ void sm_second(f32x16& p0, f32x16& p1, float& l_reg, bf16x8& pa0, bf16x8& pa1, bf16x8& pa2, bf16x8& pa3) {
#pragma unroll
  for (int r = 0; r < 16; ++r) p1[r] = __builtin_amdgcn_exp2f(p1[r]);
  float ps = 0;
#pragma unroll
  for (int r = 0; r < 16; ++r) ps += p0[r];
#pragma unroll
  for (int r = 0; r < 16; ++r) ps += p1[r];
  { auto rr = __builtin_amdgcn_permlane32_swap(__float_as_uint(ps), __float_as_uint(ps), false, false);
    ps = __uint_as_float(rr[0]) + __uint_as_float(rr[1]); }
  l_reg += ps;
  pack_p(p0, p1, pa0, pa1, pa2, pa3);
}
__device__ __forceinline__ void attn_unit(const bf16* __restrict__ Qb, const bf16* __restrict__ Kh, const bf16* __restrict__ Vh, bf16* __restrict__ Ob, int seq, char* lds, int tid, float kmax) {
  const int wid = tid >> 6, lane = tid & 63, r32 = lane & 31, hi = lane >> 5;
  bf16* V_lds = (bf16*)lds; bf16* K_lds = (bf16*)(lds + 2 * SHM_V);
  float* ws = (float*)(lds + 2 * SHM_V + 2 * SHM_K) + wid * 64; float* li_l = ws; float* al_l = ws + 32;
  float m_reg = -1e30f, l_reg = 0; f32x16 o[4] = {}; bf16x8 qr[4];
  const bf16* Qw = Qb + (long)(wid * QBLK + r32) * LDQ + hi * 8;
#pragma unroll
  for (int d0 = 0; d0 < 4; ++d0) qr[d0] = *(const __attribute__((address_space(1))) bf16x8*)(Qw + d0 * 16);
  { float qs = 0.f;
#pragma unroll
    for (int d0 = 0; d0 < 4; ++d0)
#pragma unroll
      for (int e = 0; e < 8; ++e) { const float qv = __uint_as_float((unsigned)(unsigned short)qr[d0][e] << 16); qs += qv * qv; }
    auto rr = __builtin_amdgcn_permlane32_swap(__float_as_uint(qs), __float_as_uint(qs), false, false);
    qs = __uint_as_float(rr[0]) + __uint_as_float(rr[1]);
    m_reg = sqrtf(qs) * kmax * 1.002f + 1e-3f; }
  const int sr = tid >> 4, sc = (tid & 15) * 8, vst0 = v_st(sr, sc), vst1 = v_st(32 + sr, sc);
  const int kr = tid >> 3, kc = (tid & 7) * 8, kst = KSWZ64(kr, kc * 2);
  const int vb0 = (int)(uintptr_t)V_lds + v_rd_base(lane);
  struct { bf16x8 vs0, vs1, ks0; } sr_[2];
#define GLD8(p) (*(const __attribute__((address_space(1))) bf16x8*)(p))
#define SLOAD(i, k0) do { sr_[i].vs0 = GLD8(&Vh[(long)((k0) + sr) * LDK + sc]); sr_[i].vs1 = GLD8(&Vh[(long)((k0) + 32 + sr) * LDK + sc]); \
    sr_[i].ks0 = GLD8(&Kh[(long)((k0) + kr) * LDK + kc]); } while (0)
#define SWRITE(b, i) do { *(bf16x8*)((char*)V_lds + (b) * SHM_V + vst0) = sr_[i].vs0; *(bf16x8*)((char*)V_lds + (b) * SHM_V + vst1) = sr_[i].vs1; \
    *(bf16x8*)((char*)K_lds + (b) * SHM_K + kst) = sr_[i].ks0; } while (0)
#define SWAIT() asm volatile("s_waitcnt vmcnt(3)" ::: "memory")
#define RESC(a) do { if (__any((a) < 1.f)) { if (hi == 0) al_l[r32] = (a); asm volatile("s_waitcnt lgkmcnt(0)" ::: "memory"); \
    _Pragma("unroll") for (int d = 0; d < 4; ++d) _Pragma("unroll") for (int r = 0; r < 16; ++r) o[d][r] *= al_l[crow(r, hi)]; } } while (0)
  f32x16 pA0, pA1, pB0, pB1; float mnA, mnB, alA, alB; bf16x8 pa0, pa1, pa2, pa3; const int NT = seq / KVBLK;
  if (__builtin_amdgcn_readfirstlane(wid) >= 4) __builtin_amdgcn_s_setprio(1);
  constexpr int SE = 0, SO = 1;
  SLOAD(SE, 0); asm volatile("s_waitcnt vmcnt(0)" ::: "memory"); SWRITE(0, SE); __syncthreads();
  qkt(pA0, pA1, K_lds, qr, r32, hi); sm_first(pA0, pA1, m_reg);
  SLOAD(SO, KVBLK); if (2 < NT) SLOAD(SE, 2 * KVBLK);
  SWAIT(); SWRITE(1, SO); __syncthreads();
  for (int j = 1; j + 1 < NT; j += 2) {
    SBAR(); qkt(pB0, pB1, (bf16*)((char*)K_lds + SHM_K), qr, r32, hi);
    sm_second(pA0, pA1, l_reg, pa0, pa1, pa2, pa3); SBAR();
    SLOAD(SO, (j + 2) * KVBLK); SBAR();
    pv_d0(o, vb0, pa0, pa1, pa2, pa3); sm_first(pB0, pB1, m_reg);
    __syncthreads(); SWAIT(); SWRITE(0, SE);
    __syncthreads();
    SBAR(); qkt(pA0, pA1, K_lds, qr, r32, hi);
    sm_second(pB0, pB1, l_reg, pa0, pa1, pa2, pa3); SBAR();
    if (j + 3 < NT) SLOAD(SE, (j + 3) * KVBLK); SBAR();
    pv_d0(o, vb0 + (int)SHM_V, pa0, pa1, pa2, pa3); sm_first(pA0, pA1, m_reg);
    __syncthreads(); SWAIT(); SWRITE(1, SO);
    __syncthreads();
  }
  SBAR(); qkt(pB0, pB1, (bf16*)((char*)K_lds + SHM_K), qr, r32, hi);
  sm_second(pA0, pA1, l_reg, pa0, pa1, pa2, pa3); SBAR();
  pv_d0(o, vb0, pa0, pa1, pa2, pa3); sm_first(pB0, pB1, m_reg);
  __syncthreads();
  sm_second(pB0, pB1, l_reg, pa0, pa1, pa2, pa3); SBAR();
  pv_d0(o, vb0 + (int)SHM_V, pa0, pa1, pa2, pa3);
  __builtin_amdgcn_s_setprio(0);
  if (hi == 0) li_l[r32] = l_reg; asm volatile("s_waitcnt lgkmcnt(0)" ::: "memory");
  float rli[16];
#pragma unroll
  for (int r = 0; r < 16; ++r) rli[r] = __builtin_amdgcn_rcpf(li_l[crow(r, hi)]);
  bf16* Ow = Ob + (long)(wid * QBLK) * LDO;
#pragma unroll
  for (int r = 0; r < 16; ++r) { const int orow = crow(r, hi);
#pragma unroll
    for (int d0 = 0; d0 < 4; ++d0) Ow[(long)orow * LDO + d0 * 32 + r32] = (bf16)(cvtpk(o[d0][r] * rli[r], 0.f) & 0xffffu); }
#undef SLOAD
#undef GLD8
#undef SWRITE
#undef SWAIT
#undef RESC
}
}

constexpr int CW_KMX = 13312;
constexpr int CW_Q = 12288;
namespace att2 {
using att::bf16x8; using att::s16x4; using att::f32x16; using att::u32x4;
typedef LAS const char* lds_cptr;
typedef short v4i16_t __attribute__((ext_vector_type(4)));
typedef unsigned u32x2 __attribute__((ext_vector_type(2)));
constexpr int KSLOT = 8192, VSLOT = 16384, LDS_K = 0, LDS_V = 4 * KSLOT, KVBLK = 64;
#define A2_PIN(x) asm volatile("" : "+v"(x))
#define A2_MFMA(a, b, c) __builtin_amdgcn_mfma_f32_32x32x16_bf16(a, b, c, 0, 0, 0)
#define A2_WAIT_BAR(N) asm volatile("s_waitcnt vmcnt(" #N ") lgkmcnt(0)\n\ts_barrier" ::: "memory")
__device__ __forceinline__ unsigned cvtpk(float lo, float hi) { unsigned r; asm("v_cvt_pk_bf16_f32 %0, %1, %2" : "=v"(r) : "v"(lo), "v"(hi)); return r; }
__device__ __forceinline__ void glds16s(const char* gbase, unsigned voff, unsigned lds_base) {
    unsigned sv; asm volatile("s_mov_b32 %0, m0\n\ts_mov_b32 m0, %3\n\ts_nop 0\n\tglobal_load_lds_dwordx4 %1, %2\n\ts_mov_b32 m0, %0" : "=&s"(sv) : "v"(voff), "s"(gbase), "s"(lds_base) : "memory"); }
__device__ __forceinline__ const char* uni_ptr(const void* p) { const unsigned long long v = (unsigned long long)p;
    const unsigned lo = __builtin_amdgcn_readfirstlane((unsigned)v), hi = __builtin_amdgcn_readfirstlane((unsigned)(v >> 32)); return (const char*)(((unsigned long long)hi << 32) | lo); }
__device__ __forceinline__ void kload2(bf16x8* kf, lds_cptr kp, int d0) { kf[2 * d0] = *(const LAS bf16x8*)(kp + d0 * 2048); kf[2 * d0 + 1] = *(const LAS bf16x8*)(kp + d0 * 2048 + 512); }
__device__ __forceinline__ s16x4 vtr(lds_cptr p) { return __builtin_bit_cast(s16x4, __builtin_amdgcn_ds_read_tr16_b64_v4i16((LAS v4i16_t*)p)); }
struct UnitP { const bf16* Q; const char* K; const char* V; bf16* O; int NT, kmi; };
__device__ __forceinline__ void decode_unit(int u, int myq, const bf16* P, bf16* OD, UnitP& U) {
    int g, qt;
    if (u < 128) { const int pi = u >> 4, mp = (u >> 3) & 1; g = ((pi * 8 + myq) << 1) + mp; qt = 1 + (u & 7); }
    else { const int gi = u - 128; g = (((gi >> 1) * 8 + myq) << 1) + (gi & 1); qt = 0; }
    const int b = g >> 3, hh = g & 7;
    const size_t row0 = (size_t)b * TPB;
    U.Q = P + poff(row0 + qt * 256, C_Q + hh * 64); U.K = (const char*)(P + poff(row0, C_K + hh * 64)); U.V = (const char*)(P + poff(row0, C_V + (hh >> 1) * 128));
    U.O = OD + (row0 + qt * 256) * DM + hh * 128; U.NT = qt == 0 ? CTX / 64 : TPB / 64;
    U.kmi = (b * 8 + hh) * 2;
}
__device__ __forceinline__ void attn_stream(Frame& F, int l) {
    const bf16* P = (const bf16*)(F.ws + WS_PROJ); bf16* OD = (bf16*)(F.ws + WS_OD);
    const unsigned* kmxp = (const unsigned*)F.ws + CW_KMX + 256 * l;
    gu32* qheads = (gu32*)F.ws + CW_Q + 64 * l;
    volatile LAS unsigned* slot = F.MISC + 24;
    const int limit = (l == DEPTH - 1 ? 128 : 144);
    LAS unsigned char* lds = F.lds; const int tid = F.tid;
    const int lane = tid & 63, r32 = lane & 31, hi = lane >> 5; const int wid = __builtin_amdgcn_readfirstlane(tid >> 6);
    constexpr unsigned TSTR = KVBLK * NP * 2;
    const unsigned lds0 = (unsigned)(uintptr_t)lds;
    const unsigned koff = (unsigned)poff(lane, wid * 8) * 2;
    const unsigned voff0 = (unsigned)poff(16 * (wid & 3) + (lane >> 2), (wid >> 2) * 32 + (lane & 3) * 8) * 2, voff1 = voff0 + 2 * 512 * 2;
    const unsigned kdst = lds0 + LDS_K + wid * 1024, vdst = lds0 + LDS_V + wid * 1024;
#define DMA_K(src, slotB) glds16s((src), koff, kdst + (slotB))
#define DMA_V(src, slotB) do { const char* vb_ = (src); glds16s(vb_, voff0, vdst + (slotB)); glds16s(vb_, voff1, vdst + (slotB) + 8192); } while (0)
    const lds_cptr vp0 = (lds_cptr)lds + LDS_V + ((lane >> 4) & 1) * 32 + (lane & 3) * 8 + (4 * hi + ((lane & 15) >> 2)) * 64;
    const lds_cptr kp0 = (lds_cptr)lds + LDS_K + hi * 1024 + r32 * 16;
    if (wid >= 4) __builtin_amdgcn_s_setprio(1);
    int myq = F.blk & 7, tries = 0, vstart = 0; bool warm = false; UnitP cur, nx;
    for (;;) {
        if (!warm) {
            int u;
            for (;;) {
                __syncthreads();
                if (tid == 0) slot[0] = __hip_atomic_fetch_add((unsigned*)(qheads + myq), 1u, __ATOMIC_RELAXED, __HIP_MEMORY_SCOPE_AGENT);
                __syncthreads();
                u = __builtin_amdgcn_readfirstlane((int)slot[0]);
                if (u < limit) break;
                if (++tries >= 8) { u = -1; break; }
                myq = (myq + 1) & 7;
            }
            if (u < 0) break;
            decode_unit(u, myq, P, OD, cur);
            const char* Kc = uni_ptr(cur.K); const char* Vc = uni_ptr(cur.V);
            DMA_K(Kc, 0); DMA_V(Vc, 0); DMA_K(Kc + TSTR, KSLOT); DMA_K(Kc + 2 * (size_t)TSTR, 2 * KSLOT); vstart = 0;
        }
        const char* Kh = uni_ptr(cur.K); const char* Vh = uni_ptr(cur.V); const int NT = cur.NT;
        const int tpop = NT - 5;
        unsigned nxt = 0xffffffffu;
        if (NT < 8 && tid == 0) nxt = __hip_atomic_fetch_add((unsigned*)(qheads + myq), 1u, __ATOMIC_RELAXED, __HIP_MEMORY_SCOPE_AGENT);
        bf16x8 qr[4];
        const bf16* Qw = cur.Q + poff(wid * 32 + r32, hi * 8);
#pragma unroll
        for (int d0 = 0; d0 < 4; ++d0) qr[d0] = *(const GAS bf16x8*)(Qw + (d0 >> 1) * 512 + (d0 & 1) * 16);
        const float kmax = sqrtf(__uint_as_float(kmxp[cur.kmi]) + __uint_as_float(kmxp[cur.kmi + 1])) * 1.01f;
        float m_row;
        { float qs = 0.f;
#pragma unroll
          for (int d0 = 0; d0 < 4; ++d0)
#pragma unroll
            for (int e = 0; e < 8; ++e) { const float qv = __uint_as_float((unsigned)(unsigned short)qr[d0][e] << 16); qs += qv * qv; }
          auto rr = __builtin_amdgcn_permlane32_swap(__float_as_uint(qs), __float_as_uint(qs), false, false);
          qs = __uint_as_float(rr[0]) + __uint_as_float(rr[1]);
          m_row = sqrtf(qs) * kmax * 1.002f + 1e-3f; }
        f32x16 negm16;
#pragma unroll
        for (int r = 0; r < 16; ++r) negm16[r] = -m_row;
        A2_PIN(negm16);
        float l_reg = 0.f; f32x16 o[4]; o[0] = f32x16{}; o[1] = f32x16{}; o[2] = f32x16{}; o[3] = f32x16{};
        f32x16 pA0, pA1, pB0, pB1; bf16x8 kf[8]; s16x4 vlo[5], vhi[5]; u32x4 pw[4];
        asm volatile("s_waitcnt vmcnt(0)" ::: "memory");
        if (NT < 8 && tid == 0) slot[1] = nxt;
        asm volatile("s_waitcnt lgkmcnt(0)\n\ts_barrier" ::: "memory");
        bool hasn = false; const char* KhN = Kh; const char* VhN = Vh;
#define GET_NEXT() do { const int un_ = __builtin_amdgcn_readfirstlane((int)slot[1]); hasn = un_ < limit; if (hasn) { decode_unit(un_, myq, P, OD, nx); KhN = uni_ptr(nx.K); VhN = uni_ptr(nx.V); } } while (0)
        if (NT < 8) GET_NEXT();
#pragma unroll
        for (int d0 = 0; d0 < 4; ++d0) kload2(kf, kp0, d0);
        pA0 = A2_MFMA(kf[0], qr[0], negm16); pA1 = A2_MFMA(kf[1], qr[0], negm16); pA0 = A2_MFMA(kf[2], qr[1], pA0); pA1 = A2_MFMA(kf[3], qr[1], pA1);
        pA0 = A2_MFMA(kf[4], qr[2], pA0); pA1 = A2_MFMA(kf[5], qr[2], pA1); pA0 = A2_MFMA(kf[6], qr[3], pA0); pA1 = A2_MFMA(kf[7], qr[3], pA1);
#pragma unroll
        for (int r = 0; r < 16; ++r) { pA0[r] = __builtin_amdgcn_exp2f(pA0[r]); pA1[r] = __builtin_amdgcn_exp2f(pA1[r]); }
        int vp = vstart;
        { int v1 = vp + VSLOT; if (v1 == 3 * VSLOT) v1 = 0; DMA_K(Kh + 3 * (size_t)TSTR, 3 * KSLOT); DMA_V(Vh + TSTR, v1); }
        kload2(kf, kp0 + KSLOT, 0); kload2(kf, kp0 + KSLOT, 1);
        A2_WAIT_BAR(3);
        int kc = KSLOT;
#define PKW(P, i) cvtpk(P[i], P[(i) + 1])
#define VFR(s) (bf16x8){vlo[s][0], vlo[s][1], vlo[s][2], vlo[s][3], vhi[s][0], vhi[s][1], vhi[s][2], vhi[s][3]}
#define VRD(s, i) do { vlo[s] = vtr(vq_ + (((i) & 3) * 4096 + ((i) >> 2) * 1024)); vhi[s] = vtr(vq_ + (((i) & 3) * 4096 + ((i) >> 2) * 1024 + 512)); } while (0)
#define GAPA(MF, W0, W1, PW) do { MF; W0; W1; A2_PIN(PW); SBAR(); } while (0)
#define GAPB(i, X, j, Y) do { if ((i) + 4 < 16) VRD(((i) + 4) % 5, (i) + 4); if ((i) == 9) kload2(kf, kn_, 0); if ((i) == 10) kload2(kf, kn_, 1); SBAR(); \
    o[(i) & 3] = A2_MFMA(VFR((i) % 5), __builtin_bit_cast(bf16x8, pw[(i) >> 2]), o[(i) & 3]); X[j] = __builtin_amdgcn_exp2f(X[j]); X[(j) + 1] = __builtin_amdgcn_exp2f(X[(j) + 1]); l_reg += Y[j]; l_reg += Y[(j) + 1]; A2_PIN(X); A2_PIN(l_reg); SBAR(); } while (0)
#define A2_STEP(C0, C1, P0, P1, t) do { \
    if ((t) == tpop) { if (tid == 0) slot[1] = __hip_atomic_fetch_add((unsigned*)(qheads + myq), 1u, __ATOMIC_RELAXED, __HIP_MEMORY_SCOPE_AGENT); } \
    if ((t) == tpop + 1) GET_NEXT();                                                                                 \
    SBAR(); \
    const lds_cptr kq_ = kp0 + kc, vq_ = vp0 + vp, kn_ = kp0 + ((kc + KSLOT) & (4 * KSLOT - 1)); \
    const int ik_ = (t) + 3, iv_ = (t) + 1; \
    const char* ks_ = ik_ < NT ? Kh + (size_t)ik_ * TSTR : KhN + (size_t)(ik_ - NT) * TSTR;                            \
    const char* vs_ = iv_ < NT ? Vh + (size_t)iv_ * TSTR : VhN; \
    const int kprev_ = (kc - KSLOT) & (4 * KSLOT - 1); int vnew_ = vp + 2 * VSLOT; if (vnew_ >= 3 * VSLOT) vnew_ -= 3 * VSLOT; \
    kload2(kf, kq_, 2); SBAR(); \
    GAPA(C0 = A2_MFMA(kf[0], qr[0], negm16), pw[0][0] = PKW(P0, 0),  pw[0][1] = PKW(P0, 2),  pw[0]); \
    kload2(kf, kq_, 3); SBAR(); \
    GAPA(C1 = A2_MFMA(kf[1], qr[0], negm16), pw[0][2] = PKW(P0, 4),  pw[0][3] = PKW(P0, 6),  pw[0]); \
    VRD(0, 0); SBAR(); GAPA(C0 = A2_MFMA(kf[2], qr[1], C0), pw[1][0] = PKW(P0, 8),  pw[1][1] = PKW(P0, 10), pw[1]); \
    VRD(1, 1); SBAR(); GAPA(C1 = A2_MFMA(kf[3], qr[1], C1), pw[1][2] = PKW(P0, 12), pw[1][3] = PKW(P0, 14), pw[1]); \
    VRD(2, 2); SBAR(); GAPA(C0 = A2_MFMA(kf[4], qr[2], C0), pw[2][0] = PKW(P1, 0),  pw[2][1] = PKW(P1, 2),  pw[2]); \
    VRD(3, 3); SBAR(); GAPA(C1 = A2_MFMA(kf[5], qr[2], C1), pw[2][2] = PKW(P1, 4),  pw[2][3] = PKW(P1, 6),  pw[2]); \
                       GAPA(C0 = A2_MFMA(kf[6], qr[3], C0), pw[3][0] = PKW(P1, 8),  pw[3][1] = PKW(P1, 10), pw[3]); \
                       GAPA(C1 = A2_MFMA(kf[7], qr[3], C1), pw[3][2] = PKW(P1, 12), pw[3][3] = PKW(P1, 14), pw[3]); \
    DMA_K(ks_, kprev_); DMA_V(vs_, vnew_); SBAR();                                                                   \
    GAPB(0, C0, 0, P0);  GAPB(1, C0, 2, P0);  GAPB(2, C0, 4, P0);   GAPB(3, C0, 6, P0);   GAPB(4, C0, 8, P0);   GAPB(5, C0, 10, P0);  GAPB(6, C0, 12, P0);  GAPB(7, C0, 14, P0); \
    GAPB(8, C1, 0, P1);  GAPB(9, C1, 2, P1);  GAPB(10, C1, 4, P1);  GAPB(11, C1, 6, P1);  GAPB(12, C1, 8, P1);  GAPB(13, C1, 10, P1); GAPB(14, C1, 12, P1); GAPB(15, C1, 14, P1); \
    A2_WAIT_BAR(3);                                                                                                   \
    kc = (kc + KSLOT) & (4 * KSLOT - 1); vp += VSLOT; if (vp == 3 * VSLOT) vp = 0; \
    } while (0)
        int t = 1;
        for (; t + 1 < NT; t += 2) {
            A2_STEP(pB0, pB1, pA0, pA1, t);
            A2_STEP(pA0, pA1, pB0, pB1, t + 1);
        }
        A2_STEP(pB0, pB1, pA0, pA1, NT - 1);
        { float sacc = pB0[0] + pB0[1];
#pragma unroll
          for (int r = 2; r < 16; ++r) sacc += pB0[r];
#pragma unroll
          for (int r = 0; r < 16; ++r) sacc += pB1[r];
          l_reg += sacc;
          pw[0] = (u32x4){PKW(pB0, 0), PKW(pB0, 2), PKW(pB0, 4), PKW(pB0, 6)}; pw[1] = (u32x4){PKW(pB0, 8), PKW(pB0, 10), PKW(pB0, 12), PKW(pB0, 14)};
          pw[2] = (u32x4){PKW(pB1, 0), PKW(pB1, 2), PKW(pB1, 4), PKW(pB1, 6)}; pw[3] = (u32x4){PKW(pB1, 8), PKW(pB1, 10), PKW(pB1, 12), PKW(pB1, 14)};
          const lds_cptr vq_ = vp0 + vp;
#pragma unroll
          for (int kg = 0; kg < 4; ++kg) {
              VRD(0, kg * 4 + 0); VRD(1, kg * 4 + 1); VRD(2, kg * 4 + 2); VRD(3, kg * 4 + 3);
              o[0] = A2_MFMA(VFR(0), __builtin_bit_cast(bf16x8, pw[kg]), o[0]); o[1] = A2_MFMA(VFR(1), __builtin_bit_cast(bf16x8, pw[kg]), o[1]);
              o[2] = A2_MFMA(VFR(2), __builtin_bit_cast(bf16x8, pw[kg]), o[2]); o[3] = A2_MFMA(VFR(3), __builtin_bit_cast(bf16x8, pw[kg]), o[3]); } }
        { auto rr = __builtin_amdgcn_permlane32_swap(__float_as_uint(l_reg), __float_as_uint(l_reg), false, false); l_reg = __uint_as_float(rr[0]) + __uint_as_float(rr[1]); }
        const float rli = __builtin_amdgcn_rcpf(l_reg);
        GAS bf16* Ow = (GAS bf16*)cur.O + (long)(wid * 32 + r32) * DM + 4 * hi;
#pragma unroll
        for (int d = 0; d < 4; ++d)
#pragma unroll
          for (int g = 0; g < 4; ++g) { u32x2 w; w.x = cvtpk(o[d][4 * g] * rli, o[d][4 * g + 1] * rli); w.y = cvtpk(o[d][4 * g + 2] * rli, o[d][4 * g + 3] * rli);
              *(GAS u32x2*)(Ow + d * 32 + 8 * g) = w; }
        vstart = vp + VSLOT; if (vstart == 3 * VSLOT) vstart = 0;
        if (hasn) { cur = nx; warm = true; }
        else { asm volatile("s_waitcnt vmcnt(0)" ::: "memory"); warm = false; }
    }
    __builtin_amdgcn_s_setprio(0);
    __syncthreads();
#undef DMA_K
#undef DMA_V
#undef PKW
#undef VFR
#undef VRD
#undef GAPA
#undef GAPB
#undef A2_STEP
#undef GET_NEXT
}
}

__device__ __forceinline__ int gla_item(int b, int h, int dir, int c) { return ((b * 4 + h) * 2 + dir) * NCH + c; }
namespace gla {
using att::bf16x8; using att::f32x16; using att::u32x4;
__device__ __forceinline__ void gates8(const bf16* P, const float* w2, const float* gb, size_t row0, int dir, int seg, int k, float (&gl)[8]) {
    float w[16];
#pragma unroll
    for (int j = 0; j < 16; ++j) w[j] = w2[j * 256 + k];
    const float bias = gb[k];
#pragma unroll
    for (int i = 0; i < 8; ++i) {
        const bf16* gp = P + (row0 + seg * 8 + i) * NP + C_GLR + dir * 16;
        const v4u a = *(const v4u*)gp, b = *(const v4u*)(gp + 8);
        float z = bias;
        z += bflo(a.x) * w[0] + bfhi(a.x) * w[1] + bflo(a.y) * w[2] + bfhi(a.y) * w[3] + bflo(a.z) * w[4] + bfhi(a.z) * w[5] + bflo(a.w) * w[6] + bfhi(a.w) * w[7];
        z += bflo(b.x) * w[8] + bfhi(b.x) * w[9] + bflo(b.y) * w[10] + bfhi(b.y) * w[11] + bflo(b.z) * w[12] + bfhi(b.z) * w[13] + bflo(b.w) * w[14] + bfhi(b.w) * w[15];
        gl[i] = (fminf(z, 0.f) - log1pf(expf(-fabsf(z)))) * (1.f / 16.f);
    }
}
__device__ __forceinline__ float lscan(const float (&gl)[8], int dir, float (&loc)[8]) {
    float run = 0.f;
    if (dir == 0) {
#pragma unroll
        for (int i = 0; i < 8; ++i) { run += gl[i]; loc[i] = run; }
    } else {
#pragma unroll
        for (int i = 7; i >= 0; --i) { run += gl[i]; loc[i] = run; }
    }
    return run;
}
__device__ __forceinline__ void stage_tile_bf16(const bf16* src, size_t pitch, char* tile, int tid) {
    const int sr = tid >> 4, sc = (tid & 15) * 8;
    const bf16x8 a = *reinterpret_cast<const bf16x8*>(src + (size_t)sr * pitch + sc), b = *reinterpret_cast<const bf16x8*>(src + (size_t)(32 + sr) * pitch + sc);
    *(bf16x8*)(tile + att::v_st(sr, sc)) = a; *(bf16x8*)(tile + att::v_st(32 + sr, sc)) = b;
}
__device__ __forceinline__ void stage_tile_f32(const float* src, char* tile, int tid) {
    const int sr = tid >> 4, sc = (tid & 15) * 8;
#pragma unroll
    for (int t = 0; t < 2; ++t) { const int row = sr + 32 * t; const f32x4 x = *(const f32x4*)(src + row * 128 + sc), y = *(const f32x4*)(src + row * 128 + sc + 4);
        u32x4 w = {att::cvtpk(x[0], x[1]), att::cvtpk(x[2], x[3]), att::cvtpk(y[0], y[1]), att::cvtpk(y[2], y[3])};
        *(u32x4*)(tile + att::v_st(row, sc)) = w; }
}
__device__ __forceinline__ void pv_sel(int d0, f32x16& o, int vb, bf16x8 a0, bf16x8 a1, bf16x8 a2, bf16x8 a3) {
    switch (d0) { case 0: att::pv_one<0>(o, vb, a0, a1, a2, a3); break; case 1: att::pv_one<1>(o, vb, a0, a1, a2, a3); break;
                  case 2: att::pv_one<2>(o, vb, a0, a1, a2, a3); break; default: att::pv_one<3>(o, vb, a0, a1, a2, a3); break; }
}
__device__ __forceinline__ void afrag4(const char* img, int row, int hi, bf16x8 (&a)[4]) {
#pragma unroll
    for (int s = 0; s < 4; ++s) a[s] = *reinterpret_cast<const bf16x8*>(img + KSWZ64(row, (s * 16 + hi * 8) * 2));
}
__device__ __forceinline__ void st_sw(char* img, int row, int col, float v) { *(unsigned short*)(img + KSWZ64(row, col * 2)) = (unsigned short)(att::cvtpk(v, 0.f) & 0xffffu); }
}

constexpr size_t WS_OG = WS_DS;
struct GlaPre { unsigned g; unsigned short q[8], k[8]; att::bf16x8 v0, v1; };
__device__ __forceinline__ void gla_prefetch(GlaPre& R, const bf16* P_, size_t row0, int h, int dir, int k, int seg, int tid) {
    const GAS bf16* P = (const GAS bf16*)P_;
    R.g = *(const GAS unsigned*)(P + poff(row0 + seg * 8 + (k >> 3), C_GLR + dir * 16 + (k & 7) * 2));
#pragma unroll
    for (int i = 0; i < 8; ++i) { const size_t rw = row0 + seg * 8 + i; R.q[i] = P[poff(rw, C_GQ + h * 64 + k)]; R.k[i] = P[poff(rw, C_GK + h * 64 + k)]; }
    const int sr = tid >> 4, sc = (tid & 15) * 8;
    R.v0 = *(const GAS att::bf16x8*)(P + poff(row0 + sr, C_GV + h * 128 + sc)); R.v1 = *(const GAS att::bf16x8*)(P + poff(row0 + 32 + sr, C_GV + h * 128 + sc));
}
__device__ __forceinline__ void gla_chain(Frame& F, int l, int chain) {
    const int b = chain >> 3, h = (chain >> 1) & 3, dir = chain & 1;
    const bf16* P = (const bf16*)(F.ws + WS_PROJ); bf16* OG = (bf16*)(F.ws + WS_OG) + (size_t)dir * M * 512;
    char* lds = (char*)F.lds; char* Vt = lds; char* St = lds + 16384; char* KtT = lds + 32768; char* Kt = lds + 40960; char* Qt = lds + 49152; char* Qh = lds + 57344;
    float* T = (float*)(lds + 65536); float* Dec = (float*)(lds + 67584);
    const int k = F.lane, seg = F.tid >> 6, r32 = F.lane & 31, hi = F.lane >> 5, mt = F.wave >> 2, d0 = F.wave & 3;
    const int vbV = (int)(uintptr_t)Vt + att::v_rd_base(F.lane), vbS = (int)(uintptr_t)St + att::v_rd_base(F.lane);
    const int sr = F.tid >> 4, sc = (F.tid & 15) * 8;
    float w[16];
    { const float* w2 = INP(11) + (size_t)((l * 2 + dir) * 16) * 256 + h * 64;
#pragma unroll
      for (int j = 0; j < 16; ++j) w[j] = w2[j * 256 + k]; }
    const float bias = (INP(12) + (l * 2 + dir) * 256 + h * 64)[k];
    att::f32x16 S = {};
    GlaPre R, RN;
    { const int c0 = dir == 0 ? 0 : 3; gla_prefetch(RN, P, (size_t)b * TPB + c0 * 64, h, dir, k, seg, F.tid); }
    for (int j = 0; j < NCH; ++j) {
        const int c = dir == 0 ? j : (j < 4 ? 3 - j : 39 - j);
        const size_t row0 = (size_t)b * TPB + c * 64;
        R = RN;
        if (j + 1 < NCH) { const int cn = dir == 0 ? j + 1 : (j + 1 < 4 ? 2 - j : 38 - j); gla_prefetch(RN, P, (size_t)b * TPB + cn * 64, h, dir, k, seg, F.tid); }
        float gl[8], loc[8];
#pragma unroll
        for (int i = 0; i < 8; ++i) {
            float z = bias;
#pragma unroll
            for (int d = 0; d < 8; ++d) { const unsigned s = (unsigned)__builtin_amdgcn_readlane((int)R.g, i * 8 + d); z += bflo(s) * w[2 * d] + bfhi(s) * w[2 * d + 1]; }
            gl[i] = (fminf(z, 0.f) - __logf(1.f + __expf(-fabsf(z)))) * (1.f / 16.f); }
        const float segtot = gla::lscan(gl, dir, loc);
        T[seg * 64 + k] = segtot;
        *(att::bf16x8*)(Vt + att::v_st(sr, sc)) = R.v0; *(att::bf16x8*)(Vt + att::v_st(32 + sr, sc)) = R.v1;
#pragma unroll
        for (int r = 0; r < 16; ++r) *(unsigned short*)(St + att::v_st(mt * 32 + att::crow(r, hi), d0 * 32 + r32)) = (unsigned short)(att::cvtpk(S[r], 0.f) & 0xffffu);
        __syncthreads();
        float off = 0.f, tot = 0.f;
        int sg = seg; asm volatile("" : "+v"(sg));
#pragma unroll
        for (int s = 0; s < 8; ++s) { const float t = T[s * 64 + k]; tot += t; const bool inoff = dir == 0 ? (s < sg) : (s > sg); off += inoff ? t : 0.f; }
        const float etot = __expf(tot);
        float kt[8];
#pragma unroll
        for (int i = 0; i < 8; ++i) { const int tau = seg * 8 + i; const float qv = bf2f(R.q[i]), kv = bf2f(R.k[i]); const float cc = loc[i] + off;
            const float a = fmaxf(__expf(cc), 1e-30f)  , bq = __builtin_amdgcn_rcpf(a), kb = kv * bq;
            kt[i] = kb * etot;
            gla::st_sw(Qh, tau, k, qv * a); gla::st_sw(Kt, tau, k, kb); }
        { att::u32x4 wv = {att::cvtpk(kt[0], kt[1]), att::cvtpk(kt[2], kt[3]), att::cvtpk(kt[4], kt[5]), att::cvtpk(kt[6], kt[7])};
          *(att::u32x4*)(KtT + KSWZ64(k, seg * 16)) = wv; }
        if (sg == 0) Dec[k] = etot;
        __syncthreads();
        att::f32x16 o = {};
        int tau_q = mt * 32 + r32; asm volatile("" : "+v"(tau_q));
        { att::bf16x8 qr[4]; gla::afrag4(Qh, tau_q, hi, qr);
          att::f32x16 p0, p1; att::qkt(p0, p1, (const bf16*)Kt, qr, r32, hi);
#pragma unroll
          for (int r = 0; r < 16; ++r) { const int t0 = att::crow(r, hi), t1 = 32 + t0;
              const bool k0 = dir == 0 ? (t0 <= tau_q) : (t0 >= tau_q), k1 = dir == 0 ? (t1 <= tau_q) : (t1 >= tau_q);
              p0[r] = k0 ? p0[r] : 0.f; p1[r] = k1 ? p1[r] : 0.f; }
          att::bf16x8 pa0, pa1, pa2, pa3; att::pack_p(p0, p1, pa0, pa1, pa2, pa3);
          gla::pv_sel(d0, o, vbV, pa0, pa1, pa2, pa3);
          gla::pv_sel(d0, o, vbS, qr[0], qr[1], qr[2], qr[3]); }
#pragma unroll
        for (int r = 0; r < 16; ++r) S[r] *= Dec[mt * 32 + att::crow(r, hi)];
        { att::bf16x8 a[4]; gla::afrag4(KtT, mt * 32 + r32, hi, a); gla::pv_sel(d0, S, vbV, a[0], a[1], a[2], a[3]); }
        GAS bf16* op = (GAS bf16*)(OG + row0 * 512 + h * 128 + d0 * 32 + r32);
#pragma unroll
        for (int r = 0; r < 16; ++r) op[(size_t)(mt * 32 + att::crow(r, hi)) * 512] = (bf16)(att::cvtpk(o[r], 0.f) & 0xffffu);
        __syncthreads();
    }
}
__device__ __forceinline__ void p3_mixer(Frame& F, int l) {
    refresh(F);
    for (int ch = F.blk; ch < NBATCH * 8; ch += F.G) gla_chain(F, l, ch);
    att2::attn_stream(F, l);
}
__device__ __forceinline__ void p5_merge_all(Frame& F, int l) {
    refresh(F);
    const bf16* OD = (const bf16*)(F.ws + WS_OD); const bf16* OG = (const bf16*)(F.ws + WS_OG); const bf16* P = (const bf16*)(F.ws + WS_PROJ); bf16* MRG = (bf16*)(F.ws + WS_H);
    const float lam = ((const float*)(F.ws + WS_ROPE + 16384))[l]; const float omli = 1.f - lam_init_of(l);
    const float* subln = INP(14) + l * 128; const float* onorm = INP(15) + l * 128;
    const int h = F.lane >> 4, c0 = (F.lane & 15) * 8;
    const int rpw = (M + F.NGW - 1) / F.NGW, r0 = F.gw * rpw, r1 = (r0 + rpw < M) ? r0 + rpw : M;
    for (int r = r0; r < r1; ++r) {
        const v4u a = *(const v4u*)(OD + (size_t)r * DM + h * 256 + c0), bq = *(const v4u*)(OD + (size_t)r * DM + h * 256 + 128 + c0);
        const v4u gf = *(const v4u*)(OG + (size_t)r * 512 + h * 128 + c0), gbk = *(const v4u*)(OG + ((size_t)M + r) * 512 + h * 128 + c0);
        const v4u gt = *(const v4u*)(P + poff((size_t)r, C_GG + h * 128 + c0));
        float d[8], e[8], g[8];
        d[0] = bflo(a.x) - lam * bflo(bq.x); d[1] = bfhi(a.x) - lam * bfhi(bq.x); d[2] = bflo(a.y) - lam * bflo(bq.y); d[3] = bfhi(a.y) - lam * bfhi(bq.y);
        d[4] = bflo(a.z) - lam * bflo(bq.z); d[5] = bfhi(a.z) - lam * bfhi(bq.z); d[6] = bflo(a.w) - lam * bflo(bq.w); d[7] = bfhi(a.w) - lam * bfhi(bq.w);
        e[0] = bflo(gf.x) + bflo(gbk.x); e[1] = bfhi(gf.x) + bfhi(gbk.x); e[2] = bflo(gf.y) + bflo(gbk.y); e[3] = bfhi(gf.y) + bfhi(gbk.y);
        e[4] = bflo(gf.z) + bflo(gbk.z); e[5] = bfhi(gf.z) + bfhi(gbk.z); e[6] = bflo(gf.w) + bflo(gbk.w); e[7] = bfhi(gf.w) + bfhi(gbk.w);
        g[0] = bflo(gt.x); g[1] = bfhi(gt.x); g[2] = bflo(gt.y); g[3] = bfhi(gt.y); g[4] = bflo(gt.z); g[5] = bfhi(gt.z); g[6] = bflo(gt.w); g[7] = bfhi(gt.w);
        float ss = 0.f, se = 0.f;
#pragma unroll
        for (int i = 0; i < 8; ++i) { ss += d[i] * d[i]; se += e[i] * e[i]; }
        ss = xadd<1>(ss); ss = xadd<2>(ss); ss = xadd<4>(ss); ss = xadd<8>(ss);
        se = xadd<1>(se); se = xadd<2>(se); se = xadd<4>(se); se = xadd<8>(se);
        const float sc = omli / sqrtf(ss * (1.f / 128.f) + EPS), se2 = 1.0f / sqrtf(se * (1.f / 128.f) + EPS);
#pragma unroll
        for (int i = 0; i < 8; ++i) { d[i] = d[i] * sc * subln[c0 + i]; e[i] = e[i] * se2 * onorm[c0 + i] * siluf(g[i]); }
        v4u w; w.x = pg8::cvt_pk_bf16(d[0], d[1]); w.y = pg8::cvt_pk_bf16(d[2], d[3]); w.z = pg8::cvt_pk_bf16(d[4], d[5]); w.w = pg8::cvt_pk_bf16(d[6], d[7]);
        *(v4u*)(MRG + (size_t)r * DM + h * 128 + c0) = w;
        v4u x; x.x = pg8::cvt_pk_bf16(e[0], e[1]); x.y = pg8::cvt_pk_bf16(e[2], e[3]); x.z = pg8::cvt_pk_bf16(e[4], e[5]); x.w = pg8::cvt_pk_bf16(e[6], e[7]);
        *(v4u*)(MRG + (size_t)r * DM + 512 + h * 128 + c0) = x;
    }
}

__device__ __forceinline__ float dpp_sum16(float v) {
    v += __int_as_float(__builtin_amdgcn_update_dpp(0, __float_as_int(v), 0xB1, 0xF, 0xF, true));
    v += __int_as_float(__builtin_amdgcn_update_dpp(0, __float_as_int(v), 0x4E, 0xF, 0xF, true));
    v += __int_as_float(__builtin_amdgcn_update_dpp(0, __float_as_int(v), 0x141, 0xF, 0xF, true));
    v += __int_as_float(__builtin_amdgcn_update_dpp(0, __float_as_int(v), 0x140, 0xF, 0xF, true));
    return v;
}
__device__ __forceinline__ float wave_sum2(float v) { v = dpp_sum16(v); v = xadd<16>(v); v = xadd<32>(v); return v; }
__device__ __forceinline__ float row_rinv2(const f32x4 (&v)[4]) {
    float s = 0.f;
#pragma unroll
    for (int j = 0; j < 4; ++j) s += (v[j][0] * v[j][0] + v[j][1] * v[j][1]) + (v[j][2] * v[j][2] + v[j][3] * v[j][3]);
    return __builtin_amdgcn_rsqf(wave_sum2(s) * (1.f / DM) + EPS);
}
__device__ __forceinline__ void ld_raw_bf16(const bf16* row, int lane, u32x2 (&v)[4]) {
#pragma unroll
    for (int j = 0; j < 4; ++j) v[j] = *(const u32x2*)(row + 4 * lane + 256 * j);
}
__device__ __forceinline__ void ld_raw_bf16_blk(const bf16* base, int row, int lane, u32x2 (&v)[4]) {
    const bf16* p = base + ((size_t)(row >> 4) * 32 + (lane >> 3)) * 512 + (row & 15) * 32 + (lane & 7) * 4;
#pragma unroll
    for (int j = 0; j < 4; ++j) v[j] = *(const u32x2*)(p + j * (8 * 512));
}
__device__ __forceinline__ f32x4 raw2f(u32x2 w) { return (f32x4){bflo(w.x), bfhi(w.x), bflo(w.y), bfhi(w.y)}; }
__device__ __forceinline__ void ld_vec(const float* p, int lane, f32x4 (&v)[4]) {
#pragma unroll
    for (int j = 0; j < 4; ++j) v[j] = *(const f32x4*)(p + 4 * lane + 256 * j);
}

__device__ __forceinline__ void p1_rows(Frame& F, int l) {
    refresh(F);
    const float* MOD = (const float*)(F.ws + WS_MOD);
    bf16* X = (bf16*)(F.ws + WS_X); bf16* H = (bf16*)(F.ws + WS_H); const bf16* F2 = (const bf16*)(F.ws + WS_F2);
    const int rpw = (M + F.NGW - 1) / F.NGW, r0 = F.gw * rpw, r1 = (r0 + rpw < M) ? r0 + rpw : M;
    if (r0 >= r1) return;
    const bool two = l > 0 && ((l - 1) & 1);
    f32x4 gpre[4], gpost[4], sh[4], sc[4], gt[4];
    ld_vec(INP(6) + l * DM, F.lane, gpre);
    if (l > 0) ld_vec(INP(9) + (l - 1) * DM, F.lane, gpost);
    int cur = -1;
    f32x4 xn[4]; u32x2 xr[4], fn[4], gn[4];
#define P1_ISSUE(r) do { const int b_ = (r) / TPB, p_ = (r) % TPB; \
        if (l == 0) ld_row_f32(p_ < CTX ? INP(2) + ((size_t)b_ * CTX + p_) * DM : INP(0) + ((size_t)b_ * SEQ + (p_ - CTX)) * DM, F.lane, xn); \
        else ld_raw_bf16(X + (size_t)(r) * DM, F.lane, xr); \
        if (l > 0) { ld_raw_bf16(F2 + (size_t)(r) * DM, F.lane, fn); if (two) ld_raw_bf16(F2 + ((size_t)M + (r)) * DM, F.lane, gn); } } while (0)
    P1_ISSUE(r0);
    for (int r = r0; r < r1; ++r) {
        f32x4 x[4]; u32x2 fr[4], gr[4];
#pragma unroll
        for (int j = 0; j < 4; ++j) { x[j] = (l == 0) ? xn[j] : raw2f(xr[j]); fr[j] = fn[j]; gr[j] = gn[j]; }
        if (r + 1 < r1) P1_ISSUE(r + 1);
        const int b = r / TPB, p = r % TPB, mrow = p < CTX ? 16 : b;
        if (mrow != cur) { cur = mrow; const float* modp = MOD + ((size_t)l * 17 + mrow) * 6144; ld_vec(modp, F.lane, sh); ld_vec(modp + 1024, F.lane, sc);
            if (l > 0) ld_vec(MOD + ((size_t)(l - 1) * 17 + mrow) * 6144 + 5 * 1024, F.lane, gt); }
        if (l > 0) {
            f32x4 f[4];
#pragma unroll
            for (int j = 0; j < 4; ++j) { f[j] = raw2f(fr[j]); if (two) f[j] = f[j] + raw2f(gr[j]); }
            const float rinv = row_rinv2(f);
#pragma unroll
            for (int j = 0; j < 4; ++j) x[j] = x[j] + gt[j] * (f[j] * rinv * gpost[j]);
        }
        st_row_bf16(X + (size_t)r * DM, F.lane, x);
        const float rinv = row_rinv2(x);
        f32x4 h[4];
#pragma unroll
        for (int j = 0; j < 4; ++j) h[j] = (x[j] * rinv * gpre[j]) * (sc[j] + 1.0f) + sh[j];
        st_row_bf16(H + (size_t)r * DM, F.lane, h);
    }
#undef P1_ISSUE
}
__device__ __forceinline__ void pf_final(Frame& F) {
    refresh(F);
    const float* MOD = (const float*)(F.ws + WS_MOD);
    const bf16* X = (const bf16*)(F.ws + WS_X); const bf16* F2 = (const bf16*)(F.ws + WS_F2);
    const int l = DEPTH - 1, NR = NBATCH * SEQ;
    const int rpw = (NR + F.NGW - 1) / F.NGW, i0 = F.gw * rpw, i1 = (i0 + rpw < NR) ? i0 + rpw : NR;
    if (i0 >= i1) return;
    f32x4 gpost[4], gt[4]; ld_vec(INP(9) + l * DM, F.lane, gpost);
    int cur = -1;
    u32x2 xn[4], fn[4], gn[4];
#define PF_ISSUE(i) do { const size_t r_ = (size_t)((i) / SEQ) * TPB + CTX + (i) % SEQ; ld_raw_bf16(X + r_ * DM, F.lane, xn); ld_raw_bf16(F2 + r_ * DM, F.lane, fn); ld_raw_bf16(F2 + ((size_t)M + r_) * DM, F.lane, gn); } while (0)
    PF_ISSUE(i0);
    for (int i = i0; i < i1; ++i) {
        f32x4 x[4], f[4];
#pragma unroll
        for (int j = 0; j < 4; ++j) { x[j] = raw2f(xn[j]); f[j] = raw2f(fn[j]) + raw2f(gn[j]); }
        if (i + 1 < i1) PF_ISSUE(i + 1);
        const int b = i / SEQ;
        if (b != cur) { cur = b; ld_vec(MOD + ((size_t)l * 17 + b) * 6144 + 5 * 1024, F.lane, gt); }
        const float rinv = row_rinv2(f);
#pragma unroll
        for (int j = 0; j < 4; ++j) x[j] = x[j] + gt[j] * (f[j] * rinv * gpost[j]);
        st_row_f32(F.A->out + (size_t)i * DM, F.lane, x);
    }
#undef PF_ISSUE
}
__device__ __forceinline__ void p7_rows(Frame& F, int l) {
    refresh(F);
    const float* MOD = (const float*)(F.ws + WS_MOD);
    bf16* X = (bf16*)(F.ws + WS_X); const bf16* Y = (const bf16*)(F.ws + WS_Y); bf16* H2 = (bf16*)(F.ws + WS_H2);
    const bool moe = l & 1; const int li = l >> 1;
    int* TOPE = (int*)(F.ws + WS_TOPE); int* LIDX = (int*)(F.ws + WS_LIDX); float* TOPW = (float*)(F.ws + WS_TOPW); int* BLKB = (int*)(F.ws + WS_BLKB);
    volatile LAS unsigned* LCNT = F.MISC + 16;
    LAS float* RT = (LAS float*)F.lds;
    if (moe) {
        const float* router = INP(20) + (size_t)li * DM * NE;
        if (F.tid < 8) LCNT[F.tid] = 0u;
        for (int i = F.tid; i < DM * NE / 4; i += 512) { const f32x4 q = *(const f32x4*)(router + 4 * i); const int c = i >> 1, e0 = (i & 1) * 4;
            RT[(e0 + 0) * DM + c] = q[0]; RT[(e0 + 1) * DM + c] = q[1]; RT[(e0 + 2) * DM + c] = q[2]; RT[(e0 + 3) * DM + c] = q[3]; }
        __syncthreads();
    }
    const bool lastl = (l == DEPTH - 1); const int NR = lastl ? NBATCH * SEQ : M;
#define P7_ROW(i) (lastl ? ((i) / SEQ) * TPB + CTX + (i) % SEQ : (i))
    const int rpw = (NR + F.NGW - 1) / F.NGW, r0 = F.gw * rpw, r1 = (r0 + rpw < NR) ? r0 + rpw : NR;
    if (r0 < r1) {
        f32x4 gpost[4], gpre[4], gt[4], sh[4], sc[4];
        ld_vec(INP(7) + l * DM, F.lane, gpost); ld_vec(INP(8) + l * DM, F.lane, gpre);
        int cur = -1;
        u32x2 xn[4], yn[4];
        ld_raw_bf16(X + (size_t)P7_ROW(r0) * DM, F.lane, xn); ld_raw_bf16_blk(Y, P7_ROW(r0), F.lane, yn);
        for (int ri = r0; ri < r1; ++ri) {
            const int r = P7_ROW(ri);
            f32x4 x[4], y[4];
#pragma unroll
            for (int j = 0; j < 4; ++j) { x[j] = raw2f(xn[j]); y[j] = raw2f(yn[j]); }
            if (ri + 1 < r1) { const int rn = P7_ROW(ri + 1); ld_raw_bf16(X + (size_t)rn * DM, F.lane, xn); ld_raw_bf16_blk(Y, rn, F.lane, yn); }
            const int b = r / TPB, p = r % TPB, mrow = p < CTX ? 16 : b;
            if (mrow != cur) { cur = mrow; const float* modp = MOD + ((size_t)l * 17 + mrow) * 6144; ld_vec(modp + 2 * 1024, F.lane, gt); ld_vec(modp + 3 * 1024, F.lane, sh); ld_vec(modp + 4 * 1024, F.lane, sc); }
            const float ry = row_rinv2(y);
#pragma unroll
            for (int j = 0; j < 4; ++j) x[j] = x[j] + gt[j] * (y[j] * ry * gpost[j]);
            st_row_bf16(X + (size_t)r * DM, F.lane, x);
            const float rx = row_rinv2(x);
            f32x4 h[4];
#pragma unroll
            for (int j = 0; j < 4; ++j) h[j] = (x[j] * rx * gpre[j]) * (sc[j] + 1.0f) + sh[j];
            if constexpr (FFN_F8) {
#pragma unroll
                for (int j = 0; j < 4; ++j) *(unsigned*)((unsigned char*)H2 + (size_t)r * DM + 4 * F.lane + 256 * j) = pk4_f8(h[j][0], h[j][1], h[j][2], h[j][3]);
            } else st_row_bf16(H2 + (size_t)r * DM, F.lane, h);
            if (moe) {
                float lg[8];
#pragma unroll
                for (int e = 0; e < 8; ++e) lg[e] = 0.f;
#pragma unroll
                for (int j = 0; j < 4; ++j)
#pragma unroll
                    for (int e = 0; e < 8; ++e) { const f32x4 q = *(const LAS f32x4*)(RT + e * DM + 4 * F.lane + 256 * j); lg[e] += (h[j][0] * q[0] + h[j][1] * q[1]) + (h[j][2] * q[2] + h[j][3] * q[3]); }
#pragma unroll
                for (int e = 0; e < 8; ++e) lg[e] = wave_sum2(lg[e]);
                int e0 = 0; float v0 = lg[0];
#pragma unroll
                for (int e = 1; e < 8; ++e) if (lg[e] > v0) { v0 = lg[e]; e0 = e; }
                int e1 = -1; float v1 = -3.0e38f;
#pragma unroll
                for (int e = 0; e < 8; ++e) if (e != e0 && lg[e] > v1) { v1 = lg[e]; e1 = e; }
                const float ex = __expf(v1 - v0), w0 = 1.f / (1.f + ex), w1 = ex / (1.f + ex);
                if (F.lane == 0) {
                    const unsigned i0 = __hip_atomic_fetch_add((LAS unsigned*)&LCNT[e0], 1u, __ATOMIC_RELAXED, __HIP_MEMORY_SCOPE_WORKGROUP), i1 = __hip_atomic_fetch_add((LAS unsigned*)&LCNT[e1], 1u, __ATOMIC_RELAXED, __HIP_MEMORY_SCOPE_WORKGROUP);
                    TOPE[r] = e0 | (e1 << 8); LIDX[2 * r] = (int)i0; LIDX[2 * r + 1] = (int)i1; TOPW[2 * r] = w0; TOPW[2 * r + 1] = w1;
                }
            }
        }
    }
    if (moe) {
        __syncthreads();
        if (F.tid < 8) { const unsigned base = __hip_atomic_fetch_add((unsigned*)((gu32*)F.ws + CW_CNT + 64 * li + F.tid), LCNT[F.tid], __ATOMIC_RELAXED, __HIP_MEMORY_SCOPE_AGENT); BLKB[F.blk * 8 + F.tid] = (int)base; }
    }
#undef P7_ROW
}
__device__ __forceinline__ void moe_offsets(Frame& F, int li, int (&cnt)[8], int (&off)[9]) {
    off[0] = 0;
#pragma unroll
    for (int e = 0; e < 8; ++e) { cnt[e] = (int)__hip_atomic_load((unsigned*)(((gu32*)F.ws) + CW_CNT + 64 * li + e), __ATOMIC_RELAXED, __HIP_MEMORY_SCOPE_AGENT); off[e + 1] = off[e] + ((cnt[e] + 255) & ~255); }
}
__device__ __forceinline__ void p7b_gather(Frame& F, int l) {
    refresh(F);
    const int li = l >> 1; int cnt[8], off[9]; moe_offsets(F, li, cnt, off);
    const bf16* H2 = (const bf16*)(F.ws + WS_H2); bf16* HG = (bf16*)(F.ws + WS_HG);
    const int* TOPE = (const int*)(F.ws + WS_TOPE); const int* LIDX = (const int*)(F.ws + WS_LIDX); const float* TOPW = (const float*)(F.ws + WS_TOPW); const int* BLKB = (const int*)(F.ws + WS_BLKB);
    int* RMAP = (int*)(F.ws + WS_RMAP); float* ROWW = (float*)(F.ws + WS_ROWW);
    constexpr int RB = FFN_F8 ? DM : 2 * DM, LB = RB / 64;
    const unsigned char* H2b = (const unsigned char*)H2; unsigned char* HGb = (unsigned char*)HG;
    const bool lastl = (l == DEPTH - 1); const int NR = lastl ? NBATCH * SEQ : M;
    const int rpw = (NR + F.NGW - 1) / F.NGW, r0 = F.gw * rpw, r1 = (r0 + rpw < NR) ? r0 + rpw : NR;
    for (int ri = r0; ri < r1; ++ri) {
        const int r = lastl ? (ri / SEQ) * TPB + CTX + ri % SEQ : ri;
        const int te = TOPE[r];
        v4u a, bq = {0u, 0u, 0u, 0u}; a = *(const v4u*)(H2b + (size_t)r * RB + F.lane * LB); if constexpr (!FFN_F8) bq = *(const v4u*)(H2b + (size_t)r * RB + F.lane * LB + 16);
#pragma unroll
        for (int s = 0; s < 2; ++s) {
            const int e = (te >> (8 * s)) & 0xff;
            int o = 0;
#pragma unroll
            for (int q = 0; q < 8; ++q) o = (q == e) ? off[q] : o;
            const int pos = o + BLKB[F.blk * 8 + e] + LIDX[2 * r + s];
            *(v4u*)(HGb + (size_t)pos * RB + F.lane * LB) = a; if constexpr (!FFN_F8) *(v4u*)(HGb + (size_t)pos * RB + F.lane * LB + 16) = bq;
            if (F.lane == 0) { RMAP[pos] = r | (s << 30); ROWW[pos] = TOPW[2 * r + s]; }
        }
    }
#pragma unroll
    for (int e = 0; e < 8; ++e) {
        const int npad = off[e + 1] - off[e] - cnt[e];
        for (int i = F.gw; i < npad; i += F.NGW) { const int pos = off[e] + cnt[e] + i; const unsigned zz = (unsigned)F.z; const v4u z = {zz, zz, zz, zz};
            *(v4u*)(HGb + (size_t)pos * RB + F.lane * LB) = z; if constexpr (!FFN_F8) *(v4u*)(HGb + (size_t)pos * RB + F.lane * LB + 16) = z;
            if (F.lane == 0) { RMAP[pos] = -1; ROWW[pos] = 0.f; } }
    }
}

__global__ void __launch_bounds__(NWAVES * 64, 2) mk_fwd(Args args) {
    extern __shared__ __attribute__((aligned(16))) unsigned char lds[];
    Frame F;
    F.lds = (LAS unsigned char*)lds;
    F.MISC = (volatile LAS unsigned*)(F.lds + MISC_OFF);
    F.tid = threadIdx.x; F.lane = F.tid & 63; F.wave = __builtin_amdgcn_readfirstlane(F.tid >> 6); F.wv = F.wave;
    F.G = gridDim.x; F.blk = blockIdx.x; F.gw = F.blk * NWAVES + F.wave; F.NGW = F.G * NWAVES;
    F.ws = args.ws;
    F.A = &args;
    for (int u = F.tid; u < 128; u += NWAVES * 64) F.MISC[u] = 0u;
    __syncthreads();
    { XcdBarrier b0 = xcd_barrier_post((unsigned*)F.ws + CW_BAR, F.MISC + 8); (void)b0; }
#define GRID_BAR() do { XcdBarrier b_; b_.bar = (unsigned*)F.ws + CW_BAR; b_.x = xb_xcc_id(); b_.st = F.MISC + 8; refresh(F); xcd_barrier(b_, F.tid == 0); } while (0)

    p0_mod(F); p0_misc(F); convert_weights(F, 0);
    GRID_BAR();
    for (int l = 0; l < DEPTH; ++l) {
        const bool moe = l & 1; const int li = l >> 1;
        { unsigned char* wsp = args.ws; asm volatile("" : "+s"(wsp)); F.ws = wsp; }
        p1_rows(F, l);
        if (l > 0) convert_weights(F, l);
        GRID_BAR();
        {
            refresh(F);
            pg8::Gemm g{(const pg8::bf16_t*)(F.ws + WS_H), (const pg8::bf16_t*)(F.ws + WS_WIN), M, NP, DM};
            pg8::StaticOrder S; S.init(M, NP, F.G, F.blk);
            pg8::EpiProj E{(pg8::bf16_t*)(F.ws + WS_PROJ), (const float*)(F.ws + WS_ROPE), (const float*)(F.ws + WS_ROPE) + 1024, (unsigned*)F.ws + CW_KMX + 256 * l};
            pg8::gemm_phase<pg8::EpiProj, pg8::StaticOrder, true, true>(F.lds, g, S, E, F.wave);
        }
        GRID_BAR();
        p3_mixer(F, l);
        GRID_BAR();
        p5_merge_all(F, l);
        GRID_BAR();
        {
            refresh(F);
            pg8::Gemm g{(const pg8::bf16_t*)(F.ws + WS_H), (const pg8::bf16_t*)(F.ws + WS_WOUT), M, DM, DM};
            const int lastl = (l == DEPTH - 1);
            pg8::LatOrder S; S.S.init(lastl ? NBATCH * SEQ : M, DM, F.G, F.blk); S.lat = lastl;
            pg8::EpiF32 E{(pg8::bf16_t*)(F.ws + WS_Y)};
            pg8::gemm_phase<pg8::EpiF32, pg8::LatOrder, true, true>(F.lds, g, S, E, F.wave);
        }
        GRID_BAR();
        p7_rows(F, l);
        GRID_BAR();
        if (moe) { p7b_gather(F, l); GRID_BAR(); }
        int ntiles = M / 256;
        {
            refresh(F);
            LAS int* texp = (LAS int*)(F.lds + TEXP_OFF);
            if (moe) { int cnt[8], off[9]; moe_offsets(F, li, cnt, off); ntiles = off[8] >> 8;
                for (int t = F.tid; t < ntiles; t += 512) { int e = 0;
#pragma unroll
                    for (int q = 1; q < 8; ++q) e += ((t << 8) >= off[q]) ? 1 : 0;
                    texp[t] = e; } }
            else { for (int t = F.tid; t < ntiles; t += 512) texp[t] = 0; }
            __syncthreads();
        }
        {
            refresh(F);
            pg8::Gemm g{(const pg8::bf16_t*)(F.ws + (moe ? WS_HG : WS_H2)), (const pg8::bf16_t*)(F.ws + WS_WUP), ntiles * 256, 2 * DFF, FFN_F8 ? DM / 2 : DM};
            pg8::GroupedOrder S; S.S.init(ntiles * 256, 2 * DFF, F.G, F.blk); S.texp = (const LAS int*)(F.lds + TEXP_OFF); S.nN = 22;
            pg8::EpiSwiglu E{(pg8::bf16_t*)(F.ws + WS_U)};
            pg8::gemm_phase<pg8::EpiSwiglu, pg8::GroupedOrder, true, true, FFN_F8 != 0>(F.lds, g, S, E, F.wave);
        }
        GRID_BAR();
        {
            refresh(F);
            pg8::Gemm g{(const pg8::bf16_t*)(F.ws + WS_U), (const pg8::bf16_t*)(F.ws + WS_WDN), ntiles * 256, DM, FFN_F8 ? DFF / 2 : DFF};
            pg8::GroupedOrder S; S.S.init(ntiles * 256, DM, F.G, F.blk); S.texp = (const LAS int*)(F.lds + TEXP_OFF); S.nN = 4;
            pg8::EpiDown E{(pg8::bf16_t*)(F.ws + WS_F2), (const int*)(F.ws + WS_RMAP), (const float*)(F.ws + WS_ROWW), moe ? 0 : 1};
            pg8::gemm_phase<pg8::EpiDown, pg8::GroupedOrder, true, true, FFN_F8 != 0>(F.lds, g, S, E, F.wave);
        }
        GRID_BAR();
    }
    pf_final(F);
}

extern "C" void kernel_launch(void* const* d_in, const int* in_sizes, int n_in, void* d_out, int out_size, void* d_ws, size_t ws_size, hipStream_t stream) {
    static int grid = 0;
    if (grid == 0) {
        if (n_in != 24 || out_size != NBATCH * SEQ * DM || ws_size < WS_END) { fprintf(stderr, "kernel_launch: unexpected shapes or workspace (%d inputs, out %d, ws %zu < %zu)\n", n_in, out_size, ws_size, (size_t)WS_END); grid = -1; return; }
        int dev = 0, cus = 0, per_cu = 0;
        if (hipGetDevice(&dev) != hipSuccess || hipDeviceGetAttribute(&cus, hipDeviceAttributeMultiprocessorCount, dev) != hipSuccess) { grid = -1; return; }
        if (hipFuncSetAttribute((const void*)mk_fwd, hipFuncAttributeMaxDynamicSharedMemorySize, LDS_BYTES) != hipSuccess) { grid = -1; return; }
        if (hipOccupancyMaxActiveBlocksPerMultiprocessor(&per_cu, (const void*)mk_fwd, NWAVES * 64, LDS_BYTES) != hipSuccess || per_cu < 1) { fprintf(stderr, "kernel_launch: occupancy query says %d\n", per_cu); }
        (void)hipGetLastError();
        grid = cus;
    }
    if (grid < 0) return;
    if (hipMemsetAsync((char*)d_ws + WS_CTL, 0, CTL_ZERO_BYTES, stream) != hipSuccess) return;
    Args a{};
    for (int i = 0; i < 24; ++i) a.in[i] = (const float*)d_in[i];
    a.out = (float*)d_out; a.ws = (unsigned char*)d_ws;
    hipLaunchKernelGGL(mk_fwd, dim3(grid), dim3(NWAVES * 64), LDS_BYTES, stream, a);
}
```
